# Optimizing an MI355X kernel written in HIP

```python
import jax, jax.numpy as jnp
from jax import lax
import numpy as np

D_MODEL = 1024
BATCH = 8
SEQ = 4096
DEPTH = 2

CTX_LEN = 256
GRID_W = 64
HEAD_DIM = 64
H_ML = 4
H_NA = 6
H_GQ = 6
H_KV = 2
D_ML = H_ML * HEAD_DIM
D_NA = H_NA * HEAD_DIM
D_GQ = H_GQ * HEAD_DIM
D_KV = H_KV * HEAD_DIM
GQ_GROUP = H_GQ // H_KV
N_BRANCH = 3
D_FF = 2816
NA_WIN_R = 8
NA_WIN_C = 16
ML_CHUNK = 64
Q_BLOCK = 128
ROPE_THETA = 10000.0
EPS = 1e-6
N_MOD = 9
ATTN_SCALE = HEAD_DIM ** -0.5
KV_SPLITS = (D_ML, D_ML, 4 * H_ML, D_NA, D_NA, D_KV, D_KV)
Q_SPLITS = (D_ML, D_ML, D_NA, D_GQ, N_BRANCH * D_MODEL)
N_KV_COLS = sum(KV_SPLITS)
N_IN = N_KV_COLS + sum(Q_SPLITS)

kernel_name = 'hybrid_mlstm_natten_gqa_prefix_block'


def _split(a, sizes):
    return jnp.split(a, np.cumsum(sizes)[:-1].tolist(), axis=-1)


def _heads(a, n):
    return a.reshape(a.shape[:-1] + (n, HEAD_DIM))


def rms_norm(x, w):
    x32 = x.astype(jnp.float32)
    y = x32 * lax.rsqrt(jnp.mean(x32 * x32, axis=-1, keepdims=True) + EPS)
    return (y * w.astype(jnp.float32)).astype(x.dtype)


def modulate(x, w_norm, shift, scale):
    return rms_norm(x, w_norm) * (1 + scale) + shift


def swiglu(h, w_in, w_out):
    g, u = jnp.split(h @ w_in, 2, axis=-1)
    return (jax.nn.silu(g) * u) @ w_out


def axial_rope(n_tok):
    t = jnp.arange(n_tok, dtype=jnp.int32)
    row = (t // GRID_W).astype(jnp.float32)
    col = (t % GRID_W).astype(jnp.float32)
    n_freq = HEAD_DIM // 4
    inv = ROPE_THETA ** (-jnp.arange(n_freq, dtype=jnp.float32) / n_freq)
    ang = jnp.concatenate([row[:, None] * inv, col[:, None] * inv], axis=-1)
    return jnp.cos(ang)[:, None, :], jnp.sin(ang)[:, None, :]


def apply_rope(x, cos, sin):
    x32 = x.astype(jnp.float32)
    x1, x2 = jnp.split(x32, 2, axis=-1)
    return jnp.concatenate([x1 * cos - x2 * sin, x1 * sin + x2 * cos], axis=-1).astype(x.dtype)


def attend(q, k, v):
    s = jnp.einsum('btkgd,bnkd->bkgtn', q, k).astype(jnp.float32) * ATTN_SCALE
    p = jax.nn.softmax(s, axis=-1).astype(v.dtype)
    return jnp.einsum('bkgtn,bnkd->btkgd', p, v)


def gqa_latent(q, k, v, kc, vc):
    B, S = q.shape[:2]
    k_all = jnp.concatenate([k, kc], axis=1)
    v_all = jnp.concatenate([v, vc], axis=1)
    qb = q.reshape(B, S // Q_BLOCK, Q_BLOCK, H_KV, GQ_GROUP, HEAD_DIM).swapaxes(0, 1)
    out = lax.map(lambda qi: attend(qi, k_all, v_all), qb)
    return out.swapaxes(0, 1).reshape(B, S, D_GQ)


def na_latent(q, k, v, kc, vc, rpb, n_rows):
    B, S, H, d = q.shape
    wr = min(NA_WIN_R, n_rows)
    n_win = wr * NA_WIN_C
    col = np.arange(GRID_W)
    col_idx = np.clip(col - NA_WIN_C // 2, 0, GRID_W - NA_WIN_C)[:, None] + np.arange(NA_WIN_C)[None, :]
    col_off = col_idx - col[:, None] + NA_WIN_C - 1
    grid = lambda a: a.reshape(B, n_rows, GRID_W, H, d)
    kg, vg = grid(k), grid(v)
    qg = jnp.swapaxes(grid(q), 0, 1)

    def row_block(args):
        r, q_r = args
        rs = jnp.clip(r - wr // 2, 0, n_rows - wr)

        def window(a):
            band = lax.dynamic_slice_in_dim(a, rs, wr, axis=1)
            return jnp.swapaxes(band[:, :, col_idx], 1, 2).reshape(B, GRID_W, n_win, H, d)

        kw, vw = window(kg), window(vg)
        row_off = rs + jnp.arange(wr) - r + NA_WIN_R - 1
        bias = rpb[:, row_off][:, :, col_off]
        bias = jnp.swapaxes(bias, 1, 2).reshape(H, GRID_W, n_win).astype(jnp.float32)
        s_win = jnp.einsum('bwhd,bwnhd->bhwn', q_r, kw).astype(jnp.float32) * ATTN_SCALE + bias
        s_ctx = jnp.einsum('bwhd,blhd->bhwl', q_r, kc).astype(jnp.float32) * ATTN_SCALE
        p = jax.nn.softmax(jnp.concatenate([s_win, s_ctx], axis=-1), axis=-1).astype(v.dtype)
        return (jnp.einsum('bhwn,bwnhd->bwhd', p[..., :n_win], vw)
                + jnp.einsum('bhwl,blhd->bwhd', p[..., n_win:], vc))

    out = lax.map(row_block, (jnp.arange(n_rows, dtype=jnp.int32), qg))
    return jnp.swapaxes(out, 0, 1).reshape(B, S, H * d)


def mlstm_scan(q, k, v, ig, lf, state):
    B, T, H, d = k.shape
    nc = T // ML_CHUNK
    chunked = lambda a: jnp.swapaxes(a.reshape((B, nc, ML_CHUNK) + a.shape[2:]), 0, 1)
    with_out = q is not None
    xs = (chunked(k), chunked(v), chunked(ig), chunked(lf)) + ((chunked(q),) if with_out else ())
    tri = jnp.asarray(np.tril(np.ones((ML_CHUNK, ML_CHUNK), dtype=bool)))

    def step(carry, xs_c):
        C, n, m = carry
        kc, vc, ic, fc = xs_c[:4]
        b = jnp.cumsum(fc, axis=1)
        b_tot = b[:, -1]
        w_end = b_tot[:, None] - b + ic
        m_new = jnp.maximum(b_tot + m, jnp.max(w_end, axis=1))
        a_end = jnp.exp(w_end - m_new[:, None])
        decay = jnp.exp(b_tot + m - m_new)
        C_new = decay[..., None, None] * C + jnp.einsum('blh,blhk,blhv->bhkv', a_end, kc, vc)
        n_new = decay[..., None] * n + jnp.einsum('blh,blhk->bhk', a_end, kc)
        if not with_out:
            return (C_new, n_new, m_new), None
        q_c = xs_c[4]
        m_inter = b + m[:, None]
        logw = b[:, :, None] - b[:, None, :] + ic[:, None]
        logw = jnp.where(tri[None, :, :, None], logw, -jnp.inf)
        m_j = jnp.maximum(m_inter, jnp.max(logw, axis=2))
        w = jnp.exp(logw - m_j[:, :, None])
        g = jnp.exp(m_inter - m_j)
        qk = jnp.einsum('bjhd,bshd->bjsh', q_c, kc) * w
        num = jnp.einsum('bjsh,bshd->bjhd', qk, vc) + g[..., None] * jnp.einsum('bjhk,bhkv->bjhv', q_c, C)
        den = jnp.sum(qk, axis=2) + g * jnp.einsum('bjhk,bhk->bjh', q_c, n)
        h = num / jnp.maximum(jnp.abs(den), jnp.exp(-m_j))[..., None]
        return (C_new, n_new, m_new), h

    state, hs = lax.scan(step, state, xs)
    h = None if hs is None else jnp.swapaxes(hs, 0, 1).reshape(B, T, H, d)
    return state, h


def mlstm_gates(pre, bias):
    g = (pre.astype(jnp.float32) + bias.astype(jnp.float32)).reshape(pre.shape[:-1] + (4, H_ML))
    fwd = (g[..., 0, :], jax.nn.log_sigmoid(g[..., 1, :]))
    bwd = (g[..., 2, :], jax.nn.log_sigmoid(g[..., 3, :]))
    return fwd, bwd


def _flip(a):
    return None if a is None else jnp.flip(a, axis=1)


def mlstm_bidir(q, k, v, g_pre, qc, kc, vc, gc_pre, gate_b):
    f32 = jnp.float32
    B = k.shape[0]
    q, k, v = q.astype(f32), k.astype(f32) * ATTN_SCALE, v.astype(f32)
    kc, vc = kc.astype(f32) * ATTN_SCALE, vc.astype(f32)
    qc = None if qc is None else qc.astype(f32)
    (ig_f, lf_f), (ig_b, lf_b) = mlstm_gates(g_pre, gate_b)
    (igc_f, lfc_f), (igc_b, lfc_b) = mlstm_gates(gc_pre, gate_b)
    init = (jnp.zeros((B, H_ML, HEAD_DIM, HEAD_DIM), f32), jnp.zeros((B, H_ML, HEAD_DIM), f32),
            jnp.zeros((B, H_ML), f32))
    st_f, hc_f = mlstm_scan(qc, kc, vc, igc_f, lfc_f, init)
    _, h_f = mlstm_scan(q, k, v, ig_f, lf_f, st_f)
    st_b, hc_b = mlstm_scan(_flip(qc), _flip(kc), _flip(vc), _flip(igc_b), _flip(lfc_b), init)
    _, h_b = mlstm_scan(_flip(q), _flip(k), _flip(v), _flip(ig_b), _flip(lf_b), st_b)
    h = h_f + _flip(h_b)
    h_c = None if qc is None else hc_f + _flip(hc_b)
    return h, h_c


def mlstm_out(h, o, norm_w):
    y = rms_norm(h, norm_w.reshape(H_ML, HEAD_DIM)).astype(o.dtype)
    return y.reshape(o.shape) * jax.nn.sigmoid(o)


def merge_branches(br_g, o_ml, o_na, o_gq, w_br_ml, w_br_na, w_br_gq, w_out):
    g_ml, g_na, g_gq = jnp.split(jax.nn.sigmoid(br_g), N_BRANCH, axis=-1)
    y = g_ml * (o_ml @ w_br_ml) + g_na * (o_na @ w_br_na) + g_gq * (o_gq @ w_br_gq)
    return y @ w_out


def token_mixer(hx, hc, n_rows, cos, sin, w_in, ml_gate_b, ml_norm_w, na_qk_w, na_rpb, gq_qk_w,
                w_br_ml, w_br_na, w_br_gq, w_out, ctx_out):
    B, S, _ = hx.shape
    L = hc.shape[1]
    px = hx @ w_in
    pc = hc @ (w_in if ctx_out else w_in[:, :N_KV_COLS])
    ml_k, ml_v, ml_g, na_k, na_v, gq_k, gq_v = _split(px[..., :N_KV_COLS], KV_SPLITS)
    ml_q, ml_o, na_q, gq_q, br_g = _split(px[..., N_KV_COLS:], Q_SPLITS)
    cml_k, cml_v, cml_g, cna_k, cna_v, cgq_k, cgq_v = _split(pc[..., :N_KV_COLS], KV_SPLITS)
    if ctx_out:
        cml_q, cml_o, cna_q, cgq_q, cbr_g = _split(pc[..., N_KV_COLS:], Q_SPLITS)

    h_ml, hc_ml = mlstm_bidir(_heads(ml_q, H_ML), _heads(ml_k, H_ML), _heads(ml_v, H_ML), ml_g,
                              _heads(cml_q, H_ML) if ctx_out else None,
                              _heads(cml_k, H_ML), _heads(cml_v, H_ML), cml_g, ml_gate_b)
    o_ml = mlstm_out(h_ml, ml_o, ml_norm_w)

    nq = rms_norm(_heads(na_q, H_NA), na_qk_w[0])
    nk = rms_norm(_heads(na_k, H_NA), na_qk_w[1])
    cnk = rms_norm(_heads(cna_k, H_NA), na_qk_w[1])
    cnv = _heads(cna_v, H_NA)
    o_na = na_latent(nq, nk, _heads(na_v, H_NA), cnk, cnv, na_rpb, n_rows)

    gq = apply_rope(rms_norm(_heads(gq_q, H_GQ), gq_qk_w[0]), cos, sin)
    gk = apply_rope(rms_norm(_heads(gq_k, H_KV), gq_qk_w[1]), cos, sin)
    cgk = rms_norm(_heads(cgq_k, H_KV), gq_qk_w[1])
    cgv = _heads(cgq_v, H_KV)
    o_gq = gqa_latent(gq, gk, _heads(gq_v, H_KV), cgk, cgv)

    yx = merge_branches(br_g, o_ml, o_na, o_gq, w_br_ml, w_br_na, w_br_gq, w_out)
    if not ctx_out:
        return yx, None
    co_ml = mlstm_out(hc_ml, cml_o, ml_norm_w)
    cq_na = rms_norm(_heads(cna_q, H_NA), na_qk_w[0])[:, :, :, None, :]
    co_na = attend(cq_na, cnk, cnv).reshape(B, L, D_NA)
    cq_gq = rms_norm(_heads(cgq_q, H_GQ), gq_qk_w[0]).reshape(B, L, H_KV, GQ_GROUP, HEAD_DIM)
    co_gq = attend(cq_gq, cgk, cgv).reshape(B, L, D_GQ)
    yc = merge_branches(cbr_g, co_ml, co_na, co_gq, w_br_ml, w_br_na, w_br_gq, w_out)
    return yx, yc


def setup_inputs(seed: int = 0) -> dict:
    key = jax.random.key(seed)
    ks = jax.random.split(key, 20)
    nrm = lambda k, shape, s: s * jax.random.normal(k, shape, jnp.float32)
    gate_base = np.concatenate([np.zeros(H_ML), np.linspace(3.0, 6.0, H_ML),
                                np.zeros(H_ML), np.linspace(3.0, 6.0, H_ML)]).astype(np.float32)
    return {
        'x': nrm(ks[0], (BATCH, SEQ, D_MODEL), 1.0),
        'c': nrm(ks[1], (BATCH, D_MODEL), 1.0),
        'ctx': nrm(ks[2], (BATCH, CTX_LEN, D_MODEL), 1.0),
        'c_ctx': nrm(ks[3], (D_MODEL,), 1.0),
        'ada_w': nrm(ks[4], (DEPTH, D_MODEL, N_MOD * D_MODEL), 0.5 * D_MODEL ** -0.5),
        'ada_b': nrm(ks[5], (DEPTH, N_MOD * D_MODEL), 0.01),
        'norm_w': 1.0 + nrm(ks[6], (DEPTH, 3, D_MODEL), 0.02),
        'ffn_w_in': nrm(ks[7], (DEPTH, 2, D_MODEL, 2 * D_FF), D_MODEL ** -0.5),
        'ffn_w_out': nrm(ks[8], (DEPTH, 2, D_FF, D_MODEL), D_FF ** -0.5),
        'mix_w_in': nrm(ks[9], (DEPTH, D_MODEL, N_IN), D_MODEL ** -0.5),
        'ml_gate_b': jnp.asarray(gate_base)[None, :] + nrm(ks[10], (DEPTH, 4 * H_ML), 0.01),
        'ml_norm_w': 1.0 + nrm(ks[11], (DEPTH, D_ML), 0.02),
        'na_qk_w': 1.0 + nrm(ks[12], (DEPTH, 2, HEAD_DIM), 0.02),
        'na_rpb': nrm(ks[13], (DEPTH, H_NA, 2 * NA_WIN_R - 1, 2 * NA_WIN_C - 1), 0.2),
        'gq_qk_w': 1.0 + nrm(ks[14], (DEPTH, 2, HEAD_DIM), 0.02),
        'w_br_ml': nrm(ks[15], (DEPTH, D_ML, D_MODEL), D_ML ** -0.5),
        'w_br_na': nrm(ks[16], (DEPTH, D_NA, D_MODEL), D_NA ** -0.5),
        'w_br_gq': nrm(ks[17], (DEPTH, D_GQ, D_MODEL), D_GQ ** -0.5),
        'w_out': nrm(ks[18], (DEPTH, D_MODEL, D_MODEL), D_MODEL ** -0.5),
    }


def reference(x, c, ctx, c_ctx, ada_w, ada_b, norm_w, ffn_w_in, ffn_w_out, mix_w_in, ml_gate_b,
              ml_norm_w, na_qk_w, na_rpb, gq_qk_w, w_br_ml, w_br_na, w_br_gq, w_out):
    n_rows = x.shape[1] // GRID_W
    cos, sin = axial_rope(x.shape[1])
    xc = ctx
    silu_c = jax.nn.silu(c)
    silu_cc = jax.nn.silu(c_ctx)
    for l in range(DEPTH):
        ctx_out = l < DEPTH - 1
        mx = jnp.split((silu_c @ ada_w[l] + ada_b[l])[:, None, :], N_MOD, axis=-1)
        mc = jnp.split(silu_cc @ ada_w[l] + ada_b[l], N_MOD, axis=-1)
        x = x + 0.5 * mx[2] * swiglu(modulate(x, norm_w[l, 0], mx[0], mx[1]), ffn_w_in[l, 0], ffn_w_out[l, 0])
        xc = xc + 0.5 * mc[2] * swiglu(modulate(xc, norm_w[l, 0], mc[0], mc[1]), ffn_w_in[l, 0], ffn_w_out[l, 0])
        yx, yc = token_mixer(modulate(x, norm_w[l, 1], mx[3], mx[4]), modulate(xc, norm_w[l, 1], mc[3], mc[4]),
                             n_rows, cos, sin, mix_w_in[l], ml_gate_b[l], ml_norm_w[l], na_qk_w[l], na_rpb[l],
                             gq_qk_w[l], w_br_ml[l], w_br_na[l], w_br_gq[l], w_out[l], ctx_out)
        x = x + mx[5] * yx
        x = x + 0.5 * mx[8] * swiglu(modulate(x, norm_w[l, 2], mx[6], mx[7]), ffn_w_in[l, 1], ffn_w_out[l, 1])
        if ctx_out:
            xc = xc + mc[5] * yc
            xc = xc + 0.5 * mc[8] * swiglu(modulate(xc, norm_w[l, 2], mc[6], mc[7]), ffn_w_in[l, 1], ffn_w_out[l, 1])
    return x
```

```cpp
#include <hip/hip_runtime.h>
#include <hip/hip_cooperative_groups.h>
#include <stdint.h>
#include <cstdio>
namespace cg = cooperative_groups;

#ifndef ONE_LAUNCH
#define ONE_LAUNCH 1
#endif

#define VTID ((int)((threadIdx.x + p.z) & 255))
typedef unsigned short u16;
typedef __attribute__((ext_vector_type(8))) short bf16x8;
typedef __attribute__((ext_vector_type(4))) float f32x4;
#define DEV __device__ __forceinline__

constexpr int D = 1024, NB = 8, SEQ = 4096, CTXL = 256;
constexpr int NL = NB * SEQ, NCX = NB * CTXL, MTOT = NL + NCX;
constexpr int DFF = 2816, PW = 2816, UT = SEQ + CTXL, NCH = UT / 64;
constexpr int NIN = 5904;
constexpr int PC_MLQ = 0, PC_NAQ = 256, PC_GQQ = 640, PC_MLO = 1024, PC_MLK = 1280, PC_NAK = 1536, PC_GQK = 1920,
              PC_MLV = 2048, PC_NAV = 2304, PC_GQV = 2688, PC_Y = 1024;
constexpr int TC_MLK = 0, TC_MLV = 256, TC_NAV = 512, TC_GQV = 896, TW = 1024;
constexpr int DBG_MLO = PC_MLQ, DBG_NAO = PC_NAQ;
constexpr int SCH = 4160;
constexpr int NSCAN = 64;

constexpr size_t al256(size_t x) { return (x + 255) & ~(size_t)255; }
constexpr size_t OFF_MODS = 0;
constexpr size_t OFF_ROPE = al256(OFF_MODS + (size_t)9 * 9216 * 4);
constexpr size_t OFF_G    = al256(OFF_ROPE + (size_t)4096 * 64 * 4);
constexpr size_t OFF_BC   = al256(OFF_G + (size_t)MTOT * 16 * 4);
constexpr size_t OFF_IG   = al256(OFF_BC + (size_t)NSCAN * UT * 4);
constexpr size_t OFF_AE   = al256(OFF_IG + (size_t)NSCAN * UT * 4);
constexpr size_t OFF_MS   = al256(OFF_AE + (size_t)NSCAN * UT * 4);
constexpr size_t OFF_DEC  = al256(OFF_MS + (size_t)NSCAN * NCH * 4);
constexpr size_t OFF_XC   = al256(OFF_DEC + (size_t)NSCAN * NCH * 4);
constexpr size_t OFF_H    = al256(OFF_XC + (size_t)NCX * D * 4);
constexpr size_t OFF_P    = al256(OFF_H + (size_t)MTOT * D * 2);
constexpr size_t OFF_T    = al256(OFF_P + (size_t)MTOT * PW * 2);
constexpr size_t OFF_S    = al256(OFF_T + (size_t)NB * TW * UT * 2);
constexpr size_t OFF_W    = al256(OFF_S + (size_t)NSCAN * NCH * SCH * 4);
constexpr size_t WE_IN0 = 0, WE_IN1 = WE_IN0 + (size_t)5632 * 1024, WE_OUT0 = WE_IN1 + (size_t)5632 * 1024,
                 WE_OUT1 = WE_OUT0 + (size_t)1024 * 2816, WE_MIX = WE_OUT1 + (size_t)1024 * 2816,
                 WE_BR = WE_MIX + (size_t)6016 * 1024, WE_O = WE_BR + (size_t)1024 * 1024, WE_END = WE_O + (size_t)1024 * 1024;
constexpr size_t OFF_BAR = al256(OFF_W + WE_END * 2);
constexpr size_t WS_END = OFF_BAR + 3456 * 4;
static_assert(WS_END < (size_t)536000000, "workspace too large");

struct Params {
    const float *x, *c, *ctx, *c_ctx, *ada_w, *ada_b, *norm_w, *ffn_w_in, *ffn_w_out, *mix_w_in, *ml_gate_b, *ml_norm_w,
        *na_qk_w, *na_rpb, *gq_qk_w, *w_br_ml, *w_br_na, *w_br_gq, *w_out;
    float* out;
    char* ws;
    int z, pad;
};

DEV uint32_t pk2(float lo, float hi) { uint32_t r; asm("v_cvt_pk_bf16_f32 %0, %1, %2" : "=v"(r) : "v"(lo), "v"(hi)); return r; }
DEV float bflo(uint32_t w) { return __uint_as_float(w << 16); }
DEV float bfhi(uint32_t w) { return __uint_as_float(w & 0xffff0000u); }
DEV f32x4 mfma16(bf16x8 a, bf16x8 b, f32x4 c) { return __builtin_amdgcn_mfma_f32_16x16x32_bf16(a, b, c, 0, 0, 0); }
typedef unsigned u32x4 __attribute__((ext_vector_type(4)));
DEV u32x4 gld16(const void* q) { u32x4 r; asm volatile("global_load_dwordx4 %0, %1, off" : "=v"(r) : "v"(q) : "memory"); return r; }
DEV u32x4 gld16s(const void* sbase, unsigned voff) { u32x4 r; asm volatile("global_load_dwordx4 %0, %1, %2" : "=v"(r) : "v"(voff), "s"(sbase) : "memory"); return r; }
DEV void glds16(const void* sbase, unsigned voff, unsigned ldsaddr) {
    asm volatile("s_mov_b32 m0, %2\n\ts_nop 0\n\tglobal_load_lds_dwordx4 %0, %1" :: "v"(voff), "s"(sbase), "s"(ldsaddr) : "memory", "m0");
}
#define VM_WAIT0() asm volatile("s_waitcnt vmcnt(0)" ::: "memory")
union Frag { bf16x8 v; uint4 q; uint32_t u[4]; uint2 d[2]; };
DEV int cu_of(int c, int dir) { return c < 4 ? 64 + (dir ? 3 - c : c) : (dir ? 63 - (c - 4) : (c - 4)); }
DEV int rowof(int b, int u) { return u < SEQ ? b * SEQ + u : NL + b * CTXL + (u - SEQ); }
DEV float fexp2(float x) { return __builtin_amdgcn_exp2f(x); }
DEV float fexp(float x) { return __builtin_amdgcn_exp2f(x * 1.4426950408889634f); }
DEV float sigmoidf_(float x) { return 1.f / (1.f + fexp(-x)); }
DEV float xq_max(float v) {
    auto r = __builtin_amdgcn_permlane16_swap(__float_as_uint(v), __float_as_uint(v), false, false);
    const float m = fmaxf(__uint_as_float(r[0]), __uint_as_float(r[1]));
    auto q = __builtin_amdgcn_permlane32_swap(__float_as_uint(m), __float_as_uint(m), false, false);
    return fmaxf(__uint_as_float(q[0]), __uint_as_float(q[1]));
}
DEV float xq_sum(float v) {
    auto r = __builtin_amdgcn_permlane16_swap(__float_as_uint(v), __float_as_uint(v), false, false);
    const float m = __uint_as_float(r[0]) + __uint_as_float(r[1]);
    auto q = __builtin_amdgcn_permlane32_swap(__float_as_uint(m), __float_as_uint(m), false, false);
    return __uint_as_float(q[0]) + __uint_as_float(q[1]);
}
DEV float wave_sum(float v) {
#pragma unroll
    for (int o = 1; o < 64; o <<= 1) v += __shfl_xor(v, o);
    return v;
}
DEV float wave_max(float v) {
#pragma unroll
    for (int o = 1; o < 64; o <<= 1) v = fmaxf(v, __shfl_xor(v, o));
    return v;
}

#define WSP(T_, off) ((T_*)(p.ws + (off)))
DEV float m_scan(const Params& p, int sc, int c_end) {
    const float* BT = WSP(float, OFF_MS) + sc * NCH;
    const float* MX = WSP(float, OFF_DEC) + sc * NCH;
    const int lane = VTID & 63;
    const float bt0 = BT[lane], mx0 = MX[lane], bt1 = BT[64 + (lane & 3)], mx1 = MX[64 + (lane & 3)];
    float m = 0.f;
    for (int c = 0; c < c_end; ++c) {
        const float b = c < 64 ? __shfl(bt0, c) : __shfl(bt1, c - 64);
        const float x = c < 64 ? __shfl(mx0, c) : __shfl(mx1, c - 64);
        m = fmaxf(b + m, x);
    }
    return m;
}

template <int TN>
DEV void gemm_accum(f32x4 (&acc)[4][TN], const u16* __restrict__ A, int lda, const u16* __restrict__ B, int ldb, int K, char* smem, int tid) {
    constexpr int BROWS = TN * 32;
    constexpr int STAGE = (128 + BROWS) * 144;
    constexpr int NBCH = BROWS / 32;
    const int lane = tid & 63, wave = tid >> 6;
    const int wm = wave >> 1, wn = wave & 1, fr = lane & 15, fq = lane >> 4;
    const int lrow = tid >> 3, lc8 = tid & 7;
    const u16* ga = A + (size_t)lrow * lda + lc8 * 8;
    const u16* gb = B + (size_t)lrow * ldb + lc8 * 8;
    u32x4 ra[4], rb[NBCH];
    const int nk = K >> 6;
#pragma unroll
    for (int i = 0; i < 4; ++i) ra[i] = gld16(ga + (size_t)(32 * i) * lda);
#pragma unroll
    for (int i = 0; i < NBCH; ++i) rb[i] = gld16(gb + (size_t)(32 * i) * ldb);
    char* sw = smem + lrow * 144 + lc8 * 16;
    VM_WAIT0();
#pragma unroll
    for (int i = 0; i < 4; ++i) *(u32x4*)(sw + i * 32 * 144) = ra[i];
#pragma unroll
    for (int i = 0; i < NBCH; ++i) *(u32x4*)(sw + 128 * 144 + i * 32 * 144) = rb[i];
    __syncthreads();
    const char* sa_r = smem + (wm * 64 + fr) * 144 + fq * 16;
    const char* sb_r = smem + 128 * 144 + (wn * TN * 16 + fr) * 144 + fq * 16;
    for (int kt = 0; kt < nk; ++kt) {
        const int cur = kt & 1;
        const int k0 = (kt + 1 < nk ? kt + 1 : kt) * 64;
#pragma unroll
        for (int i = 0; i < 4; ++i) ra[i] = gld16(ga + (size_t)(32 * i) * lda + k0);
#pragma unroll
        for (int i = 0; i < NBCH; ++i) rb[i] = gld16(gb + (size_t)(32 * i) * ldb + k0);
        __builtin_amdgcn_sched_barrier(0);
#pragma unroll
        for (int ks = 0; ks < 2; ++ks) {
            bf16x8 af[4], bfr[TN];
#pragma unroll
            for (int mt = 0; mt < 4; ++mt) af[mt] = *(const bf16x8*)(sa_r + cur * STAGE + mt * 16 * 144 + ks * 64);
#pragma unroll
            for (int nt = 0; nt < TN; ++nt) bfr[nt] = *(const bf16x8*)(sb_r + cur * STAGE + nt * 16 * 144 + ks * 64);
#pragma unroll
            for (int mt = 0; mt < 4; ++mt)
#pragma unroll
                for (int nt = 0; nt < TN; ++nt) acc[mt][nt] = mfma16(af[mt], bfr[nt], acc[mt][nt]);
        }
        __builtin_amdgcn_sched_barrier(0);
        VM_WAIT0();
        {
            char* sw2 = sw + (cur ^ 1) * STAGE;
#pragma unroll
            for (int i = 0; i < 4; ++i) *(u32x4*)(sw2 + i * 32 * 144) = ra[i];
#pragma unroll
            for (int i = 0; i < NBCH; ++i) *(u32x4*)(sw2 + 128 * 144 + i * 32 * 144) = rb[i];
        }
        __syncthreads();
    }
}

template <int TN>
DEV void zero_acc(f32x4 (&acc)[4][TN]) {
#pragma unroll
    for (int i = 0; i < 4; ++i)
#pragma unroll
        for (int j = 0; j < TN; ++j) acc[i][j] = f32x4{0.f, 0.f, 0.f, 0.f};
}

DEV void tile_decode(int t, int ntn, int& mt, int& nt) {
    const int per = 8 * ntn;
    const int gi = t / per, rem = t - gi * per;
    nt = rem >> 3;
    mt = gi * 8 + (rem & 7);
}


DEV void gemm8_accum(f32x4 (&acc)[8][4], const u16* __restrict__ A, int lda, const u16* __restrict__ B, int ldb, int K, char* smem, int tid) {
    constexpr int STAGE = 65536;
    const int lane = tid & 63, wave = tid >> 6;
    const int wm = wave >> 2, wn = wave & 3, fr = lane & 15, fq = lane >> 4;
    const int lr = lane >> 3, pos = lane & 7;
    const int ce = pos ^ (lr >> 1), co = pos ^ (4 | (lr >> 1));
    const unsigned ra_ = (unsigned)((wave * 32 + lr) * lda) * 2u, rb_ = (unsigned)((wave * 32 + lr) * ldb) * 2u;
    const unsigned voa_e = ra_ + ce * 16, voa_o = ra_ + co * 16, vob_e = rb_ + ce * 16, vob_o = rb_ + co * 16;
    const int nk = K >> 6;
    const unsigned ldsw = __builtin_amdgcn_readfirstlane((unsigned)(size_t)(__attribute__((address_space(3))) char*)smem + wave * 4096);
#define G8_ISSUE(STG, K0) do { \
        _Pragma("unroll") for (int i = 0; i < 4; ++i) { \
            glds16(A + (size_t)(8 * i) * lda + (K0), (i & 1) ? voa_o : voa_e, ldsw + (STG) * STAGE + i * 1024); \
            glds16(B + (size_t)(8 * i) * ldb + (K0), (i & 1) ? vob_o : vob_e, ldsw + (STG) * STAGE + 32768 + i * 1024); \
        } } while (0)
    G8_ISSUE(0, 0);
    VM_WAIT0();
    __syncthreads();
    const int s3 = (fr >> 1) & 7;
    const int oa_base = (wm * 128 + fr) * 128 + ((fq ^ s3) * 16);
    const int ob_base = 32768 + (wn * 64 + fr) * 128 + ((fq ^ s3) * 16);
    for (int kt = 0; kt < nk; ++kt) {
        const int cur = kt & 1;
        const int k0 = (kt + 1 < nk ? kt + 1 : kt) * 64;
        G8_ISSUE(cur ^ 1, k0);
        int o_a = cur * STAGE + oa_base, o_b = cur * STAGE + ob_base;
        asm volatile("" : "+v"(o_a), "+v"(o_b));
#pragma unroll
        for (int ks = 0; ks < 2; ++ks) {
            const char* sa_c = smem + (ks ? (o_a ^ 64) : o_a);
            const char* sb_c = smem + (ks ? (o_b ^ 64) : o_b);
            bf16x8 bfr[4], af[8];
#pragma unroll
            for (int nt = 0; nt < 4; ++nt) bfr[nt] = *(const bf16x8*)(sb_c + nt * 2048);
#pragma unroll
            for (int mt = 0; mt < 8; ++mt) af[mt] = *(const bf16x8*)(sa_c + mt * 2048);
#pragma unroll
            for (int mt = 0; mt < 8; ++mt)
#pragma unroll
                for (int nt = 0; nt < 4; ++nt) acc[mt][nt] = mfma16(af[mt], bfr[nt], acc[mt][nt]);
            __builtin_amdgcn_sched_group_barrier(0x100, 7, 0);
#pragma unroll
            for (int i = 0; i < 5; ++i) { __builtin_amdgcn_sched_group_barrier(0x008, 4, 0); __builtin_amdgcn_sched_group_barrier(0x100, 1, 0); }
#pragma unroll
            for (int i = 0; i < 3; ++i) __builtin_amdgcn_sched_group_barrier(0x008, 4, 0);
        }
        VM_WAIT0();
        __syncthreads();
    }
#undef G8_ISSUE
}
DEV void zero_acc8(f32x4 (&acc)[8][4]) {
#pragma unroll
    for (int i = 0; i < 8; ++i)
#pragma unroll
        for (int j = 0; j < 4; ++j) acc[i][j] = f32x4{0.f, 0.f, 0.f, 0.f};
}
DEV void tile_decode8(int t, int ntn, int& mt, int& nt) {
    const int per = 4 * ntn;
    const int gi = t / per, rem = t - gi * per;
    nt = rem >> 2;
    mt = gi * 4 + (rem & 3);
}

DEV void ph_ffn_in8(const Params& p, int which, char* smem, int rvid, int RG, int tid) {
    const u16* H = WSP(u16, OFF_H);
    const u16* Wt = WSP(u16, OFF_W) + (which ? WE_IN1 : WE_IN0);
    u16* ACT = WSP(u16, OFF_P);
    const int lane = tid & 63, wave = tid >> 6, wm = wave >> 2, wn = wave & 3, fr = lane & 15, fq = lane >> 4;
    const int total = 128 * 22;
    for (int t = rvid; t < total; t += RG) {
        int mt_, nt_;
        tile_decode8(t, 22, mt_, nt_);
        const int m0 = mt_ * 256, n0 = nt_ * 256;
        f32x4 acc[8][4];
        zero_acc8(acc);
        gemm8_accum(acc, H + (size_t)m0 * D, D, Wt + (size_t)n0 * D, D, D, smem, tid);
#pragma unroll
        for (int mt = 0; mt < 8; ++mt)
#pragma unroll
            for (int pp = 0; pp < 2; ++pp)
#pragma unroll
                for (int r = 0; r < 4; ++r) {
                    const int row = m0 + wm * 128 + mt * 16 + fq * 4 + r;
                    const int hid = (n0 >> 1) + wn * 32 + pp * 16 + fr;
                    const float g = acc[mt][2 * pp][r], u = acc[mt][2 * pp + 1][r];
                    const float v = g * sigmoidf_(g) * u;
                    ACT[(size_t)row * DFF + hid] = (u16)(pk2(v, 0.f) & 0xffff);
                }
    }
}
DEV void ph_resid8(const Params& p, const u16* A, int lda, const u16* Wt, int K, int modidx, float coef, char* smem, int rvid, int RG, int tid) {
    const float* mods = WSP(float, OFF_MODS);
    const int lane = tid & 63, wave = tid >> 6, wm = wave >> 2, wn = wave & 3, fr = lane & 15, fq = lane >> 4;
    const int total = 128 * 4;
    for (int t = rvid; t < total; t += RG) {
        int mt_, nt_;
        tile_decode8(t, 4, mt_, nt_);
        const int m0 = mt_ * 256, n0 = nt_ * 256;
        f32x4 acc[8][4];
        zero_acc8(acc);
        gemm8_accum(acc, A + (size_t)m0 * lda, lda, Wt + (size_t)n0 * K, K, K, smem, tid);
        const float* gp = mods + (m0 >> 12) * 9216 + modidx * 1024;
#pragma unroll
        for (int nt = 0; nt < 4; ++nt) {
            const int col = n0 + wn * 64 + nt * 16 + fr;
            const float gv = gp[col] * coef;
#pragma unroll
            for (int mt = 0; mt < 8; ++mt) {
#pragma unroll
                for (int r = 0; r < 4; ++r) {
                    const int row = m0 + wm * 128 + mt * 16 + fq * 4 + r;
                    float* xp = p.out + (size_t)row * D + col;
                    *xp = *xp + gv * acc[mt][nt][r];
                }
                __builtin_amdgcn_sched_barrier(0);
            }
        }
    }
}
DEV void ph_pgemm8(const Params& p, char* smem, int rvid, int RG, int tid) {
    const u16* H = WSP(u16, OFF_H);
    const u16* Wt = WSP(u16, OFF_W) + WE_MIX;
    u16* P = WSP(u16, OFF_P);
    u16* T = WSP(u16, OFF_T);
    float* Gt = WSP(float, OFF_G);
    const int lane = tid & 63, wave = tid >> 6, wm = wave >> 2, wn = wave & 3, fr = lane & 15, fq = lane >> 4;
    const int total = 128 * 12;
    for (int t = rvid; t < total; t += RG) {
        int mt_, nt_;
        tile_decode8(t, 12, mt_, nt_);
        const int m0 = mt_ * 256, n0 = nt_ * 256;
        f32x4 acc[8][4];
        zero_acc8(acc);
        gemm8_accum(acc, H + (size_t)m0 * D, D, Wt + (size_t)n0 * D, D, D, smem, tid);
        const int cb = n0 + wn * 64;
        const int j = cb >> 7;
        if (j >= 22) {
            if (cb == 2816) {
#pragma unroll
                for (int mt = 0; mt < 8; ++mt)
#pragma unroll
                    for (int r = 0; r < 4; ++r) {
                        const int row = m0 + wm * 128 + mt * 16 + fq * 4 + r;
                        Gt[(size_t)row * 16 + fr] = acc[mt][0][r];
                    }
            }
            continue;
        }
        const bool rowmajor = j < 16;
        const bool transp = (j == 10) || (j == 11) || (j >= 16);
        if (rowmajor) {
#pragma unroll
            for (int mt = 0; mt < 8; ++mt)
#pragma unroll
                for (int nt = 0; nt < 4; ++nt)
#pragma unroll
                    for (int r = 0; r < 4; ++r) {
                        const int row = m0 + wm * 128 + mt * 16 + fq * 4 + r;
                        P[(size_t)row * PW + cb + nt * 16 + fr] = (u16)(pk2(acc[mt][nt][r], 0.f) & 0xffff);
                    }
        }
        if (transp) {
            const int tcb = (j >= 16) ? (cb - 1792) : (cb - 1280);
            const int b = m0 >> 12, u0 = m0 & 4095;
#pragma unroll
            for (int mt = 0; mt < 8; ++mt)
#pragma unroll
                for (int nt = 0; nt < 4; ++nt) {
                    const int tc = tcb + nt * 16 + fr;
                    const int u = u0 + wm * 128 + mt * 16 + fq * 4;
                    *(uint2*)(T + ((size_t)(b * TW + tc)) * UT + u) = uint2{pk2(acc[mt][nt][0], acc[mt][nt][1]), pk2(acc[mt][nt][2], acc[mt][nt][3])};
                }
        }
    }
}

DEV int map_col(int type, int n) {
    if (type == 0) return n;
    if (type == 1) {
        const int jb = n >> 5, r = n & 31;
        return r < 16 ? jb * 16 + r : DFF + jb * 16 + (r - 16);
    }
    if (n < 256) return 1552 + n;
    if (n < 640) return 2064 + (n - 256);
    if (n < 1024) return 2448 + (n - 640);
    if (n < 1280) return 1808 + (n - 1024);
    if (n < 1536) return (n - 1280);
    if (n < 1920) return 528 + (n - 1536);
    if (n < 2048) return 1296 + (n - 1920);
    if (n < 2304) return 256 + (n - 2048);
    if (n < 2688) return 912 + (n - 2304);
    if (n < 2816) return 1424 + (n - 2688);
    if (n < 2832) return 512 + (n - 2816);
    if (n < 2944) return -1;
    return 2832 + (n - 2944);
}

DEV void conv_tile(const float* __restrict__ src, int ld_src, int type, u16* __restrict__ dst, int ld_dst, int k_off, int kt, int ntile, char* smem, int tid) {
    float* lds = (float*)smem;
    const int k0 = kt * 64, n0 = ntile * 64;
    {
        const int r = tid >> 6, c = tid & 63;
        const int col = map_col(type, n0 + c);
#pragma unroll 4
        for (int i = 0; i < 16; ++i) {
            const int k = r + 4 * i;
            float v = 0.f;
            if (col >= 0) v = src[(size_t)(k0 + k) * ld_src + col];
            lds[k * 65 + c] = v;
        }
    }
    __syncthreads();
    {
        const int n = tid >> 2, kq = tid & 3;
        uint32_t w[8];
#pragma unroll
        for (int j = 0; j < 8; ++j) w[j] = pk2(lds[(kq * 16 + 2 * j) * 65 + n], lds[(kq * 16 + 2 * j + 1) * 65 + n]);
        u16* d = dst + (size_t)(n0 + n) * ld_dst + k_off + k0 + kq * 16;
        *(uint4*)d = uint4{w[0], w[1], w[2], w[3]};
        *(uint4*)(d + 8) = uint4{w[4], w[5], w[6], w[7]};
    }
    __syncthreads();
}

DEV void ph_prep(const Params& p, int l, char* smem, int bid, int G) {
    u16* W = WSP(u16, OFF_W);
    const int tid = VTID;
    constexpr int N_CONV = 6240, N_MODS = 288;
    for (int it = bid; it < N_CONV + N_MODS; it += G) {
        if (it < N_CONV) {
            int r = it;
            if (r < 2816) {
                const int which = r / 1408; r -= which * 1408;
                conv_tile(p.ffn_w_in + (size_t)(l * 2 + which) * 1024 * 5632, 5632, 1, W + (which ? WE_IN1 : WE_IN0), 1024, 0, r / 88, r % 88, smem, tid);
                continue;
            }
            r -= 2816;
            if (r < 1408) {
                const int which = r / 704; r -= which * 704;
                conv_tile(p.ffn_w_out + (size_t)(l * 2 + which) * 2816 * 1024, 1024, 0, W + (which ? WE_OUT1 : WE_OUT0), 2816, 0, r / 16, r % 16, smem, tid);
                continue;
            }
            r -= 1408;
            if (r < 1504) {
                conv_tile(p.mix_w_in + (size_t)l * 1024 * NIN, NIN, 2, W + WE_MIX, 1024, 0, r / 94, r % 94, smem, tid);
                continue;
            }
            r -= 1504;
            if (r < 64) { conv_tile(p.w_br_ml + (size_t)l * 256 * 1024, 1024, 0, W + WE_BR, 1024, 0, r / 16, r % 16, smem, tid); continue; }
            r -= 64;
            if (r < 96) { conv_tile(p.w_br_na + (size_t)l * 384 * 1024, 1024, 0, W + WE_BR, 1024, 256, r / 16, r % 16, smem, tid); continue; }
            r -= 96;
            if (r < 96) { conv_tile(p.w_br_gq + (size_t)l * 384 * 1024, 1024, 0, W + WE_BR, 1024, 640, r / 16, r % 16, smem, tid); continue; }
            r -= 96;
            conv_tile(p.w_out + (size_t)l * 1024 * 1024, 1024, 0, W + WE_O, 1024, 0, r / 16, r % 16, smem, tid);
        } else {
            const int cb = it - N_CONV;
            float* s = (float*)smem;
            float* red = s + 9 * 1024;
            for (int i = tid; i < 9 * 1024; i += 256) {
                const int b = i >> 10, k = i & 1023;
                const float v = b < 8 ? p.c[b * 1024 + k] : p.c_ctx[k];
                s[i] = v * sigmoidf_(v);
            }
            __syncthreads();
            const int kg = tid >> 5, c = tid & 31, col = cb * 32 + c;
            float a[9];
#pragma unroll
            for (int b = 0; b < 9; ++b) a[b] = 0.f;
            const float* wp = p.ada_w + (size_t)l * 1024 * 9216 + (size_t)(kg * 128) * 9216 + col;
#pragma unroll 8
            for (int k = 0; k < 128; ++k) {
                const float w = wp[(size_t)k * 9216];
#pragma unroll
                for (int b = 0; b < 9; ++b) a[b] += s[b * 1024 + kg * 128 + k] * w;
            }
#pragma unroll
            for (int b = 0; b < 9; ++b) red[(kg * 9 + b) * 32 + c] = a[b];
            __syncthreads();
            for (int i = tid; i < 288; i += 256) {
                const int b = i >> 5, cc = i & 31;
                float v = p.ada_b[l * 9216 + cb * 32 + cc];
#pragma unroll
                for (int g = 0; g < 8; ++g) v += red[(g * 9 + b) * 32 + cc];
                WSP(float, OFF_MODS)[b * 9216 + cb * 32 + cc] = v;
            }
            __syncthreads();
        }
    }
    if (l == 0) {
        const size_t gt = (size_t)bid * 256 + tid, gs = (size_t)G * 256;
        const float4* xs = (const float4*)p.x; float4* xd = (float4*)p.out;
        for (size_t i = gt; i < (size_t)NL * D / 4; i += gs) xd[i] = xs[i];
        const float4* cs = (const float4*)p.ctx; float4* cd = WSP(float4, OFF_XC);
        for (size_t i = gt; i < (size_t)NCX * D / 4; i += gs) cd[i] = cs[i];
        float* rope = WSP(float, OFF_ROPE);
        for (size_t i = gt; i < (size_t)4096 * 32; i += gs) {
            const int t = (int)(i >> 5), f = (int)(i & 31);
            const float pos = (float)((f < 16) ? (t >> 6) : (t & 63));
            const float inv = powf(10000.f, -(float)(f & 15) / 16.f);
            float sn, cs_;
            sincosf(pos * inv, &sn, &cs_);
            rope[i * 2] = cs_;
            rope[i * 2 + 1] = sn;
        }
    }
}

DEV void ph_mod(const Params& p, int l, int sub, int nrows, int bid, int G) {
    const int lane = VTID & 63, gw = bid * 4 + (VTID >> 6), NW = G * 4;
    const float* nw = p.norm_w + (size_t)(l * 3 + sub) * 1024;
    const float* mods = WSP(float, OFF_MODS);
    u16* H = WSP(u16, OFF_H);
    for (int r = gw; r < nrows; r += NW) {
        const float* xr = r < NL ? p.out + (size_t)r * D : WSP(float, OFF_XC) + (size_t)(r - NL) * D;
        const int b9 = r < NL ? (r >> 12) : 8;
        const float* sh = mods + b9 * 9216 + (3 * sub) * 1024;
        const float* sc = sh + 1024;
        float4 v[4];
        float ss = 0.f;
#pragma unroll
        for (int j = 0; j < 4; ++j) {
            v[j] = *(const float4*)(xr + lane * 4 + 256 * j);
            ss += v[j].x * v[j].x + v[j].y * v[j].y + v[j].z * v[j].z + v[j].w * v[j].w;
        }
        ss = wave_sum(ss);
        const float rstd = rsqrtf(ss * (1.f / 1024.f) + 1e-6f);
#pragma unroll
        for (int j = 0; j < 4; ++j) {
            const int k = lane * 4 + 256 * j;
            const float4 w = *(const float4*)(nw + k), s1 = *(const float4*)(sc + k), s0 = *(const float4*)(sh + k);
            const float y0 = v[j].x * rstd * w.x * (1.f + s1.x) + s0.x;
            const float y1 = v[j].y * rstd * w.y * (1.f + s1.y) + s0.y;
            const float y2 = v[j].z * rstd * w.z * (1.f + s1.z) + s0.z;
            const float y3 = v[j].w * rstd * w.w * (1.f + s1.w) + s0.w;
            *(uint2*)(H + (size_t)r * D + k) = uint2{pk2(y0, y1), pk2(y2, y3)};
        }
    }
}

DEV void ph_ffn_in(const Params& p, int which, int mt0, int mtiles, char* smem, int vid, int G) {
    const u16* H = WSP(u16, OFF_H);
    const u16* Wt = WSP(u16, OFF_W) + (which ? WE_IN1 : WE_IN0);
    u16* ACT = WSP(u16, OFF_P);
    const int lane = VTID & 63, wave = VTID >> 6, wm = wave >> 1, wn = wave & 1, fr = lane & 15, fq = lane >> 4;
    const int total = mtiles * 44;
    for (int t = vid; t < total; t += G) {
        int mt_, nt_;
        tile_decode(t, 44, mt_, nt_);
        mt_ += mt0;
        const int m0 = mt_ * 128, n0 = nt_ * 128;
        f32x4 acc[4][4];
        zero_acc<4>(acc);
        gemm_accum<4>(acc, H + (size_t)m0 * D, D, Wt + (size_t)n0 * D, D, D, smem, VTID);
#pragma unroll
        for (int mt = 0; mt < 4; ++mt)
#pragma unroll
            for (int pp = 0; pp < 2; ++pp)
#pragma unroll
                for (int r = 0; r < 4; ++r) {
                    const int row = m0 + wm * 64 + mt * 16 + fq * 4 + r;
                    const int hid = (n0 >> 1) + wn * 32 + pp * 16 + fr;
                    const float g = acc[mt][2 * pp][r], u = acc[mt][2 * pp + 1][r];
                    const float v = g * sigmoidf_(g) * u;
                    ACT[(size_t)row * DFF + hid] = (u16)(pk2(v, 0.f) & 0xffff);
                }
    }
}

DEV void ph_resid(const Params& p, const u16* A, int lda, const u16* Wt, int K, int modidx, float coef, int mt0, int mtiles, char* smem, int vid, int G) {
    const float* mods = WSP(float, OFF_MODS);
    const int lane = VTID & 63, wave = VTID >> 6, wm = wave >> 1, wn = wave & 1, fr = lane & 15, fq = lane >> 4;
    const int total = mtiles * 8 * 4;
    const int Kc = K >> 2;
    for (int t = vid; t < total; t += G) {
        int mt_, nt_;
        const int ksp = t & 3;
        tile_decode(t >> 2, 8, mt_, nt_);
        mt_ += mt0;
        const int m0 = mt_ * 128, n0 = nt_ * 128;
        f32x4 acc[4][4];
        zero_acc<4>(acc);
        gemm_accum<4>(acc, A + (size_t)m0 * lda + ksp * Kc, lda, Wt + (size_t)n0 * K + ksp * Kc, K, Kc, smem, VTID);
        const int b9 = m0 < NL ? (m0 >> 12) : 8;
        const float* gp = mods + b9 * 9216 + modidx * 1024;
#pragma unroll
        for (int nt = 0; nt < 4; ++nt) {
            const int col = n0 + wn * 64 + nt * 16 + fr;
            const float gv = gp[col] * coef;
#pragma unroll
            for (int mt = 0; mt < 4; ++mt)
#pragma unroll
                for (int r = 0; r < 4; ++r) {
                    const int row = m0 + wm * 64 + mt * 16 + fq * 4 + r;
                    float* xp = (row < NL ? p.out + (size_t)row * D : WSP(float, OFF_XC) + (size_t)(row - NL) * D) + col;
                    __hip_atomic_fetch_add(xp, gv * acc[mt][nt][r], __ATOMIC_RELAXED, __HIP_MEMORY_SCOPE_AGENT);
                }
        }
    }
}

DEV void ph_pgemm(const Params& p, int mt0, int mtiles, char* smem, int vid, int G) {
    const u16* H = WSP(u16, OFF_H);
    const u16* Wt = WSP(u16, OFF_W) + WE_MIX;
    u16* P = WSP(u16, OFF_P);
    u16* T = WSP(u16, OFF_T);
    float* Gt = WSP(float, OFF_G);
    const int lane = VTID & 63, wave = VTID >> 6, wm = wave >> 1, wn = wave & 1, fr = lane & 15, fq = lane >> 4;
    const int total = mtiles * 23;
    for (int t = vid; t < total; t += G) {
        int mt_, nt_;
        tile_decode(t, 23, mt_, nt_);
        mt_ += mt0;
        const int m0 = mt_ * 128, n0 = nt_ * 128;
        f32x4 acc[4][4];
        zero_acc<4>(acc);
        gemm_accum<4>(acc, H + (size_t)m0 * D, D, Wt + (size_t)n0 * D, D, D, smem, VTID);
        if (nt_ == 22) {
            if (wn == 0) {
#pragma unroll
                for (int mt = 0; mt < 4; ++mt)
#pragma unroll
                    for (int r = 0; r < 4; ++r) {
                        const int row = m0 + wm * 64 + mt * 16 + fq * 4 + r;
                        Gt[(size_t)row * 16 + fr] = acc[mt][0][r];
                    }
            }
            continue;
        }
        const bool rowmajor = nt_ < 16;
        const bool transp = (nt_ == 10) || (nt_ == 11) || (nt_ >= 16);
        if (rowmajor) {
#pragma unroll
            for (int mt = 0; mt < 4; ++mt)
#pragma unroll
                for (int nt = 0; nt < 4; ++nt)
#pragma unroll
                    for (int r = 0; r < 4; ++r) {
                        const int row = m0 + wm * 64 + mt * 16 + fq * 4 + r;
                        const int col = n0 + wn * 64 + nt * 16 + fr;
                        P[(size_t)row * PW + col] = (u16)(pk2(acc[mt][nt][r], 0.f) & 0xffff);
                    }
        }
        if (transp) {
            const int tcb = (nt_ >= 16) ? (n0 - 1792) : (n0 - 1280);
            int b, u0;
            if (m0 < NL) { b = m0 >> 12; u0 = m0 & 4095; } else { b = (m0 - NL) >> 8; u0 = SEQ + ((m0 - NL) & 255); }
#pragma unroll
            for (int mt = 0; mt < 4; ++mt)
#pragma unroll
                for (int nt = 0; nt < 4; ++nt) {
                    const int tc = tcb + wn * 64 + nt * 16 + fr;
                    const int u = u0 + wm * 64 + mt * 16 + fq * 4;
                    *(uint2*)(T + ((size_t)(b * TW + tc)) * UT + u) = uint2{pk2(acc[mt][nt][0], acc[mt][nt][1]), pk2(acc[mt][nt][2], acc[mt][nt][3])};
                }
        }
    }
}

DEV void ph_qknorm_gates(const Params& p, int l, int bid, int G) {
    const int lane = VTID & 63, gw = bid * 4 + (VTID >> 6), NW = G * 4;
    u16* P = WSP(u16, OFF_P);
    for (int it = gw; it < NSCAN * NCH; it += NW) {
        const int sc = it / NCH, c = it - sc * NCH, dir = sc & 1, h = (sc >> 1) & 3, b = sc >> 3;
        const float* Gt = WSP(float, OFF_G);
        float* BC = WSP(float, OFF_BC) + (size_t)sc * UT;
        float* IG = WSP(float, OFF_IG) + (size_t)sc * UT;
        float* WE = WSP(float, OFF_AE) + (size_t)sc * UT;
        const float bi = p.ml_gate_b[l * 16 + dir * 8 + h], bf = p.ml_gate_b[l * 16 + dir * 8 + 4 + h];
        const int cu = cu_of(c, dir);
        const int u = cu * 64 + (dir ? 63 - lane : lane);
        const int row = rowof(b, u);
        const float ig = Gt[(size_t)row * 16 + dir * 8 + h] + bi;
        const float fp = Gt[(size_t)row * 16 + dir * 8 + 4 + h] + bf;
        const float lf = fminf(fp, 0.f) - log1pf(expf(-fabsf(fp)));
        float bc = lf;
#pragma unroll
        for (int o = 1; o < 64; o <<= 1) { const float tv = __shfl_up(bc, o); if (lane >= o) bc += tv; }
        const float btot = __shfl(bc, 63);
        const float wend = btot - bc + ig;
        const float mx = wave_max(wend);
        WE[u] = wend;
        BC[u] = bc;
        IG[u] = ig;
        if (lane == 0) { WSP(float, OFF_MS)[sc * NCH + c] = btot; WSP(float, OFF_DEC)[sc * NCH + c] = mx; }
    }
    const float* rope = WSP(float, OFF_ROPE);
    const int hs = lane >> 4, e4 = (lane & 15) * 4;
    for (int r = gw; r < MTOT; r += NW) {
        const bool latent = r < NL;
        const int tok = r & 4095;
#pragma unroll
        for (int g = 0; g < 5; ++g) {
            const int cbase = (g < 3 ? 256 + g * 256 : 1536 + (g - 3) * 256) + hs * 64 + e4;
            const int slot = g * 4 + hs;
            u16* pp = P + (size_t)r * PW + cbase;
            const uint2 raw = *(const uint2*)pp;
            float v0 = bflo(raw.x), v1 = bfhi(raw.x), v2 = bflo(raw.y), v3 = bfhi(raw.y);
            float ss = v0 * v0 + v1 * v1 + v2 * v2 + v3 * v3;
            ss += __shfl_xor(ss, 1); ss += __shfl_xor(ss, 2); ss += __shfl_xor(ss, 4); ss += __shfl_xor(ss, 8);
            const float* wv;
            float scl;
            bool do_rope;
            if (slot < 6) { wv = p.na_qk_w + (l * 2 + 0) * 64; scl = 0.125f; do_rope = false; }
            else if (slot < 12) { wv = p.gq_qk_w + (l * 2 + 0) * 64; scl = 0.125f; do_rope = latent; }
            else if (slot < 18) { wv = p.na_qk_w + (l * 2 + 1) * 64; scl = 1.f; do_rope = false; }
            else { wv = p.gq_qk_w + (l * 2 + 1) * 64; scl = 1.f; do_rope = latent; }
            const float rstd = rsqrtf(ss * (1.f / 64.f) + 1e-6f) * scl;
            const float4 w4 = *(const float4*)(wv + e4);
            v0 *= rstd * w4.x; v1 *= rstd * w4.y; v2 *= rstd * w4.z; v3 *= rstd * w4.w;
            const float o0 = __shfl_xor(v0, 8), o1 = __shfl_xor(v1, 8), o2 = __shfl_xor(v2, 8), o3 = __shfl_xor(v3, 8);
            if (do_rope) {
                const int fi = e4 & 31;
                const float4 cs01 = *(const float4*)(rope + ((size_t)tok * 32 + fi) * 2);
                const float4 cs23 = *(const float4*)(rope + ((size_t)tok * 32 + fi + 2) * 2);
                if (e4 < 32) {
                    v0 = v0 * cs01.x - o0 * cs01.y; v1 = v1 * cs01.z - o1 * cs01.w;
                    v2 = v2 * cs23.x - o2 * cs23.y; v3 = v3 * cs23.z - o3 * cs23.w;
                } else {
                    v0 = o0 * cs01.y + v0 * cs01.x; v1 = o1 * cs01.w + v1 * cs01.z;
                    v2 = o2 * cs23.y + v2 * cs23.x; v3 = o3 * cs23.w + v3 * cs23.z;
                }
            }
            *(uint2*)pp = uint2{pk2(v0, v1), pk2(v2, v3)};
        }
    }
}

template <int MT, bool NAMASK, int NWV>
DEV void flash_item(const Params& p, int b, int qrow0, int qcol, int kcol, int tcol, int ua, int n1, int ub, int ntiles,
                    int r_q, int rs, const float* __restrict__ rpb_h, char* smem, int ocol) {
    u16* P = WSP(u16, OFF_P);
    const u16* T = WSP(u16, OFF_T);
    const int tid = (NWV == 8) ? (int)(threadIdx.x + p.z) : VTID, lane = tid & 63, wave = tid >> 6, fr = lane & 15, fq = lane >> 4;
    constexpr int KVS = 64 * 144;
    char* Ks = smem;
    char* Vs = smem + 2 * KVS;
    float* rpb_s = (float*)(smem + 4 * KVS);
    __syncthreads();
    if (NAMASK) {
        for (int i = tid; i < 465; i += 256) rpb_s[i] = rpb_h[i] * 1.4426950408889634f;
    }
    Frag qf[MT][2];
#pragma unroll
    for (int mt = 0; mt < MT; ++mt)
#pragma unroll
        for (int ks = 0; ks < 2; ++ks)
            qf[mt][ks].q = *(const uint4*)(P + (size_t)(qrow0 + (wave * MT + mt) * 16 + fr) * PW + qcol + ks * 32 + fq * 8);
    const int lr = tid >> 3, lc8 = tid & 7;
    u32x4 rk0, rk1 = {0, 0, 0, 0}, rv0, rv1 = {0, 0, 0, 0};
#define FL_GLOAD(KT) do { const int kt_ = (KT); const int u0_ = kt_ < n1 ? ua + 64 * kt_ : ub + 64 * (kt_ - n1); const int row0_ = rowof(b, u0_); \
        rk0 = gld16(P + (size_t)(row0_ + lr) * PW + kcol + lc8 * 8); rv0 = gld16(T + ((size_t)(b * TW + tcol + lr)) * UT + u0_ + lc8 * 8); \
        if (NWV == 4) { rk1 = gld16(P + (size_t)(row0_ + lr + 32) * PW + kcol + lc8 * 8); rv1 = gld16(T + ((size_t)(b * TW + tcol + lr + 32)) * UT + u0_ + lc8 * 8); } } while (0)
#define FL_SSTORE(S) do { const int s_ = (S); \
        *(u32x4*)(Ks + s_ * KVS + lr * 144 + lc8 * 16) = rk0; *(u32x4*)(Vs + s_ * KVS + lr * 144 + lc8 * 16) = rv0; \
        if (NWV == 4) { *(u32x4*)(Ks + s_ * KVS + (lr + 32) * 144 + lc8 * 16) = rk1; *(u32x4*)(Vs + s_ * KVS + (lr + 32) * 144 + lc8 * 16) = rv1; } } while (0)
    FL_GLOAD(0);
    VM_WAIT0();
    FL_SSTORE(0);
    __syncthreads();
    f32x4 o[MT][4];
    float mrow[MT], lrow[MT];
#pragma unroll
    for (int mt = 0; mt < MT; ++mt) {
        mrow[mt] = -1e30f; lrow[mt] = 0.f;
#pragma unroll
        for (int dt = 0; dt < 4; ++dt) o[mt][dt] = f32x4{0.f, 0.f, 0.f, 0.f};
    }
    const float L2E = 1.4426950408889634f;
    for (int kt = 0; kt < ntiles; ++kt) {
        const int cur = kt & 1;
        const bool more = kt + 1 < ntiles;
        FL_GLOAD(more ? kt + 1 : kt);
        __builtin_amdgcn_sched_barrier(0);
        f32x4 s[MT][4];
#pragma unroll
        for (int mt = 0; mt < MT; ++mt)
#pragma unroll
            for (int nt = 0; nt < 4; ++nt) s[mt][nt] = f32x4{0.f, 0.f, 0.f, 0.f};
#pragma unroll
        for (int ks = 0; ks < 2; ++ks)
#pragma unroll
            for (int nt = 0; nt < 4; ++nt) {
                const bf16x8 kf = *(const bf16x8*)(Ks + cur * KVS + (nt * 16 + fr) * 144 + (ks * 32 + fq * 8) * 2);
#pragma unroll
                for (int mt = 0; mt < MT; ++mt) s[mt][nt] = mfma16(kf, qf[mt][ks].v, s[mt][nt]);
            }
        Frag pf[MT][2];
#pragma unroll
        for (int mt = 0; mt < MT; ++mt) {
            if (NAMASK && kt < 8) {
                const int qc = (wave * MT + mt) * 16 + fr;
                int cs = qc - 8; cs = cs < 0 ? 0 : (cs > 48 ? 48 : cs);
                const int brow = rs + kt - r_q + 7;
#pragma unroll
                for (int nt = 0; nt < 4; ++nt)
#pragma unroll
                    for (int r = 0; r < 4; ++r) {
                        const int kc = nt * 16 + fq * 4 + r;
                        const bool valid = (kc >= cs) && (kc < cs + 16);
                        const int bi = valid ? brow * 31 + (kc - qc + 15) : 0;
                        s[mt][nt][r] = valid ? s[mt][nt][r] * L2E + rpb_s[bi] : -1e30f;
                    }
            } else {
#pragma unroll
                for (int nt = 0; nt < 4; ++nt)
#pragma unroll
                    for (int r = 0; r < 4; ++r) s[mt][nt][r] *= L2E;
            }
            float mx = -1e30f;
#pragma unroll
            for (int nt = 0; nt < 4; ++nt)
#pragma unroll
                for (int r = 0; r < 4; ++r) mx = fmaxf(mx, s[mt][nt][r]);
            mx = xq_max(mx);
            const float mnew = fmaxf(mrow[mt], mx);
            const float alpha = fexp2(mrow[mt] - mnew);
            float rsum = 0.f;
#pragma unroll
            for (int nt = 0; nt < 4; ++nt)
#pragma unroll
                for (int r = 0; r < 4; ++r) { const float e = fexp2(s[mt][nt][r] - mnew); s[mt][nt][r] = e; rsum += e; }
            rsum = xq_sum(rsum);
            lrow[mt] = lrow[mt] * alpha + rsum;
            mrow[mt] = mnew;
#pragma unroll
            for (int dt = 0; dt < 4; ++dt) o[mt][dt] *= alpha;
#pragma unroll
            for (int ks = 0; ks < 2; ++ks) {
                pf[mt][ks].u[0] = pk2(s[mt][2 * ks][0], s[mt][2 * ks][1]);
                pf[mt][ks].u[1] = pk2(s[mt][2 * ks][2], s[mt][2 * ks][3]);
                pf[mt][ks].u[2] = pk2(s[mt][2 * ks + 1][0], s[mt][2 * ks + 1][1]);
                pf[mt][ks].u[3] = pk2(s[mt][2 * ks + 1][2], s[mt][2 * ks + 1][3]);
            }
        }
#pragma unroll
        for (int ks = 0; ks < 2; ++ks)
#pragma unroll
            for (int dt = 0; dt < 4; ++dt) {
                Frag vf;
                vf.d[0] = *(const uint2*)(Vs + cur * KVS + (dt * 16 + fr) * 144 + (ks * 32 + fq * 4) * 2);
                vf.d[1] = *(const uint2*)(Vs + cur * KVS + (dt * 16 + fr) * 144 + (ks * 32 + 16 + fq * 4) * 2);
#pragma unroll
                for (int mt = 0; mt < MT; ++mt) o[mt][dt] = mfma16(vf.v, pf[mt][ks].v, o[mt][dt]);
            }
        __builtin_amdgcn_sched_barrier(0);
        VM_WAIT0();
        FL_SSTORE(cur ^ 1);
        __syncthreads();
    }
#pragma unroll
    for (int mt = 0; mt < MT; ++mt) {
        const float inv = 1.f / lrow[mt];
        u16* op = P + (size_t)(qrow0 + (wave * MT + mt) * 16 + fr) * PW + ocol;
#pragma unroll
        for (int dt = 0; dt < 4; ++dt)
            *(uint2*)(op + dt * 16 + fq * 4) = uint2{pk2(o[mt][dt][0] * inv, o[mt][dt][1] * inv), pk2(o[mt][dt][2] * inv, o[mt][dt][3] * inv)};
    }
}


DEV void m2_item(const Params& p, int sc, int c) {
    const u16* T = WSP(u16, OFF_T);
    const int lane = VTID & 63, wave = VTID >> 6, fr = lane & 15, fq = lane >> 4;
    const int dir = sc & 1, h = (sc >> 1) & 3, b = sc >> 3;
    const int u0 = cu_of(c, dir) * 64;
    const float* AE = WSP(float, OFF_AE) + (size_t)sc * UT + u0;
    float* S = WSP(float, OFF_S) + ((size_t)sc * NCH + c) * SCH;
    const float mnew = fmaxf(WSP(float, OFF_MS)[sc * NCH + c] + m_scan(p, sc, c), WSP(float, OFF_DEC)[sc * NCH + c]);
    f32x4 acc[4], accn[4];
#pragma unroll
    for (int nt = 0; nt < 4; ++nt) { acc[nt] = f32x4{0.f, 0.f, 0.f, 0.f}; accn[nt] = f32x4{0.f, 0.f, 0.f, 0.f}; }
    Frag ones;
    ones.u[0] = ones.u[1] = ones.u[2] = ones.u[3] = 0x3F803F80u;
#pragma unroll
    for (int ks = 0; ks < 2; ++ks) {
        Frag vf;
        vf.q = *(const uint4*)(T + ((size_t)(b * TW + TC_MLV + h * 64 + wave * 16 + fr)) * UT + u0 + ks * 32 + fq * 8);
        float4 a0 = *(const float4*)(AE + ks * 32 + fq * 8), a1 = *(const float4*)(AE + ks * 32 + fq * 8 + 4);
        a0.x = expf(a0.x - mnew); a0.y = expf(a0.y - mnew); a0.z = expf(a0.z - mnew); a0.w = expf(a0.w - mnew);
        a1.x = expf(a1.x - mnew); a1.y = expf(a1.y - mnew); a1.z = expf(a1.z - mnew); a1.w = expf(a1.w - mnew);
#pragma unroll
        for (int nt = 0; nt < 4; ++nt) {
            Frag kf, kb;
            kf.q = *(const uint4*)(T + ((size_t)(b * TW + TC_MLK + h * 64 + nt * 16 + fr)) * UT + u0 + ks * 32 + fq * 8);
            kb.u[0] = pk2(bflo(kf.u[0]) * a0.x * 0.125f, bfhi(kf.u[0]) * a0.y * 0.125f);
            kb.u[1] = pk2(bflo(kf.u[1]) * a0.z * 0.125f, bfhi(kf.u[1]) * a0.w * 0.125f);
            kb.u[2] = pk2(bflo(kf.u[2]) * a1.x * 0.125f, bfhi(kf.u[2]) * a1.y * 0.125f);
            kb.u[3] = pk2(bflo(kf.u[3]) * a1.z * 0.125f, bfhi(kf.u[3]) * a1.w * 0.125f);
            acc[nt] = mfma16(vf.v, kb.v, acc[nt]);
            if (wave == 0) accn[nt] = mfma16(ones.v, kb.v, accn[nt]);
        }
    }
#pragma unroll
    for (int nt = 0; nt < 4; ++nt) {
#pragma unroll
        for (int r = 0; r < 4; ++r) S[(wave * 16 + fq * 4 + r) * 64 + nt * 16 + fr] = acc[nt][r];
        if (wave == 0 && fq == 0) S[4096 + nt * 16 + fr] = accn[nt][0];
    }
}

DEV void ph_m3(const Params& p, int bid, int G) {
    const float* DEC = WSP(float, OFF_DEC);
    float* S = WSP(float, OFF_S);
    const int total = NSCAN * SCH;
    for (int i = bid * 256 + VTID; i < total; i += G * 256) {
        const int sc = i / SCH, e = i - sc * SCH;
        float* base = S + (size_t)sc * NCH * SCH + e;
        const float* mxp = DEC + sc * NCH;
        const float* btp = WSP(float, OFF_MS) + sc * NCH;
        float st = 0.f, m = 0.f;
#pragma unroll 4
        for (int c = 0; c < NCH; ++c) {
            const float tmp = base[(size_t)c * SCH];
            base[(size_t)c * SCH] = st;
            const float bm = btp[c] + m;
            const float mnew = fmaxf(bm, mxp[c]);
            st = expf(bm - mnew) * st + tmp;
            m = mnew;
        }
    }
}

DEV void m4_item(const Params& p, int l, int b, int h, int cu, int ocolbase) {
    u16* P = WSP(u16, OFF_P);
    const u16* T = WSP(u16, OFF_T);
    const int lane = VTID & 63, wave = VTID >> 6, fr = lane & 15, fq = lane >> 4;
    const int u0 = cu * 64;
    const int row0 = rowof(b, u0);
    const int j = wave * 16 + fr;
    Frag qf[2];
#pragma unroll
    for (int ks = 0; ks < 2; ++ks) qf[ks].q = *(const uint4*)(P + (size_t)(row0 + j) * PW + PC_MLQ + h * 64 + ks * 32 + fq * 8);
    f32x4 hsum[4];
#pragma unroll
    for (int dt = 0; dt < 4; ++dt) hsum[dt] = f32x4{0.f, 0.f, 0.f, 0.f};
#pragma unroll 1
    for (int dir = 0; dir < 2; ++dir) {
        const int sc = (b * 4 + h) * 2 + dir;
        int c;
        if (cu >= 64) c = dir ? 3 - (cu - 64) : (cu - 64); else c = 4 + (dir ? 63 - cu : cu);
        const float m0 = m_scan(p, sc, c);
        const float* BC = WSP(float, OFF_BC) + (size_t)sc * UT + u0;
        const float* IG = WSP(float, OFF_IG) + (size_t)sc * UT + u0;
        const float* S = WSP(float, OFF_S) + ((size_t)sc * NCH + c) * SCH;
        const float bj = BC[j];
        f32x4 s[4];
#pragma unroll
        for (int nt = 0; nt < 4; ++nt) s[nt] = f32x4{0.f, 0.f, 0.f, 0.f};
#pragma unroll
        for (int ks = 0; ks < 2; ++ks)
#pragma unroll
            for (int nt = 0; nt < 4; ++nt) {
                Frag kf;
                kf.q = *(const uint4*)(P + (size_t)(row0 + nt * 16 + fr) * PW + PC_MLK + h * 64 + ks * 32 + fq * 8);
                s[nt] = mfma16(kf.v, qf[ks].v, s[nt]);
            }
        float lw[4][4];
        float mx = -1e30f;
#pragma unroll
        for (int nt = 0; nt < 4; ++nt) {
            const float4 bs = *(const float4*)(BC + nt * 16 + fq * 4);
            const float4 is = *(const float4*)(IG + nt * 16 + fq * 4);
            const float bsv[4] = {bs.x, bs.y, bs.z, bs.w}, isv[4] = {is.x, is.y, is.z, is.w};
#pragma unroll
            for (int r = 0; r < 4; ++r) {
                const int sidx = nt * 16 + fq * 4 + r;
                const bool valid = dir ? (sidx >= j) : (sidx <= j);
                lw[nt][r] = valid ? (bj - bsv[r] + isv[r]) : -1e30f;
                mx = fmaxf(mx, lw[nt][r]);
            }
        }
        mx = xq_max(mx);
        const float minter = bj + m0;
        const float mj = fmaxf(minter, mx);
        const float g = fexp(minter - mj);
        float den = 0.f;
#pragma unroll
        for (int nt = 0; nt < 4; ++nt)
#pragma unroll
            for (int r = 0; r < 4; ++r) {
                const float w = fexp(lw[nt][r] - mj);
                const float qk = s[nt][r] * 0.125f * w;
                s[nt][r] = qk;
                den += qk;
            }
        den = xq_sum(den);
        Frag pf[2];
#pragma unroll
        for (int ks = 0; ks < 2; ++ks) {
            pf[ks].u[0] = pk2(s[2 * ks][0], s[2 * ks][1]);
            pf[ks].u[1] = pk2(s[2 * ks][2], s[2 * ks][3]);
            pf[ks].u[2] = pk2(s[2 * ks + 1][0], s[2 * ks + 1][1]);
            pf[ks].u[3] = pk2(s[2 * ks + 1][2], s[2 * ks + 1][3]);
        }
        f32x4 acc[4], accn = f32x4{0.f, 0.f, 0.f, 0.f};
#pragma unroll
        for (int dt = 0; dt < 4; ++dt) acc[dt] = f32x4{0.f, 0.f, 0.f, 0.f};
#pragma unroll
        for (int ks = 0; ks < 2; ++ks) {
            {
                const float4 n0 = *(const float4*)(S + 4096 + ks * 32 + fq * 8), n1 = *(const float4*)(S + 4096 + ks * 32 + fq * 8 + 4);
                Frag nf;
                nf.u[0] = pk2(n0.x, n0.y); nf.u[1] = pk2(n0.z, n0.w); nf.u[2] = pk2(n1.x, n1.y); nf.u[3] = pk2(n1.z, n1.w);
                accn = mfma16(nf.v, qf[ks].v, accn);
            }
#pragma unroll
            for (int dt = 0; dt < 4; ++dt) {
                const float* cp = S + (dt * 16 + fr) * 64 + ks * 32 + fq * 8;
                const float4 c0 = *(const float4*)cp, c1 = *(const float4*)(cp + 4);
                Frag cf;
                cf.u[0] = pk2(c0.x, c0.y); cf.u[1] = pk2(c0.z, c0.w); cf.u[2] = pk2(c1.x, c1.y); cf.u[3] = pk2(c1.z, c1.w);
                acc[dt] = mfma16(cf.v, qf[ks].v, acc[dt]);
            }
        }
#pragma unroll
        for (int dt = 0; dt < 4; ++dt) acc[dt] *= g;
        den += g * accn[0];
#pragma unroll
        for (int ks = 0; ks < 2; ++ks)
#pragma unroll
            for (int dt = 0; dt < 4; ++dt) {
                const u16* vp = T + ((size_t)(b * TW + TC_MLV + h * 64 + dt * 16 + fr)) * UT + u0 + ks * 32 + fq * 4;
                Frag vf;
                vf.d[0] = *(const uint2*)vp;
                vf.d[1] = *(const uint2*)(vp + 16);
                acc[dt] = mfma16(vf.v, pf[ks].v, acc[dt]);
            }
        const float dd = 1.f / fmaxf(fabsf(den), fexp(-mj));
#pragma unroll
        for (int dt = 0; dt < 4; ++dt) hsum[dt] += acc[dt] * dd;
    }
    float ss = 0.f;
#pragma unroll
    for (int dt = 0; dt < 4; ++dt)
#pragma unroll
        for (int r = 0; r < 4; ++r) ss += hsum[dt][r] * hsum[dt][r];
    ss = xq_sum(ss);
    const float rstd = rsqrtf(ss * (1.f / 64.f) + 1e-6f);
    const float* nw = p.ml_norm_w + l * 256 + h * 64;
    u16* orow = P + (size_t)(row0 + j) * PW;
#pragma unroll
    for (int dt = 0; dt < 4; ++dt) {
        const int v0 = dt * 16 + fq * 4;
        const float4 w4 = *(const float4*)(nw + v0);
        const uint2 og = *(const uint2*)(orow + PC_MLO + h * 64 + v0);
        const float y0 = hsum[dt][0] * rstd * w4.x * sigmoidf_(bflo(og.x));
        const float y1 = hsum[dt][1] * rstd * w4.y * sigmoidf_(bfhi(og.x));
        const float y2 = hsum[dt][2] * rstd * w4.z * sigmoidf_(bflo(og.y));
        const float y3 = hsum[dt][3] * rstd * w4.w * sigmoidf_(bfhi(og.y));
        *(uint2*)(orow + ocolbase + h * 64 + v0) = uint2{pk2(y0, y1), pk2(y2, y3)};
    }
}

DEV void ph_attn8(const Params& p, int l, char* smem0, int rbid, int RG) {
    const int n_gq = 768, n_c = (l == 0) ? 96 : 0;
    for (int it = rbid; it < n_gq + n_c; it += RG) {
        int b, qrow0, qcol, kcol, tcol, ua, nt;
        if (it < n_gq) {
            const int qt = it & 15, hq = (it >> 4) % 6;
            b = it / 96; qrow0 = b * SEQ + qt * 256; qcol = PC_GQQ + hq * 64; kcol = PC_GQK + (hq / 3) * 64; tcol = TC_GQV + (hq / 3) * 64; ua = 0; nt = 68;
        } else {
            const int r = it - n_gq;
            const int kind = r / 48, rr = r % 48, hh = rr % 6;
            b = rr / 6; qrow0 = NL + b * CTXL; ua = SEQ; nt = 4;
            if (kind == 0) { qcol = PC_GQQ + hh * 64; kcol = PC_GQK + (hh / 3) * 64; tcol = TC_GQV + (hh / 3) * 64; }
            else { qcol = PC_NAQ + hh * 64; kcol = PC_NAK + hh * 64; tcol = TC_NAV + hh * 64; }
        }
        flash_item<2, false, 8>(p, b, qrow0, qcol, kcol, tcol, ua, nt, 0, nt, 0, 0, nullptr, smem0, qcol);
    }
}
DEV void ph_attn(const Params& p, int l, char* smem, int bid, int G, int rep) {
    const int n_na = 3072, n_m2 = NSCAN * NCH;
    const int total = n_na + n_m2;
    for (int it = bid; it < total; it += G) {
        int r = it;
        if (r < n_na) {
            const int gr = r & 63, hn = (r >> 6) % 6, b = r / 384;
            int rs = gr - 4; rs = rs < 0 ? 0 : (rs > 56 ? 56 : rs);
            flash_item<1, true, 4>(p, b, b * SEQ + gr * 64, PC_NAQ + hn * 64, PC_NAK + hn * 64, TC_NAV + hn * 64, rs * 64, 8, SEQ, 12, gr, rs,
                                p.na_rpb + (size_t)(l * 6 + hn) * 465, smem, PC_NAQ + hn * 64 + (rep ? 1792 : 0));
            continue;
        }
        r -= n_na;
        m2_item(p, r / NCH, r % NCH);
    }
}

DEV void ph_m4(const Params& p, int l, int bid, int G, int rep) {
    const int nch = (l == 0) ? NCH : 64;
    const int total = NB * 4 * nch;
    for (int it = bid; it < total; it += G) {
        const int cu = it % nch, h = (it / nch) & 3, b = it / (nch * 4);
        m4_item(p, l, b, h, cu, rep ? 2048 : PC_MLQ);
    }
}

DEV void ph_merge(const Params& p, int mt0, int mtiles, char* smem, int vid, int G) {
    const u16* H = WSP(u16, OFF_H);
    u16* P = WSP(u16, OFF_P);
    const u16* Wg = WSP(u16, OFF_W) + WE_MIX + (size_t)2944 * 1024;
    const u16* Wbr = WSP(u16, OFF_W) + WE_BR;
    const int lane = VTID & 63, wave = VTID >> 6, wm = wave >> 1, wn = wave & 1, fr = lane & 15, fq = lane >> 4;
    const int total = mtiles * 16;
    for (int t = vid; t < total; t += G) {
        int mt_, nt_;
        tile_decode(t, 16, mt_, nt_);
        mt_ += mt0;
        const int m0 = mt_ * 128, n0 = nt_ * 64;
        f32x4 y[4][2];
        zero_acc<2>(y);
#pragma unroll 1
        for (int br = 0; br < 3; ++br) {
            const int ko = br == 0 ? 0 : (br == 1 ? 256 : 640);
            const int kk = br == 0 ? 256 : 384;
            f32x4 g[4][2];
            zero_acc<2>(g);
            gemm_accum<2>(g, H + (size_t)m0 * D, D, Wg + (size_t)(br * 1024 + n0) * D, D, D, smem, VTID);
#pragma unroll
            for (int i = 0; i < 4; ++i)
#pragma unroll
                for (int jn = 0; jn < 2; ++jn)
#pragma unroll
                    for (int r = 0; r < 4; ++r) g[i][jn][r] = sigmoidf_(g[i][jn][r]);
            f32x4 a[4][2];
            zero_acc<2>(a);
            gemm_accum<2>(a, P + (size_t)m0 * PW + ko, PW, Wbr + (size_t)n0 * D + ko, D, kk, smem, VTID);
#pragma unroll
            for (int i = 0; i < 4; ++i)
#pragma unroll
                for (int jn = 0; jn < 2; ++jn) y[i][jn] += g[i][jn] * a[i][jn];
        }
#pragma unroll
        for (int mt = 0; mt < 4; ++mt)
#pragma unroll
            for (int nt = 0; nt < 2; ++nt)
#pragma unroll
                for (int r = 0; r < 4; ++r) {
                    const int row = m0 + wm * 64 + mt * 16 + fq * 4 + r;
                    const int col = n0 + wn * 32 + nt * 16 + fr;
                    P[(size_t)row * PW + PC_Y + col] = (u16)(pk2(y[mt][nt][r], 0.f) & 0xffff);
                }
    }
}


#ifdef DBG
constexpr size_t OFF_DBG = al256(WS_END);
__global__ void __launch_bounds__(64) dbg_mlstm(Params p, int l) {
    const int sc = blockIdx.x, dir = sc & 1, h = (sc >> 1) & 3, b = sc >> 3, lane = VTID;
    const u16* P = WSP(u16, OFF_P); const u16* T = WSP(u16, OFF_T); const float* Gt = WSP(float, OFF_G);
    float* HN = WSP(float, OFF_S) + (size_t)sc * UT * 64;
    const float bi = p.ml_gate_b[l * 16 + dir * 8 + h], bf = p.ml_gate_b[l * 16 + dir * 8 + 4 + h];
    float C[64], n[64];
    for (int k = 0; k < 64; ++k) { C[k] = 0.f; n[k] = 0.f; }
    float m = 0.f;
    for (int pos = 0; pos < UT; ++pos) {
        int u;
        if (pos < 256) u = SEQ + (dir ? 255 - pos : pos); else u = dir ? 4095 - (pos - 256) : (pos - 256);
        const int row = rowof(b, u);
        const float ig = Gt[(size_t)row * 16 + dir * 8 + h] + bi;
        const float fp = Gt[(size_t)row * 16 + dir * 8 + 4 + h] + bf;
        const float lf = fminf(fp, 0.f) - log1pf(expf(-fabsf(fp)));
        const float mn = fmaxf(lf + m, ig);
        const float fw = expf(lf + m - mn), iw = expf(ig - mn);
        m = mn;
        const float qv = __uint_as_float(((uint32_t)P[(size_t)row * PW + 2048 + h * 64 + lane]) << 16);
        const float kv = __uint_as_float(((uint32_t)P[(size_t)row * PW + PC_MLK + h * 64 + lane]) << 16) * 0.125f;
        const float vv = __uint_as_float(((uint32_t)T[((size_t)(b * TW + TC_MLV + h * 64 + lane)) * UT + u]) << 16);
        float num = 0.f, den = 0.f;
#pragma unroll
        for (int k = 0; k < 64; ++k) {
            const float kk = __shfl(kv, k), qq = __shfl(qv, k);
            C[k] = fw * C[k] + iw * kk * vv;
            n[k] = fw * n[k] + iw * kk;
            num += qq * C[k];
            den += qq * n[k];
        }
        HN[(size_t)u * 64 + lane] = num / fmaxf(fabsf(den), expf(-m));
    }
}
__global__ void dbg_cmp(Params p, int l) {
    const int gid = blockIdx.x * blockDim.x + VTID;
    const u16* P = WSP(u16, OFF_P); const u16* T = WSP(u16, OFF_T);
    unsigned* dw = (unsigned*)(p.ws + OFF_DBG);
    float* df = (float*)(p.ws + OFF_DBG);
    if (gid < NB * 4 * UT) {
        const int u = gid % UT, h = (gid / UT) & 3, b = gid / (UT * 4);
        const int row = rowof(b, u);
        const float* hf = WSP(float, OFF_S) + ((size_t)((b * 4 + h) * 2 + 0) * UT + u) * 64;
        const float* hb = WSP(float, OFF_S) + ((size_t)((b * 4 + h) * 2 + 1) * UT + u) * 64;
        float ss = 0.f;
        for (int v = 0; v < 64; ++v) { const float x = hf[v] + hb[v]; ss += x * x; }
        const float rstd = rsqrtf(ss / 64.f + 1e-6f);
        float md = 0.f;
        for (int v = 0; v < 64; ++v) {
            const float x = (hf[v] + hb[v]) * rstd * p.ml_norm_w[l * 256 + h * 64 + v];
            const float o = __uint_as_float(((uint32_t)P[(size_t)row * PW + PC_MLO + h * 64 + v]) << 16);
            const float y = x / (1.f + expf(-o));
            const float got = __uint_as_float(((uint32_t)P[(size_t)row * PW + PC_MLQ + h * 64 + v]) << 16);
            md += fabsf(y - got);
        }
        atomicAdd(df + (u < SEQ ? 0 : 1), md * (1.f / 64.f));
        return;
    }
    const int w = (gid - NB * 4 * UT) >> 6;
    const int lane = VTID & 63;
    int type, b, qrow, qc, kcol, tcol, ocol, hn = 0, gr = 0, gc = 0, nkeys;
    if (w < 6144) {
        type = 0; const int i = w & 127; hn = (w >> 7) % 6; b = w / 768;
        gr = i & 63; gc = (i < 64) ? gr : 63 - gr;
        qrow = b * SEQ + gr * 64 + gc; qc = 2048 + 256 + hn * 64; kcol = PC_NAK + hn * 64; tcol = TC_NAV + hn * 64; ocol = PC_NAQ + hn * 64; nkeys = 384;
    } else if (w < 6144 + 256) {
        type = 1; const int x = w - 6144; const int i = x & 15, hh = (x >> 4) & 1; b = x >> 5;
        qrow = b * SEQ + (i * 273) % 4096; qc = 2688 + hh * 64; kcol = PC_GQK + hh * 64; tcol = TC_GQV + hh * 64; ocol = PC_GQQ + hh * 3 * 64; nkeys = 4352;
    } else if (w < 6144 + 256 + 768) {
        type = 2; const int x = w - 6400; const int i = x & 15; hn = (x >> 4) % 6; b = x / 96;
        qrow = NL + b * CTXL + (i * 17) % 256; qc = 2048 + 256 + hn * 64; kcol = PC_NAK + hn * 64; tcol = TC_NAV + hn * 64; ocol = PC_NAQ + hn * 64; nkeys = 256;
    } else if (w < 6144 + 256 + 768 + 256) {
        type = 3; const int x = w - 7168; const int i = x & 15, hh = (x >> 4) & 1; b = x >> 5;
        qrow = NL + b * CTXL + (i * 17) % 256; qc = 2688 + hh * 64; kcol = PC_GQK + hh * 64; tcol = TC_GQV + hh * 64; ocol = PC_GQQ + hh * 3 * 64; nkeys = 256;
    } else return;
    const float q = __uint_as_float(((uint32_t)P[(size_t)qrow * PW + qc + lane]) << 16);
    float o = 0.f;
    int rs = gr - 4; rs = rs < 0 ? 0 : (rs > 56 ? 56 : rs);
    int cs = gc - 8; cs = cs < 0 ? 0 : (cs > 48 ? 48 : cs);
    float mx = -1e30f, lsum = 0.f;
    for (int kidx = 0; kidx < nkeys; ++kidx) {
        int u; float bias = 0.f;
        if (type == 0) {
            if (kidx < 128) {
                const int ri = kidx >> 4, ci = kidx & 15;
                u = (rs + ri) * 64 + cs + ci;
                bias = p.na_rpb[(size_t)(l * 6 + hn) * 465 + (rs + ri - gr + 7) * 31 + (cs + ci - gc + 15)];
            } else u = SEQ + (kidx - 128);
        } else if (type == 1) u = kidx;
        else u = SEQ + kidx;
        const int krow = rowof(b, u);
        float sdot = wave_sum(q * __uint_as_float(((uint32_t)P[(size_t)krow * PW + kcol + lane]) << 16));
        sdot += bias;
        const float mn = fmaxf(mx, sdot);
        const float al = expf(mx - mn), e = expf(sdot - mn);
        lsum = lsum * al + e; mx = mn;
        o = o * al + e * __uint_as_float(((uint32_t)T[((size_t)(b * TW + tcol + lane)) * UT + u]) << 16);
    }
    const float got = __uint_as_float(((uint32_t)P[(size_t)qrow * PW + ocol + lane]) << 16);
    float md = wave_max(fabsf(o / lsum - got));
    if (lane == 0) atomicMax(dw + 2 + type, __float_as_uint(md));
}
__global__ void dbg_copy(Params p) {
    u16* P = WSP(u16, OFF_P);
    for (size_t i = (size_t)blockIdx.x * 256 + VTID; i < (size_t)MTOT * 768; i += (size_t)gridDim.x * 256) {
        const size_t row = i / 768, c = i % 768;
        const size_t src = c < 640 ? c : (c < 704 ? PC_GQQ + (c - 640) : PC_GQQ + 192 + (c - 704));
        P[row * PW + 2048 + c] = P[row * PW + src];
    }
}
DEV int dbg_row(int sr) { return sr < 8 ? sr * 4096 + (sr * 577 + 13) % 4096 : NL + (sr - 8) * 256 + ((sr - 8) * 37 + 5) % 256; }
DEV float* dbg_xrow(const Params& p, int row) { return row < NL ? p.out + (size_t)row * D : WSP(float, OFF_XC) + (size_t)(row - NL) * D; }
DEV float dbg_mod(const Params& p, int l, int b9, int idx, int n) {
    float a = p.ada_b[l * 9216 + idx * 1024 + n];
    for (int k = 0; k < 1024; ++k) {
        const float c = b9 < 8 ? p.c[b9 * 1024 + k] : p.c_ctx[k];
        a += c / (1.f + expf(-c)) * p.ada_w[((size_t)l * 1024 + k) * 9216 + idx * 1024 + n];
    }
    return a;
}
DEV float blk_sum(float v, float* red) {
    v = wave_sum(v);
    __syncthreads();
    if ((VTID & 63) == 0) red[VTID >> 6] = v;
    __syncthreads();
    return red[0] + red[1] + red[2] + red[3];
}
DEV float blk_max(float v, float* red) {
    v = wave_max(v);
    __syncthreads();
    if ((VTID & 63) == 0) red[VTID >> 6] = v;
    __syncthreads();
    return fmaxf(fmaxf(red[0], red[1]), fmaxf(red[2], red[3]));
}
__global__ void dbg_save(Params p, int slot) {
    const int sr = blockIdx.x, row = dbg_row(sr);
    float* dst = (float*)(p.ws + OFF_DBG + 256) + ((size_t)slot * 16 + sr) * 1024;
    const float* src = dbg_xrow(p, row);
    for (int n = VTID; n < 1024; n += 256) dst[n] = src[n];
}
DEV float dbg_modulate(const Params& p, int l, int sub, int b9, const float* xs, float* hs, float* red) {
    float ss = 0.f;
    for (int n = VTID; n < 1024; n += 256) ss += xs[n] * xs[n];
    ss = blk_sum(ss, red);
    const float rstd = rsqrtf(ss / 1024.f + 1e-6f);
    float md = 0.f;
    for (int n = VTID; n < 1024; n += 256) {
        const float sh = dbg_mod(p, l, b9, 3 * sub, n), sc = dbg_mod(p, l, b9, 3 * sub + 1, n);
        md = fmaxf(md, fabsf(sh - WSP(float, OFF_MODS)[b9 * 9216 + (3 * sub) * 1024 + n]));
        md = fmaxf(md, fabsf(sc - WSP(float, OFF_MODS)[b9 * 9216 + (3 * sub + 1) * 1024 + n]));
        hs[n] = xs[n] * rstd * p.norm_w[(l * 3 + sub) * 1024 + n] * (1.f + sc) + sh;
    }
    __syncthreads();
    return md;
}
__global__ void __launch_bounds__(256) dbg_ffn(Params p, int l, int which, int slot, int bit) {
    __shared__ float xs[1024], hs[1024], gs[1024], as[2816], red[4];
    const int sr = blockIdx.x, row = dbg_row(sr), b9 = row < NL ? row >> 12 : 8, sub = which ? 2 : 0;
    const float* xin = (const float*)(p.ws + OFF_DBG + 256) + ((size_t)slot * 16 + sr) * 1024;
    for (int n = VTID; n < 1024; n += 256) xs[n] = xin[n];
    __syncthreads();
    float mdm = dbg_modulate(p, l, sub, b9, xs, hs, red);
    for (int n = VTID; n < 1024; n += 256) gs[n] = dbg_mod(p, l, b9, 3 * sub + 2, n);
    const float* win = p.ffn_w_in + (size_t)(l * 2 + which) * 1024 * 5632;
    const float* wout = p.ffn_w_out + (size_t)(l * 2 + which) * 2816 * 1024;
    for (int j = VTID; j < 2816; j += 256) {
        float g = 0.f, u = 0.f;
        for (int k = 0; k < 1024; ++k) { g += hs[k] * win[(size_t)k * 5632 + j]; u += hs[k] * win[(size_t)k * 5632 + 2816 + j]; }
        as[j] = g / (1.f + expf(-g)) * u;
    }
    __syncthreads();
    float md = 0.f;
    const float* xc = dbg_xrow(p, row);
    for (int n = VTID; n < 1024; n += 256) {
        float o = 0.f;
        for (int j = 0; j < 2816; ++j) o += as[j] * wout[(size_t)j * 1024 + n];
        md = fmaxf(md, fabsf(xs[n] + 0.5f * gs[n] * o - xc[n]));
    }
    md = blk_max(md, red);
    mdm = blk_max(mdm, red);
    unsigned* dw = (unsigned*)(p.ws + OFF_DBG);
    if (VTID == 0) { atomicMax(dw + bit, __float_as_uint(md)); atomicMax(dw + 15, __float_as_uint(mdm)); }
}
__global__ void __launch_bounds__(256) dbg_pchk(Params p, int l) {
    __shared__ float xs[1024], hs[1024], red[4];
    const int sr = blockIdx.x, row = dbg_row(sr), b9 = row < NL ? row >> 12 : 8;
    const float* xin = dbg_xrow(p, row);
    for (int n = VTID; n < 1024; n += 256) xs[n] = xin[n];
    __syncthreads();
    float mdm = dbg_modulate(p, l, 1, b9, xs, hs, red);
    const float* w = p.mix_w_in + (size_t)l * 1024 * NIN;
    const u16* P = WSP(u16, OFF_P); const u16* T = WSP(u16, OFF_T);
    int b, u;
    if (row < NL) { b = row >> 12; u = row & 4095; } else { b = (row - NL) >> 8; u = SEQ + ((row - NL) & 255); }
    float md = 0.f;
    for (int n = VTID; n < 2832; n += 256) {
        const int sc = map_col(2, n);
        float v = 0.f;
        for (int k = 0; k < 1024; ++k) v += hs[k] * w[(size_t)k * NIN + sc];
        if (n < 2048) md = fmaxf(md, fabsf(v - __uint_as_float(((uint32_t)P[(size_t)row * PW + n]) << 16)));
        if (n >= 1280 && n < 1536) md = fmaxf(md, fabsf(v - __uint_as_float(((uint32_t)T[((size_t)(b * TW + n - 1280)) * UT + u]) << 16)));
        if (n >= 2048 && n < 2816) md = fmaxf(md, fabsf(v - __uint_as_float(((uint32_t)T[((size_t)(b * TW + n - 1792)) * UT + u]) << 16)));
        if (n >= 2816) md = fmaxf(md, fabsf(v - WSP(float, OFF_G)[(size_t)row * 16 + n - 2816]));
    }
    md = blk_max(md, red);
    mdm = blk_max(mdm, red);
    unsigned* dw = (unsigned*)(p.ws + OFF_DBG);
    if (VTID == 0) { atomicMax(dw + 9, __float_as_uint(md)); atomicMax(dw + 15, __float_as_uint(mdm)); }
}
__global__ void __launch_bounds__(256) dbg_mix(Params p, int l, int slot) {
    __shared__ float xs[1024], hs[1024], os[1024], ys[1024], red[4];
    const int sr = blockIdx.x, row = dbg_row(sr), b9 = row < NL ? row >> 12 : 8;
    const float* xin = (const float*)(p.ws + OFF_DBG + 256) + ((size_t)slot * 16 + sr) * 1024;
    const u16* P = WSP(u16, OFF_P);
    for (int n = VTID; n < 1024; n += 256) { xs[n] = xin[n]; os[n] = __uint_as_float(((uint32_t)P[(size_t)row * PW + n]) << 16); }
    __syncthreads();
    float mdm = dbg_modulate(p, l, 1, b9, xs, hs, red);
    const float* w = p.mix_w_in + (size_t)l * 1024 * NIN;
    for (int n = VTID; n < 1024; n += 256) {
        float y = 0.f;
        for (int i = 0; i < 3; ++i) {
            float g = 0.f;
            for (int k = 0; k < 1024; ++k) g += hs[k] * w[(size_t)k * NIN + 2832 + i * 1024 + n];
            g = 1.f / (1.f + expf(-g));
            const float* wb = i == 0 ? p.w_br_ml + (size_t)l * 256 * 1024 : (i == 1 ? p.w_br_na + (size_t)l * 384 * 1024 : p.w_br_gq + (size_t)l * 384 * 1024);
            const int ko = i == 0 ? 0 : (i == 1 ? 256 : 640), kk = i == 0 ? 256 : 384;
            float a = 0.f;
            for (int k = 0; k < kk; ++k) a += os[ko + k] * wb[(size_t)k * 1024 + n];
            y += g * a;
        }
        ys[n] = y;
    }
    __syncthreads();
    float md = 0.f;
    const float* xc = dbg_xrow(p, row);
    for (int n = VTID; n < 1024; n += 256) {
        float o = 0.f;
        for (int k = 0; k < 1024; ++k) o += ys[k] * p.w_out[((size_t)l * 1024 + k) * 1024 + n];
        const float g5 = dbg_mod(p, l, b9, 5, n);
        md = fmaxf(md, fabsf(xs[n] + g5 * o - xc[n]));
    }
    md = blk_max(md, red);
    mdm = blk_max(mdm, red);
    unsigned* dw = (unsigned*)(p.ws + OFF_DBG);
    if (VTID == 0) { atomicMax(dw + 10, __float_as_uint(md)); atomicMax(dw + 15, __float_as_uint(mdm)); }
}
__global__ void dbg_fin(Params p) {
    const unsigned* dw = (const unsigned*)(p.ws + OFF_DBG);
    int mask = 0;
    if (__uint_as_float(dw[8]) > 0.02f) mask |= 1;
    if (__uint_as_float(dw[9]) > 0.03f) mask |= 2;
    if (__uint_as_float(dw[10]) > 0.02f) mask |= 4;
    if (__uint_as_float(dw[11]) > 0.02f) mask |= 8;
    if (__uint_as_float(dw[15]) > 1e-3f) mask |= 16;
    if (__uint_as_float(dw[4]) > 0.03f) mask |= 32;
    p.out[0] += 10.f * (float)mask;
    p.out[1] += 1000.f * __uint_as_float(dw[4]);
}
#endif


DEV void gemm8b_accum(f32x4 (&acc)[4][4], const u16* __restrict__ A, int lda, const u16* __restrict__ B, int ldb, int K, char* smem, int tid) {
    constexpr int STAGE = 49152;
    const int lane = tid & 63, wave = tid >> 6;
    const int wm = wave >> 1, wn = wave & 1, fr = lane & 15, fq = lane >> 4;
    const int lr = lane >> 3, pos = lane & 7;
    const int ce = pos ^ (lr >> 1), co = pos ^ (4 | (lr >> 1));
    const unsigned ra_ = (unsigned)((wave * 32 + lr) * lda) * 2u, rb_ = (unsigned)((wave * 16 + lr) * ldb) * 2u;
    const unsigned voa_e = ra_ + ce * 16, voa_o = ra_ + co * 16, vob_e = rb_ + ce * 16, vob_o = rb_ + co * 16;
    const int nk = K >> 6;
    const unsigned ldsb = (unsigned)(size_t)(__attribute__((address_space(3))) char*)smem;
    const unsigned ldsa_w = __builtin_amdgcn_readfirstlane(ldsb + wave * 4096);
    const unsigned ldsb_w = __builtin_amdgcn_readfirstlane(ldsb + 32768 + wave * 2048);
#define G8B_ISSUE(STG, K0) do { \
        _Pragma("unroll") for (int i = 0; i < 4; ++i) glds16(A + (size_t)(8 * i) * lda + (K0), (i & 1) ? voa_o : voa_e, ldsa_w + (STG) * STAGE + i * 1024); \
        _Pragma("unroll") for (int i = 0; i < 2; ++i) glds16(B + (size_t)(8 * i) * ldb + (K0), (i & 1) ? vob_o : vob_e, ldsb_w + (STG) * STAGE + i * 1024); \
    } while (0)
    G8B_ISSUE(0, 0);
    VM_WAIT0();
    __syncthreads();
    const int s3 = (fr >> 1) & 7;
    const int oa_base = (wm * 64 + fr) * 128 + ((fq ^ s3) * 16);
    const int ob_base = 32768 + (wn * 64 + fr) * 128 + ((fq ^ s3) * 16);
    for (int kt = 0; kt < nk; ++kt) {
        const int cur = kt & 1;
        const int k0 = (kt + 1 < nk ? kt + 1 : kt) * 64;
        G8B_ISSUE(cur ^ 1, k0);
        int o_a = cur * STAGE + oa_base, o_b = cur * STAGE + ob_base;
        asm volatile("" : "+v"(o_a), "+v"(o_b));
#pragma unroll
        for (int ks = 0; ks < 2; ++ks) {
            const char* sa_c = smem + (ks ? (o_a ^ 64) : o_a);
            const char* sb_c = smem + (ks ? (o_b ^ 64) : o_b);
            bf16x8 bfr[4], af[4];
#pragma unroll
            for (int nt = 0; nt < 4; ++nt) bfr[nt] = *(const bf16x8*)(sb_c + nt * 2048);
#pragma unroll
            for (int mt = 0; mt < 4; ++mt) af[mt] = *(const bf16x8*)(sa_c + mt * 2048);
#pragma unroll
            for (int mt = 0; mt < 4; ++mt)
#pragma unroll
                for (int nt = 0; nt < 4; ++nt) acc[mt][nt] = mfma16(af[mt], bfr[nt], acc[mt][nt]);
            __builtin_amdgcn_sched_group_barrier(0x100, 7, 0);
            __builtin_amdgcn_sched_group_barrier(0x008, 4, 0);
            __builtin_amdgcn_sched_group_barrier(0x100, 1, 0);
#pragma unroll
            for (int i = 0; i < 3; ++i) __builtin_amdgcn_sched_group_barrier(0x008, 4, 0);
        }
        VM_WAIT0();
        __syncthreads();
    }
#undef G8B_ISSUE
}

DEV void ph_merge8(const Params& p, char* smem, int rvid, int RG, int tid) {
    const u16* H = WSP(u16, OFF_H);
    u16* P = WSP(u16, OFF_P);
    const u16* Wg = WSP(u16, OFF_W) + WE_MIX + (size_t)2944 * 1024;
    const u16* Wbr = WSP(u16, OFF_W) + WE_BR;
    const int lane = tid & 63, wave = tid >> 6, wm = wave >> 1, wn = wave & 1, fr = lane & 15, fq = lane >> 4;
    const int total = 128 * 8;
    for (int t = rvid; t < total; t += RG) {
        const int gi = t >> 5, rem = t & 31;
        const int mt_ = gi * 4 + (rem & 3), nt_ = rem >> 2;
        const int m0 = mt_ * 256, n0 = nt_ * 128;
        f32x4 y[4][4];
        zero_acc<4>(y);
#pragma unroll 1
        for (int br = 0; br < 3; ++br) {
            const int ko = br == 0 ? 0 : (br == 1 ? 256 : 640);
            const int kk = br == 0 ? 256 : 384;
            uint32_t gpk[4][4][2];
            {
                f32x4 g[4][4];
                zero_acc<4>(g);
                gemm8b_accum(g, H + (size_t)m0 * D, D, Wg + (size_t)(br * 1024 + n0) * D, D, D, smem, tid);
#pragma unroll
                for (int i = 0; i < 4; ++i)
#pragma unroll
                    for (int jn = 0; jn < 4; ++jn) {
                        gpk[i][jn][0] = pk2(sigmoidf_(g[i][jn][0]), sigmoidf_(g[i][jn][1]));
                        gpk[i][jn][1] = pk2(sigmoidf_(g[i][jn][2]), sigmoidf_(g[i][jn][3]));
                    }
            }
            f32x4 a[4][4];
            zero_acc<4>(a);
            gemm8b_accum(a, P + (size_t)m0 * PW + ko, PW, Wbr + (size_t)n0 * D + ko, D, kk, smem, tid);
#pragma unroll
            for (int i = 0; i < 4; ++i)
#pragma unroll
                for (int jn = 0; jn < 4; ++jn) {
                    y[i][jn][0] += bflo(gpk[i][jn][0]) * a[i][jn][0];
                    y[i][jn][1] += bfhi(gpk[i][jn][0]) * a[i][jn][1];
                    y[i][jn][2] += bflo(gpk[i][jn][1]) * a[i][jn][2];
                    y[i][jn][3] += bfhi(gpk[i][jn][1]) * a[i][jn][3];
                }
        }
#pragma unroll
        for (int mt = 0; mt < 4; ++mt)
#pragma unroll
            for (int nt = 0; nt < 4; ++nt)
#pragma unroll
                for (int r = 0; r < 4; ++r) {
                    const int row = m0 + wm * 64 + mt * 16 + fq * 4 + r;
                    const int col = n0 + wn * 64 + nt * 16 + fr;
                    P[(size_t)row * PW + PC_Y + col] = (u16)(pk2(y[mt][nt][r], 0.f) & 0xffff);
                }
    }
}

constexpr int PH_PER_LAYER = 15;
constexpr int N_PHASES = 2 * PH_PER_LAYER;

#ifndef REPEAT_MASK
#define REPEAT_MASK 0
#endif
template <int Q>
DEV void run_phase_q(const Params& p, int l, char* smem) {
    const int half = (int)((threadIdx.x + p.z) >> 8);
    const int G = gridDim.x * 2, bid = blockIdx.x * 2 + half;
    const int vid = (gridDim.x % 8 == 0) ? (int)(blockIdx.x & 7) * (G >> 3) + (int)(blockIdx.x >> 3) * 2 + half : bid;
    smem += half * 73728;
    const bool last = (l == 1);
    const u16* W = WSP(u16, OFF_W);
    const int nrep = ((REPEAT_MASK >> Q) & 1) ? 2 : 1;
    char* smem0 = smem - half * 73728;
    const int rtid = (int)(threadIdx.x + p.z);
    const int RG = gridDim.x;
    const int rvid = (RG % 8 == 0) ? (int)(blockIdx.x & 7) * (RG >> 3) + (int)(blockIdx.x >> 3) : (int)blockIdx.x;
    for (int rep = 0; rep < nrep; ++rep) {
        const float cm = rep ? 0.f : 1.f;
        if (Q == 0) ph_prep(p, l, smem, bid, G);
        if (Q == 1) ph_mod(p, l, 0, MTOT, bid, G);
        Params p2 = p;
        if (Q == 2) { ph_ffn_in8(p, 0, smem0, rvid, RG, rtid); int z2 = p.z; asm volatile("" : "+s"(z2) :: "memory"); p2.z = z2; ph_ffn_in(p2, 0, 256, 16, smem, vid, G); }
        if (Q == 3) { ph_resid8(p, WSP(u16, OFF_P), DFF, W + WE_OUT0, DFF, 2, 0.5f * cm, smem0, rvid, RG, rtid); int z2 = p.z; asm volatile("" : "+s"(z2) :: "memory"); p2.z = z2;
                      ph_resid(p2, WSP(u16, OFF_P), DFF, W + WE_OUT0, DFF, 2, 0.5f * cm, 256, 16, smem, vid, G); }
        if (Q == 4) ph_mod(p, l, 1, MTOT, bid, G);
        if (Q == 5) { ph_pgemm8(p, smem0, rvid, RG, rtid); int z2 = p.z; asm volatile("" : "+s"(z2) :: "memory"); p2.z = z2; ph_pgemm(p2, 256, 16, smem, vid, G); }
        if (Q == 6) ph_qknorm_gates(p, l, bid, G);
        if (Q == 7) { ph_attn8(p, l, smem0, rvid, RG); int z2 = p.z; asm volatile("" : "+s"(z2) :: "memory"); p2.z = z2; ph_attn(p2, l, smem, bid, G, rep); }
        if (Q == 8) ph_m3(p, bid, G);
        if (Q == 9) ph_m4(p, l, bid, G, rep);
        if (Q == 10) { ph_merge8(p, smem0, rvid, RG, rtid); int z2 = p.z; asm volatile("" : "+s"(z2) :: "memory"); p2.z = z2; if (!last) ph_merge(p2, 256, 16, smem, vid, G); }
        if (Q == 11) { ph_resid8(p, WSP(u16, OFF_P) + PC_Y, PW, W + WE_O, D, 5, 1.0f * cm, smem0, rvid, RG, rtid);
                       int z2 = p.z; asm volatile("" : "+s"(z2) :: "memory"); p2.z = z2;
                       if (!last) ph_resid(p2, WSP(u16, OFF_P) + PC_Y, PW, W + WE_O, D, 5, 1.0f * cm, 256, 16, smem, vid, G); }
        if (Q == 12) ph_mod(p, l, 2, last ? NL : MTOT, bid, G);
        if (Q == 13) { ph_ffn_in8(p, 1, smem0, rvid, RG, rtid); int z2 = p.z; asm volatile("" : "+s"(z2) :: "memory"); p2.z = z2; if (!last) ph_ffn_in(p2, 1, 256, 16, smem, vid, G); }
        if (Q == 14) { ph_resid8(p, WSP(u16, OFF_P), DFF, W + WE_OUT1, DFF, 8, 0.5f * cm, smem0, rvid, RG, rtid);
                       int z2 = p.z; asm volatile("" : "+s"(z2) :: "memory"); p2.z = z2;
                       if (!last) ph_resid(p2, WSP(u16, OFF_P), DFF, W + WE_OUT1, DFF, 8, 0.5f * cm, 256, 16, smem, vid, G); }
    }
}

DEV void run_phase(const Params& p, int ph, char* smem) {
    const int l = ph / PH_PER_LAYER, q = ph % PH_PER_LAYER;
    switch (q) {
        case 0: run_phase_q<0>(p, l, smem); break;
        case 1: run_phase_q<1>(p, l, smem); break;
        case 2: run_phase_q<2>(p, l, smem); break;
        case 3: run_phase_q<3>(p, l, smem); break;
        case 4: run_phase_q<4>(p, l, smem); break;
        case 5: run_phase_q<5>(p, l, smem); break;
        case 6: run_phase_q<6>(p, l, smem); break;
        case 7: run_phase_q<7>(p, l, smem); break;
        case 8: run_phase_q<8>(p, l, smem); break;
        case 9: run_phase_q<9>(p, l, smem); break;
        case 10: run_phase_q<10>(p, l, smem); break;
        case 11: run_phase_q<11>(p, l, smem); break;
        case 12: run_phase_q<12>(p, l, smem); break;
        case 13: run_phase_q<13>(p, l, smem); break;
        case 14: run_phase_q<14>(p, l, smem); break;
    }
}

template <int Q>
__global__ void __launch_bounds__(256, 2) phase_kernel(Params p, int l) {
    __shared__ __attribute__((aligned(16))) char smem[73728];
    run_phase_q<Q>(p, l, smem);
}

#if ONE_LAUNCH
#define XB_TMO      128
#define XB_XCNT(j)  (256  + 64 * (j))
#define XB_XSUB(j)  (1280 + 64 * (j))
#define XB_XGEN(j)  (2304 + 64 * (j))
#define XB_TOP      3328
#define XB_TOPGEN   3392
#define XB_SPIN_CAP (1u << 22)
DEV unsigned xb_ld(unsigned* q) { return __hip_atomic_load(q, __ATOMIC_RELAXED, __HIP_MEMORY_SCOPE_AGENT); }
DEV unsigned xb_add(unsigned* q, unsigned v) { return __hip_atomic_fetch_add(q, v, __ATOMIC_RELAXED, __HIP_MEMORY_SCOPE_AGENT); }
DEV unsigned xb_xcc_id() { return (unsigned)__builtin_amdgcn_s_getreg((3 << 11) | 20) & 0xFu; }
#define XB_SPIN(cond, bar) do { unsigned _sp = 0; while (cond) { __builtin_amdgcn_s_sleep(1); \
    if ((++_sp & 255u) == 0u) { if (xb_ld(&(bar)[XB_TMO])) break; if (_sp > XB_SPIN_CAP) { atomicAdd(&(bar)[XB_TMO], 1u); break; } } } } while (0)
DEV void xcd_census(unsigned* bar, unsigned x, unsigned& nloc, unsigned& nx) {
    const unsigned G = gridDim.x;
    unsigned sum, cnt, mine, sp = 0u;
    for (;;) {
        sum = 0u; cnt = 0u; mine = 0u;
#pragma unroll
        for (unsigned j = 0; j < 16; ++j) { const unsigned c = xb_ld(&bar[XB_XCNT(j)]); sum += c; cnt += (c > 0u) ? 1u : 0u; mine = (j == x) ? c : mine; }
        if (sum == G) break;
        __builtin_amdgcn_s_sleep(1);
        if ((++sp & 255u) == 0u) { if (xb_ld(&bar[XB_TMO])) break; if (sp > XB_SPIN_CAP) { atomicAdd(&bar[XB_TMO], 1u); break; } }
    }
    nloc = mine > 0u ? mine : 1u; nx = cnt > 0u ? cnt : 1u;
}
DEV void xcd_barrier(unsigned* bar, unsigned x, volatile unsigned* st, int tid) {
    asm volatile("s_waitcnt vmcnt(0)" ::: "memory");
    __syncthreads();
    if (tid == 0) {
        __builtin_amdgcn_s_waitcnt(0);
        unsigned nloc = st[0], nx = st[1];
        if (nloc == 0u) { xcd_census(bar, x, nloc, nx); st[0] = nloc; st[1] = nx; }
        const unsigned old = xb_add(&bar[XB_XSUB(x)], 1u);
        const unsigned gen = old / nloc;
        if (old + 1u == (gen + 1u) * nloc) {
            __builtin_amdgcn_fence(__ATOMIC_RELEASE, "agent");
            asm volatile("s_waitcnt vmcnt(0)" ::: "memory");
            const unsigned og = xb_add(&bar[XB_TOP], 1u);
            const unsigned tg = og / nx;
            if (og + 1u == (tg + 1u) * nx) xb_add(&bar[XB_TOPGEN], 1u);
            else XB_SPIN(xb_ld(&bar[XB_TOPGEN]) == tg, bar);
            __builtin_amdgcn_fence(__ATOMIC_ACQUIRE, "agent");
            xb_add(&bar[XB_XGEN(x)], 1u);
            asm volatile("s_waitcnt vmcnt(0)" ::: "memory");
        } else {
            XB_SPIN(xb_ld(&bar[XB_XGEN(x)]) == gen, bar);
            __builtin_amdgcn_fence(__ATOMIC_ACQUIRE, "agent");
            asm volatile("s_waitcnt vmcnt(0)" ::: "memory");
        }
    }
    __syncthreads();
}
__global__ void __launch_bounds__(512, 2) mega_kernel(Params p0, int ph_begin, int ph_end) {
    __shared__ __attribute__((aligned(16))) char smem[147456];
    __shared__ uint4 xb_words;
    unsigned* bar = (unsigned*)(p0.ws + OFF_BAR);
    const unsigned xcc = xb_xcc_id();
    if (threadIdx.x == 0) { xb_words = make_uint4(0u, 0u, 0u, 0u); (void)xb_add(&bar[XB_XCNT(xcc)], 1u); }
    __syncthreads();
    for (int ph = ph_begin; ph < ph_end; ++ph) {
        Params p = p0;
        int z = p0.z;
        asm volatile("" : "+s"(z));
        p.z = z;
        p.ws = p0.ws + z;
        p.out = p0.out + z;
        run_phase(p, ph, smem);
        if (ph + 1 < ph_end) {
            if (p0.z == 0x7fffffff) cg::this_grid().sync();
            xcd_barrier(bar, xcc, (volatile unsigned*)&xb_words, (int)threadIdx.x + z);
        }
    }
}
#endif

extern "C" void kernel_launch(void* const* d_in, const int* in_sizes, int n_in, void* d_out, int out_size, void* d_ws, size_t ws_size,
                              hipStream_t stream) {
    if (ws_size < WS_END) { fprintf(stderr, "workspace too small: %zu < %zu\n", ws_size, (size_t)WS_END); return; }
    Params p{};
    p.x = (const float*)d_in[0]; p.c = (const float*)d_in[1]; p.ctx = (const float*)d_in[2]; p.c_ctx = (const float*)d_in[3];
    p.ada_w = (const float*)d_in[4]; p.ada_b = (const float*)d_in[5]; p.norm_w = (const float*)d_in[6];
    p.ffn_w_in = (const float*)d_in[7]; p.ffn_w_out = (const float*)d_in[8]; p.mix_w_in = (const float*)d_in[9];
    p.ml_gate_b = (const float*)d_in[10]; p.ml_norm_w = (const float*)d_in[11]; p.na_qk_w = (const float*)d_in[12];
    p.na_rpb = (const float*)d_in[13]; p.gq_qk_w = (const float*)d_in[14]; p.w_br_ml = (const float*)d_in[15];
    p.w_br_na = (const float*)d_in[16]; p.w_br_gq = (const float*)d_in[17]; p.w_out = (const float*)d_in[18];
    p.out = (float*)d_out; p.ws = (char*)d_ws;
#ifdef NANFILL
    hipMemsetAsync(d_ws, 0xFF, WS_END, stream);
#endif
#if ONE_LAUNCH
    static int grid_blocks = 0;
    if (!grid_blocks) {
        int dev = 0, cus = 0, per_cu = 0;
        hipGetDevice(&dev);
        hipDeviceGetAttribute(&cus, hipDeviceAttributeMultiprocessorCount, dev);
        hipOccupancyMaxActiveBlocksPerMultiprocessor(&per_cu, mega_kernel, 512, 0);
        per_cu = 1;
        grid_blocks = cus * per_cu;
    }
    hipMemsetAsync((char*)d_ws + OFF_BAR, 0, 3456 * 4, stream);
    int pb = 0, pe = N_PHASES;
    void* args[] = {&p, &pb, &pe};
#ifdef SPLIT_TEST
    (void)args;
    for (int ph = 0; ph < N_PHASES; ++ph) mega_kernel<<<grid_blocks, 256, 0, stream>>>(p, ph, ph + 1);
#else
    hipError_t e = hipLaunchCooperativeKernel((void*)mega_kernel, dim3(grid_blocks), dim3(512), args, 0, stream);
    if (e != hipSuccess) fprintf(stderr, "cooperative launch failed: %s (grid %d)\n", hipGetErrorString(e), grid_blocks);
#endif
#else
    for (int l = 0; l < 2; ++l) {
#define LP(Q) phase_kernel<Q><<<512, 256, 0, stream>>>(p, l)
#ifdef DBG
        const bool dl = (l == DBG_LAYER);
        if (dl) hipMemsetAsync((char*)d_ws + OFF_DBG, 0, 256, stream);
        LP(0);
        if (dl) dbg_save<<<16, 256, 0, stream>>>(p, 0);
        LP(1); LP(2); LP(3);
        if (dl) dbg_ffn<<<16, 256, 0, stream>>>(p, l, 0, 0, 8);
        LP(4); LP(5);
        if (dl) dbg_pchk<<<16, 256, 0, stream>>>(p, l);
        LP(6);
        if (dl) dbg_copy<<<2048, 256, 0, stream>>>(p);
        LP(7); LP(8); LP(9);
        if (dl) {
            dbg_mlstm<<<64, 64, 0, stream>>>(p, l);
            dbg_cmp<<<(NB * 4 * UT + 7424 * 64 + 255) / 256, 256, 0, stream>>>(p, l);
            dbg_save<<<16, 256, 0, stream>>>(p, 1);
        }
        LP(10); LP(11);
        if (dl) { dbg_mix<<<16, 256, 0, stream>>>(p, l, 1); dbg_save<<<16, 256, 0, stream>>>(p, 2); }
        LP(12); LP(13); LP(14);
        if (dl) dbg_ffn<<<16, 256, 0, stream>>>(p, l, 1, 2, 11);
#else
        LP(0); LP(1); LP(2); LP(3); LP(4); LP(5); LP(6); LP(7); LP(8); LP(9); LP(10); LP(11); LP(12); LP(13); LP(14);
#endif
#undef LP
    }
#ifdef DBG
    dbg_fin<<<1, 1, 0, stream>>>(p);
#endif
#endif
}
```

```cpp
#include <hip/hip_runtime.h>
#include <hip/hip_cooperative_groups.h>
#include <stdint.h>
#include <cstdio>
namespace cg = cooperative_groups;

#ifndef ONE_LAUNCH
#define ONE_LAUNCH 1
#endif

#define VTID ((int)((threadIdx.x + p.z) & 255))
typedef unsigned short u16;
typedef __attribute__((ext_vector_type(8))) short bf16x8;
typedef __attribute__((ext_vector_type(4))) float f32x4;
#define DEV __device__ __forceinline__

constexpr int D = 1024, NB = 8, SEQ = 4096, CTXL = 256;
constexpr int NL = NB * SEQ, NCX = NB * CTXL, MTOT = NL + NCX;
constexpr int DFF = 2816, PW = 2816, UT = SEQ + CTXL, NCH = UT / 64;
constexpr int NIN = 5904;
constexpr int PC_MLQ = 0, PC_NAQ = 256, PC_GQQ = 640, PC_MLO = 1024, PC_MLK = 1280, PC_NAK = 1536, PC_GQK = 1920,
              PC_MLV = 2048, PC_NAV = 2304, PC_GQV = 2688, PC_Y = 1024;
constexpr int TC_MLK = 0, TC_MLV = 256, TC_NAV = 512, TC_GQV = 896, TW = 1024;
constexpr int DBG_MLO = PC_MLQ, DBG_NAO = PC_NAQ;
constexpr int SCH = 4160;
constexpr int NSCAN = 64;

constexpr size_t al256(size_t x) { return (x + 255) & ~(size_t)255; }
constexpr size_t OFF_MODS = 0;
constexpr size_t OFF_ROPE = al256(OFF_MODS + (size_t)9 * 9216 * 4);
constexpr size_t OFF_G    = al256(OFF_ROPE + (size_t)4096 * 64 * 4);
constexpr size_t OFF_BC   = al256(OFF_G + (size_t)MTOT * 16 * 4);
constexpr size_t OFF_IG   = al256(OFF_BC + (size_t)NSCAN * UT * 4);
constexpr size_t OFF_AE   = al256(OFF_IG + (size_t)NSCAN * UT * 4);
constexpr size_t OFF_MS   = al256(OFF_AE + (size_t)NSCAN * UT * 4);
constexpr size_t OFF_DEC  = al256(OFF_MS + (size_t)NSCAN * NCH * 4);
constexpr size_t OFF_XC   = al256(OFF_DEC + (size_t)NSCAN * NCH * 4);
constexpr size_t OFF_H    = al256(OFF_XC + (size_t)NCX * D * 4);
constexpr size_t OFF_P    = al256(OFF_H + (size_t)MTOT * D * 2);
constexpr size_t OFF_T    = al256(OFF_P + (size_t)MTOT * PW * 2);
constexpr size_t OFF_S    = al256(OFF_T + (size_t)NB * TW * UT * 2);
constexpr size_t OFF_W    = al256(OFF_S + (size_t)NSCAN * NCH * SCH * 4);
constexpr size_t WE_IN0 = 0, WE_IN1 = WE_IN0 + (size_t)5632 * 1024, WE_OUT0 = WE_IN1 + (size_t)5632 * 1024,
                 WE_OUT1 = WE_OUT0 + (size_t)1024 * 2816, WE_MIX = WE_OUT1 + (size_t)1024 * 2816,
                 WE_BR = WE_MIX + (size_t)6016 * 1024, WE_O = WE_BR + (size_t)1024 * 1024, WE_END = WE_O + (size_t)1024 * 1024;
constexpr size_t OFF_BAR = al256(OFF_W + WE_END * 2);
constexpr size_t WS_END = OFF_BAR + 3456 * 4;
static_assert(WS_END < (size_t)536000000, "workspace too large");

struct Params {
    const float *x, *c, *ctx, *c_ctx, *ada_w, *ada_b, *norm_w, *ffn_w_in, *ffn_w_out, *mix_w_in, *ml_gate_b, *ml_norm_w,
        *na_qk_w, *na_rpb, *gq_qk_w, *w_br_ml, *w_br_na, *w_br_gq, *w_out;
    float* out;
    char* ws;
    int z, pad;
};

DEV uint32_t pk2(float lo, float hi) { uint32_t r; asm("v_cvt_pk_bf16_f32 %0, %1, %2" : "=v"(r) : "v"(lo), "v"(hi)); return r; }
DEV float bflo(uint32_t w) { return __uint_as_float(w << 16); }
DEV float bfhi(uint32_t w) { return __uint_as_float(w & 0xffff0000u); }
DEV f32x4 mfma16(bf16x8 a, bf16x8 b, f32x4 c) { return __builtin_amdgcn_mfma_f32_16x16x32_bf16(a, b, c, 0, 0, 0); }
typedef unsigned u32x4 __attribute__((ext_vector_type(4)));
DEV u32x4 gld16(const void* q) { u32x4 r; asm volatile("global_load_dwordx4 %0, %1, off" : "=v"(r) : "v"(q) : "memory"); return r; }
DEV u32x4 gld16s(const void* sbase, unsigned voff) { u32x4 r; asm volatile("global_load_dwordx4 %0, %1, %2" : "=v"(r) : "v"(voff), "s"(sbase) : "memory"); return r; }
DEV void glds16(const void* sbase, unsigned voff, unsigned ldsaddr) {
    asm volatile("s_mov_b32 m0, %2\n\ts_nop 0\n\tglobal_load_lds_dwordx4 %0, %1" :: "v"(voff), "s"(sbase), "s"(ldsaddr) : "memory", "m0");
}
#define VM_WAIT0() asm volatile("s_waitcnt vmcnt(0)" ::: "memory")
union Frag { bf16x8 v; uint4 q; uint32_t u[4]; uint2 d[2]; };
DEV int cu_of(int c, int dir) { return c < 4 ? 64 + (dir ? 3 - c : c) : (dir ? 63 - (c - 4) : (c - 4)); }
DEV int rowof(int b, int u) { return u < SEQ ? b * SEQ + u : NL + b * CTXL + (u - SEQ); }
DEV float fexp2(float x) { return __builtin_amdgcn_exp2f(x); }
DEV float fexp(float x) { return __builtin_amdgcn_exp2f(x * 1.4426950408889634f); }
DEV float sigmoidf_(float x) { return 1.f / (1.f + fexp(-x)); }
DEV float xq_max(float v) {
    auto r = __builtin_amdgcn_permlane16_swap(__float_as_uint(v), __float_as_uint(v), false, false);
    const float m = fmaxf(__uint_as_float(r[0]), __uint_as_float(r[1]));
    auto q = __builtin_amdgcn_permlane32_swap(__float_as_uint(m), __float_as_uint(m), false, false);
    return fmaxf(__uint_as_float(q[0]), __uint_as_float(q[1]));
}
DEV float xq_sum(float v) {
    auto r = __builtin_amdgcn_permlane16_swap(__float_as_uint(v), __float_as_uint(v), false, false);
    const float m = __uint_as_float(r[0]) + __uint_as_float(r[1]);
    auto q = __builtin_amdgcn_permlane32_swap(__float_as_uint(m), __float_as_uint(m), false, false);
    return __uint_as_float(q[0]) + __uint_as_float(q[1]);
}
DEV float wave_sum(float v) {
#pragma unroll
    for (int o = 1; o < 64; o <<= 1) v += __shfl_xor(v, o);
    return v;
}
DEV float wave_max(float v) {
#pragma unroll
    for (int o = 1; o < 64; o <<= 1) v = fmaxf(v, __shfl_xor(v, o));
    return v;
}

#define WSP(T_, off) ((T_*)(p.ws + (off)))
DEV float m_scan(const Params& p, int sc, int c_end) {
    const float* BT = WSP(float, OFF_MS) + sc * NCH;
    const float* MX = WSP(float, OFF_DEC) + sc * NCH;
    const int lane = VTID & 63;
    const float bt0 = BT[lane], mx0 = MX[lane], bt1 = BT[64 + (lane & 3)], mx1 = MX[64 + (lane & 3)];
    float m = 0.f;
    for (int c = 0; c < c_end; ++c) {
        const float b = c < 64 ? __shfl(bt0, c) : __shfl(bt1, c - 64);
        const float x = c < 64 ? __shfl(mx0, c) : __shfl(mx1, c - 64);
        m = fmaxf(b + m, x);
    }
    return m;
}

template <int TN>
DEV void gemm_accum(f32x4 (&acc)[4][TN], const u16* __restrict__ A, int lda, const u16* __restrict__ B, int ldb, int K, char* smem, int tid) {
    constexpr int BROWS = TN * 32;
    constexpr int STAGE = (128 + BROWS) * 144;
    constexpr int NBCH = BROWS / 32;
    const int lane = tid & 63, wave = tid >> 6;
    const int wm = wave >> 1, wn = wave & 1, fr = lane & 15, fq = lane >> 4;
    const int lrow = tid >> 3, lc8 = tid & 7;
    const u16* ga = A + (size_t)lrow * lda + lc8 * 8;
    const u16* gb = B + (size_t)lrow * ldb + lc8 * 8;
    u32x4 ra[4], rb[NBCH];
    const int nk = K >> 6;
#pragma unroll
    for (int i = 0; i < 4; ++i) ra[i] = gld16(ga + (size_t)(32 * i) * lda);
#pragma unroll
    for (int i = 0; i < NBCH; ++i) rb[i] = gld16(gb + (size_t)(32 * i) * ldb);
    char* sw = smem + lrow * 144 + lc8 * 16;
    VM_WAIT0();
#pragma unroll
    for (int i = 0; i < 4; ++i) *(u32x4*)(sw + i * 32 * 144) = ra[i];
#pragma unroll
    for (int i = 0; i < NBCH; ++i) *(u32x4*)(sw + 128 * 144 + i * 32 * 144) = rb[i];
    __syncthreads();
    const char* sa_r = smem + (wm * 64 + fr) * 144 + fq * 16;
    const char* sb_r = smem + 128 * 144 + (wn * TN * 16 + fr) * 144 + fq * 16;
    for (int kt = 0; kt < nk; ++kt) {
        const int cur = kt & 1;
        const int k0 = (kt + 1 < nk ? kt + 1 : kt) * 64;
#pragma unroll
        for (int i = 0; i < 4; ++i) ra[i] = gld16(ga + (size_t)(32 * i) * lda + k0);
#pragma unroll
        for (int i = 0; i < NBCH; ++i) rb[i] = gld16(gb + (size_t)(32 * i) * ldb + k0);
        __builtin_amdgcn_sched_barrier(0);
#pragma unroll
        for (int ks = 0; ks < 2; ++ks) {
            bf16x8 af[4], bfr[TN];
#pragma unroll
            for (int mt = 0; mt < 4; ++mt) af[mt] = *(const bf16x8*)(sa_r + cur * STAGE + mt * 16 * 144 + ks * 64);
#pragma unroll
            for (int nt = 0; nt < TN; ++nt) bfr[nt] = *(const bf16x8*)(sb_r + cur * STAGE + nt * 16 * 144 + ks * 64);
#pragma unroll
            for (int mt = 0; mt < 4; ++mt)
#pragma unroll
                for (int nt = 0; nt < TN; ++nt) acc[mt][nt] = mfma16(af[mt], bfr[nt], acc[mt][nt]);
        }
        __builtin_amdgcn_sched_barrier(0);
        VM_WAIT0();
        {
            char* sw2 = sw + (cur ^ 1) * STAGE;
#pragma unroll
            for (int i = 0; i < 4; ++i) *(u32x4*)(sw2 + i * 32 * 144) = ra[i];
#pragma unroll
            for (int i = 0; i < NBCH; ++i) *(u32x4*)(sw2 + 128 * 144 + i * 32 * 144) = rb[i];
        }
        __syncthreads();
    }
}

template <int TN>
DEV void zero_acc(f32x4 (&acc)[4][TN]) {
#pragma unroll
    for (int i = 0; i < 4; ++i)
#pragma unroll
        for (int j = 0; j < TN; ++j) acc[i][j] = f32x4{0.f, 0.f, 0.f, 0.f};
}

DEV void tile_decode(int t, int ntn, int& mt, int& nt) {
    const int per = 8 * ntn;
    const int gi = t / per, rem = t - gi * per;
    nt = rem >> 3;
    mt = gi * 8 + (rem & 7);
}


DEV void gemm8_accum(f32x4 (&acc)[8][4], const u16* __restrict__ A, int lda, const u16* __restrict__ B, int ldb, int K, char* smem, int tid) {
    constexpr int STAGE = 65536;
    const int lane = tid & 63, wave = tid >> 6;
    const int wm = wave >> 2, wn = wave & 3, fr = lane & 15, fq = lane >> 4;
    const int lr = lane >> 3, pos = lane & 7;
    const int ce = pos ^ (lr >> 1), co = pos ^ (4 | (lr >> 1));
    const unsigned ra_ = (unsigned)((wave * 32 + lr) * lda) * 2u, rb_ = (unsigned)((wave * 32 + lr) * ldb) * 2u;
    const unsigned voa_e = ra_ + ce * 16, voa_o = ra_ + co * 16, vob_e = rb_ + ce * 16, vob_o = rb_ + co * 16;
    const int nk = K >> 6;
    const unsigned ldsw = __builtin_amdgcn_readfirstlane((unsigned)(size_t)(__attribute__((address_space(3))) char*)smem + wave * 4096);
#define G8_ISSUE(STG, K0) do { \
        _Pragma("unroll") for (int i = 0; i < 4; ++i) { \
            glds16(A + (size_t)(8 * i) * lda + (K0), (i & 1) ? voa_o : voa_e, ldsw + (STG) * STAGE + i * 1024); \
            glds16(B + (size_t)(8 * i) * ldb + (K0), (i & 1) ? vob_o : vob_e, ldsw + (STG) * STAGE + 32768 + i * 1024); \
        } } while (0)
    G8_ISSUE(0, 0);
    VM_WAIT0();
    __syncthreads();
    const int s3 = (fr >> 1) & 7;
    const int oa_base = (wm * 128 + fr) * 128 + ((fq ^ s3) * 16);
    const int ob_base = 32768 + (wn * 64 + fr) * 128 + ((fq ^ s3) * 16);
    for (int kt = 0; kt < nk; ++kt) {
        const int cur = kt & 1;
        const int k0 = (kt + 1 < nk ? kt + 1 : kt) * 64;
        G8_ISSUE(cur ^ 1, k0);
        int o_a = cur * STAGE + oa_base, o_b = cur * STAGE + ob_base;
        asm volatile("" : "+v"(o_a), "+v"(o_b));
#pragma unroll
        for (int ks = 0; ks < 2; ++ks) {
            const char* sa_c = smem + (ks ? (o_a ^ 64) : o_a);
            const char* sb_c = smem + (ks ? (o_b ^ 64) : o_b);
            bf16x8 bfr[4], af[8];
#pragma unroll
            for (int nt = 0; nt < 4; ++nt) bfr[nt] = *(const bf16x8*)(sb_c + nt * 2048);
#pragma unroll
            for (int mt = 0; mt < 8; ++mt) af[mt] = *(const bf16x8*)(sa_c + mt * 2048);
#pragma unroll
            for (int mt = 0; mt < 8; ++mt)
#pragma unroll
                for (int nt = 0; nt < 4; ++nt) acc[mt][nt] = mfma16(af[mt], bfr[nt], acc[mt][nt]);
            __builtin_amdgcn_sched_group_barrier(0x100, 7, 0);
#pragma unroll
            for (int i = 0; i < 5; ++i) { __builtin_amdgcn_sched_group_barrier(0x008, 4, 0); __builtin_amdgcn_sched_group_barrier(0x100, 1, 0); }
#pragma unroll
            for (int i = 0; i < 3; ++i) __builtin_amdgcn_sched_group_barrier(0x008, 4, 0);
        }
        VM_WAIT0();
        __syncthreads();
    }
#undef G8_ISSUE
}
DEV void zero_acc8(f32x4 (&acc)[8][4]) {
#pragma unroll
    for (int i = 0; i < 8; ++i)
#pragma unroll
        for (int j = 0; j < 4; ++j) acc[i][j] = f32x4{0.f, 0.f, 0.f, 0.f};
}
DEV void tile_decode8(int t, int ntn, int& mt, int& nt) {
    const int per = 4 * ntn;
    const int gi = t / per, rem = t - gi * per;
    nt = rem >> 2;
    mt = gi * 4 + (rem & 3);
}

DEV void ph_ffn_in8(const Params& p, int which, char* smem, int rvid, int RG, int tid) {
    const u16* H = WSP(u16, OFF_H);
    const u16* Wt = WSP(u16, OFF_W) + (which ? WE_IN1 : WE_IN0);
    u16* ACT = WSP(u16, OFF_P);
    const int lane = tid & 63, wave = tid >> 6, wm = wave >> 2, wn = wave & 3, fr = lane & 15, fq = lane >> 4;
    const int total = 128 * 22;
    for (int t = rvid; t < total; t += RG) {
        int mt_, nt_;
        tile_decode8(t, 22, mt_, nt_);
        const int m0 = mt_ * 256, n0 = nt_ * 256;
        f32x4 acc[8][4];
        zero_acc8(acc);
        gemm8_accum(acc, H + (size_t)m0 * D, D, Wt + (size_t)n0 * D, D, D, smem, tid);
#pragma unroll
        for (int mt = 0; mt < 8; ++mt)
#pragma unroll
            for (int pp = 0; pp < 2; ++pp)
#pragma unroll
                for (int r = 0; r < 4; ++r) {
                    const int row = m0 + wm * 128 + mt * 16 + fq * 4 + r;
                    const int hid = (n0 >> 1) + wn * 32 + pp * 16 + fr;
                    const float g = acc[mt][2 * pp][r], u = acc[mt][2 * pp + 1][r];
                    const float v = g * sigmoidf_(g) * u;
                    ACT[(size_t)row * DFF + hid] = (u16)(pk2(v, 0.f) & 0xffff);
                }
    }
}
DEV void ph_resid8(const Params& p, const u16* A, int lda, const u16* Wt, int K, int modidx, float coef, char* smem, int rvid, int RG, int tid, const float* xsrc) {
    const float* mods = WSP(float, OFF_MODS);
    const int lane = tid & 63, wave = tid >> 6, wm = wave >> 2, wn = wave & 3, fr = lane & 15, fq = lane >> 4;
    const int total = 128 * 4;
    for (int t = rvid; t < total; t += RG) {
        int mt_, nt_;
        tile_decode8(t, 4, mt_, nt_);
        const int m0 = mt_ * 256, n0 = nt_ * 256;
        f32x4 acc[8][4];
        zero_acc8(acc);
        gemm8_accum(acc, A + (size_t)m0 * lda, lda, Wt + (size_t)n0 * K, K, K, smem, tid);
        const float* gp = mods + (m0 >> 12) * 9216 + modidx * 1024;
#pragma unroll
        for (int nt = 0; nt < 4; ++nt) {
            const int col = n0 + wn * 64 + nt * 16 + fr;
            const float gv = gp[col] * coef;
#pragma unroll
            for (int mt = 0; mt < 8; ++mt) {
#pragma unroll
                for (int r = 0; r < 4; ++r) {
                    const int row = m0 + wm * 128 + mt * 16 + fq * 4 + r;
                    p.out[(size_t)row * D + col] = xsrc[(size_t)row * D + col] + gv * acc[mt][nt][r];
                }
                __builtin_amdgcn_sched_barrier(0);
            }
        }
    }
}
DEV void ph_pgemm8(const Params& p, char* smem, int rvid, int RG, int tid) {
    const u16* H = WSP(u16, OFF_H);
    const u16* Wt = WSP(u16, OFF_W) + WE_MIX;
    u16* P = WSP(u16, OFF_P);
    u16* T = WSP(u16, OFF_T);
    float* Gt = WSP(float, OFF_G);
    const int lane = tid & 63, wave = tid >> 6, wm = wave >> 2, wn = wave & 3, fr = lane & 15, fq = lane >> 4;
    const int total = 128 * 12;
    for (int t = rvid; t < total; t += RG) {
        int mt_, nt_;
        tile_decode8(t, 12, mt_, nt_);
        const int m0 = mt_ * 256, n0 = nt_ * 256;
        f32x4 acc[8][4];
        zero_acc8(acc);
        gemm8_accum(acc, H + (size_t)m0 * D, D, Wt + (size_t)n0 * D, D, D, smem, tid);
        const int cb = n0 + wn * 64;
        const int j = cb >> 7;
        if (j >= 22) {
            if (cb == 2816) {
#pragma unroll
                for (int mt = 0; mt < 8; ++mt)
#pragma unroll
                    for (int r = 0; r < 4; ++r) {
                        const int row = m0 + wm * 128 + mt * 16 + fq * 4 + r;
                        Gt[(size_t)row * 16 + fr] = acc[mt][0][r];
                    }
            }
            continue;
        }
        const bool rowmajor = j < 16;
        const bool transp = (j == 10) || (j == 11) || (j >= 16);
        if (rowmajor) {
#pragma unroll
            for (int mt = 0; mt < 8; ++mt)
#pragma unroll
                for (int nt = 0; nt < 4; ++nt)
#pragma unroll
                    for (int r = 0; r < 4; ++r) {
                        const int row = m0 + wm * 128 + mt * 16 + fq * 4 + r;
                        P[(size_t)row * PW + cb + nt * 16 + fr] = (u16)(pk2(acc[mt][nt][r], 0.f) & 0xffff);
                    }
        }
        if (transp) {
            const int tcb = (j >= 16) ? (cb - 1792) : (cb - 1280);
            const int b = m0 >> 12, u0 = m0 & 4095;
#pragma unroll
            for (int mt = 0; mt < 8; ++mt)
#pragma unroll
                for (int nt = 0; nt < 4; ++nt) {
                    const int tc = tcb + nt * 16 + fr;
                    const int u = u0 + wm * 128 + mt * 16 + fq * 4;
                    *(uint2*)(T + ((size_t)(b * TW + tc)) * UT + u) = uint2{pk2(acc[mt][nt][0], acc[mt][nt][1]), pk2(acc[mt][nt][2], acc[mt][nt][3])};
                }
        }
    }
}

DEV int map_col(int type, int n) {
    if (type == 0) return n;
    if (type == 1) {
        const int jb = n >> 5, r = n & 31;
        return r < 16 ? jb * 16 + r : DFF + jb * 16 + (r - 16);
    }
    if (n < 256) return 1552 + n;
    if (n < 640) return 2064 + (n - 256);
    if (n < 1024) return 2448 + (n - 640);
    if (n < 1280) return 1808 + (n - 1024);
    if (n < 1536) return (n - 1280);
    if (n < 1920) return 528 + (n - 1536);
    if (n < 2048) return 1296 + (n - 1920);
    if (n < 2304) return 256 + (n - 2048);
    if (n < 2688) return 912 + (n - 2304);
    if (n < 2816) return 1424 + (n - 2688);
    if (n < 2832) return 512 + (n - 2816);
    if (n < 2944) return -1;
    return 2832 + (n - 2944);
}

DEV void conv_tile(const float* __restrict__ src, int ld_src, int type, u16* __restrict__ dst, int ld_dst, int k_off, int kt, int ntile, char* smem, int tid) {
    float* lds = (float*)smem;
    const int k0 = kt * 64, n0 = ntile * 64;
    {
        const int r = tid >> 6, c = tid & 63;
        const int col = map_col(type, n0 + c);
#pragma unroll 4
        for (int i = 0; i < 16; ++i) {
            const int k = r + 4 * i;
            float v = 0.f;
            if (col >= 0) v = src[(size_t)(k0 + k) * ld_src + col];
            lds[k * 65 + c] = v;
        }
    }
    __syncthreads();
    {
        const int n = tid >> 2, kq = tid & 3;
        uint32_t w[8];
#pragma unroll
        for (int j = 0; j < 8; ++j) w[j] = pk2(lds[(kq * 16 + 2 * j) * 65 + n], lds[(kq * 16 + 2 * j + 1) * 65 + n]);
        u16* d = dst + (size_t)(n0 + n) * ld_dst + k_off + k0 + kq * 16;
        *(uint4*)d = uint4{w[0], w[1], w[2], w[3]};
        *(uint4*)(d + 8) = uint4{w[4], w[5], w[6], w[7]};
    }
    __syncthreads();
}

DEV void ph_prep(const Params& p, int l, char* smem, int bid, int G) {
    u16* W = WSP(u16, OFF_W);
    const int tid = VTID;
    constexpr int N_CONV = 6240, N_MODS = 288;
    for (int it = bid; it < N_CONV + N_MODS; it += G) {
        if (it < N_CONV) {
            int r = it;
            if (r < 2816) {
                const int which = r / 1408; r -= which * 1408;
                conv_tile(p.ffn_w_in + (size_t)(l * 2 + which) * 1024 * 5632, 5632, 1, W + (which ? WE_IN1 : WE_IN0), 1024, 0, r / 88, r % 88, smem, tid);
                continue;
            }
            r -= 2816;
            if (r < 1408) {
                const int which = r / 704; r -= which * 704;
                conv_tile(p.ffn_w_out + (size_t)(l * 2 + which) * 2816 * 1024, 1024, 0, W + (which ? WE_OUT1 : WE_OUT0), 2816, 0, r / 16, r % 16, smem, tid);
                continue;
            }
            r -= 1408;
            if (r < 1504) {
                conv_tile(p.mix_w_in + (size_t)l * 1024 * NIN, NIN, 2, W + WE_MIX, 1024, 0, r / 94, r % 94, smem, tid);
                continue;
            }
            r -= 1504;
            if (r < 64) { conv_tile(p.w_br_ml + (size_t)l * 256 * 1024, 1024, 0, W + WE_BR, 1024, 0, r / 16, r % 16, smem, tid); continue; }
            r -= 64;
            if (r < 96) { conv_tile(p.w_br_na + (size_t)l * 384 * 1024, 1024, 0, W + WE_BR, 1024, 256, r / 16, r % 16, smem, tid); continue; }
            r -= 96;
            if (r < 96) { conv_tile(p.w_br_gq + (size_t)l * 384 * 1024, 1024, 0, W + WE_BR, 1024, 640, r / 16, r % 16, smem, tid); continue; }
            r -= 96;
            conv_tile(p.w_out + (size_t)l * 1024 * 1024, 1024, 0, W + WE_O, 1024, 0, r / 16, r % 16, smem, tid);
        } else {
            const int cb = it - N_CONV;
            float* s = (float*)smem;
            float* red = s + 9 * 1024;
            for (int i = tid; i < 9 * 1024; i += 256) {
                const int b = i >> 10, k = i & 1023;
                const float v = b < 8 ? p.c[b * 1024 + k] : p.c_ctx[k];
                s[i] = v * sigmoidf_(v);
            }
            __syncthreads();
            const int kg = tid >> 5, c = tid & 31, col = cb * 32 + c;
            float a[9];
#pragma unroll
            for (int b = 0; b < 9; ++b) a[b] = 0.f;
            const float* wp = p.ada_w + (size_t)l * 1024 * 9216 + (size_t)(kg * 128) * 9216 + col;
#pragma unroll 8
            for (int k = 0; k < 128; ++k) {
                const float w = wp[(size_t)k * 9216];
#pragma unroll
                for (int b = 0; b < 9; ++b) a[b] += s[b * 1024 + kg * 128 + k] * w;
            }
#pragma unroll
            for (int b = 0; b < 9; ++b) red[(kg * 9 + b) * 32 + c] = a[b];
            __syncthreads();
            for (int i = tid; i < 288; i += 256) {
                const int b = i >> 5, cc = i & 31;
                float v = p.ada_b[l * 9216 + cb * 32 + cc];
#pragma unroll
                for (int g = 0; g < 8; ++g) v += red[(g * 9 + b) * 32 + cc];
                WSP(float, OFF_MODS)[b * 9216 + cb * 32 + cc] = v;
            }
            __syncthreads();
        }
    }
    if (l == 0) {
        const size_t gt = (size_t)bid * 256 + tid, gs = (size_t)G * 256;
        const float4* cs = (const float4*)p.ctx; float4* cd = WSP(float4, OFF_XC);
        for (size_t i = gt; i < (size_t)NCX * D / 4; i += gs) cd[i] = cs[i];
        float* rope = WSP(float, OFF_ROPE);
        for (size_t i = gt; i < (size_t)4096 * 32; i += gs) {
            const int t = (int)(i >> 5), f = (int)(i & 31);
            const float pos = (float)((f < 16) ? (t >> 6) : (t & 63));
            const float inv = powf(10000.f, -(float)(f & 15) / 16.f);
            float sn, cs_;
            sincosf(pos * inv, &sn, &cs_);
            rope[i * 2] = cs_;
            rope[i * 2 + 1] = sn;
        }
    }
}

DEV void ph_mod(const Params& p, int l, int sub, int nrows, int bid, int G) {
    const bool first = (l == 0 && sub == 0);
    const int lane = VTID & 63, gw = bid * 4 + (VTID >> 6), NW = G * 4;
    const float* nw = p.norm_w + (size_t)(l * 3 + sub) * 1024;
    const float* mods = WSP(float, OFF_MODS);
    u16* H = WSP(u16, OFF_H);
    for (int r = gw; r < nrows; r += NW) {
        const float* xr = r < NL ? (first ? p.x : p.out) + (size_t)r * D : (first ? p.ctx : WSP(float, OFF_XC)) + (size_t)(r - NL) * D;
        const int b9 = r < NL ? (r >> 12) : 8;
        const float* sh = mods + b9 * 9216 + (3 * sub) * 1024;
        const float* sc = sh + 1024;
        float4 v[4];
        float ss = 0.f;
#pragma unroll
        for (int j = 0; j < 4; ++j) {
            v[j] = *(const float4*)(xr + lane * 4 + 256 * j);
            ss += v[j].x * v[j].x + v[j].y * v[j].y + v[j].z * v[j].z + v[j].w * v[j].w;
        }
        ss = wave_sum(ss);
        const float rstd = rsqrtf(ss * (1.f / 1024.f) + 1e-6f);
#pragma unroll
        for (int j = 0; j < 4; ++j) {
            const int k = lane * 4 + 256 * j;
            const float4 w = *(const float4*)(nw + k), s1 = *(const float4*)(sc + k), s0 = *(const float4*)(sh + k);
            const float y0 = v[j].x * rstd * w.x * (1.f + s1.x) + s0.x;
            const float y1 = v[j].y * rstd * w.y * (1.f + s1.y) + s0.y;
            const float y2 = v[j].z * rstd * w.z * (1.f + s1.z) + s0.z;
            const float y3 = v[j].w * rstd * w.w * (1.f + s1.w) + s0.w;
            *(uint2*)(H + (size_t)r * D + k) = uint2{pk2(y0, y1), pk2(y2, y3)};
        }
    }
}

DEV void ph_ffn_in(const Params& p, int which, int mt0, int mtiles, char* smem, int vid, int G) {
    const u16* H = WSP(u16, OFF_H);
    const u16* Wt = WSP(u16, OFF_W) + (which ? WE_IN1 : WE_IN0);
    u16* ACT = WSP(u16, OFF_P);
    const int lane = VTID & 63, wave = VTID >> 6, wm = wave >> 1, wn = wave & 1, fr = lane & 15, fq = lane >> 4;
    const int total = mtiles * 44;
    for (int t = vid; t < total; t += G) {
        int mt_, nt_;
        tile_decode(t, 44, mt_, nt_);
        mt_ += mt0;
        const int m0 = mt_ * 128, n0 = nt_ * 128;
        f32x4 acc[4][4];
        zero_acc<4>(acc);
        gemm_accum<4>(acc, H + (size_t)m0 * D, D, Wt + (size_t)n0 * D, D, D, smem, VTID);
#pragma unroll
        for (int mt = 0; mt < 4; ++mt)
#pragma unroll
            for (int pp = 0; pp < 2; ++pp)
#pragma unroll
                for (int r = 0; r < 4; ++r) {
                    const int row = m0 + wm * 64 + mt * 16 + fq * 4 + r;
                    const int hid = (n0 >> 1) + wn * 32 + pp * 16 + fr;
                    const float g = acc[mt][2 * pp][r], u = acc[mt][2 * pp + 1][r];
                    const float v = g * sigmoidf_(g) * u;
                    ACT[(size_t)row * DFF + hid] = (u16)(pk2(v, 0.f) & 0xffff);
                }
    }
}

DEV void ph_resid(const Params& p, const u16* A, int lda, const u16* Wt, int K, int modidx, float coef, int mt0, int mtiles, char* smem, int vid, int G) {
    const float* mods = WSP(float, OFF_MODS);
    const int lane = VTID & 63, wave = VTID >> 6, wm = wave >> 1, wn = wave & 1, fr = lane & 15, fq = lane >> 4;
    const int total = mtiles * 8 * 4;
    const int Kc = K >> 2;
    for (int t = vid; t < total; t += G) {
        int mt_, nt_;
        const int ksp = t & 3;
        tile_decode(t >> 2, 8, mt_, nt_);
        mt_ += mt0;
        const int m0 = mt_ * 128, n0 = nt_ * 128;
        f32x4 acc[4][4];
        zero_acc<4>(acc);
        gemm_accum<4>(acc, A + (size_t)m0 * lda + ksp * Kc, lda, Wt + (size_t)n0 * K + ksp * Kc, K, Kc, smem, VTID);
        const int b9 = m0 < NL ? (m0 >> 12) : 8;
        const float* gp = mods + b9 * 9216 + modidx * 1024;
#pragma unroll
        for (int nt = 0; nt < 4; ++nt) {
            const int col = n0 + wn * 64 + nt * 16 + fr;
            const float gv = gp[col] * coef;
#pragma unroll
            for (int mt = 0; mt < 4; ++mt)
#pragma unroll
                for (int r = 0; r < 4; ++r) {
                    const int row = m0 + wm * 64 + mt * 16 + fq * 4 + r;
                    float* xp = (row < NL ? p.out + (size_t)row * D : WSP(float, OFF_XC) + (size_t)(row - NL) * D) + col;
                    __hip_atomic_fetch_add(xp, gv * acc[mt][nt][r], __ATOMIC_RELAXED, __HIP_MEMORY_SCOPE_AGENT);
                }
        }
    }
}

DEV void ph_pgemm(const Params& p, int mt0, int mtiles, char* smem, int vid, int G) {
    const u16* H = WSP(u16, OFF_H);
    const u16* Wt = WSP(u16, OFF_W) + WE_MIX;
    u16* P = WSP(u16, OFF_P);
    u16* T = WSP(u16, OFF_T);
    float* Gt = WSP(float, OFF_G);
    const int lane = VTID & 63, wave = VTID >> 6, wm = wave >> 1, wn = wave & 1, fr = lane & 15, fq = lane >> 4;
    const int total = mtiles * 23;
    for (int t = vid; t < total; t += G) {
        int mt_, nt_;
        tile_decode(t, 23, mt_, nt_);
        mt_ += mt0;
        const int m0 = mt_ * 128, n0 = nt_ * 128;
        f32x4 acc[4][4];
        zero_acc<4>(acc);
        gemm_accum<4>(acc, H + (size_t)m0 * D, D, Wt + (size_t)n0 * D, D, D, smem, VTID);
        if (nt_ == 22) {
            if (wn == 0) {
#pragma unroll
                for (int mt = 0; mt < 4; ++mt)
#pragma unroll
                    for (int r = 0; r < 4; ++r) {
                        const int row = m0 + wm * 64 + mt * 16 + fq * 4 + r;
                        Gt[(size_t)row * 16 + fr] = acc[mt][0][r];
                    }
            }
            continue;
        }
        const bool rowmajor = nt_ < 16;
        const bool transp = (nt_ == 10) || (nt_ == 11) || (nt_ >= 16);
        if (rowmajor) {
#pragma unroll
            for (int mt = 0; mt < 4; ++mt)
#pragma unroll
                for (int nt = 0; nt < 4; ++nt)
#pragma unroll
                    for (int r = 0; r < 4; ++r) {
                        const int row = m0 + wm * 64 + mt * 16 + fq * 4 + r;
                        const int col = n0 + wn * 64 + nt * 16 + fr;
                        P[(size_t)row * PW + col] = (u16)(pk2(acc[mt][nt][r], 0.f) & 0xffff);
                    }
        }
        if (transp) {
            const int tcb = (nt_ >= 16) ? (n0 - 1792) : (n0 - 1280);
            int b, u0;
            if (m0 < NL) { b = m0 >> 12; u0 = m0 & 4095; } else { b = (m0 - NL) >> 8; u0 = SEQ + ((m0 - NL) & 255); }
#pragma unroll
            for (int mt = 0; mt < 4; ++mt)
#pragma unroll
                for (int nt = 0; nt < 4; ++nt) {
                    const int tc = tcb + wn * 64 + nt * 16 + fr;
                    const int u = u0 + wm * 64 + mt * 16 + fq * 4;
                    *(uint2*)(T + ((size_t)(b * TW + tc)) * UT + u) = uint2{pk2(acc[mt][nt][0], acc[mt][nt][1]), pk2(acc[mt][nt][2], acc[mt][nt][3])};
                }
        }
    }
}

DEV void ph_qknorm_gates(const Params& p, int l, int bid, int G) {
    const int lane = VTID & 63, gw = bid * 4 + (VTID >> 6), NW = G * 4;
    u16* P = WSP(u16, OFF_P);
    for (int it = gw; it < NSCAN * NCH; it += NW) {
        const int sc = it / NCH, c = it - sc * NCH, dir = sc & 1, h = (sc >> 1) & 3, b = sc >> 3;
        const float* Gt = WSP(float, OFF_G);
        float* BC = WSP(float, OFF_BC) + (size_t)sc * UT;
        float* IG = WSP(float, OFF_IG) + (size_t)sc * UT;
        float* WE = WSP(float, OFF_AE) + (size_t)sc * UT;
        const float bi = p.ml_gate_b[l * 16 + dir * 8 + h], bf = p.ml_gate_b[l * 16 + dir * 8 + 4 + h];
        const int cu = cu_of(c, dir);
        const int u = cu * 64 + (dir ? 63 - lane : lane);
        const int row = rowof(b, u);
        const float ig = Gt[(size_t)row * 16 + dir * 8 + h] + bi;
        const float fp = Gt[(size_t)row * 16 + dir * 8 + 4 + h] + bf;
        const float lf = fminf(fp, 0.f) - log1pf(expf(-fabsf(fp)));
        float bc = lf;
#pragma unroll
        for (int o = 1; o < 64; o <<= 1) { const float tv = __shfl_up(bc, o); if (lane >= o) bc += tv; }
        const float btot = __shfl(bc, 63);
        const float wend = btot - bc + ig;
        const float mx = wave_max(wend);
        WE[u] = wend;
        BC[u] = bc;
        IG[u] = ig;
        if (lane == 0) { WSP(float, OFF_MS)[sc * NCH + c] = btot; WSP(float, OFF_DEC)[sc * NCH + c] = mx; }
    }
    const float* rope = WSP(float, OFF_ROPE);
    const int hs = lane >> 4, e4 = (lane & 15) * 4;
    for (int r = gw; r < MTOT; r += NW) {
        const bool latent = r < NL;
        const int tok = r & 4095;
#pragma unroll
        for (int g = 0; g < 5; ++g) {
            const int cbase = (g < 3 ? 256 + g * 256 : 1536 + (g - 3) * 256) + hs * 64 + e4;
            const int slot = g * 4 + hs;
            u16* pp = P + (size_t)r * PW + cbase;
            const uint2 raw = *(const uint2*)pp;
            float v0 = bflo(raw.x), v1 = bfhi(raw.x), v2 = bflo(raw.y), v3 = bfhi(raw.y);
            float ss = v0 * v0 + v1 * v1 + v2 * v2 + v3 * v3;
            ss += __shfl_xor(ss, 1); ss += __shfl_xor(ss, 2); ss += __shfl_xor(ss, 4); ss += __shfl_xor(ss, 8);
            const float* wv;
            float scl;
            bool do_rope;
            if (slot < 6) { wv = p.na_qk_w + (l * 2 + 0) * 64; scl = 0.125f; do_rope = false; }
            else if (slot < 12) { wv = p.gq_qk_w + (l * 2 + 0) * 64; scl = 0.125f; do_rope = latent; }
            else if (slot < 18) { wv = p.na_qk_w + (l * 2 + 1) * 64; scl = 1.f; do_rope = false; }
            else { wv = p.gq_qk_w + (l * 2 + 1) * 64; scl = 1.f; do_rope = latent; }
            const float rstd = rsqrtf(ss * (1.f / 64.f) + 1e-6f) * scl;
            const float4 w4 = *(const float4*)(wv + e4);
            v0 *= rstd * w4.x; v1 *= rstd * w4.y; v2 *= rstd * w4.z; v3 *= rstd * w4.w;
            const float o0 = __shfl_xor(v0, 8), o1 = __shfl_xor(v1, 8), o2 = __shfl_xor(v2, 8), o3 = __shfl_xor(v3, 8);
            if (do_rope) {
                const int fi = e4 & 31;
                const float4 cs01 = *(const float4*)(rope + ((size_t)tok * 32 + fi) * 2);
                const float4 cs23 = *(const float4*)(rope + ((size_t)tok * 32 + fi + 2) * 2);
                if (e4 < 32) {
                    v0 = v0 * cs01.x - o0 * cs01.y; v1 = v1 * cs01.z - o1 * cs01.w;
                    v2 = v2 * cs23.x - o2 * cs23.y; v3 = v3 * cs23.z - o3 * cs23.w;
                } else {
                    v0 = o0 * cs01.y + v0 * cs01.x; v1 = o1 * cs01.w + v1 * cs01.z;
                    v2 = o2 * cs23.y + v2 * cs23.x; v3 = o3 * cs23.w + v3 * cs23.z;
                }
            }
            *(uint2*)pp = uint2{pk2(v0, v1), pk2(v2, v3)};
        }
    }
}

template <int MT, bool NAMASK, int NWV>
DEV void flash_item(const Params& p, int b, int qrow0, int qcol, int kcol, int tcol, int ua, int n1, int ub, int ntiles,
                    int r_q, int rs, const float* __restrict__ rpb_h, char* smem, int ocol) {
    u16* P = WSP(u16, OFF_P);
    const u16* T = WSP(u16, OFF_T);
    const int tid = (NWV == 8) ? (int)(threadIdx.x + p.z) : VTID, lane = tid & 63, wave = tid >> 6, fr = lane & 15, fq = lane >> 4;
    constexpr int KVS = 64 * 144;
    char* Ks = smem;
    char* Vs = smem + 2 * KVS;
    float* rpb_s = (float*)(smem + 4 * KVS);
    __syncthreads();
    if (NAMASK) {
        for (int i = tid; i < 465; i += 256) rpb_s[i] = rpb_h[i] * 1.4426950408889634f;
    }
    Frag qf[MT][2];
#pragma unroll
    for (int mt = 0; mt < MT; ++mt)
#pragma unroll
        for (int ks = 0; ks < 2; ++ks)
            qf[mt][ks].q = *(const uint4*)(P + (size_t)(qrow0 + (wave * MT + mt) * 16 + fr) * PW + qcol + ks * 32 + fq * 8);
    const int lr = tid >> 3, lc8 = tid & 7;
    u32x4 rk0, rk1 = {0, 0, 0, 0}, rv0, rv1 = {0, 0, 0, 0};
#define FL_GLOAD(KT) do { const int kt_ = (KT); const int u0_ = kt_ < n1 ? ua + 64 * kt_ : ub + 64 * (kt_ - n1); const int row0_ = rowof(b, u0_); \
        rk0 = gld16(P + (size_t)(row0_ + lr) * PW + kcol + lc8 * 8); rv0 = gld16(T + ((size_t)(b * TW + tcol + lr)) * UT + u0_ + lc8 * 8); \
        if (NWV == 4) { rk1 = gld16(P + (size_t)(row0_ + lr + 32) * PW + kcol + lc8 * 8); rv1 = gld16(T + ((size_t)(b * TW + tcol + lr + 32)) * UT + u0_ + lc8 * 8); } } while (0)
#define FL_SSTORE(S) do { const int s_ = (S); \
        *(u32x4*)(Ks + s_ * KVS + lr * 144 + lc8 * 16) = rk0; *(u32x4*)(Vs + s_ * KVS + lr * 144 + lc8 * 16) = rv0; \
        if (NWV == 4) { *(u32x4*)(Ks + s_ * KVS + (lr + 32) * 144 + lc8 * 16) = rk1; *(u32x4*)(Vs + s_ * KVS + (lr + 32) * 144 + lc8 * 16) = rv1; } } while (0)
    FL_GLOAD(0);
    VM_WAIT0();
    FL_SSTORE(0);
    __syncthreads();
    f32x4 o[MT][4];
    float mrow[MT], lrow[MT];
#pragma unroll
    for (int mt = 0; mt < MT; ++mt) {
        mrow[mt] = -1e30f; lrow[mt] = 0.f;
#pragma unroll
        for (int dt = 0; dt < 4; ++dt) o[mt][dt] = f32x4{0.f, 0.f, 0.f, 0.f};
    }
    const float L2E = 1.4426950408889634f;
    for (int kt = 0; kt < ntiles; ++kt) {
        const int cur = kt & 1;
        const bool more = kt + 1 < ntiles;
        FL_GLOAD(more ? kt + 1 : kt);
        __builtin_amdgcn_sched_barrier(0);
        f32x4 s[MT][4];
#pragma unroll
        for (int mt = 0; mt < MT; ++mt)
#pragma unroll
            for (int nt = 0; nt < 4; ++nt) s[mt][nt] = f32x4{0.f, 0.f, 0.f, 0.f};
#pragma unroll
        for (int ks = 0; ks < 2; ++ks)
#pragma unroll
            for (int nt = 0; nt < 4; ++nt) {
                const bf16x8 kf = *(const bf16x8*)(Ks + cur * KVS + (nt * 16 + fr) * 144 + (ks * 32 + fq * 8) * 2);
#pragma unroll
                for (int mt = 0; mt < MT; ++mt) s[mt][nt] = mfma16(kf, qf[mt][ks].v, s[mt][nt]);
            }
        Frag pf[MT][2];
#pragma unroll
        for (int mt = 0; mt < MT; ++mt) {
            if (NAMASK && kt < 8) {
                const int qc = (wave * MT + mt) * 16 + fr;
                int cs = qc - 8; cs = cs < 0 ? 0 : (cs > 48 ? 48 : cs);
                const int brow = rs + kt - r_q + 7;
#pragma unroll
                for (int nt = 0; nt < 4; ++nt)
#pragma unroll
                    for (int r = 0; r < 4; ++r) {
                        const int kc = nt * 16 + fq * 4 + r;
                        const bool valid = (kc >= cs) && (kc < cs + 16);
                        const int bi = valid ? brow * 31 + (kc - qc + 15) : 0;
                        s[mt][nt][r] = valid ? s[mt][nt][r] * L2E + rpb_s[bi] : -1e30f;
                    }
            } else {
#pragma unroll
                for (int nt = 0; nt < 4; ++nt)
#pragma unroll
                    for (int r = 0; r < 4; ++r) s[mt][nt][r] *= L2E;
            }
            float mx = -1e30f;
#pragma unroll
            for (int nt = 0; nt < 4; ++nt)
#pragma unroll
                for (int r = 0; r < 4; ++r) mx = fmaxf(mx, s[mt][nt][r]);
            mx = xq_max(mx);
            const float mnew = fmaxf(mrow[mt], mx);
            const float alpha = fexp2(mrow[mt] - mnew);
            float rsum = 0.f;
#pragma unroll
            for (int nt = 0; nt < 4; ++nt)
#pragma unroll
                for (int r = 0; r < 4; ++r) { const float e = fexp2(s[mt][nt][r] - mnew); s[mt][nt][r] = e; rsum += e; }
            rsum = xq_sum(rsum);
            lrow[mt] = lrow[mt] * alpha + rsum;
            mrow[mt] = mnew;
#pragma unroll
            for (int dt = 0; dt < 4; ++dt) o[mt][dt] *= alpha;
#pragma unroll
            for (int ks = 0; ks < 2; ++ks) {
                pf[mt][ks].u[0] = pk2(s[mt][2 * ks][0], s[mt][2 * ks][1]);
                pf[mt][ks].u[1] = pk2(s[mt][2 * ks][2], s[mt][2 * ks][3]);
                pf[mt][ks].u[2] = pk2(s[mt][2 * ks + 1][0], s[mt][2 * ks + 1][1]);
                pf[mt][ks].u[3] = pk2(s[mt][2 * ks + 1][2], s[mt][2 * ks + 1][3]);
            }
        }
#pragma unroll
        for (int ks = 0; ks < 2; ++ks)
#pragma unroll
            for (int dt = 0; dt < 4; ++dt) {
                Frag vf;
                vf.d[0] = *(const uint2*)(Vs + cur * KVS + (dt * 16 + fr) * 144 + (ks * 32 + fq * 4) * 2);
                vf.d[1] = *(const uint2*)(Vs + cur * KVS + (dt * 16 + fr) * 144 + (ks * 32 + 16 + fq * 4) * 2);
#pragma unroll
                for (int mt = 0; mt < MT; ++mt) o[mt][dt] = mfma16(vf.v, pf[mt][ks].v, o[mt][dt]);
            }
        __builtin_amdgcn_sched_barrier(0);
        VM_WAIT0();
        FL_SSTORE(cur ^ 1);
        __syncthreads();
    }
#pragma unroll
    for (int mt = 0; mt < MT; ++mt) {
        const float inv = 1.f / lrow[mt];
        u16* op = P + (size_t)(qrow0 + (wave * MT + mt) * 16 + fr) * PW + ocol;
#pragma unroll
        for (int dt = 0; dt < 4; ++dt)
            *(uint2*)(op + dt * 16 + fq * 4) = uint2{pk2(o[mt][dt][0] * inv, o[mt][dt][1] * inv), pk2(o[mt][dt][2] * inv, o[mt][dt][3] * inv)};
    }
}


DEV void m2_item(const Params& p, int sc, int c) {
    const u16* T = WSP(u16, OFF_T);
    const int lane = VTID & 63, wave = VTID >> 6, fr = lane & 15, fq = lane >> 4;
    const int dir = sc & 1, h = (sc >> 1) & 3, b = sc >> 3;
    const int u0 = cu_of(c, dir) * 64;
    const float* AE = WSP(float, OFF_AE) + (size_t)sc * UT + u0;
    float* S = WSP(float, OFF_S) + ((size_t)sc * NCH + c) * SCH;
    const float mnew = fmaxf(WSP(float, OFF_MS)[sc * NCH + c] + m_scan(p, sc, c), WSP(float, OFF_DEC)[sc * NCH + c]);
    f32x4 acc[4], accn[4];
#pragma unroll
    for (int nt = 0; nt < 4; ++nt) { acc[nt] = f32x4{0.f, 0.f, 0.f, 0.f}; accn[nt] = f32x4{0.f, 0.f, 0.f, 0.f}; }
    Frag ones;
    ones.u[0] = ones.u[1] = ones.u[2] = ones.u[3] = 0x3F803F80u;
#pragma unroll
    for (int ks = 0; ks < 2; ++ks) {
        Frag vf;
        vf.q = *(const uint4*)(T + ((size_t)(b * TW + TC_MLV + h * 64 + wave * 16 + fr)) * UT + u0 + ks * 32 + fq * 8);
        float4 a0 = *(const float4*)(AE + ks * 32 + fq * 8), a1 = *(const float4*)(AE + ks * 32 + fq * 8 + 4);
        a0.x = expf(a0.x - mnew); a0.y = expf(a0.y - mnew); a0.z = expf(a0.z - mnew); a0.w = expf(a0.w - mnew);
        a1.x = expf(a1.x - mnew); a1.y = expf(a1.y - mnew); a1.z = expf(a1.z - mnew); a1.w = expf(a1.w - mnew);
#pragma unroll
        for (int nt = 0; nt < 4; ++nt) {
            Frag kf, kb;
            kf.q = *(const uint4*)(T + ((size_t)(b * TW + TC_MLK + h * 64 + nt * 16 + fr)) * UT + u0 + ks * 32 + fq * 8);
            kb.u[0] = pk2(bflo(kf.u[0]) * a0.x * 0.125f, bfhi(kf.u[0]) * a0.y * 0.125f);
            kb.u[1] = pk2(bflo(kf.u[1]) * a0.z * 0.125f, bfhi(kf.u[1]) * a0.w * 0.125f);
            kb.u[2] = pk2(bflo(kf.u[2]) * a1.x * 0.125f, bfhi(kf.u[2]) * a1.y * 0.125f);
            kb.u[3] = pk2(bflo(kf.u[3]) * a1.z * 0.125f, bfhi(kf.u[3]) * a1.w * 0.125f);
            acc[nt] = mfma16(vf.v, kb.v, acc[nt]);
            if (wave == 0) accn[nt] = mfma16(ones.v, kb.v, accn[nt]);
        }
    }
#pragma unroll
    for (int nt = 0; nt < 4; ++nt) {
#pragma unroll
        for (int r = 0; r < 4; ++r) S[(wave * 16 + fq * 4 + r) * 64 + nt * 16 + fr] = acc[nt][r];
        if (wave == 0 && fq == 0) S[4096 + nt * 16 + fr] = accn[nt][0];
    }
}

DEV void ph_m3(const Params& p, int bid, int G) {
    const float* DEC = WSP(float, OFF_DEC);
    float* S = WSP(float, OFF_S);
    const int total = NSCAN * SCH;
    for (int i = bid * 256 + VTID; i < total; i += G * 256) {
        const int sc = i / SCH, e = i - sc * SCH;
        float* base = S + (size_t)sc * NCH * SCH + e;
        const float* mxp = DEC + sc * NCH;
        const float* btp = WSP(float, OFF_MS) + sc * NCH;
        float st = 0.f, m = 0.f;
#pragma unroll 4
        for (int c = 0; c < NCH; ++c) {
            const float tmp = base[(size_t)c * SCH];
            base[(size_t)c * SCH] = st;
            const float bm = btp[c] + m;
            const float mnew = fmaxf(bm, mxp[c]);
            st = expf(bm - mnew) * st + tmp;
            m = mnew;
        }
    }
}

DEV void m4_item(const Params& p, int l, int b, int h, int cu, int ocolbase) {
    u16* P = WSP(u16, OFF_P);
    const u16* T = WSP(u16, OFF_T);
    const int lane = VTID & 63, wave = VTID >> 6, fr = lane & 15, fq = lane >> 4;
    const int u0 = cu * 64;
    const int row0 = rowof(b, u0);
    const int j = wave * 16 + fr;
    Frag qf[2];
#pragma unroll
    for (int ks = 0; ks < 2; ++ks) qf[ks].q = *(const uint4*)(P + (size_t)(row0 + j) * PW + PC_MLQ + h * 64 + ks * 32 + fq * 8);
    f32x4 hsum[4];
#pragma unroll
    for (int dt = 0; dt < 4; ++dt) hsum[dt] = f32x4{0.f, 0.f, 0.f, 0.f};
#pragma unroll 1
    for (int dir = 0; dir < 2; ++dir) {
        const int sc = (b * 4 + h) * 2 + dir;
        int c;
        if (cu >= 64) c = dir ? 3 - (cu - 64) : (cu - 64); else c = 4 + (dir ? 63 - cu : cu);
        const float m0 = m_scan(p, sc, c);
        const float* BC = WSP(float, OFF_BC) + (size_t)sc * UT + u0;
        const float* IG = WSP(float, OFF_IG) + (size_t)sc * UT + u0;
        const float* S = WSP(float, OFF_S) + ((size_t)sc * NCH + c) * SCH;
        const float bj = BC[j];
        f32x4 s[4];
#pragma unroll
        for (int nt = 0; nt < 4; ++nt) s[nt] = f32x4{0.f, 0.f, 0.f, 0.f};
#pragma unroll
        for (int ks = 0; ks < 2; ++ks)
#pragma unroll
            for (int nt = 0; nt < 4; ++nt) {
                Frag kf;
                kf.q = *(const uint4*)(P + (size_t)(row0 + nt * 16 + fr) * PW + PC_MLK + h * 64 + ks * 32 + fq * 8);
                s[nt] = mfma16(kf.v, qf[ks].v, s[nt]);
            }
        float lw[4][4];
        float mx = -1e30f;
#pragma unroll
        for (int nt = 0; nt < 4; ++nt) {
            const float4 bs = *(const float4*)(BC + nt * 16 + fq * 4);
            const float4 is = *(const float4*)(IG + nt * 16 + fq * 4);
            const float bsv[4] = {bs.x, bs.y, bs.z, bs.w}, isv[4] = {is.x, is.y, is.z, is.w};
#pragma unroll
            for (int r = 0; r < 4; ++r) {
                const int sidx = nt * 16 + fq * 4 + r;
                const bool valid = dir ? (sidx >= j) : (sidx <= j);
                lw[nt][r] = valid ? (bj - bsv[r] + isv[r]) : -1e30f;
                mx = fmaxf(mx, lw[nt][r]);
            }
        }
        mx = xq_max(mx);
        const float minter = bj + m0;
        const float mj = fmaxf(minter, mx);
        const float g = fexp(minter - mj);
        float den = 0.f;
#pragma unroll
        for (int nt = 0; nt < 4; ++nt)
#pragma unroll
            for (int r = 0; r < 4; ++r) {
                const float w = fexp(lw[nt][r] - mj);
                const float qk = s[nt][r] * 0.125f * w;
                s[nt][r] = qk;
                den += qk;
            }
        den = xq_sum(den);
        Frag pf[2];
#pragma unroll
        for (int ks = 0; ks < 2; ++ks) {
            pf[ks].u[0] = pk2(s[2 * ks][0], s[2 * ks][1]);
            pf[ks].u[1] = pk2(s[2 * ks][2], s[2 * ks][3]);
            pf[ks].u[2] = pk2(s[2 * ks + 1][0], s[2 * ks + 1][1]);
            pf[ks].u[3] = pk2(s[2 * ks + 1][2], s[2 * ks + 1][3]);
        }
        f32x4 acc[4], accn = f32x4{0.f, 0.f, 0.f, 0.f};
#pragma unroll
        for (int dt = 0; dt < 4; ++dt) acc[dt] = f32x4{0.f, 0.f, 0.f, 0.f};
#pragma unroll
        for (int ks = 0; ks < 2; ++ks) {
            {
                const float4 n0 = *(const float4*)(S + 4096 + ks * 32 + fq * 8), n1 = *(const float4*)(S + 4096 + ks * 32 + fq * 8 + 4);
                Frag nf;
                nf.u[0] = pk2(n0.x, n0.y); nf.u[1] = pk2(n0.z, n0.w); nf.u[2] = pk2(n1.x, n1.y); nf.u[3] = pk2(n1.z, n1.w);
                accn = mfma16(nf.v, qf[ks].v, accn);
            }
#pragma unroll
            for (int dt = 0; dt < 4; ++dt) {
                const float* cp = S + (dt * 16 + fr) * 64 + ks * 32 + fq * 8;
                const float4 c0 = *(const float4*)cp, c1 = *(const float4*)(cp + 4);
                Frag cf;
                cf.u[0] = pk2(c0.x, c0.y); cf.u[1] = pk2(c0.z, c0.w); cf.u[2] = pk2(c1.x, c1.y); cf.u[3] = pk2(c1.z, c1.w);
                acc[dt] = mfma16(cf.v, qf[ks].v, acc[dt]);
            }
        }
#pragma unroll
        for (int dt = 0; dt < 4; ++dt) acc[dt] *= g;
        den += g * accn[0];
#pragma unroll
        for (int ks = 0; ks < 2; ++ks)
#pragma unroll
            for (int dt = 0; dt < 4; ++dt) {
                const u16* vp = T + ((size_t)(b * TW + TC_MLV + h * 64 + dt * 16 + fr)) * UT + u0 + ks * 32 + fq * 4;
                Frag vf;
                vf.d[0] = *(const uint2*)vp;
                vf.d[1] = *(const uint2*)(vp + 16);
                acc[dt] = mfma16(vf.v, pf[ks].v, acc[dt]);
            }
        const float dd = 1.f / fmaxf(fabsf(den), fexp(-mj));
#pragma unroll
        for (int dt = 0; dt < 4; ++dt) hsum[dt] += acc[dt] * dd;
    }
    float ss = 0.f;
#pragma unroll
    for (int dt = 0; dt < 4; ++dt)
#pragma unroll
        for (int r = 0; r < 4; ++r) ss += hsum[dt][r] * hsum[dt][r];
    ss = xq_sum(ss);
    const float rstd = rsqrtf(ss * (1.f / 64.f) + 1e-6f);
    const float* nw = p.ml_norm_w + l * 256 + h * 64;
    u16* orow = P + (size_t)(row0 + j) * PW;
#pragma unroll
    for (int dt = 0; dt < 4; ++dt) {
        const int v0 = dt * 16 + fq * 4;
        const float4 w4 = *(const float4*)(nw + v0);
        const uint2 og = *(const uint2*)(orow + PC_MLO + h * 64 + v0);
        const float y0 = hsum[dt][0] * rstd * w4.x * sigmoidf_(bflo(og.x));
        const float y1 = hsum[dt][1] * rstd * w4.y * sigmoidf_(bfhi(og.x));
        const float y2 = hsum[dt][2] * rstd * w4.z * sigmoidf_(bflo(og.y));
        const float y3 = hsum[dt][3] * rstd * w4.w * sigmoidf_(bfhi(og.y));
        *(uint2*)(orow + ocolbase + h * 64 + v0) = uint2{pk2(y0, y1), pk2(y2, y3)};
    }
}

DEV void ph_attn8(const Params& p, int l, char* smem0, int rbid, int RG) {
    const int n_gq = 768, n_c = (l == 0) ? 96 : 0;
    for (int it = rbid; it < n_gq + n_c; it += RG) {
        int b, qrow0, qcol, kcol, tcol, ua, nt;
        if (it < n_gq) {
            const int qt = it & 15, hq = (it >> 4) % 6;
            b = it / 96; qrow0 = b * SEQ + qt * 256; qcol = PC_GQQ + hq * 64; kcol = PC_GQK + (hq / 3) * 64; tcol = TC_GQV + (hq / 3) * 64; ua = 0; nt = 68;
        } else {
            const int r = it - n_gq;
            const int kind = r / 48, rr = r % 48, hh = rr % 6;
            b = rr / 6; qrow0 = NL + b * CTXL; ua = SEQ; nt = 4;
            if (kind == 0) { qcol = PC_GQQ + hh * 64; kcol = PC_GQK + (hh / 3) * 64; tcol = TC_GQV + (hh / 3) * 64; }
            else { qcol = PC_NAQ + hh * 64; kcol = PC_NAK + hh * 64; tcol = TC_NAV + hh * 64; }
        }
        flash_item<2, false, 8>(p, b, qrow0, qcol, kcol, tcol, ua, nt, 0, nt, 0, 0, nullptr, smem0, qcol);
    }
}
DEV void ph_attn(const Params& p, int l, char* smem, int bid, int G, int rep) {
    const int n_na = 3072, n_m2 = NSCAN * NCH;
    const int total = n_na + n_m2;
    for (int it = bid; it < total; it += G) {
        int r = it;
        if (r < n_na) {
            const int gr = r & 63, hn = (r >> 6) % 6, b = r / 384;
            int rs = gr - 4; rs = rs < 0 ? 0 : (rs > 56 ? 56 : rs);
            flash_item<1, true, 4>(p, b, b * SEQ + gr * 64, PC_NAQ + hn * 64, PC_NAK + hn * 64, TC_NAV + hn * 64, rs * 64, 8, SEQ, 12, gr, rs,
                                p.na_rpb + (size_t)(l * 6 + hn) * 465, smem, PC_NAQ + hn * 64 + (rep ? 1792 : 0));
            continue;
        }
        r -= n_na;
        m2_item(p, r / NCH, r % NCH);
    }
}

DEV void ph_m4(const Params& p, int l, int bid, int G, int rep) {
    const int nch = (l == 0) ? NCH : 64;
    const int total = NB * 4 * nch;
    for (int it = bid; it < total; it += G) {
        const int cu = it % nch, h = (it / nch) & 3, b = it / (nch * 4);
        m4_item(p, l, b, h, cu, rep ? 2048 : PC_MLQ);
    }
}

DEV void ph_merge(const Params& p, int mt0, int mtiles, char* smem, int vid, int G) {
    const u16* H = WSP(u16, OFF_H);
    u16* P = WSP(u16, OFF_P);
    const u16* Wg = WSP(u16, OFF_W) + WE_MIX + (size_t)2944 * 1024;
    const u16* Wbr = WSP(u16, OFF_W) + WE_BR;
    const int lane = VTID & 63, wave = VTID >> 6, wm = wave >> 1, wn = wave & 1, fr = lane & 15, fq = lane >> 4;
    const int total = mtiles * 16;
    for (int t = vid; t < total; t += G) {
        int mt_, nt_;
        tile_decode(t, 16, mt_, nt_);
        mt_ += mt0;
        const int m0 = mt_ * 128, n0 = nt_ * 64;
        f32x4 y[4][2];
        zero_acc<2>(y);
#pragma unroll 1
        for (int br = 0; br < 3; ++br) {
            const int ko = br == 0 ? 0 : (br == 1 ? 256 : 640);
            const int kk = br == 0 ? 256 : 384;
            f32x4 g[4][2];
            zero_acc<2>(g);
            gemm_accum<2>(g, H + (size_t)m0 * D, D, Wg + (size_t)(br * 1024 + n0) * D, D, D, smem, VTID);
#pragma unroll
            for (int i = 0; i < 4; ++i)
#pragma unroll
                for (int jn = 0; jn < 2; ++jn)
#pragma unroll
                    for (int r = 0; r < 4; ++r) g[i][jn][r] = sigmoidf_(g[i][jn][r]);
            f32x4 a[4][2];
            zero_acc<2>(a);
            gemm_accum<2>(a, P + (size_t)m0 * PW + ko, PW, Wbr + (size_t)n0 * D + ko, D, kk, smem, VTID);
#pragma unroll
            for (int i = 0; i < 4; ++i)
#pragma unroll
                for (int jn = 0; jn < 2; ++jn) y[i][jn] += g[i][jn] * a[i][jn];
        }
#pragma unroll
        for (int mt = 0; mt < 4; ++mt)
#pragma unroll
            for (int nt = 0; nt < 2; ++nt)
#pragma unroll
                for (int r = 0; r < 4; ++r) {
                    const int row = m0 + wm * 64 + mt * 16 + fq * 4 + r;
                    const int col = n0 + wn * 32 + nt * 16 + fr;
                    P[(size_t)row * PW + PC_Y + col] = (u16)(pk2(y[mt][nt][r], 0.f) & 0xffff);
                }
    }
}


#ifdef DBG
constexpr size_t OFF_DBG = al256(WS_END);
__global__ void __launch_bounds__(64) dbg_mlstm(Params p, int l) {
    const int sc = blockIdx.x, dir = sc & 1, h = (sc >> 1) & 3, b = sc >> 3, lane = VTID;
    const u16* P = WSP(u16, OFF_P); const u16* T = WSP(u16, OFF_T); const float* Gt = WSP(float, OFF_G);
    float* HN = WSP(float, OFF_S) + (size_t)sc * UT * 64;
    const float bi = p.ml_gate_b[l * 16 + dir * 8 + h], bf = p.ml_gate_b[l * 16 + dir * 8 + 4 + h];
    float C[64], n[64];
    for (int k = 0; k < 64; ++k) { C[k] = 0.f; n[k] = 0.f; }
    float m = 0.f;
    for (int pos = 0; pos < UT; ++pos) {
        int u;
        if (pos < 256) u = SEQ + (dir ? 255 - pos : pos); else u = dir ? 4095 - (pos - 256) : (pos - 256);
        const int row = rowof(b, u);
        const float ig = Gt[(size_t)row * 16 + dir * 8 + h] + bi;
        const float fp = Gt[(size_t)row * 16 + dir * 8 + 4 + h] + bf;
        const float lf = fminf(fp, 0.f) - log1pf(expf(-fabsf(fp)));
        const float mn = fmaxf(lf + m, ig);
        const float fw = expf(lf + m - mn), iw = expf(ig - mn);
        m = mn;
        const float qv = __uint_as_float(((uint32_t)P[(size_t)row * PW + 2048 + h * 64 + lane]) << 16);
        const float kv = __uint_as_float(((uint32_t)P[(size_t)row * PW + PC_MLK + h * 64 + lane]) << 16) * 0.125f;
        const float vv = __uint_as_float(((uint32_t)T[((size_t)(b * TW + TC_MLV + h * 64 + lane)) * UT + u]) << 16);
        float num = 0.f, den = 0.f;
#pragma unroll
        for (int k = 0; k < 64; ++k) {
            const float kk = __shfl(kv, k), qq = __shfl(qv, k);
            C[k] = fw * C[k] + iw * kk * vv;
            n[k] = fw * n[k] + iw * kk;
            num += qq * C[k];
            den += qq * n[k];
        }
        HN[(size_t)u * 64 + lane] = num / fmaxf(fabsf(den), expf(-m));
    }
}
__global__ void dbg_cmp(Params p, int l) {
    const int gid = blockIdx.x * blockDim.x + VTID;
    const u16* P = WSP(u16, OFF_P); const u16* T = WSP(u16, OFF_T);
    unsigned* dw = (unsigned*)(p.ws + OFF_DBG);
    float* df = (float*)(p.ws + OFF_DBG);
    if (gid < NB * 4 * UT) {
        const int u = gid % UT, h = (gid / UT) & 3, b = gid / (UT * 4);
        const int row = rowof(b, u);
        const float* hf = WSP(float, OFF_S) + ((size_t)((b * 4 + h) * 2 + 0) * UT + u) * 64;
        const float* hb = WSP(float, OFF_S) + ((size_t)((b * 4 + h) * 2 + 1) * UT + u) * 64;
        float ss = 0.f;
        for (int v = 0; v < 64; ++v) { const float x = hf[v] + hb[v]; ss += x * x; }
        const float rstd = rsqrtf(ss / 64.f + 1e-6f);
        float md = 0.f;
        for (int v = 0; v < 64; ++v) {
            const float x = (hf[v] + hb[v]) * rstd * p.ml_norm_w[l * 256 + h * 64 + v];
            const float o = __uint_as_float(((uint32_t)P[(size_t)row * PW + PC_MLO + h * 64 + v]) << 16);
            const float y = x / (1.f + expf(-o));
            const float got = __uint_as_float(((uint32_t)P[(size_t)row * PW + PC_MLQ + h * 64 + v]) << 16);
            md += fabsf(y - got);
        }
        atomicAdd(df + (u < SEQ ? 0 : 1), md * (1.f / 64.f));
        return;
    }
    const int w = (gid - NB * 4 * UT) >> 6;
    const int lane = VTID & 63;
    int type, b, qrow, qc, kcol, tcol, ocol, hn = 0, gr = 0, gc = 0, nkeys;
    if (w < 6144) {
        type = 0; const int i = w & 127; hn = (w >> 7) % 6; b = w / 768;
        gr = i & 63; gc = (i < 64) ? gr : 63 - gr;
        qrow = b * SEQ + gr * 64 + gc; qc = 2048 + 256 + hn * 64; kcol = PC_NAK + hn * 64; tcol = TC_NAV + hn * 64; ocol = PC_NAQ + hn * 64; nkeys = 384;
    } else if (w < 6144 + 256) {
        type = 1; const int x = w - 6144; const int i = x & 15, hh = (x >> 4) & 1; b = x >> 5;
        qrow = b * SEQ + (i * 273) % 4096; qc = 2688 + hh * 64; kcol = PC_GQK + hh * 64; tcol = TC_GQV + hh * 64; ocol = PC_GQQ + hh * 3 * 64; nkeys = 4352;
    } else if (w < 6144 + 256 + 768) {
        type = 2; const int x = w - 6400; const int i = x & 15; hn = (x >> 4) % 6; b = x / 96;
        qrow = NL + b * CTXL + (i * 17) % 256; qc = 2048 + 256 + hn * 64; kcol = PC_NAK + hn * 64; tcol = TC_NAV + hn * 64; ocol = PC_NAQ + hn * 64; nkeys = 256;
    } else if (w < 6144 + 256 + 768 + 256) {
        type = 3; const int x = w - 7168; const int i = x & 15, hh = (x >> 4) & 1; b = x >> 5;
        qrow = NL + b * CTXL + (i * 17) % 256; qc = 2688 + hh * 64; kcol = PC_GQK + hh * 64; tcol = TC_GQV + hh * 64; ocol = PC_GQQ + hh * 3 * 64; nkeys = 256;
    } else return;
    const float q = __uint_as_float(((uint32_t)P[(size_t)qrow * PW + qc + lane]) << 16);
    float o = 0.f;
    int rs = gr - 4; rs = rs < 0 ? 0 : (rs > 56 ? 56 : rs);
    int cs = gc - 8; cs = cs < 0 ? 0 : (cs > 48 ? 48 : cs);
    float mx = -1e30f, lsum = 0.f;
    for (int kidx = 0; kidx < nkeys; ++kidx) {
        int u; float bias = 0.f;
        if (type == 0) {
            if (kidx < 128) {
                const int ri = kidx >> 4, ci = kidx & 15;
                u = (rs + ri) * 64 + cs + ci;
                bias = p.na_rpb[(size_t)(l * 6 + hn) * 465 + (rs + ri - gr + 7) * 31 + (cs + ci - gc + 15)];
            } else u = SEQ + (kidx - 128);
        } else if (type == 1) u = kidx;
        else u = SEQ + kidx;
        const int krow = rowof(b, u);
        float sdot = wave_sum(q * __uint_as_float(((uint32_t)P[(size_t)krow * PW + kcol + lane]) << 16));
        sdot += bias;
        const float mn = fmaxf(mx, sdot);
        const float al = expf(mx - mn), e = expf(sdot - mn);
        lsum = lsum * al + e; mx = mn;
        o = o * al + e * __uint_as_float(((uint32_t)T[((size_t)(b * TW + tcol + lane)) * UT + u]) << 16);
    }
    const float got = __uint_as_float(((uint32_t)P[(size_t)qrow * PW + ocol + lane]) << 16);
    float md = wave_max(fabsf(o / lsum - got));
    if (lane == 0) atomicMax(dw + 2 + type, __float_as_uint(md));
}
__global__ void dbg_copy(Params p) {
    u16* P = WSP(u16, OFF_P);
    for (size_t i = (size_t)blockIdx.x * 256 + VTID; i < (size_t)MTOT * 768; i += (size_t)gridDim.x * 256) {
        const size_t row = i / 768, c = i % 768;
        const size_t src = c < 640 ? c : (c < 704 ? PC_GQQ + (c - 640) : PC_GQQ + 192 + (c - 704));
        P[row * PW + 2048 + c] = P[row * PW + src];
    }
}
DEV int dbg_row(int sr) { return sr < 8 ? sr * 4096 + (sr * 577 + 13) % 4096 : NL + (sr - 8) * 256 + ((sr - 8) * 37 + 5) % 256; }
DEV float* dbg_xrow(const Params& p, int row) { return row < NL ? p.out + (size_t)row * D : WSP(float, OFF_XC) + (size_t)(row - NL) * D; }
DEV float dbg_mod(const Params& p, int l, int b9, int idx, int n) {
    float a = p.ada_b[l * 9216 + idx * 1024 + n];
    for (int k = 0; k < 1024; ++k) {
        const float c = b9 < 8 ? p.c[b9 * 1024 + k] : p.c_ctx[k];
        a += c / (1.f + expf(-c)) * p.ada_w[((size_t)l * 1024 + k) * 9216 + idx * 1024 + n];
    }
    return a;
}
DEV float blk_sum(float v, float* red) {
    v = wave_sum(v);
    __syncthreads();
    if ((VTID & 63) == 0) red[VTID >> 6] = v;
    __syncthreads();
    return red[0] + red[1] + red[2] + red[3];
}
DEV float blk_max(float v, float* red) {
    v = wave_max(v);
    __syncthreads();
    if ((VTID & 63) == 0) red[VTID >> 6] = v;
    __syncthreads();
    return fmaxf(fmaxf(red[0], red[1]), fmaxf(red[2], red[3]));
}
__global__ void dbg_save(Params p, int slot) {
    const int sr = blockIdx.x, row = dbg_row(sr);
    float* dst = (float*)(p.ws + OFF_DBG + 256) + ((size_t)slot * 16 + sr) * 1024;
    const float* src = dbg_xrow(p, row);
    for (int n = VTID; n < 1024; n += 256) dst[n] = src[n];
}
DEV float dbg_modulate(const Params& p, int l, int sub, int b9, const float* xs, float* hs, float* red) {
    float ss = 0.f;
    for (int n = VTID; n < 1024; n += 256) ss += xs[n] * xs[n];
    ss = blk_sum(ss, red);
    const float rstd = rsqrtf(ss / 1024.f + 1e-6f);
    float md = 0.f;
    for (int n = VTID; n < 1024; n += 256) {
        const float sh = dbg_mod(p, l, b9, 3 * sub, n), sc = dbg_mod(p, l, b9, 3 * sub + 1, n);
        md = fmaxf(md, fabsf(sh - WSP(float, OFF_MODS)[b9 * 9216 + (3 * sub) * 1024 + n]));
        md = fmaxf(md, fabsf(sc - WSP(float, OFF_MODS)[b9 * 9216 + (3 * sub + 1) * 1024 + n]));
        hs[n] = xs[n] * rstd * p.norm_w[(l * 3 + sub) * 1024 + n] * (1.f + sc) + sh;
    }
    __syncthreads();
    return md;
}
__global__ void __launch_bounds__(256) dbg_ffn(Params p, int l, int which, int slot, int bit) {
    __shared__ float xs[1024], hs[1024], gs[1024], as[2816], red[4];
    const int sr = blockIdx.x, row = dbg_row(sr), b9 = row < NL ? row >> 12 : 8, sub = which ? 2 : 0;
    const float* xin = (const float*)(p.ws + OFF_DBG + 256) + ((size_t)slot * 16 + sr) * 1024;
    for (int n = VTID; n < 1024; n += 256) xs[n] = xin[n];
    __syncthreads();
    float mdm = dbg_modulate(p, l, sub, b9, xs, hs, red);
    for (int n = VTID; n < 1024; n += 256) gs[n] = dbg_mod(p, l, b9, 3 * sub + 2, n);
    const float* win = p.ffn_w_in + (size_t)(l * 2 + which) * 1024 * 5632;
    const float* wout = p.ffn_w_out + (size_t)(l * 2 + which) * 2816 * 1024;
    for (int j = VTID; j < 2816; j += 256) {
        float g = 0.f, u = 0.f;
        for (int k = 0; k < 1024; ++k) { g += hs[k] * win[(size_t)k * 5632 + j]; u += hs[k] * win[(size_t)k * 5632 + 2816 + j]; }
        as[j] = g / (1.f + expf(-g)) * u;
    }
    __syncthreads();
    float md = 0.f;
    const float* xc = dbg_xrow(p, row);
    for (int n = VTID; n < 1024; n += 256) {
        float o = 0.f;
        for (int j = 0; j < 2816; ++j) o += as[j] * wout[(size_t)j * 1024 + n];
        md = fmaxf(md, fabsf(xs[n] + 0.5f * gs[n] * o - xc[n]));
    }
    md = blk_max(md, red);
    mdm = blk_max(mdm, red);
    unsigned* dw = (unsigned*)(p.ws + OFF_DBG);
    if (VTID == 0) { atomicMax(dw + bit, __float_as_uint(md)); atomicMax(dw + 15, __float_as_uint(mdm)); }
}
__global__ void __launch_bounds__(256) dbg_pchk(Params p, int l) {
    __shared__ float xs[1024], hs[1024], red[4];
    const int sr = blockIdx.x, row = dbg_row(sr), b9 = row < NL ? row >> 12 : 8;
    const float* xin = dbg_xrow(p, row);
    for (int n = VTID; n < 1024; n += 256) xs[n] = xin[n];
    __syncthreads();
    float mdm = dbg_modulate(p, l, 1, b9, xs, hs, red);
    const float* w = p.mix_w_in + (size_t)l * 1024 * NIN;
    const u16* P = WSP(u16, OFF_P); const u16* T = WSP(u16, OFF_T);
    int b, u;
    if (row < NL) { b = row >> 12; u = row & 4095; } else { b = (row - NL) >> 8; u = SEQ + ((row - NL) & 255); }
    float md = 0.f;
    for (int n = VTID; n < 2832; n += 256) {
        const int sc = map_col(2, n);
        float v = 0.f;
        for (int k = 0; k < 1024; ++k) v += hs[k] * w[(size_t)k * NIN + sc];
        if (n < 2048) md = fmaxf(md, fabsf(v - __uint_as_float(((uint32_t)P[(size_t)row * PW + n]) << 16)));
        if (n >= 1280 && n < 1536) md = fmaxf(md, fabsf(v - __uint_as_float(((uint32_t)T[((size_t)(b * TW + n - 1280)) * UT + u]) << 16)));
        if (n >= 2048 && n < 2816) md = fmaxf(md, fabsf(v - __uint_as_float(((uint32_t)T[((size_t)(b * TW + n - 1792)) * UT + u]) << 16)));
        if (n >= 2816) md = fmaxf(md, fabsf(v - WSP(float, OFF_G)[(size_t)row * 16 + n - 2816]));
    }
    md = blk_max(md, red);
    mdm = blk_max(mdm, red);
    unsigned* dw = (unsigned*)(p.ws + OFF_DBG);
    if (VTID == 0) { atomicMax(dw + 9, __float_as_uint(md)); atomicMax(dw + 15, __float_as_uint(mdm)); }
}
__global__ void __launch_bounds__(256) dbg_mix(Params p, int l, int slot) {
    __shared__ float xs[1024], hs[1024], os[1024], ys[1024], red[4];
    const int sr = blockIdx.x, row = dbg_row(sr), b9 = row < NL ? row >> 12 : 8;
    const float* xin = (const float*)(p.ws + OFF_DBG + 256) + ((size_t)slot * 16 + sr) * 1024;
    const u16* P = WSP(u16, OFF_P);
    for (int n = VTID; n < 1024; n += 256) { xs[n] = xin[n]; os[n] = __uint_as_float(((uint32_t)P[(size_t)row * PW + n]) << 16); }
    __syncthreads();
    float mdm = dbg_modulate(p, l, 1, b9, xs, hs, red);
    const float* w = p.mix_w_in + (size_t)l * 1024 * NIN;
    for (int n = VTID; n < 1024; n += 256) {
        float y = 0.f;
        for (int i = 0; i < 3; ++i) {
            float g = 0.f;
            for (int k = 0; k < 1024; ++k) g += hs[k] * w[(size_t)k * NIN + 2832 + i * 1024 + n];
            g = 1.f / (1.f + expf(-g));
            const float* wb = i == 0 ? p.w_br_ml + (size_t)l * 256 * 1024 : (i == 1 ? p.w_br_na + (size_t)l * 384 * 1024 : p.w_br_gq + (size_t)l * 384 * 1024);
            const int ko = i == 0 ? 0 : (i == 1 ? 256 : 640), kk = i == 0 ? 256 : 384;
            float a = 0.f;
            for (int k = 0; k < kk; ++k) a += os[ko + k] * wb[(size_t)k * 1024 + n];
            y += g * a;
        }
        ys[n] = y;
    }
    __syncthreads();
    float md = 0.f;
    const float* xc = dbg_xrow(p, row);
    for (int n = VTID; n < 1024; n += 256) {
        float o = 0.f;
        for (int k = 0; k < 1024; ++k) o += ys[k] * p.w_out[((size_t)l * 1024 + k) * 1024 + n];
        const float g5 = dbg_mod(p, l, b9, 5, n);
        md = fmaxf(md, fabsf(xs[n] + g5 * o - xc[n]));
    }
    md = blk_max(md, red);
    mdm = blk_max(mdm, red);
    unsigned* dw = (unsigned*)(p.ws + OFF_DBG);
    if (VTID == 0) { atomicMax(dw + 10, __float_as_uint(md)); atomicMax(dw + 15, __float_as_uint(mdm)); }
}
__global__ void dbg_fin(Params p) {
    const unsigned* dw = (const unsigned*)(p.ws + OFF_DBG);
    int mask = 0;
    if (__uint_as_float(dw[8]) > 0.02f) mask |= 1;
    if (__uint_as_float(dw[9]) > 0.03f) mask |= 2;
    if (__uint_as_float(dw[10]) > 0.02f) mask |= 4;
    if (__uint_as_float(dw[11]) > 0.02f) mask |= 8;
    if (__uint_as_float(dw[15]) > 1e-3f) mask |= 16;
    if (__uint_as_float(dw[4]) > 0.03f) mask |= 32;
    p.out[0] += 10.f * (float)mask;
    p.out[1] += 1000.f * __uint_as_float(dw[4]);
}
#endif


DEV void gemm8b_accum(f32x4 (&acc)[4][4], const u16* __restrict__ A, int lda, const u16* __restrict__ B, int ldb, int K, char* smem, int tid) {
    constexpr int STAGE = 49152;
    const int lane = tid & 63, wave = tid >> 6;
    const int wm = wave >> 1, wn = wave & 1, fr = lane & 15, fq = lane >> 4;
    const int lr = lane >> 3, pos = lane & 7;
    const int ce = pos ^ (lr >> 1), co = pos ^ (4 | (lr >> 1));
    const unsigned ra_ = (unsigned)((wave * 32 + lr) * lda) * 2u, rb_ = (unsigned)((wave * 16 + lr) * ldb) * 2u;
    const unsigned voa_e = ra_ + ce * 16, voa_o = ra_ + co * 16, vob_e = rb_ + ce * 16, vob_o = rb_ + co * 16;
    const int nk = K >> 6;
    const unsigned ldsb = (unsigned)(size_t)(__attribute__((address_space(3))) char*)smem;
    const unsigned ldsa_w = __builtin_amdgcn_readfirstlane(ldsb + wave * 4096);
    const unsigned ldsb_w = __builtin_amdgcn_readfirstlane(ldsb + 32768 + wave * 2048);
#define G8B_ISSUE(STG, K0) do { \
        _Pragma("unroll") for (int i = 0; i < 4; ++i) glds16(A + (size_t)(8 * i) * lda + (K0), (i & 1) ? voa_o : voa_e, ldsa_w + (STG) * STAGE + i * 1024); \
        _Pragma("unroll") for (int i = 0; i < 2; ++i) glds16(B + (size_t)(8 * i) * ldb + (K0), (i & 1) ? vob_o : vob_e, ldsb_w + (STG) * STAGE + i * 1024); \
    } while (0)
    G8B_ISSUE(0, 0);
    VM_WAIT0();
    __syncthreads();
    const int s3 = (fr >> 1) & 7;
    const int oa_base = (wm * 64 + fr) * 128 + ((fq ^ s3) * 16);
    const int ob_base = 32768 + (wn * 64 + fr) * 128 + ((fq ^ s3) * 16);
    for (int kt = 0; kt < nk; ++kt) {
        const int cur = kt & 1;
        const int k0 = (kt + 1 < nk ? kt + 1 : kt) * 64;
        G8B_ISSUE(cur ^ 1, k0);
        int o_a = cur * STAGE + oa_base, o_b = cur * STAGE + ob_base;
        asm volatile("" : "+v"(o_a), "+v"(o_b));
#pragma unroll
        for (int ks = 0; ks < 2; ++ks) {
            const char* sa_c = smem + (ks ? (o_a ^ 64) : o_a);
            const char* sb_c = smem + (ks ? (o_b ^ 64) : o_b);
            bf16x8 bfr[4], af[4];
#pragma unroll
            for (int nt = 0; nt < 4; ++nt) bfr[nt] = *(const bf16x8*)(sb_c + nt * 2048);
#pragma unroll
            for (int mt = 0; mt < 4; ++mt) af[mt] = *(const bf16x8*)(sa_c + mt * 2048);
#pragma unroll
            for (int mt = 0; mt < 4; ++mt)
#pragma unroll
                for (int nt = 0; nt < 4; ++nt) acc[mt][nt] = mfma16(af[mt], bfr[nt], acc[mt][nt]);
            __builtin_amdgcn_sched_group_barrier(0x100, 7, 0);
            __builtin_amdgcn_sched_group_barrier(0x008, 4, 0);
            __builtin_amdgcn_sched_group_barrier(0x100, 1, 0);
#pragma unroll
            for (int i = 0; i < 3; ++i) __builtin_amdgcn_sched_group_barrier(0x008, 4, 0);
        }
        VM_WAIT0();
        __syncthreads();
    }
#undef G8B_ISSUE
}

DEV void ph_merge8(const Params& p, char* smem, int rvid, int RG, int tid) {
    const u16* H = WSP(u16, OFF_H);
    u16* P = WSP(u16, OFF_P);
    const u16* Wg = WSP(u16, OFF_W) + WE_MIX + (size_t)2944 * 1024;
    const u16* Wbr = WSP(u16, OFF_W) + WE_BR;
    const int lane = tid & 63, wave = tid >> 6, wm = wave >> 1, wn = wave & 1, fr = lane & 15, fq = lane >> 4;
    const int total = 128 * 8;
    for (int t = rvid; t < total; t += RG) {
        const int gi = t >> 5, rem = t & 31;
        const int mt_ = gi * 4 + (rem & 3), nt_ = rem >> 2;
        const int m0 = mt_ * 256, n0 = nt_ * 128;
        f32x4 y[4][4];
        zero_acc<4>(y);
#pragma unroll 1
        for (int br = 0; br < 3; ++br) {
            const int ko = br == 0 ? 0 : (br == 1 ? 256 : 640);
            const int kk = br == 0 ? 256 : 384;
            uint32_t gpk[4][4][2];
            {
                f32x4 g[4][4];
                zero_acc<4>(g);
                gemm8b_accum(g, H + (size_t)m0 * D, D, Wg + (size_t)(br * 1024 + n0) * D, D, D, smem, tid);
#pragma unroll
                for (int i = 0; i < 4; ++i)
#pragma unroll
                    for (int jn = 0; jn < 4; ++jn) {
                        gpk[i][jn][0] = pk2(sigmoidf_(g[i][jn][0]), sigmoidf_(g[i][jn][1]));
                        gpk[i][jn][1] = pk2(sigmoidf_(g[i][jn][2]), sigmoidf_(g[i][jn][3]));
                    }
            }
            f32x4 a[4][4];
            zero_acc<4>(a);
            gemm8b_accum(a, P + (size_t)m0 * PW + ko, PW, Wbr + (size_t)n0 * D + ko, D, kk, smem, tid);
#pragma unroll
            for (int i = 0; i < 4; ++i)
#pragma unroll
                for (int jn = 0; jn < 4; ++jn) {
                    y[i][jn][0] += bflo(gpk[i][jn][0]) * a[i][jn][0];
                    y[i][jn][1] += bfhi(gpk[i][jn][0]) * a[i][jn][1];
                    y[i][jn][2] += bflo(gpk[i][jn][1]) * a[i][jn][2];
                    y[i][jn][3] += bfhi(gpk[i][jn][1]) * a[i][jn][3];
                }
        }
#pragma unroll
        for (int mt = 0; mt < 4; ++mt)
#pragma unroll
            for (int nt = 0; nt < 4; ++nt)
#pragma unroll
                for (int r = 0; r < 4; ++r) {
                    const int row = m0 + wm * 64 + mt * 16 + fq * 4 + r;
                    const int col = n0 + wn * 64 + nt * 16 + fr;
                    P[(size_t)row * PW + PC_Y + col] = (u16)(pk2(y[mt][nt][r], 0.f) & 0xffff);
                }
    }
}

constexpr int PH_PER_LAYER = 15;
constexpr int N_PHASES = 2 * PH_PER_LAYER;

#ifndef REPEAT_MASK
#define REPEAT_MASK 0
#endif
template <int Q>
DEV void run_phase_q(const Params& p, int l, char* smem) {
    const int half = (int)((threadIdx.x + p.z) >> 8);
    const int G = gridDim.x * 2, bid = blockIdx.x * 2 + half;
    const int vid = (gridDim.x % 8 == 0) ? (int)(blockIdx.x & 7) * (G >> 3) + (int)(blockIdx.x >> 3) * 2 + half : bid;
    smem += half * 73728;
    const bool last = (l == 1);
    const u16* W = WSP(u16, OFF_W);
    const int nrep = ((REPEAT_MASK >> Q) & 1) ? 2 : 1;
    char* smem0 = smem - half * 73728;
    const int rtid = (int)(threadIdx.x + p.z);
    const int RG = gridDim.x;
    const int rvid = (RG % 8 == 0) ? (int)(blockIdx.x & 7) * (RG >> 3) + (int)(blockIdx.x >> 3) : (int)blockIdx.x;
    for (int rep = 0; rep < nrep; ++rep) {
        const float cm = rep ? 0.f : 1.f;
        if (Q == 0) ph_prep(p, l, smem, bid, G);
        if (Q == 1) ph_mod(p, l, 0, MTOT, bid, G);
        Params p2 = p;
        if (Q == 2) { ph_ffn_in8(p, 0, smem0, rvid, RG, rtid); int z2 = p.z; asm volatile("" : "+s"(z2) :: "memory"); p2.z = z2; ph_ffn_in(p2, 0, 256, 16, smem, vid, G); }
        if (Q == 3) { ph_resid8(p, WSP(u16, OFF_P), DFF, W + WE_OUT0, DFF, 2, 0.5f * cm, smem0, rvid, RG, rtid, l == 0 ? p.x : p.out); int z2 = p.z; asm volatile("" : "+s"(z2) :: "memory"); p2.z = z2;
                      ph_resid(p2, WSP(u16, OFF_P), DFF, W + WE_OUT0, DFF, 2, 0.5f * cm, 256, 16, smem, vid, G); }
        if (Q == 4) ph_mod(p, l, 1, MTOT, bid, G);
        if (Q == 5) { ph_pgemm8(p, smem0, rvid, RG, rtid); int z2 = p.z; asm volatile("" : "+s"(z2) :: "memory"); p2.z = z2; ph_pgemm(p2, 256, 16, smem, vid, G); }
        if (Q == 6) ph_qknorm_gates(p, l, bid, G);
        if (Q == 7) { ph_attn8(p, l, smem0, rvid, RG); int z2 = p.z; asm volatile("" : "+s"(z2) :: "memory"); p2.z = z2; ph_attn(p2, l, smem, bid, G, rep); }
        if (Q == 8) ph_m3(p, bid, G);
        if (Q == 9) ph_m4(p, l, bid, G, rep);
        if (Q == 10) { ph_merge8(p, smem0, rvid, RG, rtid); int z2 = p.z; asm volatile("" : "+s"(z2) :: "memory"); p2.z = z2; if (!last) ph_merge(p2, 256, 16, smem, vid, G); }
        if (Q == 11) { ph_resid8(p, WSP(u16, OFF_P) + PC_Y, PW, W + WE_O, D, 5, 1.0f * cm, smem0, rvid, RG, rtid, p.out);
                       int z2 = p.z; asm volatile("" : "+s"(z2) :: "memory"); p2.z = z2;
                       if (!last) ph_resid(p2, WSP(u16, OFF_P) + PC_Y, PW, W + WE_O, D, 5, 1.0f * cm, 256, 16, smem, vid, G); }
        if (Q == 12) ph_mod(p, l, 2, last ? NL : MTOT, bid, G);
        if (Q == 13) { ph_ffn_in8(p, 1, smem0, rvid, RG, rtid); int z2 = p.z; asm volatile("" : "+s"(z2) :: "memory"); p2.z = z2; if (!last) ph_ffn_in(p2, 1, 256, 16, smem, vid, G); }
        if (Q == 14) { ph_resid8(p, WSP(u16, OFF_P), DFF, W + WE_OUT1, DFF, 8, 0.5f * cm, smem0, rvid, RG, rtid, p.out);
                       int z2 = p.z; asm volatile("" : "+s"(z2) :: "memory"); p2.z = z2;
                       if (!last) ph_resid(p2, WSP(u16, OFF_P), DFF, W + WE_OUT1, DFF, 8, 0.5f * cm, 256, 16, smem, vid, G); }
    }
}

DEV void run_phase(const Params& p, int ph, char* smem) {
    const int l = ph / PH_PER_LAYER, q = ph % PH_PER_LAYER;
    switch (q) {
        case 0: run_phase_q<0>(p, l, smem); break;
        case 1: run_phase_q<1>(p, l, smem); break;
        case 2: run_phase_q<2>(p, l, smem); break;
        case 3: run_phase_q<3>(p, l, smem); break;
        case 4: run_phase_q<4>(p, l, smem); break;
        case 5: run_phase_q<5>(p, l, smem); break;
        case 6: run_phase_q<6>(p, l, smem); break;
        case 7: run_phase_q<7>(p, l, smem); break;
        case 8: run_phase_q<8>(p, l, smem); break;
        case 9: run_phase_q<9>(p, l, smem); break;
        case 10: run_phase_q<10>(p, l, smem); break;
        case 11: run_phase_q<11>(p, l, smem); break;
        case 12: run_phase_q<12>(p, l, smem); break;
        case 13: run_phase_q<13>(p, l, smem); break;
        case 14: run_phase_q<14>(p, l, smem); break;
    }
}

template <int Q>
__global__ void __launch_bounds__(256, 2) phase_kernel(Params p, int l) {
    __shared__ __attribute__((aligned(16))) char smem[73728];
    run_phase_q<Q>(p, l, smem);
}

#if ONE_LAUNCH
#define XB_TMO      128
#define XB_XCNT(j)  (256  + 64 * (j))
#define XB_XSUB(j)  (1280 + 64 * (j))
#define XB_XGEN(j)  (2304 + 64 * (j))
#define XB_TOP      3328
#define XB_TOPGEN   3392
#define XB_SPIN_CAP (1u << 22)
DEV unsigned xb_ld(unsigned* q) { return __hip_atomic_load(q, __ATOMIC_RELAXED, __HIP_MEMORY_SCOPE_AGENT); }
DEV unsigned xb_add(unsigned* q, unsigned v) { return __hip_atomic_fetch_add(q, v, __ATOMIC_RELAXED, __HIP_MEMORY_SCOPE_AGENT); }
DEV unsigned xb_xcc_id() { return (unsigned)__builtin_amdgcn_s_getreg((3 << 11) | 20) & 0xFu; }
#define XB_SPIN(cond, bar) do { unsigned _sp = 0; while (cond) { __builtin_amdgcn_s_sleep(1); \
    if ((++_sp & 255u) == 0u) { if (xb_ld(&(bar)[XB_TMO])) break; if (_sp > XB_SPIN_CAP) { atomicAdd(&(bar)[XB_TMO], 1u); break; } } } } while (0)
DEV void xcd_census(unsigned* bar, unsigned x, unsigned& nloc, unsigned& nx) {
    const unsigned G = gridDim.x;
    unsigned sum, cnt, mine, sp = 0u;
    for (;;) {
        sum = 0u; cnt = 0u; mine = 0u;
#pragma unroll
        for (unsigned j = 0; j < 16; ++j) { const unsigned c = xb_ld(&bar[XB_XCNT(j)]); sum += c; cnt += (c > 0u) ? 1u : 0u; mine = (j == x) ? c : mine; }
        if (sum == G) break;
        __builtin_amdgcn_s_sleep(1);
        if ((++sp & 255u) == 0u) { if (xb_ld(&bar[XB_TMO])) break; if (sp > XB_SPIN_CAP) { atomicAdd(&bar[XB_TMO], 1u); break; } }
    }
    nloc = mine > 0u ? mine : 1u; nx = cnt > 0u ? cnt : 1u;
}
DEV void xcd_barrier(unsigned* bar, unsigned x, volatile unsigned* st, int tid) {
    asm volatile("s_waitcnt vmcnt(0)" ::: "memory");
    __syncthreads();
    if (tid == 0) {
        __builtin_amdgcn_s_waitcnt(0);
        unsigned nloc = st[0], nx = st[1];
        if (nloc == 0u) { xcd_census(bar, x, nloc, nx); st[0] = nloc; st[1] = nx; }
        const unsigned old = xb_add(&bar[XB_XSUB(x)], 1u);
        const unsigned gen = old / nloc;
        if (old + 1u == (gen + 1u) * nloc) {
            __builtin_amdgcn_fence(__ATOMIC_RELEASE, "agent");
            asm volatile("s_waitcnt vmcnt(0)" ::: "memory");
            const unsigned og = xb_add(&bar[XB_TOP], 1u);
            const unsigned tg = og / nx;
            if (og + 1u == (tg + 1u) * nx) xb_add(&bar[XB_TOPGEN], 1u);
            else XB_SPIN(xb_ld(&bar[XB_TOPGEN]) == tg, bar);
            __builtin_amdgcn_fence(__ATOMIC_ACQUIRE, "agent");
            xb_add(&bar[XB_XGEN(x)], 1u);
            asm volatile("s_waitcnt vmcnt(0)" ::: "memory");
        } else {
            XB_SPIN(xb_ld(&bar[XB_XGEN(x)]) == gen, bar);
            __builtin_amdgcn_fence(__ATOMIC_ACQUIRE, "agent");
            asm volatile("s_waitcnt vmcnt(0)" ::: "memory");
        }
    }
    __syncthreads();
}
__global__ void __launch_bounds__(512, 2) mega_kernel(Params p0, int ph_begin, int ph_end) {
    __shared__ __attribute__((aligned(16))) char smem[147456];
    __shared__ uint4 xb_words;
    unsigned* bar = (unsigned*)(p0.ws + OFF_BAR);
    const unsigned xcc = xb_xcc_id();
    if (threadIdx.x == 0) { xb_words = make_uint4(0u, 0u, 0u, 0u); (void)xb_add(&bar[XB_XCNT(xcc)], 1u); }
    __syncthreads();
    for (int ph = ph_begin; ph < ph_end; ++ph) {
        Params p = p0;
        int z = p0.z;
        asm volatile("" : "+s"(z));
        p.z = z;
        p.ws = p0.ws + z;
        p.out = p0.out + z;
        run_phase(p, ph, smem);
        if (ph + 1 < ph_end) {
            if (p0.z == 0x7fffffff) cg::this_grid().sync();
            xcd_barrier(bar, xcc, (volatile unsigned*)&xb_words, (int)threadIdx.x + z);
        }
    }
}
#endif

extern "C" void kernel_launch(void* const* d_in, const int* in_sizes, int n_in, void* d_out, int out_size, void* d_ws, size_t ws_size,
                              hipStream_t stream) {
    if (ws_size < WS_END) { fprintf(stderr, "workspace too small: %zu < %zu\n", ws_size, (size_t)WS_END); return; }
    Params p{};
    p.x = (const float*)d_in[0]; p.c = (const float*)d_in[1]; p.ctx = (const float*)d_in[2]; p.c_ctx = (const float*)d_in[3];
    p.ada_w = (const float*)d_in[4]; p.ada_b = (const float*)d_in[5]; p.norm_w = (const float*)d_in[6];
    p.ffn_w_in = (const float*)d_in[7]; p.ffn_w_out = (const float*)d_in[8]; p.mix_w_in = (const float*)d_in[9];
    p.ml_gate_b = (const float*)d_in[10]; p.ml_norm_w = (const float*)d_in[11]; p.na_qk_w = (const float*)d_in[12];
    p.na_rpb = (const float*)d_in[13]; p.gq_qk_w = (const float*)d_in[14]; p.w_br_ml = (const float*)d_in[15];
    p.w_br_na = (const float*)d_in[16]; p.w_br_gq = (const float*)d_in[17]; p.w_out = (const float*)d_in[18];
    p.out = (float*)d_out; p.ws = (char*)d_ws;
#ifdef NANFILL
    hipMemsetAsync(d_ws, 0xFF, WS_END, stream);
#endif
#if ONE_LAUNCH
    static int grid_blocks = 0;
    if (!grid_blocks) {
        int dev = 0, cus = 0, per_cu = 0;
        hipGetDevice(&dev);
        hipDeviceGetAttribute(&cus, hipDeviceAttributeMultiprocessorCount, dev);
        hipOccupancyMaxActiveBlocksPerMultiprocessor(&per_cu, mega_kernel, 512, 0);
        per_cu = 1;
        grid_blocks = cus * per_cu;
    }
    hipMemsetAsync((char*)d_ws + OFF_BAR, 0, 3456 * 4, stream);
    int pb = 0, pe = N_PHASES;
    void* args[] = {&p, &pb, &pe};
#ifdef SPLIT_TEST
    (void)args;
    for (int ph = 0; ph < N_PHASES; ++ph) mega_kernel<<<grid_blocks, 256, 0, stream>>>(p, ph, ph + 1);
#else
    hipError_t e = hipLaunchCooperativeKernel((void*)mega_kernel, dim3(grid_blocks), dim3(512), args, 0, stream);
    if (e != hipSuccess) fprintf(stderr, "cooperative launch failed: %s (grid %d)\n", hipGetErrorString(e), grid_blocks);
#endif
#else
    for (int l = 0; l < 2; ++l) {
#define LP(Q) phase_kernel<Q><<<512, 256, 0, stream>>>(p, l)
#ifdef DBG
        const bool dl = (l == DBG_LAYER);
        if (dl) hipMemsetAsync((char*)d_ws + OFF_DBG, 0, 256, stream);
        LP(0);
        if (dl) dbg_save<<<16, 256, 0, stream>>>(p, 0);
        LP(1); LP(2); LP(3);
        if (dl) dbg_ffn<<<16, 256, 0, stream>>>(p, l, 0, 0, 8);
        LP(4); LP(5);
        if (dl) dbg_pchk<<<16, 256, 0, stream>>>(p, l);
        LP(6);
        if (dl) dbg_copy<<<2048, 256, 0, stream>>>(p);
        LP(7); LP(8); LP(9);
        if (dl) {
            dbg_mlstm<<<64, 64, 0, stream>>>(p, l);
            dbg_cmp<<<(NB * 4 * UT + 7424 * 64 + 255) / 256, 256, 0, stream>>>(p, l);
            dbg_save<<<16, 256, 0, stream>>>(p, 1);
        }
        LP(10); LP(11);
        if (dl) { dbg_mix<<<16, 256, 0, stream>>>(p, l, 1); dbg_save<<<16, 256, 0, stream>>>(p, 2); }
        LP(12); LP(13); LP(14);
        if (dl) dbg_ffn<<<16, 256, 0, stream>>>(p, l, 1, 2, 11);
#else
        LP(0); LP(1); LP(2); LP(3); LP(4); LP(5); LP(6); LP(7); LP(8); LP(9); LP(10); LP(11); LP(12); LP(13); LP(14);
#endif
#undef LP
    }
#ifdef DBG
    dbg_fin<<<1, 1, 0, stream>>>(p);
#endif
#endif
}
```

```cpp
#include <hip/hip_runtime.h>
#include <hip/hip_cooperative_groups.h>
#include <stdint.h>
#include <cstdio>
namespace cg = cooperative_groups;

#ifndef ONE_LAUNCH
#define ONE_LAUNCH 1
#endif

#define VTID ((int)((threadIdx.x + p.z) & 255))
typedef unsigned short u16;
typedef __attribute__((ext_vector_type(8))) short bf16x8;
typedef __attribute__((ext_vector_type(4))) float f32x4;
#define DEV __device__ __forceinline__

constexpr int D = 1024, NB = 8, SEQ = 4096, CTXL = 256;
constexpr int NL = NB * SEQ, NCX = NB * CTXL, MTOT = NL + NCX;
constexpr int DFF = 2816, PW = 2816, UT = SEQ + CTXL, NCH = UT / 64;
constexpr int NIN = 5904;
constexpr int PC_MLQ = 0, PC_NAQ = 256, PC_GQQ = 640, PC_MLO = 1024, PC_MLK = 1280, PC_NAK = 1536, PC_GQK = 1920,
              PC_MLV = 2048, PC_NAV = 2304, PC_GQV = 2688, PC_Y = 1024;
constexpr int TC_MLK = 0, TC_MLV = 256, TC_NAV = 512, TC_GQV = 896, TW = 1024;
constexpr int DBG_MLO = PC_MLQ, DBG_NAO = PC_NAQ;
constexpr int SCH = 4160;
constexpr int NSCAN = 64;

constexpr size_t al256(size_t x) { return (x + 255) & ~(size_t)255; }
constexpr size_t OFF_MODS = 0;
constexpr size_t OFF_ROPE = al256(OFF_MODS + (size_t)9 * 9216 * 4);
constexpr size_t OFF_G    = al256(OFF_ROPE + (size_t)4096 * 64 * 4);
constexpr size_t OFF_BC   = al256(OFF_G + (size_t)MTOT * 16 * 4);
constexpr size_t OFF_IG   = al256(OFF_BC + (size_t)NSCAN * UT * 4);
constexpr size_t OFF_AE   = al256(OFF_IG + (size_t)NSCAN * UT * 4);
constexpr size_t OFF_MS   = al256(OFF_AE + (size_t)NSCAN * UT * 4);
constexpr size_t OFF_DEC  = al256(OFF_MS + (size_t)NSCAN * NCH * 4);
constexpr size_t OFF_XC   = al256(OFF_DEC + (size_t)NSCAN * NCH * 4);
constexpr size_t OFF_H    = al256(OFF_XC + (size_t)NCX * D * 4);
constexpr size_t OFF_P    = al256(OFF_H + (size_t)MTOT * D * 2);
constexpr size_t OFF_T    = al256(OFF_P + (size_t)MTOT * PW * 2);
constexpr size_t OFF_S    = al256(OFF_T + (size_t)NB * TW * UT * 2);
constexpr size_t OFF_W    = al256(OFF_S + (size_t)NSCAN * NCH * SCH * 4);
constexpr size_t WE_IN0 = 0, WE_IN1 = WE_IN0 + (size_t)5632 * 1024, WE_OUT0 = WE_IN1 + (size_t)5632 * 1024,
                 WE_OUT1 = WE_OUT0 + (size_t)1024 * 2816, WE_MIX = WE_OUT1 + (size_t)1024 * 2816,
                 WE_BR = WE_MIX + (size_t)6016 * 1024, WE_O = WE_BR + (size_t)1024 * 1024, WE_END = WE_O + (size_t)1024 * 1024;
constexpr size_t OFF_BAR = al256(OFF_W + WE_END * 2);
constexpr size_t WS_END = OFF_BAR + 3456 * 4;
static_assert(WS_END < (size_t)536000000, "workspace too large");

struct Params {
    const float *x, *c, *ctx, *c_ctx, *ada_w, *ada_b, *norm_w, *ffn_w_in, *ffn_w_out, *mix_w_in, *ml_gate_b, *ml_norm_w,
        *na_qk_w, *na_rpb, *gq_qk_w, *w_br_ml, *w_br_na, *w_br_gq, *w_out;
    float* out;
    char* ws;
    int z, pad;
};

DEV uint32_t pk2(float lo, float hi) { uint32_t r; asm("v_cvt_pk_bf16_f32 %0, %1, %2" : "=v"(r) : "v"(lo), "v"(hi)); return r; }
DEV float bflo(uint32_t w) { return __uint_as_float(w << 16); }
DEV float bfhi(uint32_t w) { return __uint_as_float(w & 0xffff0000u); }
DEV f32x4 mfma16(bf16x8 a, bf16x8 b, f32x4 c) { return __builtin_amdgcn_mfma_f32_16x16x32_bf16(a, b, c, 0, 0, 0); }
typedef unsigned u32x4 __attribute__((ext_vector_type(4)));
DEV u32x4 gld16(const void* q) { u32x4 r; asm volatile("global_load_dwordx4 %0, %1, off" : "=v"(r) : "v"(q) : "memory"); return r; }
DEV u32x4 gld16s(const void* sbase, unsigned voff) { u32x4 r; asm volatile("global_load_dwordx4 %0, %1, %2" : "=v"(r) : "v"(voff), "s"(sbase) : "memory"); return r; }
DEV void glds16(const void* sbase, unsigned voff, unsigned ldsaddr) {
    asm volatile("s_mov_b32 m0, %2\n\ts_nop 0\n\tglobal_load_lds_dwordx4 %0, %1" :: "v"(voff), "s"(sbase), "s"(ldsaddr) : "memory", "m0");
}
#define VM_WAIT0() asm volatile("s_waitcnt vmcnt(0)" ::: "memory")
union Frag { bf16x8 v; uint4 q; uint32_t u[4]; uint2 d[2]; };
DEV int cu_of(int c, int dir) { return c < 4 ? 64 + (dir ? 3 - c : c) : (dir ? 63 - (c - 4) : (c - 4)); }
DEV int rowof(int b, int u) { return u < SEQ ? b * SEQ + u : NL + b * CTXL + (u - SEQ); }
DEV float fexp2(float x) { return __builtin_amdgcn_exp2f(x); }
DEV float fexp(float x) { return __builtin_amdgcn_exp2f(x * 1.4426950408889634f); }
DEV float sigmoidf_(float x) { return 1.f / (1.f + fexp(-x)); }
DEV float xq_max(float v) {
    auto r = __builtin_amdgcn_permlane16_swap(__float_as_uint(v), __float_as_uint(v), false, false);
    const float m = fmaxf(__uint_as_float(r[0]), __uint_as_float(r[1]));
    auto q = __builtin_amdgcn_permlane32_swap(__float_as_uint(m), __float_as_uint(m), false, false);
    return fmaxf(__uint_as_float(q[0]), __uint_as_float(q[1]));
}
DEV float xq_sum(float v) {
    auto r = __builtin_amdgcn_permlane16_swap(__float_as_uint(v), __float_as_uint(v), false, false);
    const float m = __uint_as_float(r[0]) + __uint_as_float(r[1]);
    auto q = __builtin_amdgcn_permlane32_swap(__float_as_uint(m), __float_as_uint(m), false, false);
    return __uint_as_float(q[0]) + __uint_as_float(q[1]);
}
DEV float wave_sum(float v) {
#pragma unroll
    for (int o = 1; o < 64; o <<= 1) v += __shfl_xor(v, o);
    return v;
}
DEV float wave_max(float v) {
#pragma unroll
    for (int o = 1; o < 64; o <<= 1) v = fmaxf(v, __shfl_xor(v, o));
    return v;
}

#define WSP(T_, off) ((T_*)(p.ws + (off)))
DEV float m_scan(const Params& p, int sc, int c_end) {
    const float* BT = WSP(float, OFF_MS) + sc * NCH;
    const float* MX = WSP(float, OFF_DEC) + sc * NCH;
    const int lane = VTID & 63;
    const float bt0 = BT[lane], mx0 = MX[lane], bt1 = BT[64 + (lane & 3)], mx1 = MX[64 + (lane & 3)];
    float m = 0.f;
    for (int c = 0; c < c_end; ++c) {
        const float b = c < 64 ? __shfl(bt0, c) : __shfl(bt1, c - 64);
        const float x = c < 64 ? __shfl(mx0, c) : __shfl(mx1, c - 64);
        m = fmaxf(b + m, x);
    }
    return m;
}

template <int TN>
DEV void gemm_accum(f32x4 (&acc)[4][TN], const u16* __restrict__ A, int lda, const u16* __restrict__ B, int ldb, int K, char* smem, int tid) {
    constexpr int BROWS = TN * 32;
    constexpr int STAGE = (128 + BROWS) * 144;
    constexpr int NBCH = BROWS / 32;
    const int lane = tid & 63, wave = tid >> 6;
    const int wm = wave >> 1, wn = wave & 1, fr = lane & 15, fq = lane >> 4;
    const int lrow = tid >> 3, lc8 = tid & 7;
    const u16* ga = A + (size_t)lrow * lda + lc8 * 8;
    const u16* gb = B + (size_t)lrow * ldb + lc8 * 8;
    u32x4 ra[4], rb[NBCH];
    const int nk = K >> 6;
#pragma unroll
    for (int i = 0; i < 4; ++i) ra[i] = gld16(ga + (size_t)(32 * i) * lda);
#pragma unroll
    for (int i = 0; i < NBCH; ++i) rb[i] = gld16(gb + (size_t)(32 * i) * ldb);
    char* sw = smem + lrow * 144 + lc8 * 16;
    VM_WAIT0();
#pragma unroll
    for (int i = 0; i < 4; ++i) *(u32x4*)(sw + i * 32 * 144) = ra[i];
#pragma unroll
    for (int i = 0; i < NBCH; ++i) *(u32x4*)(sw + 128 * 144 + i * 32 * 144) = rb[i];
    __syncthreads();
    const char* sa_r = smem + (wm * 64 + fr) * 144 + fq * 16;
    const char* sb_r = smem + 128 * 144 + (wn * TN * 16 + fr) * 144 + fq * 16;
    for (int kt = 0; kt < nk; ++kt) {
        const int cur = kt & 1;
        const int k0 = (kt + 1 < nk ? kt + 1 : kt) * 64;
#pragma unroll
        for (int i = 0; i < 4; ++i) ra[i] = gld16(ga + (size_t)(32 * i) * lda + k0);
#pragma unroll
        for (int i = 0; i < NBCH; ++i) rb[i] = gld16(gb + (size_t)(32 * i) * ldb + k0);
        __builtin_amdgcn_sched_barrier(0);
#pragma unroll
        for (int ks = 0; ks < 2; ++ks) {
            bf16x8 af[4], bfr[TN];
#pragma unroll
            for (int mt = 0; mt < 4; ++mt) af[mt] = *(const bf16x8*)(sa_r + cur * STAGE + mt * 16 * 144 + ks * 64);
#pragma unroll
            for (int nt = 0; nt < TN; ++nt) bfr[nt] = *(const bf16x8*)(sb_r + cur * STAGE + nt * 16 * 144 + ks * 64);
#pragma unroll
            for (int mt = 0; mt < 4; ++mt)
#pragma unroll
                for (int nt = 0; nt < TN; ++nt) acc[mt][nt] = mfma16(af[mt], bfr[nt], acc[mt][nt]);
        }
        __builtin_amdgcn_sched_barrier(0);
        VM_WAIT0();
        {
            char* sw2 = sw + (cur ^ 1) * STAGE;
#pragma unroll
            for (int i = 0; i < 4; ++i) *(u32x4*)(sw2 + i * 32 * 144) = ra[i];
#pragma unroll
            for (int i = 0; i < NBCH; ++i) *(u32x4*)(sw2 + 128 * 144 + i * 32 * 144) = rb[i];
        }
        __syncthreads();
    }
}

template <int TN>
DEV void zero_acc(f32x4 (&acc)[4][TN]) {
#pragma unroll
    for (int i = 0; i < 4; ++i)
#pragma unroll
        for (int j = 0; j < TN; ++j) acc[i][j] = f32x4{0.f, 0.f, 0.f, 0.f};
}

DEV void tile_decode(int t, int ntn, int& mt, int& nt) {
    const int per = 8 * ntn;
    const int gi = t / per, rem = t - gi * per;
    nt = rem >> 3;
    mt = gi * 8 + (rem & 7);
}


DEV void gemm8_accum(f32x4 (&acc)[8][4], const u16* __restrict__ A, int lda, const u16* __restrict__ B, int ldb, int K, char* smem, int tid) {
    constexpr int STAGE = 65536;
    const int lane = tid & 63, wave = tid >> 6;
    const int wm = wave >> 2, wn = wave & 3, fr = lane & 15, fq = lane >> 4;
    const int lr = lane >> 3, pos = lane & 7;
    const int ce = pos ^ (lr >> 1), co = pos ^ (4 | (lr >> 1));
    const unsigned ra_ = (unsigned)((wave * 32 + lr) * lda) * 2u, rb_ = (unsigned)((wave * 32 + lr) * ldb) * 2u;
    const unsigned voa_e = ra_ + ce * 16, voa_o = ra_ + co * 16, vob_e = rb_ + ce * 16, vob_o = rb_ + co * 16;
    const int nk = K >> 6;
    const unsigned ldsw = __builtin_amdgcn_readfirstlane((unsigned)(size_t)(__attribute__((address_space(3))) char*)smem + wave * 4096);
#define G8_ISSUE(STG, K0) do { \
        _Pragma("unroll") for (int i = 0; i < 4; ++i) { \
            glds16(A + (size_t)(8 * i) * lda + (K0), (i & 1) ? voa_o : voa_e, ldsw + (STG) * STAGE + i * 1024); \
            glds16(B + (size_t)(8 * i) * ldb + (K0), (i & 1) ? vob_o : vob_e, ldsw + (STG) * STAGE + 32768 + i * 1024); \
        } } while (0)
    G8_ISSUE(0, 0);
    VM_WAIT0();
    __syncthreads();
    const int s3 = (fr >> 1) & 7;
    const int oa_base = (wm * 128 + fr) * 128 + ((fq ^ s3) * 16);
    const int ob_base = 32768 + (wn * 64 + fr) * 128 + ((fq ^ s3) * 16);
    for (int kt = 0; kt < nk; ++kt) {
        const int cur = kt & 1;
        const int k0 = (kt + 1 < nk ? kt + 1 : kt) * 64;
        G8_ISSUE(cur ^ 1, k0);
        int o_a = cur * STAGE + oa_base, o_b = cur * STAGE + ob_base;
        asm volatile("" : "+v"(o_a), "+v"(o_b));
#pragma unroll
        for (int ks = 0; ks < 2; ++ks) {
            const char* sa_c = smem + (ks ? (o_a ^ 64) : o_a);
            const char* sb_c = smem + (ks ? (o_b ^ 64) : o_b);
            bf16x8 bfr[4], af[8];
#pragma unroll
            for (int nt = 0; nt < 4; ++nt) bfr[nt] = *(const bf16x8*)(sb_c + nt * 2048);
#pragma unroll
            for (int mt = 0; mt < 8; ++mt) af[mt] = *(const bf16x8*)(sa_c + mt * 2048);
#pragma unroll
            for (int mt = 0; mt < 8; ++mt)
#pragma unroll
                for (int nt = 0; nt < 4; ++nt) acc[mt][nt] = mfma16(af[mt], bfr[nt], acc[mt][nt]);
            __builtin_amdgcn_sched_group_barrier(0x100, 7, 0);
#pragma unroll
            for (int i = 0; i < 5; ++i) { __builtin_amdgcn_sched_group_barrier(0x008, 4, 0); __builtin_amdgcn_sched_group_barrier(0x100, 1, 0); }
#pragma unroll
            for (int i = 0; i < 3; ++i) __builtin_amdgcn_sched_group_barrier(0x008, 4, 0);
        }
        VM_WAIT0();
        __syncthreads();
    }
#undef G8_ISSUE
}
DEV void zero_acc8(f32x4 (&acc)[8][4]) {
#pragma unroll
    for (int i = 0; i < 8; ++i)
#pragma unroll
        for (int j = 0; j < 4; ++j) acc[i][j] = f32x4{0.f, 0.f, 0.f, 0.f};
}
DEV void tile_decode8(int t, int ntn, int& mt, int& nt) {
    const int per = 4 * ntn;
    const int gi = t / per, rem = t - gi * per;
    nt = rem >> 2;
    mt = gi * 4 + (rem & 3);
}

DEV void ph_ffn_in8(const Params& p, int which, char* smem, int rvid, int RG, int tid) {
    const u16* H = WSP(u16, OFF_H);
    const u16* Wt = WSP(u16, OFF_W) + (which ? WE_IN1 : WE_IN0);
    u16* ACT = WSP(u16, OFF_P);
    const int lane = tid & 63, wave = tid >> 6, wm = wave >> 2, wn = wave & 3, fr = lane & 15, fq = lane >> 4;
    const int total = 128 * 22;
    for (int t = rvid; t < total; t += RG) {
        int mt_, nt_;
        tile_decode8(t, 22, mt_, nt_);
        const int m0 = mt_ * 256, n0 = nt_ * 256;
        f32x4 acc[8][4];
        zero_acc8(acc);
        gemm8_accum(acc, H + (size_t)m0 * D, D, Wt + (size_t)n0 * D, D, D, smem, tid);
#pragma unroll
        for (int mt = 0; mt < 8; ++mt)
#pragma unroll
            for (int pp = 0; pp < 2; ++pp)
#pragma unroll
                for (int r = 0; r < 4; ++r) {
                    const int row = m0 + wm * 128 + mt * 16 + fq * 4 + r;
                    const int hid = (n0 >> 1) + wn * 32 + pp * 16 + fr;
                    const float g = acc[mt][2 * pp][r], u = acc[mt][2 * pp + 1][r];
                    const float v = g * sigmoidf_(g) * u;
                    ACT[(size_t)row * DFF + hid] = (u16)(pk2(v, 0.f) & 0xffff);
                }
    }
}
DEV void ph_resid8(const Params& p, const u16* A, int lda, const u16* Wt, int K, int modidx, float coef, char* smem, int rvid, int RG, int tid, const float* xsrc) {
    const float* mods = WSP(float, OFF_MODS);
    const int lane = tid & 63, wave = tid >> 6, wm = wave >> 2, wn = wave & 3, fr = lane & 15, fq = lane >> 4;
    const int total = 128 * 4;
    for (int t = rvid; t < total; t += RG) {
        int mt_, nt_;
        tile_decode8(t, 4, mt_, nt_);
        const int m0 = mt_ * 256, n0 = nt_ * 256;
        f32x4 acc[8][4];
        zero_acc8(acc);
        gemm8_accum(acc, A + (size_t)m0 * lda, lda, Wt + (size_t)n0 * K, K, K, smem, tid);
        const float* gp = mods + (m0 >> 12) * 9216 + modidx * 1024;
#pragma unroll
        for (int nt = 0; nt < 4; ++nt) {
            const int col = n0 + wn * 64 + nt * 16 + fr;
            const float gv = gp[col] * coef;
#pragma unroll
            for (int mt = 0; mt < 8; ++mt) {
#pragma unroll
                for (int r = 0; r < 4; ++r) {
                    const int row = m0 + wm * 128 + mt * 16 + fq * 4 + r;
                    p.out[(size_t)row * D + col] = xsrc[(size_t)row * D + col] + gv * acc[mt][nt][r];
                }
                __builtin_amdgcn_sched_barrier(0);
            }
        }
    }
}
DEV void ph_pgemm8(const Params& p, char* smem, int rvid, int RG, int tid) {
    const u16* H = WSP(u16, OFF_H);
    const u16* Wt = WSP(u16, OFF_W) + WE_MIX;
    u16* P = WSP(u16, OFF_P);
    u16* T = WSP(u16, OFF_T);
    float* Gt = WSP(float, OFF_G);
    const int lane = tid & 63, wave = tid >> 6, wm = wave >> 2, wn = wave & 3, fr = lane & 15, fq = lane >> 4;
    const int total = 128 * 12;
    for (int t = rvid; t < total; t += RG) {
        int mt_, nt_;
        tile_decode8(t, 12, mt_, nt_);
        const int m0 = mt_ * 256, n0 = nt_ * 256;
        f32x4 acc[8][4];
        zero_acc8(acc);
        gemm8_accum(acc, H + (size_t)m0 * D, D, Wt + (size_t)n0 * D, D, D, smem, tid);
        const int cb = n0 + wn * 64;
        const int j = cb >> 7;
        if (j >= 22) {
            if (cb == 2816) {
#pragma unroll
                for (int mt = 0; mt < 8; ++mt)
#pragma unroll
                    for (int r = 0; r < 4; ++r) {
                        const int row = m0 + wm * 128 + mt * 16 + fq * 4 + r;
                        Gt[(size_t)row * 16 + fr] = acc[mt][0][r];
                    }
            }
            continue;
        }
        const bool rowmajor = j < 16;
        const bool transp = (j == 10) || (j == 11) || (j >= 16);
        if (rowmajor) {
#pragma unroll
            for (int mt = 0; mt < 8; ++mt)
#pragma unroll
                for (int nt = 0; nt < 4; ++nt)
#pragma unroll
                    for (int r = 0; r < 4; ++r) {
                        const int row = m0 + wm * 128 + mt * 16 + fq * 4 + r;
                        P[(size_t)row * PW + cb + nt * 16 + fr] = (u16)(pk2(acc[mt][nt][r], 0.f) & 0xffff);
                    }
        }
        if (transp) {
            const int tcb = (j >= 16) ? (cb - 1792) : (cb - 1280);
            const int b = m0 >> 12, u0 = m0 & 4095;
#pragma unroll
            for (int mt = 0; mt < 8; ++mt)
#pragma unroll
                for (int nt = 0; nt < 4; ++nt) {
                    const int tc = tcb + nt * 16 + fr;
                    const int u = u0 + wm * 128 + mt * 16 + fq * 4;
                    *(uint2*)(T + ((size_t)(b * TW + tc)) * UT + u) = uint2{pk2(acc[mt][nt][0], acc[mt][nt][1]), pk2(acc[mt][nt][2], acc[mt][nt][3])};
                }
        }
    }
}

DEV int map_col(int type, int n) {
    if (type == 0) return n;
    if (type == 1) {
        const int jb = n >> 5, r = n & 31;
        return r < 16 ? jb * 16 + r : DFF + jb * 16 + (r - 16);
    }
    if (n < 256) return 1552 + n;
    if (n < 640) return 2064 + (n - 256);
    if (n < 1024) return 2448 + (n - 640);
    if (n < 1280) return 1808 + (n - 1024);
    if (n < 1536) return (n - 1280);
    if (n < 1920) return 528 + (n - 1536);
    if (n < 2048) return 1296 + (n - 1920);
    if (n < 2304) return 256 + (n - 2048);
    if (n < 2688) return 912 + (n - 2304);
    if (n < 2816) return 1424 + (n - 2688);
    if (n < 2832) return 512 + (n - 2816);
    if (n < 2944) return -1;
    return 2832 + (n - 2944);
}

DEV void conv_tile(const float* __restrict__ src, int ld_src, int type, u16* __restrict__ dst, int ld_dst, int k_off, int kt, int ntile, char* smem, int tid) {
    float* lds = (float*)smem;
    const int k0 = kt * 64, n0 = ntile * 64;
    {
        const int r = tid >> 6, c = tid & 63;
        const int col = map_col(type, n0 + c);
#pragma unroll 4
        for (int i = 0; i < 16; ++i) {
            const int k = r + 4 * i;
            float v = 0.f;
            if (col >= 0) v = src[(size_t)(k0 + k) * ld_src + col];
            lds[k * 65 + c] = v;
        }
    }
    __syncthreads();
    {
        const int n = tid >> 2, kq = tid & 3;
        uint32_t w[8];
#pragma unroll
        for (int j = 0; j < 8; ++j) w[j] = pk2(lds[(kq * 16 + 2 * j) * 65 + n], lds[(kq * 16 + 2 * j + 1) * 65 + n]);
        u16* d = dst + (size_t)(n0 + n) * ld_dst + k_off + k0 + kq * 16;
        *(uint4*)d = uint4{w[0], w[1], w[2], w[3]};
        *(uint4*)(d + 8) = uint4{w[4], w[5], w[6], w[7]};
    }
    __syncthreads();
}

DEV void ph_prep(const Params& p, int l, char* smem, int bid, int G) {
    u16* W = WSP(u16, OFF_W);
    const int tid = VTID;
    constexpr int N_CONV = 6240, N_MODS = 288;
    for (int it = bid; it < N_CONV + N_MODS; it += G) {
        if (it < N_CONV) {
            int r = it;
            if (r < 2816) {
                const int which = r / 1408; r -= which * 1408;
                conv_tile(p.ffn_w_in + (size_t)(l * 2 + which) * 1024 * 5632, 5632, 1, W + (which ? WE_IN1 : WE_IN0), 1024, 0, r / 88, r % 88, smem, tid);
                continue;
            }
            r -= 2816;
            if (r < 1408) {
                const int which = r / 704; r -= which * 704;
                conv_tile(p.ffn_w_out + (size_t)(l * 2 + which) * 2816 * 1024, 1024, 0, W + (which ? WE_OUT1 : WE_OUT0), 2816, 0, r / 16, r % 16, smem, tid);
                continue;
            }
            r -= 1408;
            if (r < 1504) {
                conv_tile(p.mix_w_in + (size_t)l * 1024 * NIN, NIN, 2, W + WE_MIX, 1024, 0, r / 94, r % 94, smem, tid);
                continue;
            }
            r -= 1504;
            if (r < 64) { conv_tile(p.w_br_ml + (size_t)l * 256 * 1024, 1024, 0, W + WE_BR, 1024, 0, r / 16, r % 16, smem, tid); continue; }
            r -= 64;
            if (r < 96) { conv_tile(p.w_br_na + (size_t)l * 384 * 1024, 1024, 0, W + WE_BR, 1024, 256, r / 16, r % 16, smem, tid); continue; }
            r -= 96;
            if (r < 96) { conv_tile(p.w_br_gq + (size_t)l * 384 * 1024, 1024, 0, W + WE_BR, 1024, 640, r / 16, r % 16, smem, tid); continue; }
            r -= 96;
            conv_tile(p.w_out + (size_t)l * 1024 * 1024, 1024, 0, W + WE_O, 1024, 0, r / 16, r % 16, smem, tid);
        } else {
            const int cb = it - N_CONV;
            float* s = (float*)smem;
            float* red = s + 9 * 1024;
            for (int i = tid; i < 9 * 1024; i += 256) {
                const int b = i >> 10, k = i & 1023;
                const float v = b < 8 ? p.c[b * 1024 + k] : p.c_ctx[k];
                s[i] = v * sigmoidf_(v);
            }
            __syncthreads();
            const int kg = tid >> 5, c = tid & 31, col = cb * 32 + c;
            float a[9];
#pragma unroll
            for (int b = 0; b < 9; ++b) a[b] = 0.f;
            const float* wp = p.ada_w + (size_t)l * 1024 * 9216 + (size_t)(kg * 128) * 9216 + col;
#pragma unroll 8
            for (int k = 0; k < 128; ++k) {
                const float w = wp[(size_t)k * 9216];
#pragma unroll
                for (int b = 0; b < 9; ++b) a[b] += s[b * 1024 + kg * 128 + k] * w;
            }
#pragma unroll
            for (int b = 0; b < 9; ++b) red[(kg * 9 + b) * 32 + c] = a[b];
            __syncthreads();
            for (int i = tid; i < 288; i += 256) {
                const int b = i >> 5, cc = i & 31;
                float v = p.ada_b[l * 9216 + cb * 32 + cc];
#pragma unroll
                for (int g = 0; g < 8; ++g) v += red[(g * 9 + b) * 32 + cc];
                WSP(float, OFF_MODS)[b * 9216 + cb * 32 + cc] = v;
            }
            __syncthreads();
        }
    }
    if (l == 0) {
        const size_t gt = (size_t)bid * 256 + tid, gs = (size_t)G * 256;
        const float4* cs = (const float4*)p.ctx; float4* cd = WSP(float4, OFF_XC);
        for (size_t i = gt; i < (size_t)NCX * D / 4; i += gs) cd[i] = cs[i];
        float* rope = WSP(float, OFF_ROPE);
        for (size_t i = gt; i < (size_t)4096 * 32; i += gs) {
            const int t = (int)(i >> 5), f = (int)(i & 31);
            const float pos = (float)((f < 16) ? (t >> 6) : (t & 63));
            const float inv = powf(10000.f, -(float)(f & 15) / 16.f);
            float sn, cs_;
            sincosf(pos * inv, &sn, &cs_);
            rope[i * 2] = cs_;
            rope[i * 2 + 1] = sn;
        }
    }
}

DEV void ph_mod(const Params& p, int l, int sub, int nrows, int bid, int G) {
    const bool first = (l == 0 && sub == 0);
    const int lane = VTID & 63, gw = bid * 4 + (VTID >> 6), NW = G * 4;
    const float* nw = p.norm_w + (size_t)(l * 3 + sub) * 1024;
    const float* mods = WSP(float, OFF_MODS);
    u16* H = WSP(u16, OFF_H);
    for (int r = gw; r < nrows; r += NW) {
        const float* xr = r < NL ? (first ? p.x : p.out) + (size_t)r * D : (first ? p.ctx : WSP(float, OFF_XC)) + (size_t)(r - NL) * D;
        const int b9 = r < NL ? (r >> 12) : 8;
        const float* sh = mods + b9 * 9216 + (3 * sub) * 1024;
        const float* sc = sh + 1024;
        float4 v[4];
        float ss = 0.f;
#pragma unroll
        for (int j = 0; j < 4; ++j) {
            v[j] = *(const float4*)(xr + lane * 4 + 256 * j);
            ss += v[j].x * v[j].x + v[j].y * v[j].y + v[j].z * v[j].z + v[j].w * v[j].w;
        }
        ss = wave_sum(ss);
        const float rstd = rsqrtf(ss * (1.f / 1024.f) + 1e-6f);
#pragma unroll
        for (int j = 0; j < 4; ++j) {
            const int k = lane * 4 + 256 * j;
            const float4 w = *(const float4*)(nw + k), s1 = *(const float4*)(sc + k), s0 = *(const float4*)(sh + k);
            const float y0 = v[j].x * rstd * w.x * (1.f + s1.x) + s0.x;
            const float y1 = v[j].y * rstd * w.y * (1.f + s1.y) + s0.y;
            const float y2 = v[j].z * rstd * w.z * (1.f + s1.z) + s0.z;
            const float y3 = v[j].w * rstd * w.w * (1.f + s1.w) + s0.w;
            *(uint2*)(H + (size_t)r * D + k) = uint2{pk2(y0, y1), pk2(y2, y3)};
        }
    }
}

DEV void ph_ffn_in(const Params& p, int which, int mt0, int mtiles, char* smem, int vid, int G) {
    const u16* H = WSP(u16, OFF_H);
    const u16* Wt = WSP(u16, OFF_W) + (which ? WE_IN1 : WE_IN0);
    u16* ACT = WSP(u16, OFF_P);
    const int lane = VTID & 63, wave = VTID >> 6, wm = wave >> 1, wn = wave & 1, fr = lane & 15, fq = lane >> 4;
    const int total = mtiles * 44;
    for (int t = vid; t < total; t += G) {
        int mt_, nt_;
        tile_decode(t, 44, mt_, nt_);
        mt_ += mt0;
        const int m0 = mt_ * 128, n0 = nt_ * 128;
        f32x4 acc[4][4];
        zero_acc<4>(acc);
        gemm_accum<4>(acc, H + (size_t)m0 * D, D, Wt + (size_t)n0 * D, D, D, smem, VTID);
#pragma unroll
        for (int mt = 0; mt < 4; ++mt)
#pragma unroll
            for (int pp = 0; pp < 2; ++pp)
#pragma unroll
                for (int r = 0; r < 4; ++r) {
                    const int row = m0 + wm * 64 + mt * 16 + fq * 4 + r;
                    const int hid = (n0 >> 1) + wn * 32 + pp * 16 + fr;
                    const float g = acc[mt][2 * pp][r], u = acc[mt][2 * pp + 1][r];
                    const float v = g * sigmoidf_(g) * u;
                    ACT[(size_t)row * DFF + hid] = (u16)(pk2(v, 0.f) & 0xffff);
                }
    }
}

DEV void ph_resid(const Params& p, const u16* A, int lda, const u16* Wt, int K, int modidx, float coef, int mt0, int mtiles, char* smem, int vid, int G) {
    const float* mods = WSP(float, OFF_MODS);
    const int lane = VTID & 63, wave = VTID >> 6, wm = wave >> 1, wn = wave & 1, fr = lane & 15, fq = lane >> 4;
    const int total = mtiles * 8 * 4;
    const int Kc = K >> 2;
    for (int t = vid; t < total; t += G) {
        int mt_, nt_;
        const int ksp = t & 3;
        tile_decode(t >> 2, 8, mt_, nt_);
        mt_ += mt0;
        const int m0 = mt_ * 128, n0 = nt_ * 128;
        f32x4 acc[4][4];
        zero_acc<4>(acc);
        gemm_accum<4>(acc, A + (size_t)m0 * lda + ksp * Kc, lda, Wt + (size_t)n0 * K + ksp * Kc, K, Kc, smem, VTID);
        const int b9 = m0 < NL ? (m0 >> 12) : 8;
        const float* gp = mods + b9 * 9216 + modidx * 1024;
#pragma unroll
        for (int nt = 0; nt < 4; ++nt) {
            const int col = n0 + wn * 64 + nt * 16 + fr;
            const float gv = gp[col] * coef;
#pragma unroll
            for (int mt = 0; mt < 4; ++mt)
#pragma unroll
                for (int r = 0; r < 4; ++r) {
                    const int row = m0 + wm * 64 + mt * 16 + fq * 4 + r;
                    float* xp = (row < NL ? p.out + (size_t)row * D : WSP(float, OFF_XC) + (size_t)(row - NL) * D) + col;
                    __hip_atomic_fetch_add(xp, gv * acc[mt][nt][r], __ATOMIC_RELAXED, __HIP_MEMORY_SCOPE_AGENT);
                }
        }
    }
}

DEV void ph_pgemm(const Params& p, int mt0, int mtiles, char* smem, int vid, int G) {
    const u16* H = WSP(u16, OFF_H);
    const u16* Wt = WSP(u16, OFF_W) + WE_MIX;
    u16* P = WSP(u16, OFF_P);
    u16* T = WSP(u16, OFF_T);
    float* Gt = WSP(float, OFF_G);
    const int lane = VTID & 63, wave = VTID >> 6, wm = wave >> 1, wn = wave & 1, fr = lane & 15, fq = lane >> 4;
    const int total = mtiles * 23;
    for (int t = vid; t < total; t += G) {
        int mt_, nt_;
        tile_decode(t, 23, mt_, nt_);
        mt_ += mt0;
        const int m0 = mt_ * 128, n0 = nt_ * 128;
        f32x4 acc[4][4];
        zero_acc<4>(acc);
        gemm_accum<4>(acc, H + (size_t)m0 * D, D, Wt + (size_t)n0 * D, D, D, smem, VTID);
        if (nt_ == 22) {
            if (wn == 0) {
#pragma unroll
                for (int mt = 0; mt < 4; ++mt)
#pragma unroll
                    for (int r = 0; r < 4; ++r) {
                        const int row = m0 + wm * 64 + mt * 16 + fq * 4 + r;
                        Gt[(size_t)row * 16 + fr] = acc[mt][0][r];
                    }
            }
            continue;
        }
        const bool rowmajor = nt_ < 16;
        const bool transp = (nt_ == 10) || (nt_ == 11) || (nt_ >= 16);
        if (rowmajor) {
#pragma unroll
            for (int mt = 0; mt < 4; ++mt)
#pragma unroll
                for (int nt = 0; nt < 4; ++nt)
#pragma unroll
                    for (int r = 0; r < 4; ++r) {
                        const int row = m0 + wm * 64 + mt * 16 + fq * 4 + r;
                        const int col = n0 + wn * 64 + nt * 16 + fr;
                        P[(size_t)row * PW + col] = (u16)(pk2(acc[mt][nt][r], 0.f) & 0xffff);
                    }
        }
        if (transp) {
            const int tcb = (nt_ >= 16) ? (n0 - 1792) : (n0 - 1280);
            int b, u0;
            if (m0 < NL) { b = m0 >> 12; u0 = m0 & 4095; } else { b = (m0 - NL) >> 8; u0 = SEQ + ((m0 - NL) & 255); }
#pragma unroll
            for (int mt = 0; mt < 4; ++mt)
#pragma unroll
                for (int nt = 0; nt < 4; ++nt) {
                    const int tc = tcb + wn * 64 + nt * 16 + fr;
                    const int u = u0 + wm * 64 + mt * 16 + fq * 4;
                    *(uint2*)(T + ((size_t)(b * TW + tc)) * UT + u) = uint2{pk2(acc[mt][nt][0], acc[mt][nt][1]), pk2(acc[mt][nt][2], acc[mt][nt][3])};
                }
        }
    }
}

DEV void ph_qknorm_gates(const Params& p, int l, int bid, int G) {
    const int lane = VTID & 63, gw = bid * 4 + (VTID >> 6), NW = G * 4;
    u16* P = WSP(u16, OFF_P);
    for (int it = gw; it < NSCAN * NCH; it += NW) {
        const int sc = it / NCH, c = it - sc * NCH, dir = sc & 1, h = (sc >> 1) & 3, b = sc >> 3;
        const float* Gt = WSP(float, OFF_G);
        float* BC = WSP(float, OFF_BC) + (size_t)sc * UT;
        float* IG = WSP(float, OFF_IG) + (size_t)sc * UT;
        float* WE = WSP(float, OFF_AE) + (size_t)sc * UT;
        const float bi = p.ml_gate_b[l * 16 + dir * 8 + h], bf = p.ml_gate_b[l * 16 + dir * 8 + 4 + h];
        const int cu = cu_of(c, dir);
        const int u = cu * 64 + (dir ? 63 - lane : lane);
        const int row = rowof(b, u);
        const float ig = Gt[(size_t)row * 16 + dir * 8 + h] + bi;
        const float fp = Gt[(size_t)row * 16 + dir * 8 + 4 + h] + bf;
        const float lf = fminf(fp, 0.f) - log1pf(expf(-fabsf(fp)));
        float bc = lf;
#pragma unroll
        for (int o = 1; o < 64; o <<= 1) { const float tv = __shfl_up(bc, o); if (lane >= o) bc += tv; }
        const float btot = __shfl(bc, 63);
        const float wend = btot - bc + ig;
        const float mx = wave_max(wend);
        WE[u] = wend;
        BC[u] = bc;
        IG[u] = ig;
        if (lane == 0) { WSP(float, OFF_MS)[sc * NCH + c] = btot; WSP(float, OFF_DEC)[sc * NCH + c] = mx; }
    }
    const float* rope = WSP(float, OFF_ROPE);
    const int hs = lane >> 4, e4 = (lane & 15) * 4;
    for (int r = gw; r < MTOT; r += NW) {
        const bool latent = r < NL;
        const int tok = r & 4095;
#pragma unroll
        for (int g = 0; g < 5; ++g) {
            const int cbase = (g < 3 ? 256 + g * 256 : 1536 + (g - 3) * 256) + hs * 64 + e4;
            const int slot = g * 4 + hs;
            u16* pp = P + (size_t)r * PW + cbase;
            const uint2 raw = *(const uint2*)pp;
            float v0 = bflo(raw.x), v1 = bfhi(raw.x), v2 = bflo(raw.y), v3 = bfhi(raw.y);
            float ss = v0 * v0 + v1 * v1 + v2 * v2 + v3 * v3;
            ss += __shfl_xor(ss, 1); ss += __shfl_xor(ss, 2); ss += __shfl_xor(ss, 4); ss += __shfl_xor(ss, 8);
            const float* wv;
            float scl;
            bool do_rope;
            if (slot < 6) { wv = p.na_qk_w + (l * 2 + 0) * 64; scl = 0.125f; do_rope = false; }
            else if (slot < 12) { wv = p.gq_qk_w + (l * 2 + 0) * 64; scl = 0.125f; do_rope = latent; }
            else if (slot < 18) { wv = p.na_qk_w + (l * 2 + 1) * 64; scl = 1.f; do_rope = false; }
            else { wv = p.gq_qk_w + (l * 2 + 1) * 64; scl = 1.f; do_rope = latent; }
            const float rstd = rsqrtf(ss * (1.f / 64.f) + 1e-6f) * scl;
            const float4 w4 = *(const float4*)(wv + e4);
            v0 *= rstd * w4.x; v1 *= rstd * w4.y; v2 *= rstd * w4.z; v3 *= rstd * w4.w;
            const float o0 = __shfl_xor(v0, 8), o1 = __shfl_xor(v1, 8), o2 = __shfl_xor(v2, 8), o3 = __shfl_xor(v3, 8);
            if (do_rope) {
                const int fi = e4 & 31;
                const float4 cs01 = *(const float4*)(rope + ((size_t)tok * 32 + fi) * 2);
                const float4 cs23 = *(const float4*)(rope + ((size_t)tok * 32 + fi + 2) * 2);
                if (e4 < 32) {
                    v0 = v0 * cs01.x - o0 * cs01.y; v1 = v1 * cs01.z - o1 * cs01.w;
                    v2 = v2 * cs23.x - o2 * cs23.y; v3 = v3 * cs23.z - o3 * cs23.w;
                } else {
                    v0 = o0 * cs01.y + v0 * cs01.x; v1 = o1 * cs01.w + v1 * cs01.z;
                    v2 = o2 * cs23.y + v2 * cs23.x; v3 = o3 * cs23.w + v3 * cs23.z;
                }
            }
            *(uint2*)pp = uint2{pk2(v0, v1), pk2(v2, v3)};
        }
    }
}

template <int MT, bool NAMASK, int NWV>
DEV void flash_item(const Params& p, int b, int qrow0, int qcol, int kcol, int tcol, int ua, int n1, int ub, int ntiles,
                    int r_q, int rs, const float* __restrict__ rpb_h, char* smem, int ocol, float mfix = 0.f) {
    u16* P = WSP(u16, OFF_P);
    const u16* T = WSP(u16, OFF_T);
    const int tid = (NWV == 8) ? (int)(threadIdx.x + p.z) : VTID, lane = tid & 63, wave = tid >> 6, fr = lane & 15, fq = lane >> 4;
    constexpr int KVS = 64 * 144;
    char* Ks = smem;
    char* Vs = smem + 2 * KVS;
    float* rpb_s = (float*)(smem + 4 * KVS);
    __syncthreads();
    if (NAMASK) {
        for (int i = tid; i < 465; i += 256) rpb_s[i] = rpb_h[i] * 1.4426950408889634f;
    }
    Frag qf[MT][2];
#pragma unroll
    for (int mt = 0; mt < MT; ++mt)
#pragma unroll
        for (int ks = 0; ks < 2; ++ks)
            qf[mt][ks].q = *(const uint4*)(P + (size_t)(qrow0 + (wave * MT + mt) * 16 + fr) * PW + qcol + ks * 32 + fq * 8);
    const int lr = tid >> 3, lc8 = tid & 7;
    u32x4 rk0, rk1 = {0, 0, 0, 0}, rv0, rv1 = {0, 0, 0, 0};
#define FL_GLOAD(KT) do { const int kt_ = (KT); const int u0_ = kt_ < n1 ? ua + 64 * kt_ : ub + 64 * (kt_ - n1); const int row0_ = rowof(b, u0_); \
        rk0 = gld16(P + (size_t)(row0_ + lr) * PW + kcol + lc8 * 8); rv0 = gld16(T + ((size_t)(b * TW + tcol + lr)) * UT + u0_ + lc8 * 8); \
        if (NWV == 4) { rk1 = gld16(P + (size_t)(row0_ + lr + 32) * PW + kcol + lc8 * 8); rv1 = gld16(T + ((size_t)(b * TW + tcol + lr + 32)) * UT + u0_ + lc8 * 8); } } while (0)
#define FL_SSTORE(S) do { const int s_ = (S); \
        *(u32x4*)(Ks + s_ * KVS + lr * 144 + lc8 * 16) = rk0; *(u32x4*)(Vs + s_ * KVS + lr * 144 + lc8 * 16) = rv0; \
        if (NWV == 4) { *(u32x4*)(Ks + s_ * KVS + (lr + 32) * 144 + lc8 * 16) = rk1; *(u32x4*)(Vs + s_ * KVS + (lr + 32) * 144 + lc8 * 16) = rv1; } } while (0)
    FL_GLOAD(0);
    VM_WAIT0();
    FL_SSTORE(0);
    __syncthreads();
    f32x4 o[MT][4];
    float mrow[MT], lrow[MT];
#pragma unroll
    for (int mt = 0; mt < MT; ++mt) {
        mrow[mt] = -1e30f; lrow[mt] = 0.f;
#pragma unroll
        for (int dt = 0; dt < 4; ++dt) o[mt][dt] = f32x4{0.f, 0.f, 0.f, 0.f};
    }
    const float L2E = 1.4426950408889634f;
    for (int kt = 0; kt < ntiles; ++kt) {
        const int cur = kt & 1;
        const bool more = kt + 1 < ntiles;
        FL_GLOAD(more ? kt + 1 : kt);
        __builtin_amdgcn_sched_barrier(0);
        f32x4 s[MT][4];
#pragma unroll
        for (int mt = 0; mt < MT; ++mt)
#pragma unroll
            for (int nt = 0; nt < 4; ++nt) s[mt][nt] = f32x4{0.f, 0.f, 0.f, 0.f};
#pragma unroll
        for (int ks = 0; ks < 2; ++ks)
#pragma unroll
            for (int nt = 0; nt < 4; ++nt) {
                const bf16x8 kf = *(const bf16x8*)(Ks + cur * KVS + (nt * 16 + fr) * 144 + (ks * 32 + fq * 8) * 2);
#pragma unroll
                for (int mt = 0; mt < MT; ++mt) s[mt][nt] = mfma16(kf, qf[mt][ks].v, s[mt][nt]);
            }
        Frag pf[MT][2];
#pragma unroll
        for (int mt = 0; mt < MT; ++mt) {
            if (NAMASK && kt < 8) {
                const int qc = (wave * MT + mt) * 16 + fr;
                int cs = qc - 8; cs = cs < 0 ? 0 : (cs > 48 ? 48 : cs);
                const int brow = rs + kt - r_q + 7;
#pragma unroll
                for (int nt = 0; nt < 4; ++nt)
#pragma unroll
                    for (int r = 0; r < 4; ++r) {
                        const int kc = nt * 16 + fq * 4 + r;
                        const bool valid = (kc >= cs) && (kc < cs + 16);
                        const int bi = valid ? brow * 31 + (kc - qc + 15) : 0;
                        s[mt][nt][r] = valid ? s[mt][nt][r] * L2E + rpb_s[bi] : -1e30f;
                    }
            } else if (NAMASK) {
#pragma unroll
                for (int nt = 0; nt < 4; ++nt)
#pragma unroll
                    for (int r = 0; r < 4; ++r) s[mt][nt][r] *= L2E;
            }
            if (NAMASK) {
                float mx = -1e30f;
#pragma unroll
                for (int nt = 0; nt < 4; ++nt)
#pragma unroll
                    for (int r = 0; r < 4; ++r) mx = fmaxf(mx, s[mt][nt][r]);
                mx = xq_max(mx);
                const float mnew = fmaxf(mrow[mt], mx);
                const float alpha = fexp2(mrow[mt] - mnew);
                float rsum = 0.f;
#pragma unroll
                for (int nt = 0; nt < 4; ++nt)
#pragma unroll
                    for (int r = 0; r < 4; ++r) { const float e = fexp2(s[mt][nt][r] - mnew); s[mt][nt][r] = e; rsum += e; }
                rsum = xq_sum(rsum);
                lrow[mt] = lrow[mt] * alpha + rsum;
                mrow[mt] = mnew;
#pragma unroll
                for (int dt = 0; dt < 4; ++dt) o[mt][dt] *= alpha;
            } else {
                float rsum = 0.f;
#pragma unroll
                for (int nt = 0; nt < 4; ++nt)
#pragma unroll
                    for (int r = 0; r < 4; ++r) { const float e = fexp2(fmaf(s[mt][nt][r], L2E, -mfix)); s[mt][nt][r] = e; rsum += e; }
                lrow[mt] += rsum;
            }
#pragma unroll
            for (int ks = 0; ks < 2; ++ks) {
                pf[mt][ks].u[0] = pk2(s[mt][2 * ks][0], s[mt][2 * ks][1]);
                pf[mt][ks].u[1] = pk2(s[mt][2 * ks][2], s[mt][2 * ks][3]);
                pf[mt][ks].u[2] = pk2(s[mt][2 * ks + 1][0], s[mt][2 * ks + 1][1]);
                pf[mt][ks].u[3] = pk2(s[mt][2 * ks + 1][2], s[mt][2 * ks + 1][3]);
            }
        }
#pragma unroll
        for (int ks = 0; ks < 2; ++ks)
#pragma unroll
            for (int dt = 0; dt < 4; ++dt) {
                Frag vf;
                vf.d[0] = *(const uint2*)(Vs + cur * KVS + (dt * 16 + fr) * 144 + (ks * 32 + fq * 4) * 2);
                vf.d[1] = *(const uint2*)(Vs + cur * KVS + (dt * 16 + fr) * 144 + (ks * 32 + 16 + fq * 4) * 2);
#pragma unroll
                for (int mt = 0; mt < MT; ++mt) o[mt][dt] = mfma16(vf.v, pf[mt][ks].v, o[mt][dt]);
            }
        __builtin_amdgcn_sched_barrier(0);
        VM_WAIT0();
        FL_SSTORE(cur ^ 1);
        __syncthreads();
    }
#pragma unroll
    for (int mt = 0; mt < MT; ++mt) {
        const float inv = 1.f / (NAMASK ? lrow[mt] : xq_sum(lrow[mt]));
        u16* op = P + (size_t)(qrow0 + (wave * MT + mt) * 16 + fr) * PW + ocol;
#pragma unroll
        for (int dt = 0; dt < 4; ++dt)
            *(uint2*)(op + dt * 16 + fq * 4) = uint2{pk2(o[mt][dt][0] * inv, o[mt][dt][1] * inv), pk2(o[mt][dt][2] * inv, o[mt][dt][3] * inv)};
    }
}


DEV void m2_item(const Params& p, int sc, int c) {
    const u16* T = WSP(u16, OFF_T);
    const int lane = VTID & 63, wave = VTID >> 6, fr = lane & 15, fq = lane >> 4;
    const int dir = sc & 1, h = (sc >> 1) & 3, b = sc >> 3;
    const int u0 = cu_of(c, dir) * 64;
    const float* AE = WSP(float, OFF_AE) + (size_t)sc * UT + u0;
    float* S = WSP(float, OFF_S) + ((size_t)sc * NCH + c) * SCH;
    const float mnew = fmaxf(WSP(float, OFF_MS)[sc * NCH + c] + m_scan(p, sc, c), WSP(float, OFF_DEC)[sc * NCH + c]);
    f32x4 acc[4], accn[4];
#pragma unroll
    for (int nt = 0; nt < 4; ++nt) { acc[nt] = f32x4{0.f, 0.f, 0.f, 0.f}; accn[nt] = f32x4{0.f, 0.f, 0.f, 0.f}; }
    Frag ones;
    ones.u[0] = ones.u[1] = ones.u[2] = ones.u[3] = 0x3F803F80u;
#pragma unroll
    for (int ks = 0; ks < 2; ++ks) {
        Frag vf;
        vf.q = *(const uint4*)(T + ((size_t)(b * TW + TC_MLV + h * 64 + wave * 16 + fr)) * UT + u0 + ks * 32 + fq * 8);
        float4 a0 = *(const float4*)(AE + ks * 32 + fq * 8), a1 = *(const float4*)(AE + ks * 32 + fq * 8 + 4);
        a0.x = expf(a0.x - mnew); a0.y = expf(a0.y - mnew); a0.z = expf(a0.z - mnew); a0.w = expf(a0.w - mnew);
        a1.x = expf(a1.x - mnew); a1.y = expf(a1.y - mnew); a1.z = expf(a1.z - mnew); a1.w = expf(a1.w - mnew);
#pragma unroll
        for (int nt = 0; nt < 4; ++nt) {
            Frag kf, kb;
            kf.q = *(const uint4*)(T + ((size_t)(b * TW + TC_MLK + h * 64 + nt * 16 + fr)) * UT + u0 + ks * 32 + fq * 8);
            kb.u[0] = pk2(bflo(kf.u[0]) * a0.x * 0.125f, bfhi(kf.u[0]) * a0.y * 0.125f);
            kb.u[1] = pk2(bflo(kf.u[1]) * a0.z * 0.125f, bfhi(kf.u[1]) * a0.w * 0.125f);
            kb.u[2] = pk2(bflo(kf.u[2]) * a1.x * 0.125f, bfhi(kf.u[2]) * a1.y * 0.125f);
            kb.u[3] = pk2(bflo(kf.u[3]) * a1.z * 0.125f, bfhi(kf.u[3]) * a1.w * 0.125f);
            acc[nt] = mfma16(vf.v, kb.v, acc[nt]);
            if (wave == 0) accn[nt] = mfma16(ones.v, kb.v, accn[nt]);
        }
    }
#pragma unroll
    for (int nt = 0; nt < 4; ++nt) {
#pragma unroll
        for (int r = 0; r < 4; ++r) S[(wave * 16 + fq * 4 + r) * 64 + nt * 16 + fr] = acc[nt][r];
        if (wave == 0 && fq == 0) S[4096 + nt * 16 + fr] = accn[nt][0];
    }
}

DEV void ph_m3(const Params& p, int bid, int G) {
    const float* DEC = WSP(float, OFF_DEC);
    float* S = WSP(float, OFF_S);
    const int total = NSCAN * SCH;
    for (int i = bid * 256 + VTID; i < total; i += G * 256) {
        const int sc = i / SCH, e = i - sc * SCH;
        float* base = S + (size_t)sc * NCH * SCH + e;
        const float* mxp = DEC + sc * NCH;
        const float* btp = WSP(float, OFF_MS) + sc * NCH;
        float st = 0.f, m = 0.f;
#pragma unroll 4
        for (int c = 0; c < NCH; ++c) {
            const float tmp = base[(size_t)c * SCH];
            base[(size_t)c * SCH] = st;
            const float bm = btp[c] + m;
            const float mnew = fmaxf(bm, mxp[c]);
            st = expf(bm - mnew) * st + tmp;
            m = mnew;
        }
    }
}

DEV void m4_item(const Params& p, int l, int b, int h, int cu, int ocolbase) {
    u16* P = WSP(u16, OFF_P);
    const u16* T = WSP(u16, OFF_T);
    const int lane = VTID & 63, wave = VTID >> 6, fr = lane & 15, fq = lane >> 4;
    const int u0 = cu * 64;
    const int row0 = rowof(b, u0);
    const int j = wave * 16 + fr;
    Frag qf[2];
#pragma unroll
    for (int ks = 0; ks < 2; ++ks) qf[ks].q = *(const uint4*)(P + (size_t)(row0 + j) * PW + PC_MLQ + h * 64 + ks * 32 + fq * 8);
    f32x4 hsum[4];
#pragma unroll
    for (int dt = 0; dt < 4; ++dt) hsum[dt] = f32x4{0.f, 0.f, 0.f, 0.f};
#pragma unroll 1
    for (int dir = 0; dir < 2; ++dir) {
        const int sc = (b * 4 + h) * 2 + dir;
        int c;
        if (cu >= 64) c = dir ? 3 - (cu - 64) : (cu - 64); else c = 4 + (dir ? 63 - cu : cu);
        const float m0 = m_scan(p, sc, c);
        const float* BC = WSP(float, OFF_BC) + (size_t)sc * UT + u0;
        const float* IG = WSP(float, OFF_IG) + (size_t)sc * UT + u0;
        const float* S = WSP(float, OFF_S) + ((size_t)sc * NCH + c) * SCH;
        const float bj = BC[j];
        f32x4 s[4];
#pragma unroll
        for (int nt = 0; nt < 4; ++nt) s[nt] = f32x4{0.f, 0.f, 0.f, 0.f};
#pragma unroll
        for (int ks = 0; ks < 2; ++ks)
#pragma unroll
            for (int nt = 0; nt < 4; ++nt) {
                Frag kf;
                kf.q = *(const uint4*)(P + (size_t)(row0 + nt * 16 + fr) * PW + PC_MLK + h * 64 + ks * 32 + fq * 8);
                s[nt] = mfma16(kf.v, qf[ks].v, s[nt]);
            }
        float lw[4][4];
        float mx = -1e30f;
#pragma unroll
        for (int nt = 0; nt < 4; ++nt) {
            const float4 bs = *(const float4*)(BC + nt * 16 + fq * 4);
            const float4 is = *(const float4*)(IG + nt * 16 + fq * 4);
            const float bsv[4] = {bs.x, bs.y, bs.z, bs.w}, isv[4] = {is.x, is.y, is.z, is.w};
#pragma unroll
            for (int r = 0; r < 4; ++r) {
                const int sidx = nt * 16 + fq * 4 + r;
                const bool valid = dir ? (sidx >= j) : (sidx <= j);
                lw[nt][r] = valid ? (bj - bsv[r] + isv[r]) : -1e30f;
                mx = fmaxf(mx, lw[nt][r]);
            }
        }
        mx = xq_max(mx);
        const float minter = bj + m0;
        const float mj = fmaxf(minter, mx);
        const float g = fexp(minter - mj);
        float den = 0.f;
#pragma unroll
        for (int nt = 0; nt < 4; ++nt)
#pragma unroll
            for (int r = 0; r < 4; ++r) {
                const float w = fexp(lw[nt][r] - mj);
                const float qk = s[nt][r] * 0.125f * w;
                s[nt][r] = qk;
                den += qk;
            }
        den = xq_sum(den);
        Frag pf[2];
#pragma unroll
        for (int ks = 0; ks < 2; ++ks) {
            pf[ks].u[0] = pk2(s[2 * ks][0], s[2 * ks][1]);
            pf[ks].u[1] = pk2(s[2 * ks][2], s[2 * ks][3]);
            pf[ks].u[2] = pk2(s[2 * ks + 1][0], s[2 * ks + 1][1]);
            pf[ks].u[3] = pk2(s[2 * ks + 1][2], s[2 * ks + 1][3]);
        }
        f32x4 acc[4], accn = f32x4{0.f, 0.f, 0.f, 0.f};
#pragma unroll
        for (int dt = 0; dt < 4; ++dt) acc[dt] = f32x4{0.f, 0.f, 0.f, 0.f};
#pragma unroll
        for (int ks = 0; ks < 2; ++ks) {
            {
                const float4 n0 = *(const float4*)(S + 4096 + ks * 32 + fq * 8), n1 = *(const float4*)(S + 4096 + ks * 32 + fq * 8 + 4);
                Frag nf;
                nf.u[0] = pk2(n0.x, n0.y); nf.u[1] = pk2(n0.z, n0.w); nf.u[2] = pk2(n1.x, n1.y); nf.u[3] = pk2(n1.z, n1.w);
                accn = mfma16(nf.v, qf[ks].v, accn);
            }
#pragma unroll
            for (int dt = 0; dt < 4; ++dt) {
                const float* cp = S + (dt * 16 + fr) * 64 + ks * 32 + fq * 8;
                const float4 c0 = *(const float4*)cp, c1 = *(const float4*)(cp + 4);
                Frag cf;
                cf.u[0] = pk2(c0.x, c0.y); cf.u[1] = pk2(c0.z, c0.w); cf.u[2] = pk2(c1.x, c1.y); cf.u[3] = pk2(c1.z, c1.w);
                acc[dt] = mfma16(cf.v, qf[ks].v, acc[dt]);
            }
        }
#pragma unroll
        for (int dt = 0; dt < 4; ++dt) acc[dt] *= g;
        den += g * accn[0];
#pragma unroll
        for (int ks = 0; ks < 2; ++ks)
#pragma unroll
            for (int dt = 0; dt < 4; ++dt) {
                const u16* vp = T + ((size_t)(b * TW + TC_MLV + h * 64 + dt * 16 + fr)) * UT + u0 + ks * 32 + fq * 4;
                Frag vf;
                vf.d[0] = *(const uint2*)vp;
                vf.d[1] = *(const uint2*)(vp + 16);
                acc[dt] = mfma16(vf.v, pf[ks].v, acc[dt]);
            }
        const float dd = 1.f / fmaxf(fabsf(den), fexp(-mj));
#pragma unroll
        for (int dt = 0; dt < 4; ++dt) hsum[dt] += acc[dt] * dd;
    }
    float ss = 0.f;
#pragma unroll
    for (int dt = 0; dt < 4; ++dt)
#pragma unroll
        for (int r = 0; r < 4; ++r) ss += hsum[dt][r] * hsum[dt][r];
    ss = xq_sum(ss);
    const float rstd = rsqrtf(ss * (1.f / 64.f) + 1e-6f);
    const float* nw = p.ml_norm_w + l * 256 + h * 64;
    u16* orow = P + (size_t)(row0 + j) * PW;
#pragma unroll
    for (int dt = 0; dt < 4; ++dt) {
        const int v0 = dt * 16 + fq * 4;
        const float4 w4 = *(const float4*)(nw + v0);
        const uint2 og = *(const uint2*)(orow + PC_MLO + h * 64 + v0);
        const float y0 = hsum[dt][0] * rstd * w4.x * sigmoidf_(bflo(og.x));
        const float y1 = hsum[dt][1] * rstd * w4.y * sigmoidf_(bfhi(og.x));
        const float y2 = hsum[dt][2] * rstd * w4.z * sigmoidf_(bflo(og.y));
        const float y3 = hsum[dt][3] * rstd * w4.w * sigmoidf_(bfhi(og.y));
        *(uint2*)(orow + ocolbase + h * 64 + v0) = uint2{pk2(y0, y1), pk2(y2, y3)};
    }
}

DEV void ph_attn8(const Params& p, int l, char* smem0, int rbid, int RG) {
    const int n_gq = 768, n_c = (l == 0) ? 96 : 0;
    const int ln_ = (int)((threadIdx.x + p.z) & 63);
    const float bgq = 8.f * wave_max(fabsf(p.gq_qk_w[(l * 2 + 0) * 64 + ln_])) * wave_max(fabsf(p.gq_qk_w[(l * 2 + 1) * 64 + ln_])) * 1.4426950408889634f * 1.03f + 0.5f;
    const float bna = 8.f * wave_max(fabsf(p.na_qk_w[(l * 2 + 0) * 64 + ln_])) * wave_max(fabsf(p.na_qk_w[(l * 2 + 1) * 64 + ln_])) * 1.4426950408889634f * 1.03f + 0.5f;
    for (int it = rbid; it < n_gq + n_c; it += RG) {
        float mfix = bgq;
        int b, qrow0, qcol, kcol, tcol, ua, nt;
        if (it < n_gq) {
            const int qt = it & 15, hq = (it >> 4) % 6;
            b = it / 96; qrow0 = b * SEQ + qt * 256; qcol = PC_GQQ + hq * 64; kcol = PC_GQK + (hq / 3) * 64; tcol = TC_GQV + (hq / 3) * 64; ua = 0; nt = 68;
        } else {
            const int r = it - n_gq;
            const int kind = r / 48, rr = r % 48, hh = rr % 6;
            b = rr / 6; qrow0 = NL + b * CTXL; ua = SEQ; nt = 4;
            if (kind == 0) { qcol = PC_GQQ + hh * 64; kcol = PC_GQK + (hh / 3) * 64; tcol = TC_GQV + (hh / 3) * 64; }
            else { qcol = PC_NAQ + hh * 64; kcol = PC_NAK + hh * 64; tcol = TC_NAV + hh * 64; mfix = bna; }
        }
        flash_item<2, false, 8>(p, b, qrow0, qcol, kcol, tcol, ua, nt, 0, nt, 0, 0, nullptr, smem0, qcol, mfix);
    }
}
DEV void ph_attn(const Params& p, int l, char* smem, int bid, int G, int rep) {
    const int n_na = 3072, n_m2 = NSCAN * NCH;
    const int total = n_na + n_m2;
    for (int it = bid; it < total; it += G) {
        int r = it;
        if (r < n_na) {
            const int gr = r & 63, hn = (r >> 6) % 6, b = r / 384;
            int rs = gr - 4; rs = rs < 0 ? 0 : (rs > 56 ? 56 : rs);
            flash_item<1, true, 4>(p, b, b * SEQ + gr * 64, PC_NAQ + hn * 64, PC_NAK + hn * 64, TC_NAV + hn * 64, rs * 64, 8, SEQ, 12, gr, rs,
                                p.na_rpb + (size_t)(l * 6 + hn) * 465, smem, PC_NAQ + hn * 64 + (rep ? 1792 : 0));
            continue;
        }
        r -= n_na;
        m2_item(p, r / NCH, r % NCH);
    }
}

DEV void ph_m4(const Params& p, int l, int bid, int G, int rep) {
    const int nch = (l == 0) ? NCH : 64;
    const int total = NB * 4 * nch;
    for (int it = bid; it < total; it += G) {
        const int cu = it % nch, h = (it / nch) & 3, b = it / (nch * 4);
        m4_item(p, l, b, h, cu, rep ? 2048 : PC_MLQ);
    }
}

DEV void ph_merge(const Params& p, int mt0, int mtiles, char* smem, int vid, int G) {
    const u16* H = WSP(u16, OFF_H);
    u16* P = WSP(u16, OFF_P);
    const u16* Wg = WSP(u16, OFF_W) + WE_MIX + (size_t)2944 * 1024;
    const u16* Wbr = WSP(u16, OFF_W) + WE_BR;
    const int lane = VTID & 63, wave = VTID >> 6, wm = wave >> 1, wn = wave & 1, fr = lane & 15, fq = lane >> 4;
    const int total = mtiles * 16;
    for (int t = vid; t < total; t += G) {
        int mt_, nt_;
        tile_decode(t, 16, mt_, nt_);
        mt_ += mt0;
        const int m0 = mt_ * 128, n0 = nt_ * 64;
        f32x4 y[4][2];
        zero_acc<2>(y);
#pragma unroll 1
        for (int br = 0; br < 3; ++br) {
            const int ko = br == 0 ? 0 : (br == 1 ? 256 : 640);
            const int kk = br == 0 ? 256 : 384;
            f32x4 g[4][2];
            zero_acc<2>(g);
            gemm_accum<2>(g, H + (size_t)m0 * D, D, Wg + (size_t)(br * 1024 + n0) * D, D, D, smem, VTID);
#pragma unroll
            for (int i = 0; i < 4; ++i)
#pragma unroll
                for (int jn = 0; jn < 2; ++jn)
#pragma unroll
                    for (int r = 0; r < 4; ++r) g[i][jn][r] = sigmoidf_(g[i][jn][r]);
            f32x4 a[4][2];
            zero_acc<2>(a);
            gemm_accum<2>(a, P + (size_t)m0 * PW + ko, PW, Wbr + (size_t)n0 * D + ko, D, kk, smem, VTID);
#pragma unroll
            for (int i = 0; i < 4; ++i)
#pragma unroll
                for (int jn = 0; jn < 2; ++jn) y[i][jn] += g[i][jn] * a[i][jn];
        }
#pragma unroll
        for (int mt = 0; mt < 4; ++mt)
#pragma unroll
            for (int nt = 0; nt < 2; ++nt)
#pragma unroll
                for (int r = 0; r < 4; ++r) {
                    const int row = m0 + wm * 64 + mt * 16 + fq * 4 + r;
                    const int col = n0 + wn * 32 + nt * 16 + fr;
                    P[(size_t)row * PW + PC_Y + col] = (u16)(pk2(y[mt][nt][r], 0.f) & 0xffff);
                }
    }
}


#ifdef DBG
constexpr size_t OFF_DBG = al256(WS_END);
__global__ void __launch_bounds__(64) dbg_mlstm(Params p, int l) {
    const int sc = blockIdx.x, dir = sc & 1, h = (sc >> 1) & 3, b = sc >> 3, lane = VTID;
    const u16* P = WSP(u16, OFF_P); const u16* T = WSP(u16, OFF_T); const float* Gt = WSP(float, OFF_G);
    float* HN = WSP(float, OFF_S) + (size_t)sc * UT * 64;
    const float bi = p.ml_gate_b[l * 16 + dir * 8 + h], bf = p.ml_gate_b[l * 16 + dir * 8 + 4 + h];
    float C[64], n[64];
    for (int k = 0; k < 64; ++k) { C[k] = 0.f; n[k] = 0.f; }
    float m = 0.f;
    for (int pos = 0; pos < UT; ++pos) {
        int u;
        if (pos < 256) u = SEQ + (dir ? 255 - pos : pos); else u = dir ? 4095 - (pos - 256) : (pos - 256);
        const int row = rowof(b, u);
        const float ig = Gt[(size_t)row * 16 + dir * 8 + h] + bi;
        const float fp = Gt[(size_t)row * 16 + dir * 8 + 4 + h] + bf;
        const float lf = fminf(fp, 0.f) - log1pf(expf(-fabsf(fp)));
        const float mn = fmaxf(lf + m, ig);
        const float fw = expf(lf + m - mn), iw = expf(ig - mn);
        m = mn;
        const float qv = __uint_as_float(((uint32_t)P[(size_t)row * PW + 2048 + h * 64 + lane]) << 16);
        const float kv = __uint_as_float(((uint32_t)P[(size_t)row * PW + PC_MLK + h * 64 + lane]) << 16) * 0.125f;
        const float vv = __uint_as_float(((uint32_t)T[((size_t)(b * TW + TC_MLV + h * 64 + lane)) * UT + u]) << 16);
        float num = 0.f, den = 0.f;
#pragma unroll
        for (int k = 0; k < 64; ++k) {
            const float kk = __shfl(kv, k), qq = __shfl(qv, k);
            C[k] = fw * C[k] + iw * kk * vv;
            n[k] = fw * n[k] + iw * kk;
            num += qq * C[k];
            den += qq * n[k];
        }
        HN[(size_t)u * 64 + lane] = num / fmaxf(fabsf(den), expf(-m));
    }
}
__global__ void dbg_cmp(Params p, int l) {
    const int gid = blockIdx.x * blockDim.x + VTID;
    const u16* P = WSP(u16, OFF_P); const u16* T = WSP(u16, OFF_T);
    unsigned* dw = (unsigned*)(p.ws + OFF_DBG);
    float* df = (float*)(p.ws + OFF_DBG);
    if (gid < NB * 4 * UT) {
        const int u = gid % UT, h = (gid / UT) & 3, b = gid / (UT * 4);
        const int row = rowof(b, u);
        const float* hf = WSP(float, OFF_S) + ((size_t)((b * 4 + h) * 2 + 0) * UT + u) * 64;
        const float* hb = WSP(float, OFF_S) + ((size_t)((b * 4 + h) * 2 + 1) * UT + u) * 64;
        float ss = 0.f;
        for (int v = 0; v < 64; ++v) { const float x = hf[v] + hb[v]; ss += x * x; }
        const float rstd = rsqrtf(ss / 64.f + 1e-6f);
        float md = 0.f;
        for (int v = 0; v < 64; ++v) {
            const float x = (hf[v] + hb[v]) * rstd * p.ml_norm_w[l * 256 + h * 64 + v];
            const float o = __uint_as_float(((uint32_t)P[(size_t)row * PW + PC_MLO + h * 64 + v]) << 16);
            const float y = x / (1.f + expf(-o));
            const float got = __uint_as_float(((uint32_t)P[(size_t)row * PW + PC_MLQ + h * 64 + v]) << 16);
            md += fabsf(y - got);
        }
        atomicAdd(df + (u < SEQ ? 0 : 1), md * (1.f / 64.f));
        return;
    }
    const int w = (gid - NB * 4 * UT) >> 6;
    const int lane = VTID & 63;
    int type, b, qrow, qc, kcol, tcol, ocol, hn = 0, gr = 0, gc = 0, nkeys;
    if (w < 6144) {
        type = 0; const int i = w & 127; hn = (w >> 7) % 6; b = w / 768;
        gr = i & 63; gc = (i < 64) ? gr : 63 - gr;
        qrow = b * SEQ + gr * 64 + gc; qc = 2048 + 256 + hn * 64; kcol = PC_NAK + hn * 64; tcol = TC_NAV + hn * 64; ocol = PC_NAQ + hn * 64; nkeys = 384;
    } else if (w < 6144 + 256) {
        type = 1; const int x = w - 6144; const int i = x & 15, hh = (x >> 4) & 1; b = x >> 5;
        qrow = b * SEQ + (i * 273) % 4096; qc = 2688 + hh * 64; kcol = PC_GQK + hh * 64; tcol = TC_GQV + hh * 64; ocol = PC_GQQ + hh * 3 * 64; nkeys = 4352;
    } else if (w < 6144 + 256 + 768) {
        type = 2; const int x = w - 6400; const int i = x & 15; hn = (x >> 4) % 6; b = x / 96;
        qrow = NL + b * CTXL + (i * 17) % 256; qc = 2048 + 256 + hn * 64; kcol = PC_NAK + hn * 64; tcol = TC_NAV + hn * 64; ocol = PC_NAQ + hn * 64; nkeys = 256;
    } else if (w < 6144 + 256 + 768 + 256) {
        type = 3; const int x = w - 7168; const int i = x & 15, hh = (x >> 4) & 1; b = x >> 5;
        qrow = NL + b * CTXL + (i * 17) % 256; qc = 2688 + hh * 64; kcol = PC_GQK + hh * 64; tcol = TC_GQV + hh * 64; ocol = PC_GQQ + hh * 3 * 64; nkeys = 256;
    } else return;
    const float q = __uint_as_float(((uint32_t)P[(size_t)qrow * PW + qc + lane]) << 16);
    float o = 0.f;
    int rs = gr - 4; rs = rs < 0 ? 0 : (rs > 56 ? 56 : rs);
    int cs = gc - 8; cs = cs < 0 ? 0 : (cs > 48 ? 48 : cs);
    float mx = -1e30f, lsum = 0.f;
    for (int kidx = 0; kidx < nkeys; ++kidx) {
        int u; float bias = 0.f;
        if (type == 0) {
            if (kidx < 128) {
                const int ri = kidx >> 4, ci = kidx & 15;
                u = (rs + ri) * 64 + cs + ci;
                bias = p.na_rpb[(size_t)(l * 6 + hn) * 465 + (rs + ri - gr + 7) * 31 + (cs + ci - gc + 15)];
            } else u = SEQ + (kidx - 128);
        } else if (type == 1) u = kidx;
        else u = SEQ + kidx;
        const int krow = rowof(b, u);
        float sdot = wave_sum(q * __uint_as_float(((uint32_t)P[(size_t)krow * PW + kcol + lane]) << 16));
        sdot += bias;
        const float mn = fmaxf(mx, sdot);
        const float al = expf(mx - mn), e = expf(sdot - mn);
        lsum = lsum * al + e; mx = mn;
        o = o * al + e * __uint_as_float(((uint32_t)T[((size_t)(b * TW + tcol + lane)) * UT + u]) << 16);
    }
    const float got = __uint_as_float(((uint32_t)P[(size_t)qrow * PW + ocol + lane]) << 16);
    float md = wave_max(fabsf(o / lsum - got));
    if (lane == 0) atomicMax(dw + 2 + type, __float_as_uint(md));
}
__global__ void dbg_copy(Params p) {
    u16* P = WSP(u16, OFF_P);
    for (size_t i = (size_t)blockIdx.x * 256 + VTID; i < (size_t)MTOT * 768; i += (size_t)gridDim.x * 256) {
        const size_t row = i / 768, c = i % 768;
        const size_t src = c < 640 ? c : (c < 704 ? PC_GQQ + (c - 640) : PC_GQQ + 192 + (c - 704));
        P[row * PW + 2048 + c] = P[row * PW + src];
    }
}
DEV int dbg_row(int sr) { return sr < 8 ? sr * 4096 + (sr * 577 + 13) % 4096 : NL + (sr - 8) * 256 + ((sr - 8) * 37 + 5) % 256; }
DEV float* dbg_xrow(const Params& p, int row) { return row < NL ? p.out + (size_t)row * D : WSP(float, OFF_XC) + (size_t)(row - NL) * D; }
DEV float dbg_mod(const Params& p, int l, int b9, int idx, int n) {
    float a = p.ada_b[l * 9216 + idx * 1024 + n];
    for (int k = 0; k < 1024; ++k) {
        const float c = b9 < 8 ? p.c[b9 * 1024 + k] : p.c_ctx[k];
        a += c / (1.f + expf(-c)) * p.ada_w[((size_t)l * 1024 + k) * 9216 + idx * 1024 + n];
    }
    return a;
}
DEV float blk_sum(float v, float* red) {
    v = wave_sum(v);
    __syncthreads();
    if ((VTID & 63) == 0) red[VTID >> 6] = v;
    __syncthreads();
    return red[0] + red[1] + red[2] + red[3];
}
DEV float blk_max(float v, float* red) {
    v = wave_max(v);
    __syncthreads();
    if ((VTID & 63) == 0) red[VTID >> 6] = v;
    __syncthreads();
    return fmaxf(fmaxf(red[0], red[1]), fmaxf(red[2], red[3]));
}
__global__ void dbg_save(Params p, int slot) {
    const int sr = blockIdx.x, row = dbg_row(sr);
    float* dst = (float*)(p.ws + OFF_DBG + 256) + ((size_t)slot * 16 + sr) * 1024;
    const float* src = dbg_xrow(p, row);
    for (int n = VTID; n < 1024; n += 256) dst[n] = src[n];
}
DEV float dbg_modulate(const Params& p, int l, int sub, int b9, const float* xs, float* hs, float* red) {
    float ss = 0.f;
    for (int n = VTID; n < 1024; n += 256) ss += xs[n] * xs[n];
    ss = blk_sum(ss, red);
    const float rstd = rsqrtf(ss / 1024.f + 1e-6f);
    float md = 0.f;
    for (int n = VTID; n < 1024; n += 256) {
        const float sh = dbg_mod(p, l, b9, 3 * sub, n), sc = dbg_mod(p, l, b9, 3 * sub + 1, n);
        md = fmaxf(md, fabsf(sh - WSP(float, OFF_MODS)[b9 * 9216 + (3 * sub) * 1024 + n]));
        md = fmaxf(md, fabsf(sc - WSP(float, OFF_MODS)[b9 * 9216 + (3 * sub + 1) * 1024 + n]));
        hs[n] = xs[n] * rstd * p.norm_w[(l * 3 + sub) * 1024 + n] * (1.f + sc) + sh;
    }
    __syncthreads();
    return md;
}
__global__ void __launch_bounds__(256) dbg_ffn(Params p, int l, int which, int slot, int bit) {
    __shared__ float xs[1024], hs[1024], gs[1024], as[2816], red[4];
    const int sr = blockIdx.x, row = dbg_row(sr), b9 = row < NL ? row >> 12 : 8, sub = which ? 2 : 0;
    const float* xin = (const float*)(p.ws + OFF_DBG + 256) + ((size_t)slot * 16 + sr) * 1024;
    for (int n = VTID; n < 1024; n += 256) xs[n] = xin[n];
    __syncthreads();
    float mdm = dbg_modulate(p, l, sub, b9, xs, hs, red);
    for (int n = VTID; n < 1024; n += 256) gs[n] = dbg_mod(p, l, b9, 3 * sub + 2, n);
    const float* win = p.ffn_w_in + (size_t)(l * 2 + which) * 1024 * 5632;
    const float* wout = p.ffn_w_out + (size_t)(l * 2 + which) * 2816 * 1024;
    for (int j = VTID; j < 2816; j += 256) {
        float g = 0.f, u = 0.f;
        for (int k = 0; k < 1024; ++k) { g += hs[k] * win[(size_t)k * 5632 + j]; u += hs[k] * win[(size_t)k * 5632 + 2816 + j]; }
        as[j] = g / (1.f + expf(-g)) * u;
    }
    __syncthreads();
    float md = 0.f;
    const float* xc = dbg_xrow(p, row);
    for (int n = VTID; n < 1024; n += 256) {
        float o = 0.f;
        for (int j = 0; j < 2816; ++j) o += as[j] * wout[(size_t)j * 1024 + n];
        md = fmaxf(md, fabsf(xs[n] + 0.5f * gs[n] * o - xc[n]));
    }
    md = blk_max(md, red);
    mdm = blk_max(mdm, red);
    unsigned* dw = (unsigned*)(p.ws + OFF_DBG);
    if (VTID == 0) { atomicMax(dw + bit, __float_as_uint(md)); atomicMax(dw + 15, __float_as_uint(mdm)); }
}
__global__ void __launch_bounds__(256) dbg_pchk(Params p, int l) {
    __shared__ float xs[1024], hs[1024], red[4];
    const int sr = blockIdx.x, row = dbg_row(sr), b9 = row < NL ? row >> 12 : 8;
    const float* xin = dbg_xrow(p, row);
    for (int n = VTID; n < 1024; n += 256) xs[n] = xin[n];
    __syncthreads();
    float mdm = dbg_modulate(p, l, 1, b9, xs, hs, red);
    const float* w = p.mix_w_in + (size_t)l * 1024 * NIN;
    const u16* P = WSP(u16, OFF_P); const u16* T = WSP(u16, OFF_T);
    int b, u;
    if (row < NL) { b = row >> 12; u = row & 4095; } else { b = (row - NL) >> 8; u = SEQ + ((row - NL) & 255); }
    float md = 0.f;
    for (int n = VTID; n < 2832; n += 256) {
        const int sc = map_col(2, n);
        float v = 0.f;
        for (int k = 0; k < 1024; ++k) v += hs[k] * w[(size_t)k * NIN + sc];
        if (n < 2048) md = fmaxf(md, fabsf(v - __uint_as_float(((uint32_t)P[(size_t)row * PW + n]) << 16)));
        if (n >= 1280 && n < 1536) md = fmaxf(md, fabsf(v - __uint_as_float(((uint32_t)T[((size_t)(b * TW + n - 1280)) * UT + u]) << 16)));
        if (n >= 2048 && n < 2816) md = fmaxf(md, fabsf(v - __uint_as_float(((uint32_t)T[((size_t)(b * TW + n - 1792)) * UT + u]) << 16)));
        if (n >= 2816) md = fmaxf(md, fabsf(v - WSP(float, OFF_G)[(size_t)row * 16 + n - 2816]));
    }
    md = blk_max(md, red);
    mdm = blk_max(mdm, red);
    unsigned* dw = (unsigned*)(p.ws + OFF_DBG);
    if (VTID == 0) { atomicMax(dw + 9, __float_as_uint(md)); atomicMax(dw + 15, __float_as_uint(mdm)); }
}
__global__ void __launch_bounds__(256) dbg_mix(Params p, int l, int slot) {
    __shared__ float xs[1024], hs[1024], os[1024], ys[1024], red[4];
    const int sr = blockIdx.x, row = dbg_row(sr), b9 = row < NL ? row >> 12 : 8;
    const float* xin = (const float*)(p.ws + OFF_DBG + 256) + ((size_t)slot * 16 + sr) * 1024;
    const u16* P = WSP(u16, OFF_P);
    for (int n = VTID; n < 1024; n += 256) { xs[n] = xin[n]; os[n] = __uint_as_float(((uint32_t)P[(size_t)row * PW + n]) << 16); }
    __syncthreads();
    float mdm = dbg_modulate(p, l, 1, b9, xs, hs, red);
    const float* w = p.mix_w_in + (size_t)l * 1024 * NIN;
    for (int n = VTID; n < 1024; n += 256) {
        float y = 0.f;
        for (int i = 0; i < 3; ++i) {
            float g = 0.f;
            for (int k = 0; k < 1024; ++k) g += hs[k] * w[(size_t)k * NIN + 2832 + i * 1024 + n];
            g = 1.f / (1.f + expf(-g));
            const float* wb = i == 0 ? p.w_br_ml + (size_t)l * 256 * 1024 : (i == 1 ? p.w_br_na + (size_t)l * 384 * 1024 : p.w_br_gq + (size_t)l * 384 * 1024);
            const int ko = i == 0 ? 0 : (i == 1 ? 256 : 640), kk = i == 0 ? 256 : 384;
            float a = 0.f;
            for (int k = 0; k < kk; ++k) a += os[ko + k] * wb[(size_t)k * 1024 + n];
            y += g * a;
        }
        ys[n] = y;
    }
    __syncthreads();
    float md = 0.f;
    const float* xc = dbg_xrow(p, row);
    for (int n = VTID; n < 1024; n += 256) {
        float o = 0.f;
        for (int k = 0; k < 1024; ++k) o += ys[k] * p.w_out[((size_t)l * 1024 + k) * 1024 + n];
        const float g5 = dbg_mod(p, l, b9, 5, n);
        md = fmaxf(md, fabsf(xs[n] + g5 * o - xc[n]));
    }
    md = blk_max(md, red);
    mdm = blk_max(mdm, red);
    unsigned* dw = (unsigned*)(p.ws + OFF_DBG);
    if (VTID == 0) { atomicMax(dw + 10, __float_as_uint(md)); atomicMax(dw + 15, __float_as_uint(mdm)); }
}
__global__ void dbg_fin(Params p) {
    const unsigned* dw = (const unsigned*)(p.ws + OFF_DBG);
    int mask = 0;
    if (__uint_as_float(dw[8]) > 0.02f) mask |= 1;
    if (__uint_as_float(dw[9]) > 0.03f) mask |= 2;
    if (__uint_as_float(dw[10]) > 0.02f) mask |= 4;
    if (__uint_as_float(dw[11]) > 0.02f) mask |= 8;
    if (__uint_as_float(dw[15]) > 1e-3f) mask |= 16;
    if (__uint_as_float(dw[4]) > 0.03f) mask |= 32;
    p.out[0] += 10.f * (float)mask;
    p.out[1] += 1000.f * __uint_as_float(dw[4]);
}
#endif


DEV void gemm8b_accum(f32x4 (&acc)[4][4], const u16* __restrict__ A, int lda, const u16* __restrict__ B, int ldb, int K, char* smem, int tid) {
    constexpr int STAGE = 49152;
    const int lane = tid & 63, wave = tid >> 6;
    const int wm = wave >> 1, wn = wave & 1, fr = lane & 15, fq = lane >> 4;
    const int lr = lane >> 3, pos = lane & 7;
    const int ce = pos ^ (lr >> 1), co = pos ^ (4 | (lr >> 1));
    const unsigned ra_ = (unsigned)((wave * 32 + lr) * lda) * 2u, rb_ = (unsigned)((wave * 16 + lr) * ldb) * 2u;
    const unsigned voa_e = ra_ + ce * 16, voa_o = ra_ + co * 16, vob_e = rb_ + ce * 16, vob_o = rb_ + co * 16;
    const int nk = K >> 6;
    const unsigned ldsb = (unsigned)(size_t)(__attribute__((address_space(3))) char*)smem;
    const unsigned ldsa_w = __builtin_amdgcn_readfirstlane(ldsb + wave * 4096);
    const unsigned ldsb_w = __builtin_amdgcn_readfirstlane(ldsb + 32768 + wave * 2048);
#define G8B_ISSUE(STG, K0) do { \
        _Pragma("unroll") for (int i = 0; i < 4; ++i) glds16(A + (size_t)(8 * i) * lda + (K0), (i & 1) ? voa_o : voa_e, ldsa_w + (STG) * STAGE + i * 1024); \
        _Pragma("unroll") for (int i = 0; i < 2; ++i) glds16(B + (size_t)(8 * i) * ldb + (K0), (i & 1) ? vob_o : vob_e, ldsb_w + (STG) * STAGE + i * 1024); \
    } while (0)
    G8B_ISSUE(0, 0);
    VM_WAIT0();
    __syncthreads();
    const int s3 = (fr >> 1) & 7;
    const int oa_base = (wm * 64 + fr) * 128 + ((fq ^ s3) * 16);
    const int ob_base = 32768 + (wn * 64 + fr) * 128 + ((fq ^ s3) * 16);
    for (int kt = 0; kt < nk; ++kt) {
        const int cur = kt & 1;
        const int k0 = (kt + 1 < nk ? kt + 1 : kt) * 64;
        G8B_ISSUE(cur ^ 1, k0);
        int o_a = cur * STAGE + oa_base, o_b = cur * STAGE + ob_base;
        asm volatile("" : "+v"(o_a), "+v"(o_b));
#pragma unroll
        for (int ks = 0; ks < 2; ++ks) {
            const char* sa_c = smem + (ks ? (o_a ^ 64) : o_a);
            const char* sb_c = smem + (ks ? (o_b ^ 64) : o_b);
            bf16x8 bfr[4], af[4];
#pragma unroll
            for (int nt = 0; nt < 4; ++nt) bfr[nt] = *(const bf16x8*)(sb_c + nt * 2048);
#pragma unroll
            for (int mt = 0; mt < 4; ++mt) af[mt] = *(const bf16x8*)(sa_c + mt * 2048);
#pragma unroll
            for (int mt = 0; mt < 4; ++mt)
#pragma unroll
                for (int nt = 0; nt < 4; ++nt) acc[mt][nt] = mfma16(af[mt], bfr[nt], acc[mt][nt]);
            __builtin_amdgcn_sched_group_barrier(0x100, 7, 0);
            __builtin_amdgcn_sched_group_barrier(0x008, 4, 0);
            __builtin_amdgcn_sched_group_barrier(0x100, 1, 0);
#pragma unroll
            for (int i = 0; i < 3; ++i) __builtin_amdgcn_sched_group_barrier(0x008, 4, 0);
        }
        VM_WAIT0();
        __syncthreads();
    }
#undef G8B_ISSUE
}

DEV void ph_merge8(const Params& p, char* smem, int rvid, int RG, int tid) {
    const u16* H = WSP(u16, OFF_H);
    u16* P = WSP(u16, OFF_P);
    const u16* Wg = WSP(u16, OFF_W) + WE_MIX + (size_t)2944 * 1024;
    const u16* Wbr = WSP(u16, OFF_W) + WE_BR;
    const int lane = tid & 63, wave = tid >> 6, wm = wave >> 1, wn = wave & 1, fr = lane & 15, fq = lane >> 4;
    const int total = 128 * 8;
    for (int t = rvid; t < total; t += RG) {
        const int gi = t >> 5, rem = t & 31;
        const int mt_ = gi * 4 + (rem & 3), nt_ = rem >> 2;
        const int m0 = mt_ * 256, n0 = nt_ * 128;
        f32x4 y[4][4];
        zero_acc<4>(y);
#pragma unroll 1
        for (int br = 0; br < 3; ++br) {
            const int ko = br == 0 ? 0 : (br == 1 ? 256 : 640);
            const int kk = br == 0 ? 256 : 384;
            uint32_t gpk[4][4][2];
            {
                f32x4 g[4][4];
                zero_acc<4>(g);
                gemm8b_accum(g, H + (size_t)m0 * D, D, Wg + (size_t)(br * 1024 + n0) * D, D, D, smem, tid);
#pragma unroll
                for (int i = 0; i < 4; ++i)
#pragma unroll
                    for (int jn = 0; jn < 4; ++jn) {
                        gpk[i][jn][0] = pk2(sigmoidf_(g[i][jn][0]), sigmoidf_(g[i][jn][1]));
                        gpk[i][jn][1] = pk2(sigmoidf_(g[i][jn][2]), sigmoidf_(g[i][jn][3]));
                    }
            }
            f32x4 a[4][4];
            zero_acc<4>(a);
            gemm8b_accum(a, P + (size_t)m0 * PW + ko, PW, Wbr + (size_t)n0 * D + ko, D, kk, smem, tid);
#pragma unroll
            for (int i = 0; i < 4; ++i)
#pragma unroll
                for (int jn = 0; jn < 4; ++jn) {
                    y[i][jn][0] += bflo(gpk[i][jn][0]) * a[i][jn][0];
                    y[i][jn][1] += bfhi(gpk[i][jn][0]) * a[i][jn][1];
                    y[i][jn][2] += bflo(gpk[i][jn][1]) * a[i][jn][2];
                    y[i][jn][3] += bfhi(gpk[i][jn][1]) * a[i][jn][3];
                }
        }
#pragma unroll
        for (int mt = 0; mt < 4; ++mt)
#pragma unroll
            for (int nt = 0; nt < 4; ++nt)
#pragma unroll
                for (int r = 0; r < 4; ++r) {
                    const int row = m0 + wm * 64 + mt * 16 + fq * 4 + r;
                    const int col = n0 + wn * 64 + nt * 16 + fr;
                    P[(size_t)row * PW + PC_Y + col] = (u16)(pk2(y[mt][nt][r], 0.f) & 0xffff);
                }
    }
}

constexpr int PH_PER_LAYER = 15;
constexpr int N_PHASES = 2 * PH_PER_LAYER;

#ifndef REPEAT_MASK
#define REPEAT_MASK 0
#endif
template <int Q>
DEV void run_phase_q(const Params& p, int l, char* smem) {
    const int half = (int)((threadIdx.x + p.z) >> 8);
    const int G = gridDim.x * 2, bid = blockIdx.x * 2 + half;
    const int vid = (gridDim.x % 8 == 0) ? (int)(blockIdx.x & 7) * (G >> 3) + (int)(blockIdx.x >> 3) * 2 + half : bid;
    smem += half * 73728;
    const bool last = (l == 1);
    const u16* W = WSP(u16, OFF_W);
    const int nrep = ((REPEAT_MASK >> Q) & 1) ? 2 : 1;
    char* smem0 = smem - half * 73728;
    const int rtid = (int)(threadIdx.x + p.z);
    const int RG = gridDim.x;
    const int rvid = (RG % 8 == 0) ? (int)(blockIdx.x & 7) * (RG >> 3) + (int)(blockIdx.x >> 3) : (int)blockIdx.x;
    for (int rep = 0; rep < nrep; ++rep) {
        const float cm = rep ? 0.f : 1.f;
        if (Q == 0) ph_prep(p, l, smem, bid, G);
        if (Q == 1) ph_mod(p, l, 0, MTOT, bid, G);
        Params p2 = p;
        if (Q == 2) { ph_ffn_in8(p, 0, smem0, rvid, RG, rtid); int z2 = p.z; asm volatile("" : "+s"(z2) :: "memory"); p2.z = z2; ph_ffn_in(p2, 0, 256, 16, smem, vid, G); }
        if (Q == 3) { ph_resid8(p, WSP(u16, OFF_P), DFF, W + WE_OUT0, DFF, 2, 0.5f * cm, smem0, rvid, RG, rtid, l == 0 ? p.x : p.out); int z2 = p.z; asm volatile("" : "+s"(z2) :: "memory"); p2.z = z2;
                      ph_resid(p2, WSP(u16, OFF_P), DFF, W + WE_OUT0, DFF, 2, 0.5f * cm, 256, 16, smem, vid, G); }
        if (Q == 4) ph_mod(p, l, 1, MTOT, bid, G);
        if (Q == 5) { ph_pgemm8(p, smem0, rvid, RG, rtid); int z2 = p.z; asm volatile("" : "+s"(z2) :: "memory"); p2.z = z2; ph_pgemm(p2, 256, 16, smem, vid, G); }
        if (Q == 6) ph_qknorm_gates(p, l, bid, G);
        if (Q == 7) { ph_attn8(p, l, smem0, rvid, RG); int z2 = p.z; asm volatile("" : "+s"(z2) :: "memory"); p2.z = z2; ph_attn(p2, l, smem, bid, G, rep); }
        if (Q == 8) ph_m3(p, bid, G);
        if (Q == 9) ph_m4(p, l, bid, G, rep);
        if (Q == 10) { ph_merge8(p, smem0, rvid, RG, rtid); int z2 = p.z; asm volatile("" : "+s"(z2) :: "memory"); p2.z = z2; if (!last) ph_merge(p2, 256, 16, smem, vid, G); }
        if (Q == 11) { ph_resid8(p, WSP(u16, OFF_P) + PC_Y, PW, W + WE_O, D, 5, 1.0f * cm, smem0, rvid, RG, rtid, p.out);
                       int z2 = p.z; asm volatile("" : "+s"(z2) :: "memory"); p2.z = z2;
                       if (!last) ph_resid(p2, WSP(u16, OFF_P) + PC_Y, PW, W + WE_O, D, 5, 1.0f * cm, 256, 16, smem, vid, G); }
        if (Q == 12) ph_mod(p, l, 2, last ? NL : MTOT, bid, G);
        if (Q == 13) { ph_ffn_in8(p, 1, smem0, rvid, RG, rtid); int z2 = p.z; asm volatile("" : "+s"(z2) :: "memory"); p2.z = z2; if (!last) ph_ffn_in(p2, 1, 256, 16, smem, vid, G); }
        if (Q == 14) { ph_resid8(p, WSP(u16, OFF_P), DFF, W + WE_OUT1, DFF, 8, 0.5f * cm, smem0, rvid, RG, rtid, p.out);
                       int z2 = p.z; asm volatile("" : "+s"(z2) :: "memory"); p2.z = z2;
                       if (!last) ph_resid(p2, WSP(u16, OFF_P), DFF, W + WE_OUT1, DFF, 8, 0.5f * cm, 256, 16, smem, vid, G); }
    }
}

DEV void run_phase(const Params& p, int ph, char* smem) {
    const int l = ph / PH_PER_LAYER, q = ph % PH_PER_LAYER;
    switch (q) {
        case 0: run_phase_q<0>(p, l, smem); break;
        case 1: run_phase_q<1>(p, l, smem); break;
        case 2: run_phase_q<2>(p, l, smem); break;
        case 3: run_phase_q<3>(p, l, smem); break;
        case 4: run_phase_q<4>(p, l, smem); break;
        case 5: run_phase_q<5>(p, l, smem); break;
        case 6: run_phase_q<6>(p, l, smem); break;
        case 7: run_phase_q<7>(p, l, smem); break;
        case 8: run_phase_q<8>(p, l, smem); break;
        case 9: run_phase_q<9>(p, l, smem); break;
        case 10: run_phase_q<10>(p, l, smem); break;
        case 11: run_phase_q<11>(p, l, smem); break;
        case 12: run_phase_q<12>(p, l, smem); break;
        case 13: run_phase_q<13>(p, l, smem); break;
        case 14: run_phase_q<14>(p, l, smem); break;
    }
}

template <int Q>
__global__ void __launch_bounds__(256, 2) phase_kernel(Params p, int l) {
    __shared__ __attribute__((aligned(16))) char smem[73728];
    run_phase_q<Q>(p, l, smem);
}

#if ONE_LAUNCH
#define XB_TMO      128
#define XB_XCNT(j)  (256  + 64 * (j))
#define XB_XSUB(j)  (1280 + 64 * (j))
#define XB_XGEN(j)  (2304 + 64 * (j))
#define XB_TOP      3328
#define XB_TOPGEN   3392
#define XB_SPIN_CAP (1u << 22)
DEV unsigned xb_ld(unsigned* q) { return __hip_atomic_load(q, __ATOMIC_RELAXED, __HIP_MEMORY_SCOPE_AGENT); }
DEV unsigned xb_add(unsigned* q, unsigned v) { return __hip_atomic_fetch_add(q, v, __ATOMIC_RELAXED, __HIP_MEMORY_SCOPE_AGENT); }
DEV unsigned xb_xcc_id() { return (unsigned)__builtin_amdgcn_s_getreg((3 << 11) | 20) & 0xFu; }
#define XB_SPIN(cond, bar) do { unsigned _sp = 0; while (cond) { __builtin_amdgcn_s_sleep(1); \
    if ((++_sp & 255u) == 0u) { if (xb_ld(&(bar)[XB_TMO])) break; if (_sp > XB_SPIN_CAP) { atomicAdd(&(bar)[XB_TMO], 1u); break; } } } } while (0)
DEV void xcd_census(unsigned* bar, unsigned x, unsigned& nloc, unsigned& nx) {
    const unsigned G = gridDim.x;
    unsigned sum, cnt, mine, sp = 0u;
    for (;;) {
        sum = 0u; cnt = 0u; mine = 0u;
#pragma unroll
        for (unsigned j = 0; j < 16; ++j) { const unsigned c = xb_ld(&bar[XB_XCNT(j)]); sum += c; cnt += (c > 0u) ? 1u : 0u; mine = (j == x) ? c : mine; }
        if (sum == G) break;
        __builtin_amdgcn_s_sleep(1);
        if ((++sp & 255u) == 0u) { if (xb_ld(&bar[XB_TMO])) break; if (sp > XB_SPIN_CAP) { atomicAdd(&bar[XB_TMO], 1u); break; } }
    }
    nloc = mine > 0u ? mine : 1u; nx = cnt > 0u ? cnt : 1u;
}
DEV void xcd_barrier(unsigned* bar, unsigned x, volatile unsigned* st, int tid) {
    asm volatile("s_waitcnt vmcnt(0)" ::: "memory");
    __syncthreads();
    if (tid == 0) {
        __builtin_amdgcn_s_waitcnt(0);
        unsigned nloc = st[0], nx = st[1];
        if (nloc == 0u) { xcd_census(bar, x, nloc, nx); st[0] = nloc; st[1] = nx; }
        const unsigned old = xb_add(&bar[XB_XSUB(x)], 1u);
        const unsigned gen = old / nloc;
        if (old + 1u == (gen + 1u) * nloc) {
            __builtin_amdgcn_fence(__ATOMIC_RELEASE, "agent");
            asm volatile("s_waitcnt vmcnt(0)" ::: "memory");
            const unsigned og = xb_add(&bar[XB_TOP], 1u);
            const unsigned tg = og / nx;
            if (og + 1u == (tg + 1u) * nx) xb_add(&bar[XB_TOPGEN], 1u);
            else XB_SPIN(xb_ld(&bar[XB_TOPGEN]) == tg, bar);
            __builtin_amdgcn_fence(__ATOMIC_ACQUIRE, "agent");
            xb_add(&bar[XB_XGEN(x)], 1u);
            asm volatile("s_waitcnt vmcnt(0)" ::: "memory");
        } else {
            XB_SPIN(xb_ld(&bar[XB_XGEN(x)]) == gen, bar);
            __builtin_amdgcn_fence(__ATOMIC_ACQUIRE, "agent");
            asm volatile("s_waitcnt vmcnt(0)" ::: "memory");
        }
    }
    __syncthreads();
}
__global__ void __launch_bounds__(512, 2) mega_kernel(Params p0, int ph_begin, int ph_end) {
    __shared__ __attribute__((aligned(16))) char smem[147456];
    __shared__ uint4 xb_words;
    unsigned* bar = (unsigned*)(p0.ws + OFF_BAR);
    const unsigned xcc = xb_xcc_id();
    if (threadIdx.x == 0) { xb_words = make_uint4(0u, 0u, 0u, 0u); (void)xb_add(&bar[XB_XCNT(xcc)], 1u); }
    __syncthreads();
    for (int ph = ph_begin; ph < ph_end; ++ph) {
        Params p = p0;
        int z = p0.z;
        asm volatile("" : "+s"(z));
        p.z = z;
        p.ws = p0.ws + z;
        p.out = p0.out + z;
        run_phase(p, ph, smem);
        if (ph + 1 < ph_end) {
            if (p0.z == 0x7fffffff) cg::this_grid().sync();
            xcd_barrier(bar, xcc, (volatile unsigned*)&xb_words, (int)threadIdx.x + z);
        }
    }
}
#endif

extern "C" void kernel_launch(void* const* d_in, const int* in_sizes, int n_in, void* d_out, int out_size, void* d_ws, size_t ws_size,
                              hipStream_t stream) {
    if (ws_size < WS_END) { fprintf(stderr, "workspace too small: %zu < %zu\n", ws_size, (size_t)WS_END); return; }
    Params p{};
    p.x = (const float*)d_in[0]; p.c = (const float*)d_in[1]; p.ctx = (const float*)d_in[2]; p.c_ctx = (const float*)d_in[3];
    p.ada_w = (const float*)d_in[4]; p.ada_b = (const float*)d_in[5]; p.norm_w = (const float*)d_in[6];
    p.ffn_w_in = (const float*)d_in[7]; p.ffn_w_out = (const float*)d_in[8]; p.mix_w_in = (const float*)d_in[9];
    p.ml_gate_b = (const float*)d_in[10]; p.ml_norm_w = (const float*)d_in[11]; p.na_qk_w = (const float*)d_in[12];
    p.na_rpb = (const float*)d_in[13]; p.gq_qk_w = (const float*)d_in[14]; p.w_br_ml = (const float*)d_in[15];
    p.w_br_na = (const float*)d_in[16]; p.w_br_gq = (const float*)d_in[17]; p.w_out = (const float*)d_in[18];
    p.out = (float*)d_out; p.ws = (char*)d_ws;
#ifdef NANFILL
    hipMemsetAsync(d_ws, 0xFF, WS_END, stream);
#endif
#if ONE_LAUNCH
    static int grid_blocks = 0;
    if (!grid_blocks) {
        int dev = 0, cus = 0, per_cu = 0;
        hipGetDevice(&dev);
        hipDeviceGetAttribute(&cus, hipDeviceAttributeMultiprocessorCount, dev);
        hipOccupancyMaxActiveBlocksPerMultiprocessor(&per_cu, mega_kernel, 512, 0);
        per_cu = 1;
        grid_blocks = cus * per_cu;
    }
    hipMemsetAsync((char*)d_ws + OFF_BAR, 0, 3456 * 4, stream);
    int pb = 0, pe = N_PHASES;
    void* args[] = {&p, &pb, &pe};
#ifdef SPLIT_TEST
    (void)args;
    for (int ph = 0; ph < N_PHASES; ++ph) mega_kernel<<<grid_blocks, 256, 0, stream>>>(p, ph, ph + 1);
#else
    hipError_t e = hipLaunchCooperativeKernel((void*)mega_kernel, dim3(grid_blocks), dim3(512), args, 0, stream);
    if (e != hipSuccess) fprintf(stderr, "cooperative launch failed: %s (grid %d)\n", hipGetErrorString(e), grid_blocks);
#endif
#else
    for (int l = 0; l < 2; ++l) {
#define LP(Q) phase_kernel<Q><<<512, 256, 0, stream>>>(p, l)
#ifdef DBG
        const bool dl = (l == DBG_LAYER);
        if (dl) hipMemsetAsync((char*)d_ws + OFF_DBG, 0, 256, stream);
        LP(0);
        if (dl) dbg_save<<<16, 256, 0, stream>>>(p, 0);
        LP(1); LP(2); LP(3);
        if (dl) dbg_ffn<<<16, 256, 0, stream>>>(p, l, 0, 0, 8);
        LP(4); LP(5);
        if (dl) dbg_pchk<<<16, 256, 0, stream>>>(p, l);
        LP(6);
        if (dl) dbg_copy<<<2048, 256, 0, stream>>>(p);
        LP(7); LP(8); LP(9);
        if (dl) {
            dbg_mlstm<<<64, 64, 0, stream>>>(p, l);
            dbg_cmp<<<(NB * 4 * UT + 7424 * 64 + 255) / 256, 256, 0, stream>>>(p, l);
            dbg_save<<<16, 256, 0, stream>>>(p, 1);
        }
        LP(10); LP(11);
        if (dl) { dbg_mix<<<16, 256, 0, stream>>>(p, l, 1); dbg_save<<<16, 256, 0, stream>>>(p, 2); }
        LP(12); LP(13); LP(14);
        if (dl) dbg_ffn<<<16, 256, 0, stream>>>(p, l, 1, 2, 11);
#else
        LP(0); LP(1); LP(2); LP(3); LP(4); LP(5); LP(6); LP(7); LP(8); LP(9); LP(10); LP(11); LP(12); LP(13); LP(14);
#endif
#undef LP
    }
#ifdef DBG
    dbg_fin<<<1, 1, 0, stream>>>(p);
#endif
#endif
}
```

```cpp
#include <hip/hip_runtime.h>
#include <hip/hip_cooperative_groups.h>
#include <stdint.h>
#include <cstdio>
namespace cg = cooperative_groups;

#ifndef ONE_LAUNCH
#define ONE_LAUNCH 1
#endif

#define VTID ((int)((threadIdx.x + p.z) & 255))
typedef unsigned short u16;
typedef __attribute__((ext_vector_type(8))) short bf16x8;
typedef __attribute__((ext_vector_type(4))) float f32x4;
#define DEV __device__ __forceinline__

constexpr int D = 1024, NB = 8, SEQ = 4096, CTXL = 256;
constexpr int NL = NB * SEQ, NCX = NB * CTXL, MTOT = NL + NCX;
constexpr int DFF = 2816, PW = 2816, UT = SEQ + CTXL, NCH = UT / 64;
constexpr int NIN = 5904;
constexpr int PC_MLQ = 0, PC_NAQ = 256, PC_GQQ = 640, PC_MLO = 1024, PC_MLK = 1280, PC_NAK = 1536, PC_GQK = 1920,
              PC_MLV = 2048, PC_NAV = 2304, PC_GQV = 2688, PC_Y = 1024;
constexpr int TC_MLK = 0, TC_MLV = 256, TC_NAV = 512, TC_GQV = 896, TW = 1024;
constexpr int DBG_MLO = PC_MLQ, DBG_NAO = PC_NAQ;
constexpr int SCH = 4160;
constexpr int NSCAN = 64;

constexpr size_t al256(size_t x) { return (x + 255) & ~(size_t)255; }
constexpr size_t OFF_MODS = 0;
constexpr size_t OFF_ROPE = al256(OFF_MODS + (size_t)9 * 9216 * 4);
constexpr size_t OFF_G    = al256(OFF_ROPE + (size_t)4096 * 64 * 4);
constexpr size_t OFF_BC   = al256(OFF_G + (size_t)MTOT * 16 * 4);
constexpr size_t OFF_IG   = al256(OFF_BC + (size_t)NSCAN * UT * 4);
constexpr size_t OFF_AE   = al256(OFF_IG + (size_t)NSCAN * UT * 4);
constexpr size_t OFF_MS   = al256(OFF_AE + (size_t)NSCAN * UT * 4);
constexpr size_t OFF_DEC  = al256(OFF_MS + (size_t)NSCAN * NCH * 4);
constexpr size_t OFF_XC   = al256(OFF_DEC + (size_t)NSCAN * NCH * 4);
constexpr size_t OFF_H    = al256(OFF_XC + (size_t)NCX * D * 4);
constexpr size_t OFF_P    = al256(OFF_H + (size_t)MTOT * D * 2);
constexpr size_t OFF_T    = al256(OFF_P + (size_t)MTOT * PW * 2);
constexpr size_t OFF_S    = al256(OFF_T + (size_t)NB * TW * UT * 2);
constexpr size_t OFF_W    = al256(OFF_S + (size_t)NSCAN * NCH * SCH * 4);
constexpr size_t WE_IN0 = 0, WE_IN1 = WE_IN0 + (size_t)5632 * 1024, WE_OUT0 = WE_IN1 + (size_t)5632 * 1024,
                 WE_OUT1 = WE_OUT0 + (size_t)1024 * 2816, WE_MIX = WE_OUT1 + (size_t)1024 * 2816,
                 WE_BR = WE_MIX + (size_t)6016 * 1024, WE_O = WE_BR + (size_t)1024 * 1024, WE_END = WE_O + (size_t)1024 * 1024;
constexpr size_t OFF_BAR = al256(OFF_W + WE_END * 2);
constexpr size_t WS_END = OFF_BAR + 3456 * 4;
static_assert(WS_END < (size_t)536000000, "workspace too large");

struct Params {
    const float *x, *c, *ctx, *c_ctx, *ada_w, *ada_b, *norm_w, *ffn_w_in, *ffn_w_out, *mix_w_in, *ml_gate_b, *ml_norm_w,
        *na_qk_w, *na_rpb, *gq_qk_w, *w_br_ml, *w_br_na, *w_br_gq, *w_out;
    float* out;
    char* ws;
    int z, pad;
};

DEV uint32_t pk2(float lo, float hi) { uint32_t r; asm("v_cvt_pk_bf16_f32 %0, %1, %2" : "=v"(r) : "v"(lo), "v"(hi)); return r; }
DEV float bflo(uint32_t w) { return __uint_as_float(w << 16); }
DEV float bfhi(uint32_t w) { return __uint_as_float(w & 0xffff0000u); }
DEV f32x4 mfma16(bf16x8 a, bf16x8 b, f32x4 c) { return __builtin_amdgcn_mfma_f32_16x16x32_bf16(a, b, c, 0, 0, 0); }
typedef unsigned u32x4 __attribute__((ext_vector_type(4)));
DEV u32x4 gld16(const void* q) { u32x4 r; asm volatile("global_load_dwordx4 %0, %1, off" : "=v"(r) : "v"(q) : "memory"); return r; }
DEV u32x4 gld16s(const void* sbase, unsigned voff) { u32x4 r; asm volatile("global_load_dwordx4 %0, %1, %2" : "=v"(r) : "v"(voff), "s"(sbase) : "memory"); return r; }
DEV void glds16(const void* sbase, unsigned voff, unsigned ldsaddr) {
    asm volatile("s_mov_b32 m0, %2\n\ts_nop 0\n\tglobal_load_lds_dwordx4 %0, %1" :: "v"(voff), "s"(sbase), "s"(ldsaddr) : "memory", "m0");
}
#define VM_WAIT0() asm volatile("s_waitcnt vmcnt(0)" ::: "memory")
union Frag { bf16x8 v; uint4 q; uint32_t u[4]; uint2 d[2]; };
DEV int cu_of(int c, int dir) { return c < 4 ? 64 + (dir ? 3 - c : c) : (dir ? 63 - (c - 4) : (c - 4)); }
DEV int rowof(int b, int u) { return u < SEQ ? b * SEQ + u : NL + b * CTXL + (u - SEQ); }
DEV float fexp2(float x) { return __builtin_amdgcn_exp2f(x); }
DEV float fexp(float x) { return __builtin_amdgcn_exp2f(x * 1.4426950408889634f); }
DEV float sigmoidf_(float x) { return 1.f / (1.f + fexp(-x)); }
DEV float xq_max(float v) {
    auto r = __builtin_amdgcn_permlane16_swap(__float_as_uint(v), __float_as_uint(v), false, false);
    const float m = fmaxf(__uint_as_float(r[0]), __uint_as_float(r[1]));
    auto q = __builtin_amdgcn_permlane32_swap(__float_as_uint(m), __float_as_uint(m), false, false);
    return fmaxf(__uint_as_float(q[0]), __uint_as_float(q[1]));
}
DEV float xq_sum(float v) {
    auto r = __builtin_amdgcn_permlane16_swap(__float_as_uint(v), __float_as_uint(v), false, false);
    const float m = __uint_as_float(r[0]) + __uint_as_float(r[1]);
    auto q = __builtin_amdgcn_permlane32_swap(__float_as_uint(m), __float_as_uint(m), false, false);
    return __uint_as_float(q[0]) + __uint_as_float(q[1]);
}
DEV float wave_sum(float v) {
#pragma unroll
    for (int o = 1; o < 64; o <<= 1) v += __shfl_xor(v, o);
    return v;
}
DEV float wave_max(float v) {
#pragma unroll
    for (int o = 1; o < 64; o <<= 1) v = fmaxf(v, __shfl_xor(v, o));
    return v;
}

#define WSP(T_, off) ((T_*)(p.ws + (off)))
DEV float m_scan(const Params& p, int sc, int c_end) {
    const float* BT = WSP(float, OFF_MS) + sc * NCH;
    const float* MX = WSP(float, OFF_DEC) + sc * NCH;
    const int lane = VTID & 63;
    const float bt0 = BT[lane], mx0 = MX[lane], bt1 = BT[64 + (lane & 3)], mx1 = MX[64 + (lane & 3)];
    float m = 0.f;
    for (int c = 0; c < c_end; ++c) {
        const float b = c < 64 ? __shfl(bt0, c) : __shfl(bt1, c - 64);
        const float x = c < 64 ? __shfl(mx0, c) : __shfl(mx1, c - 64);
        m = fmaxf(b + m, x);
    }
    return m;
}

template <int TN>
DEV void gemm_accum(f32x4 (&acc)[4][TN], const u16* __restrict__ A, int lda, const u16* __restrict__ B, int ldb, int K, char* smem, int tid) {
    constexpr int BROWS = TN * 32;
    constexpr int STAGE = (128 + BROWS) * 144;
    constexpr int NBCH = BROWS / 32;
    const int lane = tid & 63, wave = tid >> 6;
    const int wm = wave >> 1, wn = wave & 1, fr = lane & 15, fq = lane >> 4;
    const int lrow = tid >> 3, lc8 = tid & 7;
    const u16* ga = A + (size_t)lrow * lda + lc8 * 8;
    const u16* gb = B + (size_t)lrow * ldb + lc8 * 8;
    u32x4 ra[4], rb[NBCH];
    const int nk = K >> 6;
#pragma unroll
    for (int i = 0; i < 4; ++i) ra[i] = gld16(ga + (size_t)(32 * i) * lda);
#pragma unroll
    for (int i = 0; i < NBCH; ++i) rb[i] = gld16(gb + (size_t)(32 * i) * ldb);
    char* sw = smem + lrow * 144 + lc8 * 16;
    VM_WAIT0();
#pragma unroll
    for (int i = 0; i < 4; ++i) *(u32x4*)(sw + i * 32 * 144) = ra[i];
#pragma unroll
    for (int i = 0; i < NBCH; ++i) *(u32x4*)(sw + 128 * 144 + i * 32 * 144) = rb[i];
    __syncthreads();
    const char* sa_r = smem + (wm * 64 + fr) * 144 + fq * 16;
    const char* sb_r = smem + 128 * 144 + (wn * TN * 16 + fr) * 144 + fq * 16;
    for (int kt = 0; kt < nk; ++kt) {
        const int cur = kt & 1;
        const int k0 = (kt + 1 < nk ? kt + 1 : kt) * 64;
#pragma unroll
        for (int i = 0; i < 4; ++i) ra[i] = gld16(ga + (size_t)(32 * i) * lda + k0);
#pragma unroll
        for (int i = 0; i < NBCH; ++i) rb[i] = gld16(gb + (size_t)(32 * i) * ldb + k0);
        __builtin_amdgcn_sched_barrier(0);
#pragma unroll
        for (int ks = 0; ks < 2; ++ks) {
            bf16x8 af[4], bfr[TN];
#pragma unroll
            for (int mt = 0; mt < 4; ++mt) af[mt] = *(const bf16x8*)(sa_r + cur * STAGE + mt * 16 * 144 + ks * 64);
#pragma unroll
            for (int nt = 0; nt < TN; ++nt) bfr[nt] = *(const bf16x8*)(sb_r + cur * STAGE + nt * 16 * 144 + ks * 64);
#pragma unroll
            for (int mt = 0; mt < 4; ++mt)
#pragma unroll
                for (int nt = 0; nt < TN; ++nt) acc[mt][nt] = mfma16(af[mt], bfr[nt], acc[mt][nt]);
        }
        __builtin_amdgcn_sched_barrier(0);
        VM_WAIT0();
        {
            char* sw2 = sw + (cur ^ 1) * STAGE;
#pragma unroll
            for (int i = 0; i < 4; ++i) *(u32x4*)(sw2 + i * 32 * 144) = ra[i];
#pragma unroll
            for (int i = 0; i < NBCH; ++i) *(u32x4*)(sw2 + 128 * 144 + i * 32 * 144) = rb[i];
        }
        __syncthreads();
    }
}

template <int TN>
DEV void zero_acc(f32x4 (&acc)[4][TN]) {
#pragma unroll
    for (int i = 0; i < 4; ++i)
#pragma unroll
        for (int j = 0; j < TN; ++j) acc[i][j] = f32x4{0.f, 0.f, 0.f, 0.f};
}

DEV void tile_decode(int t, int ntn, int& mt, int& nt) {
    const int per = 8 * ntn;
    const int gi = t / per, rem = t - gi * per;
    nt = rem >> 3;
    mt = gi * 8 + (rem & 7);
}


DEV void gemm8_accum(f32x4 (&acc)[8][4], const u16* __restrict__ A, int lda, const u16* __restrict__ B, int ldb, int K, char* smem, int tid) {
    constexpr int STAGE = 65536;
    const int lane = tid & 63, wave = tid >> 6;
    const int wm = wave >> 2, wn = wave & 3, fr = lane & 15, fq = lane >> 4;
    const int lr = lane >> 3, pos = lane & 7;
    const int ce = pos ^ (lr >> 1), co = pos ^ (4 | (lr >> 1));
    const unsigned ra_ = (unsigned)((wave * 32 + lr) * lda) * 2u, rb_ = (unsigned)((wave * 32 + lr) * ldb) * 2u;
    const unsigned voa_e = ra_ + ce * 16, voa_o = ra_ + co * 16, vob_e = rb_ + ce * 16, vob_o = rb_ + co * 16;
    const int nk = K >> 6;
    const unsigned ldsw = __builtin_amdgcn_readfirstlane((unsigned)(size_t)(__attribute__((address_space(3))) char*)smem + wave * 4096);
#define G8_ISSUE(STG, K0) do { \
        _Pragma("unroll") for (int i = 0; i < 4; ++i) { \
            glds16(A + (size_t)(8 * i) * lda + (K0), (i & 1) ? voa_o : voa_e, ldsw + (STG) * STAGE + i * 1024); \
            glds16(B + (size_t)(8 * i) * ldb + (K0), (i & 1) ? vob_o : vob_e, ldsw + (STG) * STAGE + 32768 + i * 1024); \
        } } while (0)
    G8_ISSUE(0, 0);
    VM_WAIT0();
    __syncthreads();
    const int s3 = (fr >> 1) & 7;
    const int oa_base = (wm * 128 + fr) * 128 + ((fq ^ s3) * 16);
    const int ob_base = 32768 + (wn * 64 + fr) * 128 + ((fq ^ s3) * 16);
    for (int kt = 0; kt < nk; ++kt) {
        const int cur = kt & 1;
        const int k0 = (kt + 1 < nk ? kt + 1 : kt) * 64;
        G8_ISSUE(cur ^ 1, k0);
        int o_a = cur * STAGE + oa_base, o_b = cur * STAGE + ob_base;
        asm volatile("" : "+v"(o_a), "+v"(o_b));
#pragma unroll
        for (int ks = 0; ks < 2; ++ks) {
            const char* sa_c = smem + (ks ? (o_a ^ 64) : o_a);
            const char* sb_c = smem + (ks ? (o_b ^ 64) : o_b);
            bf16x8 bfr[4], af[8];
#pragma unroll
            for (int nt = 0; nt < 4; ++nt) bfr[nt] = *(const bf16x8*)(sb_c + nt * 2048);
#pragma unroll
            for (int mt = 0; mt < 8; ++mt) af[mt] = *(const bf16x8*)(sa_c + mt * 2048);
#pragma unroll
            for (int mt = 0; mt < 8; ++mt)
#pragma unroll
                for (int nt = 0; nt < 4; ++nt) acc[mt][nt] = mfma16(af[mt], bfr[nt], acc[mt][nt]);
            __builtin_amdgcn_sched_group_barrier(0x100, 7, 0);
#pragma unroll
            for (int i = 0; i < 5; ++i) { __builtin_amdgcn_sched_group_barrier(0x008, 4, 0); __builtin_amdgcn_sched_group_barrier(0x100, 1, 0); }
#pragma unroll
            for (int i = 0; i < 3; ++i) __builtin_amdgcn_sched_group_barrier(0x008, 4, 0);
        }
        VM_WAIT0();
        __syncthreads();
    }
#undef G8_ISSUE
}
DEV void zero_acc8(f32x4 (&acc)[8][4]) {
#pragma unroll
    for (int i = 0; i < 8; ++i)
#pragma unroll
        for (int j = 0; j < 4; ++j) acc[i][j] = f32x4{0.f, 0.f, 0.f, 0.f};
}
DEV void tile_decode8(int t, int ntn, int& mt, int& nt) {
    const int per = 4 * ntn;
    const int gi = t / per, rem = t - gi * per;
    nt = rem >> 2;
    mt = gi * 4 + (rem & 3);
}

DEV void ph_ffn_in8(const Params& p, int which, char* smem, int rvid, int RG, int tid) {
    const u16* H = WSP(u16, OFF_H);
    const u16* Wt = WSP(u16, OFF_W) + (which ? WE_IN1 : WE_IN0);
    u16* ACT = WSP(u16, OFF_P);
    const int lane = tid & 63, wave = tid >> 6, wm = wave >> 2, wn = wave & 3, fr = lane & 15, fq = lane >> 4;
    const int total = 128 * 22;
    for (int t = rvid; t < total; t += RG) {
        int mt_, nt_;
        tile_decode8(t, 22, mt_, nt_);
        const int m0 = mt_ * 256, n0 = nt_ * 256;
        f32x4 acc[8][4];
        zero_acc8(acc);
        gemm8_accum(acc, H + (size_t)m0 * D, D, Wt + (size_t)n0 * D, D, D, smem, tid);
#pragma unroll
        for (int mt = 0; mt < 8; ++mt)
#pragma unroll
            for (int pp = 0; pp < 2; ++pp)
#pragma unroll
                for (int r = 0; r < 4; ++r) {
                    const int row = m0 + wm * 128 + mt * 16 + fq * 4 + r;
                    const int hid = (n0 >> 1) + wn * 32 + pp * 16 + fr;
                    const float g = acc[mt][2 * pp][r], u = acc[mt][2 * pp + 1][r];
                    const float v = g * sigmoidf_(g) * u;
                    ACT[(size_t)row * DFF + hid] = (u16)(pk2(v, 0.f) & 0xffff);
                }
    }
}
DEV void ph_resid8(const Params& p, const u16* A, int lda, const u16* Wt, int K, int modidx, float coef, char* smem, int rvid, int RG, int tid, const float* xsrc) {
    const float* mods = WSP(float, OFF_MODS);
    const int lane = tid & 63, wave = tid >> 6, wm = wave >> 2, wn = wave & 3, fr = lane & 15, fq = lane >> 4;
    const int total = 128 * 4;
    for (int t = rvid; t < total; t += RG) {
        int mt_, nt_;
        tile_decode8(t, 4, mt_, nt_);
        const int m0 = mt_ * 256, n0 = nt_ * 256;
        f32x4 acc[8][4];
        zero_acc8(acc);
        gemm8_accum(acc, A + (size_t)m0 * lda, lda, Wt + (size_t)n0 * K, K, K, smem, tid);
        const float* gp = mods + (m0 >> 12) * 9216 + modidx * 1024;
#pragma unroll
        for (int nt = 0; nt < 4; ++nt) {
            const int col = n0 + wn * 64 + nt * 16 + fr;
            const float gv = gp[col] * coef;
#pragma unroll
            for (int mt = 0; mt < 8; ++mt) {
#pragma unroll
                for (int r = 0; r < 4; ++r) {
                    const int row = m0 + wm * 128 + mt * 16 + fq * 4 + r;
                    p.out[(size_t)row * D + col] = xsrc[(size_t)row * D + col] + gv * acc[mt][nt][r];
                }
                __builtin_amdgcn_sched_barrier(0);
            }
        }
    }
}
DEV void ph_pgemm8(const Params& p, char* smem, int rvid, int RG, int tid) {
    const u16* H = WSP(u16, OFF_H);
    const u16* Wt = WSP(u16, OFF_W) + WE_MIX;
    u16* P = WSP(u16, OFF_P);
    u16* T = WSP(u16, OFF_T);
    float* Gt = WSP(float, OFF_G);
    const int lane = tid & 63, wave = tid >> 6, wm = wave >> 2, wn = wave & 3, fr = lane & 15, fq = lane >> 4;
    const int total = 128 * 12;
    for (int t = rvid; t < total; t += RG) {
        int mt_, nt_;
        tile_decode8(t, 12, mt_, nt_);
        const int m0 = mt_ * 256, n0 = nt_ * 256;
        f32x4 acc[8][4];
        zero_acc8(acc);
        gemm8_accum(acc, H + (size_t)m0 * D, D, Wt + (size_t)n0 * D, D, D, smem, tid);
        const int cb = n0 + wn * 64;
        const int j = cb >> 7;
        if (j >= 22) {
            if (cb == 2816) {
#pragma unroll
                for (int mt = 0; mt < 8; ++mt)
#pragma unroll
                    for (int r = 0; r < 4; ++r) {
                        const int row = m0 + wm * 128 + mt * 16 + fq * 4 + r;
                        Gt[(size_t)row * 16 + fr] = acc[mt][0][r];
                    }
            }
            continue;
        }
        const bool rowmajor = j < 16;
        const bool transp = (j == 10) || (j == 11) || (j >= 16);
        if (rowmajor) {
#pragma unroll
            for (int mt = 0; mt < 8; ++mt)
#pragma unroll
                for (int nt = 0; nt < 4; ++nt)
#pragma unroll
                    for (int r = 0; r < 4; ++r) {
                        const int row = m0 + wm * 128 + mt * 16 + fq * 4 + r;
                        P[(size_t)row * PW + cb + nt * 16 + fr] = (u16)(pk2(acc[mt][nt][r], 0.f) & 0xffff);
                    }
        }
        if (transp) {
            const int tcb = (j >= 16) ? (cb - 1792) : (cb - 1280);
            const int b = m0 >> 12, u0 = m0 & 4095;
#pragma unroll
            for (int mt = 0; mt < 8; ++mt)
#pragma unroll
                for (int nt = 0; nt < 4; ++nt) {
                    const int tc = tcb + nt * 16 + fr;
                    const int u = u0 + wm * 128 + mt * 16 + fq * 4;
                    *(uint2*)(T + ((size_t)(b * TW + tc)) * UT + u) = uint2{pk2(acc[mt][nt][0], acc[mt][nt][1]), pk2(acc[mt][nt][2], acc[mt][nt][3])};
                }
        }
    }
}

DEV int map_col(int type, int n) {
    if (type == 0) return n;
    if (type == 1) {
        const int jb = n >> 5, r = n & 31;
        return r < 16 ? jb * 16 + r : DFF + jb * 16 + (r - 16);
    }
    if (n < 256) return 1552 + n;
    if (n < 640) return 2064 + (n - 256);
    if (n < 1024) return 2448 + (n - 640);
    if (n < 1280) return 1808 + (n - 1024);
    if (n < 1536) return (n - 1280);
    if (n < 1920) return 528 + (n - 1536);
    if (n < 2048) return 1296 + (n - 1920);
    if (n < 2304) return 256 + (n - 2048);
    if (n < 2688) return 912 + (n - 2304);
    if (n < 2816) return 1424 + (n - 2688);
    if (n < 2832) return 512 + (n - 2816);
    if (n < 2944) return -1;
    return 2832 + (n - 2944);
}

DEV void conv_tile(const float* __restrict__ src, int ld_src, int type, u16* __restrict__ dst, int ld_dst, int k_off, int kt, int ntile, char* smem, int tid) {
    float* lds = (float*)smem;
    const int k0 = kt * 64, n0 = ntile * 64;
    {
        const int r = tid >> 6, c = tid & 63;
        const int col = map_col(type, n0 + c);
#pragma unroll 4
        for (int i = 0; i < 16; ++i) {
            const int k = r + 4 * i;
            float v = 0.f;
            if (col >= 0) v = src[(size_t)(k0 + k) * ld_src + col];
            lds[k * 65 + c] = v;
        }
    }
    __syncthreads();
    {
        const int n = tid >> 2, kq = tid & 3;
        uint32_t w[8];
#pragma unroll
        for (int j = 0; j < 8; ++j) w[j] = pk2(lds[(kq * 16 + 2 * j) * 65 + n], lds[(kq * 16 + 2 * j + 1) * 65 + n]);
        u16* d = dst + (size_t)(n0 + n) * ld_dst + k_off + k0 + kq * 16;
        *(uint4*)d = uint4{w[0], w[1], w[2], w[3]};
        *(uint4*)(d + 8) = uint4{w[4], w[5], w[6], w[7]};
    }
    __syncthreads();
}

DEV void ph_prep(const Params& p, int l, char* smem, int bid, int G) {
    u16* W = WSP(u16, OFF_W);
    const int tid = VTID;
    constexpr int N_CONV = 6240, N_MODS = 288;
    for (int it = bid; it < N_CONV + N_MODS; it += G) {
        if (it < N_CONV) {
            int r = it;
            if (r < 2816) {
                const int which = r / 1408; r -= which * 1408;
                conv_tile(p.ffn_w_in + (size_t)(l * 2 + which) * 1024 * 5632, 5632, 1, W + (which ? WE_IN1 : WE_IN0), 1024, 0, r / 88, r % 88, smem, tid);
                continue;
            }
            r -= 2816;
            if (r < 1408) {
                const int which = r / 704; r -= which * 704;
                conv_tile(p.ffn_w_out + (size_t)(l * 2 + which) * 2816 * 1024, 1024, 0, W + (which ? WE_OUT1 : WE_OUT0), 2816, 0, r / 16, r % 16, smem, tid);
                continue;
            }
            r -= 1408;
            if (r < 1504) {
                conv_tile(p.mix_w_in + (size_t)l * 1024 * NIN, NIN, 2, W + WE_MIX, 1024, 0, r / 94, r % 94, smem, tid);
                continue;
            }
            r -= 1504;
            if (r < 64) { conv_tile(p.w_br_ml + (size_t)l * 256 * 1024, 1024, 0, W + WE_BR, 1024, 0, r / 16, r % 16, smem, tid); continue; }
            r -= 64;
            if (r < 96) { conv_tile(p.w_br_na + (size_t)l * 384 * 1024, 1024, 0, W + WE_BR, 1024, 256, r / 16, r % 16, smem, tid); continue; }
            r -= 96;
            if (r < 96) { conv_tile(p.w_br_gq + (size_t)l * 384 * 1024, 1024, 0, W + WE_BR, 1024, 640, r / 16, r % 16, smem, tid); continue; }
            r -= 96;
            conv_tile(p.w_out + (size_t)l * 1024 * 1024, 1024, 0, W + WE_O, 1024, 0, r / 16, r % 16, smem, tid);
        } else {
            const int cb = it - N_CONV;
            float* s = (float*)smem;
            float* red = s + 9 * 1024;
            for (int i = tid; i < 9 * 1024; i += 256) {
                const int b = i >> 10, k = i & 1023;
                const float v = b < 8 ? p.c[b * 1024 + k] : p.c_ctx[k];
                s[i] = v * sigmoidf_(v);
            }
            __syncthreads();
            const int kg = tid >> 5, c = tid & 31, col = cb * 32 + c;
            float a[9];
#pragma unroll
            for (int b = 0; b < 9; ++b) a[b] = 0.f;
            const float* wp = p.ada_w + (size_t)l * 1024 * 9216 + (size_t)(kg * 128) * 9216 + col;
#pragma unroll 8
            for (int k = 0; k < 128; ++k) {
                const float w = wp[(size_t)k * 9216];
#pragma unroll
                for (int b = 0; b < 9; ++b) a[b] += s[b * 1024 + kg * 128 + k] * w;
            }
#pragma unroll
            for (int b = 0; b < 9; ++b) red[(kg * 9 + b) * 32 + c] = a[b];
            __syncthreads();
            for (int i = tid; i < 288; i += 256) {
                const int b = i >> 5, cc = i & 31;
                float v = p.ada_b[l * 9216 + cb * 32 + cc];
#pragma unroll
                for (int g = 0; g < 8; ++g) v += red[(g * 9 + b) * 32 + cc];
                WSP(float, OFF_MODS)[b * 9216 + cb * 32 + cc] = v;
            }
            __syncthreads();
        }
    }
    if (l == 0) {
        const size_t gt = (size_t)bid * 256 + tid, gs = (size_t)G * 256;
        const float4* cs = (const float4*)p.ctx; float4* cd = WSP(float4, OFF_XC);
        for (size_t i = gt; i < (size_t)NCX * D / 4; i += gs) cd[i] = cs[i];
        float* rope = WSP(float, OFF_ROPE);
        for (size_t i = gt; i < (size_t)4096 * 32; i += gs) {
            const int t = (int)(i >> 5), f = (int)(i & 31);
            const float pos = (float)((f < 16) ? (t >> 6) : (t & 63));
            const float inv = powf(10000.f, -(float)(f & 15) / 16.f);
            float sn, cs_;
            sincosf(pos * inv, &sn, &cs_);
            rope[i * 2] = cs_;
            rope[i * 2 + 1] = sn;
        }
    }
}

DEV void ph_mod(const Params& p, int l, int sub, int nrows, int bid, int G) {
    const bool first = (l == 0 && sub == 0);
    const int lane = VTID & 63, gw = bid * 4 + (VTID >> 6), NW = G * 4;
    const float* nw = p.norm_w + (size_t)(l * 3 + sub) * 1024;
    const float* mods = WSP(float, OFF_MODS);
    u16* H = WSP(u16, OFF_H);
    for (int r = gw; r < nrows; r += NW) {
        const float* xr = r < NL ? (first ? p.x : p.out) + (size_t)r * D : (first ? p.ctx : WSP(float, OFF_XC)) + (size_t)(r - NL) * D;
        const int b9 = r < NL ? (r >> 12) : 8;
        const float* sh = mods + b9 * 9216 + (3 * sub) * 1024;
        const float* sc = sh + 1024;
        float4 v[4];
        float ss = 0.f;
#pragma unroll
        for (int j = 0; j < 4; ++j) {
            v[j] = *(const float4*)(xr + lane * 4 + 256 * j);
            ss += v[j].x * v[j].x + v[j].y * v[j].y + v[j].z * v[j].z + v[j].w * v[j].w;
        }
        ss = wave_sum(ss);
        const float rstd = rsqrtf(ss * (1.f / 1024.f) + 1e-6f);
#pragma unroll
        for (int j = 0; j < 4; ++j) {
            const int k = lane * 4 + 256 * j;
            const float4 w = *(const float4*)(nw + k), s1 = *(const float4*)(sc + k), s0 = *(const float4*)(sh + k);
            const float y0 = v[j].x * rstd * w.x * (1.f + s1.x) + s0.x;
            const float y1 = v[j].y * rstd * w.y * (1.f + s1.y) + s0.y;
            const float y2 = v[j].z * rstd * w.z * (1.f + s1.z) + s0.z;
            const float y3 = v[j].w * rstd * w.w * (1.f + s1.w) + s0.w;
            *(uint2*)(H + (size_t)r * D + k) = uint2{pk2(y0, y1), pk2(y2, y3)};
        }
    }
}

DEV void ph_ffn_in(const Params& p, int which, int mt0, int mtiles, char* smem, int vid, int G) {
    const u16* H = WSP(u16, OFF_H);
    const u16* Wt = WSP(u16, OFF_W) + (which ? WE_IN1 : WE_IN0);
    u16* ACT = WSP(u16, OFF_P);
    const int lane = VTID & 63, wave = VTID >> 6, wm = wave >> 1, wn = wave & 1, fr = lane & 15, fq = lane >> 4;
    const int total = mtiles * 44;
    for (int t = vid; t < total; t += G) {
        int mt_, nt_;
        tile_decode(t, 44, mt_, nt_);
        mt_ += mt0;
        const int m0 = mt_ * 128, n0 = nt_ * 128;
        f32x4 acc[4][4];
        zero_acc<4>(acc);
        gemm_accum<4>(acc, H + (size_t)m0 * D, D, Wt + (size_t)n0 * D, D, D, smem, VTID);
#pragma unroll
        for (int mt = 0; mt < 4; ++mt)
#pragma unroll
            for (int pp = 0; pp < 2; ++pp)
#pragma unroll
                for (int r = 0; r < 4; ++r) {
                    const int row = m0 + wm * 64 + mt * 16 + fq * 4 + r;
                    const int hid = (n0 >> 1) + wn * 32 + pp * 16 + fr;
                    const float g = acc[mt][2 * pp][r], u = acc[mt][2 * pp + 1][r];
                    const float v = g * sigmoidf_(g) * u;
                    ACT[(size_t)row * DFF + hid] = (u16)(pk2(v, 0.f) & 0xffff);
                }
    }
}

DEV void ph_resid(const Params& p, const u16* A, int lda, const u16* Wt, int K, int modidx, float coef, int mt0, int mtiles, char* smem, int vid, int G) {
    const float* mods = WSP(float, OFF_MODS);
    const int lane = VTID & 63, wave = VTID >> 6, wm = wave >> 1, wn = wave & 1, fr = lane & 15, fq = lane >> 4;
    const int total = mtiles * 8 * 4;
    const int Kc = K >> 2;
    for (int t = vid; t < total; t += G) {
        int mt_, nt_;
        const int ksp = t & 3;
        tile_decode(t >> 2, 8, mt_, nt_);
        mt_ += mt0;
        const int m0 = mt_ * 128, n0 = nt_ * 128;
        f32x4 acc[4][4];
        zero_acc<4>(acc);
        gemm_accum<4>(acc, A + (size_t)m0 * lda + ksp * Kc, lda, Wt + (size_t)n0 * K + ksp * Kc, K, Kc, smem, VTID);
        const int b9 = m0 < NL ? (m0 >> 12) : 8;
        const float* gp = mods + b9 * 9216 + modidx * 1024;
#pragma unroll
        for (int nt = 0; nt < 4; ++nt) {
            const int col = n0 + wn * 64 + nt * 16 + fr;
            const float gv = gp[col] * coef;
#pragma unroll
            for (int mt = 0; mt < 4; ++mt)
#pragma unroll
                for (int r = 0; r < 4; ++r) {
                    const int row = m0 + wm * 64 + mt * 16 + fq * 4 + r;
                    float* xp = (row < NL ? p.out + (size_t)row * D : WSP(float, OFF_XC) + (size_t)(row - NL) * D) + col;
                    __hip_atomic_fetch_add(xp, gv * acc[mt][nt][r], __ATOMIC_RELAXED, __HIP_MEMORY_SCOPE_AGENT);
                }
        }
    }
}

DEV void ph_pgemm(const Params& p, int mt0, int mtiles, char* smem, int vid, int G) {
    const u16* H = WSP(u16, OFF_H);
    const u16* Wt = WSP(u16, OFF_W) + WE_MIX;
    u16* P = WSP(u16, OFF_P);
    u16* T = WSP(u16, OFF_T);
    float* Gt = WSP(float, OFF_G);
    const int lane = VTID & 63, wave = VTID >> 6, wm = wave >> 1, wn = wave & 1, fr = lane & 15, fq = lane >> 4;
    const int total = mtiles * 23;
    for (int t = vid; t < total; t += G) {
        int mt_, nt_;
        tile_decode(t, 23, mt_, nt_);
        mt_ += mt0;
        const int m0 = mt_ * 128, n0 = nt_ * 128;
        f32x4 acc[4][4];
        zero_acc<4>(acc);
        gemm_accum<4>(acc, H + (size_t)m0 * D, D, Wt + (size_t)n0 * D, D, D, smem, VTID);
        if (nt_ == 22) {
            if (wn == 0) {
#pragma unroll
                for (int mt = 0; mt < 4; ++mt)
#pragma unroll
                    for (int r = 0; r < 4; ++r) {
                        const int row = m0 + wm * 64 + mt * 16 + fq * 4 + r;
                        Gt[(size_t)row * 16 + fr] = acc[mt][0][r];
                    }
            }
            continue;
        }
        const bool rowmajor = nt_ < 16;
        const bool transp = (nt_ == 10) || (nt_ == 11) || (nt_ >= 16);
        if (rowmajor) {
#pragma unroll
            for (int mt = 0; mt < 4; ++mt)
#pragma unroll
                for (int nt = 0; nt < 4; ++nt)
#pragma unroll
                    for (int r = 0; r < 4; ++r) {
                        const int row = m0 + wm * 64 + mt * 16 + fq * 4 + r;
                        const int col = n0 + wn * 64 + nt * 16 + fr;
                        P[(size_t)row * PW + col] = (u16)(pk2(acc[mt][nt][r], 0.f) & 0xffff);
                    }
        }
        if (transp) {
            const int tcb = (nt_ >= 16) ? (n0 - 1792) : (n0 - 1280);
            int b, u0;
            if (m0 < NL) { b = m0 >> 12; u0 = m0 & 4095; } else { b = (m0 - NL) >> 8; u0 = SEQ + ((m0 - NL) & 255); }
#pragma unroll
            for (int mt = 0; mt < 4; ++mt)
#pragma unroll
                for (int nt = 0; nt < 4; ++nt) {
                    const int tc = tcb + wn * 64 + nt * 16 + fr;
                    const int u = u0 + wm * 64 + mt * 16 + fq * 4;
                    *(uint2*)(T + ((size_t)(b * TW + tc)) * UT + u) = uint2{pk2(acc[mt][nt][0], acc[mt][nt][1]), pk2(acc[mt][nt][2], acc[mt][nt][3])};
                }
        }
    }
}

DEV void ph_qknorm_gates(const Params& p, int l, int bid, int G) {
    const int lane = VTID & 63, gw = bid * 4 + (VTID >> 6), NW = G * 4;
    u16* P = WSP(u16, OFF_P);
    for (int it = gw; it < NSCAN * NCH; it += NW) {
        const int sc = it / NCH, c = it - sc * NCH, dir = sc & 1, h = (sc >> 1) & 3, b = sc >> 3;
        const float* Gt = WSP(float, OFF_G);
        float* BC = WSP(float, OFF_BC) + (size_t)sc * UT;
        float* IG = WSP(float, OFF_IG) + (size_t)sc * UT;
        float* WE = WSP(float, OFF_AE) + (size_t)sc * UT;
        const float bi = p.ml_gate_b[l * 16 + dir * 8 + h], bf = p.ml_gate_b[l * 16 + dir * 8 + 4 + h];
        const int cu = cu_of(c, dir);
        const int u = cu * 64 + (dir ? 63 - lane : lane);
        const int row = rowof(b, u);
        const float ig = Gt[(size_t)row * 16 + dir * 8 + h] + bi;
        const float fp = Gt[(size_t)row * 16 + dir * 8 + 4 + h] + bf;
        const float lf = fminf(fp, 0.f) - log1pf(expf(-fabsf(fp)));
        float bc = lf;
#pragma unroll
        for (int o = 1; o < 64; o <<= 1) { const float tv = __shfl_up(bc, o); if (lane >= o) bc += tv; }
        const float btot = __shfl(bc, 63);
        const float wend = btot - bc + ig;
        const float mx = wave_max(wend);
        WE[u] = wend;
        BC[u] = bc;
        IG[u] = ig;
        if (lane == 0) { WSP(float, OFF_MS)[sc * NCH + c] = btot; WSP(float, OFF_DEC)[sc * NCH + c] = mx; }
    }
    const float* rope = WSP(float, OFF_ROPE);
    const int hs = lane >> 4, e4 = (lane & 15) * 4;
    for (int r = gw; r < MTOT; r += NW) {
        const bool latent = r < NL;
        const int tok = r & 4095;
#pragma unroll
        for (int g = 0; g < 5; ++g) {
            const int cbase = (g < 3 ? 256 + g * 256 : 1536 + (g - 3) * 256) + hs * 64 + e4;
            const int slot = g * 4 + hs;
            u16* pp = P + (size_t)r * PW + cbase;
            const uint2 raw = *(const uint2*)pp;
            float v0 = bflo(raw.x), v1 = bfhi(raw.x), v2 = bflo(raw.y), v3 = bfhi(raw.y);
            float ss = v0 * v0 + v1 * v1 + v2 * v2 + v3 * v3;
            ss += __shfl_xor(ss, 1); ss += __shfl_xor(ss, 2); ss += __shfl_xor(ss, 4); ss += __shfl_xor(ss, 8);
            const float* wv;
            float scl;
            bool do_rope;
            if (slot < 6) { wv = p.na_qk_w + (l * 2 + 0) * 64; scl = 0.125f; do_rope = false; }
            else if (slot < 12) { wv = p.gq_qk_w + (l * 2 + 0) * 64; scl = 0.125f; do_rope = latent; }
            else if (slot < 18) { wv = p.na_qk_w + (l * 2 + 1) * 64; scl = 1.f; do_rope = false; }
            else { wv = p.gq_qk_w + (l * 2 + 1) * 64; scl = 1.f; do_rope = latent; }
            const float rstd = rsqrtf(ss * (1.f / 64.f) + 1e-6f) * scl;
            const float4 w4 = *(const float4*)(wv + e4);
            v0 *= rstd * w4.x; v1 *= rstd * w4.y; v2 *= rstd * w4.z; v3 *= rstd * w4.w;
            const float o0 = __shfl_xor(v0, 8), o1 = __shfl_xor(v1, 8), o2 = __shfl_xor(v2, 8), o3 = __shfl_xor(v3, 8);
            if (do_rope) {
                const int fi = e4 & 31;
                const float4 cs01 = *(const float4*)(rope + ((size_t)tok * 32 + fi) * 2);
                const float4 cs23 = *(const float4*)(rope + ((size_t)tok * 32 + fi + 2) * 2);
                if (e4 < 32) {
                    v0 = v0 * cs01.x - o0 * cs01.y; v1 = v1 * cs01.z - o1 * cs01.w;
                    v2 = v2 * cs23.x - o2 * cs23.y; v3 = v3 * cs23.z - o3 * cs23.w;
                } else {
                    v0 = o0 * cs01.y + v0 * cs01.x; v1 = o1 * cs01.w + v1 * cs01.z;
                    v2 = o2 * cs23.y + v2 * cs23.x; v3 = o3 * cs23.w + v3 * cs23.z;
                }
            }
            *(uint2*)pp = uint2{pk2(v0, v1), pk2(v2, v3)};
        }
    }
}

template <int MT, bool NAMASK, int NWV>
DEV void flash_item(const Params& p, int b, int qrow0, int qcol, int kcol, int tcol, int ua, int n1, int ub, int ntiles,
                    int r_q, int rs, const float* __restrict__ rpb_h, char* smem, int ocol, float mfix = 0.f) {
    u16* P = WSP(u16, OFF_P);
    const u16* T = WSP(u16, OFF_T);
    const int tid = (NWV == 8) ? (int)(threadIdx.x + p.z) : VTID, lane = tid & 63, wave = tid >> 6, fr = lane & 15, fq = lane >> 4;
    constexpr int KVS = 64 * 144;
    char* Ks = smem;
    char* Vs = smem + 2 * KVS;
    float* rpb_s = (float*)(smem + 4 * KVS);
    __syncthreads();
    if (NAMASK) {
        for (int i = tid; i < 465; i += 256) rpb_s[i] = rpb_h[i] * 1.4426950408889634f;
    }
    Frag qf[MT][2];
#pragma unroll
    for (int mt = 0; mt < MT; ++mt)
#pragma unroll
        for (int ks = 0; ks < 2; ++ks)
            qf[mt][ks].q = *(const uint4*)(P + (size_t)(qrow0 + (wave * MT + mt) * 16 + fr) * PW + qcol + ks * 32 + fq * 8);
    const int lr = tid >> 3, lc8 = tid & 7;
    u32x4 rk0, rk1 = {0, 0, 0, 0}, rv0, rv1 = {0, 0, 0, 0};
#define FL_GLOAD(KT) do { const int kt_ = (KT); const int u0_ = kt_ < n1 ? ua + 64 * kt_ : ub + 64 * (kt_ - n1); const int row0_ = rowof(b, u0_); \
        rk0 = gld16(P + (size_t)(row0_ + lr) * PW + kcol + lc8 * 8); rv0 = gld16(T + ((size_t)(b * TW + tcol + lr)) * UT + u0_ + lc8 * 8); \
        if (NWV == 4) { rk1 = gld16(P + (size_t)(row0_ + lr + 32) * PW + kcol + lc8 * 8); rv1 = gld16(T + ((size_t)(b * TW + tcol + lr + 32)) * UT + u0_ + lc8 * 8); } } while (0)
#define FL_SSTORE(S) do { const int s_ = (S); \
        *(u32x4*)(Ks + s_ * KVS + lr * 144 + lc8 * 16) = rk0; *(u32x4*)(Vs + s_ * KVS + lr * 144 + lc8 * 16) = rv0; \
        if (NWV == 4) { *(u32x4*)(Ks + s_ * KVS + (lr + 32) * 144 + lc8 * 16) = rk1; *(u32x4*)(Vs + s_ * KVS + (lr + 32) * 144 + lc8 * 16) = rv1; } } while (0)
    FL_GLOAD(0);
    VM_WAIT0();
    FL_SSTORE(0);
    __syncthreads();
    f32x4 o[MT][4];
    float mrow[MT], lrow[MT];
#pragma unroll
    for (int mt = 0; mt < MT; ++mt) {
        mrow[mt] = -1e30f; lrow[mt] = 0.f;
#pragma unroll
        for (int dt = 0; dt < 4; ++dt) o[mt][dt] = f32x4{0.f, 0.f, 0.f, 0.f};
    }
    const float L2E = 1.4426950408889634f;
    for (int kt = 0; kt < ntiles; ++kt) {
        const int cur = kt & 1;
        const bool more = kt + 1 < ntiles;
        FL_GLOAD(more ? kt + 1 : kt);
        __builtin_amdgcn_sched_barrier(0);
        f32x4 s[MT][4];
#pragma unroll
        for (int mt = 0; mt < MT; ++mt)
#pragma unroll
            for (int nt = 0; nt < 4; ++nt) s[mt][nt] = f32x4{0.f, 0.f, 0.f, 0.f};
#pragma unroll
        for (int ks = 0; ks < 2; ++ks)
#pragma unroll
            for (int nt = 0; nt < 4; ++nt) {
                const bf16x8 kf = *(const bf16x8*)(Ks + cur * KVS + (nt * 16 + fr) * 144 + (ks * 32 + fq * 8) * 2);
#pragma unroll
                for (int mt = 0; mt < MT; ++mt) s[mt][nt] = mfma16(kf, qf[mt][ks].v, s[mt][nt]);
            }
        Frag pf[MT][2];
#pragma unroll
        for (int mt = 0; mt < MT; ++mt) {
            float rsum = 0.f;
            if (NAMASK && kt < 8) {
                const int qc = (wave * MT + mt) * 16 + fr;
                int cs = qc - 8; cs = cs < 0 ? 0 : (cs > 48 ? 48 : cs);
                const int brow = rs + kt - r_q + 7;
#pragma unroll
                for (int nt = 0; nt < 4; ++nt)
#pragma unroll
                    for (int r = 0; r < 4; ++r) {
                        const int kc = nt * 16 + fq * 4 + r;
                        const bool valid = (kc >= cs) && (kc < cs + 16);
                        const int bi = valid ? brow * 31 + (kc - qc + 15) : 0;
                        const float e = valid ? fexp2(fmaf(s[mt][nt][r], L2E, rpb_s[bi] - mfix)) : 0.f;
                        s[mt][nt][r] = e; rsum += e;
                    }
            } else {
#pragma unroll
                for (int nt = 0; nt < 4; ++nt)
#pragma unroll
                    for (int r = 0; r < 4; ++r) { const float e = fexp2(fmaf(s[mt][nt][r], L2E, -mfix)); s[mt][nt][r] = e; rsum += e; }
            }
            lrow[mt] += rsum;
#pragma unroll
            for (int ks = 0; ks < 2; ++ks) {
                pf[mt][ks].u[0] = pk2(s[mt][2 * ks][0], s[mt][2 * ks][1]);
                pf[mt][ks].u[1] = pk2(s[mt][2 * ks][2], s[mt][2 * ks][3]);
                pf[mt][ks].u[2] = pk2(s[mt][2 * ks + 1][0], s[mt][2 * ks + 1][1]);
                pf[mt][ks].u[3] = pk2(s[mt][2 * ks + 1][2], s[mt][2 * ks + 1][3]);
            }
        }
#pragma unroll
        for (int ks = 0; ks < 2; ++ks)
#pragma unroll
            for (int dt = 0; dt < 4; ++dt) {
                Frag vf;
                vf.d[0] = *(const uint2*)(Vs + cur * KVS + (dt * 16 + fr) * 144 + (ks * 32 + fq * 4) * 2);
                vf.d[1] = *(const uint2*)(Vs + cur * KVS + (dt * 16 + fr) * 144 + (ks * 32 + 16 + fq * 4) * 2);
#pragma unroll
                for (int mt = 0; mt < MT; ++mt) o[mt][dt] = mfma16(vf.v, pf[mt][ks].v, o[mt][dt]);
            }
        __builtin_amdgcn_sched_barrier(0);
        VM_WAIT0();
        FL_SSTORE(cur ^ 1);
        __syncthreads();
    }
#pragma unroll
    for (int mt = 0; mt < MT; ++mt) {
        const float inv = 1.f / xq_sum(lrow[mt]);
        u16* op = P + (size_t)(qrow0 + (wave * MT + mt) * 16 + fr) * PW + ocol;
#pragma unroll
        for (int dt = 0; dt < 4; ++dt)
            *(uint2*)(op + dt * 16 + fq * 4) = uint2{pk2(o[mt][dt][0] * inv, o[mt][dt][1] * inv), pk2(o[mt][dt][2] * inv, o[mt][dt][3] * inv)};
    }
}


DEV void m2_item(const Params& p, int sc, int c) {
    const u16* T = WSP(u16, OFF_T);
    const int lane = VTID & 63, wave = VTID >> 6, fr = lane & 15, fq = lane >> 4;
    const int dir = sc & 1, h = (sc >> 1) & 3, b = sc >> 3;
    const int u0 = cu_of(c, dir) * 64;
    const float* AE = WSP(float, OFF_AE) + (size_t)sc * UT + u0;
    float* S = WSP(float, OFF_S) + ((size_t)sc * NCH + c) * SCH;
    const float mnew = fmaxf(WSP(float, OFF_MS)[sc * NCH + c] + m_scan(p, sc, c), WSP(float, OFF_DEC)[sc * NCH + c]);
    f32x4 acc[4], accn[4];
#pragma unroll
    for (int nt = 0; nt < 4; ++nt) { acc[nt] = f32x4{0.f, 0.f, 0.f, 0.f}; accn[nt] = f32x4{0.f, 0.f, 0.f, 0.f}; }
    Frag ones;
    ones.u[0] = ones.u[1] = ones.u[2] = ones.u[3] = 0x3F803F80u;
#pragma unroll
    for (int ks = 0; ks < 2; ++ks) {
        Frag vf;
        vf.q = *(const uint4*)(T + ((size_t)(b * TW + TC_MLV + h * 64 + wave * 16 + fr)) * UT + u0 + ks * 32 + fq * 8);
        float4 a0 = *(const float4*)(AE + ks * 32 + fq * 8), a1 = *(const float4*)(AE + ks * 32 + fq * 8 + 4);
        a0.x = expf(a0.x - mnew); a0.y = expf(a0.y - mnew); a0.z = expf(a0.z - mnew); a0.w = expf(a0.w - mnew);
        a1.x = expf(a1.x - mnew); a1.y = expf(a1.y - mnew); a1.z = expf(a1.z - mnew); a1.w = expf(a1.w - mnew);
#pragma unroll
        for (int nt = 0; nt < 4; ++nt) {
            Frag kf, kb;
            kf.q = *(const uint4*)(T + ((size_t)(b * TW + TC_MLK + h * 64 + nt * 16 + fr)) * UT + u0 + ks * 32 + fq * 8);
            kb.u[0] = pk2(bflo(kf.u[0]) * a0.x * 0.125f, bfhi(kf.u[0]) * a0.y * 0.125f);
            kb.u[1] = pk2(bflo(kf.u[1]) * a0.z * 0.125f, bfhi(kf.u[1]) * a0.w * 0.125f);
            kb.u[2] = pk2(bflo(kf.u[2]) * a1.x * 0.125f, bfhi(kf.u[2]) * a1.y * 0.125f);
            kb.u[3] = pk2(bflo(kf.u[3]) * a1.z * 0.125f, bfhi(kf.u[3]) * a1.w * 0.125f);
            acc[nt] = mfma16(vf.v, kb.v, acc[nt]);
            if (wave == 0) accn[nt] = mfma16(ones.v, kb.v, accn[nt]);
        }
    }
#pragma unroll
    for (int nt = 0; nt < 4; ++nt) {
#pragma unroll
        for (int r = 0; r < 4; ++r) S[(wave * 16 + fq * 4 + r) * 64 + nt * 16 + fr] = acc[nt][r];
        if (wave == 0 && fq == 0) S[4096 + nt * 16 + fr] = accn[nt][0];
    }
}

DEV void ph_m3(const Params& p, int bid, int G) {
    const float* DEC = WSP(float, OFF_DEC);
    float* S = WSP(float, OFF_S);
    const int total = NSCAN * SCH;
    for (int i = bid * 256 + VTID; i < total; i += G * 256) {
        const int sc = i / SCH, e = i - sc * SCH;
        float* base = S + (size_t)sc * NCH * SCH + e;
        const float* mxp = DEC + sc * NCH;
        const float* btp = WSP(float, OFF_MS) + sc * NCH;
        float st = 0.f, m = 0.f;
#pragma unroll 4
        for (int c = 0; c < NCH; ++c) {
            const float tmp = base[(size_t)c * SCH];
            base[(size_t)c * SCH] = st;
            const float bm = btp[c] + m;
            const float mnew = fmaxf(bm, mxp[c]);
            st = expf(bm - mnew) * st + tmp;
            m = mnew;
        }
    }
}

DEV void m4_item(const Params& p, int l, int b, int h, int cu, int ocolbase) {
    u16* P = WSP(u16, OFF_P);
    const u16* T = WSP(u16, OFF_T);
    const int lane = VTID & 63, wave = VTID >> 6, fr = lane & 15, fq = lane >> 4;
    const int u0 = cu * 64;
    const int row0 = rowof(b, u0);
    const int j = wave * 16 + fr;
    Frag qf[2];
#pragma unroll
    for (int ks = 0; ks < 2; ++ks) qf[ks].q = *(const uint4*)(P + (size_t)(row0 + j) * PW + PC_MLQ + h * 64 + ks * 32 + fq * 8);
    f32x4 hsum[4];
#pragma unroll
    for (int dt = 0; dt < 4; ++dt) hsum[dt] = f32x4{0.f, 0.f, 0.f, 0.f};
#pragma unroll 1
    for (int dir = 0; dir < 2; ++dir) {
        const int sc = (b * 4 + h) * 2 + dir;
        int c;
        if (cu >= 64) c = dir ? 3 - (cu - 64) : (cu - 64); else c = 4 + (dir ? 63 - cu : cu);
        const float m0 = m_scan(p, sc, c);
        const float* BC = WSP(float, OFF_BC) + (size_t)sc * UT + u0;
        const float* IG = WSP(float, OFF_IG) + (size_t)sc * UT + u0;
        const float* S = WSP(float, OFF_S) + ((size_t)sc * NCH + c) * SCH;
        const float bj = BC[j];
        f32x4 s[4];
#pragma unroll
        for (int nt = 0; nt < 4; ++nt) s[nt] = f32x4{0.f, 0.f, 0.f, 0.f};
#pragma unroll
        for (int ks = 0; ks < 2; ++ks)
#pragma unroll
            for (int nt = 0; nt < 4; ++nt) {
                Frag kf;
                kf.q = *(const uint4*)(P + (size_t)(row0 + nt * 16 + fr) * PW + PC_MLK + h * 64 + ks * 32 + fq * 8);
                s[nt] = mfma16(kf.v, qf[ks].v, s[nt]);
            }
        float lw[4][4];
        float mx = -1e30f;
#pragma unroll
        for (int nt = 0; nt < 4; ++nt) {
            const float4 bs = *(const float4*)(BC + nt * 16 + fq * 4);
            const float4 is = *(const float4*)(IG + nt * 16 + fq * 4);
            const float bsv[4] = {bs.x, bs.y, bs.z, bs.w}, isv[4] = {is.x, is.y, is.z, is.w};
#pragma unroll
            for (int r = 0; r < 4; ++r) {
                const int sidx = nt * 16 + fq * 4 + r;
                const bool valid = dir ? (sidx >= j) : (sidx <= j);
                lw[nt][r] = valid ? (bj - bsv[r] + isv[r]) : -1e30f;
                mx = fmaxf(mx, lw[nt][r]);
            }
        }
        mx = xq_max(mx);
        const float minter = bj + m0;
        const float mj = fmaxf(minter, mx);
        const float g = fexp(minter - mj);
        float den = 0.f;
#pragma unroll
        for (int nt = 0; nt < 4; ++nt)
#pragma unroll
            for (int r = 0; r < 4; ++r) {
                const float w = fexp(lw[nt][r] - mj);
                const float qk = s[nt][r] * 0.125f * w;
                s[nt][r] = qk;
                den += qk;
            }
        den = xq_sum(den);
        Frag pf[2];
#pragma unroll
        for (int ks = 0; ks < 2; ++ks) {
            pf[ks].u[0] = pk2(s[2 * ks][0], s[2 * ks][1]);
            pf[ks].u[1] = pk2(s[2 * ks][2], s[2 * ks][3]);
            pf[ks].u[2] = pk2(s[2 * ks + 1][0], s[2 * ks + 1][1]);
            pf[ks].u[3] = pk2(s[2 * ks + 1][2], s[2 * ks + 1][3]);
        }
        f32x4 acc[4], accn = f32x4{0.f, 0.f, 0.f, 0.f};
#pragma unroll
        for (int dt = 0; dt < 4; ++dt) acc[dt] = f32x4{0.f, 0.f, 0.f, 0.f};
#pragma unroll
        for (int ks = 0; ks < 2; ++ks) {
            {
                const float4 n0 = *(const float4*)(S + 4096 + ks * 32 + fq * 8), n1 = *(const float4*)(S + 4096 + ks * 32 + fq * 8 + 4);
                Frag nf;
                nf.u[0] = pk2(n0.x, n0.y); nf.u[1] = pk2(n0.z, n0.w); nf.u[2] = pk2(n1.x, n1.y); nf.u[3] = pk2(n1.z, n1.w);
                accn = mfma16(nf.v, qf[ks].v, accn);
            }
#pragma unroll
            for (int dt = 0; dt < 4; ++dt) {
                const float* cp = S + (dt * 16 + fr) * 64 + ks * 32 + fq * 8;
                const float4 c0 = *(const float4*)cp, c1 = *(const float4*)(cp + 4);
                Frag cf;
                cf.u[0] = pk2(c0.x, c0.y); cf.u[1] = pk2(c0.z, c0.w); cf.u[2] = pk2(c1.x, c1.y); cf.u[3] = pk2(c1.z, c1.w);
                acc[dt] = mfma16(cf.v, qf[ks].v, acc[dt]);
            }
        }
#pragma unroll
        for (int dt = 0; dt < 4; ++dt) acc[dt] *= g;
        den += g * accn[0];
#pragma unroll
        for (int ks = 0; ks < 2; ++ks)
#pragma unroll
            for (int dt = 0; dt < 4; ++dt) {
                const u16* vp = T + ((size_t)(b * TW + TC_MLV + h * 64 + dt * 16 + fr)) * UT + u0 + ks * 32 + fq * 4;
                Frag vf;
                vf.d[0] = *(const uint2*)vp;
                vf.d[1] = *(const uint2*)(vp + 16);
                acc[dt] = mfma16(vf.v, pf[ks].v, acc[dt]);
            }
        const float dd = 1.f / fmaxf(fabsf(den), fexp(-mj));
#pragma unroll
        for (int dt = 0; dt < 4; ++dt) hsum[dt] += acc[dt] * dd;
    }
    float ss = 0.f;
#pragma unroll
    for (int dt = 0; dt < 4; ++dt)
#pragma unroll
        for (int r = 0; r < 4; ++r) ss += hsum[dt][r] * hsum[dt][r];
    ss = xq_sum(ss);
    const float rstd = rsqrtf(ss * (1.f / 64.f) + 1e-6f);
    const float* nw = p.ml_norm_w + l * 256 + h * 64;
    u16* orow = P + (size_t)(row0 + j) * PW;
#pragma unroll
    for (int dt = 0; dt < 4; ++dt) {
        const int v0 = dt * 16 + fq * 4;
        const float4 w4 = *(const float4*)(nw + v0);
        const uint2 og = *(const uint2*)(orow + PC_MLO + h * 64 + v0);
        const float y0 = hsum[dt][0] * rstd * w4.x * sigmoidf_(bflo(og.x));
        const float y1 = hsum[dt][1] * rstd * w4.y * sigmoidf_(bfhi(og.x));
        const float y2 = hsum[dt][2] * rstd * w4.z * sigmoidf_(bflo(og.y));
        const float y3 = hsum[dt][3] * rstd * w4.w * sigmoidf_(bfhi(og.y));
        *(uint2*)(orow + ocolbase + h * 64 + v0) = uint2{pk2(y0, y1), pk2(y2, y3)};
    }
}

DEV void ph_attn8(const Params& p, int l, char* smem0, int rbid, int RG) {
    const int n_gq = 768, n_c = (l == 0) ? 96 : 0;
    const int ln_ = (int)((threadIdx.x + p.z) & 63);
    const float bgq = 8.f * wave_max(fabsf(p.gq_qk_w[(l * 2 + 0) * 64 + ln_])) * wave_max(fabsf(p.gq_qk_w[(l * 2 + 1) * 64 + ln_])) * 1.4426950408889634f * 1.03f + 0.5f;
    const float bna = 8.f * wave_max(fabsf(p.na_qk_w[(l * 2 + 0) * 64 + ln_])) * wave_max(fabsf(p.na_qk_w[(l * 2 + 1) * 64 + ln_])) * 1.4426950408889634f * 1.03f + 0.5f;
    for (int it = rbid; it < n_gq + n_c; it += RG) {
        float mfix = bgq;
        int b, qrow0, qcol, kcol, tcol, ua, nt;
        if (it < n_gq) {
            const int qt = it & 15, hq = (it >> 4) % 6;
            b = it / 96; qrow0 = b * SEQ + qt * 256; qcol = PC_GQQ + hq * 64; kcol = PC_GQK + (hq / 3) * 64; tcol = TC_GQV + (hq / 3) * 64; ua = 0; nt = 68;
        } else {
            const int r = it - n_gq;
            const int kind = r / 48, rr = r % 48, hh = rr % 6;
            b = rr / 6; qrow0 = NL + b * CTXL; ua = SEQ; nt = 4;
            if (kind == 0) { qcol = PC_GQQ + hh * 64; kcol = PC_GQK + (hh / 3) * 64; tcol = TC_GQV + (hh / 3) * 64; }
            else { qcol = PC_NAQ + hh * 64; kcol = PC_NAK + hh * 64; tcol = TC_NAV + hh * 64; mfix = bna; }
        }
        flash_item<2, false, 8>(p, b, qrow0, qcol, kcol, tcol, ua, nt, 0, nt, 0, 0, nullptr, smem0, qcol, mfix);
    }
}
DEV void ph_attn(const Params& p, int l, char* smem, int bid, int G, int rep) {
    const int n_na = 3072, n_m2 = NSCAN * NCH;
    const int total = n_na + n_m2;
    const int ln_ = VTID & 63;
    float rmax = 0.f;
    for (int i = ln_; i < 6 * 465; i += 64) rmax = fmaxf(rmax, fabsf(p.na_rpb[(size_t)l * 6 * 465 + i]));
    const float mfix_na = (8.f * wave_max(fabsf(p.na_qk_w[(l * 2 + 0) * 64 + ln_])) * wave_max(fabsf(p.na_qk_w[(l * 2 + 1) * 64 + ln_])) * 1.03f + wave_max(rmax)) * 1.4426950408889634f + 0.5f;
    for (int it = bid; it < total; it += G) {
        int r = it;
        if (r < n_na) {
            const int gr = r & 63, hn = (r >> 6) % 6, b = r / 384;
            int rs = gr - 4; rs = rs < 0 ? 0 : (rs > 56 ? 56 : rs);
            flash_item<1, true, 4>(p, b, b * SEQ + gr * 64, PC_NAQ + hn * 64, PC_NAK + hn * 64, TC_NAV + hn * 64, rs * 64, 8, SEQ, 12, gr, rs,
                                p.na_rpb + (size_t)(l * 6 + hn) * 465, smem, PC_NAQ + hn * 64 + (rep ? 1792 : 0), mfix_na);
            continue;
        }
        r -= n_na;
        m2_item(p, r / NCH, r % NCH);
    }
}

DEV void ph_m4(const Params& p, int l, int bid, int G, int rep) {
    const int nch = (l == 0) ? NCH : 64;
    const int total = NB * 4 * nch;
    for (int it = bid; it < total; it += G) {
        const int cu = it % nch, h = (it / nch) & 3, b = it / (nch * 4);
        m4_item(p, l, b, h, cu, rep ? 2048 : PC_MLQ);
    }
}

DEV void ph_merge(const Params& p, int mt0, int mtiles, char* smem, int vid, int G) {
    const u16* H = WSP(u16, OFF_H);
    u16* P = WSP(u16, OFF_P);
    const u16* Wg = WSP(u16, OFF_W) + WE_MIX + (size_t)2944 * 1024;
    const u16* Wbr = WSP(u16, OFF_W) + WE_BR;
    const int lane = VTID & 63, wave = VTID >> 6, wm = wave >> 1, wn = wave & 1, fr = lane & 15, fq = lane >> 4;
    const int total = mtiles * 16;
    for (int t = vid; t < total; t += G) {
        int mt_, nt_;
        tile_decode(t, 16, mt_, nt_);
        mt_ += mt0;
        const int m0 = mt_ * 128, n0 = nt_ * 64;
        f32x4 y[4][2];
        zero_acc<2>(y);
#pragma unroll 1
        for (int br = 0; br < 3; ++br) {
            const int ko = br == 0 ? 0 : (br == 1 ? 256 : 640);
            const int kk = br == 0 ? 256 : 384;
            f32x4 g[4][2];
            zero_acc<2>(g);
            gemm_accum<2>(g, H + (size_t)m0 * D, D, Wg + (size_t)(br * 1024 + n0) * D, D, D, smem, VTID);
#pragma unroll
            for (int i = 0; i < 4; ++i)
#pragma unroll
                for (int jn = 0; jn < 2; ++jn)
#pragma unroll
                    for (int r = 0; r < 4; ++r) g[i][jn][r] = sigmoidf_(g[i][jn][r]);
            f32x4 a[4][2];
            zero_acc<2>(a);
            gemm_accum<2>(a, P + (size_t)m0 * PW + ko, PW, Wbr + (size_t)n0 * D + ko, D, kk, smem, VTID);
#pragma unroll
            for (int i = 0; i < 4; ++i)
#pragma unroll
                for (int jn = 0; jn < 2; ++jn) y[i][jn] += g[i][jn] * a[i][jn];
        }
#pragma unroll
        for (int mt = 0; mt < 4; ++mt)
#pragma unroll
            for (int nt = 0; nt < 2; ++nt)
#pragma unroll
                for (int r = 0; r < 4; ++r) {
                    const int row = m0 + wm * 64 + mt * 16 + fq * 4 + r;
                    const int col = n0 + wn * 32 + nt * 16 + fr;
                    P[(size_t)row * PW + PC_Y + col] = (u16)(pk2(y[mt][nt][r], 0.f) & 0xffff);
                }
    }
}


#ifdef DBG
constexpr size_t OFF_DBG = al256(WS_END);
__global__ void __launch_bounds__(64) dbg_mlstm(Params p, int l) {
    const int sc = blockIdx.x, dir = sc & 1, h = (sc >> 1) & 3, b = sc >> 3, lane = VTID;
    const u16* P = WSP(u16, OFF_P); const u16* T = WSP(u16, OFF_T); const float* Gt = WSP(float, OFF_G);
    float* HN = WSP(float, OFF_S) + (size_t)sc * UT * 64;
    const float bi = p.ml_gate_b[l * 16 + dir * 8 + h], bf = p.ml_gate_b[l * 16 + dir * 8 + 4 + h];
    float C[64], n[64];
    for (int k = 0; k < 64; ++k) { C[k] = 0.f; n[k] = 0.f; }
    float m = 0.f;
    for (int pos = 0; pos < UT; ++pos) {
        int u;
        if (pos < 256) u = SEQ + (dir ? 255 - pos : pos); else u = dir ? 4095 - (pos - 256) : (pos - 256);
        const int row = rowof(b, u);
        const float ig = Gt[(size_t)row * 16 + dir * 8 + h] + bi;
        const float fp = Gt[(size_t)row * 16 + dir * 8 + 4 + h] + bf;
        const float lf = fminf(fp, 0.f) - log1pf(expf(-fabsf(fp)));
        const float mn = fmaxf(lf + m, ig);
        const float fw = expf(lf + m - mn), iw = expf(ig - mn);
        m = mn;
        const float qv = __uint_as_float(((uint32_t)P[(size_t)row * PW + 2048 + h * 64 + lane]) << 16);
        const float kv = __uint_as_float(((uint32_t)P[(size_t)row * PW + PC_MLK + h * 64 + lane]) << 16) * 0.125f;
        const float vv = __uint_as_float(((uint32_t)T[((size_t)(b * TW + TC_MLV + h * 64 + lane)) * UT + u]) << 16);
        float num = 0.f, den = 0.f;
#pragma unroll
        for (int k = 0; k < 64; ++k) {
            const float kk = __shfl(kv, k), qq = __shfl(qv, k);
            C[k] = fw * C[k] + iw * kk * vv;
            n[k] = fw * n[k] + iw * kk;
            num += qq * C[k];
            den += qq * n[k];
        }
        HN[(size_t)u * 64 + lane] = num / fmaxf(fabsf(den), expf(-m));
    }
}
__global__ void dbg_cmp(Params p, int l) {
    const int gid = blockIdx.x * blockDim.x + VTID;
    const u16* P = WSP(u16, OFF_P); const u16* T = WSP(u16, OFF_T);
    unsigned* dw = (unsigned*)(p.ws + OFF_DBG);
    float* df = (float*)(p.ws + OFF_DBG);
    if (gid < NB * 4 * UT) {
        const int u = gid % UT, h = (gid / UT) & 3, b = gid / (UT * 4);
        const int row = rowof(b, u);
        const float* hf = WSP(float, OFF_S) + ((size_t)((b * 4 + h) * 2 + 0) * UT + u) * 64;
        const float* hb = WSP(float, OFF_S) + ((size_t)((b * 4 + h) * 2 + 1) * UT + u) * 64;
        float ss = 0.f;
        for (int v = 0; v < 64; ++v) { const float x = hf[v] + hb[v]; ss += x * x; }
        const float rstd = rsqrtf(ss / 64.f + 1e-6f);
        float md = 0.f;
        for (int v = 0; v < 64; ++v) {
            const float x = (hf[v] + hb[v]) * rstd * p.ml_norm_w[l * 256 + h * 64 + v];
            const float o = __uint_as_float(((uint32_t)P[(size_t)row * PW + PC_MLO + h * 64 + v]) << 16);
            const float y = x / (1.f + expf(-o));
            const float got = __uint_as_float(((uint32_t)P[(size_t)row * PW + PC_MLQ + h * 64 + v]) << 16);
            md += fabsf(y - got);
        }
        atomicAdd(df + (u < SEQ ? 0 : 1), md * (1.f / 64.f));
        return;
    }
    const int w = (gid - NB * 4 * UT) >> 6;
    const int lane = VTID & 63;
    int type, b, qrow, qc, kcol, tcol, ocol, hn = 0, gr = 0, gc = 0, nkeys;
    if (w < 6144) {
        type = 0; const int i = w & 127; hn = (w >> 7) % 6; b = w / 768;
        gr = i & 63; gc = (i < 64) ? gr : 63 - gr;
        qrow = b * SEQ + gr * 64 + gc; qc = 2048 + 256 + hn * 64; kcol = PC_NAK + hn * 64; tcol = TC_NAV + hn * 64; ocol = PC_NAQ + hn * 64; nkeys = 384;
    } else if (w < 6144 + 256) {
        type = 1; const int x = w - 6144; const int i = x & 15, hh = (x >> 4) & 1; b = x >> 5;
        qrow = b * SEQ + (i * 273) % 4096; qc = 2688 + hh * 64; kcol = PC_GQK + hh * 64; tcol = TC_GQV + hh * 64; ocol = PC_GQQ + hh * 3 * 64; nkeys = 4352;
    } else if (w < 6144 + 256 + 768) {
        type = 2; const int x = w - 6400; const int i = x & 15; hn = (x >> 4) % 6; b = x / 96;
        qrow = NL + b * CTXL + (i * 17) % 256; qc = 2048 + 256 + hn * 64; kcol = PC_NAK + hn * 64; tcol = TC_NAV + hn * 64; ocol = PC_NAQ + hn * 64; nkeys = 256;
    } else if (w < 6144 + 256 + 768 + 256) {
        type = 3; const int x = w - 7168; const int i = x & 15, hh = (x >> 4) & 1; b = x >> 5;
        qrow = NL + b * CTXL + (i * 17) % 256; qc = 2688 + hh * 64; kcol = PC_GQK + hh * 64; tcol = TC_GQV + hh * 64; ocol = PC_GQQ + hh * 3 * 64; nkeys = 256;
    } else return;
    const float q = __uint_as_float(((uint32_t)P[(size_t)qrow * PW + qc + lane]) << 16);
    float o = 0.f;
    int rs = gr - 4; rs = rs < 0 ? 0 : (rs > 56 ? 56 : rs);
    int cs = gc - 8; cs = cs < 0 ? 0 : (cs > 48 ? 48 : cs);
    float mx = -1e30f, lsum = 0.f;
    for (int kidx = 0; kidx < nkeys; ++kidx) {
        int u; float bias = 0.f;
        if (type == 0) {
            if (kidx < 128) {
                const int ri = kidx >> 4, ci = kidx & 15;
                u = (rs + ri) * 64 + cs + ci;
                bias = p.na_rpb[(size_t)(l * 6 + hn) * 465 + (rs + ri - gr + 7) * 31 + (cs + ci - gc + 15)];
            } else u = SEQ + (kidx - 128);
        } else if (type == 1) u = kidx;
        else u = SEQ + kidx;
        const int krow = rowof(b, u);
        float sdot = wave_sum(q * __uint_as_float(((uint32_t)P[(size_t)krow * PW + kcol + lane]) << 16));
        sdot += bias;
        const float mn = fmaxf(mx, sdot);
        const float al = expf(mx - mn), e = expf(sdot - mn);
        lsum = lsum * al + e; mx = mn;
        o = o * al + e * __uint_as_float(((uint32_t)T[((size_t)(b * TW + tcol + lane)) * UT + u]) << 16);
    }
    const float got = __uint_as_float(((uint32_t)P[(size_t)qrow * PW + ocol + lane]) << 16);
    float md = wave_max(fabsf(o / lsum - got));
    if (lane == 0) atomicMax(dw + 2 + type, __float_as_uint(md));
}
__global__ void dbg_copy(Params p) {
    u16* P = WSP(u16, OFF_P);
    for (size_t i = (size_t)blockIdx.x * 256 + VTID; i < (size_t)MTOT * 768; i += (size_t)gridDim.x * 256) {
        const size_t row = i / 768, c = i % 768;
        const size_t src = c < 640 ? c : (c < 704 ? PC_GQQ + (c - 640) : PC_GQQ + 192 + (c - 704));
        P[row * PW + 2048 + c] = P[row * PW + src];
    }
}
DEV int dbg_row(int sr) { return sr < 8 ? sr * 4096 + (sr * 577 + 13) % 4096 : NL + (sr - 8) * 256 + ((sr - 8) * 37 + 5) % 256; }
DEV float* dbg_xrow(const Params& p, int row) { return row < NL ? p.out + (size_t)row * D : WSP(float, OFF_XC) + (size_t)(row - NL) * D; }
DEV float dbg_mod(const Params& p, int l, int b9, int idx, int n) {
    float a = p.ada_b[l * 9216 + idx * 1024 + n];
    for (int k = 0; k < 1024; ++k) {
        const float c = b9 < 8 ? p.c[b9 * 1024 + k] : p.c_ctx[k];
        a += c / (1.f + expf(-c)) * p.ada_w[((size_t)l * 1024 + k) * 9216 + idx * 1024 + n];
    }
    return a;
}
DEV float blk_sum(float v, float* red) {
    v = wave_sum(v);
    __syncthreads();
    if ((VTID & 63) == 0) red[VTID >> 6] = v;
    __syncthreads();
    return red[0] + red[1] + red[2] + red[3];
}
DEV float blk_max(float v, float* red) {
    v = wave_max(v);
    __syncthreads();
    if ((VTID & 63) == 0) red[VTID >> 6] = v;
    __syncthreads();
    return fmaxf(fmaxf(red[0], red[1]), fmaxf(red[2], red[3]));
}
__global__ void dbg_save(Params p, int slot) {
    const int sr = blockIdx.x, row = dbg_row(sr);
    float* dst = (float*)(p.ws + OFF_DBG + 256) + ((size_t)slot * 16 + sr) * 1024;
    const float* src = dbg_xrow(p, row);
    for (int n = VTID; n < 1024; n += 256) dst[n] = src[n];
}
DEV float dbg_modulate(const Params& p, int l, int sub, int b9, const float* xs, float* hs, float* red) {
    float ss = 0.f;
    for (int n = VTID; n < 1024; n += 256) ss += xs[n] * xs[n];
    ss = blk_sum(ss, red);
    const float rstd = rsqrtf(ss / 1024.f + 1e-6f);
    float md = 0.f;
    for (int n = VTID; n < 1024; n += 256) {
        const float sh = dbg_mod(p, l, b9, 3 * sub, n), sc = dbg_mod(p, l, b9, 3 * sub + 1, n);
        md = fmaxf(md, fabsf(sh - WSP(float, OFF_MODS)[b9 * 9216 + (3 * sub) * 1024 + n]));
        md = fmaxf(md, fabsf(sc - WSP(float, OFF_MODS)[b9 * 9216 + (3 * sub + 1) * 1024 + n]));
        hs[n] = xs[n] * rstd * p.norm_w[(l * 3 + sub) * 1024 + n] * (1.f + sc) + sh;
    }
    __syncthreads();
    return md;
}
__global__ void __launch_bounds__(256) dbg_ffn(Params p, int l, int which, int slot, int bit) {
    __shared__ float xs[1024], hs[1024], gs[1024], as[2816], red[4];
    const int sr = blockIdx.x, row = dbg_row(sr), b9 = row < NL ? row >> 12 : 8, sub = which ? 2 : 0;
    const float* xin = (const float*)(p.ws + OFF_DBG + 256) + ((size_t)slot * 16 + sr) * 1024;
    for (int n = VTID; n < 1024; n += 256) xs[n] = xin[n];
    __syncthreads();
    float mdm = dbg_modulate(p, l, sub, b9, xs, hs, red);
    for (int n = VTID; n < 1024; n += 256) gs[n] = dbg_mod(p, l, b9, 3 * sub + 2, n);
    const float* win = p.ffn_w_in + (size_t)(l * 2 + which) * 1024 * 5632;
    const float* wout = p.ffn_w_out + (size_t)(l * 2 + which) * 2816 * 1024;
    for (int j = VTID; j < 2816; j += 256) {
        float g = 0.f, u = 0.f;
        for (int k = 0; k < 1024; ++k) { g += hs[k] * win[(size_t)k * 5632 + j]; u += hs[k] * win[(size_t)k * 5632 + 2816 + j]; }
        as[j] = g / (1.f + expf(-g)) * u;
    }
    __syncthreads();
    float md = 0.f;
    const float* xc = dbg_xrow(p, row);
    for (int n = VTID; n < 1024; n += 256) {
        float o = 0.f;
        for (int j = 0; j < 2816; ++j) o += as[j] * wout[(size_t)j * 1024 + n];
        md = fmaxf(md, fabsf(xs[n] + 0.5f * gs[n] * o - xc[n]));
    }
    md = blk_max(md, red);
    mdm = blk_max(mdm, red);
    unsigned* dw = (unsigned*)(p.ws + OFF_DBG);
    if (VTID == 0) { atomicMax(dw + bit, __float_as_uint(md)); atomicMax(dw + 15, __float_as_uint(mdm)); }
}
__global__ void __launch_bounds__(256) dbg_pchk(Params p, int l) {
    __shared__ float xs[1024], hs[1024], red[4];
    const int sr = blockIdx.x, row = dbg_row(sr), b9 = row < NL ? row >> 12 : 8;
    const float* xin = dbg_xrow(p, row);
    for (int n = VTID; n < 1024; n += 256) xs[n] = xin[n];
    __syncthreads();
    float mdm = dbg_modulate(p, l, 1, b9, xs, hs, red);
    const float* w = p.mix_w_in + (size_t)l * 1024 * NIN;
    const u16* P = WSP(u16, OFF_P); const u16* T = WSP(u16, OFF_T);
    int b, u;
    if (row < NL) { b = row >> 12; u = row & 4095; } else { b = (row - NL) >> 8; u = SEQ + ((row - NL) & 255); }
    float md = 0.f;
    for (int n = VTID; n < 2832; n += 256) {
        const int sc = map_col(2, n);
        float v = 0.f;
        for (int k = 0; k < 1024; ++k) v += hs[k] * w[(size_t)k * NIN + sc];
        if (n < 2048) md = fmaxf(md, fabsf(v - __uint_as_float(((uint32_t)P[(size_t)row * PW + n]) << 16)));
        if (n >= 1280 && n < 1536) md = fmaxf(md, fabsf(v - __uint_as_float(((uint32_t)T[((size_t)(b * TW + n - 1280)) * UT + u]) << 16)));
        if (n >= 2048 && n < 2816) md = fmaxf(md, fabsf(v - __uint_as_float(((uint32_t)T[((size_t)(b * TW + n - 1792)) * UT + u]) << 16)));
        if (n >= 2816) md = fmaxf(md, fabsf(v - WSP(float, OFF_G)[(size_t)row * 16 + n - 2816]));
    }
    md = blk_max(md, red);
    mdm = blk_max(mdm, red);
    unsigned* dw = (unsigned*)(p.ws + OFF_DBG);
    if (VTID == 0) { atomicMax(dw + 9, __float_as_uint(md)); atomicMax(dw + 15, __float_as_uint(mdm)); }
}
__global__ void __launch_bounds__(256) dbg_mix(Params p, int l, int slot) {
    __shared__ float xs[1024], hs[1024], os[1024], ys[1024], red[4];
    const int sr = blockIdx.x, row = dbg_row(sr), b9 = row < NL ? row >> 12 : 8;
    const float* xin = (const float*)(p.ws + OFF_DBG + 256) + ((size_t)slot * 16 + sr) * 1024;
    const u16* P = WSP(u16, OFF_P);
    for (int n = VTID; n < 1024; n += 256) { xs[n] = xin[n]; os[n] = __uint_as_float(((uint32_t)P[(size_t)row * PW + n]) << 16); }
    __syncthreads();
    float mdm = dbg_modulate(p, l, 1, b9, xs, hs, red);
    const float* w = p.mix_w_in + (size_t)l * 1024 * NIN;
    for (int n = VTID; n < 1024; n += 256) {
        float y = 0.f;
        for (int i = 0; i < 3; ++i) {
            float g = 0.f;
            for (int k = 0; k < 1024; ++k) g += hs[k] * w[(size_t)k * NIN + 2832 + i * 1024 + n];
            g = 1.f / (1.f + expf(-g));
            const float* wb = i == 0 ? p.w_br_ml + (size_t)l * 256 * 1024 : (i == 1 ? p.w_br_na + (size_t)l * 384 * 1024 : p.w_br_gq + (size_t)l * 384 * 1024);
            const int ko = i == 0 ? 0 : (i == 1 ? 256 : 640), kk = i == 0 ? 256 : 384;
            float a = 0.f;
            for (int k = 0; k < kk; ++k) a += os[ko + k] * wb[(size_t)k * 1024 + n];
            y += g * a;
        }
        ys[n] = y;
    }
    __syncthreads();
    float md = 0.f;
    const float* xc = dbg_xrow(p, row);
    for (int n = VTID; n < 1024; n += 256) {
        float o = 0.f;
        for (int k = 0; k < 1024; ++k) o += ys[k] * p.w_out[((size_t)l * 1024 + k) * 1024 + n];
        const float g5 = dbg_mod(p, l, b9, 5, n);
        md = fmaxf(md, fabsf(xs[n] + g5 * o - xc[n]));
    }
    md = blk_max(md, red);
    mdm = blk_max(mdm, red);
    unsigned* dw = (unsigned*)(p.ws + OFF_DBG);
    if (VTID == 0) { atomicMax(dw + 10, __float_as_uint(md)); atomicMax(dw + 15, __float_as_uint(mdm)); }
}
__global__ void dbg_fin(Params p) {
    const unsigned* dw = (const unsigned*)(p.ws + OFF_DBG);
    int mask = 0;
    if (__uint_as_float(dw[8]) > 0.02f) mask |= 1;
    if (__uint_as_float(dw[9]) > 0.03f) mask |= 2;
    if (__uint_as_float(dw[10]) > 0.02f) mask |= 4;
    if (__uint_as_float(dw[11]) > 0.02f) mask |= 8;
    if (__uint_as_float(dw[15]) > 1e-3f) mask |= 16;
    if (__uint_as_float(dw[4]) > 0.03f) mask |= 32;
    p.out[0] += 10.f * (float)mask;
    p.out[1] += 1000.f * __uint_as_float(dw[4]);
}
#endif


DEV void gemm8b_accum(f32x4 (&acc)[4][4], const u16* __restrict__ A, int lda, const u16* __restrict__ B, int ldb, int K, char* smem, int tid) {
    constexpr int STAGE = 49152;
    const int lane = tid & 63, wave = tid >> 6;
    const int wm = wave >> 1, wn = wave & 1, fr = lane & 15, fq = lane >> 4;
    const int lr = lane >> 3, pos = lane & 7;
    const int ce = pos ^ (lr >> 1), co = pos ^ (4 | (lr >> 1));
    const unsigned ra_ = (unsigned)((wave * 32 + lr) * lda) * 2u, rb_ = (unsigned)((wave * 16 + lr) * ldb) * 2u;
    const unsigned voa_e = ra_ + ce * 16, voa_o = ra_ + co * 16, vob_e = rb_ + ce * 16, vob_o = rb_ + co * 16;
    const int nk = K >> 6;
    const unsigned ldsb = (unsigned)(size_t)(__attribute__((address_space(3))) char*)smem;
    const unsigned ldsa_w = __builtin_amdgcn_readfirstlane(ldsb + wave * 4096);
    const unsigned ldsb_w = __builtin_amdgcn_readfirstlane(ldsb + 32768 + wave * 2048);
#define G8B_ISSUE(STG, K0) do { \
        _Pragma("unroll") for (int i = 0; i < 4; ++i) glds16(A + (size_t)(8 * i) * lda + (K0), (i & 1) ? voa_o : voa_e, ldsa_w + (STG) * STAGE + i * 1024); \
        _Pragma("unroll") for (int i = 0; i < 2; ++i) glds16(B + (size_t)(8 * i) * ldb + (K0), (i & 1) ? vob_o : vob_e, ldsb_w + (STG) * STAGE + i * 1024); \
    } while (0)
    G8B_ISSUE(0, 0);
    VM_WAIT0();
    __syncthreads();
    const int s3 = (fr >> 1) & 7;
    const int oa_base = (wm * 64 + fr) * 128 + ((fq ^ s3) * 16);
    const int ob_base = 32768 + (wn * 64 + fr) * 128 + ((fq ^ s3) * 16);
    for (int kt = 0; kt < nk; ++kt) {
        const int cur = kt & 1;
        const int k0 = (kt + 1 < nk ? kt + 1 : kt) * 64;
        G8B_ISSUE(cur ^ 1, k0);
        int o_a = cur * STAGE + oa_base, o_b = cur * STAGE + ob_base;
        asm volatile("" : "+v"(o_a), "+v"(o_b));
#pragma unroll
        for (int ks = 0; ks < 2; ++ks) {
            const char* sa_c = smem + (ks ? (o_a ^ 64) : o_a);
            const char* sb_c = smem + (ks ? (o_b ^ 64) : o_b);
            bf16x8 bfr[4], af[4];
#pragma unroll
            for (int nt = 0; nt < 4; ++nt) bfr[nt] = *(const bf16x8*)(sb_c + nt * 2048);
#pragma unroll
            for (int mt = 0; mt < 4; ++mt) af[mt] = *(const bf16x8*)(sa_c + mt * 2048);
#pragma unroll
            for (int mt = 0; mt < 4; ++mt)
#pragma unroll
                for (int nt = 0; nt < 4; ++nt) acc[mt][nt] = mfma16(af[mt], bfr[nt], acc[mt][nt]);
            __builtin_amdgcn_sched_group_barrier(0x100, 7, 0);
            __builtin_amdgcn_sched_group_barrier(0x008, 4, 0);
            __builtin_amdgcn_sched_group_barrier(0x100, 1, 0);
#pragma unroll
            for (int i = 0; i < 3; ++i) __builtin_amdgcn_sched_group_barrier(0x008, 4, 0);
        }
        VM_WAIT0();
        __syncthreads();
    }
#undef G8B_ISSUE
}

DEV void ph_merge8(const Params& p, char* smem, int rvid, int RG, int tid) {
    const u16* H = WSP(u16, OFF_H);
    u16* P = WSP(u16, OFF_P);
    const u16* Wg = WSP(u16, OFF_W) + WE_MIX + (size_t)2944 * 1024;
    const u16* Wbr = WSP(u16, OFF_W) + WE_BR;
    const int lane = tid & 63, wave = tid >> 6, wm = wave >> 1, wn = wave & 1, fr = lane & 15, fq = lane >> 4;
    const int total = 128 * 8;
    for (int t = rvid; t < total; t += RG) {
        const int gi = t >> 5, rem = t & 31;
        const int mt_ = gi * 4 + (rem & 3), nt_ = rem >> 2;
        const int m0 = mt_ * 256, n0 = nt_ * 128;
        f32x4 y[4][4];
        zero_acc<4>(y);
#pragma unroll 1
        for (int br = 0; br < 3; ++br) {
            const int ko = br == 0 ? 0 : (br == 1 ? 256 : 640);
            const int kk = br == 0 ? 256 : 384;
            uint32_t gpk[4][4][2];
            {
                f32x4 g[4][4];
                zero_acc<4>(g);
                gemm8b_accum(g, H + (size_t)m0 * D, D, Wg + (size_t)(br * 1024 + n0) * D, D, D, smem, tid);
#pragma unroll
                for (int i = 0; i < 4; ++i)
#pragma unroll
                    for (int jn = 0; jn < 4; ++jn) {
                        gpk[i][jn][0] = pk2(sigmoidf_(g[i][jn][0]), sigmoidf_(g[i][jn][1]));
                        gpk[i][jn][1] = pk2(sigmoidf_(g[i][jn][2]), sigmoidf_(g[i][jn][3]));
                    }
            }
            f32x4 a[4][4];
            zero_acc<4>(a);
            gemm8b_accum(a, P + (size_t)m0 * PW + ko, PW, Wbr + (size_t)n0 * D + ko, D, kk, smem, tid);
#pragma unroll
            for (int i = 0; i < 4; ++i)
#pragma unroll
                for (int jn = 0; jn < 4; ++jn) {
                    y[i][jn][0] += bflo(gpk[i][jn][0]) * a[i][jn][0];
                    y[i][jn][1] += bfhi(gpk[i][jn][0]) * a[i][jn][1];
                    y[i][jn][2] += bflo(gpk[i][jn][1]) * a[i][jn][2];
                    y[i][jn][3] += bfhi(gpk[i][jn][1]) * a[i][jn][3];
                }
        }
#pragma unroll
        for (int mt = 0; mt < 4; ++mt)
#pragma unroll
            for (int nt = 0; nt < 4; ++nt)
#pragma unroll
                for (int r = 0; r < 4; ++r) {
                    const int row = m0 + wm * 64 + mt * 16 + fq * 4 + r;
                    const int col = n0 + wn * 64 + nt * 16 + fr;
                    P[(size_t)row * PW + PC_Y + col] = (u16)(pk2(y[mt][nt][r], 0.f) & 0xffff);
                }
    }
}

constexpr int PH_PER_LAYER = 15;
constexpr int N_PHASES = 2 * PH_PER_LAYER;

#ifndef REPEAT_MASK
#define REPEAT_MASK 0
#endif
template <int Q>
DEV void run_phase_q(const Params& p, int l, char* smem) {
    const int half = (int)((threadIdx.x + p.z) >> 8);
    const int G = gridDim.x * 2, bid = blockIdx.x * 2 + half;
    const int vid = (gridDim.x % 8 == 0) ? (int)(blockIdx.x & 7) * (G >> 3) + (int)(blockIdx.x >> 3) * 2 + half : bid;
    smem += half * 73728;
    const bool last = (l == 1);
    const u16* W = WSP(u16, OFF_W);
    const int nrep = ((REPEAT_MASK >> Q) & 1) ? 2 : 1;
    char* smem0 = smem - half * 73728;
    const int rtid = (int)(threadIdx.x + p.z);
    const int RG = gridDim.x;
    const int rvid = (RG % 8 == 0) ? (int)(blockIdx.x & 7) * (RG >> 3) + (int)(blockIdx.x >> 3) : (int)blockIdx.x;
    for (int rep = 0; rep < nrep; ++rep) {
        const float cm = rep ? 0.f : 1.f;
        if (Q == 0) ph_prep(p, l, smem, bid, G);
        if (Q == 1) ph_mod(p, l, 0, MTOT, bid, G);
        Params p2 = p;
        if (Q == 2) { ph_ffn_in8(p, 0, smem0, rvid, RG, rtid); int z2 = p.z; asm volatile("" : "+s"(z2) :: "memory"); p2.z = z2; ph_ffn_in(p2, 0, 256, 16, smem, vid, G); }
        if (Q == 3) { ph_resid8(p, WSP(u16, OFF_P), DFF, W + WE_OUT0, DFF, 2, 0.5f * cm, smem0, rvid, RG, rtid, l == 0 ? p.x : p.out); int z2 = p.z; asm volatile("" : "+s"(z2) :: "memory"); p2.z = z2;
                      ph_resid(p2, WSP(u16, OFF_P), DFF, W + WE_OUT0, DFF, 2, 0.5f * cm, 256, 16, smem, vid, G); }
        if (Q == 4) ph_mod(p, l, 1, MTOT, bid, G);
        if (Q == 5) { ph_pgemm8(p, smem0, rvid, RG, rtid); int z2 = p.z; asm volatile("" : "+s"(z2) :: "memory"); p2.z = z2; ph_pgemm(p2, 256, 16, smem, vid, G); }
        if (Q == 6) ph_qknorm_gates(p, l, bid, G);
        if (Q == 7) { ph_attn8(p, l, smem0, rvid, RG); int z2 = p.z; asm volatile("" : "+s"(z2) :: "memory"); p2.z = z2; ph_attn(p2, l, smem, bid, G, rep); }
        if (Q == 8) ph_m3(p, bid, G);
        if (Q == 9) ph_m4(p, l, bid, G, rep);
        if (Q == 10) { ph_merge8(p, smem0, rvid, RG, rtid); int z2 = p.z; asm volatile("" : "+s"(z2) :: "memory"); p2.z = z2; if (!last) ph_merge(p2, 256, 16, smem, vid, G); }
        if (Q == 11) { ph_resid8(p, WSP(u16, OFF_P) + PC_Y, PW, W + WE_O, D, 5, 1.0f * cm, smem0, rvid, RG, rtid, p.out);
                       int z2 = p.z; asm volatile("" : "+s"(z2) :: "memory"); p2.z = z2;
                       if (!last) ph_resid(p2, WSP(u16, OFF_P) + PC_Y, PW, W + WE_O, D, 5, 1.0f * cm, 256, 16, smem, vid, G); }
        if (Q == 12) ph_mod(p, l, 2, last ? NL : MTOT, bid, G);
        if (Q == 13) { ph_ffn_in8(p, 1, smem0, rvid, RG, rtid); int z2 = p.z; asm volatile("" : "+s"(z2) :: "memory"); p2.z = z2; if (!last) ph_ffn_in(p2, 1, 256, 16, smem, vid, G); }
        if (Q == 14) { ph_resid8(p, WSP(u16, OFF_P), DFF, W + WE_OUT1, DFF, 8, 0.5f * cm, smem0, rvid, RG, rtid, p.out);
                       int z2 = p.z; asm volatile("" : "+s"(z2) :: "memory"); p2.z = z2;
                       if (!last) ph_resid(p2, WSP(u16, OFF_P), DFF, W + WE_OUT1, DFF, 8, 0.5f * cm, 256, 16, smem, vid, G); }
    }
}

DEV void run_phase(const Params& p, int ph, char* smem) {
    const int l = ph / PH_PER_LAYER, q = ph % PH_PER_LAYER;
    switch (q) {
        case 0: run_phase_q<0>(p, l, smem); break;
        case 1: run_phase_q<1>(p, l, smem); break;
        case 2: run_phase_q<2>(p, l, smem); break;
        case 3: run_phase_q<3>(p, l, smem); break;
        case 4: run_phase_q<4>(p, l, smem); break;
        case 5: run_phase_q<5>(p, l, smem); break;
        case 6: run_phase_q<6>(p, l, smem); break;
        case 7: run_phase_q<7>(p, l, smem); break;
        case 8: run_phase_q<8>(p, l, smem); break;
        case 9: run_phase_q<9>(p, l, smem); break;
        case 10: run_phase_q<10>(p, l, smem); break;
        case 11: run_phase_q<11>(p, l, smem); break;
        case 12: run_phase_q<12>(p, l, smem); break;
        case 13: run_phase_q<13>(p, l, smem); break;
        case 14: run_phase_q<14>(p, l, smem); break;
    }
}

template <int Q>
__global__ void __launch_bounds__(256, 2) phase_kernel(Params p, int l) {
    __shared__ __attribute__((aligned(16))) char smem[73728];
    run_phase_q<Q>(p, l, smem);
}

#if ONE_LAUNCH
#define XB_TMO      128
#define XB_XCNT(j)  (256  + 64 * (j))
#define XB_XSUB(j)  (1280 + 64 * (j))
#define XB_XGEN(j)  (2304 + 64 * (j))
#define XB_TOP      3328
#define XB_TOPGEN   3392
#define XB_SPIN_CAP (1u << 22)
DEV unsigned xb_ld(unsigned* q) { return __hip_atomic_load(q, __ATOMIC_RELAXED, __HIP_MEMORY_SCOPE_AGENT); }
DEV unsigned xb_add(unsigned* q, unsigned v) { return __hip_atomic_fetch_add(q, v, __ATOMIC_RELAXED, __HIP_MEMORY_SCOPE_AGENT); }
DEV unsigned xb_xcc_id() { return (unsigned)__builtin_amdgcn_s_getreg((3 << 11) | 20) & 0xFu; }
#define XB_SPIN(cond, bar) do { unsigned _sp = 0; while (cond) { __builtin_amdgcn_s_sleep(1); \
    if ((++_sp & 255u) == 0u) { if (xb_ld(&(bar)[XB_TMO])) break; if (_sp > XB_SPIN_CAP) { atomicAdd(&(bar)[XB_TMO], 1u); break; } } } } while (0)
DEV void xcd_census(unsigned* bar, unsigned x, unsigned& nloc, unsigned& nx) {
    const unsigned G = gridDim.x;
    unsigned sum, cnt, mine, sp = 0u;
    for (;;) {
        sum = 0u; cnt = 0u; mine = 0u;
#pragma unroll
        for (unsigned j = 0; j < 16; ++j) { const unsigned c = xb_ld(&bar[XB_XCNT(j)]); sum += c; cnt += (c > 0u) ? 1u : 0u; mine = (j == x) ? c : mine; }
        if (sum == G) break;
        __builtin_amdgcn_s_sleep(1);
        if ((++sp & 255u) == 0u) { if (xb_ld(&bar[XB_TMO])) break; if (sp > XB_SPIN_CAP) { atomicAdd(&bar[XB_TMO], 1u); break; } }
    }
    nloc = mine > 0u ? mine : 1u; nx = cnt > 0u ? cnt : 1u;
}
DEV void xcd_barrier(unsigned* bar, unsigned x, volatile unsigned* st, int tid) {
    asm volatile("s_waitcnt vmcnt(0)" ::: "memory");
    __syncthreads();
    if (tid == 0) {
        __builtin_amdgcn_s_waitcnt(0);
        unsigned nloc = st[0], nx = st[1];
        if (nloc == 0u) { xcd_census(bar, x, nloc, nx); st[0] = nloc; st[1] = nx; }
        const unsigned old = xb_add(&bar[XB_XSUB(x)], 1u);
        const unsigned gen = old / nloc;
        if (old + 1u == (gen + 1u) * nloc) {
            __builtin_amdgcn_fence(__ATOMIC_RELEASE, "agent");
            asm volatile("s_waitcnt vmcnt(0)" ::: "memory");
            const unsigned og = xb_add(&bar[XB_TOP], 1u);
            const unsigned tg = og / nx;
            if (og + 1u == (tg + 1u) * nx) xb_add(&bar[XB_TOPGEN], 1u);
            else XB_SPIN(xb_ld(&bar[XB_TOPGEN]) == tg, bar);
            __builtin_amdgcn_fence(__ATOMIC_ACQUIRE, "agent");
            xb_add(&bar[XB_XGEN(x)], 1u);
            asm volatile("s_waitcnt vmcnt(0)" ::: "memory");
        } else {
            XB_SPIN(xb_ld(&bar[XB_XGEN(x)]) == gen, bar);
            __builtin_amdgcn_fence(__ATOMIC_ACQUIRE, "agent");
            asm volatile("s_waitcnt vmcnt(0)" ::: "memory");
        }
    }
    __syncthreads();
}
__global__ void __launch_bounds__(512, 2) mega_kernel(Params p0, int ph_begin, int ph_end) {
    __shared__ __attribute__((aligned(16))) char smem[147456];
    __shared__ uint4 xb_words;
    unsigned* bar = (unsigned*)(p0.ws + OFF_BAR);
    const unsigned xcc = xb_xcc_id();
    if (threadIdx.x == 0) { xb_words = make_uint4(0u, 0u, 0u, 0u); (void)xb_add(&bar[XB_XCNT(xcc)], 1u); }
    __syncthreads();
    for (int ph = ph_begin; ph < ph_end; ++ph) {
        Params p = p0;
        int z = p0.z;
        asm volatile("" : "+s"(z));
        p.z = z;
        p.ws = p0.ws + z;
        p.out = p0.out + z;
        run_phase(p, ph, smem);
        if (ph + 1 < ph_end) {
            if (p0.z == 0x7fffffff) cg::this_grid().sync();
            xcd_barrier(bar, xcc, (volatile unsigned*)&xb_words, (int)threadIdx.x + z);
        }
    }
}
#endif

extern "C" void kernel_launch(void* const* d_in, const int* in_sizes, int n_in, void* d_out, int out_size, void* d_ws, size_t ws_size,
                              hipStream_t stream) {
    if (ws_size < WS_END) { fprintf(stderr, "workspace too small: %zu < %zu\n", ws_size, (size_t)WS_END); return; }
    Params p{};
    p.x = (const float*)d_in[0]; p.c = (const float*)d_in[1]; p.ctx = (const float*)d_in[2]; p.c_ctx = (const float*)d_in[3];
    p.ada_w = (const float*)d_in[4]; p.ada_b = (const float*)d_in[5]; p.norm_w = (const float*)d_in[6];
    p.ffn_w_in = (const float*)d_in[7]; p.ffn_w_out = (const float*)d_in[8]; p.mix_w_in = (const float*)d_in[9];
    p.ml_gate_b = (const float*)d_in[10]; p.ml_norm_w = (const float*)d_in[11]; p.na_qk_w = (const float*)d_in[12];
    p.na_rpb = (const float*)d_in[13]; p.gq_qk_w = (const float*)d_in[14]; p.w_br_ml = (const float*)d_in[15];
    p.w_br_na = (const float*)d_in[16]; p.w_br_gq = (const float*)d_in[17]; p.w_out = (const float*)d_in[18];
    p.out = (float*)d_out; p.ws = (char*)d_ws;
#ifdef NANFILL
    hipMemsetAsync(d_ws, 0xFF, WS_END, stream);
#endif
#if ONE_LAUNCH
    static int grid_blocks = 0;
    if (!grid_blocks) {
        int dev = 0, cus = 0, per_cu = 0;
        hipGetDevice(&dev);
        hipDeviceGetAttribute(&cus, hipDeviceAttributeMultiprocessorCount, dev);
        hipOccupancyMaxActiveBlocksPerMultiprocessor(&per_cu, mega_kernel, 512, 0);
        per_cu = 1;
        grid_blocks = cus * per_cu;
    }
    hipMemsetAsync((char*)d_ws + OFF_BAR, 0, 3456 * 4, stream);
    int pb = 0, pe = N_PHASES;
    void* args[] = {&p, &pb, &pe};
#ifdef SPLIT_TEST
    (void)args;
    for (int ph = 0; ph < N_PHASES; ++ph) mega_kernel<<<grid_blocks, 256, 0, stream>>>(p, ph, ph + 1);
#else
    hipError_t e = hipLaunchCooperativeKernel((void*)mega_kernel, dim3(grid_blocks), dim3(512), args, 0, stream);
    if (e != hipSuccess) fprintf(stderr, "cooperative launch failed: %s (grid %d)\n", hipGetErrorString(e), grid_blocks);
#endif
#else
    for (int l = 0; l < 2; ++l) {
#define LP(Q) phase_kernel<Q><<<512, 256, 0, stream>>>(p, l)
#ifdef DBG
        const bool dl = (l == DBG_LAYER);
        if (dl) hipMemsetAsync((char*)d_ws + OFF_DBG, 0, 256, stream);
        LP(0);
        if (dl) dbg_save<<<16, 256, 0, stream>>>(p, 0);
        LP(1); LP(2); LP(3);
        if (dl) dbg_ffn<<<16, 256, 0, stream>>>(p, l, 0, 0, 8);
        LP(4); LP(5);
        if (dl) dbg_pchk<<<16, 256, 0, stream>>>(p, l);
        LP(6);
        if (dl) dbg_copy<<<2048, 256, 0, stream>>>(p);
        LP(7); LP(8); LP(9);
        if (dl) {
            dbg_mlstm<<<64, 64, 0, stream>>>(p, l);
            dbg_cmp<<<(NB * 4 * UT + 7424 * 64 + 255) / 256, 256, 0, stream>>>(p, l);
            dbg_save<<<16, 256, 0, stream>>>(p, 1);
        }
        LP(10); LP(11);
        if (dl) { dbg_mix<<<16, 256, 0, stream>>>(p, l, 1); dbg_save<<<16, 256, 0, stream>>>(p, 2); }
        LP(12); LP(13); LP(14);
        if (dl) dbg_ffn<<<16, 256, 0, stream>>>(p, l, 1, 2, 11);
#else
        LP(0); LP(1); LP(2); LP(3); LP(4); LP(5); LP(6); LP(7); LP(8); LP(9); LP(10); LP(11); LP(12); LP(13); LP(14);
#endif
#undef LP
    }
#ifdef DBG
    dbg_fin<<<1, 1, 0, stream>>>(p);
#endif
#endif
}
```

```cpp
#include <hip/hip_runtime.h>
#include <hip/hip_cooperative_groups.h>
#include <stdint.h>
#include <cstdio>
namespace cg = cooperative_groups;

#ifndef ONE_LAUNCH
#define ONE_LAUNCH 1
#endif

#define VTID ((int)((threadIdx.x + p.z) & 255))
typedef unsigned short u16;
typedef __attribute__((ext_vector_type(8))) short bf16x8;
typedef __attribute__((ext_vector_type(4))) float f32x4;
#define DEV __device__ __forceinline__

constexpr int D = 1024, NB = 8, SEQ = 4096, CTXL = 256;
constexpr int NL = NB * SEQ, NCX = NB * CTXL, MTOT = NL + NCX;
constexpr int DFF = 2816, PW = 2816, UT = SEQ + CTXL, NCH = UT / 64;
constexpr int NIN = 5904;
constexpr int PC_MLQ = 0, PC_NAQ = 256, PC_GQQ = 640, PC_MLO = 1024, PC_MLK = 1280, PC_NAK = 1536, PC_GQK = 1920,
              PC_MLV = 2048, PC_NAV = 2304, PC_GQV = 2688, PC_Y = 1024;
constexpr int TC_MLK = 0, TC_MLV = 256, TC_NAV = 512, TC_GQV = 896, TW = 1024;
constexpr int DBG_MLO = PC_MLQ, DBG_NAO = PC_NAQ;
constexpr int SCH = 4160;
constexpr int NSCAN = 64;

constexpr size_t al256(size_t x) { return (x + 255) & ~(size_t)255; }
constexpr size_t OFF_MODS = 0;
constexpr size_t OFF_ROPE = al256(OFF_MODS + (size_t)9 * 9216 * 4);
constexpr size_t OFF_G    = al256(OFF_ROPE + (size_t)4096 * 64 * 4);
constexpr size_t OFF_BC   = al256(OFF_G + (size_t)MTOT * 16 * 4);
constexpr size_t OFF_IG   = al256(OFF_BC + (size_t)NSCAN * UT * 4);
constexpr size_t OFF_AE   = al256(OFF_IG + (size_t)NSCAN * UT * 4);
constexpr size_t OFF_MS   = al256(OFF_AE + (size_t)NSCAN * UT * 4);
constexpr size_t OFF_DEC  = al256(OFF_MS + (size_t)NSCAN * NCH * 4);
constexpr size_t OFF_XC   = al256(OFF_DEC + (size_t)NSCAN * NCH * 4);
constexpr size_t OFF_H    = al256(OFF_XC + (size_t)NCX * D * 4);
constexpr size_t OFF_P    = al256(OFF_H + (size_t)MTOT * D * 2);
constexpr size_t OFF_T    = al256(OFF_P + (size_t)MTOT * PW * 2);
constexpr size_t OFF_S    = al256(OFF_T + (size_t)NB * TW * UT * 2);
constexpr size_t OFF_W    = al256(OFF_S + (size_t)NSCAN * NCH * SCH * 4);
constexpr size_t WE_IN0 = 0, WE_IN1 = WE_IN0 + (size_t)5632 * 1024, WE_OUT0 = WE_IN1 + (size_t)5632 * 1024,
                 WE_OUT1 = WE_OUT0 + (size_t)1024 * 2816, WE_MIX = WE_OUT1 + (size_t)1024 * 2816,
                 WE_BR = WE_MIX + (size_t)6016 * 1024, WE_O = WE_BR + (size_t)1024 * 1024, WE_END = WE_O + (size_t)1024 * 1024;
constexpr size_t OFF_BAR = al256(OFF_W + WE_END * 2);
constexpr size_t WS_END = OFF_BAR + 3456 * 4;
static_assert(WS_END < (size_t)536000000, "workspace too large");

struct Params {
    const float *x, *c, *ctx, *c_ctx, *ada_w, *ada_b, *norm_w, *ffn_w_in, *ffn_w_out, *mix_w_in, *ml_gate_b, *ml_norm_w,
        *na_qk_w, *na_rpb, *gq_qk_w, *w_br_ml, *w_br_na, *w_br_gq, *w_out;
    float* out;
    char* ws;
    int z, pad;
};

DEV uint32_t pk2(float lo, float hi) { uint32_t r; asm("v_cvt_pk_bf16_f32 %0, %1, %2" : "=v"(r) : "v"(lo), "v"(hi)); return r; }
DEV float bflo(uint32_t w) { return __uint_as_float(w << 16); }
DEV float bfhi(uint32_t w) { return __uint_as_float(w & 0xffff0000u); }
DEV f32x4 mfma16(bf16x8 a, bf16x8 b, f32x4 c) { return __builtin_amdgcn_mfma_f32_16x16x32_bf16(a, b, c, 0, 0, 0); }
typedef unsigned u32x4 __attribute__((ext_vector_type(4)));
DEV u32x4 gld16(const void* q) { u32x4 r; asm volatile("global_load_dwordx4 %0, %1, off" : "=v"(r) : "v"(q) : "memory"); return r; }
DEV u32x4 gld16s(const void* sbase, unsigned voff) { u32x4 r; asm volatile("global_load_dwordx4 %0, %1, %2" : "=v"(r) : "v"(voff), "s"(sbase) : "memory"); return r; }
DEV void glds16(const void* sbase, unsigned voff, unsigned ldsaddr) {
    asm volatile("s_mov_b32 m0, %2\n\ts_nop 0\n\tglobal_load_lds_dwordx4 %0, %1" :: "v"(voff), "s"(sbase), "s"(ldsaddr) : "memory", "m0");
}
#define VM_WAIT0() asm volatile("s_waitcnt vmcnt(0)" ::: "memory")
union Frag { bf16x8 v; uint4 q; uint32_t u[4]; uint2 d[2]; };
DEV int cu_of(int c, int dir) { return c < 4 ? 64 + (dir ? 3 - c : c) : (dir ? 63 - (c - 4) : (c - 4)); }
DEV int rowof(int b, int u) { return u < SEQ ? b * SEQ + u : NL + b * CTXL + (u - SEQ); }
DEV float fexp2(float x) { return __builtin_amdgcn_exp2f(x); }
DEV float fexp(float x) { return __builtin_amdgcn_exp2f(x * 1.4426950408889634f); }
DEV float sigmoidf_(float x) { return 1.f / (1.f + fexp(-x)); }
DEV float xq_max(float v) {
    auto r = __builtin_amdgcn_permlane16_swap(__float_as_uint(v), __float_as_uint(v), false, false);
    const float m = fmaxf(__uint_as_float(r[0]), __uint_as_float(r[1]));
    auto q = __builtin_amdgcn_permlane32_swap(__float_as_uint(m), __float_as_uint(m), false, false);
    return fmaxf(__uint_as_float(q[0]), __uint_as_float(q[1]));
}
DEV float xq_sum(float v) {
    auto r = __builtin_amdgcn_permlane16_swap(__float_as_uint(v), __float_as_uint(v), false, false);
    const float m = __uint_as_float(r[0]) + __uint_as_float(r[1]);
    auto q = __builtin_amdgcn_permlane32_swap(__float_as_uint(m), __float_as_uint(m), false, false);
    return __uint_as_float(q[0]) + __uint_as_float(q[1]);
}
DEV float wave_sum(float v) {
#pragma unroll
    for (int o = 1; o < 64; o <<= 1) v += __shfl_xor(v, o);
    return v;
}
DEV float wave_max(float v) {
#pragma unroll
    for (int o = 1; o < 64; o <<= 1) v = fmaxf(v, __shfl_xor(v, o));
    return v;
}

#define WSP(T_, off) ((T_*)(p.ws + (off)))
DEV float m_scan(const Params& p, int sc, int c_end) {
    const float* BT = WSP(float, OFF_MS) + sc * NCH;
    const float* MX = WSP(float, OFF_DEC) + sc * NCH;
    const int lane = VTID & 63;
    const float bt0 = BT[lane], mx0 = MX[lane], bt1 = BT[64 + (lane & 3)], mx1 = MX[64 + (lane & 3)];
    float m = 0.f;
    for (int c = 0; c < c_end; ++c) {
        const float b = c < 64 ? __shfl(bt0, c) : __shfl(bt1, c - 64);
        const float x = c < 64 ? __shfl(mx0, c) : __shfl(mx1, c - 64);
        m = fmaxf(b + m, x);
    }
    return m;
}

template <int TN>
DEV void gemm_accum(f32x4 (&acc)[4][TN], const u16* __restrict__ A, int lda, const u16* __restrict__ B, int ldb, int K, char* smem, int tid) {
    constexpr int BROWS = TN * 32;
    constexpr int STAGE = (128 + BROWS) * 144;
    constexpr int NBCH = BROWS / 32;
    const int lane = tid & 63, wave = tid >> 6;
    const int wm = wave >> 1, wn = wave & 1, fr = lane & 15, fq = lane >> 4;
    const int lrow = tid >> 3, lc8 = tid & 7;
    const u16* ga = A + (size_t)lrow * lda + lc8 * 8;
    const u16* gb = B + (size_t)lrow * ldb + lc8 * 8;
    u32x4 ra[4], rb[NBCH];
    const int nk = K >> 6;
#pragma unroll
    for (int i = 0; i < 4; ++i) ra[i] = gld16(ga + (size_t)(32 * i) * lda);
#pragma unroll
    for (int i = 0; i < NBCH; ++i) rb[i] = gld16(gb + (size_t)(32 * i) * ldb);
    char* sw = smem + lrow * 144 + lc8 * 16;
    VM_WAIT0();
#pragma unroll
    for (int i = 0; i < 4; ++i) *(u32x4*)(sw + i * 32 * 144) = ra[i];
#pragma unroll
    for (int i = 0; i < NBCH; ++i) *(u32x4*)(sw + 128 * 144 + i * 32 * 144) = rb[i];
    __syncthreads();
    const char* sa_r = smem + (wm * 64 + fr) * 144 + fq * 16;
    const char* sb_r = smem + 128 * 144 + (wn * TN * 16 + fr) * 144 + fq * 16;
    for (int kt = 0; kt < nk; ++kt) {
        const int cur = kt & 1;
        const int k0 = (kt + 1 < nk ? kt + 1 : kt) * 64;
#pragma unroll
        for (int i = 0; i < 4; ++i) ra[i] = gld16(ga + (size_t)(32 * i) * lda + k0);
#pragma unroll
        for (int i = 0; i < NBCH; ++i) rb[i] = gld16(gb + (size_t)(32 * i) * ldb + k0);
        __builtin_amdgcn_sched_barrier(0);
#pragma unroll
        for (int ks = 0; ks < 2; ++ks) {
            bf16x8 af[4], bfr[TN];
#pragma unroll
            for (int mt = 0; mt < 4; ++mt) af[mt] = *(const bf16x8*)(sa_r + cur * STAGE + mt * 16 * 144 + ks * 64);
#pragma unroll
            for (int nt = 0; nt < TN; ++nt) bfr[nt] = *(const bf16x8*)(sb_r + cur * STAGE + nt * 16 * 144 + ks * 64);
#pragma unroll
            for (int mt = 0; mt < 4; ++mt)
#pragma unroll
                for (int nt = 0; nt < TN; ++nt) acc[mt][nt] = mfma16(af[mt], bfr[nt], acc[mt][nt]);
        }
        __builtin_amdgcn_sched_barrier(0);
        VM_WAIT0();
        {
            char* sw2 = sw + (cur ^ 1) * STAGE;
#pragma unroll
            for (int i = 0; i < 4; ++i) *(u32x4*)(sw2 + i * 32 * 144) = ra[i];
#pragma unroll
            for (int i = 0; i < NBCH; ++i) *(u32x4*)(sw2 + 128 * 144 + i * 32 * 144) = rb[i];
        }
        __syncthreads();
    }
}

template <int TN>
DEV void zero_acc(f32x4 (&acc)[4][TN]) {
#pragma unroll
    for (int i = 0; i < 4; ++i)
#pragma unroll
        for (int j = 0; j < TN; ++j) acc[i][j] = f32x4{0.f, 0.f, 0.f, 0.f};
}

DEV void tile_decode(int t, int ntn, int& mt, int& nt) {
    const int per = 8 * ntn;
    const int gi = t / per, rem = t - gi * per;
    nt = rem >> 3;
    mt = gi * 8 + (rem & 7);
}


template <bool SWAP = false>
DEV void gemm8_accum(f32x4 (&acc)[8][4], const u16* __restrict__ A, int lda, const u16* __restrict__ B, int ldb, int K, char* smem, int tid) {
    constexpr int STAGE = 65536;
    const int lane = tid & 63, wave = tid >> 6;
    const int wm = wave >> 2, wn = wave & 3, fr = lane & 15, fq = lane >> 4;
    const int lr = lane >> 3, pos = lane & 7;
    const int ce = pos ^ (lr >> 1), co = pos ^ (4 | (lr >> 1));
    const unsigned ra_ = (unsigned)((wave * 32 + lr) * lda) * 2u, rb_ = (unsigned)((wave * 32 + lr) * ldb) * 2u;
    const unsigned voa_e = ra_ + ce * 16, voa_o = ra_ + co * 16, vob_e = rb_ + ce * 16, vob_o = rb_ + co * 16;
    const int nk = K >> 6;
    const unsigned ldsw = __builtin_amdgcn_readfirstlane((unsigned)(size_t)(__attribute__((address_space(3))) char*)smem + wave * 4096);
#define G8_ISSUE(STG, K0) do { \
        _Pragma("unroll") for (int i = 0; i < 4; ++i) { \
            glds16(A + (size_t)(8 * i) * lda + (K0), (i & 1) ? voa_o : voa_e, ldsw + (STG) * STAGE + i * 1024); \
            glds16(B + (size_t)(8 * i) * ldb + (K0), (i & 1) ? vob_o : vob_e, ldsw + (STG) * STAGE + 32768 + i * 1024); \
        } } while (0)
    G8_ISSUE(0, 0);
    VM_WAIT0();
    __syncthreads();
    const int s3 = (fr >> 1) & 7;
    const int oa_base = (wm * 128 + fr) * 128 + ((fq ^ s3) * 16);
    const int ob_base = 32768 + (wn * 64 + fr) * 128 + ((fq ^ s3) * 16);
    for (int kt = 0; kt < nk; ++kt) {
        const int cur = kt & 1;
        const int k0 = (kt + 1 < nk ? kt + 1 : kt) * 64;
        G8_ISSUE(cur ^ 1, k0);
        int o_a = cur * STAGE + oa_base, o_b = cur * STAGE + ob_base;
        asm volatile("" : "+v"(o_a), "+v"(o_b));
#pragma unroll
        for (int ks = 0; ks < 2; ++ks) {
            const char* sa_c = smem + (ks ? (o_a ^ 64) : o_a);
            const char* sb_c = smem + (ks ? (o_b ^ 64) : o_b);
            bf16x8 bfr[4], af[8];
#pragma unroll
            for (int nt = 0; nt < 4; ++nt) bfr[nt] = *(const bf16x8*)(sb_c + nt * 2048);
#pragma unroll
            for (int mt = 0; mt < 8; ++mt) af[mt] = *(const bf16x8*)(sa_c + mt * 2048);
#pragma unroll
            for (int mt = 0; mt < 8; ++mt)
#pragma unroll
                for (int nt = 0; nt < 4; ++nt) acc[mt][nt] = SWAP ? mfma16(bfr[nt], af[mt], acc[mt][nt]) : mfma16(af[mt], bfr[nt], acc[mt][nt]);
            __builtin_amdgcn_sched_group_barrier(0x100, 7, 0);
#pragma unroll
            for (int i = 0; i < 5; ++i) { __builtin_amdgcn_sched_group_barrier(0x008, 4, 0); __builtin_amdgcn_sched_group_barrier(0x100, 1, 0); }
#pragma unroll
            for (int i = 0; i < 3; ++i) __builtin_amdgcn_sched_group_barrier(0x008, 4, 0);
        }
        VM_WAIT0();
        __syncthreads();
    }
#undef G8_ISSUE
}
DEV void zero_acc8(f32x4 (&acc)[8][4]) {
#pragma unroll
    for (int i = 0; i < 8; ++i)
#pragma unroll
        for (int j = 0; j < 4; ++j) acc[i][j] = f32x4{0.f, 0.f, 0.f, 0.f};
}
DEV void tile_decode8(int t, int ntn, int& mt, int& nt) {
    const int per = 4 * ntn;
    const int gi = t / per, rem = t - gi * per;
    nt = rem >> 2;
    mt = gi * 4 + (rem & 3);
}

DEV void ph_ffn_in8(const Params& p, int which, char* smem, int rvid, int RG, int tid) {
    const u16* H = WSP(u16, OFF_H);
    const u16* Wt = WSP(u16, OFF_W) + (which ? WE_IN1 : WE_IN0);
    u16* ACT = WSP(u16, OFF_P);
    const int lane = tid & 63, wave = tid >> 6, wm = wave >> 2, wn = wave & 3, fr = lane & 15, fq = lane >> 4;
    const int total = 128 * 22;
    for (int t = rvid; t < total; t += RG) {
        int mt_, nt_;
        tile_decode8(t, 22, mt_, nt_);
        const int m0 = mt_ * 256, n0 = nt_ * 256;
        f32x4 acc[8][4];
        zero_acc8(acc);
        gemm8_accum(acc, H + (size_t)m0 * D, D, Wt + (size_t)n0 * D, D, D, smem, tid);
#pragma unroll
        for (int mt = 0; mt < 8; ++mt)
#pragma unroll
            for (int pp = 0; pp < 2; ++pp)
#pragma unroll
                for (int r = 0; r < 4; ++r) {
                    const int row = m0 + wm * 128 + mt * 16 + fq * 4 + r;
                    const int hid = (n0 >> 1) + wn * 32 + pp * 16 + fr;
                    const float g = acc[mt][2 * pp][r], u = acc[mt][2 * pp + 1][r];
                    const float v = g * sigmoidf_(g) * u;
                    ACT[(size_t)row * DFF + hid] = (u16)(pk2(v, 0.f) & 0xffff);
                }
    }
}
DEV void ph_resid8(const Params& p, const u16* A, int lda, const u16* Wt, int K, int modidx, float coef, char* smem, int rvid, int RG, int tid, const float* xsrc) {
    const float* mods = WSP(float, OFF_MODS);
    const int lane = tid & 63, wave = tid >> 6, wm = wave >> 2, wn = wave & 3, fr = lane & 15, fq = lane >> 4;
    const int total = 128 * 4;
    for (int t = rvid; t < total; t += RG) {
        int mt_, nt_;
        tile_decode8(t, 4, mt_, nt_);
        const int m0 = mt_ * 256, n0 = nt_ * 256;
        f32x4 acc[8][4];
        zero_acc8(acc);
        gemm8_accum<true>(acc, A + (size_t)m0 * lda, lda, Wt + (size_t)n0 * K, K, K, smem, tid);
        const float* gp = mods + (m0 >> 12) * 9216 + modidx * 1024;
#pragma unroll
        for (int nt = 0; nt < 4; ++nt) {
            const int col = n0 + wn * 64 + nt * 16 + fq * 4;
            float4 g4 = *(const float4*)(gp + col);
            g4.x *= coef; g4.y *= coef; g4.z *= coef; g4.w *= coef;
#pragma unroll
            for (int mt = 0; mt < 8; ++mt) {
                const size_t off = (size_t)(m0 + wm * 128 + mt * 16 + fr) * D + col;
                float4 xv = *(const float4*)(xsrc + off);
                xv.x += g4.x * acc[mt][nt][0];
                xv.y += g4.y * acc[mt][nt][1];
                xv.z += g4.z * acc[mt][nt][2];
                xv.w += g4.w * acc[mt][nt][3];
                *(float4*)(p.out + off) = xv;
            }
        }
    }
}
DEV void ph_pgemm8(const Params& p, int lsel, char* smem, int rvid, int RG, int tid) {
    const u16* H = WSP(u16, OFF_H);
    const u16* Wt = WSP(u16, OFF_W) + WE_MIX;
    u16* P = WSP(u16, OFF_P);
    u16* T = WSP(u16, OFF_T);
    float* Gt = WSP(float, OFF_G);
    const int lane = tid & 63, wave = tid >> 6, wm = wave >> 2, wn = wave & 3, fr = lane & 15, fq = lane >> 4;
    const int total = 128 * 12;
    for (int t = rvid; t < total; t += RG) {
        int mt_, nt_;
        tile_decode8(t, 12, mt_, nt_);
        const int m0 = mt_ * 256, n0 = nt_ * 256;
        f32x4 acc[8][4];
        zero_acc8(acc);
        const int cb = n0 + wn * 64;
        const int j = cb >> 7;
        const bool swap_tile = (nt_ <= 4) || (nt_ == 6) || (nt_ == 7);
        if (swap_tile) {
            gemm8_accum<true>(acc, H + (size_t)m0 * D, D, Wt + (size_t)n0 * D, D, D, smem, tid);
            const bool normed = (cb >= 256 && cb < 1024) || (cb >= 1536);
            const bool isq = cb < 1024;
            const bool isgq = (cb >= 640 && cb < 1024) || (cb >= 1920);
            const float* wv = (isgq ? p.gq_qk_w : p.na_qk_w) + (lsel * 2 + (isq ? 0 : 1)) * 64;
            const float scl = isq ? 0.125f : 1.f;
            float4 w4[4];
#pragma unroll
            for (int nt = 0; nt < 4; ++nt) w4[nt] = normed ? *(const float4*)(wv + nt * 16 + fq * 4) : float4{1.f, 1.f, 1.f, 1.f};
            const float* rope = WSP(float, OFF_ROPE);
#pragma unroll
            for (int mt = 0; mt < 8; ++mt) {
                const int row = m0 + wm * 128 + mt * 16 + fr;
                if (normed) {
                    float ss = 0.f;
#pragma unroll
                    for (int nt = 0; nt < 4; ++nt)
#pragma unroll
                        for (int r = 0; r < 4; ++r) ss += acc[mt][nt][r] * acc[mt][nt][r];
                    ss = xq_sum(ss);
                    const float rstd = rsqrtf(ss * (1.f / 64.f) + 1e-6f) * scl;
#pragma unroll
                    for (int nt = 0; nt < 4; ++nt) {
                        acc[mt][nt][0] *= rstd * w4[nt].x; acc[mt][nt][1] *= rstd * w4[nt].y;
                        acc[mt][nt][2] *= rstd * w4[nt].z; acc[mt][nt][3] *= rstd * w4[nt].w;
                    }
                    if (isgq) {
                        const int tok = row & 4095;
#pragma unroll
                        for (int nt = 0; nt < 2; ++nt) {
                            const float* rp = rope + ((size_t)tok * 32 + nt * 16 + fq * 4) * 2;
                            const float4 cs01 = *(const float4*)rp, cs23 = *(const float4*)(rp + 4);
                            const float cv[4] = {cs01.x, cs01.z, cs23.x, cs23.z}, sv[4] = {cs01.y, cs01.w, cs23.y, cs23.w};
#pragma unroll
                            for (int r = 0; r < 4; ++r) {
                                const float x1 = acc[mt][nt][r], x2 = acc[mt][nt + 2][r];
                                acc[mt][nt][r] = x1 * cv[r] - x2 * sv[r];
                                acc[mt][nt + 2][r] = x1 * sv[r] + x2 * cv[r];
                            }
                        }
                    }
                }
#pragma unroll
                for (int nt = 0; nt < 4; ++nt)
                    *(uint2*)(P + (size_t)row * PW + cb + nt * 16 + fq * 4) = uint2{pk2(acc[mt][nt][0], acc[mt][nt][1]), pk2(acc[mt][nt][2], acc[mt][nt][3])};
            }
            continue;
        }
        gemm8_accum(acc, H + (size_t)m0 * D, D, Wt + (size_t)n0 * D, D, D, smem, tid);
        if (j >= 22) {
            if (cb == 2816) {
#pragma unroll
                for (int mt = 0; mt < 8; ++mt)
#pragma unroll
                    for (int r = 0; r < 4; ++r) {
                        const int row = m0 + wm * 128 + mt * 16 + fq * 4 + r;
                        Gt[(size_t)row * 16 + fr] = acc[mt][0][r];
                    }
            }
            continue;
        }
        const bool rowmajor = j < 16;
        const bool transp = (j == 10) || (j == 11) || (j >= 16);
        if (rowmajor) {
#pragma unroll
            for (int mt = 0; mt < 8; ++mt)
#pragma unroll
                for (int nt = 0; nt < 4; ++nt)
#pragma unroll
                    for (int r = 0; r < 4; ++r) {
                        const int row = m0 + wm * 128 + mt * 16 + fq * 4 + r;
                        P[(size_t)row * PW + cb + nt * 16 + fr] = (u16)(pk2(acc[mt][nt][r], 0.f) & 0xffff);
                    }
        }
        if (transp) {
            const int tcb = (j >= 16) ? (cb - 1792) : (cb - 1280);
            const int b = m0 >> 12, u0 = m0 & 4095;
#pragma unroll
            for (int mt = 0; mt < 8; ++mt)
#pragma unroll
                for (int nt = 0; nt < 4; ++nt) {
                    const int tc = tcb + nt * 16 + fr;
                    const int u = u0 + wm * 128 + mt * 16 + fq * 4;
                    *(uint2*)(T + ((size_t)(b * TW + tc)) * UT + u) = uint2{pk2(acc[mt][nt][0], acc[mt][nt][1]), pk2(acc[mt][nt][2], acc[mt][nt][3])};
                }
        }
    }
}

DEV int map_col(int type, int n) {
    if (type == 0) return n;
    if (type == 1) {
        const int jb = n >> 5, r = n & 31;
        return r < 16 ? jb * 16 + r : DFF + jb * 16 + (r - 16);
    }
    if (n < 256) return 1552 + n;
    if (n < 640) return 2064 + (n - 256);
    if (n < 1024) return 2448 + (n - 640);
    if (n < 1280) return 1808 + (n - 1024);
    if (n < 1536) return (n - 1280);
    if (n < 1920) return 528 + (n - 1536);
    if (n < 2048) return 1296 + (n - 1920);
    if (n < 2304) return 256 + (n - 2048);
    if (n < 2688) return 912 + (n - 2304);
    if (n < 2816) return 1424 + (n - 2688);
    if (n < 2832) return 512 + (n - 2816);
    if (n < 2944) return -1;
    return 2832 + (n - 2944);
}

DEV void conv_tile(const float* __restrict__ src, int ld_src, int type, u16* __restrict__ dst, int ld_dst, int k_off, int kt, int ntile, char* smem, int tid) {
    float* lds = (float*)smem;
    const int k0 = kt * 64, n0 = ntile * 64;
    {
        const int r = tid >> 6, c = tid & 63;
        const int col = map_col(type, n0 + c);
#pragma unroll 4
        for (int i = 0; i < 16; ++i) {
            const int k = r + 4 * i;
            float v = 0.f;
            if (col >= 0) v = src[(size_t)(k0 + k) * ld_src + col];
            lds[k * 65 + c] = v;
        }
    }
    __syncthreads();
    {
        const int n = tid >> 2, kq = tid & 3;
        uint32_t w[8];
#pragma unroll
        for (int j = 0; j < 8; ++j) w[j] = pk2(lds[(kq * 16 + 2 * j) * 65 + n], lds[(kq * 16 + 2 * j + 1) * 65 + n]);
        u16* d = dst + (size_t)(n0 + n) * ld_dst + k_off + k0 + kq * 16;
        *(uint4*)d = uint4{w[0], w[1], w[2], w[3]};
        *(uint4*)(d + 8) = uint4{w[4], w[5], w[6], w[7]};
    }
    __syncthreads();
}

DEV void ph_prep(const Params& p, int l, char* smem, int bid, int G) {
    u16* W = WSP(u16, OFF_W);
    const int tid = VTID;
    constexpr int N_CONV = 6240, N_MODS = 288;
    for (int it = bid; it < N_CONV + N_MODS; it += G) {
        if (it < N_CONV) {
            int r = it;
            if (r < 2816) {
                const int which = r / 1408; r -= which * 1408;
                conv_tile(p.ffn_w_in + (size_t)(l * 2 + which) * 1024 * 5632, 5632, 1, W + (which ? WE_IN1 : WE_IN0), 1024, 0, r / 88, r % 88, smem, tid);
                continue;
            }
            r -= 2816;
            if (r < 1408) {
                const int which = r / 704; r -= which * 704;
                conv_tile(p.ffn_w_out + (size_t)(l * 2 + which) * 2816 * 1024, 1024, 0, W + (which ? WE_OUT1 : WE_OUT0), 2816, 0, r / 16, r % 16, smem, tid);
                continue;
            }
            r -= 1408;
            if (r < 1504) {
                conv_tile(p.mix_w_in + (size_t)l * 1024 * NIN, NIN, 2, W + WE_MIX, 1024, 0, r / 94, r % 94, smem, tid);
                continue;
            }
            r -= 1504;
            if (r < 64) { conv_tile(p.w_br_ml + (size_t)l * 256 * 1024, 1024, 0, W + WE_BR, 1024, 0, r / 16, r % 16, smem, tid); continue; }
            r -= 64;
            if (r < 96) { conv_tile(p.w_br_na + (size_t)l * 384 * 1024, 1024, 0, W + WE_BR, 1024, 256, r / 16, r % 16, smem, tid); continue; }
            r -= 96;
            if (r < 96) { conv_tile(p.w_br_gq + (size_t)l * 384 * 1024, 1024, 0, W + WE_BR, 1024, 640, r / 16, r % 16, smem, tid); continue; }
            r -= 96;
            conv_tile(p.w_out + (size_t)l * 1024 * 1024, 1024, 0, W + WE_O, 1024, 0, r / 16, r % 16, smem, tid);
        } else {
            const int cb = it - N_CONV;
            float* s = (float*)smem;
            float* red = s + 9 * 1024;
            for (int i = tid; i < 9 * 1024; i += 256) {
                const int b = i >> 10, k = i & 1023;
                const float v = b < 8 ? p.c[b * 1024 + k] : p.c_ctx[k];
                s[i] = v * sigmoidf_(v);
            }
            __syncthreads();
            const int kg = tid >> 5, c = tid & 31, col = cb * 32 + c;
            float a[9];
#pragma unroll
            for (int b = 0; b < 9; ++b) a[b] = 0.f;
            const float* wp = p.ada_w + (size_t)l * 1024 * 9216 + (size_t)(kg * 128) * 9216 + col;
#pragma unroll 8
            for (int k = 0; k < 128; ++k) {
                const float w = wp[(size_t)k * 9216];
#pragma unroll
                for (int b = 0; b < 9; ++b) a[b] += s[b * 1024 + kg * 128 + k] * w;
            }
#pragma unroll
            for (int b = 0; b < 9; ++b) red[(kg * 9 + b) * 32 + c] = a[b];
            __syncthreads();
            for (int i = tid; i < 288; i += 256) {
                const int b = i >> 5, cc = i & 31;
                float v = p.ada_b[l * 9216 + cb * 32 + cc];
#pragma unroll
                for (int g = 0; g < 8; ++g) v += red[(g * 9 + b) * 32 + cc];
                WSP(float, OFF_MODS)[b * 9216 + cb * 32 + cc] = v;
            }
            __syncthreads();
        }
    }
    if (l == 0) {
        const size_t gt = (size_t)bid * 256 + tid, gs = (size_t)G * 256;
        const float4* cs = (const float4*)p.ctx; float4* cd = WSP(float4, OFF_XC);
        for (size_t i = gt; i < (size_t)NCX * D / 4; i += gs) cd[i] = cs[i];
        float* rope = WSP(float, OFF_ROPE);
        for (size_t i = gt; i < (size_t)4096 * 32; i += gs) {
            const int t = (int)(i >> 5), f = (int)(i & 31);
            const float pos = (float)((f < 16) ? (t >> 6) : (t & 63));
            const float inv = powf(10000.f, -(float)(f & 15) / 16.f);
            float sn, cs_;
            sincosf(pos * inv, &sn, &cs_);
            rope[i * 2] = cs_;
            rope[i * 2 + 1] = sn;
        }
    }
}

DEV void ph_mod(const Params& p, int l, int sub, int nrows, int bid, int G) {
    const bool first = (l == 0 && sub == 0);
    const int lane = VTID & 63, gw = bid * 4 + (VTID >> 6), NW = G * 4;
    const float* nw = p.norm_w + (size_t)(l * 3 + sub) * 1024;
    const float* mods = WSP(float, OFF_MODS);
    u16* H = WSP(u16, OFF_H);
    for (int r = gw; r < nrows; r += NW) {
        const float* xr = r < NL ? (first ? p.x : p.out) + (size_t)r * D : (first ? p.ctx : WSP(float, OFF_XC)) + (size_t)(r - NL) * D;
        const int b9 = r < NL ? (r >> 12) : 8;
        const float* sh = mods + b9 * 9216 + (3 * sub) * 1024;
        const float* sc = sh + 1024;
        float4 v[4];
        float ss = 0.f;
#pragma unroll
        for (int j = 0; j < 4; ++j) {
            v[j] = *(const float4*)(xr + lane * 4 + 256 * j);
            ss += v[j].x * v[j].x + v[j].y * v[j].y + v[j].z * v[j].z + v[j].w * v[j].w;
        }
        ss = wave_sum(ss);
        const float rstd = rsqrtf(ss * (1.f / 1024.f) + 1e-6f);
#pragma unroll
        for (int j = 0; j < 4; ++j) {
            const int k = lane * 4 + 256 * j;
            const float4 w = *(const float4*)(nw + k), s1 = *(const float4*)(sc + k), s0 = *(const float4*)(sh + k);
            const float y0 = v[j].x * rstd * w.x * (1.f + s1.x) + s0.x;
            const float y1 = v[j].y * rstd * w.y * (1.f + s1.y) + s0.y;
            const float y2 = v[j].z * rstd * w.z * (1.f + s1.z) + s0.z;
            const float y3 = v[j].w * rstd * w.w * (1.f + s1.w) + s0.w;
            *(uint2*)(H + (size_t)r * D + k) = uint2{pk2(y0, y1), pk2(y2, y3)};
        }
    }
}

DEV void ph_ffn_in(const Params& p, int which, int mt0, int mtiles, char* smem, int vid, int G) {
    const u16* H = WSP(u16, OFF_H);
    const u16* Wt = WSP(u16, OFF_W) + (which ? WE_IN1 : WE_IN0);
    u16* ACT = WSP(u16, OFF_P);
    const int lane = VTID & 63, wave = VTID >> 6, wm = wave >> 1, wn = wave & 1, fr = lane & 15, fq = lane >> 4;
    const int total = mtiles * 44;
    for (int t = vid; t < total; t += G) {
        int mt_, nt_;
        tile_decode(t, 44, mt_, nt_);
        mt_ += mt0;
        const int m0 = mt_ * 128, n0 = nt_ * 128;
        f32x4 acc[4][4];
        zero_acc<4>(acc);
        gemm_accum<4>(acc, H + (size_t)m0 * D, D, Wt + (size_t)n0 * D, D, D, smem, VTID);
#pragma unroll
        for (int mt = 0; mt < 4; ++mt)
#pragma unroll
            for (int pp = 0; pp < 2; ++pp)
#pragma unroll
                for (int r = 0; r < 4; ++r) {
                    const int row = m0 + wm * 64 + mt * 16 + fq * 4 + r;
                    const int hid = (n0 >> 1) + wn * 32 + pp * 16 + fr;
                    const float g = acc[mt][2 * pp][r], u = acc[mt][2 * pp + 1][r];
                    const float v = g * sigmoidf_(g) * u;
                    ACT[(size_t)row * DFF + hid] = (u16)(pk2(v, 0.f) & 0xffff);
                }
    }
}

DEV void ph_resid(const Params& p, const u16* A, int lda, const u16* Wt, int K, int modidx, float coef, int mt0, int mtiles, char* smem, int vid, int G) {
    const float* mods = WSP(float, OFF_MODS);
    const int lane = VTID & 63, wave = VTID >> 6, wm = wave >> 1, wn = wave & 1, fr = lane & 15, fq = lane >> 4;
    const int total = mtiles * 8 * 4;
    const int Kc = K >> 2;
    for (int t = vid; t < total; t += G) {
        int mt_, nt_;
        const int ksp = t & 3;
        tile_decode(t >> 2, 8, mt_, nt_);
        mt_ += mt0;
        const int m0 = mt_ * 128, n0 = nt_ * 128;
        f32x4 acc[4][4];
        zero_acc<4>(acc);
        gemm_accum<4>(acc, A + (size_t)m0 * lda + ksp * Kc, lda, Wt + (size_t)n0 * K + ksp * Kc, K, Kc, smem, VTID);
        const int b9 = m0 < NL ? (m0 >> 12) : 8;
        const float* gp = mods + b9 * 9216 + modidx * 1024;
#pragma unroll
        for (int nt = 0; nt < 4; ++nt) {
            const int col = n0 + wn * 64 + nt * 16 + fr;
            const float gv = gp[col] * coef;
#pragma unroll
            for (int mt = 0; mt < 4; ++mt)
#pragma unroll
                for (int r = 0; r < 4; ++r) {
                    const int row = m0 + wm * 64 + mt * 16 + fq * 4 + r;
                    float* xp = (row < NL ? p.out + (size_t)row * D : WSP(float, OFF_XC) + (size_t)(row - NL) * D) + col;
                    __hip_atomic_fetch_add(xp, gv * acc[mt][nt][r], __ATOMIC_RELAXED, __HIP_MEMORY_SCOPE_AGENT);
                }
        }
    }
}

DEV void ph_pgemm(const Params& p, int mt0, int mtiles, char* smem, int vid, int G) {
    const u16* H = WSP(u16, OFF_H);
    const u16* Wt = WSP(u16, OFF_W) + WE_MIX;
    u16* P = WSP(u16, OFF_P);
    u16* T = WSP(u16, OFF_T);
    float* Gt = WSP(float, OFF_G);
    const int lane = VTID & 63, wave = VTID >> 6, wm = wave >> 1, wn = wave & 1, fr = lane & 15, fq = lane >> 4;
    const int total = mtiles * 23;
    for (int t = vid; t < total; t += G) {
        int mt_, nt_;
        tile_decode(t, 23, mt_, nt_);
        mt_ += mt0;
        const int m0 = mt_ * 128, n0 = nt_ * 128;
        f32x4 acc[4][4];
        zero_acc<4>(acc);
        gemm_accum<4>(acc, H + (size_t)m0 * D, D, Wt + (size_t)n0 * D, D, D, smem, VTID);
        if (nt_ == 22) {
            if (wn == 0) {
#pragma unroll
                for (int mt = 0; mt < 4; ++mt)
#pragma unroll
                    for (int r = 0; r < 4; ++r) {
                        const int row = m0 + wm * 64 + mt * 16 + fq * 4 + r;
                        Gt[(size_t)row * 16 + fr] = acc[mt][0][r];
                    }
            }
            continue;
        }
        const bool rowmajor = nt_ < 16;
        const bool transp = (nt_ == 10) || (nt_ == 11) || (nt_ >= 16);
        if (rowmajor) {
#pragma unroll
            for (int mt = 0; mt < 4; ++mt)
#pragma unroll
                for (int nt = 0; nt < 4; ++nt)
#pragma unroll
                    for (int r = 0; r < 4; ++r) {
                        const int row = m0 + wm * 64 + mt * 16 + fq * 4 + r;
                        const int col = n0 + wn * 64 + nt * 16 + fr;
                        P[(size_t)row * PW + col] = (u16)(pk2(acc[mt][nt][r], 0.f) & 0xffff);
                    }
        }
        if (transp) {
            const int tcb = (nt_ >= 16) ? (n0 - 1792) : (n0 - 1280);
            int b, u0;
            if (m0 < NL) { b = m0 >> 12; u0 = m0 & 4095; } else { b = (m0 - NL) >> 8; u0 = SEQ + ((m0 - NL) & 255); }
#pragma unroll
            for (int mt = 0; mt < 4; ++mt)
#pragma unroll
                for (int nt = 0; nt < 4; ++nt) {
                    const int tc = tcb + wn * 64 + nt * 16 + fr;
                    const int u = u0 + wm * 64 + mt * 16 + fq * 4;
                    *(uint2*)(T + ((size_t)(b * TW + tc)) * UT + u) = uint2{pk2(acc[mt][nt][0], acc[mt][nt][1]), pk2(acc[mt][nt][2], acc[mt][nt][3])};
                }
        }
    }
}

DEV void ph_qknorm_gates(const Params& p, int l, int bid, int G) {
    const int lane = VTID & 63, gw = bid * 4 + (VTID >> 6), NW = G * 4;
    u16* P = WSP(u16, OFF_P);
    for (int it = gw; it < NSCAN * NCH; it += NW) {
        const int sc = it / NCH, c = it - sc * NCH, dir = sc & 1, h = (sc >> 1) & 3, b = sc >> 3;
        const float* Gt = WSP(float, OFF_G);
        float* BC = WSP(float, OFF_BC) + (size_t)sc * UT;
        float* IG = WSP(float, OFF_IG) + (size_t)sc * UT;
        float* WE = WSP(float, OFF_AE) + (size_t)sc * UT;
        const float bi = p.ml_gate_b[l * 16 + dir * 8 + h], bf = p.ml_gate_b[l * 16 + dir * 8 + 4 + h];
        const int cu = cu_of(c, dir);
        const int u = cu * 64 + (dir ? 63 - lane : lane);
        const int row = rowof(b, u);
        const float ig = Gt[(size_t)row * 16 + dir * 8 + h] + bi;
        const float fp = Gt[(size_t)row * 16 + dir * 8 + 4 + h] + bf;
        const float lf = fminf(fp, 0.f) - log1pf(expf(-fabsf(fp)));
        float bc = lf;
#pragma unroll
        for (int o = 1; o < 64; o <<= 1) { const float tv = __shfl_up(bc, o); if (lane >= o) bc += tv; }
        const float btot = __shfl(bc, 63);
        const float wend = btot - bc + ig;
        const float mx = wave_max(wend);
        WE[u] = wend;
        BC[u] = bc;
        IG[u] = ig;
        if (lane == 0) { WSP(float, OFF_MS)[sc * NCH + c] = btot; WSP(float, OFF_DEC)[sc * NCH + c] = mx; }
    }
    const float* rope = WSP(float, OFF_ROPE);
    const int hs = lane >> 4, e4 = (lane & 15) * 4;
    for (int r = NL + gw; r < MTOT; r += NW) {
        const bool latent = r < NL;
        const int tok = r & 4095;
#pragma unroll
        for (int g = 0; g < 5; ++g) {
            const int cbase = (g < 3 ? 256 + g * 256 : 1536 + (g - 3) * 256) + hs * 64 + e4;
            const int slot = g * 4 + hs;
            u16* pp = P + (size_t)r * PW + cbase;
            const uint2 raw = *(const uint2*)pp;
            float v0 = bflo(raw.x), v1 = bfhi(raw.x), v2 = bflo(raw.y), v3 = bfhi(raw.y);
            float ss = v0 * v0 + v1 * v1 + v2 * v2 + v3 * v3;
            ss += __shfl_xor(ss, 1); ss += __shfl_xor(ss, 2); ss += __shfl_xor(ss, 4); ss += __shfl_xor(ss, 8);
            const float* wv;
            float scl;
            bool do_rope;
            if (slot < 6) { wv = p.na_qk_w + (l * 2 + 0) * 64; scl = 0.125f; do_rope = false; }
            else if (slot < 12) { wv = p.gq_qk_w + (l * 2 + 0) * 64; scl = 0.125f; do_rope = latent; }
            else if (slot < 18) { wv = p.na_qk_w + (l * 2 + 1) * 64; scl = 1.f; do_rope = false; }
            else { wv = p.gq_qk_w + (l * 2 + 1) * 64; scl = 1.f; do_rope = latent; }
            const float rstd = rsqrtf(ss * (1.f / 64.f) + 1e-6f) * scl;
            const float4 w4 = *(const float4*)(wv + e4);
            v0 *= rstd * w4.x; v1 *= rstd * w4.y; v2 *= rstd * w4.z; v3 *= rstd * w4.w;
            const float o0 = __shfl_xor(v0, 8), o1 = __shfl_xor(v1, 8), o2 = __shfl_xor(v2, 8), o3 = __shfl_xor(v3, 8);
            if (do_rope) {
                const int fi = e4 & 31;
                const float4 cs01 = *(const float4*)(rope + ((size_t)tok * 32 + fi) * 2);
                const float4 cs23 = *(const float4*)(rope + ((size_t)tok * 32 + fi + 2) * 2);
                if (e4 < 32) {
                    v0 = v0 * cs01.x - o0 * cs01.y; v1 = v1 * cs01.z - o1 * cs01.w;
                    v2 = v2 * cs23.x - o2 * cs23.y; v3 = v3 * cs23.z - o3 * cs23.w;
                } else {
                    v0 = o0 * cs01.y + v0 * cs01.x; v1 = o1 * cs01.w + v1 * cs01.z;
                    v2 = o2 * cs23.y + v2 * cs23.x; v3 = o3 * cs23.w + v3 * cs23.z;
                }
            }
            *(uint2*)pp = uint2{pk2(v0, v1), pk2(v2, v3)};
        }
    }
}

template <int MT, bool NAMASK, int NWV>
DEV void flash_item(const Params& p, int b, int qrow0, int qcol, int kcol, int tcol, int ua, int n1, int ub, int ntiles,
                    int r_q, int rs, const float* __restrict__ rpb_h, char* smem, int ocol, float mfix = 0.f) {
    u16* P = WSP(u16, OFF_P);
    const u16* T = WSP(u16, OFF_T);
    const int tid = (NWV == 8) ? (int)(threadIdx.x + p.z) : VTID, lane = tid & 63, wave = tid >> 6, fr = lane & 15, fq = lane >> 4;
    constexpr int KVS = 64 * 144;
    char* Ks = smem;
    char* Vs = smem + 2 * KVS;
    float* rpb_s = (float*)(smem + 4 * KVS);
    __syncthreads();
    if (NAMASK) {
        for (int i = tid; i < 465; i += 256) rpb_s[i] = rpb_h[i] * 1.4426950408889634f;
    }
    Frag qf[MT][2];
#pragma unroll
    for (int mt = 0; mt < MT; ++mt)
#pragma unroll
        for (int ks = 0; ks < 2; ++ks)
            qf[mt][ks].q = *(const uint4*)(P + (size_t)(qrow0 + (wave * MT + mt) * 16 + fr) * PW + qcol + ks * 32 + fq * 8);
    const int lr = tid >> 3, lc8 = tid & 7;
    u32x4 rk0, rk1 = {0, 0, 0, 0}, rv0, rv1 = {0, 0, 0, 0};
#define FL_GLOAD(KT) do { const int kt_ = (KT); const int u0_ = kt_ < n1 ? ua + 64 * kt_ : ub + 64 * (kt_ - n1); const int row0_ = rowof(b, u0_); \
        rk0 = gld16(P + (size_t)(row0_ + lr) * PW + kcol + lc8 * 8); rv0 = gld16(T + ((size_t)(b * TW + tcol + lr)) * UT + u0_ + lc8 * 8); \
        if (NWV == 4) { rk1 = gld16(P + (size_t)(row0_ + lr + 32) * PW + kcol + lc8 * 8); rv1 = gld16(T + ((size_t)(b * TW + tcol + lr + 32)) * UT + u0_ + lc8 * 8); } } while (0)
#define FL_SSTORE(S) do { const int s_ = (S); \
        *(u32x4*)(Ks + s_ * KVS + lr * 144 + lc8 * 16) = rk0; *(u32x4*)(Vs + s_ * KVS + lr * 144 + lc8 * 16) = rv0; \
        if (NWV == 4) { *(u32x4*)(Ks + s_ * KVS + (lr + 32) * 144 + lc8 * 16) = rk1; *(u32x4*)(Vs + s_ * KVS + (lr + 32) * 144 + lc8 * 16) = rv1; } } while (0)
    FL_GLOAD(0);
    VM_WAIT0();
    FL_SSTORE(0);
    __syncthreads();
    f32x4 o[MT][4];
    float mrow[MT], lrow[MT];
#pragma unroll
    for (int mt = 0; mt < MT; ++mt) {
        mrow[mt] = -1e30f; lrow[mt] = 0.f;
#pragma unroll
        for (int dt = 0; dt < 4; ++dt) o[mt][dt] = f32x4{0.f, 0.f, 0.f, 0.f};
    }
    const float L2E = 1.4426950408889634f;
    for (int kt = 0; kt < ntiles; ++kt) {
        const int cur = kt & 1;
        const bool more = kt + 1 < ntiles;
        FL_GLOAD(more ? kt + 1 : kt);
        __builtin_amdgcn_sched_barrier(0);
        f32x4 s[MT][4];
#pragma unroll
        for (int mt = 0; mt < MT; ++mt)
#pragma unroll
            for (int nt = 0; nt < 4; ++nt) s[mt][nt] = f32x4{0.f, 0.f, 0.f, 0.f};
#pragma unroll
        for (int ks = 0; ks < 2; ++ks)
#pragma unroll
            for (int nt = 0; nt < 4; ++nt) {
                const bf16x8 kf = *(const bf16x8*)(Ks + cur * KVS + (nt * 16 + fr) * 144 + (ks * 32 + fq * 8) * 2);
#pragma unroll
                for (int mt = 0; mt < MT; ++mt) s[mt][nt] = mfma16(kf, qf[mt][ks].v, s[mt][nt]);
            }
        Frag pf[MT][2];
#pragma unroll
        for (int mt = 0; mt < MT; ++mt) {
            float rsum = 0.f;
            if (NAMASK && kt < 8) {
                const int qc = (wave * MT + mt) * 16 + fr;
                int cs = qc - 8; cs = cs < 0 ? 0 : (cs > 48 ? 48 : cs);
                const int brow = rs + kt - r_q + 7;
#pragma unroll
                for (int nt = 0; nt < 4; ++nt)
#pragma unroll
                    for (int r = 0; r < 4; ++r) {
                        const int kc = nt * 16 + fq * 4 + r;
                        const bool valid = (kc >= cs) && (kc < cs + 16);
                        const int bi = valid ? brow * 31 + (kc - qc + 15) : 0;
                        const float e = valid ? fexp2(fmaf(s[mt][nt][r], L2E, rpb_s[bi] - mfix)) : 0.f;
                        s[mt][nt][r] = e; rsum += e;
                    }
            } else {
#pragma unroll
                for (int nt = 0; nt < 4; ++nt)
#pragma unroll
                    for (int r = 0; r < 4; ++r) { const float e = fexp2(fmaf(s[mt][nt][r], L2E, -mfix)); s[mt][nt][r] = e; rsum += e; }
            }
            lrow[mt] += rsum;
#pragma unroll
            for (int ks = 0; ks < 2; ++ks) {
                pf[mt][ks].u[0] = pk2(s[mt][2 * ks][0], s[mt][2 * ks][1]);
                pf[mt][ks].u[1] = pk2(s[mt][2 * ks][2], s[mt][2 * ks][3]);
                pf[mt][ks].u[2] = pk2(s[mt][2 * ks + 1][0], s[mt][2 * ks + 1][1]);
                pf[mt][ks].u[3] = pk2(s[mt][2 * ks + 1][2], s[mt][2 * ks + 1][3]);
            }
        }
#pragma unroll
        for (int ks = 0; ks < 2; ++ks)
#pragma unroll
            for (int dt = 0; dt < 4; ++dt) {
                Frag vf;
                vf.d[0] = *(const uint2*)(Vs + cur * KVS + (dt * 16 + fr) * 144 + (ks * 32 + fq * 4) * 2);
                vf.d[1] = *(const uint2*)(Vs + cur * KVS + (dt * 16 + fr) * 144 + (ks * 32 + 16 + fq * 4) * 2);
#pragma unroll
                for (int mt = 0; mt < MT; ++mt) o[mt][dt] = mfma16(vf.v, pf[mt][ks].v, o[mt][dt]);
            }
        __builtin_amdgcn_sched_barrier(0);
        VM_WAIT0();
        FL_SSTORE(cur ^ 1);
        __syncthreads();
    }
#pragma unroll
    for (int mt = 0; mt < MT; ++mt) {
        const float inv = 1.f / xq_sum(lrow[mt]);
        u16* op = P + (size_t)(qrow0 + (wave * MT + mt) * 16 + fr) * PW + ocol;
#pragma unroll
        for (int dt = 0; dt < 4; ++dt)
            *(uint2*)(op + dt * 16 + fq * 4) = uint2{pk2(o[mt][dt][0] * inv, o[mt][dt][1] * inv), pk2(o[mt][dt][2] * inv, o[mt][dt][3] * inv)};
    }
}


DEV void m2_item(const Params& p, int sc, int c) {
    const u16* T = WSP(u16, OFF_T);
    const int lane = VTID & 63, wave = VTID >> 6, fr = lane & 15, fq = lane >> 4;
    const int dir = sc & 1, h = (sc >> 1) & 3, b = sc >> 3;
    const int u0 = cu_of(c, dir) * 64;
    const float* AE = WSP(float, OFF_AE) + (size_t)sc * UT + u0;
    float* S = WSP(float, OFF_S) + ((size_t)sc * NCH + c) * SCH;
    const float mnew = fmaxf(WSP(float, OFF_MS)[sc * NCH + c] + m_scan(p, sc, c), WSP(float, OFF_DEC)[sc * NCH + c]);
    f32x4 acc[4], accn[4];
#pragma unroll
    for (int nt = 0; nt < 4; ++nt) { acc[nt] = f32x4{0.f, 0.f, 0.f, 0.f}; accn[nt] = f32x4{0.f, 0.f, 0.f, 0.f}; }
    Frag ones;
    ones.u[0] = ones.u[1] = ones.u[2] = ones.u[3] = 0x3F803F80u;
#pragma unroll
    for (int ks = 0; ks < 2; ++ks) {
        Frag vf;
        vf.q = *(const uint4*)(T + ((size_t)(b * TW + TC_MLV + h * 64 + wave * 16 + fr)) * UT + u0 + ks * 32 + fq * 8);
        float4 a0 = *(const float4*)(AE + ks * 32 + fq * 8), a1 = *(const float4*)(AE + ks * 32 + fq * 8 + 4);
        a0.x = expf(a0.x - mnew); a0.y = expf(a0.y - mnew); a0.z = expf(a0.z - mnew); a0.w = expf(a0.w - mnew);
        a1.x = expf(a1.x - mnew); a1.y = expf(a1.y - mnew); a1.z = expf(a1.z - mnew); a1.w = expf(a1.w - mnew);
#pragma unroll
        for (int nt = 0; nt < 4; ++nt) {
            Frag kf, kb;
            kf.q = *(const uint4*)(T + ((size_t)(b * TW + TC_MLK + h * 64 + nt * 16 + fr)) * UT + u0 + ks * 32 + fq * 8);
            kb.u[0] = pk2(bflo(kf.u[0]) * a0.x * 0.125f, bfhi(kf.u[0]) * a0.y * 0.125f);
            kb.u[1] = pk2(bflo(kf.u[1]) * a0.z * 0.125f, bfhi(kf.u[1]) * a0.w * 0.125f);
            kb.u[2] = pk2(bflo(kf.u[2]) * a1.x * 0.125f, bfhi(kf.u[2]) * a1.y * 0.125f);
            kb.u[3] = pk2(bflo(kf.u[3]) * a1.z * 0.125f, bfhi(kf.u[3]) * a1.w * 0.125f);
            acc[nt] = mfma16(vf.v, kb.v, acc[nt]);
            if (wave == 0) accn[nt] = mfma16(ones.v, kb.v, accn[nt]);
        }
    }
#pragma unroll
    for (int nt = 0; nt < 4; ++nt) {
#pragma unroll
        for (int r = 0; r < 4; ++r) S[(wave * 16 + fq * 4 + r) * 64 + nt * 16 + fr] = acc[nt][r];
        if (wave == 0 && fq == 0) S[4096 + nt * 16 + fr] = accn[nt][0];
    }
}

DEV void ph_m3(const Params& p, int bid, int G) {
    const float* DEC = WSP(float, OFF_DEC);
    float* S = WSP(float, OFF_S);
    const int total = NSCAN * SCH;
    for (int i = bid * 256 + VTID; i < total; i += G * 256) {
        const int sc = i / SCH, e = i - sc * SCH;
        float* base = S + (size_t)sc * NCH * SCH + e;
        const float* mxp = DEC + sc * NCH;
        const float* btp = WSP(float, OFF_MS) + sc * NCH;
        float st = 0.f, m = 0.f;
#pragma unroll 4
        for (int c = 0; c < NCH; ++c) {
            const float tmp = base[(size_t)c * SCH];
            base[(size_t)c * SCH] = st;
            const float bm = btp[c] + m;
            const float mnew = fmaxf(bm, mxp[c]);
            st = expf(bm - mnew) * st + tmp;
            m = mnew;
        }
    }
}

DEV void m4_item(const Params& p, int l, int b, int h, int cu, int ocolbase) {
    u16* P = WSP(u16, OFF_P);
    const u16* T = WSP(u16, OFF_T);
    const int lane = VTID & 63, wave = VTID >> 6, fr = lane & 15, fq = lane >> 4;
    const int u0 = cu * 64;
    const int row0 = rowof(b, u0);
    const int j = wave * 16 + fr;
    Frag qf[2];
#pragma unroll
    for (int ks = 0; ks < 2; ++ks) qf[ks].q = *(const uint4*)(P + (size_t)(row0 + j) * PW + PC_MLQ + h * 64 + ks * 32 + fq * 8);
    f32x4 hsum[4];
#pragma unroll
    for (int dt = 0; dt < 4; ++dt) hsum[dt] = f32x4{0.f, 0.f, 0.f, 0.f};
#pragma unroll 1
    for (int dir = 0; dir < 2; ++dir) {
        const int sc = (b * 4 + h) * 2 + dir;
        int c;
        if (cu >= 64) c = dir ? 3 - (cu - 64) : (cu - 64); else c = 4 + (dir ? 63 - cu : cu);
        const float m0 = m_scan(p, sc, c);
        const float* BC = WSP(float, OFF_BC) + (size_t)sc * UT + u0;
        const float* IG = WSP(float, OFF_IG) + (size_t)sc * UT + u0;
        const float* S = WSP(float, OFF_S) + ((size_t)sc * NCH + c) * SCH;
        const float bj = BC[j];
        f32x4 s[4];
#pragma unroll
        for (int nt = 0; nt < 4; ++nt) s[nt] = f32x4{0.f, 0.f, 0.f, 0.f};
#pragma unroll
        for (int ks = 0; ks < 2; ++ks)
#pragma unroll
            for (int nt = 0; nt < 4; ++nt) {
                Frag kf;
                kf.q = *(const uint4*)(P + (size_t)(row0 + nt * 16 + fr) * PW + PC_MLK + h * 64 + ks * 32 + fq * 8);
                s[nt] = mfma16(kf.v, qf[ks].v, s[nt]);
            }
        float lw[4][4];
        float mx = -1e30f;
#pragma unroll
        for (int nt = 0; nt < 4; ++nt) {
            const float4 bs = *(const float4*)(BC + nt * 16 + fq * 4);
            const float4 is = *(const float4*)(IG + nt * 16 + fq * 4);
            const float bsv[4] = {bs.x, bs.y, bs.z, bs.w}, isv[4] = {is.x, is.y, is.z, is.w};
#pragma unroll
            for (int r = 0; r < 4; ++r) {
                const int sidx = nt * 16 + fq * 4 + r;
                const bool valid = dir ? (sidx >= j) : (sidx <= j);
                lw[nt][r] = valid ? (bj - bsv[r] + isv[r]) : -1e30f;
                mx = fmaxf(mx, lw[nt][r]);
            }
        }
        mx = xq_max(mx);
        const float minter = bj + m0;
        const float mj = fmaxf(minter, mx);
        const float g = fexp(minter - mj);
        float den = 0.f;
#pragma unroll
        for (int nt = 0; nt < 4; ++nt)
#pragma unroll
            for (int r = 0; r < 4; ++r) {
                const float w = fexp(lw[nt][r] - mj);
                const float qk = s[nt][r] * 0.125f * w;
                s[nt][r] = qk;
                den += qk;
            }
        den = xq_sum(den);
        Frag pf[2];
#pragma unroll
        for (int ks = 0; ks < 2; ++ks) {
            pf[ks].u[0] = pk2(s[2 * ks][0], s[2 * ks][1]);
            pf[ks].u[1] = pk2(s[2 * ks][2], s[2 * ks][3]);
            pf[ks].u[2] = pk2(s[2 * ks + 1][0], s[2 * ks + 1][1]);
            pf[ks].u[3] = pk2(s[2 * ks + 1][2], s[2 * ks + 1][3]);
        }
        f32x4 acc[4], accn = f32x4{0.f, 0.f, 0.f, 0.f};
#pragma unroll
        for (int dt = 0; dt < 4; ++dt) acc[dt] = f32x4{0.f, 0.f, 0.f, 0.f};
#pragma unroll
        for (int ks = 0; ks < 2; ++ks) {
            {
                const float4 n0 = *(const float4*)(S + 4096 + ks * 32 + fq * 8), n1 = *(const float4*)(S + 4096 + ks * 32 + fq * 8 + 4);
                Frag nf;
                nf.u[0] = pk2(n0.x, n0.y); nf.u[1] = pk2(n0.z, n0.w); nf.u[2] = pk2(n1.x, n1.y); nf.u[3] = pk2(n1.z, n1.w);
                accn = mfma16(nf.v, qf[ks].v, accn);
            }
#pragma unroll
            for (int dt = 0; dt < 4; ++dt) {
                const float* cp = S + (dt * 16 + fr) * 64 + ks * 32 + fq * 8;
                const float4 c0 = *(const float4*)cp, c1 = *(const float4*)(cp + 4);
                Frag cf;
                cf.u[0] = pk2(c0.x, c0.y); cf.u[1] = pk2(c0.z, c0.w); cf.u[2] = pk2(c1.x, c1.y); cf.u[3] = pk2(c1.z, c1.w);
                acc[dt] = mfma16(cf.v, qf[ks].v, acc[dt]);
            }
        }
#pragma unroll
        for (int dt = 0; dt < 4; ++dt) acc[dt] *= g;
        den += g * accn[0];
#pragma unroll
        for (int ks = 0; ks < 2; ++ks)
#pragma unroll
            for (int dt = 0; dt < 4; ++dt) {
                const u16* vp = T + ((size_t)(b * TW + TC_MLV + h * 64 + dt * 16 + fr)) * UT + u0 + ks * 32 + fq * 4;
                Frag vf;
                vf.d[0] = *(const uint2*)vp;
                vf.d[1] = *(const uint2*)(vp + 16);
                acc[dt] = mfma16(vf.v, pf[ks].v, acc[dt]);
            }
        const float dd = 1.f / fmaxf(fabsf(den), fexp(-mj));
#pragma unroll
        for (int dt = 0; dt < 4; ++dt) hsum[dt] += acc[dt] * dd;
    }
    float ss = 0.f;
#pragma unroll
    for (int dt = 0; dt < 4; ++dt)
#pragma unroll
        for (int r = 0; r < 4; ++r) ss += hsum[dt][r] * hsum[dt][r];
    ss = xq_sum(ss);
    const float rstd = rsqrtf(ss * (1.f / 64.f) + 1e-6f);
    const float* nw = p.ml_norm_w + l * 256 + h * 64;
    u16* orow = P + (size_t)(row0 + j) * PW;
#pragma unroll
    for (int dt = 0; dt < 4; ++dt) {
        const int v0 = dt * 16 + fq * 4;
        const float4 w4 = *(const float4*)(nw + v0);
        const uint2 og = *(const uint2*)(orow + PC_MLO + h * 64 + v0);
        const float y0 = hsum[dt][0] * rstd * w4.x * sigmoidf_(bflo(og.x));
        const float y1 = hsum[dt][1] * rstd * w4.y * sigmoidf_(bfhi(og.x));
        const float y2 = hsum[dt][2] * rstd * w4.z * sigmoidf_(bflo(og.y));
        const float y3 = hsum[dt][3] * rstd * w4.w * sigmoidf_(bfhi(og.y));
        *(uint2*)(orow + ocolbase + h * 64 + v0) = uint2{pk2(y0, y1), pk2(y2, y3)};
    }
}

DEV void ph_attn8(const Params& p, int l, char* smem0, int rbid, int RG) {
    const int n_gq = 768, n_c = (l == 0) ? 96 : 0;
    const int ln_ = (int)((threadIdx.x + p.z) & 63);
    const float bgq = 8.f * wave_max(fabsf(p.gq_qk_w[(l * 2 + 0) * 64 + ln_])) * wave_max(fabsf(p.gq_qk_w[(l * 2 + 1) * 64 + ln_])) * 1.4426950408889634f * 1.03f + 0.5f;
    const float bna = 8.f * wave_max(fabsf(p.na_qk_w[(l * 2 + 0) * 64 + ln_])) * wave_max(fabsf(p.na_qk_w[(l * 2 + 1) * 64 + ln_])) * 1.4426950408889634f * 1.03f + 0.5f;
    for (int it = rbid; it < n_gq + n_c; it += RG) {
        float mfix = bgq;
        int b, qrow0, qcol, kcol, tcol, ua, nt;
        if (it < n_gq) {
            const int qt = it & 15, hq = (it >> 4) % 6;
            b = it / 96; qrow0 = b * SEQ + qt * 256; qcol = PC_GQQ + hq * 64; kcol = PC_GQK + (hq / 3) * 64; tcol = TC_GQV + (hq / 3) * 64; ua = 0; nt = 68;
        } else {
            const int r = it - n_gq;
            const int kind = r / 48, rr = r % 48, hh = rr % 6;
            b = rr / 6; qrow0 = NL + b * CTXL; ua = SEQ; nt = 4;
            if (kind == 0) { qcol = PC_GQQ + hh * 64; kcol = PC_GQK + (hh / 3) * 64; tcol = TC_GQV + (hh / 3) * 64; }
            else { qcol = PC_NAQ + hh * 64; kcol = PC_NAK + hh * 64; tcol = TC_NAV + hh * 64; mfix = bna; }
        }
        flash_item<2, false, 8>(p, b, qrow0, qcol, kcol, tcol, ua, nt, 0, nt, 0, 0, nullptr, smem0, qcol, mfix);
    }
}
DEV void ph_attn(const Params& p, int l, char* smem, int bid, int G, int rep) {
    const int n_na = 3072, n_m2 = NSCAN * NCH;
    const int total = n_na + n_m2;
    const int ln_ = VTID & 63;
    float rmax = 0.f;
    for (int i = ln_; i < 6 * 465; i += 64) rmax = fmaxf(rmax, fabsf(p.na_rpb[(size_t)l * 6 * 465 + i]));
    const float mfix_na = (8.f * wave_max(fabsf(p.na_qk_w[(l * 2 + 0) * 64 + ln_])) * wave_max(fabsf(p.na_qk_w[(l * 2 + 1) * 64 + ln_])) * 1.03f + wave_max(rmax)) * 1.4426950408889634f + 0.5f;
    for (int it = bid; it < total; it += G) {
        int r = it;
        if (r < n_na) {
            const int gr = r & 63, hn = (r >> 6) % 6, b = r / 384;
            int rs = gr - 4; rs = rs < 0 ? 0 : (rs > 56 ? 56 : rs);
            flash_item<1, true, 4>(p, b, b * SEQ + gr * 64, PC_NAQ + hn * 64, PC_NAK + hn * 64, TC_NAV + hn * 64, rs * 64, 8, SEQ, 12, gr, rs,
                                p.na_rpb + (size_t)(l * 6 + hn) * 465, smem, PC_NAQ + hn * 64 + (rep ? 1792 : 0), mfix_na);
            continue;
        }
        r -= n_na;
        m2_item(p, r / NCH, r % NCH);
    }
}

DEV void ph_m4(const Params& p, int l, int bid, int G, int rep) {
    const int nch = (l == 0) ? NCH : 64;
    const int total = NB * 4 * nch;
    for (int it = bid; it < total; it += G) {
        const int cu = it % nch, h = (it / nch) & 3, b = it / (nch * 4);
        m4_item(p, l, b, h, cu, rep ? 2048 : PC_MLQ);
    }
}

DEV void ph_merge(const Params& p, int mt0, int mtiles, char* smem, int vid, int G) {
    const u16* H = WSP(u16, OFF_H);
    u16* P = WSP(u16, OFF_P);
    const u16* Wg = WSP(u16, OFF_W) + WE_MIX + (size_t)2944 * 1024;
    const u16* Wbr = WSP(u16, OFF_W) + WE_BR;
    const int lane = VTID & 63, wave = VTID >> 6, wm = wave >> 1, wn = wave & 1, fr = lane & 15, fq = lane >> 4;
    const int total = mtiles * 16;
    for (int t = vid; t < total; t += G) {
        int mt_, nt_;
        tile_decode(t, 16, mt_, nt_);
        mt_ += mt0;
        const int m0 = mt_ * 128, n0 = nt_ * 64;
        f32x4 y[4][2];
        zero_acc<2>(y);
#pragma unroll 1
        for (int br = 0; br < 3; ++br) {
            const int ko = br == 0 ? 0 : (br == 1 ? 256 : 640);
            const int kk = br == 0 ? 256 : 384;
            f32x4 g[4][2];
            zero_acc<2>(g);
            gemm_accum<2>(g, H + (size_t)m0 * D, D, Wg + (size_t)(br * 1024 + n0) * D, D, D, smem, VTID);
#pragma unroll
            for (int i = 0; i < 4; ++i)
#pragma unroll
                for (int jn = 0; jn < 2; ++jn)
#pragma unroll
                    for (int r = 0; r < 4; ++r) g[i][jn][r] = sigmoidf_(g[i][jn][r]);
            f32x4 a[4][2];
            zero_acc<2>(a);
            gemm_accum<2>(a, P + (size_t)m0 * PW + ko, PW, Wbr + (size_t)n0 * D + ko, D, kk, smem, VTID);
#pragma unroll
            for (int i = 0; i < 4; ++i)
#pragma unroll
                for (int jn = 0; jn < 2; ++jn) y[i][jn] += g[i][jn] * a[i][jn];
        }
#pragma unroll
        for (int mt = 0; mt < 4; ++mt)
#pragma unroll
            for (int nt = 0; nt < 2; ++nt)
#pragma unroll
                for (int r = 0; r < 4; ++r) {
                    const int row = m0 + wm * 64 + mt * 16 + fq * 4 + r;
                    const int col = n0 + wn * 32 + nt * 16 + fr;
                    P[(size_t)row * PW + PC_Y + col] = (u16)(pk2(y[mt][nt][r], 0.f) & 0xffff);
                }
    }
}


#ifdef DBG
constexpr size_t OFF_DBG = al256(WS_END);
__global__ void __launch_bounds__(64) dbg_mlstm(Params p, int l) {
    const int sc = blockIdx.x, dir = sc & 1, h = (sc >> 1) & 3, b = sc >> 3, lane = VTID;
    const u16* P = WSP(u16, OFF_P); const u16* T = WSP(u16, OFF_T); const float* Gt = WSP(float, OFF_G);
    float* HN = WSP(float, OFF_S) + (size_t)sc * UT * 64;
    const float bi = p.ml_gate_b[l * 16 + dir * 8 + h], bf = p.ml_gate_b[l * 16 + dir * 8 + 4 + h];
    float C[64], n[64];
    for (int k = 0; k < 64; ++k) { C[k] = 0.f; n[k] = 0.f; }
    float m = 0.f;
    for (int pos = 0; pos < UT; ++pos) {
        int u;
        if (pos < 256) u = SEQ + (dir ? 255 - pos : pos); else u = dir ? 4095 - (pos - 256) : (pos - 256);
        const int row = rowof(b, u);
        const float ig = Gt[(size_t)row * 16 + dir * 8 + h] + bi;
        const float fp = Gt[(size_t)row * 16 + dir * 8 + 4 + h] + bf;
        const float lf = fminf(fp, 0.f) - log1pf(expf(-fabsf(fp)));
        const float mn = fmaxf(lf + m, ig);
        const float fw = expf(lf + m - mn), iw = expf(ig - mn);
        m = mn;
        const float qv = __uint_as_float(((uint32_t)P[(size_t)row * PW + 2048 + h * 64 + lane]) << 16);
        const float kv = __uint_as_float(((uint32_t)P[(size_t)row * PW + PC_MLK + h * 64 + lane]) << 16) * 0.125f;
        const float vv = __uint_as_float(((uint32_t)T[((size_t)(b * TW + TC_MLV + h * 64 + lane)) * UT + u]) << 16);
        float num = 0.f, den = 0.f;
#pragma unroll
        for (int k = 0; k < 64; ++k) {
            const float kk = __shfl(kv, k), qq = __shfl(qv, k);
            C[k] = fw * C[k] + iw * kk * vv;
            n[k] = fw * n[k] + iw * kk;
            num += qq * C[k];
            den += qq * n[k];
        }
        HN[(size_t)u * 64 + lane] = num / fmaxf(fabsf(den), expf(-m));
    }
}
__global__ void dbg_cmp(Params p, int l) {
    const int gid = blockIdx.x * blockDim.x + VTID;
    const u16* P = WSP(u16, OFF_P); const u16* T = WSP(u16, OFF_T);
    unsigned* dw = (unsigned*)(p.ws + OFF_DBG);
    float* df = (float*)(p.ws + OFF_DBG);
    if (gid < NB * 4 * UT) {
        const int u = gid % UT, h = (gid / UT) & 3, b = gid / (UT * 4);
        const int row = rowof(b, u);
        const float* hf = WSP(float, OFF_S) + ((size_t)((b * 4 + h) * 2 + 0) * UT + u) * 64;
        const float* hb = WSP(float, OFF_S) + ((size_t)((b * 4 + h) * 2 + 1) * UT + u) * 64;
        float ss = 0.f;
        for (int v = 0; v < 64; ++v) { const float x = hf[v] + hb[v]; ss += x * x; }
        const float rstd = rsqrtf(ss / 64.f + 1e-6f);
        float md = 0.f;
        for (int v = 0; v < 64; ++v) {
            const float x = (hf[v] + hb[v]) * rstd * p.ml_norm_w[l * 256 + h * 64 + v];
            const float o = __uint_as_float(((uint32_t)P[(size_t)row * PW + PC_MLO + h * 64 + v]) << 16);
            const float y = x / (1.f + expf(-o));
            const float got = __uint_as_float(((uint32_t)P[(size_t)row * PW + PC_MLQ + h * 64 + v]) << 16);
            md += fabsf(y - got);
        }
        atomicAdd(df + (u < SEQ ? 0 : 1), md * (1.f / 64.f));
        return;
    }
    const int w = (gid - NB * 4 * UT) >> 6;
    const int lane = VTID & 63;
    int type, b, qrow, qc, kcol, tcol, ocol, hn = 0, gr = 0, gc = 0, nkeys;
    if (w < 6144) {
        type = 0; const int i = w & 127; hn = (w >> 7) % 6; b = w / 768;
        gr = i & 63; gc = (i < 64) ? gr : 63 - gr;
        qrow = b * SEQ + gr * 64 + gc; qc = 2048 + 256 + hn * 64; kcol = PC_NAK + hn * 64; tcol = TC_NAV + hn * 64; ocol = PC_NAQ + hn * 64; nkeys = 384;
    } else if (w < 6144 + 256) {
        type = 1; const int x = w - 6144; const int i = x & 15, hh = (x >> 4) & 1; b = x >> 5;
        qrow = b * SEQ + (i * 273) % 4096; qc = 2688 + hh * 64; kcol = PC_GQK + hh * 64; tcol = TC_GQV + hh * 64; ocol = PC_GQQ + hh * 3 * 64; nkeys = 4352;
    } else if (w < 6144 + 256 + 768) {
        type = 2; const int x = w - 6400; const int i = x & 15; hn = (x >> 4) % 6; b = x / 96;
        qrow = NL + b * CTXL + (i * 17) % 256; qc = 2048 + 256 + hn * 64; kcol = PC_NAK + hn * 64; tcol = TC_NAV + hn * 64; ocol = PC_NAQ + hn * 64; nkeys = 256;
    } else if (w < 6144 + 256 + 768 + 256) {
        type = 3; const int x = w - 7168; const int i = x & 15, hh = (x >> 4) & 1; b = x >> 5;
        qrow = NL + b * CTXL + (i * 17) % 256; qc = 2688 + hh * 64; kcol = PC_GQK + hh * 64; tcol = TC_GQV + hh * 64; ocol = PC_GQQ + hh * 3 * 64; nkeys = 256;
    } else return;
    const float q = __uint_as_float(((uint32_t)P[(size_t)qrow * PW + qc + lane]) << 16);
    float o = 0.f;
    int rs = gr - 4; rs = rs < 0 ? 0 : (rs > 56 ? 56 : rs);
    int cs = gc - 8; cs = cs < 0 ? 0 : (cs > 48 ? 48 : cs);
    float mx = -1e30f, lsum = 0.f;
    for (int kidx = 0; kidx < nkeys; ++kidx) {
        int u; float bias = 0.f;
        if (type == 0) {
            if (kidx < 128) {
                const int ri = kidx >> 4, ci = kidx & 15;
                u = (rs + ri) * 64 + cs + ci;
                bias = p.na_rpb[(size_t)(l * 6 + hn) * 465 + (rs + ri - gr + 7) * 31 + (cs + ci - gc + 15)];
            } else u = SEQ + (kidx - 128);
        } else if (type == 1) u = kidx;
        else u = SEQ + kidx;
        const int krow = rowof(b, u);
        float sdot = wave_sum(q * __uint_as_float(((uint32_t)P[(size_t)krow * PW + kcol + lane]) << 16));
        sdot += bias;
        const float mn = fmaxf(mx, sdot);
        const float al = expf(mx - mn), e = expf(sdot - mn);
        lsum = lsum * al + e; mx = mn;
        o = o * al + e * __uint_as_float(((uint32_t)T[((size_t)(b * TW + tcol + lane)) * UT + u]) << 16);
    }
    const float got = __uint_as_float(((uint32_t)P[(size_t)qrow * PW + ocol + lane]) << 16);
    float md = wave_max(fabsf(o / lsum - got));
    if (lane == 0) atomicMax(dw + 2 + type, __float_as_uint(md));
}
__global__ void dbg_copy(Params p) {
    u16* P = WSP(u16, OFF_P);
    for (size_t i = (size_t)blockIdx.x * 256 + VTID; i < (size_t)MTOT * 768; i += (size_t)gridDim.x * 256) {
        const size_t row = i / 768, c = i % 768;
        const size_t src = c < 640 ? c : (c < 704 ? PC_GQQ + (c - 640) : PC_GQQ + 192 + (c - 704));
        P[row * PW + 2048 + c] = P[row * PW + src];
    }
}
DEV int dbg_row(int sr) { return sr < 8 ? sr * 4096 + (sr * 577 + 13) % 4096 : NL + (sr - 8) * 256 + ((sr - 8) * 37 + 5) % 256; }
DEV float* dbg_xrow(const Params& p, int row) { return row < NL ? p.out + (size_t)row * D : WSP(float, OFF_XC) + (size_t)(row - NL) * D; }
DEV float dbg_mod(const Params& p, int l, int b9, int idx, int n) {
    float a = p.ada_b[l * 9216 + idx * 1024 + n];
    for (int k = 0; k < 1024; ++k) {
        const float c = b9 < 8 ? p.c[b9 * 1024 + k] : p.c_ctx[k];
        a += c / (1.f + expf(-c)) * p.ada_w[((size_t)l * 1024 + k) * 9216 + idx * 1024 + n];
    }
    return a;
}
DEV float blk_sum(float v, float* red) {
    v = wave_sum(v);
    __syncthreads();
    if ((VTID & 63) == 0) red[VTID >> 6] = v;
    __syncthreads();
    return red[0] + red[1] + red[2] + red[3];
}
DEV float blk_max(float v, float* red) {
    v = wave_max(v);
    __syncthreads();
    if ((VTID & 63) == 0) red[VTID >> 6] = v;
    __syncthreads();
    return fmaxf(fmaxf(red[0], red[1]), fmaxf(red[2], red[3]));
}
__global__ void dbg_save(Params p, int slot) {
    const int sr = blockIdx.x, row = dbg_row(sr);
    float* dst = (float*)(p.ws + OFF_DBG + 256) + ((size_t)slot * 16 + sr) * 1024;
    const float* src = dbg_xrow(p, row);
    for (int n = VTID; n < 1024; n += 256) dst[n] = src[n];
}
DEV float dbg_modulate(const Params& p, int l, int sub, int b9, const float* xs, float* hs, float* red) {
    float ss = 0.f;
    for (int n = VTID; n < 1024; n += 256) ss += xs[n] * xs[n];
    ss = blk_sum(ss, red);
    const float rstd = rsqrtf(ss / 1024.f + 1e-6f);
    float md = 0.f;
    for (int n = VTID; n < 1024; n += 256) {
        const float sh = dbg_mod(p, l, b9, 3 * sub, n), sc = dbg_mod(p, l, b9, 3 * sub + 1, n);
        md = fmaxf(md, fabsf(sh - WSP(float, OFF_MODS)[b9 * 9216 + (3 * sub) * 1024 + n]));
        md = fmaxf(md, fabsf(sc - WSP(float, OFF_MODS)[b9 * 9216 + (3 * sub + 1) * 1024 + n]));
        hs[n] = xs[n] * rstd * p.norm_w[(l * 3 + sub) * 1024 + n] * (1.f + sc) + sh;
    }
    __syncthreads();
    return md;
}
__global__ void __launch_bounds__(256) dbg_ffn(Params p, int l, int which, int slot, int bit) {
    __shared__ float xs[1024], hs[1024], gs[1024], as[2816], red[4];
    const int sr = blockIdx.x, row = dbg_row(sr), b9 = row < NL ? row >> 12 : 8, sub = which ? 2 : 0;
    const float* xin = (const float*)(p.ws + OFF_DBG + 256) + ((size_t)slot * 16 + sr) * 1024;
    for (int n = VTID; n < 1024; n += 256) xs[n] = xin[n];
    __syncthreads();
    float mdm = dbg_modulate(p, l, sub, b9, xs, hs, red);
    for (int n = VTID; n < 1024; n += 256) gs[n] = dbg_mod(p, l, b9, 3 * sub + 2, n);
    const float* win = p.ffn_w_in + (size_t)(l * 2 + which) * 1024 * 5632;
    const float* wout = p.ffn_w_out + (size_t)(l * 2 + which) * 2816 * 1024;
    for (int j = VTID; j < 2816; j += 256) {
        float g = 0.f, u = 0.f;
        for (int k = 0; k < 1024; ++k) { g += hs[k] * win[(size_t)k * 5632 + j]; u += hs[k] * win[(size_t)k * 5632 + 2816 + j]; }
        as[j] = g / (1.f + expf(-g)) * u;
    }
    __syncthreads();
    float md = 0.f;
    const float* xc = dbg_xrow(p, row);
    for (int n = VTID; n < 1024; n += 256) {
        float o = 0.f;
        for (int j = 0; j < 2816; ++j) o += as[j] * wout[(size_t)j * 1024 + n];
        md = fmaxf(md, fabsf(xs[n] + 0.5f * gs[n] * o - xc[n]));
    }
    md = blk_max(md, red);
    mdm = blk_max(mdm, red);
    unsigned* dw = (unsigned*)(p.ws + OFF_DBG);
    if (VTID == 0) { atomicMax(dw + bit, __float_as_uint(md)); atomicMax(dw + 15, __float_as_uint(mdm)); }
}
__global__ void __launch_bounds__(256) dbg_pchk(Params p, int l) {
    __shared__ float xs[1024], hs[1024], red[4];
    const int sr = blockIdx.x, row = dbg_row(sr), b9 = row < NL ? row >> 12 : 8;
    const float* xin = dbg_xrow(p, row);
    for (int n = VTID; n < 1024; n += 256) xs[n] = xin[n];
    __syncthreads();
    float mdm = dbg_modulate(p, l, 1, b9, xs, hs, red);
    const float* w = p.mix_w_in + (size_t)l * 1024 * NIN;
    const u16* P = WSP(u16, OFF_P); const u16* T = WSP(u16, OFF_T);
    int b, u;
    if (row < NL) { b = row >> 12; u = row & 4095; } else { b = (row - NL) >> 8; u = SEQ + ((row - NL) & 255); }
    float md = 0.f;
    for (int n = VTID; n < 2832; n += 256) {
        const int sc = map_col(2, n);
        float v = 0.f;
        for (int k = 0; k < 1024; ++k) v += hs[k] * w[(size_t)k * NIN + sc];
        if (n < 2048) md = fmaxf(md, fabsf(v - __uint_as_float(((uint32_t)P[(size_t)row * PW + n]) << 16)));
        if (n >= 1280 && n < 1536) md = fmaxf(md, fabsf(v - __uint_as_float(((uint32_t)T[((size_t)(b * TW + n - 1280)) * UT + u]) << 16)));
        if (n >= 2048 && n < 2816) md = fmaxf(md, fabsf(v - __uint_as_float(((uint32_t)T[((size_t)(b * TW + n - 1792)) * UT + u]) << 16)));
        if (n >= 2816) md = fmaxf(md, fabsf(v - WSP(float, OFF_G)[(size_t)row * 16 + n - 2816]));
    }
    md = blk_max(md, red);
    mdm = blk_max(mdm, red);
    unsigned* dw = (unsigned*)(p.ws + OFF_DBG);
    if (VTID == 0) { atomicMax(dw + 9, __float_as_uint(md)); atomicMax(dw + 15, __float_as_uint(mdm)); }
}
__global__ void __launch_bounds__(256) dbg_mix(Params p, int l, int slot) {
    __shared__ float xs[1024], hs[1024], os[1024], ys[1024], red[4];
    const int sr = blockIdx.x, row = dbg_row(sr), b9 = row < NL ? row >> 12 : 8;
    const float* xin = (const float*)(p.ws + OFF_DBG + 256) + ((size_t)slot * 16 + sr) * 1024;
    const u16* P = WSP(u16, OFF_P);
    for (int n = VTID; n < 1024; n += 256) { xs[n] = xin[n]; os[n] = __uint_as_float(((uint32_t)P[(size_t)row * PW + n]) << 16); }
    __syncthreads();
    float mdm = dbg_modulate(p, l, 1, b9, xs, hs, red);
    const float* w = p.mix_w_in + (size_t)l * 1024 * NIN;
    for (int n = VTID; n < 1024; n += 256) {
        float y = 0.f;
        for (int i = 0; i < 3; ++i) {
            float g = 0.f;
            for (int k = 0; k < 1024; ++k) g += hs[k] * w[(size_t)k * NIN + 2832 + i * 1024 + n];
            g = 1.f / (1.f + expf(-g));
            const float* wb = i == 0 ? p.w_br_ml + (size_t)l * 256 * 1024 : (i == 1 ? p.w_br_na + (size_t)l * 384 * 1024 : p.w_br_gq + (size_t)l * 384 * 1024);
            const int ko = i == 0 ? 0 : (i == 1 ? 256 : 640), kk = i == 0 ? 256 : 384;
            float a = 0.f;
            for (int k = 0; k < kk; ++k) a += os[ko + k] * wb[(size_t)k * 1024 + n];
            y += g * a;
        }
        ys[n] = y;
    }
    __syncthreads();
    float md = 0.f;
    const float* xc = dbg_xrow(p, row);
    for (int n = VTID; n < 1024; n += 256) {
        float o = 0.f;
        for (int k = 0; k < 1024; ++k) o += ys[k] * p.w_out[((size_t)l * 1024 + k) * 1024 + n];
        const float g5 = dbg_mod(p, l, b9, 5, n);
        md = fmaxf(md, fabsf(xs[n] + g5 * o - xc[n]));
    }
    md = blk_max(md, red);
    mdm = blk_max(mdm, red);
    unsigned* dw = (unsigned*)(p.ws + OFF_DBG);
    if (VTID == 0) { atomicMax(dw + 10, __float_as_uint(md)); atomicMax(dw + 15, __float_as_uint(mdm)); }
}
__global__ void dbg_fin(Params p) {
    const unsigned* dw = (const unsigned*)(p.ws + OFF_DBG);
    int mask = 0;
    if (__uint_as_float(dw[8]) > 0.02f) mask |= 1;
    if (__uint_as_float(dw[9]) > 0.03f) mask |= 2;
    if (__uint_as_float(dw[10]) > 0.02f) mask |= 4;
    if (__uint_as_float(dw[11]) > 0.02f) mask |= 8;
    if (__uint_as_float(dw[15]) > 1e-3f) mask |= 16;
    if (__uint_as_float(dw[4]) > 0.03f) mask |= 32;
    p.out[0] += 10.f * (float)mask;
    p.out[1] += 1000.f * __uint_as_float(dw[4]);
}
#endif


DEV void gemm8b_accum(f32x4 (&acc)[4][4], const u16* __restrict__ A, int lda, const u16* __restrict__ B, int ldb, int K, char* smem, int tid) {
    constexpr int STAGE = 49152;
    const int lane = tid & 63, wave = tid >> 6;
    const int wm = wave >> 1, wn = wave & 1, fr = lane & 15, fq = lane >> 4;
    const int lr = lane >> 3, pos = lane & 7;
    const int ce = pos ^ (lr >> 1), co = pos ^ (4 | (lr >> 1));
    const unsigned ra_ = (unsigned)((wave * 32 + lr) * lda) * 2u, rb_ = (unsigned)((wave * 16 + lr) * ldb) * 2u;
    const unsigned voa_e = ra_ + ce * 16, voa_o = ra_ + co * 16, vob_e = rb_ + ce * 16, vob_o = rb_ + co * 16;
    const int nk = K >> 6;
    const unsigned ldsb = (unsigned)(size_t)(__attribute__((address_space(3))) char*)smem;
    const unsigned ldsa_w = __builtin_amdgcn_readfirstlane(ldsb + wave * 4096);
    const unsigned ldsb_w = __builtin_amdgcn_readfirstlane(ldsb + 32768 + wave * 2048);
#define G8B_ISSUE(STG, K0) do { \
        _Pragma("unroll") for (int i = 0; i < 4; ++i) glds16(A + (size_t)(8 * i) * lda + (K0), (i & 1) ? voa_o : voa_e, ldsa_w + (STG) * STAGE + i * 1024); \
        _Pragma("unroll") for (int i = 0; i < 2; ++i) glds16(B + (size_t)(8 * i) * ldb + (K0), (i & 1) ? vob_o : vob_e, ldsb_w + (STG) * STAGE + i * 1024); \
    } while (0)
    G8B_ISSUE(0, 0);
    VM_WAIT0();
    __syncthreads();
    const int s3 = (fr >> 1) & 7;
    const int oa_base = (wm * 64 + fr) * 128 + ((fq ^ s3) * 16);
    const int ob_base = 32768 + (wn * 64 + fr) * 128 + ((fq ^ s3) * 16);
    for (int kt = 0; kt < nk; ++kt) {
        const int cur = kt & 1;
        const int k0 = (kt + 1 < nk ? kt + 1 : kt) * 64;
        G8B_ISSUE(cur ^ 1, k0);
        int o_a = cur * STAGE + oa_base, o_b = cur * STAGE + ob_base;
        asm volatile("" : "+v"(o_a), "+v"(o_b));
#pragma unroll
        for (int ks = 0; ks < 2; ++ks) {
            const char* sa_c = smem + (ks ? (o_a ^ 64) : o_a);
            const char* sb_c = smem + (ks ? (o_b ^ 64) : o_b);
            bf16x8 bfr[4], af[4];
#pragma unroll
            for (int nt = 0; nt < 4; ++nt) bfr[nt] = *(const bf16x8*)(sb_c + nt * 2048);
#pragma unroll
            for (int mt = 0; mt < 4; ++mt) af[mt] = *(const bf16x8*)(sa_c + mt * 2048);
#pragma unroll
            for (int mt = 0; mt < 4; ++mt)
#pragma unroll
                for (int nt = 0; nt < 4; ++nt) acc[mt][nt] = mfma16(af[mt], bfr[nt], acc[mt][nt]);
            __builtin_amdgcn_sched_group_barrier(0x100, 7, 0);
            __builtin_amdgcn_sched_group_barrier(0x008, 4, 0);
            __builtin_amdgcn_sched_group_barrier(0x100, 1, 0);
#pragma unroll
            for (int i = 0; i < 3; ++i) __builtin_amdgcn_sched_group_barrier(0x008, 4, 0);
        }
        VM_WAIT0();
        __syncthreads();
    }
#undef G8B_ISSUE
}

DEV void ph_merge8(const Params& p, char* smem, int rvid, int RG, int tid) {
    const u16* H = WSP(u16, OFF_H);
    u16* P = WSP(u16, OFF_P);
    const u16* Wg = WSP(u16, OFF_W) + WE_MIX + (size_t)2944 * 1024;
    const u16* Wbr = WSP(u16, OFF_W) + WE_BR;
    const int lane = tid & 63, wave = tid >> 6, wm = wave >> 1, wn = wave & 1, fr = lane & 15, fq = lane >> 4;
    const int total = 128 * 8;
    for (int t = rvid; t < total; t += RG) {
        const int gi = t >> 5, rem = t & 31;
        const int mt_ = gi * 4 + (rem & 3), nt_ = rem >> 2;
        const int m0 = mt_ * 256, n0 = nt_ * 128;
        f32x4 y[4][4];
        zero_acc<4>(y);
#pragma unroll 1
        for (int br = 0; br < 3; ++br) {
            const int ko = br == 0 ? 0 : (br == 1 ? 256 : 640);
            const int kk = br == 0 ? 256 : 384;
            uint32_t gpk[4][4][2];
            {
                f32x4 g[4][4];
                zero_acc<4>(g);
                gemm8b_accum(g, H + (size_t)m0 * D, D, Wg + (size_t)(br * 1024 + n0) * D, D, D, smem, tid);
#pragma unroll
                for (int i = 0; i < 4; ++i)
#pragma unroll
                    for (int jn = 0; jn < 4; ++jn) {
                        gpk[i][jn][0] = pk2(sigmoidf_(g[i][jn][0]), sigmoidf_(g[i][jn][1]));
                        gpk[i][jn][1] = pk2(sigmoidf_(g[i][jn][2]), sigmoidf_(g[i][jn][3]));
                    }
            }
            f32x4 a[4][4];
            zero_acc<4>(a);
            gemm8b_accum(a, P + (size_t)m0 * PW + ko, PW, Wbr + (size_t)n0 * D + ko, D, kk, smem, tid);
#pragma unroll
            for (int i = 0; i < 4; ++i)
#pragma unroll
                for (int jn = 0; jn < 4; ++jn) {
                    y[i][jn][0] += bflo(gpk[i][jn][0]) * a[i][jn][0];
                    y[i][jn][1] += bfhi(gpk[i][jn][0]) * a[i][jn][1];
                    y[i][jn][2] += bflo(gpk[i][jn][1]) * a[i][jn][2];
                    y[i][jn][3] += bfhi(gpk[i][jn][1]) * a[i][jn][3];
                }
        }
#pragma unroll
        for (int mt = 0; mt < 4; ++mt)
#pragma unroll
            for (int nt = 0; nt < 4; ++nt)
#pragma unroll
                for (int r = 0; r < 4; ++r) {
                    const int row = m0 + wm * 64 + mt * 16 + fq * 4 + r;
                    const int col = n0 + wn * 64 + nt * 16 + fr;
                    P[(size_t)row * PW + PC_Y + col] = (u16)(pk2(y[mt][nt][r], 0.f) & 0xffff);
                }
    }
}

constexpr int PH_PER_LAYER = 15;
constexpr int N_PHASES = 2 * PH_PER_LAYER;

#ifndef REPEAT_MASK
#define REPEAT_MASK 0
#endif
template <int Q>
DEV void run_phase_q(const Params& p, int l, char* smem) {
    const int half = (int)((threadIdx.x + p.z) >> 8);
    const int G = gridDim.x * 2, bid = blockIdx.x * 2 + half;
    const int vid = (gridDim.x % 8 == 0) ? (int)(blockIdx.x & 7) * (G >> 3) + (int)(blockIdx.x >> 3) * 2 + half : bid;
    smem += half * 73728;
    const bool last = (l == 1);
    const u16* W = WSP(u16, OFF_W);
    const int nrep = ((REPEAT_MASK >> Q) & 1) ? 2 : 1;
    char* smem0 = smem - half * 73728;
    const int rtid = (int)(threadIdx.x + p.z);
    const int RG = gridDim.x;
    const int rvid = (RG % 8 == 0) ? (int)(blockIdx.x & 7) * (RG >> 3) + (int)(blockIdx.x >> 3) : (int)blockIdx.x;
    for (int rep = 0; rep < nrep; ++rep) {
        const float cm = rep ? 0.f : 1.f;
        if (Q == 0) ph_prep(p, l, smem, bid, G);
        if (Q == 1) ph_mod(p, l, 0, MTOT, bid, G);
        Params p2 = p;
        if (Q == 2) { ph_ffn_in8(p, 0, smem0, rvid, RG, rtid); int z2 = p.z; asm volatile("" : "+s"(z2) :: "memory"); p2.z = z2; ph_ffn_in(p2, 0, 256, 16, smem, vid, G); }
        if (Q == 3) { ph_resid8(p, WSP(u16, OFF_P), DFF, W + WE_OUT0, DFF, 2, 0.5f * cm, smem0, rvid, RG, rtid, l == 0 ? p.x : p.out); int z2 = p.z; asm volatile("" : "+s"(z2) :: "memory"); p2.z = z2;
                      ph_resid(p2, WSP(u16, OFF_P), DFF, W + WE_OUT0, DFF, 2, 0.5f * cm, 256, 16, smem, vid, G); }
        if (Q == 4) ph_mod(p, l, 1, MTOT, bid, G);
        if (Q == 5) { ph_pgemm8(p, l, smem0, rvid, RG, rtid); int z2 = p.z; asm volatile("" : "+s"(z2) :: "memory"); p2.z = z2; ph_pgemm(p2, 256, 16, smem, vid, G); }
        if (Q == 6) ph_qknorm_gates(p, l, bid, G);
        if (Q == 7) { ph_attn8(p, l, smem0, rvid, RG); int z2 = p.z; asm volatile("" : "+s"(z2) :: "memory"); p2.z = z2; ph_attn(p2, l, smem, bid, G, rep); }
        if (Q == 8) ph_m3(p, bid, G);
        if (Q == 9) ph_m4(p, l, bid, G, rep);
        if (Q == 10) { ph_merge8(p, smem0, rvid, RG, rtid); int z2 = p.z; asm volatile("" : "+s"(z2) :: "memory"); p2.z = z2; if (!last) ph_merge(p2, 256, 16, smem, vid, G); }
        if (Q == 11) { ph_resid8(p, WSP(u16, OFF_P) + PC_Y, PW, W + WE_O, D, 5, 1.0f * cm, smem0, rvid, RG, rtid, p.out);
                       int z2 = p.z; asm volatile("" : "+s"(z2) :: "memory"); p2.z = z2;
                       if (!last) ph_resid(p2, WSP(u16, OFF_P) + PC_Y, PW, W + WE_O, D, 5, 1.0f * cm, 256, 16, smem, vid, G); }
        if (Q == 12) ph_mod(p, l, 2, last ? NL : MTOT, bid, G);
        if (Q == 13) { ph_ffn_in8(p, 1, smem0, rvid, RG, rtid); int z2 = p.z; asm volatile("" : "+s"(z2) :: "memory"); p2.z = z2; if (!last) ph_ffn_in(p2, 1, 256, 16, smem, vid, G); }
        if (Q == 14) { ph_resid8(p, WSP(u16, OFF_P), DFF, W + WE_OUT1, DFF, 8, 0.5f * cm, smem0, rvid, RG, rtid, p.out);
                       int z2 = p.z; asm volatile("" : "+s"(z2) :: "memory"); p2.z = z2;
                       if (!last) ph_resid(p2, WSP(u16, OFF_P), DFF, W + WE_OUT1, DFF, 8, 0.5f * cm, 256, 16, smem, vid, G); }
    }
}

DEV void run_phase(const Params& p, int ph, char* smem) {
    const int l = ph / PH_PER_LAYER, q = ph % PH_PER_LAYER;
    switch (q) {
        case 0: run_phase_q<0>(p, l, smem); break;
        case 1: run_phase_q<1>(p, l, smem); break;
        case 2: run_phase_q<2>(p, l, smem); break;
        case 3: run_phase_q<3>(p, l, smem); break;
        case 4: run_phase_q<4>(p, l, smem); break;
        case 5: run_phase_q<5>(p, l, smem); break;
        case 6: run_phase_q<6>(p, l, smem); break;
        case 7: run_phase_q<7>(p, l, smem); break;
        case 8: run_phase_q<8>(p, l, smem); break;
        case 9: run_phase_q<9>(p, l, smem); break;
        case 10: run_phase_q<10>(p, l, smem); break;
        case 11: run_phase_q<11>(p, l, smem); break;
        case 12: run_phase_q<12>(p, l, smem); break;
        case 13: run_phase_q<13>(p, l, smem); break;
        case 14: run_phase_q<14>(p, l, smem); break;
    }
}

template <int Q>
__global__ void __launch_bounds__(256, 2) phase_kernel(Params p, int l) {
    __shared__ __attribute__((aligned(16))) char smem[73728];
    run_phase_q<Q>(p, l, smem);
}

#if ONE_LAUNCH
#define XB_TMO      128
#define XB_XCNT(j)  (256  + 64 * (j))
#define XB_XSUB(j)  (1280 + 64 * (j))
#define XB_XGEN(j)  (2304 + 64 * (j))
#define XB_TOP      3328
#define XB_TOPGEN   3392
#define XB_SPIN_CAP (1u << 22)
DEV unsigned xb_ld(unsigned* q) { return __hip_atomic_load(q, __ATOMIC_RELAXED, __HIP_MEMORY_SCOPE_AGENT); }
DEV unsigned xb_add(unsigned* q, unsigned v) { return __hip_atomic_fetch_add(q, v, __ATOMIC_RELAXED, __HIP_MEMORY_SCOPE_AGENT); }
DEV unsigned xb_xcc_id() { return (unsigned)__builtin_amdgcn_s_getreg((3 << 11) | 20) & 0xFu; }
#define XB_SPIN(cond, bar) do { unsigned _sp = 0; while (cond) { __builtin_amdgcn_s_sleep(1); \
    if ((++_sp & 255u) == 0u) { if (xb_ld(&(bar)[XB_TMO])) break; if (_sp > XB_SPIN_CAP) { atomicAdd(&(bar)[XB_TMO], 1u); break; } } } } while (0)
DEV void xcd_census(unsigned* bar, unsigned x, unsigned& nloc, unsigned& nx) {
    const unsigned G = gridDim.x;
    unsigned sum, cnt, mine, sp = 0u;
    for (;;) {
        sum = 0u; cnt = 0u; mine = 0u;
#pragma unroll
        for (unsigned j = 0; j < 16; ++j) { const unsigned c = xb_ld(&bar[XB_XCNT(j)]); sum += c; cnt += (c > 0u) ? 1u : 0u; mine = (j == x) ? c : mine; }
        if (sum == G) break;
        __builtin_amdgcn_s_sleep(1);
        if ((++sp & 255u) == 0u) { if (xb_ld(&bar[XB_TMO])) break; if (sp > XB_SPIN_CAP) { atomicAdd(&bar[XB_TMO], 1u); break; } }
    }
    nloc = mine > 0u ? mine : 1u; nx = cnt > 0u ? cnt : 1u;
}
DEV void xcd_barrier(unsigned* bar, unsigned x, volatile unsigned* st, int tid) {
    asm volatile("s_waitcnt vmcnt(0)" ::: "memory");
    __syncthreads();
    if (tid == 0) {
        __builtin_amdgcn_s_waitcnt(0);
        unsigned nloc = st[0], nx = st[1];
        if (nloc == 0u) { xcd_census(bar, x, nloc, nx); st[0] = nloc; st[1] = nx; }
        const unsigned old = xb_add(&bar[XB_XSUB(x)], 1u);
        const unsigned gen = old / nloc;
        if (old + 1u == (gen + 1u) * nloc) {
            __builtin_amdgcn_fence(__ATOMIC_RELEASE, "agent");
            asm volatile("s_waitcnt vmcnt(0)" ::: "memory");
            const unsigned og = xb_add(&bar[XB_TOP], 1u);
            const unsigned tg = og / nx;
            if (og + 1u == (tg + 1u) * nx) xb_add(&bar[XB_TOPGEN], 1u);
            else XB_SPIN(xb_ld(&bar[XB_TOPGEN]) == tg, bar);
            __builtin_amdgcn_fence(__ATOMIC_ACQUIRE, "agent");
            xb_add(&bar[XB_XGEN(x)], 1u);
            asm volatile("s_waitcnt vmcnt(0)" ::: "memory");
        } else {
            XB_SPIN(xb_ld(&bar[XB_XGEN(x)]) == gen, bar);
            __builtin_amdgcn_fence(__ATOMIC_ACQUIRE, "agent");
            asm volatile("s_waitcnt vmcnt(0)" ::: "memory");
        }
    }
    __syncthreads();
}
__global__ void __launch_bounds__(512, 2) mega_kernel(Params p0, int ph_begin, int ph_end) {
    __shared__ __attribute__((aligned(16))) char smem[147456];
    __shared__ uint4 xb_words;
    unsigned* bar = (unsigned*)(p0.ws + OFF_BAR);
    const unsigned xcc = xb_xcc_id();
    if (threadIdx.x == 0) { xb_words = make_uint4(0u, 0u, 0u, 0u); (void)xb_add(&bar[XB_XCNT(xcc)], 1u); }
    __syncthreads();
    for (int ph = ph_begin; ph < ph_end; ++ph) {
        Params p = p0;
        int z = p0.z;
        asm volatile("" : "+s"(z));
        p.z = z;
        p.ws = p0.ws + z;
        p.out = p0.out + z;
        run_phase(p, ph, smem);
        if (ph + 1 < ph_end) {
            if (p0.z == 0x7fffffff) cg::this_grid().sync();
            xcd_barrier(bar, xcc, (volatile unsigned*)&xb_words, (int)threadIdx.x + z);
        }
    }
}
#endif

extern "C" void kernel_launch(void* const* d_in, const int* in_sizes, int n_in, void* d_out, int out_size, void* d_ws, size_t ws_size,
                              hipStream_t stream) {
    if (ws_size < WS_END) { fprintf(stderr, "workspace too small: %zu < %zu\n", ws_size, (size_t)WS_END); return; }
    Params p{};
    p.x = (const float*)d_in[0]; p.c = (const float*)d_in[1]; p.ctx = (const float*)d_in[2]; p.c_ctx = (const float*)d_in[3];
    p.ada_w = (const float*)d_in[4]; p.ada_b = (const float*)d_in[5]; p.norm_w = (const float*)d_in[6];
    p.ffn_w_in = (const float*)d_in[7]; p.ffn_w_out = (const float*)d_in[8]; p.mix_w_in = (const float*)d_in[9];
    p.ml_gate_b = (const float*)d_in[10]; p.ml_norm_w = (const float*)d_in[11]; p.na_qk_w = (const float*)d_in[12];
    p.na_rpb = (const float*)d_in[13]; p.gq_qk_w = (const float*)d_in[14]; p.w_br_ml = (const float*)d_in[15];
    p.w_br_na = (const float*)d_in[16]; p.w_br_gq = (const float*)d_in[17]; p.w_out = (const float*)d_in[18];
    p.out = (float*)d_out; p.ws = (char*)d_ws;
#ifdef NANFILL
    hipMemsetAsync(d_ws, 0xFF, WS_END, stream);
#endif
#if ONE_LAUNCH
    static int grid_blocks = 0;
    if (!grid_blocks) {
        int dev = 0, cus = 0, per_cu = 0;
        hipGetDevice(&dev);
        hipDeviceGetAttribute(&cus, hipDeviceAttributeMultiprocessorCount, dev);
        hipOccupancyMaxActiveBlocksPerMultiprocessor(&per_cu, mega_kernel, 512, 0);
        per_cu = 1;
        grid_blocks = cus * per_cu;
    }
    hipMemsetAsync((char*)d_ws + OFF_BAR, 0, 3456 * 4, stream);
    int pb = 0, pe = N_PHASES;
    void* args[] = {&p, &pb, &pe};
#ifdef SPLIT_TEST
    (void)args;
    for (int ph = 0; ph < N_PHASES; ++ph) mega_kernel<<<grid_blocks, 256, 0, stream>>>(p, ph, ph + 1);
#else
    hipError_t e = hipLaunchCooperativeKernel((void*)mega_kernel, dim3(grid_blocks), dim3(512), args, 0, stream);
    if (e != hipSuccess) fprintf(stderr, "cooperative launch failed: %s (grid %d)\n", hipGetErrorString(e), grid_blocks);
#endif
#else
    for (int l = 0; l < 2; ++l) {
#define LP(Q) phase_kernel<Q><<<512, 256, 0, stream>>>(p, l)
#ifdef DBG
        const bool dl = (l == DBG_LAYER);
        if (dl) hipMemsetAsync((char*)d_ws + OFF_DBG, 0, 256, stream);
        LP(0);
        if (dl) dbg_save<<<16, 256, 0, stream>>>(p, 0);
        LP(1); LP(2); LP(3);
        if (dl) dbg_ffn<<<16, 256, 0, stream>>>(p, l, 0, 0, 8);
        LP(4); LP(5);
        if (dl) dbg_pchk<<<16, 256, 0, stream>>>(p, l);
        LP(6);
        if (dl) dbg_copy<<<2048, 256, 0, stream>>>(p);
        LP(7); LP(8); LP(9);
        if (dl) {
            dbg_mlstm<<<64, 64, 0, stream>>>(p, l);
            dbg_cmp<<<(NB * 4 * UT + 7424 * 64 + 255) / 256, 256, 0, stream>>>(p, l);
            dbg_save<<<16, 256, 0, stream>>>(p, 1);
        }
        LP(10); LP(11);
        if (dl) { dbg_mix<<<16, 256, 0, stream>>>(p, l, 1); dbg_save<<<16, 256, 0, stream>>>(p, 2); }
        LP(12); LP(13); LP(14);
        if (dl) dbg_ffn<<<16, 256, 0, stream>>>(p, l, 1, 2, 11);
#else
        LP(0); LP(1); LP(2); LP(3); LP(4); LP(5); LP(6); LP(7); LP(8); LP(9); LP(10); LP(11); LP(12); LP(13); LP(14);
#endif
#undef LP
    }
#ifdef DBG
    dbg_fin<<<1, 1, 0, stream>>>(p);
#endif
#endif
}
```

```cpp
#include <hip/hip_runtime.h>
#include <hip/hip_cooperative_groups.h>
#include <stdint.h>
#include <cstdio>
namespace cg = cooperative_groups;

#ifndef ONE_LAUNCH
#define ONE_LAUNCH 1
#endif

#define VTID ((int)((threadIdx.x + p.z) & 255))
typedef unsigned short u16;
typedef __attribute__((ext_vector_type(8))) short bf16x8;
typedef __attribute__((ext_vector_type(4))) float f32x4;
#define DEV __device__ __forceinline__

constexpr int D = 1024, NB = 8, SEQ = 4096, CTXL = 256;
constexpr int NL = NB * SEQ, NCX = NB * CTXL, MTOT = NL + NCX;
constexpr int DFF = 2816, PW = 2816, UT = SEQ + CTXL, NCH = UT / 64;
constexpr int NIN = 5904;
constexpr int PC_MLQ = 0, PC_NAQ = 256, PC_GQQ = 640, PC_MLO = 1024, PC_MLK = 1280, PC_NAK = 1536, PC_GQK = 1920,
              PC_MLV = 2048, PC_NAV = 2304, PC_GQV = 2688, PC_Y = 1024;
constexpr int TC_MLK = 0, TC_MLV = 256, TC_NAV = 512, TC_GQV = 896, TW = 1024;
constexpr int DBG_MLO = PC_MLQ, DBG_NAO = PC_NAQ;
constexpr int SCH = 4160;
constexpr int NSCAN = 64;

constexpr size_t al256(size_t x) { return (x + 255) & ~(size_t)255; }
constexpr size_t OFF_MODS = 0;
constexpr size_t OFF_ROPE = al256(OFF_MODS + (size_t)9 * 9216 * 4);
constexpr size_t OFF_G    = al256(OFF_ROPE + (size_t)4096 * 64 * 4);
constexpr size_t OFF_BC   = al256(OFF_G + (size_t)MTOT * 16 * 4);
constexpr size_t OFF_IG   = al256(OFF_BC + (size_t)NSCAN * UT * 4);
constexpr size_t OFF_AE   = al256(OFF_IG + (size_t)NSCAN * UT * 4);
constexpr size_t OFF_MS   = al256(OFF_AE + (size_t)NSCAN * UT * 4);
constexpr size_t OFF_DEC  = al256(OFF_MS + (size_t)NSCAN * NCH * 4);
constexpr size_t OFF_XC   = al256(OFF_DEC + (size_t)NSCAN * NCH * 4);
constexpr size_t OFF_H    = al256(OFF_XC + (size_t)NCX * D * 4);
constexpr size_t OFF_P    = al256(OFF_H + (size_t)MTOT * D * 2);
constexpr size_t OFF_T    = al256(OFF_P + (size_t)MTOT * PW * 2);
constexpr size_t OFF_S    = al256(OFF_T + (size_t)NB * TW * UT * 2);
constexpr size_t OFF_W    = al256(OFF_S + (size_t)NSCAN * NCH * SCH * 4);
constexpr size_t WE_IN0 = 0, WE_IN1 = WE_IN0 + (size_t)5632 * 1024, WE_OUT0 = WE_IN1 + (size_t)5632 * 1024,
                 WE_OUT1 = WE_OUT0 + (size_t)1024 * 2816, WE_MIX = WE_OUT1 + (size_t)1024 * 2816,
                 WE_BR = WE_MIX + (size_t)6016 * 1024, WE_O = WE_BR + (size_t)1024 * 1024, WE_END = WE_O + (size_t)1024 * 1024;
constexpr size_t OFF_BAR = al256(OFF_W + WE_END * 2);
constexpr size_t WS_END = OFF_BAR + 3456 * 4;
static_assert(WS_END < (size_t)536000000, "workspace too large");

struct Params {
    const float *x, *c, *ctx, *c_ctx, *ada_w, *ada_b, *norm_w, *ffn_w_in, *ffn_w_out, *mix_w_in, *ml_gate_b, *ml_norm_w,
        *na_qk_w, *na_rpb, *gq_qk_w, *w_br_ml, *w_br_na, *w_br_gq, *w_out;
    float* out;
    char* ws;
    int z, pad;
};

DEV uint32_t pk2(float lo, float hi) { uint32_t r; asm("v_cvt_pk_bf16_f32 %0, %1, %2" : "=v"(r) : "v"(lo), "v"(hi)); return r; }
DEV float bflo(uint32_t w) { return __uint_as_float(w << 16); }
DEV float bfhi(uint32_t w) { return __uint_as_float(w & 0xffff0000u); }
DEV f32x4 mfma16(bf16x8 a, bf16x8 b, f32x4 c) { return __builtin_amdgcn_mfma_f32_16x16x32_bf16(a, b, c, 0, 0, 0); }
typedef unsigned u32x4 __attribute__((ext_vector_type(4)));
DEV u32x4 gld16(const void* q) { u32x4 r; asm volatile("global_load_dwordx4 %0, %1, off" : "=v"(r) : "v"(q) : "memory"); return r; }
DEV u32x4 gld16s(const void* sbase, unsigned voff) { u32x4 r; asm volatile("global_load_dwordx4 %0, %1, %2" : "=v"(r) : "v"(voff), "s"(sbase) : "memory"); return r; }
DEV void glds16(const void* sbase, unsigned voff, unsigned ldsaddr) {
    asm volatile("s_mov_b32 m0, %2\n\ts_nop 0\n\tglobal_load_lds_dwordx4 %0, %1" :: "v"(voff), "s"(sbase), "s"(ldsaddr) : "memory", "m0");
}
#define VM_WAIT0() asm volatile("s_waitcnt vmcnt(0)" ::: "memory")
union Frag { bf16x8 v; uint4 q; uint32_t u[4]; uint2 d[2]; };
DEV int cu_of(int c, int dir) { return c < 4 ? 64 + (dir ? 3 - c : c) : (dir ? 63 - (c - 4) : (c - 4)); }
DEV int rowof(int b, int u) { return u < SEQ ? b * SEQ + u : NL + b * CTXL + (u - SEQ); }
DEV float fexp2(float x) { return __builtin_amdgcn_exp2f(x); }
DEV float fexp(float x) { return __builtin_amdgcn_exp2f(x * 1.4426950408889634f); }
DEV float sigmoidf_(float x) { return 1.f / (1.f + fexp(-x)); }
DEV float xq_max(float v) {
    auto r = __builtin_amdgcn_permlane16_swap(__float_as_uint(v), __float_as_uint(v), false, false);
    const float m = fmaxf(__uint_as_float(r[0]), __uint_as_float(r[1]));
    auto q = __builtin_amdgcn_permlane32_swap(__float_as_uint(m), __float_as_uint(m), false, false);
    return fmaxf(__uint_as_float(q[0]), __uint_as_float(q[1]));
}
DEV float xq_sum(float v) {
    auto r = __builtin_amdgcn_permlane16_swap(__float_as_uint(v), __float_as_uint(v), false, false);
    const float m = __uint_as_float(r[0]) + __uint_as_float(r[1]);
    auto q = __builtin_amdgcn_permlane32_swap(__float_as_uint(m), __float_as_uint(m), false, false);
    return __uint_as_float(q[0]) + __uint_as_float(q[1]);
}
DEV float wave_sum(float v) {
#pragma unroll
    for (int o = 1; o < 64; o <<= 1) v += __shfl_xor(v, o);
    return v;
}
DEV float wave_max(float v) {
#pragma unroll
    for (int o = 1; o < 64; o <<= 1) v = fmaxf(v, __shfl_xor(v, o));
    return v;
}

#define WSP(T_, off) ((T_*)(p.ws + (off)))
DEV float m_scan(const Params& p, int sc, int c_end) {
    const float* BT = WSP(float, OFF_MS) + sc * NCH;
    const float* MX = WSP(float, OFF_DEC) + sc * NCH;
    const int lane = VTID & 63;
    const float bt0 = BT[lane], mx0 = MX[lane], bt1 = BT[64 + (lane & 3)], mx1 = MX[64 + (lane & 3)];
    float m = 0.f;
    for (int c = 0; c < c_end; ++c) {
        const float b = c < 64 ? __shfl(bt0, c) : __shfl(bt1, c - 64);
        const float x = c < 64 ? __shfl(mx0, c) : __shfl(mx1, c - 64);
        m = fmaxf(b + m, x);
    }
    return m;
}

template <int TN>
DEV void gemm_accum(f32x4 (&acc)[4][TN], const u16* __restrict__ A, int lda, const u16* __restrict__ B, int ldb, int K, char* smem, int tid) {
    constexpr int BROWS = TN * 32;
    constexpr int STAGE = (128 + BROWS) * 144;
    constexpr int NBCH = BROWS / 32;
    const int lane = tid & 63, wave = tid >> 6;
    const int wm = wave >> 1, wn = wave & 1, fr = lane & 15, fq = lane >> 4;
    const int lrow = tid >> 3, lc8 = tid & 7;
    const u16* ga = A + (size_t)lrow * lda + lc8 * 8;
    const u16* gb = B + (size_t)lrow * ldb + lc8 * 8;
    u32x4 ra[4], rb[NBCH];
    const int nk = K >> 6;
#pragma unroll
    for (int i = 0; i < 4; ++i) ra[i] = gld16(ga + (size_t)(32 * i) * lda);
#pragma unroll
    for (int i = 0; i < NBCH; ++i) rb[i] = gld16(gb + (size_t)(32 * i) * ldb);
    char* sw = smem + lrow * 144 + lc8 * 16;
    VM_WAIT0();
#pragma unroll
    for (int i = 0; i < 4; ++i) *(u32x4*)(sw + i * 32 * 144) = ra[i];
#pragma unroll
    for (int i = 0; i < NBCH; ++i) *(u32x4*)(sw + 128 * 144 + i * 32 * 144) = rb[i];
    __syncthreads();
    const char* sa_r = smem + (wm * 64 + fr) * 144 + fq * 16;
    const char* sb_r = smem + 128 * 144 + (wn * TN * 16 + fr) * 144 + fq * 16;
    for (int kt = 0; kt < nk; ++kt) {
        const int cur = kt & 1;
        const int k0 = (kt + 1 < nk ? kt + 1 : kt) * 64;
#pragma unroll
        for (int i = 0; i < 4; ++i) ra[i] = gld16(ga + (size_t)(32 * i) * lda + k0);
#pragma unroll
        for (int i = 0; i < NBCH; ++i) rb[i] = gld16(gb + (size_t)(32 * i) * ldb + k0);
        __builtin_amdgcn_sched_barrier(0);
#pragma unroll
        for (int ks = 0; ks < 2; ++ks) {
            bf16x8 af[4], bfr[TN];
#pragma unroll
            for (int mt = 0; mt < 4; ++mt) af[mt] = *(const bf16x8*)(sa_r + cur * STAGE + mt * 16 * 144 + ks * 64);
#pragma unroll
            for (int nt = 0; nt < TN; ++nt) bfr[nt] = *(const bf16x8*)(sb_r + cur * STAGE + nt * 16 * 144 + ks * 64);
#pragma unroll
            for (int mt = 0; mt < 4; ++mt)
#pragma unroll
                for (int nt = 0; nt < TN; ++nt) acc[mt][nt] = mfma16(af[mt], bfr[nt], acc[mt][nt]);
        }
        __builtin_amdgcn_sched_barrier(0);
        VM_WAIT0();
        {
            char* sw2 = sw + (cur ^ 1) * STAGE;
#pragma unroll
            for (int i = 0; i < 4; ++i) *(u32x4*)(sw2 + i * 32 * 144) = ra[i];
#pragma unroll
            for (int i = 0; i < NBCH; ++i) *(u32x4*)(sw2 + 128 * 144 + i * 32 * 144) = rb[i];
        }
        __syncthreads();
    }
}

template <int TN>
DEV void zero_acc(f32x4 (&acc)[4][TN]) {
#pragma unroll
    for (int i = 0; i < 4; ++i)
#pragma unroll
        for (int j = 0; j < TN; ++j) acc[i][j] = f32x4{0.f, 0.f, 0.f, 0.f};
}

DEV void tile_decode(int t, int ntn, int& mt, int& nt) {
    const int per = 8 * ntn;
    const int gi = t / per, rem = t - gi * per;
    nt = rem >> 3;
    mt = gi * 8 + (rem & 7);
}


template <bool SWAP = false>
DEV void gemm8_accum(f32x4 (&acc)[8][4], const u16* __restrict__ A, int lda, const u16* __restrict__ B, int ldb, int K, char* smem, int tid) {
    constexpr int STAGE = 65536;
    const int lane = tid & 63, wave = tid >> 6;
    const int wm = wave >> 2, wn = wave & 3, fr = lane & 15, fq = lane >> 4;
    const int lr = lane >> 3, pos = lane & 7;
    const int ce = pos ^ (lr >> 1), co = pos ^ (4 | (lr >> 1));
    const unsigned ra_ = (unsigned)((wave * 32 + lr) * lda) * 2u, rb_ = (unsigned)((wave * 32 + lr) * ldb) * 2u;
    const unsigned voa_e = ra_ + ce * 16, voa_o = ra_ + co * 16, vob_e = rb_ + ce * 16, vob_o = rb_ + co * 16;
    const int nk = K >> 6;
    const unsigned ldsw = __builtin_amdgcn_readfirstlane((unsigned)(size_t)(__attribute__((address_space(3))) char*)smem + wave * 4096);
#define G8_ISSUE(STG, K0) do { \
        _Pragma("unroll") for (int i = 0; i < 4; ++i) { \
            glds16(A + (size_t)(8 * i) * lda + (K0), (i & 1) ? voa_o : voa_e, ldsw + (STG) * STAGE + i * 1024); \
            glds16(B + (size_t)(8 * i) * ldb + (K0), (i & 1) ? vob_o : vob_e, ldsw + (STG) * STAGE + 32768 + i * 1024); \
        } } while (0)
    G8_ISSUE(0, 0);
    VM_WAIT0();
    __syncthreads();
    const int s3 = (fr >> 1) & 7;
    const int oa_base = (wm * 128 + fr) * 128 + ((fq ^ s3) * 16);
    const int ob_base = 32768 + (wn * 64 + fr) * 128 + ((fq ^ s3) * 16);
    for (int kt = 0; kt < nk; ++kt) {
        const int cur = kt & 1;
        const int k0 = (kt + 1 < nk ? kt + 1 : kt) * 64;
        G8_ISSUE(cur ^ 1, k0);
        int o_a = cur * STAGE + oa_base, o_b = cur * STAGE + ob_base;
        asm volatile("" : "+v"(o_a), "+v"(o_b));
#pragma unroll
        for (int ks = 0; ks < 2; ++ks) {
            const char* sa_c = smem + (ks ? (o_a ^ 64) : o_a);
            const char* sb_c = smem + (ks ? (o_b ^ 64) : o_b);
            bf16x8 bfr[4], af[8];
#pragma unroll
            for (int nt = 0; nt < 4; ++nt) bfr[nt] = *(const bf16x8*)(sb_c + nt * 2048);
#pragma unroll
            for (int mt = 0; mt < 8; ++mt) af[mt] = *(const bf16x8*)(sa_c + mt * 2048);
#pragma unroll
            for (int mt = 0; mt < 8; ++mt)
#pragma unroll
                for (int nt = 0; nt < 4; ++nt) acc[mt][nt] = SWAP ? mfma16(bfr[nt], af[mt], acc[mt][nt]) : mfma16(af[mt], bfr[nt], acc[mt][nt]);
            __builtin_amdgcn_sched_group_barrier(0x100, 7, 0);
#pragma unroll
            for (int i = 0; i < 5; ++i) { __builtin_amdgcn_sched_group_barrier(0x008, 4, 0); __builtin_amdgcn_sched_group_barrier(0x100, 1, 0); }
#pragma unroll
            for (int i = 0; i < 3; ++i) __builtin_amdgcn_sched_group_barrier(0x008, 4, 0);
        }
        VM_WAIT0();
        __syncthreads();
    }
#undef G8_ISSUE
}
DEV void zero_acc8(f32x4 (&acc)[8][4]) {
#pragma unroll
    for (int i = 0; i < 8; ++i)
#pragma unroll
        for (int j = 0; j < 4; ++j) acc[i][j] = f32x4{0.f, 0.f, 0.f, 0.f};
}
DEV void tile_decode8(int t, int ntn, int& mt, int& nt) {
    const int per = 4 * ntn;
    const int gi = t / per, rem = t - gi * per;
    nt = rem >> 2;
    mt = gi * 4 + (rem & 3);
}

DEV void ph_ffn_in8(const Params& p, int which, char* smem, int rvid, int RG, int tid) {
    const u16* H = WSP(u16, OFF_H);
    const u16* Wt = WSP(u16, OFF_W) + (which ? WE_IN1 : WE_IN0);
    u16* ACT = WSP(u16, OFF_P);
    const int lane = tid & 63, wave = tid >> 6, wm = wave >> 2, wn = wave & 3, fr = lane & 15, fq = lane >> 4;
    const int total = 128 * 22;
    for (int t = rvid; t < total; t += RG) {
        int mt_, nt_;
        tile_decode8(t, 22, mt_, nt_);
        const int m0 = mt_ * 256, n0 = nt_ * 256;
        f32x4 acc[8][4];
        zero_acc8(acc);
        gemm8_accum(acc, H + (size_t)m0 * D, D, Wt + (size_t)n0 * D, D, D, smem, tid);
#pragma unroll
        for (int mt = 0; mt < 8; ++mt)
#pragma unroll
            for (int pp = 0; pp < 2; ++pp)
#pragma unroll
                for (int r = 0; r < 4; ++r) {
                    const int row = m0 + wm * 128 + mt * 16 + fq * 4 + r;
                    const int hid = (n0 >> 1) + wn * 32 + pp * 16 + fr;
                    const float g = acc[mt][2 * pp][r], u = acc[mt][2 * pp + 1][r];
                    const float v = g * sigmoidf_(g) * u;
                    ACT[(size_t)row * DFF + hid] = (u16)(pk2(v, 0.f) & 0xffff);
                }
    }
}
DEV void ph_resid8(const Params& p, const u16* A, int lda, const u16* Wt, int K, int modidx, float coef, char* smem, int rvid, int RG, int tid, const float* xsrc) {
    const float* mods = WSP(float, OFF_MODS);
    const int lane = tid & 63, wave = tid >> 6, wm = wave >> 2, wn = wave & 3, fr = lane & 15, fq = lane >> 4;
    const int total = 128 * 4;
    for (int t = rvid; t < total; t += RG) {
        int mt_, nt_;
        tile_decode8(t, 4, mt_, nt_);
        const int m0 = mt_ * 256, n0 = nt_ * 256;
        f32x4 acc[8][4];
        zero_acc8(acc);
        gemm8_accum<true>(acc, A + (size_t)m0 * lda, lda, Wt + (size_t)n0 * K, K, K, smem, tid);
        const float* gp = mods + (m0 >> 12) * 9216 + modidx * 1024;
#pragma unroll
        for (int nt = 0; nt < 4; ++nt) {
            const int col = n0 + wn * 64 + nt * 16 + fq * 4;
            float4 g4 = *(const float4*)(gp + col);
            g4.x *= coef; g4.y *= coef; g4.z *= coef; g4.w *= coef;
#pragma unroll
            for (int mt = 0; mt < 8; ++mt) {
                const size_t off = (size_t)(m0 + wm * 128 + mt * 16 + fr) * D + col;
                float4 xv = *(const float4*)(xsrc + off);
                xv.x += g4.x * acc[mt][nt][0];
                xv.y += g4.y * acc[mt][nt][1];
                xv.z += g4.z * acc[mt][nt][2];
                xv.w += g4.w * acc[mt][nt][3];
                *(float4*)(p.out + off) = xv;
            }
        }
    }
}
DEV void ph_pgemm8(const Params& p, int lsel, char* smem, int rvid, int RG, int tid) {
    const u16* H = WSP(u16, OFF_H);
    const u16* Wt = WSP(u16, OFF_W) + WE_MIX;
    u16* P = WSP(u16, OFF_P);
    u16* T = WSP(u16, OFF_T);
    float* Gt = WSP(float, OFF_G);
    const int lane = tid & 63, wave = tid >> 6, wm = wave >> 2, wn = wave & 3, fr = lane & 15, fq = lane >> 4;
    const int total = 128 * 12;
    for (int t = rvid; t < total; t += RG) {
        int mt_, nt_;
        tile_decode8(t, 12, mt_, nt_);
        const int m0 = mt_ * 256, n0 = nt_ * 256;
        f32x4 acc[8][4];
        zero_acc8(acc);
        const int cb = n0 + wn * 64;
        const int j = cb >> 7;
        const bool swap_tile = (nt_ <= 4) || (nt_ == 6) || (nt_ == 7);
        if (swap_tile) {
            gemm8_accum<true>(acc, H + (size_t)m0 * D, D, Wt + (size_t)n0 * D, D, D, smem, tid);
            const bool normed = (cb >= 256 && cb < 1024) || (cb >= 1536);
            const bool isq = cb < 1024;
            const bool isgq = (cb >= 640 && cb < 1024) || (cb >= 1920);
            const float* wv = (isgq ? p.gq_qk_w : p.na_qk_w) + (lsel * 2 + (isq ? 0 : 1)) * 64;
            const float scl = isq ? 0.125f : 1.f;
            float4 w4[4];
#pragma unroll
            for (int nt = 0; nt < 4; ++nt) w4[nt] = normed ? *(const float4*)(wv + nt * 16 + fq * 4) : float4{1.f, 1.f, 1.f, 1.f};
            const float* rope = WSP(float, OFF_ROPE);
#pragma unroll
            for (int mt = 0; mt < 8; ++mt) {
                const int row = m0 + wm * 128 + mt * 16 + fr;
                if (normed) {
                    float ss = 0.f;
#pragma unroll
                    for (int nt = 0; nt < 4; ++nt)
#pragma unroll
                        for (int r = 0; r < 4; ++r) ss += acc[mt][nt][r] * acc[mt][nt][r];
                    ss = xq_sum(ss);
                    const float rstd = rsqrtf(ss * (1.f / 64.f) + 1e-6f) * scl;
#pragma unroll
                    for (int nt = 0; nt < 4; ++nt) {
                        acc[mt][nt][0] *= rstd * w4[nt].x; acc[mt][nt][1] *= rstd * w4[nt].y;
                        acc[mt][nt][2] *= rstd * w4[nt].z; acc[mt][nt][3] *= rstd * w4[nt].w;
                    }
                    if (isgq) {
                        const int tok = row & 4095;
#pragma unroll
                        for (int nt = 0; nt < 2; ++nt) {
                            const float* rp = rope + ((size_t)tok * 32 + nt * 16 + fq * 4) * 2;
                            const float4 cs01 = *(const float4*)rp, cs23 = *(const float4*)(rp + 4);
                            const float cv[4] = {cs01.x, cs01.z, cs23.x, cs23.z}, sv[4] = {cs01.y, cs01.w, cs23.y, cs23.w};
#pragma unroll
                            for (int r = 0; r < 4; ++r) {
                                const float x1 = acc[mt][nt][r], x2 = acc[mt][nt + 2][r];
                                acc[mt][nt][r] = x1 * cv[r] - x2 * sv[r];
                                acc[mt][nt + 2][r] = x1 * sv[r] + x2 * cv[r];
                            }
                        }
                    }
                }
#pragma unroll
                for (int nt = 0; nt < 4; ++nt)
                    *(uint2*)(P + (size_t)row * PW + cb + nt * 16 + fq * 4) = uint2{pk2(acc[mt][nt][0], acc[mt][nt][1]), pk2(acc[mt][nt][2], acc[mt][nt][3])};
            }
            continue;
        }
        gemm8_accum(acc, H + (size_t)m0 * D, D, Wt + (size_t)n0 * D, D, D, smem, tid);
        if (j >= 22) {
            if (cb == 2816) {
#pragma unroll
                for (int mt = 0; mt < 8; ++mt)
#pragma unroll
                    for (int r = 0; r < 4; ++r) {
                        const int row = m0 + wm * 128 + mt * 16 + fq * 4 + r;
                        Gt[(size_t)row * 16 + fr] = acc[mt][0][r];
                    }
            }
            continue;
        }
        const bool rowmajor = j < 16;
        const bool transp = (j == 10) || (j == 11) || (j >= 16);
        if (rowmajor) {
#pragma unroll
            for (int mt = 0; mt < 8; ++mt)
#pragma unroll
                for (int nt = 0; nt < 4; ++nt)
#pragma unroll
                    for (int r = 0; r < 4; ++r) {
                        const int row = m0 + wm * 128 + mt * 16 + fq * 4 + r;
                        P[(size_t)row * PW + cb + nt * 16 + fr] = (u16)(pk2(acc[mt][nt][r], 0.f) & 0xffff);
                    }
        }
        if (transp) {
            const int tcb = (j >= 16) ? (cb - 1792) : (cb - 1280);
            const int b = m0 >> 12, u0 = m0 & 4095;
#pragma unroll
            for (int mt = 0; mt < 8; ++mt)
#pragma unroll
                for (int nt = 0; nt < 4; ++nt) {
                    const int tc = tcb + nt * 16 + fr;
                    const int u = u0 + wm * 128 + mt * 16 + fq * 4;
                    *(uint2*)(T + ((size_t)(b * TW + tc)) * UT + u) = uint2{pk2(acc[mt][nt][0], acc[mt][nt][1]), pk2(acc[mt][nt][2], acc[mt][nt][3])};
                }
        }
    }
}

DEV int map_col(int type, int n) {
    if (type == 0) return n;
    if (type == 1) {
        const int jb = n >> 5, r = n & 31;
        return r < 16 ? jb * 16 + r : DFF + jb * 16 + (r - 16);
    }
    if (n < 256) return 1552 + n;
    if (n < 640) return 2064 + (n - 256);
    if (n < 1024) return 2448 + (n - 640);
    if (n < 1280) return 1808 + (n - 1024);
    if (n < 1536) return (n - 1280);
    if (n < 1920) return 528 + (n - 1536);
    if (n < 2048) return 1296 + (n - 1920);
    if (n < 2304) return 256 + (n - 2048);
    if (n < 2688) return 912 + (n - 2304);
    if (n < 2816) return 1424 + (n - 2688);
    if (n < 2832) return 512 + (n - 2816);
    if (n < 2944) return -1;
    return 2832 + (n - 2944);
}

DEV void conv_tile(const float* __restrict__ src, int ld_src, int type, u16* __restrict__ dst, int ld_dst, int k_off, int kt, int ntile, char* smem, int tid) {
    float* lds = (float*)smem;
    const int k0 = kt * 64, n0 = ntile * 64;
    {
        const int r = tid >> 6, c = tid & 63;
        const int col = map_col(type, n0 + c);
#pragma unroll
        for (int i = 0; i < 16; ++i) {
            const int k = r + 4 * i;
            float v = 0.f;
            if (col >= 0) v = src[(size_t)(k0 + k) * ld_src + col];
            lds[k * 65 + c] = v;
        }
    }
    __syncthreads();
    {
        const int n = tid >> 2, kq = tid & 3;
        uint32_t w[8];
#pragma unroll
        for (int j = 0; j < 8; ++j) w[j] = pk2(lds[(kq * 16 + 2 * j) * 65 + n], lds[(kq * 16 + 2 * j + 1) * 65 + n]);
        u16* d = dst + (size_t)(n0 + n) * ld_dst + k_off + k0 + kq * 16;
        *(uint4*)d = uint4{w[0], w[1], w[2], w[3]};
        *(uint4*)(d + 8) = uint4{w[4], w[5], w[6], w[7]};
    }
    __syncthreads();
}

DEV void ph_prep(const Params& p, int l, char* smem, int bid, int G) {
    u16* W = WSP(u16, OFF_W);
    const int tid = VTID;
    constexpr int N_CONV = 6240, N_MODS = 288;
    for (int it = bid; it < N_CONV + N_MODS; it += G) {
        if (it < N_CONV) {
            int r = it;
            if (r < 2816) {
                const int which = r / 1408; r -= which * 1408;
                conv_tile(p.ffn_w_in + (size_t)(l * 2 + which) * 1024 * 5632, 5632, 1, W + (which ? WE_IN1 : WE_IN0), 1024, 0, r / 88, r % 88, smem, tid);
                continue;
            }
            r -= 2816;
            if (r < 1408) {
                const int which = r / 704; r -= which * 704;
                conv_tile(p.ffn_w_out + (size_t)(l * 2 + which) * 2816 * 1024, 1024, 0, W + (which ? WE_OUT1 : WE_OUT0), 2816, 0, r / 16, r % 16, smem, tid);
                continue;
            }
            r -= 1408;
            if (r < 1504) {
                conv_tile(p.mix_w_in + (size_t)l * 1024 * NIN, NIN, 2, W + WE_MIX, 1024, 0, r / 94, r % 94, smem, tid);
                continue;
            }
            r -= 1504;
            if (r < 64) { conv_tile(p.w_br_ml + (size_t)l * 256 * 1024, 1024, 0, W + WE_BR, 1024, 0, r / 16, r % 16, smem, tid); continue; }
            r -= 64;
            if (r < 96) { conv_tile(p.w_br_na + (size_t)l * 384 * 1024, 1024, 0, W + WE_BR, 1024, 256, r / 16, r % 16, smem, tid); continue; }
            r -= 96;
            if (r < 96) { conv_tile(p.w_br_gq + (size_t)l * 384 * 1024, 1024, 0, W + WE_BR, 1024, 640, r / 16, r % 16, smem, tid); continue; }
            r -= 96;
            conv_tile(p.w_out + (size_t)l * 1024 * 1024, 1024, 0, W + WE_O, 1024, 0, r / 16, r % 16, smem, tid);
        } else {
            const int cb = it - N_CONV;
            float* s = (float*)smem;
            float* red = s + 9 * 1024;
            for (int i = tid; i < 9 * 1024; i += 256) {
                const int b = i >> 10, k = i & 1023;
                const float v = b < 8 ? p.c[b * 1024 + k] : p.c_ctx[k];
                s[i] = v * sigmoidf_(v);
            }
            __syncthreads();
            const int kg = tid >> 5, c = tid & 31, col = cb * 32 + c;
            float a[9];
#pragma unroll
            for (int b = 0; b < 9; ++b) a[b] = 0.f;
            const float* wp = p.ada_w + (size_t)l * 1024 * 9216 + (size_t)(kg * 128) * 9216 + col;
#pragma unroll 16
            for (int k = 0; k < 128; ++k) {
                const float w = wp[(size_t)k * 9216];
#pragma unroll
                for (int b = 0; b < 9; ++b) a[b] += s[b * 1024 + kg * 128 + k] * w;
            }
#pragma unroll
            for (int b = 0; b < 9; ++b) red[(kg * 9 + b) * 32 + c] = a[b];
            __syncthreads();
            for (int i = tid; i < 288; i += 256) {
                const int b = i >> 5, cc = i & 31;
                float v = p.ada_b[l * 9216 + cb * 32 + cc];
#pragma unroll
                for (int g = 0; g < 8; ++g) v += red[(g * 9 + b) * 32 + cc];
                WSP(float, OFF_MODS)[b * 9216 + cb * 32 + cc] = v;
            }
            __syncthreads();
        }
    }
    if (l == 0) {
        const size_t gt = (size_t)bid * 256 + tid, gs = (size_t)G * 256;
        const float4* cs = (const float4*)p.ctx; float4* cd = WSP(float4, OFF_XC);
        for (size_t i = gt; i < (size_t)NCX * D / 4; i += gs) cd[i] = cs[i];
        float* rope = WSP(float, OFF_ROPE);
        for (size_t i = gt; i < (size_t)4096 * 32; i += gs) {
            const int t = (int)(i >> 5), f = (int)(i & 31);
            const float pos = (float)((f < 16) ? (t >> 6) : (t & 63));
            const float inv = powf(10000.f, -(float)(f & 15) / 16.f);
            float sn, cs_;
            sincosf(pos * inv, &sn, &cs_);
            rope[i * 2] = cs_;
            rope[i * 2 + 1] = sn;
        }
    }
}

DEV void ph_mod(const Params& p, int l, int sub, int nrows, int bid, int G) {
    const bool first = (l == 0 && sub == 0);
    const int lane = VTID & 63, gw = bid * 4 + (VTID >> 6), NW = G * 4;
    const float* nw = p.norm_w + (size_t)(l * 3 + sub) * 1024;
    const float* mods = WSP(float, OFF_MODS);
    u16* H = WSP(u16, OFF_H);
#pragma unroll 2
    for (int r = gw; r < nrows; r += NW) {
        const float* xr = r < NL ? (first ? p.x : p.out) + (size_t)r * D : (first ? p.ctx : WSP(float, OFF_XC)) + (size_t)(r - NL) * D;
        const int b9 = r < NL ? (r >> 12) : 8;
        const float* sh = mods + b9 * 9216 + (3 * sub) * 1024;
        const float* sc = sh + 1024;
        float4 v[4];
        float ss = 0.f;
#pragma unroll
        for (int j = 0; j < 4; ++j) {
            v[j] = *(const float4*)(xr + lane * 4 + 256 * j);
            ss += v[j].x * v[j].x + v[j].y * v[j].y + v[j].z * v[j].z + v[j].w * v[j].w;
        }
        ss = wave_sum(ss);
        const float rstd = rsqrtf(ss * (1.f / 1024.f) + 1e-6f);
#pragma unroll
        for (int j = 0; j < 4; ++j) {
            const int k = lane * 4 + 256 * j;
            const float4 w = *(const float4*)(nw + k), s1 = *(const float4*)(sc + k), s0 = *(const float4*)(sh + k);
            const float y0 = v[j].x * rstd * w.x * (1.f + s1.x) + s0.x;
            const float y1 = v[j].y * rstd * w.y * (1.f + s1.y) + s0.y;
            const float y2 = v[j].z * rstd * w.z * (1.f + s1.z) + s0.z;
            const float y3 = v[j].w * rstd * w.w * (1.f + s1.w) + s0.w;
            *(uint2*)(H + (size_t)r * D + k) = uint2{pk2(y0, y1), pk2(y2, y3)};
        }
    }
}

DEV void ph_ffn_in(const Params& p, int which, int mt0, int mtiles, char* smem, int vid, int G) {
    const u16* H = WSP(u16, OFF_H);
    const u16* Wt = WSP(u16, OFF_W) + (which ? WE_IN1 : WE_IN0);
    u16* ACT = WSP(u16, OFF_P);
    const int lane = VTID & 63, wave = VTID >> 6, wm = wave >> 1, wn = wave & 1, fr = lane & 15, fq = lane >> 4;
    const int total = mtiles * 44;
    for (int t = vid; t < total; t += G) {
        int mt_, nt_;
        tile_decode(t, 44, mt_, nt_);
        mt_ += mt0;
        const int m0 = mt_ * 128, n0 = nt_ * 128;
        f32x4 acc[4][4];
        zero_acc<4>(acc);
        gemm_accum<4>(acc, H + (size_t)m0 * D, D, Wt + (size_t)n0 * D, D, D, smem, VTID);
#pragma unroll
        for (int mt = 0; mt < 4; ++mt)
#pragma unroll
            for (int pp = 0; pp < 2; ++pp)
#pragma unroll
                for (int r = 0; r < 4; ++r) {
                    const int row = m0 + wm * 64 + mt * 16 + fq * 4 + r;
                    const int hid = (n0 >> 1) + wn * 32 + pp * 16 + fr;
                    const float g = acc[mt][2 * pp][r], u = acc[mt][2 * pp + 1][r];
                    const float v = g * sigmoidf_(g) * u;
                    ACT[(size_t)row * DFF + hid] = (u16)(pk2(v, 0.f) & 0xffff);
                }
    }
}

DEV void ph_resid(const Params& p, const u16* A, int lda, const u16* Wt, int K, int modidx, float coef, int mt0, int mtiles, char* smem, int vid, int G) {
    const float* mods = WSP(float, OFF_MODS);
    const int lane = VTID & 63, wave = VTID >> 6, wm = wave >> 1, wn = wave & 1, fr = lane & 15, fq = lane >> 4;
    const int total = mtiles * 8 * 4;
    const int Kc = K >> 2;
    for (int t = vid; t < total; t += G) {
        int mt_, nt_;
        const int ksp = t & 3;
        tile_decode(t >> 2, 8, mt_, nt_);
        mt_ += mt0;
        const int m0 = mt_ * 128, n0 = nt_ * 128;
        f32x4 acc[4][4];
        zero_acc<4>(acc);
        gemm_accum<4>(acc, A + (size_t)m0 * lda + ksp * Kc, lda, Wt + (size_t)n0 * K + ksp * Kc, K, Kc, smem, VTID);
        const int b9 = m0 < NL ? (m0 >> 12) : 8;
        const float* gp = mods + b9 * 9216 + modidx * 1024;
#pragma unroll
        for (int nt = 0; nt < 4; ++nt) {
            const int col = n0 + wn * 64 + nt * 16 + fr;
            const float gv = gp[col] * coef;
#pragma unroll
            for (int mt = 0; mt < 4; ++mt)
#pragma unroll
                for (int r = 0; r < 4; ++r) {
                    const int row = m0 + wm * 64 + mt * 16 + fq * 4 + r;
                    float* xp = (row < NL ? p.out + (size_t)row * D : WSP(float, OFF_XC) + (size_t)(row - NL) * D) + col;
                    __hip_atomic_fetch_add(xp, gv * acc[mt][nt][r], __ATOMIC_RELAXED, __HIP_MEMORY_SCOPE_AGENT);
                }
        }
    }
}

DEV void ph_pgemm(const Params& p, int mt0, int mtiles, char* smem, int vid, int G) {
    const u16* H = WSP(u16, OFF_H);
    const u16* Wt = WSP(u16, OFF_W) + WE_MIX;
    u16* P = WSP(u16, OFF_P);
    u16* T = WSP(u16, OFF_T);
    float* Gt = WSP(float, OFF_G);
    const int lane = VTID & 63, wave = VTID >> 6, wm = wave >> 1, wn = wave & 1, fr = lane & 15, fq = lane >> 4;
    const int total = mtiles * 23;
    for (int t = vid; t < total; t += G) {
        int mt_, nt_;
        tile_decode(t, 23, mt_, nt_);
        mt_ += mt0;
        const int m0 = mt_ * 128, n0 = nt_ * 128;
        f32x4 acc[4][4];
        zero_acc<4>(acc);
        gemm_accum<4>(acc, H + (size_t)m0 * D, D, Wt + (size_t)n0 * D, D, D, smem, VTID);
        if (nt_ == 22) {
            if (wn == 0) {
#pragma unroll
                for (int mt = 0; mt < 4; ++mt)
#pragma unroll
                    for (int r = 0; r < 4; ++r) {
                        const int row = m0 + wm * 64 + mt * 16 + fq * 4 + r;
                        Gt[(size_t)row * 16 + fr] = acc[mt][0][r];
                    }
            }
            continue;
        }
        const bool rowmajor = nt_ < 16;
        const bool transp = (nt_ == 10) || (nt_ == 11) || (nt_ >= 16);
        if (rowmajor) {
#pragma unroll
            for (int mt = 0; mt < 4; ++mt)
#pragma unroll
                for (int nt = 0; nt < 4; ++nt)
#pragma unroll
                    for (int r = 0; r < 4; ++r) {
                        const int row = m0 + wm * 64 + mt * 16 + fq * 4 + r;
                        const int col = n0 + wn * 64 + nt * 16 + fr;
                        P[(size_t)row * PW + col] = (u16)(pk2(acc[mt][nt][r], 0.f) & 0xffff);
                    }
        }
        if (transp) {
            const int tcb = (nt_ >= 16) ? (n0 - 1792) : (n0 - 1280);
            int b, u0;
            if (m0 < NL) { b = m0 >> 12; u0 = m0 & 4095; } else { b = (m0 - NL) >> 8; u0 = SEQ + ((m0 - NL) & 255); }
#pragma unroll
            for (int mt = 0; mt < 4; ++mt)
#pragma unroll
                for (int nt = 0; nt < 4; ++nt) {
                    const int tc = tcb + wn * 64 + nt * 16 + fr;
                    const int u = u0 + wm * 64 + mt * 16 + fq * 4;
                    *(uint2*)(T + ((size_t)(b * TW + tc)) * UT + u) = uint2{pk2(acc[mt][nt][0], acc[mt][nt][1]), pk2(acc[mt][nt][2], acc[mt][nt][3])};
                }
        }
    }
}

DEV void ph_qknorm_gates(const Params& p, int l, int bid, int G) {
    const int lane = VTID & 63, gw = bid * 4 + (VTID >> 6), NW = G * 4;
    u16* P = WSP(u16, OFF_P);
    for (int it = gw; it < NSCAN * NCH; it += NW) {
        const int sc = it / NCH, c = it - sc * NCH, dir = sc & 1, h = (sc >> 1) & 3, b = sc >> 3;
        const float* Gt = WSP(float, OFF_G);
        float* BC = WSP(float, OFF_BC) + (size_t)sc * UT;
        float* IG = WSP(float, OFF_IG) + (size_t)sc * UT;
        float* WE = WSP(float, OFF_AE) + (size_t)sc * UT;
        const float bi = p.ml_gate_b[l * 16 + dir * 8 + h], bf = p.ml_gate_b[l * 16 + dir * 8 + 4 + h];
        const int cu = cu_of(c, dir);
        const int u = cu * 64 + (dir ? 63 - lane : lane);
        const int row = rowof(b, u);
        const float ig = Gt[(size_t)row * 16 + dir * 8 + h] + bi;
        const float fp = Gt[(size_t)row * 16 + dir * 8 + 4 + h] + bf;
        const float lf = fminf(fp, 0.f) - log1pf(expf(-fabsf(fp)));
        float bc = lf;
#pragma unroll
        for (int o = 1; o < 64; o <<= 1) { const float tv = __shfl_up(bc, o); if (lane >= o) bc += tv; }
        const float btot = __shfl(bc, 63);
        const float wend = btot - bc + ig;
        const float mx = wave_max(wend);
        WE[u] = wend;
        BC[u] = bc;
        IG[u] = ig;
        if (lane == 0) { WSP(float, OFF_MS)[sc * NCH + c] = btot; WSP(float, OFF_DEC)[sc * NCH + c] = mx; }
    }
    const float* rope = WSP(float, OFF_ROPE);
    const int hs = lane >> 4, e4 = (lane & 15) * 4;
    for (int r = NL + gw; r < MTOT; r += NW) {
        const bool latent = r < NL;
        const int tok = r & 4095;
#pragma unroll
        for (int g = 0; g < 5; ++g) {
            const int cbase = (g < 3 ? 256 + g * 256 : 1536 + (g - 3) * 256) + hs * 64 + e4;
            const int slot = g * 4 + hs;
            u16* pp = P + (size_t)r * PW + cbase;
            const uint2 raw = *(const uint2*)pp;
            float v0 = bflo(raw.x), v1 = bfhi(raw.x), v2 = bflo(raw.y), v3 = bfhi(raw.y);
            float ss = v0 * v0 + v1 * v1 + v2 * v2 + v3 * v3;
            ss += __shfl_xor(ss, 1); ss += __shfl_xor(ss, 2); ss += __shfl_xor(ss, 4); ss += __shfl_xor(ss, 8);
            const float* wv;
            float scl;
            bool do_rope;
            if (slot < 6) { wv = p.na_qk_w + (l * 2 + 0) * 64; scl = 0.125f; do_rope = false; }
            else if (slot < 12) { wv = p.gq_qk_w + (l * 2 + 0) * 64; scl = 0.125f; do_rope = latent; }
            else if (slot < 18) { wv = p.na_qk_w + (l * 2 + 1) * 64; scl = 1.f; do_rope = false; }
            else { wv = p.gq_qk_w + (l * 2 + 1) * 64; scl = 1.f; do_rope = latent; }
            const float rstd = rsqrtf(ss * (1.f / 64.f) + 1e-6f) * scl;
            const float4 w4 = *(const float4*)(wv + e4);
            v0 *= rstd * w4.x; v1 *= rstd * w4.y; v2 *= rstd * w4.z; v3 *= rstd * w4.w;
            const float o0 = __shfl_xor(v0, 8), o1 = __shfl_xor(v1, 8), o2 = __shfl_xor(v2, 8), o3 = __shfl_xor(v3, 8);
            if (do_rope) {
                const int fi = e4 & 31;
                const float4 cs01 = *(const float4*)(rope + ((size_t)tok * 32 + fi) * 2);
                const float4 cs23 = *(const float4*)(rope + ((size_t)tok * 32 + fi + 2) * 2);
                if (e4 < 32) {
                    v0 = v0 * cs01.x - o0 * cs01.y; v1 = v1 * cs01.z - o1 * cs01.w;
                    v2 = v2 * cs23.x - o2 * cs23.y; v3 = v3 * cs23.z - o3 * cs23.w;
                } else {
                    v0 = o0 * cs01.y + v0 * cs01.x; v1 = o1 * cs01.w + v1 * cs01.z;
                    v2 = o2 * cs23.y + v2 * cs23.x; v3 = o3 * cs23.w + v3 * cs23.z;
                }
            }
            *(uint2*)pp = uint2{pk2(v0, v1), pk2(v2, v3)};
        }
    }
}

template <int MT, bool NAMASK, int NWV>
DEV void flash_item(const Params& p, int b, int qrow0, int qcol, int kcol, int tcol, int ua, int n1, int ub, int ntiles,
                    int r_q, int rs, const float* __restrict__ rpb_h, char* smem, int ocol, float mfix = 0.f) {
    u16* P = WSP(u16, OFF_P);
    const u16* T = WSP(u16, OFF_T);
    const int tid = (NWV == 8) ? (int)(threadIdx.x + p.z) : VTID, lane = tid & 63, wave = tid >> 6, fr = lane & 15, fq = lane >> 4;
    constexpr int KVS = 64 * 144;
    char* Ks = smem;
    char* Vs = smem + 2 * KVS;
    float* rpb_s = (float*)(smem + 4 * KVS);
    __syncthreads();
    if (NAMASK) {
        for (int i = tid; i < 465; i += 256) rpb_s[i] = rpb_h[i] * 1.4426950408889634f;
    }
    Frag qf[MT][2];
#pragma unroll
    for (int mt = 0; mt < MT; ++mt)
#pragma unroll
        for (int ks = 0; ks < 2; ++ks)
            qf[mt][ks].q = *(const uint4*)(P + (size_t)(qrow0 + (wave * MT + mt) * 16 + fr) * PW + qcol + ks * 32 + fq * 8);
    const int lr = tid >> 3, lc8 = tid & 7;
    u32x4 rk0, rk1 = {0, 0, 0, 0}, rv0, rv1 = {0, 0, 0, 0};
#define FL_GLOAD(KT) do { const int kt_ = (KT); const int u0_ = kt_ < n1 ? ua + 64 * kt_ : ub + 64 * (kt_ - n1); const int row0_ = rowof(b, u0_); \
        rk0 = gld16(P + (size_t)(row0_ + lr) * PW + kcol + lc8 * 8); rv0 = gld16(T + ((size_t)(b * TW + tcol + lr)) * UT + u0_ + lc8 * 8); \
        if (NWV == 4) { rk1 = gld16(P + (size_t)(row0_ + lr + 32) * PW + kcol + lc8 * 8); rv1 = gld16(T + ((size_t)(b * TW + tcol + lr + 32)) * UT + u0_ + lc8 * 8); } } while (0)
#define FL_SSTORE(S) do { const int s_ = (S); \
        *(u32x4*)(Ks + s_ * KVS + lr * 144 + lc8 * 16) = rk0; *(u32x4*)(Vs + s_ * KVS + lr * 144 + lc8 * 16) = rv0; \
        if (NWV == 4) { *(u32x4*)(Ks + s_ * KVS + (lr + 32) * 144 + lc8 * 16) = rk1; *(u32x4*)(Vs + s_ * KVS + (lr + 32) * 144 + lc8 * 16) = rv1; } } while (0)
    FL_GLOAD(0);
    VM_WAIT0();
    FL_SSTORE(0);
    __syncthreads();
    f32x4 o[MT][4];
    float mrow[MT], lrow[MT];
#pragma unroll
    for (int mt = 0; mt < MT; ++mt) {
        mrow[mt] = -1e30f; lrow[mt] = 0.f;
#pragma unroll
        for (int dt = 0; dt < 4; ++dt) o[mt][dt] = f32x4{0.f, 0.f, 0.f, 0.f};
    }
    const float L2E = 1.4426950408889634f;
    for (int kt = 0; kt < ntiles; ++kt) {
        const int cur = kt & 1;
        const bool more = kt + 1 < ntiles;
        FL_GLOAD(more ? kt + 1 : kt);
        __builtin_amdgcn_sched_barrier(0);
        f32x4 s[MT][4];
#pragma unroll
        for (int mt = 0; mt < MT; ++mt)
#pragma unroll
            for (int nt = 0; nt < 4; ++nt) s[mt][nt] = f32x4{0.f, 0.f, 0.f, 0.f};
#pragma unroll
        for (int ks = 0; ks < 2; ++ks)
#pragma unroll
            for (int nt = 0; nt < 4; ++nt) {
                const bf16x8 kf = *(const bf16x8*)(Ks + cur * KVS + (nt * 16 + fr) * 144 + (ks * 32 + fq * 8) * 2);
#pragma unroll
                for (int mt = 0; mt < MT; ++mt) s[mt][nt] = mfma16(kf, qf[mt][ks].v, s[mt][nt]);
            }
        Frag pf[MT][2];
#pragma unroll
        for (int mt = 0; mt < MT; ++mt) {
            float rsum = 0.f;
            if (NAMASK && kt < 8) {
                const int qc = (wave * MT + mt) * 16 + fr;
                int cs = qc - 8; cs = cs < 0 ? 0 : (cs > 48 ? 48 : cs);
                const int brow = rs + kt - r_q + 7;
#pragma unroll
                for (int nt = 0; nt < 4; ++nt)
#pragma unroll
                    for (int r = 0; r < 4; ++r) {
                        const int kc = nt * 16 + fq * 4 + r;
                        const bool valid = (kc >= cs) && (kc < cs + 16);
                        const int bi = valid ? brow * 31 + (kc - qc + 15) : 0;
                        const float e = valid ? fexp2(fmaf(s[mt][nt][r], L2E, rpb_s[bi] - mfix)) : 0.f;
                        s[mt][nt][r] = e; rsum += e;
                    }
            } else {
#pragma unroll
                for (int nt = 0; nt < 4; ++nt)
#pragma unroll
                    for (int r = 0; r < 4; ++r) { const float e = fexp2(fmaf(s[mt][nt][r], L2E, -mfix)); s[mt][nt][r] = e; rsum += e; }
            }
            lrow[mt] += rsum;
#pragma unroll
            for (int ks = 0; ks < 2; ++ks) {
                pf[mt][ks].u[0] = pk2(s[mt][2 * ks][0], s[mt][2 * ks][1]);
                pf[mt][ks].u[1] = pk2(s[mt][2 * ks][2], s[mt][2 * ks][3]);
                pf[mt][ks].u[2] = pk2(s[mt][2 * ks + 1][0], s[mt][2 * ks + 1][1]);
                pf[mt][ks].u[3] = pk2(s[mt][2 * ks + 1][2], s[mt][2 * ks + 1][3]);
            }
        }
#pragma unroll
        for (int ks = 0; ks < 2; ++ks)
#pragma unroll
            for (int dt = 0; dt < 4; ++dt) {
                Frag vf;
                vf.d[0] = *(const uint2*)(Vs + cur * KVS + (dt * 16 + fr) * 144 + (ks * 32 + fq * 4) * 2);
                vf.d[1] = *(const uint2*)(Vs + cur * KVS + (dt * 16 + fr) * 144 + (ks * 32 + 16 + fq * 4) * 2);
#pragma unroll
                for (int mt = 0; mt < MT; ++mt) o[mt][dt] = mfma16(vf.v, pf[mt][ks].v, o[mt][dt]);
            }
        __builtin_amdgcn_sched_barrier(0);
        VM_WAIT0();
        FL_SSTORE(cur ^ 1);
        __syncthreads();
    }
#pragma unroll
    for (int mt = 0; mt < MT; ++mt) {
        const float inv = 1.f / xq_sum(lrow[mt]);
        u16* op = P + (size_t)(qrow0 + (wave * MT + mt) * 16 + fr) * PW + ocol;
#pragma unroll
        for (int dt = 0; dt < 4; ++dt)
            *(uint2*)(op + dt * 16 + fq * 4) = uint2{pk2(o[mt][dt][0] * inv, o[mt][dt][1] * inv), pk2(o[mt][dt][2] * inv, o[mt][dt][3] * inv)};
    }
}


DEV void m2_item(const Params& p, int sc, int c) {
    const u16* T = WSP(u16, OFF_T);
    const int lane = VTID & 63, wave = VTID >> 6, fr = lane & 15, fq = lane >> 4;
    const int dir = sc & 1, h = (sc >> 1) & 3, b = sc >> 3;
    const int u0 = cu_of(c, dir) * 64;
    const float* AE = WSP(float, OFF_AE) + (size_t)sc * UT + u0;
    float* S = WSP(float, OFF_S) + ((size_t)sc * NCH + c) * SCH;
    const float mnew = fmaxf(WSP(float, OFF_MS)[sc * NCH + c] + m_scan(p, sc, c), WSP(float, OFF_DEC)[sc * NCH + c]);
    f32x4 acc[4], accn[4];
#pragma unroll
    for (int nt = 0; nt < 4; ++nt) { acc[nt] = f32x4{0.f, 0.f, 0.f, 0.f}; accn[nt] = f32x4{0.f, 0.f, 0.f, 0.f}; }
    Frag ones;
    ones.u[0] = ones.u[1] = ones.u[2] = ones.u[3] = 0x3F803F80u;
#pragma unroll
    for (int ks = 0; ks < 2; ++ks) {
        Frag vf;
        vf.q = *(const uint4*)(T + ((size_t)(b * TW + TC_MLV + h * 64 + wave * 16 + fr)) * UT + u0 + ks * 32 + fq * 8);
        float4 a0 = *(const float4*)(AE + ks * 32 + fq * 8), a1 = *(const float4*)(AE + ks * 32 + fq * 8 + 4);
        a0.x = expf(a0.x - mnew); a0.y = expf(a0.y - mnew); a0.z = expf(a0.z - mnew); a0.w = expf(a0.w - mnew);
        a1.x = expf(a1.x - mnew); a1.y = expf(a1.y - mnew); a1.z = expf(a1.z - mnew); a1.w = expf(a1.w - mnew);
#pragma unroll
        for (int nt = 0; nt < 4; ++nt) {
            Frag kf, kb;
            kf.q = *(const uint4*)(T + ((size_t)(b * TW + TC_MLK + h * 64 + nt * 16 + fr)) * UT + u0 + ks * 32 + fq * 8);
            kb.u[0] = pk2(bflo(kf.u[0]) * a0.x * 0.125f, bfhi(kf.u[0]) * a0.y * 0.125f);
            kb.u[1] = pk2(bflo(kf.u[1]) * a0.z * 0.125f, bfhi(kf.u[1]) * a0.w * 0.125f);
            kb.u[2] = pk2(bflo(kf.u[2]) * a1.x * 0.125f, bfhi(kf.u[2]) * a1.y * 0.125f);
            kb.u[3] = pk2(bflo(kf.u[3]) * a1.z * 0.125f, bfhi(kf.u[3]) * a1.w * 0.125f);
            acc[nt] = mfma16(vf.v, kb.v, acc[nt]);
            if (wave == 0) accn[nt] = mfma16(ones.v, kb.v, accn[nt]);
        }
    }
#pragma unroll
    for (int nt = 0; nt < 4; ++nt) {
#pragma unroll
        for (int r = 0; r < 4; ++r) S[(wave * 16 + fq * 4 + r) * 64 + nt * 16 + fr] = acc[nt][r];
        if (wave == 0 && fq == 0) S[4096 + nt * 16 + fr] = accn[nt][0];
    }
}

DEV void ph_m3(const Params& p, int bid, int G) {
    const float* DEC = WSP(float, OFF_DEC);
    float* S = WSP(float, OFF_S);
    const int total = NSCAN * SCH;
    for (int i = bid * 256 + VTID; i < total; i += G * 256) {
        const int sc = i / SCH, e = i - sc * SCH;
        float* base = S + (size_t)sc * NCH * SCH + e;
        const float* mxp = DEC + sc * NCH;
        const float* btp = WSP(float, OFF_MS) + sc * NCH;
        float st = 0.f, m = 0.f;
#pragma unroll 17
        for (int c = 0; c < NCH; ++c) {
            const float tmp = base[(size_t)c * SCH];
            base[(size_t)c * SCH] = st;
            const float bm = btp[c] + m;
            const float mnew = fmaxf(bm, mxp[c]);
            st = expf(bm - mnew) * st + tmp;
            m = mnew;
        }
    }
}

DEV void m4_item(const Params& p, int l, int b, int h, int cu, int ocolbase) {
    u16* P = WSP(u16, OFF_P);
    const u16* T = WSP(u16, OFF_T);
    const int lane = VTID & 63, wave = VTID >> 6, fr = lane & 15, fq = lane >> 4;
    const int u0 = cu * 64;
    const int row0 = rowof(b, u0);
    const int j = wave * 16 + fr;
    Frag qf[2];
#pragma unroll
    for (int ks = 0; ks < 2; ++ks) qf[ks].q = *(const uint4*)(P + (size_t)(row0 + j) * PW + PC_MLQ + h * 64 + ks * 32 + fq * 8);
    f32x4 hsum[4];
#pragma unroll
    for (int dt = 0; dt < 4; ++dt) hsum[dt] = f32x4{0.f, 0.f, 0.f, 0.f};
#pragma unroll 1
    for (int dir = 0; dir < 2; ++dir) {
        const int sc = (b * 4 + h) * 2 + dir;
        int c;
        if (cu >= 64) c = dir ? 3 - (cu - 64) : (cu - 64); else c = 4 + (dir ? 63 - cu : cu);
        const float m0 = m_scan(p, sc, c);
        const float* BC = WSP(float, OFF_BC) + (size_t)sc * UT + u0;
        const float* IG = WSP(float, OFF_IG) + (size_t)sc * UT + u0;
        const float* S = WSP(float, OFF_S) + ((size_t)sc * NCH + c) * SCH;
        const float bj = BC[j];
        f32x4 s[4];
#pragma unroll
        for (int nt = 0; nt < 4; ++nt) s[nt] = f32x4{0.f, 0.f, 0.f, 0.f};
#pragma unroll
        for (int ks = 0; ks < 2; ++ks)
#pragma unroll
            for (int nt = 0; nt < 4; ++nt) {
                Frag kf;
                kf.q = *(const uint4*)(P + (size_t)(row0 + nt * 16 + fr) * PW + PC_MLK + h * 64 + ks * 32 + fq * 8);
                s[nt] = mfma16(kf.v, qf[ks].v, s[nt]);
            }
        float lw[4][4];
        float mx = -1e30f;
#pragma unroll
        for (int nt = 0; nt < 4; ++nt) {
            const float4 bs = *(const float4*)(BC + nt * 16 + fq * 4);
            const float4 is = *(const float4*)(IG + nt * 16 + fq * 4);
            const float bsv[4] = {bs.x, bs.y, bs.z, bs.w}, isv[4] = {is.x, is.y, is.z, is.w};
#pragma unroll
            for (int r = 0; r < 4; ++r) {
                const int sidx = nt * 16 + fq * 4 + r;
                const bool valid = dir ? (sidx >= j) : (sidx <= j);
                lw[nt][r] = valid ? (bj - bsv[r] + isv[r]) : -1e30f;
                mx = fmaxf(mx, lw[nt][r]);
            }
        }
        mx = xq_max(mx);
        const float minter = bj + m0;
        const float mj = fmaxf(minter, mx);
        const float g = fexp(minter - mj);
        float den = 0.f;
#pragma unroll
        for (int nt = 0; nt < 4; ++nt)
#pragma unroll
            for (int r = 0; r < 4; ++r) {
                const float w = fexp(lw[nt][r] - mj);
                const float qk = s[nt][r] * 0.125f * w;
                s[nt][r] = qk;
                den += qk;
            }
        den = xq_sum(den);
        Frag pf[2];
#pragma unroll
        for (int ks = 0; ks < 2; ++ks) {
            pf[ks].u[0] = pk2(s[2 * ks][0], s[2 * ks][1]);
            pf[ks].u[1] = pk2(s[2 * ks][2], s[2 * ks][3]);
            pf[ks].u[2] = pk2(s[2 * ks + 1][0], s[2 * ks + 1][1]);
            pf[ks].u[3] = pk2(s[2 * ks + 1][2], s[2 * ks + 1][3]);
        }
        f32x4 acc[4], accn = f32x4{0.f, 0.f, 0.f, 0.f};
#pragma unroll
        for (int dt = 0; dt < 4; ++dt) acc[dt] = f32x4{0.f, 0.f, 0.f, 0.f};
#pragma unroll
        for (int ks = 0; ks < 2; ++ks) {
            {
                const float4 n0 = *(const float4*)(S + 4096 + ks * 32 + fq * 8), n1 = *(const float4*)(S + 4096 + ks * 32 + fq * 8 + 4);
                Frag nf;
                nf.u[0] = pk2(n0.x, n0.y); nf.u[1] = pk2(n0.z, n0.w); nf.u[2] = pk2(n1.x, n1.y); nf.u[3] = pk2(n1.z, n1.w);
                accn = mfma16(nf.v, qf[ks].v, accn);
            }
#pragma unroll
            for (int dt = 0; dt < 4; ++dt) {
                const float* cp = S + (dt * 16 + fr) * 64 + ks * 32 + fq * 8;
                const float4 c0 = *(const float4*)cp, c1 = *(const float4*)(cp + 4);
                Frag cf;
                cf.u[0] = pk2(c0.x, c0.y); cf.u[1] = pk2(c0.z, c0.w); cf.u[2] = pk2(c1.x, c1.y); cf.u[3] = pk2(c1.z, c1.w);
                acc[dt] = mfma16(cf.v, qf[ks].v, acc[dt]);
            }
        }
#pragma unroll
        for (int dt = 0; dt < 4; ++dt) acc[dt] *= g;
        den += g * accn[0];
#pragma unroll
        for (int ks = 0; ks < 2; ++ks)
#pragma unroll
            for (int dt = 0; dt < 4; ++dt) {
                const u16* vp = T + ((size_t)(b * TW + TC_MLV + h * 64 + dt * 16 + fr)) * UT + u0 + ks * 32 + fq * 4;
                Frag vf;
                vf.d[0] = *(const uint2*)vp;
                vf.d[1] = *(const uint2*)(vp + 16);
                acc[dt] = mfma16(vf.v, pf[ks].v, acc[dt]);
            }
        const float dd = 1.f / fmaxf(fabsf(den), fexp(-mj));
#pragma unroll
        for (int dt = 0; dt < 4; ++dt) hsum[dt] += acc[dt] * dd;
    }
    float ss = 0.f;
#pragma unroll
    for (int dt = 0; dt < 4; ++dt)
#pragma unroll
        for (int r = 0; r < 4; ++r) ss += hsum[dt][r] * hsum[dt][r];
    ss = xq_sum(ss);
    const float rstd = rsqrtf(ss * (1.f / 64.f) + 1e-6f);
    const float* nw = p.ml_norm_w + l * 256 + h * 64;
    u16* orow = P + (size_t)(row0 + j) * PW;
#pragma unroll
    for (int dt = 0; dt < 4; ++dt) {
        const int v0 = dt * 16 + fq * 4;
        const float4 w4 = *(const float4*)(nw + v0);
        const uint2 og = *(const uint2*)(orow + PC_MLO + h * 64 + v0);
        const float y0 = hsum[dt][0] * rstd * w4.x * sigmoidf_(bflo(og.x));
        const float y1 = hsum[dt][1] * rstd * w4.y * sigmoidf_(bfhi(og.x));
        const float y2 = hsum[dt][2] * rstd * w4.z * sigmoidf_(bflo(og.y));
        const float y3 = hsum[dt][3] * rstd * w4.w * sigmoidf_(bfhi(og.y));
        *(uint2*)(orow + ocolbase + h * 64 + v0) = uint2{pk2(y0, y1), pk2(y2, y3)};
    }
}

DEV void ph_attn8(const Params& p, int l, char* smem0, int rbid, int RG) {
    const int n_gq = 768, n_c = (l == 0) ? 96 : 0;
    const int ln_ = (int)((threadIdx.x + p.z) & 63);
    const float bgq = 8.f * wave_max(fabsf(p.gq_qk_w[(l * 2 + 0) * 64 + ln_])) * wave_max(fabsf(p.gq_qk_w[(l * 2 + 1) * 64 + ln_])) * 1.4426950408889634f * 1.03f + 0.5f;
    const float bna = 8.f * wave_max(fabsf(p.na_qk_w[(l * 2 + 0) * 64 + ln_])) * wave_max(fabsf(p.na_qk_w[(l * 2 + 1) * 64 + ln_])) * 1.4426950408889634f * 1.03f + 0.5f;
    for (int it = rbid; it < n_gq + n_c; it += RG) {
        float mfix = bgq;
        int b, qrow0, qcol, kcol, tcol, ua, nt;
        if (it < n_gq) {
            const int qt = it & 15, hq = (it >> 4) % 6;
            b = it / 96; qrow0 = b * SEQ + qt * 256; qcol = PC_GQQ + hq * 64; kcol = PC_GQK + (hq / 3) * 64; tcol = TC_GQV + (hq / 3) * 64; ua = 0; nt = 68;
        } else {
            const int r = it - n_gq;
            const int kind = r / 48, rr = r % 48, hh = rr % 6;
            b = rr / 6; qrow0 = NL + b * CTXL; ua = SEQ; nt = 4;
            if (kind == 0) { qcol = PC_GQQ + hh * 64; kcol = PC_GQK + (hh / 3) * 64; tcol = TC_GQV + (hh / 3) * 64; }
            else { qcol = PC_NAQ + hh * 64; kcol = PC_NAK + hh * 64; tcol = TC_NAV + hh * 64; mfix = bna; }
        }
        flash_item<2, false, 8>(p, b, qrow0, qcol, kcol, tcol, ua, nt, 0, nt, 0, 0, nullptr, smem0, qcol, mfix);
    }
}
DEV void ph_attn(const Params& p, int l, char* smem, int bid, int G, int rep) {
    const int n_na = 3072, n_m2 = NSCAN * NCH;
    const int total = n_na + n_m2;
    const int ln_ = VTID & 63;
    float rmax = 0.f;
    for (int i = ln_; i < 6 * 465; i += 64) rmax = fmaxf(rmax, fabsf(p.na_rpb[(size_t)l * 6 * 465 + i]));
    const float mfix_na = (8.f * wave_max(fabsf(p.na_qk_w[(l * 2 + 0) * 64 + ln_])) * wave_max(fabsf(p.na_qk_w[(l * 2 + 1) * 64 + ln_])) * 1.03f + wave_max(rmax)) * 1.4426950408889634f + 0.5f;
    for (int it = bid; it < total; it += G) {
        int r = it;
        if (r < n_na) {
            const int gr = r & 63, hn = (r >> 6) % 6, b = r / 384;
            int rs = gr - 4; rs = rs < 0 ? 0 : (rs > 56 ? 56 : rs);
            flash_item<1, true, 4>(p, b, b * SEQ + gr * 64, PC_NAQ + hn * 64, PC_NAK + hn * 64, TC_NAV + hn * 64, rs * 64, 8, SEQ, 12, gr, rs,
                                p.na_rpb + (size_t)(l * 6 + hn) * 465, smem, PC_NAQ + hn * 64 + (rep ? 1792 : 0), mfix_na);
            continue;
        }
        r -= n_na;
        m2_item(p, r / NCH, r % NCH);
    }
}

DEV void ph_m4(const Params& p, int l, int bid, int G, int rep) {
    const int nch = (l == 0) ? NCH : 64;
    const int total = NB * 4 * nch;
    for (int it = bid; it < total; it += G) {
        const int cu = it % nch, h = (it / nch) & 3, b = it / (nch * 4);
        m4_item(p, l, b, h, cu, rep ? 2048 : PC_MLQ);
    }
}

DEV void ph_merge(const Params& p, int mt0, int mtiles, char* smem, int vid, int G) {
    const u16* H = WSP(u16, OFF_H);
    u16* P = WSP(u16, OFF_P);
    const u16* Wg = WSP(u16, OFF_W) + WE_MIX + (size_t)2944 * 1024;
    const u16* Wbr = WSP(u16, OFF_W) + WE_BR;
    const int lane = VTID & 63, wave = VTID >> 6, wm = wave >> 1, wn = wave & 1, fr = lane & 15, fq = lane >> 4;
    const int total = mtiles * 16;
    for (int t = vid; t < total; t += G) {
        int mt_, nt_;
        tile_decode(t, 16, mt_, nt_);
        mt_ += mt0;
        const int m0 = mt_ * 128, n0 = nt_ * 64;
        f32x4 y[4][2];
        zero_acc<2>(y);
#pragma unroll 1
        for (int br = 0; br < 3; ++br) {
            const int ko = br == 0 ? 0 : (br == 1 ? 256 : 640);
            const int kk = br == 0 ? 256 : 384;
            f32x4 g[4][2];
            zero_acc<2>(g);
            gemm_accum<2>(g, H + (size_t)m0 * D, D, Wg + (size_t)(br * 1024 + n0) * D, D, D, smem, VTID);
#pragma unroll
            for (int i = 0; i < 4; ++i)
#pragma unroll
                for (int jn = 0; jn < 2; ++jn)
#pragma unroll
                    for (int r = 0; r < 4; ++r) g[i][jn][r] = sigmoidf_(g[i][jn][r]);
            f32x4 a[4][2];
            zero_acc<2>(a);
            gemm_accum<2>(a, P + (size_t)m0 * PW + ko, PW, Wbr + (size_t)n0 * D + ko, D, kk, smem, VTID);
#pragma unroll
            for (int i = 0; i < 4; ++i)
#pragma unroll
                for (int jn = 0; jn < 2; ++jn) y[i][jn] += g[i][jn] * a[i][jn];
        }
#pragma unroll
        for (int mt = 0; mt < 4; ++mt)
#pragma unroll
            for (int nt = 0; nt < 2; ++nt)
#pragma unroll
                for (int r = 0; r < 4; ++r) {
                    const int row = m0 + wm * 64 + mt * 16 + fq * 4 + r;
                    const int col = n0 + wn * 32 + nt * 16 + fr;
                    P[(size_t)row * PW + PC_Y + col] = (u16)(pk2(y[mt][nt][r], 0.f) & 0xffff);
                }
    }
}


#ifdef DBG
constexpr size_t OFF_DBG = al256(WS_END);
__global__ void __launch_bounds__(64) dbg_mlstm(Params p, int l) {
    const int sc = blockIdx.x, dir = sc & 1, h = (sc >> 1) & 3, b = sc >> 3, lane = VTID;
    const u16* P = WSP(u16, OFF_P); const u16* T = WSP(u16, OFF_T); const float* Gt = WSP(float, OFF_G);
    float* HN = WSP(float, OFF_S) + (size_t)sc * UT * 64;
    const float bi = p.ml_gate_b[l * 16 + dir * 8 + h], bf = p.ml_gate_b[l * 16 + dir * 8 + 4 + h];
    float C[64], n[64];
    for (int k = 0; k < 64; ++k) { C[k] = 0.f; n[k] = 0.f; }
    float m = 0.f;
    for (int pos = 0; pos < UT; ++pos) {
        int u;
        if (pos < 256) u = SEQ + (dir ? 255 - pos : pos); else u = dir ? 4095 - (pos - 256) : (pos - 256);
        const int row = rowof(b, u);
        const float ig = Gt[(size_t)row * 16 + dir * 8 + h] + bi;
        const float fp = Gt[(size_t)row * 16 + dir * 8 + 4 + h] + bf;
        const float lf = fminf(fp, 0.f) - log1pf(expf(-fabsf(fp)));
        const float mn = fmaxf(lf + m, ig);
        const float fw = expf(lf + m - mn), iw = expf(ig - mn);
        m = mn;
        const float qv = __uint_as_float(((uint32_t)P[(size_t)row * PW + 2048 + h * 64 + lane]) << 16);
        const float kv = __uint_as_float(((uint32_t)P[(size_t)row * PW + PC_MLK + h * 64 + lane]) << 16) * 0.125f;
        const float vv = __uint_as_float(((uint32_t)T[((size_t)(b * TW + TC_MLV + h * 64 + lane)) * UT + u]) << 16);
        float num = 0.f, den = 0.f;
#pragma unroll
        for (int k = 0; k < 64; ++k) {
            const float kk = __shfl(kv, k), qq = __shfl(qv, k);
            C[k] = fw * C[k] + iw * kk * vv;
            n[k] = fw * n[k] + iw * kk;
            num += qq * C[k];
            den += qq * n[k];
        }
        HN[(size_t)u * 64 + lane] = num / fmaxf(fabsf(den), expf(-m));
    }
}
__global__ void dbg_cmp(Params p, int l) {
    const int gid = blockIdx.x * blockDim.x + VTID;
    const u16* P = WSP(u16, OFF_P); const u16* T = WSP(u16, OFF_T);
    unsigned* dw = (unsigned*)(p.ws + OFF_DBG);
    float* df = (float*)(p.ws + OFF_DBG);
    if (gid < NB * 4 * UT) {
        const int u = gid % UT, h = (gid / UT) & 3, b = gid / (UT * 4);
        const int row = rowof(b, u);
        const float* hf = WSP(float, OFF_S) + ((size_t)((b * 4 + h) * 2 + 0) * UT + u) * 64;
        const float* hb = WSP(float, OFF_S) + ((size_t)((b * 4 + h) * 2 + 1) * UT + u) * 64;
        float ss = 0.f;
        for (int v = 0; v < 64; ++v) { const float x = hf[v] + hb[v]; ss += x * x; }
        const float rstd = rsqrtf(ss / 64.f + 1e-6f);
        float md = 0.f;
        for (int v = 0; v < 64; ++v) {
            const float x = (hf[v] + hb[v]) * rstd * p.ml_norm_w[l * 256 + h * 64 + v];
            const float o = __uint_as_float(((uint32_t)P[(size_t)row * PW + PC_MLO + h * 64 + v]) << 16);
            const float y = x / (1.f + expf(-o));
            const float got = __uint_as_float(((uint32_t)P[(size_t)row * PW + PC_MLQ + h * 64 + v]) << 16);
            md += fabsf(y - got);
        }
        atomicAdd(df + (u < SEQ ? 0 : 1), md * (1.f / 64.f));
        return;
    }
    const int w = (gid - NB * 4 * UT) >> 6;
    const int lane = VTID & 63;
    int type, b, qrow, qc, kcol, tcol, ocol, hn = 0, gr = 0, gc = 0, nkeys;
    if (w < 6144) {
        type = 0; const int i = w & 127; hn = (w >> 7) % 6; b = w / 768;
        gr = i & 63; gc = (i < 64) ? gr : 63 - gr;
        qrow = b * SEQ + gr * 64 + gc; qc = 2048 + 256 + hn * 64; kcol = PC_NAK + hn * 64; tcol = TC_NAV + hn * 64; ocol = PC_NAQ + hn * 64; nkeys = 384;
    } else if (w < 6144 + 256) {
        type = 1; const int x = w - 6144; const int i = x & 15, hh = (x >> 4) & 1; b = x >> 5;
        qrow = b * SEQ + (i * 273) % 4096; qc = 2688 + hh * 64; kcol = PC_GQK + hh * 64; tcol = TC_GQV + hh * 64; ocol = PC_GQQ + hh * 3 * 64; nkeys = 4352;
    } else if (w < 6144 + 256 + 768) {
        type = 2; const int x = w - 6400; const int i = x & 15; hn = (x >> 4) % 6; b = x / 96;
        qrow = NL + b * CTXL + (i * 17) % 256; qc = 2048 + 256 + hn * 64; kcol = PC_NAK + hn * 64; tcol = TC_NAV + hn * 64; ocol = PC_NAQ + hn * 64; nkeys = 256;
    } else if (w < 6144 + 256 + 768 + 256) {
        type = 3; const int x = w - 7168; const int i = x & 15, hh = (x >> 4) & 1; b = x >> 5;
        qrow = NL + b * CTXL + (i * 17) % 256; qc = 2688 + hh * 64; kcol = PC_GQK + hh * 64; tcol = TC_GQV + hh * 64; ocol = PC_GQQ + hh * 3 * 64; nkeys = 256;
    } else return;
    const float q = __uint_as_float(((uint32_t)P[(size_t)qrow * PW + qc + lane]) << 16);
    float o = 0.f;
    int rs = gr - 4; rs = rs < 0 ? 0 : (rs > 56 ? 56 : rs);
    int cs = gc - 8; cs = cs < 0 ? 0 : (cs > 48 ? 48 : cs);
    float mx = -1e30f, lsum = 0.f;
    for (int kidx = 0; kidx < nkeys; ++kidx) {
        int u; float bias = 0.f;
        if (type == 0) {
            if (kidx < 128) {
                const int ri = kidx >> 4, ci = kidx & 15;
                u = (rs + ri) * 64 + cs + ci;
                bias = p.na_rpb[(size_t)(l * 6 + hn) * 465 + (rs + ri - gr + 7) * 31 + (cs + ci - gc + 15)];
            } else u = SEQ + (kidx - 128);
        } else if (type == 1) u = kidx;
        else u = SEQ + kidx;
        const int krow = rowof(b, u);
        float sdot = wave_sum(q * __uint_as_float(((uint32_t)P[(size_t)krow * PW + kcol + lane]) << 16));
        sdot += bias;
        const float mn = fmaxf(mx, sdot);
        const float al = expf(mx - mn), e = expf(sdot - mn);
        lsum = lsum * al + e; mx = mn;
        o = o * al + e * __uint_as_float(((uint32_t)T[((size_t)(b * TW + tcol + lane)) * UT + u]) << 16);
    }
    const float got = __uint_as_float(((uint32_t)P[(size_t)qrow * PW + ocol + lane]) << 16);
    float md = wave_max(fabsf(o / lsum - got));
    if (lane == 0) atomicMax(dw + 2 + type, __float_as_uint(md));
}
__global__ void dbg_copy(Params p) {
    u16* P = WSP(u16, OFF_P);
    for (size_t i = (size_t)blockIdx.x * 256 + VTID; i < (size_t)MTOT * 768; i += (size_t)gridDim.x * 256) {
        const size_t row = i / 768, c = i % 768;
        const size_t src = c < 640 ? c : (c < 704 ? PC_GQQ + (c - 640) : PC_GQQ + 192 + (c - 704));
        P[row * PW + 2048 + c] = P[row * PW + src];
    }
}
DEV int dbg_row(int sr) { return sr < 8 ? sr * 4096 + (sr * 577 + 13) % 4096 : NL + (sr - 8) * 256 + ((sr - 8) * 37 + 5) % 256; }
DEV float* dbg_xrow(const Params& p, int row) { return row < NL ? p.out + (size_t)row * D : WSP(float, OFF_XC) + (size_t)(row - NL) * D; }
DEV float dbg_mod(const Params& p, int l, int b9, int idx, int n) {
    float a = p.ada_b[l * 9216 + idx * 1024 + n];
    for (int k = 0; k < 1024; ++k) {
        const float c = b9 < 8 ? p.c[b9 * 1024 + k] : p.c_ctx[k];
        a += c / (1.f + expf(-c)) * p.ada_w[((size_t)l * 1024 + k) * 9216 + idx * 1024 + n];
    }
    return a;
}
DEV float blk_sum(float v, float* red) {
    v = wave_sum(v);
    __syncthreads();
    if ((VTID & 63) == 0) red[VTID >> 6] = v;
    __syncthreads();
    return red[0] + red[1] + red[2] + red[3];
}
DEV float blk_max(float v, float* red) {
    v = wave_max(v);
    __syncthreads();
    if ((VTID & 63) == 0) red[VTID >> 6] = v;
    __syncthreads();
    return fmaxf(fmaxf(red[0], red[1]), fmaxf(red[2], red[3]));
}
__global__ void dbg_save(Params p, int slot) {
    const int sr = blockIdx.x, row = dbg_row(sr);
    float* dst = (float*)(p.ws + OFF_DBG + 256) + ((size_t)slot * 16 + sr) * 1024;
    const float* src = dbg_xrow(p, row);
    for (int n = VTID; n < 1024; n += 256) dst[n] = src[n];
}
DEV float dbg_modulate(const Params& p, int l, int sub, int b9, const float* xs, float* hs, float* red) {
    float ss = 0.f;
    for (int n = VTID; n < 1024; n += 256) ss += xs[n] * xs[n];
    ss = blk_sum(ss, red);
    const float rstd = rsqrtf(ss / 1024.f + 1e-6f);
    float md = 0.f;
    for (int n = VTID; n < 1024; n += 256) {
        const float sh = dbg_mod(p, l, b9, 3 * sub, n), sc = dbg_mod(p, l, b9, 3 * sub + 1, n);
        md = fmaxf(md, fabsf(sh - WSP(float, OFF_MODS)[b9 * 9216 + (3 * sub) * 1024 + n]));
        md = fmaxf(md, fabsf(sc - WSP(float, OFF_MODS)[b9 * 9216 + (3 * sub + 1) * 1024 + n]));
        hs[n] = xs[n] * rstd * p.norm_w[(l * 3 + sub) * 1024 + n] * (1.f + sc) + sh;
    }
    __syncthreads();
    return md;
}
__global__ void __launch_bounds__(256) dbg_ffn(Params p, int l, int which, int slot, int bit) {
    __shared__ float xs[1024], hs[1024], gs[1024], as[2816], red[4];
    const int sr = blockIdx.x, row = dbg_row(sr), b9 = row < NL ? row >> 12 : 8, sub = which ? 2 : 0;
    const float* xin = (const float*)(p.ws + OFF_DBG + 256) + ((size_t)slot * 16 + sr) * 1024;
    for (int n = VTID; n < 1024; n += 256) xs[n] = xin[n];
    __syncthreads();
    float mdm = dbg_modulate(p, l, sub, b9, xs, hs, red);
    for (int n = VTID; n < 1024; n += 256) gs[n] = dbg_mod(p, l, b9, 3 * sub + 2, n);
    const float* win = p.ffn_w_in + (size_t)(l * 2 + which) * 1024 * 5632;
    const float* wout = p.ffn_w_out + (size_t)(l * 2 + which) * 2816 * 1024;
    for (int j = VTID; j < 2816; j += 256) {
        float g = 0.f, u = 0.f;
        for (int k = 0; k < 1024; ++k) { g += hs[k] * win[(size_t)k * 5632 + j]; u += hs[k] * win[(size_t)k * 5632 + 2816 + j]; }
        as[j] = g / (1.f + expf(-g)) * u;
    }
    __syncthreads();
    float md = 0.f;
    const float* xc = dbg_xrow(p, row);
    for (int n = VTID; n < 1024; n += 256) {
        float o = 0.f;
        for (int j = 0; j < 2816; ++j) o += as[j] * wout[(size_t)j * 1024 + n];
        md = fmaxf(md, fabsf(xs[n] + 0.5f * gs[n] * o - xc[n]));
    }
    md = blk_max(md, red);
    mdm = blk_max(mdm, red);
    unsigned* dw = (unsigned*)(p.ws + OFF_DBG);
    if (VTID == 0) { atomicMax(dw + bit, __float_as_uint(md)); atomicMax(dw + 15, __float_as_uint(mdm)); }
}
__global__ void __launch_bounds__(256) dbg_pchk(Params p, int l) {
    __shared__ float xs[1024], hs[1024], red[4];
    const int sr = blockIdx.x, row = dbg_row(sr), b9 = row < NL ? row >> 12 : 8;
    const float* xin = dbg_xrow(p, row);
    for (int n = VTID; n < 1024; n += 256) xs[n] = xin[n];
    __syncthreads();
    float mdm = dbg_modulate(p, l, 1, b9, xs, hs, red);
    const float* w = p.mix_w_in + (size_t)l * 1024 * NIN;
    const u16* P = WSP(u16, OFF_P); const u16* T = WSP(u16, OFF_T);
    int b, u;
    if (row < NL) { b = row >> 12; u = row & 4095; } else { b = (row - NL) >> 8; u = SEQ + ((row - NL) & 255); }
    float md = 0.f;
    for (int n = VTID; n < 2832; n += 256) {
        const int sc = map_col(2, n);
        float v = 0.f;
        for (int k = 0; k < 1024; ++k) v += hs[k] * w[(size_t)k * NIN + sc];
        if (n < 2048) md = fmaxf(md, fabsf(v - __uint_as_float(((uint32_t)P[(size_t)row * PW + n]) << 16)));
        if (n >= 1280 && n < 1536) md = fmaxf(md, fabsf(v - __uint_as_float(((uint32_t)T[((size_t)(b * TW + n - 1280)) * UT + u]) << 16)));
        if (n >= 2048 && n < 2816) md = fmaxf(md, fabsf(v - __uint_as_float(((uint32_t)T[((size_t)(b * TW + n - 1792)) * UT + u]) << 16)));
        if (n >= 2816) md = fmaxf(md, fabsf(v - WSP(float, OFF_G)[(size_t)row * 16 + n - 2816]));
    }
    md = blk_max(md, red);
    mdm = blk_max(mdm, red);
    unsigned* dw = (unsigned*)(p.ws + OFF_DBG);
    if (VTID == 0) { atomicMax(dw + 9, __float_as_uint(md)); atomicMax(dw + 15, __float_as_uint(mdm)); }
}
__global__ void __launch_bounds__(256) dbg_mix(Params p, int l, int slot) {
    __shared__ float xs[1024], hs[1024], os[1024], ys[1024], red[4];
    const int sr = blockIdx.x, row = dbg_row(sr), b9 = row < NL ? row >> 12 : 8;
    const float* xin = (const float*)(p.ws + OFF_DBG + 256) + ((size_t)slot * 16 + sr) * 1024;
    const u16* P = WSP(u16, OFF_P);
    for (int n = VTID; n < 1024; n += 256) { xs[n] = xin[n]; os[n] = __uint_as_float(((uint32_t)P[(size_t)row * PW + n]) << 16); }
    __syncthreads();
    float mdm = dbg_modulate(p, l, 1, b9, xs, hs, red);
    const float* w = p.mix_w_in + (size_t)l * 1024 * NIN;
    for (int n = VTID; n < 1024; n += 256) {
        float y = 0.f;
        for (int i = 0; i < 3; ++i) {
            float g = 0.f;
            for (int k = 0; k < 1024; ++k) g += hs[k] * w[(size_t)k * NIN + 2832 + i * 1024 + n];
            g = 1.f / (1.f + expf(-g));
            const float* wb = i == 0 ? p.w_br_ml + (size_t)l * 256 * 1024 : (i == 1 ? p.w_br_na + (size_t)l * 384 * 1024 : p.w_br_gq + (size_t)l * 384 * 1024);
            const int ko = i == 0 ? 0 : (i == 1 ? 256 : 640), kk = i == 0 ? 256 : 384;
            float a = 0.f;
            for (int k = 0; k < kk; ++k) a += os[ko + k] * wb[(size_t)k * 1024 + n];
            y += g * a;
        }
        ys[n] = y;
    }
    __syncthreads();
    float md = 0.f;
    const float* xc = dbg_xrow(p, row);
    for (int n = VTID; n < 1024; n += 256) {
        float o = 0.f;
        for (int k = 0; k < 1024; ++k) o += ys[k] * p.w_out[((size_t)l * 1024 + k) * 1024 + n];
        const float g5 = dbg_mod(p, l, b9, 5, n);
        md = fmaxf(md, fabsf(xs[n] + g5 * o - xc[n]));
    }
    md = blk_max(md, red);
    mdm = blk_max(mdm, red);
    unsigned* dw = (unsigned*)(p.ws + OFF_DBG);
    if (VTID == 0) { atomicMax(dw + 10, __float_as_uint(md)); atomicMax(dw + 15, __float_as_uint(mdm)); }
}
__global__ void dbg_fin(Params p) {
    const unsigned* dw = (const unsigned*)(p.ws + OFF_DBG);
    int mask = 0;
    if (__uint_as_float(dw[8]) > 0.02f) mask |= 1;
    if (__uint_as_float(dw[9]) > 0.03f) mask |= 2;
    if (__uint_as_float(dw[10]) > 0.02f) mask |= 4;
    if (__uint_as_float(dw[11]) > 0.02f) mask |= 8;
    if (__uint_as_float(dw[15]) > 1e-3f) mask |= 16;
    if (__uint_as_float(dw[4]) > 0.03f) mask |= 32;
    p.out[0] += 10.f * (float)mask;
    p.out[1] += 1000.f * __uint_as_float(dw[4]);
}
#endif


DEV void gemm8b_accum(f32x4 (&acc)[4][4], const u16* __restrict__ A, int lda, const u16* __restrict__ B, int ldb, int K, char* smem, int tid) {
    constexpr int STAGE = 49152;
    const int lane = tid & 63, wave = tid >> 6;
    const int wm = wave >> 1, wn = wave & 1, fr = lane & 15, fq = lane >> 4;
    const int lr = lane >> 3, pos = lane & 7;
    const int ce = pos ^ (lr >> 1), co = pos ^ (4 | (lr >> 1));
    const unsigned ra_ = (unsigned)((wave * 32 + lr) * lda) * 2u, rb_ = (unsigned)((wave * 16 + lr) * ldb) * 2u;
    const unsigned voa_e = ra_ + ce * 16, voa_o = ra_ + co * 16, vob_e = rb_ + ce * 16, vob_o = rb_ + co * 16;
    const int nk = K >> 6;
    const unsigned ldsb = (unsigned)(size_t)(__attribute__((address_space(3))) char*)smem;
    const unsigned ldsa_w = __builtin_amdgcn_readfirstlane(ldsb + wave * 4096);
    const unsigned ldsb_w = __builtin_amdgcn_readfirstlane(ldsb + 32768 + wave * 2048);
#define G8B_ISSUE(STG, K0) do { \
        _Pragma("unroll") for (int i = 0; i < 4; ++i) glds16(A + (size_t)(8 * i) * lda + (K0), (i & 1) ? voa_o : voa_e, ldsa_w + (STG) * STAGE + i * 1024); \
        _Pragma("unroll") for (int i = 0; i < 2; ++i) glds16(B + (size_t)(8 * i) * ldb + (K0), (i & 1) ? vob_o : vob_e, ldsb_w + (STG) * STAGE + i * 1024); \
    } while (0)
    G8B_ISSUE(0, 0);
    VM_WAIT0();
    __syncthreads();
    const int s3 = (fr >> 1) & 7;
    const int oa_base = (wm * 64 + fr) * 128 + ((fq ^ s3) * 16);
    const int ob_base = 32768 + (wn * 64 + fr) * 128 + ((fq ^ s3) * 16);
    for (int kt = 0; kt < nk; ++kt) {
        const int cur = kt & 1;
        const int k0 = (kt + 1 < nk ? kt + 1 : kt) * 64;
        G8B_ISSUE(cur ^ 1, k0);
        int o_a = cur * STAGE + oa_base, o_b = cur * STAGE + ob_base;
        asm volatile("" : "+v"(o_a), "+v"(o_b));
#pragma unroll
        for (int ks = 0; ks < 2; ++ks) {
            const char* sa_c = smem + (ks ? (o_a ^ 64) : o_a);
            const char* sb_c = smem + (ks ? (o_b ^ 64) : o_b);
            bf16x8 bfr[4], af[4];
#pragma unroll
            for (int nt = 0; nt < 4; ++nt) bfr[nt] = *(const bf16x8*)(sb_c + nt * 2048);
#pragma unroll
            for (int mt = 0; mt < 4; ++mt) af[mt] = *(const bf16x8*)(sa_c + mt * 2048);
#pragma unroll
            for (int mt = 0; mt < 4; ++mt)
#pragma unroll
                for (int nt = 0; nt < 4; ++nt) acc[mt][nt] = mfma16(af[mt], bfr[nt], acc[mt][nt]);
            __builtin_amdgcn_sched_group_barrier(0x100, 7, 0);
            __builtin_amdgcn_sched_group_barrier(0x008, 4, 0);
            __builtin_amdgcn_sched_group_barrier(0x100, 1, 0);
#pragma unroll
            for (int i = 0; i < 3; ++i) __builtin_amdgcn_sched_group_barrier(0x008, 4, 0);
        }
        VM_WAIT0();
        __syncthreads();
    }
#undef G8B_ISSUE
}

DEV void ph_merge8(const Params& p, char* smem, int rvid, int RG, int tid) {
    const u16* H = WSP(u16, OFF_H);
    u16* P = WSP(u16, OFF_P);
    const u16* Wg = WSP(u16, OFF_W) + WE_MIX + (size_t)2944 * 1024;
    const u16* Wbr = WSP(u16, OFF_W) + WE_BR;
    const int lane = tid & 63, wave = tid >> 6, wm = wave >> 1, wn = wave & 1, fr = lane & 15, fq = lane >> 4;
    const int total = 128 * 8;
    for (int t = rvid; t < total; t += RG) {
        const int gi = t >> 5, rem = t & 31;
        const int mt_ = gi * 4 + (rem & 3), nt_ = rem >> 2;
        const int m0 = mt_ * 256, n0 = nt_ * 128;
        f32x4 y[4][4];
        zero_acc<4>(y);
#pragma unroll 1
        for (int br = 0; br < 3; ++br) {
            const int ko = br == 0 ? 0 : (br == 1 ? 256 : 640);
            const int kk = br == 0 ? 256 : 384;
            uint32_t gpk[4][4][2];
            {
                f32x4 g[4][4];
                zero_acc<4>(g);
                gemm8b_accum(g, H + (size_t)m0 * D, D, Wg + (size_t)(br * 1024 + n0) * D, D, D, smem, tid);
#pragma unroll
                for (int i = 0; i < 4; ++i)
#pragma unroll
                    for (int jn = 0; jn < 4; ++jn) {
                        gpk[i][jn][0] = pk2(sigmoidf_(g[i][jn][0]), sigmoidf_(g[i][jn][1]));
                        gpk[i][jn][1] = pk2(sigmoidf_(g[i][jn][2]), sigmoidf_(g[i][jn][3]));
                    }
            }
            f32x4 a[4][4];
            zero_acc<4>(a);
            gemm8b_accum(a, P + (size_t)m0 * PW + ko, PW, Wbr + (size_t)n0 * D + ko, D, kk, smem, tid);
#pragma unroll
            for (int i = 0; i < 4; ++i)
#pragma unroll
                for (int jn = 0; jn < 4; ++jn) {
                    y[i][jn][0] += bflo(gpk[i][jn][0]) * a[i][jn][0];
                    y[i][jn][1] += bfhi(gpk[i][jn][0]) * a[i][jn][1];
                    y[i][jn][2] += bflo(gpk[i][jn][1]) * a[i][jn][2];
                    y[i][jn][3] += bfhi(gpk[i][jn][1]) * a[i][jn][3];
                }
        }
#pragma unroll
        for (int mt = 0; mt < 4; ++mt)
#pragma unroll
            for (int nt = 0; nt < 4; ++nt)
#pragma unroll
                for (int r = 0; r < 4; ++r) {
                    const int row = m0 + wm * 64 + mt * 16 + fq * 4 + r;
                    const int col = n0 + wn * 64 + nt * 16 + fr;
                    P[(size_t)row * PW + PC_Y + col] = (u16)(pk2(y[mt][nt][r], 0.f) & 0xffff);
                }
    }
}

constexpr int PH_PER_LAYER = 15;
constexpr int N_PHASES = 2 * PH_PER_LAYER;

#ifndef REPEAT_MASK
#define REPEAT_MASK 0
#endif
template <int Q>
DEV void run_phase_q(const Params& p, int l, char* smem) {
    const int half = (int)((threadIdx.x + p.z) >> 8);
    const int G = gridDim.x * 2, bid = blockIdx.x * 2 + half;
    const int vid = (gridDim.x % 8 == 0) ? (int)(blockIdx.x & 7) * (G >> 3) + (int)(blockIdx.x >> 3) * 2 + half : bid;
    smem += half * 73728;
    const bool last = (l == 1);
    const u16* W = WSP(u16, OFF_W);
    const int nrep = ((REPEAT_MASK >> Q) & 1) ? 2 : 1;
    char* smem0 = smem - half * 73728;
    const int rtid = (int)(threadIdx.x + p.z);
    const int RG = gridDim.x;
    const int rvid = (RG % 8 == 0) ? (int)(blockIdx.x & 7) * (RG >> 3) + (int)(blockIdx.x >> 3) : (int)blockIdx.x;
    for (int rep = 0; rep < nrep; ++rep) {
        const float cm = rep ? 0.f : 1.f;
        if (Q == 0) ph_prep(p, l, smem, bid, G);
        if (Q == 1) ph_mod(p, l, 0, MTOT, bid, G);
        Params p2 = p;
        if (Q == 2) { ph_ffn_in8(p, 0, smem0, rvid, RG, rtid); int z2 = p.z; asm volatile("" : "+s"(z2) :: "memory"); p2.z = z2; ph_ffn_in(p2, 0, 256, 16, smem, vid, G); }
        if (Q == 3) { ph_resid8(p, WSP(u16, OFF_P), DFF, W + WE_OUT0, DFF, 2, 0.5f * cm, smem0, rvid, RG, rtid, l == 0 ? p.x : p.out); int z2 = p.z; asm volatile("" : "+s"(z2) :: "memory"); p2.z = z2;
                      ph_resid(p2, WSP(u16, OFF_P), DFF, W + WE_OUT0, DFF, 2, 0.5f * cm, 256, 16, smem, vid, G); }
        if (Q == 4) ph_mod(p, l, 1, MTOT, bid, G);
        if (Q == 5) { ph_pgemm8(p, l, smem0, rvid, RG, rtid); int z2 = p.z; asm volatile("" : "+s"(z2) :: "memory"); p2.z = z2; ph_pgemm(p2, 256, 16, smem, vid, G); }
        if (Q == 6) ph_qknorm_gates(p, l, bid, G);
        if (Q == 7) { ph_attn8(p, l, smem0, rvid, RG); int z2 = p.z; asm volatile("" : "+s"(z2) :: "memory"); p2.z = z2; ph_attn(p2, l, smem, bid, G, rep); }
        if (Q == 8) ph_m3(p, bid, G);
        if (Q == 9) ph_m4(p, l, bid, G, rep);
        if (Q == 10) { ph_merge8(p, smem0, rvid, RG, rtid); int z2 = p.z; asm volatile("" : "+s"(z2) :: "memory"); p2.z = z2; if (!last) ph_merge(p2, 256, 16, smem, vid, G); }
        if (Q == 11) { ph_resid8(p, WSP(u16, OFF_P) + PC_Y, PW, W + WE_O, D, 5, 1.0f * cm, smem0, rvid, RG, rtid, p.out);
                       int z2 = p.z; asm volatile("" : "+s"(z2) :: "memory"); p2.z = z2;
                       if (!last) ph_resid(p2, WSP(u16, OFF_P) + PC_Y, PW, W + WE_O, D, 5, 1.0f * cm, 256, 16, smem, vid, G); }
        if (Q == 12) ph_mod(p, l, 2, last ? NL : MTOT, bid, G);
        if (Q == 13) { ph_ffn_in8(p, 1, smem0, rvid, RG, rtid); int z2 = p.z; asm volatile("" : "+s"(z2) :: "memory"); p2.z = z2; if (!last) ph_ffn_in(p2, 1, 256, 16, smem, vid, G); }
        if (Q == 14) { ph_resid8(p, WSP(u16, OFF_P), DFF, W + WE_OUT1, DFF, 8, 0.5f * cm, smem0, rvid, RG, rtid, p.out);
                       int z2 = p.z; asm volatile("" : "+s"(z2) :: "memory"); p2.z = z2;
                       if (!last) ph_resid(p2, WSP(u16, OFF_P), DFF, W + WE_OUT1, DFF, 8, 0.5f * cm, 256, 16, smem, vid, G); }
    }
}

DEV void run_phase(const Params& p, int ph, char* smem) {
    const int l = ph / PH_PER_LAYER, q = ph % PH_PER_LAYER;
    switch (q) {
        case 0: run_phase_q<0>(p, l, smem); break;
        case 1: run_phase_q<1>(p, l, smem); break;
        case 2: run_phase_q<2>(p, l, smem); break;
        case 3: run_phase_q<3>(p, l, smem); break;
        case 4: run_phase_q<4>(p, l, smem); break;
        case 5: run_phase_q<5>(p, l, smem); break;
        case 6: run_phase_q<6>(p, l, smem); break;
        case 7: run_phase_q<7>(p, l, smem); break;
        case 8: run_phase_q<8>(p, l, smem); break;
        case 9: run_phase_q<9>(p, l, smem); break;
        case 10: run_phase_q<10>(p, l, smem); break;
        case 11: run_phase_q<11>(p, l, smem); break;
        case 12: run_phase_q<12>(p, l, smem); break;
        case 13: run_phase_q<13>(p, l, smem); break;
        case 14: run_phase_q<14>(p, l, smem); break;
    }
}

template <int Q>
__global__ void __launch_bounds__(256, 2) phase_kernel(Params p, int l) {
    __shared__ __attribute__((aligned(16))) char smem[73728];
    run_phase_q<Q>(p, l, smem);
}

#if ONE_LAUNCH
#define XB_TMO      128
#define XB_XCNT(j)  (256  + 64 * (j))
#define XB_XSUB(j)  (1280 + 64 * (j))
#define XB_XGEN(j)  (2304 + 64 * (j))
#define XB_TOP      3328
#define XB_TOPGEN   3392
#define XB_SPIN_CAP (1u << 22)
DEV unsigned xb_ld(unsigned* q) { return __hip_atomic_load(q, __ATOMIC_RELAXED, __HIP_MEMORY_SCOPE_AGENT); }
DEV unsigned xb_add(unsigned* q, unsigned v) { return __hip_atomic_fetch_add(q, v, __ATOMIC_RELAXED, __HIP_MEMORY_SCOPE_AGENT); }
DEV unsigned xb_xcc_id() { return (unsigned)__builtin_amdgcn_s_getreg((3 << 11) | 20) & 0xFu; }
#define XB_SPIN(cond, bar) do { unsigned _sp = 0; while (cond) { __builtin_amdgcn_s_sleep(1); \
    if ((++_sp & 255u) == 0u) { if (xb_ld(&(bar)[XB_TMO])) break; if (_sp > XB_SPIN_CAP) { atomicAdd(&(bar)[XB_TMO], 1u); break; } } } } while (0)
DEV void xcd_census(unsigned* bar, unsigned x, unsigned& nloc, unsigned& nx) {
    const unsigned G = gridDim.x;
    unsigned sum, cnt, mine, sp = 0u;
    for (;;) {
        sum = 0u; cnt = 0u; mine = 0u;
#pragma unroll
        for (unsigned j = 0; j < 16; ++j) { const unsigned c = xb_ld(&bar[XB_XCNT(j)]); sum += c; cnt += (c > 0u) ? 1u : 0u; mine = (j == x) ? c : mine; }
        if (sum == G) break;
        __builtin_amdgcn_s_sleep(1);
        if ((++sp & 255u) == 0u) { if (xb_ld(&bar[XB_TMO])) break; if (sp > XB_SPIN_CAP) { atomicAdd(&bar[XB_TMO], 1u); break; } }
    }
    nloc = mine > 0u ? mine : 1u; nx = cnt > 0u ? cnt : 1u;
}
DEV void xcd_barrier(unsigned* bar, unsigned x, volatile unsigned* st, int tid) {
    asm volatile("s_waitcnt vmcnt(0)" ::: "memory");
    __syncthreads();
    if (tid == 0) {
        __builtin_amdgcn_s_waitcnt(0);
        unsigned nloc = st[0], nx = st[1];
        if (nloc == 0u) { xcd_census(bar, x, nloc, nx); st[0] = nloc; st[1] = nx; }
        const unsigned old = xb_add(&bar[XB_XSUB(x)], 1u);
        const unsigned gen = old / nloc;
        if (old + 1u == (gen + 1u) * nloc) {
            __builtin_amdgcn_fence(__ATOMIC_RELEASE, "agent");
            asm volatile("s_waitcnt vmcnt(0)" ::: "memory");
            const unsigned og = xb_add(&bar[XB_TOP], 1u);
            const unsigned tg = og / nx;
            if (og + 1u == (tg + 1u) * nx) xb_add(&bar[XB_TOPGEN], 1u);
            else XB_SPIN(xb_ld(&bar[XB_TOPGEN]) == tg, bar);
            __builtin_amdgcn_fence(__ATOMIC_ACQUIRE, "agent");
            xb_add(&bar[XB_XGEN(x)], 1u);
            asm volatile("s_waitcnt vmcnt(0)" ::: "memory");
        } else {
            XB_SPIN(xb_ld(&bar[XB_XGEN(x)]) == gen, bar);
            __builtin_amdgcn_fence(__ATOMIC_ACQUIRE, "agent");
            asm volatile("s_waitcnt vmcnt(0)" ::: "memory");
        }
    }
    __syncthreads();
}
__global__ void __launch_bounds__(512, 2) mega_kernel(Params p0, int ph_begin, int ph_end) {
    __shared__ __attribute__((aligned(16))) char smem[147456];
    __shared__ uint4 xb_words;
    unsigned* bar = (unsigned*)(p0.ws + OFF_BAR);
    const unsigned xcc = xb_xcc_id();
    if (threadIdx.x == 0) { xb_words = make_uint4(0u, 0u, 0u, 0u); (void)xb_add(&bar[XB_XCNT(xcc)], 1u); }
    __syncthreads();
    for (int ph = ph_begin; ph < ph_end; ++ph) {
        Params p = p0;
        int z = p0.z;
        asm volatile("" : "+s"(z));
        p.z = z;
        p.ws = p0.ws + z;
        p.out = p0.out + z;
        run_phase(p, ph, smem);
        if (ph + 1 < ph_end) {
            if (p0.z == 0x7fffffff) cg::this_grid().sync();
            xcd_barrier(bar, xcc, (volatile unsigned*)&xb_words, (int)threadIdx.x + z);
        }
    }
}
#endif

extern "C" void kernel_launch(void* const* d_in, const int* in_sizes, int n_in, void* d_out, int out_size, void* d_ws, size_t ws_size,
                              hipStream_t stream) {
    if (ws_size < WS_END) { fprintf(stderr, "workspace too small: %zu < %zu\n", ws_size, (size_t)WS_END); return; }
    Params p{};
    p.x = (const float*)d_in[0]; p.c = (const float*)d_in[1]; p.ctx = (const float*)d_in[2]; p.c_ctx = (const float*)d_in[3];
    p.ada_w = (const float*)d_in[4]; p.ada_b = (const float*)d_in[5]; p.norm_w = (const float*)d_in[6];
    p.ffn_w_in = (const float*)d_in[7]; p.ffn_w_out = (const float*)d_in[8]; p.mix_w_in = (const float*)d_in[9];
    p.ml_gate_b = (const float*)d_in[10]; p.ml_norm_w = (const float*)d_in[11]; p.na_qk_w = (const float*)d_in[12];
    p.na_rpb = (const float*)d_in[13]; p.gq_qk_w = (const float*)d_in[14]; p.w_br_ml = (const float*)d_in[15];
    p.w_br_na = (const float*)d_in[16]; p.w_br_gq = (const float*)d_in[17]; p.w_out = (const float*)d_in[18];
    p.out = (float*)d_out; p.ws = (char*)d_ws;
#ifdef NANFILL
    hipMemsetAsync(d_ws, 0xFF, WS_END, stream);
#endif
#if ONE_LAUNCH
    static int grid_blocks = 0;
    if (!grid_blocks) {
        int dev = 0, cus = 0, per_cu = 0;
        hipGetDevice(&dev);
        hipDeviceGetAttribute(&cus, hipDeviceAttributeMultiprocessorCount, dev);
        hipOccupancyMaxActiveBlocksPerMultiprocessor(&per_cu, mega_kernel, 512, 0);
        per_cu = 1;
        grid_blocks = cus * per_cu;
    }
    hipMemsetAsync((char*)d_ws + OFF_BAR, 0, 3456 * 4, stream);
    int pb = 0, pe = N_PHASES;
    void* args[] = {&p, &pb, &pe};
#ifdef SPLIT_TEST
    (void)args;
    for (int ph = 0; ph < N_PHASES; ++ph) mega_kernel<<<grid_blocks, 256, 0, stream>>>(p, ph, ph + 1);
#else
    hipError_t e = hipLaunchCooperativeKernel((void*)mega_kernel, dim3(grid_blocks), dim3(512), args, 0, stream);
    if (e != hipSuccess) fprintf(stderr, "cooperative launch failed: %s (grid %d)\n", hipGetErrorString(e), grid_blocks);
#endif
#else
    for (int l = 0; l < 2; ++l) {
#define LP(Q) phase_kernel<Q><<<512, 256, 0, stream>>>(p, l)
#ifdef DBG
        const bool dl = (l == DBG_LAYER);
        if (dl) hipMemsetAsync((char*)d_ws + OFF_DBG, 0, 256, stream);
        LP(0);
        if (dl) dbg_save<<<16, 256, 0, stream>>>(p, 0);
        LP(1); LP(2); LP(3);
        if (dl) dbg_ffn<<<16, 256, 0, stream>>>(p, l, 0, 0, 8);
        LP(4); LP(5);
        if (dl) dbg_pchk<<<16, 256, 0, stream>>>(p, l);
        LP(6);
        if (dl) dbg_copy<<<2048, 256, 0, stream>>>(p);
        LP(7); LP(8); LP(9);
        if (dl) {
            dbg_mlstm<<<64, 64, 0, stream>>>(p, l);
            dbg_cmp<<<(NB * 4 * UT + 7424 * 64 + 255) / 256, 256, 0, stream>>>(p, l);
            dbg_save<<<16, 256, 0, stream>>>(p, 1);
        }
        LP(10); LP(11);
        if (dl) { dbg_mix<<<16, 256, 0, stream>>>(p, l, 1); dbg_save<<<16, 256, 0, stream>>>(p, 2); }
        LP(12); LP(13); LP(14);
        if (dl) dbg_ffn<<<16, 256, 0, stream>>>(p, l, 1, 2, 11);
#else
        LP(0); LP(1); LP(2); LP(3); LP(4); LP(5); LP(6); LP(7); LP(8); LP(9); LP(10); LP(11); LP(12); LP(13); LP(14);
#endif
#undef LP
    }
#ifdef DBG
    dbg_fin<<<1, 1, 0, stream>>>(p);
#endif
#endif
}
```

```cpp
#include <hip/hip_runtime.h>
#include <hip/hip_cooperative_groups.h>
#include <stdint.h>
#include <cstdio>
namespace cg = cooperative_groups;

#ifndef ONE_LAUNCH
#define ONE_LAUNCH 1
#endif

#define VTID ((int)((threadIdx.x + p.z) & 255))
typedef unsigned short u16;
typedef __attribute__((ext_vector_type(8))) short bf16x8;
typedef __attribute__((ext_vector_type(4))) float f32x4;
#define DEV __device__ __forceinline__

constexpr int D = 1024, NB = 8, SEQ = 4096, CTXL = 256;
constexpr int NL = NB * SEQ, NCX = NB * CTXL, MTOT = NL + NCX;
constexpr int DFF = 2816, PW = 2816, UT = SEQ + CTXL, NCH = UT / 64;
constexpr int NIN = 5904;
constexpr int PC_MLQ = 0, PC_NAQ = 256, PC_GQQ = 640, PC_MLO = 1024, PC_MLK = 1280, PC_NAK = 1536, PC_GQK = 1920,
              PC_MLV = 2048, PC_NAV = 2304, PC_GQV = 2688, PC_Y = 1024;
constexpr int TC_MLK = 0, TC_MLV = 256, TC_NAV = 512, TC_GQV = 896, TW = 1024;
constexpr int DBG_MLO = PC_MLQ, DBG_NAO = PC_NAQ;
constexpr int SCH = 4160;
constexpr int NSCAN = 64;

constexpr size_t al256(size_t x) { return (x + 255) & ~(size_t)255; }
constexpr size_t OFF_MODS = 0;
constexpr size_t OFF_ROPE = al256(OFF_MODS + (size_t)9 * 9216 * 4);
constexpr size_t OFF_G    = al256(OFF_ROPE + (size_t)4096 * 64 * 4);
constexpr size_t OFF_BC   = al256(OFF_G + (size_t)MTOT * 16 * 4);
constexpr size_t OFF_IG   = al256(OFF_BC + (size_t)NSCAN * UT * 4);
constexpr size_t OFF_AE   = al256(OFF_IG + (size_t)NSCAN * UT * 4);
constexpr size_t OFF_MS   = al256(OFF_AE + (size_t)NSCAN * UT * 4);
constexpr size_t OFF_DEC  = al256(OFF_MS + (size_t)NSCAN * NCH * 4);
constexpr size_t OFF_XC   = al256(OFF_DEC + (size_t)NSCAN * NCH * 4);
constexpr size_t OFF_H    = al256(OFF_XC + (size_t)NCX * D * 4);
constexpr size_t OFF_P    = al256(OFF_H + (size_t)MTOT * D * 2);
constexpr size_t OFF_T    = al256(OFF_P + (size_t)MTOT * PW * 2);
constexpr size_t OFF_S    = al256(OFF_T + (size_t)NB * TW * UT * 2);
constexpr size_t OFF_W    = al256(OFF_S + (size_t)NSCAN * NCH * SCH * 4);
constexpr size_t WE_IN0 = 0, WE_IN1 = WE_IN0 + (size_t)5632 * 1024, WE_OUT0 = WE_IN1 + (size_t)5632 * 1024,
                 WE_OUT1 = WE_OUT0 + (size_t)1024 * 2816, WE_MIX = WE_OUT1 + (size_t)1024 * 2816,
                 WE_BR = WE_MIX + (size_t)6016 * 1024, WE_O = WE_BR + (size_t)1024 * 1024, WE_END = WE_O + (size_t)1024 * 1024;
constexpr size_t OFF_BAR = al256(OFF_W + WE_END * 2);
constexpr size_t OFF_PART = al256(OFF_BAR + 3456 * 4);
constexpr size_t WS_END = OFF_PART + (size_t)4 * NCX * D * 4;
static_assert(WS_END < (size_t)536000000, "workspace too large");

struct Params {
    const float *x, *c, *ctx, *c_ctx, *ada_w, *ada_b, *norm_w, *ffn_w_in, *ffn_w_out, *mix_w_in, *ml_gate_b, *ml_norm_w,
        *na_qk_w, *na_rpb, *gq_qk_w, *w_br_ml, *w_br_na, *w_br_gq, *w_out;
    float* out;
    char* ws;
    int z, pad;
};

DEV uint32_t pk2(float lo, float hi) { uint32_t r; asm("v_cvt_pk_bf16_f32 %0, %1, %2" : "=v"(r) : "v"(lo), "v"(hi)); return r; }
DEV float bflo(uint32_t w) { return __uint_as_float(w << 16); }
DEV float bfhi(uint32_t w) { return __uint_as_float(w & 0xffff0000u); }
DEV f32x4 mfma16(bf16x8 a, bf16x8 b, f32x4 c) { return __builtin_amdgcn_mfma_f32_16x16x32_bf16(a, b, c, 0, 0, 0); }
typedef unsigned u32x4 __attribute__((ext_vector_type(4)));
DEV u32x4 gld16(const void* q) { u32x4 r; asm volatile("global_load_dwordx4 %0, %1, off" : "=v"(r) : "v"(q) : "memory"); return r; }
DEV u32x4 gld16s(const void* sbase, unsigned voff) { u32x4 r; asm volatile("global_load_dwordx4 %0, %1, %2" : "=v"(r) : "v"(voff), "s"(sbase) : "memory"); return r; }
DEV void glds16(const void* sbase, unsigned voff, unsigned ldsaddr) {
    asm volatile("s_mov_b32 m0, %2\n\ts_nop 0\n\tglobal_load_lds_dwordx4 %0, %1" :: "v"(voff), "s"(sbase), "s"(ldsaddr) : "memory", "m0");
}
#define VM_WAIT0() asm volatile("s_waitcnt vmcnt(0)" ::: "memory")
union Frag { bf16x8 v; uint4 q; uint32_t u[4]; uint2 d[2]; };
DEV int cu_of(int c, int dir) { return c < 4 ? 64 + (dir ? 3 - c : c) : (dir ? 63 - (c - 4) : (c - 4)); }
DEV int rowof(int b, int u) { return u < SEQ ? b * SEQ + u : NL + b * CTXL + (u - SEQ); }
DEV float fexp2(float x) { return __builtin_amdgcn_exp2f(x); }
DEV float fexp(float x) { return __builtin_amdgcn_exp2f(x * 1.4426950408889634f); }
DEV float sigmoidf_(float x) { return 1.f / (1.f + fexp(-x)); }
DEV float xq_max(float v) {
    auto r = __builtin_amdgcn_permlane16_swap(__float_as_uint(v), __float_as_uint(v), false, false);
    const float m = fmaxf(__uint_as_float(r[0]), __uint_as_float(r[1]));
    auto q = __builtin_amdgcn_permlane32_swap(__float_as_uint(m), __float_as_uint(m), false, false);
    return fmaxf(__uint_as_float(q[0]), __uint_as_float(q[1]));
}
DEV float xq_sum(float v) {
    auto r = __builtin_amdgcn_permlane16_swap(__float_as_uint(v), __float_as_uint(v), false, false);
    const float m = __uint_as_float(r[0]) + __uint_as_float(r[1]);
    auto q = __builtin_amdgcn_permlane32_swap(__float_as_uint(m), __float_as_uint(m), false, false);
    return __uint_as_float(q[0]) + __uint_as_float(q[1]);
}
DEV float wave_sum(float v) {
#pragma unroll
    for (int o = 1; o < 64; o <<= 1) v += __shfl_xor(v, o);
    return v;
}
DEV float wave_max(float v) {
#pragma unroll
    for (int o = 1; o < 64; o <<= 1) v = fmaxf(v, __shfl_xor(v, o));
    return v;
}

#define WSP(T_, off) ((T_*)(p.ws + (off)))
DEV float m_scan(const Params& p, int sc, int c_end) {
    const float* BT = WSP(float, OFF_MS) + sc * NCH;
    const float* MX = WSP(float, OFF_DEC) + sc * NCH;
    const int lane = VTID & 63;
    const float bt0 = BT[lane], mx0 = MX[lane], bt1 = BT[64 + (lane & 3)], mx1 = MX[64 + (lane & 3)];
    float m = 0.f;
    for (int c = 0; c < c_end; ++c) {
        const float b = c < 64 ? __shfl(bt0, c) : __shfl(bt1, c - 64);
        const float x = c < 64 ? __shfl(mx0, c) : __shfl(mx1, c - 64);
        m = fmaxf(b + m, x);
    }
    return m;
}

template <int TN>
DEV void gemm_accum(f32x4 (&acc)[4][TN], const u16* __restrict__ A, int lda, const u16* __restrict__ B, int ldb, int K, char* smem, int tid) {
    constexpr int BROWS = TN * 32;
    constexpr int STAGE = (128 + BROWS) * 144;
    constexpr int NBCH = BROWS / 32;
    const int lane = tid & 63, wave = tid >> 6;
    const int wm = wave >> 1, wn = wave & 1, fr = lane & 15, fq = lane >> 4;
    const int lrow = tid >> 3, lc8 = tid & 7;
    const u16* ga = A + (size_t)lrow * lda + lc8 * 8;
    const u16* gb = B + (size_t)lrow * ldb + lc8 * 8;
    u32x4 ra[4], rb[NBCH];
    const int nk = K >> 6;
#pragma unroll
    for (int i = 0; i < 4; ++i) ra[i] = gld16(ga + (size_t)(32 * i) * lda);
#pragma unroll
    for (int i = 0; i < NBCH; ++i) rb[i] = gld16(gb + (size_t)(32 * i) * ldb);
    char* sw = smem + lrow * 144 + lc8 * 16;
    VM_WAIT0();
#pragma unroll
    for (int i = 0; i < 4; ++i) *(u32x4*)(sw + i * 32 * 144) = ra[i];
#pragma unroll
    for (int i = 0; i < NBCH; ++i) *(u32x4*)(sw + 128 * 144 + i * 32 * 144) = rb[i];
    __syncthreads();
    const char* sa_r = smem + (wm * 64 + fr) * 144 + fq * 16;
    const char* sb_r = smem + 128 * 144 + (wn * TN * 16 + fr) * 144 + fq * 16;
    for (int kt = 0; kt < nk; ++kt) {
        const int cur = kt & 1;
        const int k0 = (kt + 1 < nk ? kt + 1 : kt) * 64;
#pragma unroll
        for (int i = 0; i < 4; ++i) ra[i] = gld16(ga + (size_t)(32 * i) * lda + k0);
#pragma unroll
        for (int i = 0; i < NBCH; ++i) rb[i] = gld16(gb + (size_t)(32 * i) * ldb + k0);
        __builtin_amdgcn_sched_barrier(0);
#pragma unroll
        for (int ks = 0; ks < 2; ++ks) {
            bf16x8 af[4], bfr[TN];
#pragma unroll
            for (int mt = 0; mt < 4; ++mt) af[mt] = *(const bf16x8*)(sa_r + cur * STAGE + mt * 16 * 144 + ks * 64);
#pragma unroll
            for (int nt = 0; nt < TN; ++nt) bfr[nt] = *(const bf16x8*)(sb_r + cur * STAGE + nt * 16 * 144 + ks * 64);
#pragma unroll
            for (int mt = 0; mt < 4; ++mt)
#pragma unroll
                for (int nt = 0; nt < TN; ++nt) acc[mt][nt] = mfma16(af[mt], bfr[nt], acc[mt][nt]);
        }
        __builtin_amdgcn_sched_barrier(0);
        VM_WAIT0();
        {
            char* sw2 = sw + (cur ^ 1) * STAGE;
#pragma unroll
            for (int i = 0; i < 4; ++i) *(u32x4*)(sw2 + i * 32 * 144) = ra[i];
#pragma unroll
            for (int i = 0; i < NBCH; ++i) *(u32x4*)(sw2 + 128 * 144 + i * 32 * 144) = rb[i];
        }
        __syncthreads();
    }
}

template <int TN>
DEV void zero_acc(f32x4 (&acc)[4][TN]) {
#pragma unroll
    for (int i = 0; i < 4; ++i)
#pragma unroll
        for (int j = 0; j < TN; ++j) acc[i][j] = f32x4{0.f, 0.f, 0.f, 0.f};
}

DEV void tile_decode(int t, int ntn, int& mt, int& nt) {
    const int per = 8 * ntn;
    const int gi = t / per, rem = t - gi * per;
    nt = rem >> 3;
    mt = gi * 8 + (rem & 7);
}


template <bool SWAP = false>
DEV void gemm8_accum(f32x4 (&acc)[8][4], const u16* __restrict__ A, int lda, const u16* __restrict__ B, int ldb, int K, char* smem, int tid) {
    constexpr int STAGE = 65536;
    const int lane = tid & 63, wave = tid >> 6;
    const int wm = wave >> 2, wn = wave & 3, fr = lane & 15, fq = lane >> 4;
    const int lr = lane >> 3, pos = lane & 7;
    const int ce = pos ^ (lr >> 1), co = pos ^ (4 | (lr >> 1));
    const unsigned ra_ = (unsigned)((wave * 32 + lr) * lda) * 2u, rb_ = (unsigned)((wave * 32 + lr) * ldb) * 2u;
    const unsigned voa_e = ra_ + ce * 16, voa_o = ra_ + co * 16, vob_e = rb_ + ce * 16, vob_o = rb_ + co * 16;
    const int nk = K >> 6;
    const unsigned ldsw = __builtin_amdgcn_readfirstlane((unsigned)(size_t)(__attribute__((address_space(3))) char*)smem + wave * 4096);
#define G8_ISSUE(STG, K0) do { \
        _Pragma("unroll") for (int i = 0; i < 4; ++i) { \
            glds16(A + (size_t)(8 * i) * lda + (K0), (i & 1) ? voa_o : voa_e, ldsw + (STG) * STAGE + i * 1024); \
            glds16(B + (size_t)(8 * i) * ldb + (K0), (i & 1) ? vob_o : vob_e, ldsw + (STG) * STAGE + 32768 + i * 1024); \
        } } while (0)
    G8_ISSUE(0, 0);
    VM_WAIT0();
    __syncthreads();
    const int s3 = (fr >> 1) & 7;
    const int oa_base = (wm * 128 + fr) * 128 + ((fq ^ s3) * 16);
    const int ob_base = 32768 + (wn * 64 + fr) * 128 + ((fq ^ s3) * 16);
    for (int kt = 0; kt < nk; ++kt) {
        const int cur = kt & 1;
        const int k0 = (kt + 1 < nk ? kt + 1 : kt) * 64;
        G8_ISSUE(cur ^ 1, k0);
        int o_a = cur * STAGE + oa_base, o_b = cur * STAGE + ob_base;
        asm volatile("" : "+v"(o_a), "+v"(o_b));
#pragma unroll
        for (int ks = 0; ks < 2; ++ks) {
            const char* sa_c = smem + (ks ? (o_a ^ 64) : o_a);
            const char* sb_c = smem + (ks ? (o_b ^ 64) : o_b);
            bf16x8 bfr[4], af[8];
#pragma unroll
            for (int nt = 0; nt < 4; ++nt) bfr[nt] = *(const bf16x8*)(sb_c + nt * 2048);
#pragma unroll
            for (int mt = 0; mt < 8; ++mt) af[mt] = *(const bf16x8*)(sa_c + mt * 2048);
#pragma unroll
            for (int mt = 0; mt < 8; ++mt)
#pragma unroll
                for (int nt = 0; nt < 4; ++nt) acc[mt][nt] = SWAP ? mfma16(bfr[nt], af[mt], acc[mt][nt]) : mfma16(af[mt], bfr[nt], acc[mt][nt]);
            __builtin_amdgcn_sched_group_barrier(0x100, 7, 0);
#pragma unroll
            for (int i = 0; i < 5; ++i) { __builtin_amdgcn_sched_group_barrier(0x008, 4, 0); __builtin_amdgcn_sched_group_barrier(0x100, 1, 0); }
#pragma unroll
            for (int i = 0; i < 3; ++i) __builtin_amdgcn_sched_group_barrier(0x008, 4, 0);
        }
        VM_WAIT0();
        __syncthreads();
    }
#undef G8_ISSUE
}
DEV void zero_acc8(f32x4 (&acc)[8][4]) {
#pragma unroll
    for (int i = 0; i < 8; ++i)
#pragma unroll
        for (int j = 0; j < 4; ++j) acc[i][j] = f32x4{0.f, 0.f, 0.f, 0.f};
}
DEV void tile_decode8(int t, int ntn, int& mt, int& nt) {
    const int per = 4 * ntn;
    const int gi = t / per, rem = t - gi * per;
    nt = rem >> 2;
    mt = gi * 4 + (rem & 3);
}

DEV void ph_ffn_in8(const Params& p, int which, char* smem, int rvid, int RG, int tid) {
    const u16* H = WSP(u16, OFF_H);
    const u16* Wt = WSP(u16, OFF_W) + (which ? WE_IN1 : WE_IN0);
    u16* ACT = WSP(u16, OFF_P);
    const int lane = tid & 63, wave = tid >> 6, wm = wave >> 2, wn = wave & 3, fr = lane & 15, fq = lane >> 4;
    const int total = 128 * 22;
    for (int t = rvid; t < total; t += RG) {
        int mt_, nt_;
        tile_decode8(t, 22, mt_, nt_);
        const int m0 = mt_ * 256, n0 = nt_ * 256;
        f32x4 acc[8][4];
        zero_acc8(acc);
        gemm8_accum(acc, H + (size_t)m0 * D, D, Wt + (size_t)n0 * D, D, D, smem, tid);
#pragma unroll
        for (int mt = 0; mt < 8; ++mt)
#pragma unroll
            for (int pp = 0; pp < 2; ++pp)
#pragma unroll
                for (int r = 0; r < 4; ++r) {
                    const int row = m0 + wm * 128 + mt * 16 + fq * 4 + r;
                    const int hid = (n0 >> 1) + wn * 32 + pp * 16 + fr;
                    const float g = acc[mt][2 * pp][r], u = acc[mt][2 * pp + 1][r];
                    const float v = g * sigmoidf_(g) * u;
                    ACT[(size_t)row * DFF + hid] = (u16)(pk2(v, 0.f) & 0xffff);
                }
    }
}
DEV void ph_resid8(const Params& p, const u16* A, int lda, const u16* Wt, int K, int modidx, float coef, char* smem, int rvid, int RG, int tid, const float* xsrc) {
    const float* mods = WSP(float, OFF_MODS);
    const int lane = tid & 63, wave = tid >> 6, wm = wave >> 2, wn = wave & 3, fr = lane & 15, fq = lane >> 4;
    const int total = 128 * 4;
    for (int t = rvid; t < total; t += RG) {
        int mt_, nt_;
        tile_decode8(t, 4, mt_, nt_);
        const int m0 = mt_ * 256, n0 = nt_ * 256;
        f32x4 acc[8][4];
        zero_acc8(acc);
        gemm8_accum<true>(acc, A + (size_t)m0 * lda, lda, Wt + (size_t)n0 * K, K, K, smem, tid);
        const float* gp = mods + (m0 >> 12) * 9216 + modidx * 1024;
#pragma unroll
        for (int nt = 0; nt < 4; ++nt) {
            const int col = n0 + wn * 64 + nt * 16 + fq * 4;
            float4 g4 = *(const float4*)(gp + col);
            g4.x *= coef; g4.y *= coef; g4.z *= coef; g4.w *= coef;
#pragma unroll
            for (int mt = 0; mt < 8; ++mt) {
                const size_t off = (size_t)(m0 + wm * 128 + mt * 16 + fr) * D + col;
                float4 xv = *(const float4*)(xsrc + off);
                xv.x += g4.x * acc[mt][nt][0];
                xv.y += g4.y * acc[mt][nt][1];
                xv.z += g4.z * acc[mt][nt][2];
                xv.w += g4.w * acc[mt][nt][3];
                *(float4*)(p.out + off) = xv;
            }
        }
    }
}
DEV void ph_pgemm8(const Params& p, int lsel, char* smem, int rvid, int RG, int tid) {
    const u16* H = WSP(u16, OFF_H);
    const u16* Wt = WSP(u16, OFF_W) + WE_MIX;
    u16* P = WSP(u16, OFF_P);
    u16* T = WSP(u16, OFF_T);
    float* Gt = WSP(float, OFF_G);
    const int lane = tid & 63, wave = tid >> 6, wm = wave >> 2, wn = wave & 3, fr = lane & 15, fq = lane >> 4;
    const int total = 128 * 12;
    for (int t = rvid; t < total; t += RG) {
        int mt_, nt_;
        tile_decode8(t, 12, mt_, nt_);
        const int m0 = mt_ * 256, n0 = nt_ * 256;
        f32x4 acc[8][4];
        zero_acc8(acc);
        const int cb = n0 + wn * 64;
        const int j = cb >> 7;
        const bool swap_tile = (nt_ <= 4) || (nt_ == 6) || (nt_ == 7);
        if (swap_tile) {
            gemm8_accum<true>(acc, H + (size_t)m0 * D, D, Wt + (size_t)n0 * D, D, D, smem, tid);
            const bool normed = (cb >= 256 && cb < 1024) || (cb >= 1536);
            const bool isq = cb < 1024;
            const bool isgq = (cb >= 640 && cb < 1024) || (cb >= 1920);
            const float* wv = (isgq ? p.gq_qk_w : p.na_qk_w) + (lsel * 2 + (isq ? 0 : 1)) * 64;
            const float scl = isq ? 0.125f : 1.f;
            float4 w4[4];
#pragma unroll
            for (int nt = 0; nt < 4; ++nt) w4[nt] = normed ? *(const float4*)(wv + nt * 16 + fq * 4) : float4{1.f, 1.f, 1.f, 1.f};
            const float* rope = WSP(float, OFF_ROPE);
#pragma unroll
            for (int mt = 0; mt < 8; ++mt) {
                const int row = m0 + wm * 128 + mt * 16 + fr;
                if (normed) {
                    float ss = 0.f;
#pragma unroll
                    for (int nt = 0; nt < 4; ++nt)
#pragma unroll
                        for (int r = 0; r < 4; ++r) ss += acc[mt][nt][r] * acc[mt][nt][r];
                    ss = xq_sum(ss);
                    const float rstd = rsqrtf(ss * (1.f / 64.f) + 1e-6f) * scl;
#pragma unroll
                    for (int nt = 0; nt < 4; ++nt) {
                        acc[mt][nt][0] *= rstd * w4[nt].x; acc[mt][nt][1] *= rstd * w4[nt].y;
                        acc[mt][nt][2] *= rstd * w4[nt].z; acc[mt][nt][3] *= rstd * w4[nt].w;
                    }
                    if (isgq) {
                        const int tok = row & 4095;
#pragma unroll
                        for (int nt = 0; nt < 2; ++nt) {
                            const float* rp = rope + ((size_t)tok * 32 + nt * 16 + fq * 4) * 2;
                            const float4 cs01 = *(const float4*)rp, cs23 = *(const float4*)(rp + 4);
                            const float cv[4] = {cs01.x, cs01.z, cs23.x, cs23.z}, sv[4] = {cs01.y, cs01.w, cs23.y, cs23.w};
#pragma unroll
                            for (int r = 0; r < 4; ++r) {
                                const float x1 = acc[mt][nt][r], x2 = acc[mt][nt + 2][r];
                                acc[mt][nt][r] = x1 * cv[r] - x2 * sv[r];
                                acc[mt][nt + 2][r] = x1 * sv[r] + x2 * cv[r];
                            }
                        }
                    }
                }
#pragma unroll
                for (int nt = 0; nt < 4; ++nt)
                    *(uint2*)(P + (size_t)row * PW + cb + nt * 16 + fq * 4) = uint2{pk2(acc[mt][nt][0], acc[mt][nt][1]), pk2(acc[mt][nt][2], acc[mt][nt][3])};
            }
            continue;
        }
        gemm8_accum(acc, H + (size_t)m0 * D, D, Wt + (size_t)n0 * D, D, D, smem, tid);
        if (j >= 22) {
            if (cb == 2816) {
#pragma unroll
                for (int mt = 0; mt < 8; ++mt)
#pragma unroll
                    for (int r = 0; r < 4; ++r) {
                        const int row = m0 + wm * 128 + mt * 16 + fq * 4 + r;
                        Gt[(size_t)row * 16 + fr] = acc[mt][0][r];
                    }
            }
            continue;
        }
        const bool rowmajor = j < 16;
        const bool transp = (j == 10) || (j == 11) || (j >= 16);
        if (rowmajor) {
#pragma unroll
            for (int mt = 0; mt < 8; ++mt)
#pragma unroll
                for (int nt = 0; nt < 4; ++nt)
#pragma unroll
                    for (int r = 0; r < 4; ++r) {
                        const int row = m0 + wm * 128 + mt * 16 + fq * 4 + r;
                        P[(size_t)row * PW + cb + nt * 16 + fr] = (u16)(pk2(acc[mt][nt][r], 0.f) & 0xffff);
                    }
        }
        if (transp) {
            const int tcb = (j >= 16) ? (cb - 1792) : (cb - 1280);
            const int b = m0 >> 12, u0 = m0 & 4095;
#pragma unroll
            for (int mt = 0; mt < 8; ++mt)
#pragma unroll
                for (int nt = 0; nt < 4; ++nt) {
                    const int tc = tcb + nt * 16 + fr;
                    const int u = u0 + wm * 128 + mt * 16 + fq * 4;
                    *(uint2*)(T + ((size_t)(b * TW + tc)) * UT + u) = uint2{pk2(acc[mt][nt][0], acc[mt][nt][1]), pk2(acc[mt][nt][2], acc[mt][nt][3])};
                }
        }
    }
}

DEV int map_col(int type, int n) {
    if (type == 0) return n;
    if (type == 1) {
        const int jb = n >> 5, r = n & 31;
        return r < 16 ? jb * 16 + r : DFF + jb * 16 + (r - 16);
    }
    if (n < 256) return 1552 + n;
    if (n < 640) return 2064 + (n - 256);
    if (n < 1024) return 2448 + (n - 640);
    if (n < 1280) return 1808 + (n - 1024);
    if (n < 1536) return (n - 1280);
    if (n < 1920) return 528 + (n - 1536);
    if (n < 2048) return 1296 + (n - 1920);
    if (n < 2304) return 256 + (n - 2048);
    if (n < 2688) return 912 + (n - 2304);
    if (n < 2816) return 1424 + (n - 2688);
    if (n < 2832) return 512 + (n - 2816);
    if (n < 2944) return -1;
    return 2832 + (n - 2944);
}

DEV void conv_tile(const float* __restrict__ src, int ld_src, int type, u16* __restrict__ dst, int ld_dst, int k_off, int kt, int ntile, char* smem, int tid) {
    float* lds = (float*)smem;
    const int k0 = kt * 64, n0 = ntile * 64;
    {
        const int r = tid >> 6, c = tid & 63;
        const int col = map_col(type, n0 + c);
#pragma unroll
        for (int i = 0; i < 16; ++i) {
            const int k = r + 4 * i;
            float v = 0.f;
            if (col >= 0) v = src[(size_t)(k0 + k) * ld_src + col];
            lds[k * 65 + c] = v;
        }
    }
    __syncthreads();
    {
        const int n = tid >> 2, kq = tid & 3;
        uint32_t w[8];
#pragma unroll
        for (int j = 0; j < 8; ++j) w[j] = pk2(lds[(kq * 16 + 2 * j) * 65 + n], lds[(kq * 16 + 2 * j + 1) * 65 + n]);
        u16* d = dst + (size_t)(n0 + n) * ld_dst + k_off + k0 + kq * 16;
        *(uint4*)d = uint4{w[0], w[1], w[2], w[3]};
        *(uint4*)(d + 8) = uint4{w[4], w[5], w[6], w[7]};
    }
    __syncthreads();
}

DEV void ph_prep(const Params& p, int l, char* smem, int bid, int G) {
    u16* W = WSP(u16, OFF_W);
    const int tid = VTID;
    constexpr int N_CONV = 6240, N_MODS = 288;
    for (int it = bid; it < N_CONV + N_MODS; it += G) {
        if (it < N_CONV) {
            int r = it;
            if (r < 2816) {
                const int which = r / 1408; r -= which * 1408;
                conv_tile(p.ffn_w_in + (size_t)(l * 2 + which) * 1024 * 5632, 5632, 1, W + (which ? WE_IN1 : WE_IN0), 1024, 0, r / 88, r % 88, smem, tid);
                continue;
            }
            r -= 2816;
            if (r < 1408) {
                const int which = r / 704; r -= which * 704;
                conv_tile(p.ffn_w_out + (size_t)(l * 2 + which) * 2816 * 1024, 1024, 0, W + (which ? WE_OUT1 : WE_OUT0), 2816, 0, r / 16, r % 16, smem, tid);
                continue;
            }
            r -= 1408;
            if (r < 1504) {
                conv_tile(p.mix_w_in + (size_t)l * 1024 * NIN, NIN, 2, W + WE_MIX, 1024, 0, r / 94, r % 94, smem, tid);
                continue;
            }
            r -= 1504;
            if (r < 64) { conv_tile(p.w_br_ml + (size_t)l * 256 * 1024, 1024, 0, W + WE_BR, 1024, 0, r / 16, r % 16, smem, tid); continue; }
            r -= 64;
            if (r < 96) { conv_tile(p.w_br_na + (size_t)l * 384 * 1024, 1024, 0, W + WE_BR, 1024, 256, r / 16, r % 16, smem, tid); continue; }
            r -= 96;
            if (r < 96) { conv_tile(p.w_br_gq + (size_t)l * 384 * 1024, 1024, 0, W + WE_BR, 1024, 640, r / 16, r % 16, smem, tid); continue; }
            r -= 96;
            conv_tile(p.w_out + (size_t)l * 1024 * 1024, 1024, 0, W + WE_O, 1024, 0, r / 16, r % 16, smem, tid);
        } else {
            const int cb = it - N_CONV;
            float* s = (float*)smem;
            float* red = s + 9 * 1024;
            for (int i = tid; i < 9 * 1024; i += 256) {
                const int b = i >> 10, k = i & 1023;
                const float v = b < 8 ? p.c[b * 1024 + k] : p.c_ctx[k];
                s[i] = v * sigmoidf_(v);
            }
            __syncthreads();
            const int kg = tid >> 5, c = tid & 31, col = cb * 32 + c;
            float a[9];
#pragma unroll
            for (int b = 0; b < 9; ++b) a[b] = 0.f;
            const float* wp = p.ada_w + (size_t)l * 1024 * 9216 + (size_t)(kg * 128) * 9216 + col;
#pragma unroll 16
            for (int k = 0; k < 128; ++k) {
                const float w = wp[(size_t)k * 9216];
#pragma unroll
                for (int b = 0; b < 9; ++b) a[b] += s[b * 1024 + kg * 128 + k] * w;
            }
#pragma unroll
            for (int b = 0; b < 9; ++b) red[(kg * 9 + b) * 32 + c] = a[b];
            __syncthreads();
            for (int i = tid; i < 288; i += 256) {
                const int b = i >> 5, cc = i & 31;
                float v = p.ada_b[l * 9216 + cb * 32 + cc];
#pragma unroll
                for (int g = 0; g < 8; ++g) v += red[(g * 9 + b) * 32 + cc];
                WSP(float, OFF_MODS)[b * 9216 + cb * 32 + cc] = v;
            }
            __syncthreads();
        }
    }
    if (l == 0) {
        const size_t gt = (size_t)bid * 256 + tid, gs = (size_t)G * 256;
        const float4* cs = (const float4*)p.ctx; float4* cd = WSP(float4, OFF_XC);
        for (size_t i = gt; i < (size_t)NCX * D / 4; i += gs) cd[i] = cs[i];
        float* rope = WSP(float, OFF_ROPE);
        for (size_t i = gt; i < (size_t)4096 * 32; i += gs) {
            const int t = (int)(i >> 5), f = (int)(i & 31);
            const float pos = (float)((f < 16) ? (t >> 6) : (t & 63));
            const float inv = powf(10000.f, -(float)(f & 15) / 16.f);
            float sn, cs_;
            sincosf(pos * inv, &sn, &cs_);
            rope[i * 2] = cs_;
            rope[i * 2 + 1] = sn;
        }
    }
}

DEV void ph_mod(const Params& p, int l, int sub, int nrows, int bid, int G) {
    const bool first = (l == 0 && sub == 0);
    const int lane = VTID & 63, gw = bid * 4 + (VTID >> 6), NW = G * 4;
    const float* nw = p.norm_w + (size_t)(l * 3 + sub) * 1024;
    const float* mods = WSP(float, OFF_MODS);
    u16* H = WSP(u16, OFF_H);
#pragma unroll 2
    for (int r = gw; r < nrows; r += NW) {
        const float* xr = r < NL ? (first ? p.x : p.out) + (size_t)r * D : (first ? p.ctx : WSP(float, OFF_XC)) + (size_t)(r - NL) * D;
        const int b9 = r < NL ? (r >> 12) : 8;
        const float* sh = mods + b9 * 9216 + (3 * sub) * 1024;
        const float* sc = sh + 1024;
        float4 v[4];
        float ss = 0.f;
        const bool fold = (r >= NL) && !first;
#pragma unroll
        for (int j = 0; j < 4; ++j) {
            v[j] = *(const float4*)(xr + lane * 4 + 256 * j);
            if (fold) {
#pragma unroll
                for (int ks = 0; ks < 4; ++ks) {
                    const float4 q4 = *(const float4*)(WSP(float, OFF_PART) + ((size_t)ks * NCX + (r - NL)) * D + lane * 4 + 256 * j);
                    v[j].x += q4.x; v[j].y += q4.y; v[j].z += q4.z; v[j].w += q4.w;
                }
                *(float4*)(WSP(float, OFF_XC) + (size_t)(r - NL) * D + lane * 4 + 256 * j) = v[j];
            }
            ss += v[j].x * v[j].x + v[j].y * v[j].y + v[j].z * v[j].z + v[j].w * v[j].w;
        }
        ss = wave_sum(ss);
        const float rstd = rsqrtf(ss * (1.f / 1024.f) + 1e-6f);
#pragma unroll
        for (int j = 0; j < 4; ++j) {
            const int k = lane * 4 + 256 * j;
            const float4 w = *(const float4*)(nw + k), s1 = *(const float4*)(sc + k), s0 = *(const float4*)(sh + k);
            const float y0 = v[j].x * rstd * w.x * (1.f + s1.x) + s0.x;
            const float y1 = v[j].y * rstd * w.y * (1.f + s1.y) + s0.y;
            const float y2 = v[j].z * rstd * w.z * (1.f + s1.z) + s0.z;
            const float y3 = v[j].w * rstd * w.w * (1.f + s1.w) + s0.w;
            *(uint2*)(H + (size_t)r * D + k) = uint2{pk2(y0, y1), pk2(y2, y3)};
        }
    }
}

DEV void ph_ffn_in(const Params& p, int which, int mt0, int mtiles, char* smem, int vid, int G) {
    const u16* H = WSP(u16, OFF_H);
    const u16* Wt = WSP(u16, OFF_W) + (which ? WE_IN1 : WE_IN0);
    u16* ACT = WSP(u16, OFF_P);
    const int lane = VTID & 63, wave = VTID >> 6, wm = wave >> 1, wn = wave & 1, fr = lane & 15, fq = lane >> 4;
    const int total = mtiles * 44;
    for (int t = vid; t < total; t += G) {
        int mt_, nt_;
        tile_decode(t, 44, mt_, nt_);
        mt_ += mt0;
        const int m0 = mt_ * 128, n0 = nt_ * 128;
        f32x4 acc[4][4];
        zero_acc<4>(acc);
        gemm_accum<4>(acc, H + (size_t)m0 * D, D, Wt + (size_t)n0 * D, D, D, smem, VTID);
#pragma unroll
        for (int mt = 0; mt < 4; ++mt)
#pragma unroll
            for (int pp = 0; pp < 2; ++pp)
#pragma unroll
                for (int r = 0; r < 4; ++r) {
                    const int row = m0 + wm * 64 + mt * 16 + fq * 4 + r;
                    const int hid = (n0 >> 1) + wn * 32 + pp * 16 + fr;
                    const float g = acc[mt][2 * pp][r], u = acc[mt][2 * pp + 1][r];
                    const float v = g * sigmoidf_(g) * u;
                    ACT[(size_t)row * DFF + hid] = (u16)(pk2(v, 0.f) & 0xffff);
                }
    }
}

DEV void ph_resid(const Params& p, const u16* A, int lda, const u16* Wt, int K, int modidx, float coef, int mt0, int mtiles, char* smem, int vid, int G) {
    const float* mods = WSP(float, OFF_MODS);
    const int lane = VTID & 63, wave = VTID >> 6, wm = wave >> 1, wn = wave & 1, fr = lane & 15, fq = lane >> 4;
    const int total = mtiles * 8 * 4;
    const int Kc = K >> 2;
    for (int t = vid; t < total; t += G) {
        int mt_, nt_;
        const int ksp = t & 3;
        tile_decode(t >> 2, 8, mt_, nt_);
        mt_ += mt0;
        const int m0 = mt_ * 128, n0 = nt_ * 128;
        f32x4 acc[4][4];
        zero_acc<4>(acc);
        gemm_accum<4>(acc, A + (size_t)m0 * lda + ksp * Kc, lda, Wt + (size_t)n0 * K + ksp * Kc, K, Kc, smem, VTID);
        const int b9 = m0 < NL ? (m0 >> 12) : 8;
        const float* gp = mods + b9 * 9216 + modidx * 1024;
#pragma unroll
        for (int nt = 0; nt < 4; ++nt) {
            const int col = n0 + wn * 64 + nt * 16 + fr;
            const float gv = gp[col] * coef;
#pragma unroll
            for (int mt = 0; mt < 4; ++mt)
#pragma unroll
                for (int r = 0; r < 4; ++r) {
                    const int row = m0 + wm * 64 + mt * 16 + fq * 4 + r;
                    WSP(float, OFF_PART)[((size_t)ksp * NCX + (row - NL)) * D + col] = gv * acc[mt][nt][r];
                }
        }
    }
}

DEV void ph_pgemm(const Params& p, int mt0, int mtiles, char* smem, int vid, int G) {
    const u16* H = WSP(u16, OFF_H);
    const u16* Wt = WSP(u16, OFF_W) + WE_MIX;
    u16* P = WSP(u16, OFF_P);
    u16* T = WSP(u16, OFF_T);
    float* Gt = WSP(float, OFF_G);
    const int lane = VTID & 63, wave = VTID >> 6, wm = wave >> 1, wn = wave & 1, fr = lane & 15, fq = lane >> 4;
    const int total = mtiles * 23;
    for (int t = vid; t < total; t += G) {
        int mt_, nt_;
        tile_decode(t, 23, mt_, nt_);
        mt_ += mt0;
        const int m0 = mt_ * 128, n0 = nt_ * 128;
        f32x4 acc[4][4];
        zero_acc<4>(acc);
        gemm_accum<4>(acc, H + (size_t)m0 * D, D, Wt + (size_t)n0 * D, D, D, smem, VTID);
        if (nt_ == 22) {
            if (wn == 0) {
#pragma unroll
                for (int mt = 0; mt < 4; ++mt)
#pragma unroll
                    for (int r = 0; r < 4; ++r) {
                        const int row = m0 + wm * 64 + mt * 16 + fq * 4 + r;
                        Gt[(size_t)row * 16 + fr] = acc[mt][0][r];
                    }
            }
            continue;
        }
        const bool rowmajor = nt_ < 16;
        const bool transp = (nt_ == 10) || (nt_ == 11) || (nt_ >= 16);
        if (rowmajor) {
#pragma unroll
            for (int mt = 0; mt < 4; ++mt)
#pragma unroll
                for (int nt = 0; nt < 4; ++nt)
#pragma unroll
                    for (int r = 0; r < 4; ++r) {
                        const int row = m0 + wm * 64 + mt * 16 + fq * 4 + r;
                        const int col = n0 + wn * 64 + nt * 16 + fr;
                        P[(size_t)row * PW + col] = (u16)(pk2(acc[mt][nt][r], 0.f) & 0xffff);
                    }
        }
        if (transp) {
            const int tcb = (nt_ >= 16) ? (n0 - 1792) : (n0 - 1280);
            int b, u0;
            if (m0 < NL) { b = m0 >> 12; u0 = m0 & 4095; } else { b = (m0 - NL) >> 8; u0 = SEQ + ((m0 - NL) & 255); }
#pragma unroll
            for (int mt = 0; mt < 4; ++mt)
#pragma unroll
                for (int nt = 0; nt < 4; ++nt) {
                    const int tc = tcb + wn * 64 + nt * 16 + fr;
                    const int u = u0 + wm * 64 + mt * 16 + fq * 4;
                    *(uint2*)(T + ((size_t)(b * TW + tc)) * UT + u) = uint2{pk2(acc[mt][nt][0], acc[mt][nt][1]), pk2(acc[mt][nt][2], acc[mt][nt][3])};
                }
        }
    }
}

DEV void ph_qknorm_gates(const Params& p, int l, int bid, int G) {
    const int lane = VTID & 63, gw = bid * 4 + (VTID >> 6), NW = G * 4;
    u16* P = WSP(u16, OFF_P);
    for (int it = gw; it < NSCAN * NCH; it += NW) {
        const int sc = it / NCH, c = it - sc * NCH, dir = sc & 1, h = (sc >> 1) & 3, b = sc >> 3;
        const float* Gt = WSP(float, OFF_G);
        float* BC = WSP(float, OFF_BC) + (size_t)sc * UT;
        float* IG = WSP(float, OFF_IG) + (size_t)sc * UT;
        float* WE = WSP(float, OFF_AE) + (size_t)sc * UT;
        const float bi = p.ml_gate_b[l * 16 + dir * 8 + h], bf = p.ml_gate_b[l * 16 + dir * 8 + 4 + h];
        const int cu = cu_of(c, dir);
        const int u = cu * 64 + (dir ? 63 - lane : lane);
        const int row = rowof(b, u);
        const float ig = Gt[(size_t)row * 16 + dir * 8 + h] + bi;
        const float fp = Gt[(size_t)row * 16 + dir * 8 + 4 + h] + bf;
        const float lf = fminf(fp, 0.f) - log1pf(expf(-fabsf(fp)));
        float bc = lf;
#pragma unroll
        for (int o = 1; o < 64; o <<= 1) { const float tv = __shfl_up(bc, o); if (lane >= o) bc += tv; }
        const float btot = __shfl(bc, 63);
        const float wend = btot - bc + ig;
        const float mx = wave_max(wend);
        WE[u] = wend;
        BC[u] = bc;
        IG[u] = ig;
        if (lane == 0) { WSP(float, OFF_MS)[sc * NCH + c] = btot; WSP(float, OFF_DEC)[sc * NCH + c] = mx; }
    }
    const float* rope = WSP(float, OFF_ROPE);
    const int hs = lane >> 4, e4 = (lane & 15) * 4;
    for (int r = NL + gw; r < MTOT; r += NW) {
        const bool latent = r < NL;
        const int tok = r & 4095;
#pragma unroll
        for (int g = 0; g < 5; ++g) {
            const int cbase = (g < 3 ? 256 + g * 256 : 1536 + (g - 3) * 256) + hs * 64 + e4;
            const int slot = g * 4 + hs;
            u16* pp = P + (size_t)r * PW + cbase;
            const uint2 raw = *(const uint2*)pp;
            float v0 = bflo(raw.x), v1 = bfhi(raw.x), v2 = bflo(raw.y), v3 = bfhi(raw.y);
            float ss = v0 * v0 + v1 * v1 + v2 * v2 + v3 * v3;
            ss += __shfl_xor(ss, 1); ss += __shfl_xor(ss, 2); ss += __shfl_xor(ss, 4); ss += __shfl_xor(ss, 8);
            const float* wv;
            float scl;
            bool do_rope;
            if (slot < 6) { wv = p.na_qk_w + (l * 2 + 0) * 64; scl = 0.125f; do_rope = false; }
            else if (slot < 12) { wv = p.gq_qk_w + (l * 2 + 0) * 64; scl = 0.125f; do_rope = latent; }
            else if (slot < 18) { wv = p.na_qk_w + (l * 2 + 1) * 64; scl = 1.f; do_rope = false; }
            else { wv = p.gq_qk_w + (l * 2 + 1) * 64; scl = 1.f; do_rope = latent; }
            const float rstd = rsqrtf(ss * (1.f / 64.f) + 1e-6f) * scl;
            const float4 w4 = *(const float4*)(wv + e4);
            v0 *= rstd * w4.x; v1 *= rstd * w4.y; v2 *= rstd * w4.z; v3 *= rstd * w4.w;
            const float o0 = __shfl_xor(v0, 8), o1 = __shfl_xor(v1, 8), o2 = __shfl_xor(v2, 8), o3 = __shfl_xor(v3, 8);
            if (do_rope) {
                const int fi = e4 & 31;
                const float4 cs01 = *(const float4*)(rope + ((size_t)tok * 32 + fi) * 2);
                const float4 cs23 = *(const float4*)(rope + ((size_t)tok * 32 + fi + 2) * 2);
                if (e4 < 32) {
                    v0 = v0 * cs01.x - o0 * cs01.y; v1 = v1 * cs01.z - o1 * cs01.w;
                    v2 = v2 * cs23.x - o2 * cs23.y; v3 = v3 * cs23.z - o3 * cs23.w;
                } else {
                    v0 = o0 * cs01.y + v0 * cs01.x; v1 = o1 * cs01.w + v1 * cs01.z;
                    v2 = o2 * cs23.y + v2 * cs23.x; v3 = o3 * cs23.w + v3 * cs23.z;
                }
            }
            *(uint2*)pp = uint2{pk2(v0, v1), pk2(v2, v3)};
        }
    }
}

template <int MT, bool NAMASK, int NWV>
DEV void flash_item(const Params& p, int b, int qrow0, int qcol, int kcol, int tcol, int ua, int n1, int ub, int ntiles,
                    int r_q, int rs, const float* __restrict__ rpb_h, char* smem, int ocol, float mfix = 0.f) {
    u16* P = WSP(u16, OFF_P);
    const u16* T = WSP(u16, OFF_T);
    const int tid = (NWV == 8) ? (int)(threadIdx.x + p.z) : VTID, lane = tid & 63, wave = tid >> 6, fr = lane & 15, fq = lane >> 4;
    constexpr int KVS = 64 * 144;
    char* Ks = smem;
    char* Vs = smem + 2 * KVS;
    float* rpb_s = (float*)(smem + 4 * KVS);
    __syncthreads();
    if (NAMASK) {
        for (int i = tid; i < 465; i += 256) rpb_s[i] = rpb_h[i] * 1.4426950408889634f;
    }
    Frag qf[MT][2];
#pragma unroll
    for (int mt = 0; mt < MT; ++mt)
#pragma unroll
        for (int ks = 0; ks < 2; ++ks)
            qf[mt][ks].q = *(const uint4*)(P + (size_t)(qrow0 + (wave * MT + mt) * 16 + fr) * PW + qcol + ks * 32 + fq * 8);
    const int lr = tid >> 3, lc8 = tid & 7;
    u32x4 rk0, rk1 = {0, 0, 0, 0}, rv0, rv1 = {0, 0, 0, 0};
#define FL_GLOAD(KT) do { const int kt_ = (KT); const int u0_ = kt_ < n1 ? ua + 64 * kt_ : ub + 64 * (kt_ - n1); const int row0_ = rowof(b, u0_); \
        rk0 = gld16(P + (size_t)(row0_ + lr) * PW + kcol + lc8 * 8); rv0 = gld16(T + ((size_t)(b * TW + tcol + lr)) * UT + u0_ + lc8 * 8); \
        if (NWV == 4) { rk1 = gld16(P + (size_t)(row0_ + lr + 32) * PW + kcol + lc8 * 8); rv1 = gld16(T + ((size_t)(b * TW + tcol + lr + 32)) * UT + u0_ + lc8 * 8); } } while (0)
#define FL_SSTORE(S) do { const int s_ = (S); \
        *(u32x4*)(Ks + s_ * KVS + lr * 144 + lc8 * 16) = rk0; *(u32x4*)(Vs + s_ * KVS + lr * 144 + lc8 * 16) = rv0; \
        if (NWV == 4) { *(u32x4*)(Ks + s_ * KVS + (lr + 32) * 144 + lc8 * 16) = rk1; *(u32x4*)(Vs + s_ * KVS + (lr + 32) * 144 + lc8 * 16) = rv1; } } while (0)
    FL_GLOAD(0);
    VM_WAIT0();
    FL_SSTORE(0);
    __syncthreads();
    f32x4 o[MT][4];
    float mrow[MT], lrow[MT];
#pragma unroll
    for (int mt = 0; mt < MT; ++mt) {
        mrow[mt] = -1e30f; lrow[mt] = 0.f;
#pragma unroll
        for (int dt = 0; dt < 4; ++dt) o[mt][dt] = f32x4{0.f, 0.f, 0.f, 0.f};
    }
    const float L2E = 1.4426950408889634f;
    for (int kt = 0; kt < ntiles; ++kt) {
        const int cur = kt & 1;
        const bool more = kt + 1 < ntiles;
        FL_GLOAD(more ? kt + 1 : kt);
        __builtin_amdgcn_sched_barrier(0);
        f32x4 s[MT][4];
#pragma unroll
        for (int mt = 0; mt < MT; ++mt)
#pragma unroll
            for (int nt = 0; nt < 4; ++nt) s[mt][nt] = f32x4{0.f, 0.f, 0.f, 0.f};
#pragma unroll
        for (int ks = 0; ks < 2; ++ks)
#pragma unroll
            for (int nt = 0; nt < 4; ++nt) {
                const bf16x8 kf = *(const bf16x8*)(Ks + cur * KVS + (nt * 16 + fr) * 144 + (ks * 32 + fq * 8) * 2);
#pragma unroll
                for (int mt = 0; mt < MT; ++mt) s[mt][nt] = mfma16(kf, qf[mt][ks].v, s[mt][nt]);
            }
        Frag pf[MT][2];
#pragma unroll
        for (int mt = 0; mt < MT; ++mt) {
            float rsum = 0.f;
            if (NAMASK && kt < 8) {
                const int qc = (wave * MT + mt) * 16 + fr;
                int cs = qc - 8; cs = cs < 0 ? 0 : (cs > 48 ? 48 : cs);
                const int brow = rs + kt - r_q + 7;
#pragma unroll
                for (int nt = 0; nt < 4; ++nt)
#pragma unroll
                    for (int r = 0; r < 4; ++r) {
                        const int kc = nt * 16 + fq * 4 + r;
                        const bool valid = (kc >= cs) && (kc < cs + 16);
                        const int bi = valid ? brow * 31 + (kc - qc + 15) : 0;
                        const float e = valid ? fexp2(fmaf(s[mt][nt][r], L2E, rpb_s[bi] - mfix)) : 0.f;
                        s[mt][nt][r] = e; rsum += e;
                    }
            } else {
#pragma unroll
                for (int nt = 0; nt < 4; ++nt)
#pragma unroll
                    for (int r = 0; r < 4; ++r) { const float e = fexp2(fmaf(s[mt][nt][r], L2E, -mfix)); s[mt][nt][r] = e; rsum += e; }
            }
            lrow[mt] += rsum;
#pragma unroll
            for (int ks = 0; ks < 2; ++ks) {
                pf[mt][ks].u[0] = pk2(s[mt][2 * ks][0], s[mt][2 * ks][1]);
                pf[mt][ks].u[1] = pk2(s[mt][2 * ks][2], s[mt][2 * ks][3]);
                pf[mt][ks].u[2] = pk2(s[mt][2 * ks + 1][0], s[mt][2 * ks + 1][1]);
                pf[mt][ks].u[3] = pk2(s[mt][2 * ks + 1][2], s[mt][2 * ks + 1][3]);
            }
        }
#pragma unroll
        for (int ks = 0; ks < 2; ++ks)
#pragma unroll
            for (int dt = 0; dt < 4; ++dt) {
                Frag vf;
                vf.d[0] = *(const uint2*)(Vs + cur * KVS + (dt * 16 + fr) * 144 + (ks * 32 + fq * 4) * 2);
                vf.d[1] = *(const uint2*)(Vs + cur * KVS + (dt * 16 + fr) * 144 + (ks * 32 + 16 + fq * 4) * 2);
#pragma unroll
                for (int mt = 0; mt < MT; ++mt) o[mt][dt] = mfma16(vf.v, pf[mt][ks].v, o[mt][dt]);
            }
        __builtin_amdgcn_sched_barrier(0);
        VM_WAIT0();
        FL_SSTORE(cur ^ 1);
        __syncthreads();
    }
#pragma unroll
    for (int mt = 0; mt < MT; ++mt) {
        const float inv = 1.f / xq_sum(lrow[mt]);
        u16* op = P + (size_t)(qrow0 + (wave * MT + mt) * 16 + fr) * PW + ocol;
#pragma unroll
        for (int dt = 0; dt < 4; ++dt)
            *(uint2*)(op + dt * 16 + fq * 4) = uint2{pk2(o[mt][dt][0] * inv, o[mt][dt][1] * inv), pk2(o[mt][dt][2] * inv, o[mt][dt][3] * inv)};
    }
}


DEV void m2_item(const Params& p, int sc, int c) {
    const u16* T = WSP(u16, OFF_T);
    const int lane = VTID & 63, wave = VTID >> 6, fr = lane & 15, fq = lane >> 4;
    const int dir = sc & 1, h = (sc >> 1) & 3, b = sc >> 3;
    const int u0 = cu_of(c, dir) * 64;
    const float* AE = WSP(float, OFF_AE) + (size_t)sc * UT + u0;
    float* S = WSP(float, OFF_S) + ((size_t)sc * NCH + c) * SCH;
    const float mnew = fmaxf(WSP(float, OFF_MS)[sc * NCH + c] + m_scan(p, sc, c), WSP(float, OFF_DEC)[sc * NCH + c]);
    f32x4 acc[4], accn[4];
#pragma unroll
    for (int nt = 0; nt < 4; ++nt) { acc[nt] = f32x4{0.f, 0.f, 0.f, 0.f}; accn[nt] = f32x4{0.f, 0.f, 0.f, 0.f}; }
    Frag ones;
    ones.u[0] = ones.u[1] = ones.u[2] = ones.u[3] = 0x3F803F80u;
#pragma unroll
    for (int ks = 0; ks < 2; ++ks) {
        Frag vf;
        vf.q = *(const uint4*)(T + ((size_t)(b * TW + TC_MLV + h * 64 + wave * 16 + fr)) * UT + u0 + ks * 32 + fq * 8);
        float4 a0 = *(const float4*)(AE + ks * 32 + fq * 8), a1 = *(const float4*)(AE + ks * 32 + fq * 8 + 4);
        a0.x = expf(a0.x - mnew); a0.y = expf(a0.y - mnew); a0.z = expf(a0.z - mnew); a0.w = expf(a0.w - mnew);
        a1.x = expf(a1.x - mnew); a1.y = expf(a1.y - mnew); a1.z = expf(a1.z - mnew); a1.w = expf(a1.w - mnew);
#pragma unroll
        for (int nt = 0; nt < 4; ++nt) {
            Frag kf, kb;
            kf.q = *(const uint4*)(T + ((size_t)(b * TW + TC_MLK + h * 64 + nt * 16 + fr)) * UT + u0 + ks * 32 + fq * 8);
            kb.u[0] = pk2(bflo(kf.u[0]) * a0.x * 0.125f, bfhi(kf.u[0]) * a0.y * 0.125f);
            kb.u[1] = pk2(bflo(kf.u[1]) * a0.z * 0.125f, bfhi(kf.u[1]) * a0.w * 0.125f);
            kb.u[2] = pk2(bflo(kf.u[2]) * a1.x * 0.125f, bfhi(kf.u[2]) * a1.y * 0.125f);
            kb.u[3] = pk2(bflo(kf.u[3]) * a1.z * 0.125f, bfhi(kf.u[3]) * a1.w * 0.125f);
            acc[nt] = mfma16(vf.v, kb.v, acc[nt]);
            if (wave == 0) accn[nt] = mfma16(ones.v, kb.v, accn[nt]);
        }
    }
#pragma unroll
    for (int nt = 0; nt < 4; ++nt) {
#pragma unroll
        for (int r = 0; r < 4; ++r) S[(wave * 16 + fq * 4 + r) * 64 + nt * 16 + fr] = acc[nt][r];
        if (wave == 0 && fq == 0) S[4096 + nt * 16 + fr] = accn[nt][0];
    }
}

DEV void ph_m3(const Params& p, int bid, int G) {
    const float* DEC = WSP(float, OFF_DEC);
    float* S = WSP(float, OFF_S);
    const int total = NSCAN * SCH;
    for (int i = bid * 256 + VTID; i < total; i += G * 256) {
        const int sc = i / SCH, e = i - sc * SCH;
        float* base = S + (size_t)sc * NCH * SCH + e;
        const float* mxp = DEC + sc * NCH;
        const float* btp = WSP(float, OFF_MS) + sc * NCH;
        float st = 0.f, m = 0.f;
#pragma unroll 17
        for (int c = 0; c < NCH; ++c) {
            const float tmp = base[(size_t)c * SCH];
            base[(size_t)c * SCH] = st;
            const float bm = btp[c] + m;
            const float mnew = fmaxf(bm, mxp[c]);
            st = expf(bm - mnew) * st + tmp;
            m = mnew;
        }
    }
}

DEV void m4_item(const Params& p, int l, int b, int h, int cu, int ocolbase) {
    u16* P = WSP(u16, OFF_P);
    const u16* T = WSP(u16, OFF_T);
    const int lane = VTID & 63, wave = VTID >> 6, fr = lane & 15, fq = lane >> 4;
    const int u0 = cu * 64;
    const int row0 = rowof(b, u0);
    const int j = wave * 16 + fr;
    Frag qf[2];
#pragma unroll
    for (int ks = 0; ks < 2; ++ks) qf[ks].q = *(const uint4*)(P + (size_t)(row0 + j) * PW + PC_MLQ + h * 64 + ks * 32 + fq * 8);
    f32x4 hsum[4];
#pragma unroll
    for (int dt = 0; dt < 4; ++dt) hsum[dt] = f32x4{0.f, 0.f, 0.f, 0.f};
#pragma unroll 1
    for (int dir = 0; dir < 2; ++dir) {
        const int sc = (b * 4 + h) * 2 + dir;
        int c;
        if (cu >= 64) c = dir ? 3 - (cu - 64) : (cu - 64); else c = 4 + (dir ? 63 - cu : cu);
        const float m0 = m_scan(p, sc, c);
        const float* BC = WSP(float, OFF_BC) + (size_t)sc * UT + u0;
        const float* IG = WSP(float, OFF_IG) + (size_t)sc * UT + u0;
        const float* S = WSP(float, OFF_S) + ((size_t)sc * NCH + c) * SCH;
        const float bj = BC[j];
        f32x4 s[4];
#pragma unroll
        for (int nt = 0; nt < 4; ++nt) s[nt] = f32x4{0.f, 0.f, 0.f, 0.f};
#pragma unroll
        for (int ks = 0; ks < 2; ++ks)
#pragma unroll
            for (int nt = 0; nt < 4; ++nt) {
                Frag kf;
                kf.q = *(const uint4*)(P + (size_t)(row0 + nt * 16 + fr) * PW + PC_MLK + h * 64 + ks * 32 + fq * 8);
                s[nt] = mfma16(kf.v, qf[ks].v, s[nt]);
            }
        float lw[4][4];
        float mx = -1e30f;
#pragma unroll
        for (int nt = 0; nt < 4; ++nt) {
            const float4 bs = *(const float4*)(BC + nt * 16 + fq * 4);
            const float4 is = *(const float4*)(IG + nt * 16 + fq * 4);
            const float bsv[4] = {bs.x, bs.y, bs.z, bs.w}, isv[4] = {is.x, is.y, is.z, is.w};
#pragma unroll
            for (int r = 0; r < 4; ++r) {
                const int sidx = nt * 16 + fq * 4 + r;
                const bool valid = dir ? (sidx >= j) : (sidx <= j);
                lw[nt][r] = valid ? (bj - bsv[r] + isv[r]) : -1e30f;
                mx = fmaxf(mx, lw[nt][r]);
            }
        }
        mx = xq_max(mx);
        const float minter = bj + m0;
        const float mj = fmaxf(minter, mx);
        const float g = fexp(minter - mj);
        float den = 0.f;
#pragma unroll
        for (int nt = 0; nt < 4; ++nt)
#pragma unroll
            for (int r = 0; r < 4; ++r) {
                const float w = fexp(lw[nt][r] - mj);
                const float qk = s[nt][r] * 0.125f * w;
                s[nt][r] = qk;
                den += qk;
            }
        den = xq_sum(den);
        Frag pf[2];
#pragma unroll
        for (int ks = 0; ks < 2; ++ks) {
            pf[ks].u[0] = pk2(s[2 * ks][0], s[2 * ks][1]);
            pf[ks].u[1] = pk2(s[2 * ks][2], s[2 * ks][3]);
            pf[ks].u[2] = pk2(s[2 * ks + 1][0], s[2 * ks + 1][1]);
            pf[ks].u[3] = pk2(s[2 * ks + 1][2], s[2 * ks + 1][3]);
        }
        f32x4 acc[4], accn = f32x4{0.f, 0.f, 0.f, 0.f};
#pragma unroll
        for (int dt = 0; dt < 4; ++dt) acc[dt] = f32x4{0.f, 0.f, 0.f, 0.f};
#pragma unroll
        for (int ks = 0; ks < 2; ++ks) {
            {
                const float4 n0 = *(const float4*)(S + 4096 + ks * 32 + fq * 8), n1 = *(const float4*)(S + 4096 + ks * 32 + fq * 8 + 4);
                Frag nf;
                nf.u[0] = pk2(n0.x, n0.y); nf.u[1] = pk2(n0.z, n0.w); nf.u[2] = pk2(n1.x, n1.y); nf.u[3] = pk2(n1.z, n1.w);
                accn = mfma16(nf.v, qf[ks].v, accn);
            }
#pragma unroll
            for (int dt = 0; dt < 4; ++dt) {
                const float* cp = S + (dt * 16 + fr) * 64 + ks * 32 + fq * 8;
                const float4 c0 = *(const float4*)cp, c1 = *(const float4*)(cp + 4);
                Frag cf;
                cf.u[0] = pk2(c0.x, c0.y); cf.u[1] = pk2(c0.z, c0.w); cf.u[2] = pk2(c1.x, c1.y); cf.u[3] = pk2(c1.z, c1.w);
                acc[dt] = mfma16(cf.v, qf[ks].v, acc[dt]);
            }
        }
#pragma unroll
        for (int dt = 0; dt < 4; ++dt) acc[dt] *= g;
        den += g * accn[0];
#pragma unroll
        for (int ks = 0; ks < 2; ++ks)
#pragma unroll
            for (int dt = 0; dt < 4; ++dt) {
                const u16* vp = T + ((size_t)(b * TW + TC_MLV + h * 64 + dt * 16 + fr)) * UT + u0 + ks * 32 + fq * 4;
                Frag vf;
                vf.d[0] = *(const uint2*)vp;
                vf.d[1] = *(const uint2*)(vp + 16);
                acc[dt] = mfma16(vf.v, pf[ks].v, acc[dt]);
            }
        const float dd = 1.f / fmaxf(fabsf(den), fexp(-mj));
#pragma unroll
        for (int dt = 0; dt < 4; ++dt) hsum[dt] += acc[dt] * dd;
    }
    float ss = 0.f;
#pragma unroll
    for (int dt = 0; dt < 4; ++dt)
#pragma unroll
        for (int r = 0; r < 4; ++r) ss += hsum[dt][r] * hsum[dt][r];
    ss = xq_sum(ss);
    const float rstd = rsqrtf(ss * (1.f / 64.f) + 1e-6f);
    const float* nw = p.ml_norm_w + l * 256 + h * 64;
    u16* orow = P + (size_t)(row0 + j) * PW;
#pragma unroll
    for (int dt = 0; dt < 4; ++dt) {
        const int v0 = dt * 16 + fq * 4;
        const float4 w4 = *(const float4*)(nw + v0);
        const uint2 og = *(const uint2*)(orow + PC_MLO + h * 64 + v0);
        const float y0 = hsum[dt][0] * rstd * w4.x * sigmoidf_(bflo(og.x));
        const float y1 = hsum[dt][1] * rstd * w4.y * sigmoidf_(bfhi(og.x));
        const float y2 = hsum[dt][2] * rstd * w4.z * sigmoidf_(bflo(og.y));
        const float y3 = hsum[dt][3] * rstd * w4.w * sigmoidf_(bfhi(og.y));
        *(uint2*)(orow + ocolbase + h * 64 + v0) = uint2{pk2(y0, y1), pk2(y2, y3)};
    }
}

DEV void ph_attn8(const Params& p, int l, char* smem0, int rbid, int RG) {
    const int n_gq = 768, n_c = (l == 0) ? 96 : 0;
    const int ln_ = (int)((threadIdx.x + p.z) & 63);
    const float bgq = 8.f * wave_max(fabsf(p.gq_qk_w[(l * 2 + 0) * 64 + ln_])) * wave_max(fabsf(p.gq_qk_w[(l * 2 + 1) * 64 + ln_])) * 1.4426950408889634f * 1.03f + 0.5f;
    const float bna = 8.f * wave_max(fabsf(p.na_qk_w[(l * 2 + 0) * 64 + ln_])) * wave_max(fabsf(p.na_qk_w[(l * 2 + 1) * 64 + ln_])) * 1.4426950408889634f * 1.03f + 0.5f;
    for (int it = rbid; it < n_gq + n_c; it += RG) {
        float mfix = bgq;
        int b, qrow0, qcol, kcol, tcol, ua, nt;
        if (it < n_gq) {
            const int qt = it & 15, hq = (it >> 4) % 6;
            b = it / 96; qrow0 = b * SEQ + qt * 256; qcol = PC_GQQ + hq * 64; kcol = PC_GQK + (hq / 3) * 64; tcol = TC_GQV + (hq / 3) * 64; ua = 0; nt = 68;
        } else {
            const int r = it - n_gq;
            const int kind = r / 48, rr = r % 48, hh = rr % 6;
            b = rr / 6; qrow0 = NL + b * CTXL; ua = SEQ; nt = 4;
            if (kind == 0) { qcol = PC_GQQ + hh * 64; kcol = PC_GQK + (hh / 3) * 64; tcol = TC_GQV + (hh / 3) * 64; }
            else { qcol = PC_NAQ + hh * 64; kcol = PC_NAK + hh * 64; tcol = TC_NAV + hh * 64; mfix = bna; }
        }
        flash_item<2, false, 8>(p, b, qrow0, qcol, kcol, tcol, ua, nt, 0, nt, 0, 0, nullptr, smem0, qcol, mfix);
    }
}
DEV void ph_attn(const Params& p, int l, char* smem, int bid, int G, int rep) {
    const int n_na = 3072, n_m2 = NSCAN * NCH;
    const int total = n_na + n_m2;
    const int ln_ = VTID & 63;
    float rmax = 0.f;
    for (int i = ln_; i < 6 * 465; i += 64) rmax = fmaxf(rmax, fabsf(p.na_rpb[(size_t)l * 6 * 465 + i]));
    const float mfix_na = (8.f * wave_max(fabsf(p.na_qk_w[(l * 2 + 0) * 64 + ln_])) * wave_max(fabsf(p.na_qk_w[(l * 2 + 1) * 64 + ln_])) * 1.03f + wave_max(rmax)) * 1.4426950408889634f + 0.5f;
    for (int it = bid; it < total; it += G) {
        int r = it;
        if (r < n_na) {
            const int gr = r & 63, hn = (r >> 6) % 6, b = r / 384;
            int rs = gr - 4; rs = rs < 0 ? 0 : (rs > 56 ? 56 : rs);
            flash_item<1, true, 4>(p, b, b * SEQ + gr * 64, PC_NAQ + hn * 64, PC_NAK + hn * 64, TC_NAV + hn * 64, rs * 64, 8, SEQ, 12, gr, rs,
                                p.na_rpb + (size_t)(l * 6 + hn) * 465, smem, PC_NAQ + hn * 64 + (rep ? 1792 : 0), mfix_na);
            continue;
        }
        r -= n_na;
        m2_item(p, r / NCH, r % NCH);
    }
}

DEV void ph_m4(const Params& p, int l, int bid, int G, int rep) {
    const int nch = (l == 0) ? NCH : 64;
    const int total = NB * 4 * nch;
    for (int it = bid; it < total; it += G) {
        const int cu = it % nch, h = (it / nch) & 3, b = it / (nch * 4);
        m4_item(p, l, b, h, cu, rep ? 2048 : PC_MLQ);
    }
}

DEV void ph_merge(const Params& p, int mt0, int mtiles, char* smem, int vid, int G) {
    const u16* H = WSP(u16, OFF_H);
    u16* P = WSP(u16, OFF_P);
    const u16* Wg = WSP(u16, OFF_W) + WE_MIX + (size_t)2944 * 1024;
    const u16* Wbr = WSP(u16, OFF_W) + WE_BR;
    const int lane = VTID & 63, wave = VTID >> 6, wm = wave >> 1, wn = wave & 1, fr = lane & 15, fq = lane >> 4;
    const int total = mtiles * 16;
    for (int t = vid; t < total; t += G) {
        int mt_, nt_;
        tile_decode(t, 16, mt_, nt_);
        mt_ += mt0;
        const int m0 = mt_ * 128, n0 = nt_ * 64;
        f32x4 y[4][2];
        zero_acc<2>(y);
#pragma unroll 1
        for (int br = 0; br < 3; ++br) {
            const int ko = br == 0 ? 0 : (br == 1 ? 256 : 640);
            const int kk = br == 0 ? 256 : 384;
            f32x4 g[4][2];
            zero_acc<2>(g);
            gemm_accum<2>(g, H + (size_t)m0 * D, D, Wg + (size_t)(br * 1024 + n0) * D, D, D, smem, VTID);
#pragma unroll
            for (int i = 0; i < 4; ++i)
#pragma unroll
                for (int jn = 0; jn < 2; ++jn)
#pragma unroll
                    for (int r = 0; r < 4; ++r) g[i][jn][r] = sigmoidf_(g[i][jn][r]);
            f32x4 a[4][2];
            zero_acc<2>(a);
            gemm_accum<2>(a, P + (size_t)m0 * PW + ko, PW, Wbr + (size_t)n0 * D + ko, D, kk, smem, VTID);
#pragma unroll
            for (int i = 0; i < 4; ++i)
#pragma unroll
                for (int jn = 0; jn < 2; ++jn) y[i][jn] += g[i][jn] * a[i][jn];
        }
#pragma unroll
        for (int mt = 0; mt < 4; ++mt)
#pragma unroll
            for (int nt = 0; nt < 2; ++nt)
#pragma unroll
                for (int r = 0; r < 4; ++r) {
                    const int row = m0 + wm * 64 + mt * 16 + fq * 4 + r;
                    const int col = n0 + wn * 32 + nt * 16 + fr;
                    P[(size_t)row * PW + PC_Y + col] = (u16)(pk2(y[mt][nt][r], 0.f) & 0xffff);
                }
    }
}


#ifdef DBG
constexpr size_t OFF_DBG = al256(WS_END);
__global__ void __launch_bounds__(64) dbg_mlstm(Params p, int l) {
    const int sc = blockIdx.x, dir = sc & 1, h = (sc >> 1) & 3, b = sc >> 3, lane = VTID;
    const u16* P = WSP(u16, OFF_P); const u16* T = WSP(u16, OFF_T); const float* Gt = WSP(float, OFF_G);
    float* HN = WSP(float, OFF_S) + (size_t)sc * UT * 64;
    const float bi = p.ml_gate_b[l * 16 + dir * 8 + h], bf = p.ml_gate_b[l * 16 + dir * 8 + 4 + h];
    float C[64], n[64];
    for (int k = 0; k < 64; ++k) { C[k] = 0.f; n[k] = 0.f; }
    float m = 0.f;
    for (int pos = 0; pos < UT; ++pos) {
        int u;
        if (pos < 256) u = SEQ + (dir ? 255 - pos : pos); else u = dir ? 4095 - (pos - 256) : (pos - 256);
        const int row = rowof(b, u);
        const float ig = Gt[(size_t)row * 16 + dir * 8 + h] + bi;
        const float fp = Gt[(size_t)row * 16 + dir * 8 + 4 + h] + bf;
        const float lf = fminf(fp, 0.f) - log1pf(expf(-fabsf(fp)));
        const float mn = fmaxf(lf + m, ig);
        const float fw = expf(lf + m - mn), iw = expf(ig - mn);
        m = mn;
        const float qv = __uint_as_float(((uint32_t)P[(size_t)row * PW + 2048 + h * 64 + lane]) << 16);
        const float kv = __uint_as_float(((uint32_t)P[(size_t)row * PW + PC_MLK + h * 64 + lane]) << 16) * 0.125f;
        const float vv = __uint_as_float(((uint32_t)T[((size_t)(b * TW + TC_MLV + h * 64 + lane)) * UT + u]) << 16);
        float num = 0.f, den = 0.f;
#pragma unroll
        for (int k = 0; k < 64; ++k) {
            const float kk = __shfl(kv, k), qq = __shfl(qv, k);
            C[k] = fw * C[k] + iw * kk * vv;
            n[k] = fw * n[k] + iw * kk;
            num += qq * C[k];
            den += qq * n[k];
        }
        HN[(size_t)u * 64 + lane] = num / fmaxf(fabsf(den), expf(-m));
    }
}
__global__ void dbg_cmp(Params p, int l) {
    const int gid = blockIdx.x * blockDim.x + VTID;
    const u16* P = WSP(u16, OFF_P); const u16* T = WSP(u16, OFF_T);
    unsigned* dw = (unsigned*)(p.ws + OFF_DBG);
    float* df = (float*)(p.ws + OFF_DBG);
    if (gid < NB * 4 * UT) {
        const int u = gid % UT, h = (gid / UT) & 3, b = gid / (UT * 4);
        const int row = rowof(b, u);
        const float* hf = WSP(float, OFF_S) + ((size_t)((b * 4 + h) * 2 + 0) * UT + u) * 64;
        const float* hb = WSP(float, OFF_S) + ((size_t)((b * 4 + h) * 2 + 1) * UT + u) * 64;
        float ss = 0.f;
        for (int v = 0; v < 64; ++v) { const float x = hf[v] + hb[v]; ss += x * x; }
        const float rstd = rsqrtf(ss / 64.f + 1e-6f);
        float md = 0.f;
        for (int v = 0; v < 64; ++v) {
            const float x = (hf[v] + hb[v]) * rstd * p.ml_norm_w[l * 256 + h * 64 + v];
            const float o = __uint_as_float(((uint32_t)P[(size_t)row * PW + PC_MLO + h * 64 + v]) << 16);
            const float y = x / (1.f + expf(-o));
            const float got = __uint_as_float(((uint32_t)P[(size_t)row * PW + PC_MLQ + h * 64 + v]) << 16);
            md += fabsf(y - got);
        }
        atomicAdd(df + (u < SEQ ? 0 : 1), md * (1.f / 64.f));
        return;
    }
    const int w = (gid - NB * 4 * UT) >> 6;
    const int lane = VTID & 63;
    int type, b, qrow, qc, kcol, tcol, ocol, hn = 0, gr = 0, gc = 0, nkeys;
    if (w < 6144) {
        type = 0; const int i = w & 127; hn = (w >> 7) % 6; b = w / 768;
        gr = i & 63; gc = (i < 64) ? gr : 63 - gr;
        qrow = b * SEQ + gr * 64 + gc; qc = 2048 + 256 + hn * 64; kcol = PC_NAK + hn * 64; tcol = TC_NAV + hn * 64; ocol = PC_NAQ + hn * 64; nkeys = 384;
    } else if (w < 6144 + 256) {
        type = 1; const int x = w - 6144; const int i = x & 15, hh = (x >> 4) & 1; b = x >> 5;
        qrow = b * SEQ + (i * 273) % 4096; qc = 2688 + hh * 64; kcol = PC_GQK + hh * 64; tcol = TC_GQV + hh * 64; ocol = PC_GQQ + hh * 3 * 64; nkeys = 4352;
    } else if (w < 6144 + 256 + 768) {
        type = 2; const int x = w - 6400; const int i = x & 15; hn = (x >> 4) % 6; b = x / 96;
        qrow = NL + b * CTXL + (i * 17) % 256; qc = 2048 + 256 + hn * 64; kcol = PC_NAK + hn * 64; tcol = TC_NAV + hn * 64; ocol = PC_NAQ + hn * 64; nkeys = 256;
    } else if (w < 6144 + 256 + 768 + 256) {
        type = 3; const int x = w - 7168; const int i = x & 15, hh = (x >> 4) & 1; b = x >> 5;
        qrow = NL + b * CTXL + (i * 17) % 256; qc = 2688 + hh * 64; kcol = PC_GQK + hh * 64; tcol = TC_GQV + hh * 64; ocol = PC_GQQ + hh * 3 * 64; nkeys = 256;
    } else return;
    const float q = __uint_as_float(((uint32_t)P[(size_t)qrow * PW + qc + lane]) << 16);
    float o = 0.f;
    int rs = gr - 4; rs = rs < 0 ? 0 : (rs > 56 ? 56 : rs);
    int cs = gc - 8; cs = cs < 0 ? 0 : (cs > 48 ? 48 : cs);
    float mx = -1e30f, lsum = 0.f;
    for (int kidx = 0; kidx < nkeys; ++kidx) {
        int u; float bias = 0.f;
        if (type == 0) {
            if (kidx < 128) {
                const int ri = kidx >> 4, ci = kidx & 15;
                u = (rs + ri) * 64 + cs + ci;
                bias = p.na_rpb[(size_t)(l * 6 + hn) * 465 + (rs + ri - gr + 7) * 31 + (cs + ci - gc + 15)];
            } else u = SEQ + (kidx - 128);
        } else if (type == 1) u = kidx;
        else u = SEQ + kidx;
        const int krow = rowof(b, u);
        float sdot = wave_sum(q * __uint_as_float(((uint32_t)P[(size_t)krow * PW + kcol + lane]) << 16));
        sdot += bias;
        const float mn = fmaxf(mx, sdot);
        const float al = expf(mx - mn), e = expf(sdot - mn);
        lsum = lsum * al + e; mx = mn;
        o = o * al + e * __uint_as_float(((uint32_t)T[((size_t)(b * TW + tcol + lane)) * UT + u]) << 16);
    }
    const float got = __uint_as_float(((uint32_t)P[(size_t)qrow * PW + ocol + lane]) << 16);
    float md = wave_max(fabsf(o / lsum - got));
    if (lane == 0) atomicMax(dw + 2 + type, __float_as_uint(md));
}
__global__ void dbg_copy(Params p) {
    u16* P = WSP(u16, OFF_P);
    for (size_t i = (size_t)blockIdx.x * 256 + VTID; i < (size_t)MTOT * 768; i += (size_t)gridDim.x * 256) {
        const size_t row = i / 768, c = i % 768;
        const size_t src = c < 640 ? c : (c < 704 ? PC_GQQ + (c - 640) : PC_GQQ + 192 + (c - 704));
        P[row * PW + 2048 + c] = P[row * PW + src];
    }
}
DEV int dbg_row(int sr) { return sr < 8 ? sr * 4096 + (sr * 577 + 13) % 4096 : NL + (sr - 8) * 256 + ((sr - 8) * 37 + 5) % 256; }
DEV float* dbg_xrow(const Params& p, int row) { return row < NL ? p.out + (size_t)row * D : WSP(float, OFF_XC) + (size_t)(row - NL) * D; }
DEV float dbg_mod(const Params& p, int l, int b9, int idx, int n) {
    float a = p.ada_b[l * 9216 + idx * 1024 + n];
    for (int k = 0; k < 1024; ++k) {
        const float c = b9 < 8 ? p.c[b9 * 1024 + k] : p.c_ctx[k];
        a += c / (1.f + expf(-c)) * p.ada_w[((size_t)l * 1024 + k) * 9216 + idx * 1024 + n];
    }
    return a;
}
DEV float blk_sum(float v, float* red) {
    v = wave_sum(v);
    __syncthreads();
    if ((VTID & 63) == 0) red[VTID >> 6] = v;
    __syncthreads();
    return red[0] + red[1] + red[2] + red[3];
}
DEV float blk_max(float v, float* red) {
    v = wave_max(v);
    __syncthreads();
    if ((VTID & 63) == 0) red[VTID >> 6] = v;
    __syncthreads();
    return fmaxf(fmaxf(red[0], red[1]), fmaxf(red[2], red[3]));
}
__global__ void dbg_save(Params p, int slot) {
    const int sr = blockIdx.x, row = dbg_row(sr);
    float* dst = (float*)(p.ws + OFF_DBG + 256) + ((size_t)slot * 16 + sr) * 1024;
    const float* src = dbg_xrow(p, row);
    for (int n = VTID; n < 1024; n += 256) dst[n] = src[n];
}
DEV float dbg_modulate(const Params& p, int l, int sub, int b9, const float* xs, float* hs, float* red) {
    float ss = 0.f;
    for (int n = VTID; n < 1024; n += 256) ss += xs[n] * xs[n];
    ss = blk_sum(ss, red);
    const float rstd = rsqrtf(ss / 1024.f + 1e-6f);
    float md = 0.f;
    for (int n = VTID; n < 1024; n += 256) {
        const float sh = dbg_mod(p, l, b9, 3 * sub, n), sc = dbg_mod(p, l, b9, 3 * sub + 1, n);
        md = fmaxf(md, fabsf(sh - WSP(float, OFF_MODS)[b9 * 9216 + (3 * sub) * 1024 + n]));
        md = fmaxf(md, fabsf(sc - WSP(float, OFF_MODS)[b9 * 9216 + (3 * sub + 1) * 1024 + n]));
        hs[n] = xs[n] * rstd * p.norm_w[(l * 3 + sub) * 1024 + n] * (1.f + sc) + sh;
    }
    __syncthreads();
    return md;
}
__global__ void __launch_bounds__(256) dbg_ffn(Params p, int l, int which, int slot, int bit) {
    __shared__ float xs[1024], hs[1024], gs[1024], as[2816], red[4];
    const int sr = blockIdx.x, row = dbg_row(sr), b9 = row < NL ? row >> 12 : 8, sub = which ? 2 : 0;
    const float* xin = (const float*)(p.ws + OFF_DBG + 256) + ((size_t)slot * 16 + sr) * 1024;
    for (int n = VTID; n < 1024; n += 256) xs[n] = xin[n];
    __syncthreads();
    float mdm = dbg_modulate(p, l, sub, b9, xs, hs, red);
    for (int n = VTID; n < 1024; n += 256) gs[n] = dbg_mod(p, l, b9, 3 * sub + 2, n);
    const float* win = p.ffn_w_in + (size_t)(l * 2 + which) * 1024 * 5632;
    const float* wout = p.ffn_w_out + (size_t)(l * 2 + which) * 2816 * 1024;
    for (int j = VTID; j < 2816; j += 256) {
        float g = 0.f, u = 0.f;
        for (int k = 0; k < 1024; ++k) { g += hs[k] * win[(size_t)k * 5632 + j]; u += hs[k] * win[(size_t)k * 5632 + 2816 + j]; }
        as[j] = g / (1.f + expf(-g)) * u;
    }
    __syncthreads();
    float md = 0.f;
    const float* xc = dbg_xrow(p, row);
    for (int n = VTID; n < 1024; n += 256) {
        float o = 0.f;
        for (int j = 0; j < 2816; ++j) o += as[j] * wout[(size_t)j * 1024 + n];
        md = fmaxf(md, fabsf(xs[n] + 0.5f * gs[n] * o - xc[n]));
    }
    md = blk_max(md, red);
    mdm = blk_max(mdm, red);
    unsigned* dw = (unsigned*)(p.ws + OFF_DBG);
    if (VTID == 0) { atomicMax(dw + bit, __float_as_uint(md)); atomicMax(dw + 15, __float_as_uint(mdm)); }
}
__global__ void __launch_bounds__(256) dbg_pchk(Params p, int l) {
    __shared__ float xs[1024], hs[1024], red[4];
    const int sr = blockIdx.x, row = dbg_row(sr), b9 = row < NL ? row >> 12 : 8;
    const float* xin = dbg_xrow(p, row);
    for (int n = VTID; n < 1024; n += 256) xs[n] = xin[n];
    __syncthreads();
    float mdm = dbg_modulate(p, l, 1, b9, xs, hs, red);
    const float* w = p.mix_w_in + (size_t)l * 1024 * NIN;
    const u16* P = WSP(u16, OFF_P); const u16* T = WSP(u16, OFF_T);
    int b, u;
    if (row < NL) { b = row >> 12; u = row & 4095; } else { b = (row - NL) >> 8; u = SEQ + ((row - NL) & 255); }
    float md = 0.f;
    for (int n = VTID; n < 2832; n += 256) {
        const int sc = map_col(2, n);
        float v = 0.f;
        for (int k = 0; k < 1024; ++k) v += hs[k] * w[(size_t)k * NIN + sc];
        if (n < 2048) md = fmaxf(md, fabsf(v - __uint_as_float(((uint32_t)P[(size_t)row * PW + n]) << 16)));
        if (n >= 1280 && n < 1536) md = fmaxf(md, fabsf(v - __uint_as_float(((uint32_t)T[((size_t)(b * TW + n - 1280)) * UT + u]) << 16)));
        if (n >= 2048 && n < 2816) md = fmaxf(md, fabsf(v - __uint_as_float(((uint32_t)T[((size_t)(b * TW + n - 1792)) * UT + u]) << 16)));
        if (n >= 2816) md = fmaxf(md, fabsf(v - WSP(float, OFF_G)[(size_t)row * 16 + n - 2816]));
    }
    md = blk_max(md, red);
    mdm = blk_max(mdm, red);
    unsigned* dw = (unsigned*)(p.ws + OFF_DBG);
    if (VTID == 0) { atomicMax(dw + 9, __float_as_uint(md)); atomicMax(dw + 15, __float_as_uint(mdm)); }
}
__global__ void __launch_bounds__(256) dbg_mix(Params p, int l, int slot) {
    __shared__ float xs[1024], hs[1024], os[1024], ys[1024], red[4];
    const int sr = blockIdx.x, row = dbg_row(sr), b9 = row < NL ? row >> 12 : 8;
    const float* xin = (const float*)(p.ws + OFF_DBG + 256) + ((size_t)slot * 16 + sr) * 1024;
    const u16* P = WSP(u16, OFF_P);
    for (int n = VTID; n < 1024; n += 256) { xs[n] = xin[n]; os[n] = __uint_as_float(((uint32_t)P[(size_t)row * PW + n]) << 16); }
    __syncthreads();
    float mdm = dbg_modulate(p, l, 1, b9, xs, hs, red);
    const float* w = p.mix_w_in + (size_t)l * 1024 * NIN;
    for (int n = VTID; n < 1024; n += 256) {
        float y = 0.f;
        for (int i = 0; i < 3; ++i) {
            float g = 0.f;
            for (int k = 0; k < 1024; ++k) g += hs[k] * w[(size_t)k * NIN + 2832 + i * 1024 + n];
            g = 1.f / (1.f + expf(-g));
            const float* wb = i == 0 ? p.w_br_ml + (size_t)l * 256 * 1024 : (i == 1 ? p.w_br_na + (size_t)l * 384 * 1024 : p.w_br_gq + (size_t)l * 384 * 1024);
            const int ko = i == 0 ? 0 : (i == 1 ? 256 : 640), kk = i == 0 ? 256 : 384;
            float a = 0.f;
            for (int k = 0; k < kk; ++k) a += os[ko + k] * wb[(size_t)k * 1024 + n];
            y += g * a;
        }
        ys[n] = y;
    }
    __syncthreads();
    float md = 0.f;
    const float* xc = dbg_xrow(p, row);
    for (int n = VTID; n < 1024; n += 256) {
        float o = 0.f;
        for (int k = 0; k < 1024; ++k) o += ys[k] * p.w_out[((size_t)l * 1024 + k) * 1024 + n];
        const float g5 = dbg_mod(p, l, b9, 5, n);
        md = fmaxf(md, fabsf(xs[n] + g5 * o - xc[n]));
    }
    md = blk_max(md, red);
    mdm = blk_max(mdm, red);
    unsigned* dw = (unsigned*)(p.ws + OFF_DBG);
    if (VTID == 0) { atomicMax(dw + 10, __float_as_uint(md)); atomicMax(dw + 15, __float_as_uint(mdm)); }
}
__global__ void dbg_fin(Params p) {
    const unsigned* dw = (const unsigned*)(p.ws + OFF_DBG);
    int mask = 0;
    if (__uint_as_float(dw[8]) > 0.02f) mask |= 1;
    if (__uint_as_float(dw[9]) > 0.03f) mask |= 2;
    if (__uint_as_float(dw[10]) > 0.02f) mask |= 4;
    if (__uint_as_float(dw[11]) > 0.02f) mask |= 8;
    if (__uint_as_float(dw[15]) > 1e-3f) mask |= 16;
    if (__uint_as_float(dw[4]) > 0.03f) mask |= 32;
    p.out[0] += 10.f * (float)mask;
    p.out[1] += 1000.f * __uint_as_float(dw[4]);
}
#endif


DEV void gemm8b_accum(f32x4 (&acc)[4][4], const u16* __restrict__ A, int lda, const u16* __restrict__ B, int ldb, int K, char* smem, int tid) {
    constexpr int STAGE = 49152;
    const int lane = tid & 63, wave = tid >> 6;
    const int wm = wave >> 1, wn = wave & 1, fr = lane & 15, fq = lane >> 4;
    const int lr = lane >> 3, pos = lane & 7;
    const int ce = pos ^ (lr >> 1), co = pos ^ (4 | (lr >> 1));
    const unsigned ra_ = (unsigned)((wave * 32 + lr) * lda) * 2u, rb_ = (unsigned)((wave * 16 + lr) * ldb) * 2u;
    const unsigned voa_e = ra_ + ce * 16, voa_o = ra_ + co * 16, vob_e = rb_ + ce * 16, vob_o = rb_ + co * 16;
    const int nk = K >> 6;
    const unsigned ldsb = (unsigned)(size_t)(__attribute__((address_space(3))) char*)smem;
    const unsigned ldsa_w = __builtin_amdgcn_readfirstlane(ldsb + wave * 4096);
    const unsigned ldsb_w = __builtin_amdgcn_readfirstlane(ldsb + 32768 + wave * 2048);
#define G8B_ISSUE(STG, K0) do { \
        _Pragma("unroll") for (int i = 0; i < 4; ++i) glds16(A + (size_t)(8 * i) * lda + (K0), (i & 1) ? voa_o : voa_e, ldsa_w + (STG) * STAGE + i * 1024); \
        _Pragma("unroll") for (int i = 0; i < 2; ++i) glds16(B + (size_t)(8 * i) * ldb + (K0), (i & 1) ? vob_o : vob_e, ldsb_w + (STG) * STAGE + i * 1024); \
    } while (0)
    G8B_ISSUE(0, 0);
    VM_WAIT0();
    __syncthreads();
    const int s3 = (fr >> 1) & 7;
    const int oa_base = (wm * 64 + fr) * 128 + ((fq ^ s3) * 16);
    const int ob_base = 32768 + (wn * 64 + fr) * 128 + ((fq ^ s3) * 16);
    for (int kt = 0; kt < nk; ++kt) {
        const int cur = kt & 1;
        const int k0 = (kt + 1 < nk ? kt + 1 : kt) * 64;
        G8B_ISSUE(cur ^ 1, k0);
        int o_a = cur * STAGE + oa_base, o_b = cur * STAGE + ob_base;
        asm volatile("" : "+v"(o_a), "+v"(o_b));
#pragma unroll
        for (int ks = 0; ks < 2; ++ks) {
            const char* sa_c = smem + (ks ? (o_a ^ 64) : o_a);
            const char* sb_c = smem + (ks ? (o_b ^ 64) : o_b);
            bf16x8 bfr[4], af[4];
#pragma unroll
            for (int nt = 0; nt < 4; ++nt) bfr[nt] = *(const bf16x8*)(sb_c + nt * 2048);
#pragma unroll
            for (int mt = 0; mt < 4; ++mt) af[mt] = *(const bf16x8*)(sa_c + mt * 2048);
#pragma unroll
            for (int mt = 0; mt < 4; ++mt)
#pragma unroll
                for (int nt = 0; nt < 4; ++nt) acc[mt][nt] = mfma16(af[mt], bfr[nt], acc[mt][nt]);
            __builtin_amdgcn_sched_group_barrier(0x100, 7, 0);
            __builtin_amdgcn_sched_group_barrier(0x008, 4, 0);
            __builtin_amdgcn_sched_group_barrier(0x100, 1, 0);
#pragma unroll
            for (int i = 0; i < 3; ++i) __builtin_amdgcn_sched_group_barrier(0x008, 4, 0);
        }
        VM_WAIT0();
        __syncthreads();
    }
#undef G8B_ISSUE
}

DEV void ph_merge8(const Params& p, char* smem, int rvid, int RG, int tid) {
    const u16* H = WSP(u16, OFF_H);
    u16* P = WSP(u16, OFF_P);
    const u16* Wg = WSP(u16, OFF_W) + WE_MIX + (size_t)2944 * 1024;
    const u16* Wbr = WSP(u16, OFF_W) + WE_BR;
    const int lane = tid & 63, wave = tid >> 6, wm = wave >> 1, wn = wave & 1, fr = lane & 15, fq = lane >> 4;
    const int total = 128 * 8;
    for (int t = rvid; t < total; t += RG) {
        const int gi = t >> 5, rem = t & 31;
        const int mt_ = gi * 4 + (rem & 3), nt_ = rem >> 2;
        const int m0 = mt_ * 256, n0 = nt_ * 128;
        f32x4 y[4][4];
        zero_acc<4>(y);
#pragma unroll 1
        for (int br = 0; br < 3; ++br) {
            const int ko = br == 0 ? 0 : (br == 1 ? 256 : 640);
            const int kk = br == 0 ? 256 : 384;
            uint32_t gpk[4][4][2];
            {
                f32x4 g[4][4];
                zero_acc<4>(g);
                gemm8b_accum(g, H + (size_t)m0 * D, D, Wg + (size_t)(br * 1024 + n0) * D, D, D, smem, tid);
#pragma unroll
                for (int i = 0; i < 4; ++i)
#pragma unroll
                    for (int jn = 0; jn < 4; ++jn) {
                        gpk[i][jn][0] = pk2(sigmoidf_(g[i][jn][0]), sigmoidf_(g[i][jn][1]));
                        gpk[i][jn][1] = pk2(sigmoidf_(g[i][jn][2]), sigmoidf_(g[i][jn][3]));
                    }
            }
            f32x4 a[4][4];
            zero_acc<4>(a);
            gemm8b_accum(a, P + (size_t)m0 * PW + ko, PW, Wbr + (size_t)n0 * D + ko, D, kk, smem, tid);
#pragma unroll
            for (int i = 0; i < 4; ++i)
#pragma unroll
                for (int jn = 0; jn < 4; ++jn) {
                    y[i][jn][0] += bflo(gpk[i][jn][0]) * a[i][jn][0];
                    y[i][jn][1] += bfhi(gpk[i][jn][0]) * a[i][jn][1];
                    y[i][jn][2] += bflo(gpk[i][jn][1]) * a[i][jn][2];
                    y[i][jn][3] += bfhi(gpk[i][jn][1]) * a[i][jn][3];
                }
        }
#pragma unroll
        for (int mt = 0; mt < 4; ++mt)
#pragma unroll
            for (int nt = 0; nt < 4; ++nt)
#pragma unroll
                for (int r = 0; r < 4; ++r) {
                    const int row = m0 + wm * 64 + mt * 16 + fq * 4 + r;
                    const int col = n0 + wn * 64 + nt * 16 + fr;
                    P[(size_t)row * PW + PC_Y + col] = (u16)(pk2(y[mt][nt][r], 0.f) & 0xffff);
                }
    }
}

constexpr int PH_PER_LAYER = 15;
constexpr int N_PHASES = 2 * PH_PER_LAYER;

#ifndef REPEAT_MASK
#define REPEAT_MASK 0
#endif
template <int Q>
DEV void run_phase_q(const Params& p, int l, char* smem) {
    const int half = (int)((threadIdx.x + p.z) >> 8);
    const int G = gridDim.x * 2, bid = blockIdx.x * 2 + half;
    const int vid = (gridDim.x % 8 == 0) ? (int)(blockIdx.x & 7) * (G >> 3) + (int)(blockIdx.x >> 3) * 2 + half : bid;
    smem += half * 73728;
    const bool last = (l == 1);
    const u16* W = WSP(u16, OFF_W);
    const int nrep = ((REPEAT_MASK >> Q) & 1) ? 2 : 1;
    char* smem0 = smem - half * 73728;
    const int rtid = (int)(threadIdx.x + p.z);
    const int RG = gridDim.x;
    const int rvid = (RG % 8 == 0) ? (int)(blockIdx.x & 7) * (RG >> 3) + (int)(blockIdx.x >> 3) : (int)blockIdx.x;
    for (int rep = 0; rep < nrep; ++rep) {
        const float cm = rep ? 0.f : 1.f;
        if (Q == 0) ph_prep(p, l, smem, bid, G);
        if (Q == 1) ph_mod(p, l, 0, MTOT, bid, G);
        Params p2 = p;
        if (Q == 2) { ph_ffn_in8(p, 0, smem0, rvid, RG, rtid); int z2 = p.z; asm volatile("" : "+s"(z2) :: "memory"); p2.z = z2; ph_ffn_in(p2, 0, 256, 16, smem, vid, G); }
        if (Q == 3) { ph_resid8(p, WSP(u16, OFF_P), DFF, W + WE_OUT0, DFF, 2, 0.5f * cm, smem0, rvid, RG, rtid, l == 0 ? p.x : p.out); int z2 = p.z; asm volatile("" : "+s"(z2) :: "memory"); p2.z = z2;
                      ph_resid(p2, WSP(u16, OFF_P), DFF, W + WE_OUT0, DFF, 2, 0.5f * cm, 256, 16, smem, vid, G); }
        if (Q == 4) ph_mod(p, l, 1, MTOT, bid, G);
        if (Q == 5) { ph_pgemm8(p, l, smem0, rvid, RG, rtid); int z2 = p.z; asm volatile("" : "+s"(z2) :: "memory"); p2.z = z2; ph_pgemm(p2, 256, 16, smem, vid, G); }
        if (Q == 6) ph_qknorm_gates(p, l, bid, G);
        if (Q == 7) { ph_attn8(p, l, smem0, rvid, RG); int z2 = p.z; asm volatile("" : "+s"(z2) :: "memory"); p2.z = z2; ph_attn(p2, l, smem, bid, G, rep); }
        if (Q == 8) ph_m3(p, bid, G);
        if (Q == 9) ph_m4(p, l, bid, G, rep);
        if (Q == 10) { ph_merge8(p, smem0, rvid, RG, rtid); int z2 = p.z; asm volatile("" : "+s"(z2) :: "memory"); p2.z = z2; if (!last) ph_merge(p2, 256, 16, smem, vid, G); }
        if (Q == 11) { ph_resid8(p, WSP(u16, OFF_P) + PC_Y, PW, W + WE_O, D, 5, 1.0f * cm, smem0, rvid, RG, rtid, p.out);
                       int z2 = p.z; asm volatile("" : "+s"(z2) :: "memory"); p2.z = z2;
                       if (!last) ph_resid(p2, WSP(u16, OFF_P) + PC_Y, PW, W + WE_O, D, 5, 1.0f * cm, 256, 16, smem, vid, G); }
        if (Q == 12) ph_mod(p, l, 2, last ? NL : MTOT, bid, G);
        if (Q == 13) { ph_ffn_in8(p, 1, smem0, rvid, RG, rtid); int z2 = p.z; asm volatile("" : "+s"(z2) :: "memory"); p2.z = z2; if (!last) ph_ffn_in(p2, 1, 256, 16, smem, vid, G); }
        if (Q == 14) { ph_resid8(p, WSP(u16, OFF_P), DFF, W + WE_OUT1, DFF, 8, 0.5f * cm, smem0, rvid, RG, rtid, p.out);
                       int z2 = p.z; asm volatile("" : "+s"(z2) :: "memory"); p2.z = z2;
                       if (!last) ph_resid(p2, WSP(u16, OFF_P), DFF, W + WE_OUT1, DFF, 8, 0.5f * cm, 256, 16, smem, vid, G); }
    }
}

DEV void run_phase(const Params& p, int ph, char* smem) {
    const int l = ph / PH_PER_LAYER, q = ph % PH_PER_LAYER;
    switch (q) {
        case 0: run_phase_q<0>(p, l, smem); break;
        case 1: run_phase_q<1>(p, l, smem); break;
        case 2: run_phase_q<2>(p, l, smem); break;
        case 3: run_phase_q<3>(p, l, smem); break;
        case 4: run_phase_q<4>(p, l, smem); break;
        case 5: run_phase_q<5>(p, l, smem); break;
        case 6: run_phase_q<6>(p, l, smem); break;
        case 7: run_phase_q<7>(p, l, smem); break;
        case 8: run_phase_q<8>(p, l, smem); break;
        case 9: run_phase_q<9>(p, l, smem); break;
        case 10: run_phase_q<10>(p, l, smem); break;
        case 11: run_phase_q<11>(p, l, smem); break;
        case 12: run_phase_q<12>(p, l, smem); break;
        case 13: run_phase_q<13>(p, l, smem); break;
        case 14: run_phase_q<14>(p, l, smem); break;
    }
}

template <int Q>
__global__ void __launch_bounds__(256, 2) phase_kernel(Params p, int l) {
    __shared__ __attribute__((aligned(16))) char smem[73728];
    run_phase_q<Q>(p, l, smem);
}

#if ONE_LAUNCH
#define XB_TMO      128
#define XB_XCNT(j)  (256  + 64 * (j))
#define XB_XSUB(j)  (1280 + 64 * (j))
#define XB_XGEN(j)  (2304 + 64 * (j))
#define XB_TOP      3328
#define XB_TOPGEN   3392
#define XB_SPIN_CAP (1u << 22)
DEV unsigned xb_ld(unsigned* q) { return __hip_atomic_load(q, __ATOMIC_RELAXED, __HIP_MEMORY_SCOPE_AGENT); }
DEV unsigned xb_add(unsigned* q, unsigned v) { return __hip_atomic_fetch_add(q, v, __ATOMIC_RELAXED, __HIP_MEMORY_SCOPE_AGENT); }
DEV unsigned xb_xcc_id() { return (unsigned)__builtin_amdgcn_s_getreg((3 << 11) | 20) & 0xFu; }
#define XB_SPIN(cond, bar) do { unsigned _sp = 0; while (cond) { __builtin_amdgcn_s_sleep(1); \
    if ((++_sp & 255u) == 0u) { if (xb_ld(&(bar)[XB_TMO])) break; if (_sp > XB_SPIN_CAP) { atomicAdd(&(bar)[XB_TMO], 1u); break; } } } } while (0)
DEV void xcd_census(unsigned* bar, unsigned x, unsigned& nloc, unsigned& nx) {
    const unsigned G = gridDim.x;
    unsigned sum, cnt, mine, sp = 0u;
    for (;;) {
        sum = 0u; cnt = 0u; mine = 0u;
#pragma unroll
        for (unsigned j = 0; j < 16; ++j) { const unsigned c = xb_ld(&bar[XB_XCNT(j)]); sum += c; cnt += (c > 0u) ? 1u : 0u; mine = (j == x) ? c : mine; }
        if (sum == G) break;
        __builtin_amdgcn_s_sleep(1);
        if ((++sp & 255u) == 0u) { if (xb_ld(&bar[XB_TMO])) break; if (sp > XB_SPIN_CAP) { atomicAdd(&bar[XB_TMO], 1u); break; } }
    }
    nloc = mine > 0u ? mine : 1u; nx = cnt > 0u ? cnt : 1u;
}
DEV void xcd_barrier(unsigned* bar, unsigned x, volatile unsigned* st, int tid) {
    asm volatile("s_waitcnt vmcnt(0)" ::: "memory");
    __syncthreads();
    if (tid == 0) {
        __builtin_amdgcn_s_waitcnt(0);
        unsigned nloc = st[0], nx = st[1];
        if (nloc == 0u) { xcd_census(bar, x, nloc, nx); st[0] = nloc; st[1] = nx; }
        const unsigned old = xb_add(&bar[XB_XSUB(x)], 1u);
        const unsigned gen = old / nloc;
        if (old + 1u == (gen + 1u) * nloc) {
            __builtin_amdgcn_fence(__ATOMIC_RELEASE, "agent");
            asm volatile("s_waitcnt vmcnt(0)" ::: "memory");
            const unsigned og = xb_add(&bar[XB_TOP], 1u);
            const unsigned tg = og / nx;
            if (og + 1u == (tg + 1u) * nx) xb_add(&bar[XB_TOPGEN], 1u);
            else XB_SPIN(xb_ld(&bar[XB_TOPGEN]) == tg, bar);
            __builtin_amdgcn_fence(__ATOMIC_ACQUIRE, "agent");
            xb_add(&bar[XB_XGEN(x)], 1u);
            asm volatile("s_waitcnt vmcnt(0)" ::: "memory");
        } else {
            XB_SPIN(xb_ld(&bar[XB_XGEN(x)]) == gen, bar);
            __builtin_amdgcn_fence(__ATOMIC_ACQUIRE, "agent");
            asm volatile("s_waitcnt vmcnt(0)" ::: "memory");
        }
    }
    __syncthreads();
}
__global__ void __launch_bounds__(512, 2) mega_kernel(Params p0, int ph_begin, int ph_end) {
    __shared__ __attribute__((aligned(16))) char smem[147456];
    __shared__ uint4 xb_words;
    unsigned* bar = (unsigned*)(p0.ws + OFF_BAR);
    const unsigned xcc = xb_xcc_id();
    if (threadIdx.x == 0) { xb_words = make_uint4(0u, 0u, 0u, 0u); (void)xb_add(&bar[XB_XCNT(xcc)], 1u); }
    __syncthreads();
    for (int ph = ph_begin; ph < ph_end; ++ph) {
        Params p = p0;
        int z = p0.z;
        asm volatile("" : "+s"(z));
        p.z = z;
        p.ws = p0.ws + z;
        p.out = p0.out + z;
        run_phase(p, ph, smem);
        if (ph + 1 < ph_end) {
            if (p0.z == 0x7fffffff) cg::this_grid().sync();
            xcd_barrier(bar, xcc, (volatile unsigned*)&xb_words, (int)threadIdx.x + z);
        }
    }
}
#endif

extern "C" void kernel_launch(void* const* d_in, const int* in_sizes, int n_in, void* d_out, int out_size, void* d_ws, size_t ws_size,
                              hipStream_t stream) {
    if (ws_size < WS_END) { fprintf(stderr, "workspace too small: %zu < %zu\n", ws_size, (size_t)WS_END); return; }
    Params p{};
    p.x = (const float*)d_in[0]; p.c = (const float*)d_in[1]; p.ctx = (const float*)d_in[2]; p.c_ctx = (const float*)d_in[3];
    p.ada_w = (const float*)d_in[4]; p.ada_b = (const float*)d_in[5]; p.norm_w = (const float*)d_in[6];
    p.ffn_w_in = (const float*)d_in[7]; p.ffn_w_out = (const float*)d_in[8]; p.mix_w_in = (const float*)d_in[9];
    p.ml_gate_b = (const float*)d_in[10]; p.ml_norm_w = (const float*)d_in[11]; p.na_qk_w = (const float*)d_in[12];
    p.na_rpb = (const float*)d_in[13]; p.gq_qk_w = (const float*)d_in[14]; p.w_br_ml = (const float*)d_in[15];
    p.w_br_na = (const float*)d_in[16]; p.w_br_gq = (const float*)d_in[17]; p.w_out = (const float*)d_in[18];
    p.out = (float*)d_out; p.ws = (char*)d_ws;
#ifdef NANFILL
    hipMemsetAsync(d_ws, 0xFF, WS_END, stream);
#endif
#if ONE_LAUNCH
    static int grid_blocks = 0;
    if (!grid_blocks) {
        int dev = 0, cus = 0, per_cu = 0;
        hipGetDevice(&dev);
        hipDeviceGetAttribute(&cus, hipDeviceAttributeMultiprocessorCount, dev);
        hipOccupancyMaxActiveBlocksPerMultiprocessor(&per_cu, mega_kernel, 512, 0);
        per_cu = 1;
        grid_blocks = cus * per_cu;
    }
    hipMemsetAsync((char*)d_ws + OFF_BAR, 0, 3456 * 4, stream);
    int pb = 0, pe = N_PHASES;
    void* args[] = {&p, &pb, &pe};
#ifdef SPLIT_TEST
    (void)args;
    for (int ph = 0; ph < N_PHASES; ++ph) mega_kernel<<<grid_blocks, 256, 0, stream>>>(p, ph, ph + 1);
#else
    hipError_t e = hipLaunchCooperativeKernel((void*)mega_kernel, dim3(grid_blocks), dim3(512), args, 0, stream);
    if (e != hipSuccess) fprintf(stderr, "cooperative launch failed: %s (grid %d)\n", hipGetErrorString(e), grid_blocks);
#endif
#else
    for (int l = 0; l < 2; ++l) {
#define LP(Q) phase_kernel<Q><<<512, 256, 0, stream>>>(p, l)
#ifdef DBG
        const bool dl = (l == DBG_LAYER);
        if (dl) hipMemsetAsync((char*)d_ws + OFF_DBG, 0, 256, stream);
        LP(0);
        if (dl) dbg_save<<<16, 256, 0, stream>>>(p, 0);
        LP(1); LP(2); LP(3);
        if (dl) dbg_ffn<<<16, 256, 0, stream>>>(p, l, 0, 0, 8);
        LP(4); LP(5);
        if (dl) dbg_pchk<<<16, 256, 0, stream>>>(p, l);
        LP(6);
        if (dl) dbg_copy<<<2048, 256, 0, stream>>>(p);
        LP(7); LP(8); LP(9);
        if (dl) {
            dbg_mlstm<<<64, 64, 0, stream>>>(p, l);
            dbg_cmp<<<(NB * 4 * UT + 7424 * 64 + 255) / 256, 256, 0, stream>>>(p, l);
            dbg_save<<<16, 256, 0, stream>>>(p, 1);
        }
        LP(10); LP(11);
        if (dl) { dbg_mix<<<16, 256, 0, stream>>>(p, l, 1); dbg_save<<<16, 256, 0, stream>>>(p, 2); }
        LP(12); LP(13); LP(14);
        if (dl) dbg_ffn<<<16, 256, 0, stream>>>(p, l, 1, 2, 11);
#else
        LP(0); LP(1); LP(2); LP(3); LP(4); LP(5); LP(6); LP(7); LP(8); LP(9); LP(10); LP(11); LP(12); LP(13); LP(14);
#endif
#undef LP
    }
#ifdef DBG
    dbg_fin<<<1, 1, 0, stream>>>(p);
#endif
#endif
}
```

```cpp
#include <hip/hip_runtime.h>
#include <hip/hip_cooperative_groups.h>
#include <stdint.h>
#include <cstdio>
namespace cg = cooperative_groups;

#ifndef ONE_LAUNCH
#define ONE_LAUNCH 1
#endif

#define VTID ((int)((threadIdx.x + p.z) & 255))
typedef unsigned short u16;
typedef __attribute__((ext_vector_type(8))) short bf16x8;
typedef __attribute__((ext_vector_type(4))) float f32x4;
#define DEV __device__ __forceinline__

constexpr int D = 1024, NB = 8, SEQ = 4096, CTXL = 256;
constexpr int NL = NB * SEQ, NCX = NB * CTXL, MTOT = NL + NCX;
constexpr int DFF = 2816, PW = 2816, UT = SEQ + CTXL, NCH = UT / 64;
constexpr int NIN = 5904;
constexpr int PC_MLQ = 0, PC_NAQ = 256, PC_GQQ = 640, PC_MLO = 1024, PC_MLK = 1280, PC_NAK = 1536, PC_GQK = 1920,
              PC_MLV = 2048, PC_NAV = 2304, PC_GQV = 2688, PC_Y = 1024;
constexpr int TC_MLK = 0, TC_MLV = 256, TC_NAV = 512, TC_GQV = 896, TW = 1024;
constexpr int DBG_MLO = PC_MLQ, DBG_NAO = PC_NAQ;
constexpr int SCH = 4160;
constexpr int NSCAN = 64;

constexpr size_t al256(size_t x) { return (x + 255) & ~(size_t)255; }
constexpr size_t OFF_MODS = 0;
constexpr size_t OFF_ROPE = al256(OFF_MODS + (size_t)9 * 9216 * 4);
constexpr size_t OFF_G    = al256(OFF_ROPE + (size_t)4096 * 64 * 4);
constexpr size_t OFF_BC   = al256(OFF_G + (size_t)MTOT * 16 * 4);
constexpr size_t OFF_IG   = al256(OFF_BC + (size_t)NSCAN * UT * 4);
constexpr size_t OFF_AE   = al256(OFF_IG + (size_t)NSCAN * UT * 4);
constexpr size_t OFF_MS   = al256(OFF_AE + (size_t)NSCAN * UT * 4);
constexpr size_t OFF_DEC  = al256(OFF_MS + (size_t)NSCAN * NCH * 4);
constexpr size_t OFF_XC   = al256(OFF_DEC + (size_t)NSCAN * NCH * 4);
constexpr size_t OFF_H    = al256(OFF_XC + (size_t)NCX * D * 4);
constexpr size_t OFF_P    = al256(OFF_H + (size_t)MTOT * D * 2);
constexpr size_t OFF_T    = al256(OFF_P + (size_t)MTOT * PW * 2);
constexpr size_t OFF_S    = al256(OFF_T + (size_t)NB * TW * UT * 2);
constexpr size_t OFF_W    = al256(OFF_S + (size_t)NSCAN * NCH * SCH * 4);
constexpr size_t WE_IN0 = 0, WE_IN1 = WE_IN0 + (size_t)5632 * 1024, WE_OUT0 = WE_IN1 + (size_t)5632 * 1024,
                 WE_OUT1 = WE_OUT0 + (size_t)1024 * 2816, WE_MIX = WE_OUT1 + (size_t)1024 * 2816,
                 WE_BR = WE_MIX + (size_t)6016 * 1024, WE_O = WE_BR + (size_t)1024 * 1024, WE_END = WE_O + (size_t)1024 * 1024;
constexpr size_t OFF_BAR = al256(OFF_W + WE_END * 2);
constexpr size_t OFF_PART = al256(OFF_BAR + 3456 * 4);
constexpr size_t WS_END = OFF_PART + (size_t)4 * NCX * D * 4;
static_assert(WS_END < (size_t)536000000, "workspace too large");

struct Params {
    const float *x, *c, *ctx, *c_ctx, *ada_w, *ada_b, *norm_w, *ffn_w_in, *ffn_w_out, *mix_w_in, *ml_gate_b, *ml_norm_w,
        *na_qk_w, *na_rpb, *gq_qk_w, *w_br_ml, *w_br_na, *w_br_gq, *w_out;
    float* out;
    char* ws;
    int z, pad;
};

DEV uint32_t pk2(float lo, float hi) { uint32_t r; asm("v_cvt_pk_bf16_f32 %0, %1, %2" : "=v"(r) : "v"(lo), "v"(hi)); return r; }
DEV float bflo(uint32_t w) { return __uint_as_float(w << 16); }
DEV float bfhi(uint32_t w) { return __uint_as_float(w & 0xffff0000u); }
DEV f32x4 mfma16(bf16x8 a, bf16x8 b, f32x4 c) { return __builtin_amdgcn_mfma_f32_16x16x32_bf16(a, b, c, 0, 0, 0); }
typedef unsigned u32x4 __attribute__((ext_vector_type(4)));
DEV u32x4 gld16(const void* q) { u32x4 r; asm volatile("global_load_dwordx4 %0, %1, off" : "=v"(r) : "v"(q) : "memory"); return r; }
DEV u32x4 gld16s(const void* sbase, unsigned voff) { u32x4 r; asm volatile("global_load_dwordx4 %0, %1, %2" : "=v"(r) : "v"(voff), "s"(sbase) : "memory"); return r; }
DEV void glds16(const void* sbase, unsigned voff, unsigned ldsaddr) {
    asm volatile("s_mov_b32 m0, %2\n\ts_nop 0\n\tglobal_load_lds_dwordx4 %0, %1" :: "v"(voff), "s"(sbase), "s"(ldsaddr) : "memory", "m0");
}
#define VM_WAIT0() asm volatile("s_waitcnt vmcnt(0)" ::: "memory")
union Frag { bf16x8 v; uint4 q; uint32_t u[4]; uint2 d[2]; };
DEV int cu_of(int c, int dir) { return c < 4 ? 64 + (dir ? 3 - c : c) : (dir ? 63 - (c - 4) : (c - 4)); }
DEV int rowof(int b, int u) { return u < SEQ ? b * SEQ + u : NL + b * CTXL + (u - SEQ); }
DEV float fexp2(float x) { return __builtin_amdgcn_exp2f(x); }
DEV float fexp(float x) { return __builtin_amdgcn_exp2f(x * 1.4426950408889634f); }
DEV float sigmoidf_(float x) { return 1.f / (1.f + fexp(-x)); }
DEV float xq_max(float v) {
    auto r = __builtin_amdgcn_permlane16_swap(__float_as_uint(v), __float_as_uint(v), false, false);
    const float m = fmaxf(__uint_as_float(r[0]), __uint_as_float(r[1]));
    auto q = __builtin_amdgcn_permlane32_swap(__float_as_uint(m), __float_as_uint(m), false, false);
    return fmaxf(__uint_as_float(q[0]), __uint_as_float(q[1]));
}
DEV float xq_sum(float v) {
    auto r = __builtin_amdgcn_permlane16_swap(__float_as_uint(v), __float_as_uint(v), false, false);
    const float m = __uint_as_float(r[0]) + __uint_as_float(r[1]);
    auto q = __builtin_amdgcn_permlane32_swap(__float_as_uint(m), __float_as_uint(m), false, false);
    return __uint_as_float(q[0]) + __uint_as_float(q[1]);
}
DEV float wave_sum(float v) {
#pragma unroll
    for (int o = 1; o < 64; o <<= 1) v += __shfl_xor(v, o);
    return v;
}
DEV float wave_max(float v) {
#pragma unroll
    for (int o = 1; o < 64; o <<= 1) v = fmaxf(v, __shfl_xor(v, o));
    return v;
}

#define WSP(T_, off) ((T_*)(p.ws + (off)))
DEV float m_scan(const Params& p, int sc, int c_end) {
    const float* BT = WSP(float, OFF_MS) + sc * NCH;
    const float* MX = WSP(float, OFF_DEC) + sc * NCH;
    const int lane = VTID & 63;
    const float bt0 = BT[lane], mx0 = MX[lane], bt1 = BT[64 + (lane & 3)], mx1 = MX[64 + (lane & 3)];
    float m = 0.f;
    for (int c = 0; c < c_end; ++c) {
        const float b = c < 64 ? __shfl(bt0, c) : __shfl(bt1, c - 64);
        const float x = c < 64 ? __shfl(mx0, c) : __shfl(mx1, c - 64);
        m = fmaxf(b + m, x);
    }
    return m;
}

template <int TN>
DEV void gemm_accum(f32x4 (&acc)[4][TN], const u16* __restrict__ A, int lda, const u16* __restrict__ B, int ldb, int K, char* smem, int tid) {
    constexpr int BROWS = TN * 32;
    constexpr int STAGE = (128 + BROWS) * 144;
    constexpr int NBCH = BROWS / 32;
    const int lane = tid & 63, wave = tid >> 6;
    const int wm = wave >> 1, wn = wave & 1, fr = lane & 15, fq = lane >> 4;
    const int lrow = tid >> 3, lc8 = tid & 7;
    const u16* ga = A + (size_t)lrow * lda + lc8 * 8;
    const u16* gb = B + (size_t)lrow * ldb + lc8 * 8;
    u32x4 ra[4], rb[NBCH];
    const int nk = K >> 6;
#pragma unroll
    for (int i = 0; i < 4; ++i) ra[i] = gld16(ga + (size_t)(32 * i) * lda);
#pragma unroll
    for (int i = 0; i < NBCH; ++i) rb[i] = gld16(gb + (size_t)(32 * i) * ldb);
    char* sw = smem + lrow * 144 + lc8 * 16;
    VM_WAIT0();
#pragma unroll
    for (int i = 0; i < 4; ++i) *(u32x4*)(sw + i * 32 * 144) = ra[i];
#pragma unroll
    for (int i = 0; i < NBCH; ++i) *(u32x4*)(sw + 128 * 144 + i * 32 * 144) = rb[i];
    __syncthreads();
    const char* sa_r = smem + (wm * 64 + fr) * 144 + fq * 16;
    const char* sb_r = smem + 128 * 144 + (wn * TN * 16 + fr) * 144 + fq * 16;
    for (int kt = 0; kt < nk; ++kt) {
        const int cur = kt & 1;
        const int k0 = (kt + 1 < nk ? kt + 1 : kt) * 64;
#pragma unroll
        for (int i = 0; i < 4; ++i) ra[i] = gld16(ga + (size_t)(32 * i) * lda + k0);
#pragma unroll
        for (int i = 0; i < NBCH; ++i) rb[i] = gld16(gb + (size_t)(32 * i) * ldb + k0);
        __builtin_amdgcn_sched_barrier(0);
#pragma unroll
        for (int ks = 0; ks < 2; ++ks) {
            bf16x8 af[4], bfr[TN];
#pragma unroll
            for (int mt = 0; mt < 4; ++mt) af[mt] = *(const bf16x8*)(sa_r + cur * STAGE + mt * 16 * 144 + ks * 64);
#pragma unroll
            for (int nt = 0; nt < TN; ++nt) bfr[nt] = *(const bf16x8*)(sb_r + cur * STAGE + nt * 16 * 144 + ks * 64);
#pragma unroll
            for (int mt = 0; mt < 4; ++mt)
#pragma unroll
                for (int nt = 0; nt < TN; ++nt) acc[mt][nt] = mfma16(af[mt], bfr[nt], acc[mt][nt]);
        }
        __builtin_amdgcn_sched_barrier(0);
        VM_WAIT0();
        {
            char* sw2 = sw + (cur ^ 1) * STAGE;
#pragma unroll
            for (int i = 0; i < 4; ++i) *(u32x4*)(sw2 + i * 32 * 144) = ra[i];
#pragma unroll
            for (int i = 0; i < NBCH; ++i) *(u32x4*)(sw2 + 128 * 144 + i * 32 * 144) = rb[i];
        }
        __syncthreads();
    }
}

template <int TN>
DEV void zero_acc(f32x4 (&acc)[4][TN]) {
#pragma unroll
    for (int i = 0; i < 4; ++i)
#pragma unroll
        for (int j = 0; j < TN; ++j) acc[i][j] = f32x4{0.f, 0.f, 0.f, 0.f};
}

DEV void tile_decode(int t, int ntn, int& mt, int& nt) {
    const int per = 8 * ntn;
    const int gi = t / per, rem = t - gi * per;
    nt = rem >> 3;
    mt = gi * 8 + (rem & 7);
}


template <bool SWAP = false>
DEV void gemm8_accum(f32x4 (&acc)[8][4], const u16* __restrict__ A, int lda, const u16* __restrict__ B, int ldb, int K, char* smem, int tid) {
    constexpr int STAGE = 65536;
    const int lane = tid & 63, wave = tid >> 6;
    const int wm = wave >> 2, wn = wave & 3, fr = lane & 15, fq = lane >> 4;
    const int lr = lane >> 3, pos = lane & 7;
    const int ce = pos ^ (lr >> 1), co = pos ^ (4 | (lr >> 1));
    const unsigned ra_ = (unsigned)((wave * 32 + lr) * lda) * 2u, rb_ = (unsigned)((wave * 32 + lr) * ldb) * 2u;
    const unsigned voa_e = ra_ + ce * 16, voa_o = ra_ + co * 16, vob_e = rb_ + ce * 16, vob_o = rb_ + co * 16;
    const int nk = K >> 6;
    const unsigned ldsw = __builtin_amdgcn_readfirstlane((unsigned)(size_t)(__attribute__((address_space(3))) char*)smem + wave * 4096);
#define G8_ISSUE(STG, K0) do { \
        _Pragma("unroll") for (int i = 0; i < 4; ++i) { \
            glds16(A + (size_t)(8 * i) * lda + (K0), (i & 1) ? voa_o : voa_e, ldsw + (STG) * STAGE + i * 1024); \
            glds16(B + (size_t)(8 * i) * ldb + (K0), (i & 1) ? vob_o : vob_e, ldsw + (STG) * STAGE + 32768 + i * 1024); \
        } } while (0)
    G8_ISSUE(0, 0);
    VM_WAIT0();
    __syncthreads();
    const int s3 = (fr >> 1) & 7;
    const int oa_base = (wm * 128 + fr) * 128 + ((fq ^ s3) * 16);
    const int ob_base = 32768 + (wn * 64 + fr) * 128 + ((fq ^ s3) * 16);
    for (int kt = 0; kt < nk; ++kt) {
        const int cur = kt & 1;
        const int k0 = (kt + 1 < nk ? kt + 1 : kt) * 64;
        G8_ISSUE(cur ^ 1, k0);
        int o_a = cur * STAGE + oa_base, o_b = cur * STAGE + ob_base;
        asm volatile("" : "+v"(o_a), "+v"(o_b));
#pragma unroll
        for (int ks = 0; ks < 2; ++ks) {
            const char* sa_c = smem + (ks ? (o_a ^ 64) : o_a);
            const char* sb_c = smem + (ks ? (o_b ^ 64) : o_b);
            bf16x8 bfr[4], af[8];
#pragma unroll
            for (int nt = 0; nt < 4; ++nt) bfr[nt] = *(const bf16x8*)(sb_c + nt * 2048);
#pragma unroll
            for (int mt = 0; mt < 8; ++mt) af[mt] = *(const bf16x8*)(sa_c + mt * 2048);
#pragma unroll
            for (int mt = 0; mt < 8; ++mt)
#pragma unroll
                for (int nt = 0; nt < 4; ++nt) acc[mt][nt] = SWAP ? mfma16(bfr[nt], af[mt], acc[mt][nt]) : mfma16(af[mt], bfr[nt], acc[mt][nt]);
            __builtin_amdgcn_sched_group_barrier(0x100, 7, 0);
#pragma unroll
            for (int i = 0; i < 5; ++i) { __builtin_amdgcn_sched_group_barrier(0x008, 4, 0); __builtin_amdgcn_sched_group_barrier(0x100, 1, 0); }
#pragma unroll
            for (int i = 0; i < 3; ++i) __builtin_amdgcn_sched_group_barrier(0x008, 4, 0);
        }
        VM_WAIT0();
        __syncthreads();
    }
#undef G8_ISSUE
}
DEV void zero_acc8(f32x4 (&acc)[8][4]) {
#pragma unroll
    for (int i = 0; i < 8; ++i)
#pragma unroll
        for (int j = 0; j < 4; ++j) acc[i][j] = f32x4{0.f, 0.f, 0.f, 0.f};
}
DEV void tile_decode8(int t, int ntn, int& mt, int& nt) {
    const int per = 4 * ntn;
    const int gi = t / per, rem = t - gi * per;
    nt = rem >> 2;
    mt = gi * 4 + (rem & 3);
}

DEV void ph_ffn_in8(const Params& p, int which, int mtiles8, char* smem, int rvid, int RG, int tid) {
    const u16* H = WSP(u16, OFF_H);
    const u16* Wt = WSP(u16, OFF_W) + (which ? WE_IN1 : WE_IN0);
    u16* ACT = WSP(u16, OFF_P);
    const int lane = tid & 63, wave = tid >> 6, wm = wave >> 2, wn = wave & 3, fr = lane & 15, fq = lane >> 4;
    const int total = mtiles8 * 22;
    for (int t = rvid; t < total; t += RG) {
        int mt_, nt_;
        tile_decode8(t, 22, mt_, nt_);
        const int m0 = mt_ * 256, n0 = nt_ * 256;
        f32x4 acc[8][4];
        zero_acc8(acc);
        gemm8_accum(acc, H + (size_t)m0 * D, D, Wt + (size_t)n0 * D, D, D, smem, tid);
#pragma unroll
        for (int mt = 0; mt < 8; ++mt)
#pragma unroll
            for (int pp = 0; pp < 2; ++pp)
#pragma unroll
                for (int r = 0; r < 4; ++r) {
                    const int row = m0 + wm * 128 + mt * 16 + fq * 4 + r;
                    const int hid = (n0 >> 1) + wn * 32 + pp * 16 + fr;
                    const float g = acc[mt][2 * pp][r], u = acc[mt][2 * pp + 1][r];
                    const float v = g * sigmoidf_(g) * u;
                    ACT[(size_t)row * DFF + hid] = (u16)(pk2(v, 0.f) & 0xffff);
                }
    }
}
DEV void ph_resid8(const Params& p, const u16* A, int lda, const u16* Wt, int K, int modidx, float coef, char* smem, int rvid, int RG, int tid, const float* xsrc) {
    const float* mods = WSP(float, OFF_MODS);
    const int lane = tid & 63, wave = tid >> 6, wm = wave >> 2, wn = wave & 3, fr = lane & 15, fq = lane >> 4;
    const int total = 128 * 4;
    for (int t = rvid; t < total; t += RG) {
        int mt_, nt_;
        tile_decode8(t, 4, mt_, nt_);
        const int m0 = mt_ * 256, n0 = nt_ * 256;
        f32x4 acc[8][4];
        zero_acc8(acc);
        gemm8_accum<true>(acc, A + (size_t)m0 * lda, lda, Wt + (size_t)n0 * K, K, K, smem, tid);
        const float* gp = mods + (m0 >> 12) * 9216 + modidx * 1024;
#pragma unroll
        for (int nt = 0; nt < 4; ++nt) {
            const int col = n0 + wn * 64 + nt * 16 + fq * 4;
            float4 g4 = *(const float4*)(gp + col);
            g4.x *= coef; g4.y *= coef; g4.z *= coef; g4.w *= coef;
#pragma unroll
            for (int mt = 0; mt < 8; ++mt) {
                const size_t off = (size_t)(m0 + wm * 128 + mt * 16 + fr) * D + col;
                float4 xv = *(const float4*)(xsrc + off);
                xv.x += g4.x * acc[mt][nt][0];
                xv.y += g4.y * acc[mt][nt][1];
                xv.z += g4.z * acc[mt][nt][2];
                xv.w += g4.w * acc[mt][nt][3];
                *(float4*)(p.out + off) = xv;
            }
        }
    }
}
DEV void ph_pgemm8(const Params& p, int lsel, char* smem, int rvid, int RG, int tid) {
    const u16* H = WSP(u16, OFF_H);
    const u16* Wt = WSP(u16, OFF_W) + WE_MIX;
    u16* P = WSP(u16, OFF_P);
    u16* T = WSP(u16, OFF_T);
    float* Gt = WSP(float, OFF_G);
    const int lane = tid & 63, wave = tid >> 6, wm = wave >> 2, wn = wave & 3, fr = lane & 15, fq = lane >> 4;
    const int total = 128 * 12;
    for (int t = rvid; t < total; t += RG) {
        int mt_, nt_;
        tile_decode8(t, 12, mt_, nt_);
        const int m0 = mt_ * 256, n0 = nt_ * 256;
        f32x4 acc[8][4];
        zero_acc8(acc);
        const int cb = n0 + wn * 64;
        const int j = cb >> 7;
        const bool swap_tile = (nt_ <= 4) || (nt_ == 6) || (nt_ == 7);
        if (swap_tile) {
            gemm8_accum<true>(acc, H + (size_t)m0 * D, D, Wt + (size_t)n0 * D, D, D, smem, tid);
            const bool normed = (cb >= 256 && cb < 1024) || (cb >= 1536);
            const bool isq = cb < 1024;
            const bool isgq = (cb >= 640 && cb < 1024) || (cb >= 1920);
            const float* wv = (isgq ? p.gq_qk_w : p.na_qk_w) + (lsel * 2 + (isq ? 0 : 1)) * 64;
            const float scl = isq ? 0.125f : 1.f;
            float4 w4[4];
#pragma unroll
            for (int nt = 0; nt < 4; ++nt) w4[nt] = normed ? *(const float4*)(wv + nt * 16 + fq * 4) : float4{1.f, 1.f, 1.f, 1.f};
            const float* rope = WSP(float, OFF_ROPE);
#pragma unroll
            for (int mt = 0; mt < 8; ++mt) {
                const int row = m0 + wm * 128 + mt * 16 + fr;
                if (normed) {
                    float ss = 0.f;
#pragma unroll
                    for (int nt = 0; nt < 4; ++nt)
#pragma unroll
                        for (int r = 0; r < 4; ++r) ss += acc[mt][nt][r] * acc[mt][nt][r];
                    ss = xq_sum(ss);
                    const float rstd = rsqrtf(ss * (1.f / 64.f) + 1e-6f) * scl;
#pragma unroll
                    for (int nt = 0; nt < 4; ++nt) {
                        acc[mt][nt][0] *= rstd * w4[nt].x; acc[mt][nt][1] *= rstd * w4[nt].y;
                        acc[mt][nt][2] *= rstd * w4[nt].z; acc[mt][nt][3] *= rstd * w4[nt].w;
                    }
                    if (isgq) {
                        const int tok = row & 4095;
#pragma unroll
                        for (int nt = 0; nt < 2; ++nt) {
                            const float* rp = rope + ((size_t)tok * 32 + nt * 16 + fq * 4) * 2;
                            const float4 cs01 = *(const float4*)rp, cs23 = *(const float4*)(rp + 4);
                            const float cv[4] = {cs01.x, cs01.z, cs23.x, cs23.z}, sv[4] = {cs01.y, cs01.w, cs23.y, cs23.w};
#pragma unroll
                            for (int r = 0; r < 4; ++r) {
                                const float x1 = acc[mt][nt][r], x2 = acc[mt][nt + 2][r];
                                acc[mt][nt][r] = x1 * cv[r] - x2 * sv[r];
                                acc[mt][nt + 2][r] = x1 * sv[r] + x2 * cv[r];
                            }
                        }
                    }
                }
#pragma unroll
                for (int nt = 0; nt < 4; ++nt)
                    *(uint2*)(P + (size_t)row * PW + cb + nt * 16 + fq * 4) = uint2{pk2(acc[mt][nt][0], acc[mt][nt][1]), pk2(acc[mt][nt][2], acc[mt][nt][3])};
            }
            continue;
        }
        gemm8_accum(acc, H + (size_t)m0 * D, D, Wt + (size_t)n0 * D, D, D, smem, tid);
        if (j >= 22) {
            if (cb == 2816) {
#pragma unroll
                for (int mt = 0; mt < 8; ++mt)
#pragma unroll
                    for (int r = 0; r < 4; ++r) {
                        const int row = m0 + wm * 128 + mt * 16 + fq * 4 + r;
                        Gt[(size_t)row * 16 + fr] = acc[mt][0][r];
                    }
            }
            continue;
        }
        const bool rowmajor = j < 16;
        const bool transp = (j == 10) || (j == 11) || (j >= 16);
        if (rowmajor) {
#pragma unroll
            for (int mt = 0; mt < 8; ++mt)
#pragma unroll
                for (int nt = 0; nt < 4; ++nt)
#pragma unroll
                    for (int r = 0; r < 4; ++r) {
                        const int row = m0 + wm * 128 + mt * 16 + fq * 4 + r;
                        P[(size_t)row * PW + cb + nt * 16 + fr] = (u16)(pk2(acc[mt][nt][r], 0.f) & 0xffff);
                    }
        }
        if (transp) {
            const int tcb = (j >= 16) ? (cb - 1792) : (cb - 1280);
            const int b = m0 >> 12, u0 = m0 & 4095;
#pragma unroll
            for (int mt = 0; mt < 8; ++mt)
#pragma unroll
                for (int nt = 0; nt < 4; ++nt) {
                    const int tc = tcb + nt * 16 + fr;
                    const int u = u0 + wm * 128 + mt * 16 + fq * 4;
                    *(uint2*)(T + ((size_t)(b * TW + tc)) * UT + u) = uint2{pk2(acc[mt][nt][0], acc[mt][nt][1]), pk2(acc[mt][nt][2], acc[mt][nt][3])};
                }
        }
    }
}

DEV int map_col(int type, int n) {
    if (type == 0) return n;
    if (type == 1) {
        const int jb = n >> 5, r = n & 31;
        return r < 16 ? jb * 16 + r : DFF + jb * 16 + (r - 16);
    }
    if (n < 256) return 1552 + n;
    if (n < 640) return 2064 + (n - 256);
    if (n < 1024) return 2448 + (n - 640);
    if (n < 1280) return 1808 + (n - 1024);
    if (n < 1536) return (n - 1280);
    if (n < 1920) return 528 + (n - 1536);
    if (n < 2048) return 1296 + (n - 1920);
    if (n < 2304) return 256 + (n - 2048);
    if (n < 2688) return 912 + (n - 2304);
    if (n < 2816) return 1424 + (n - 2688);
    if (n < 2832) return 512 + (n - 2816);
    if (n < 2944) return -1;
    return 2832 + (n - 2944);
}

DEV void conv_tile(const float* __restrict__ src, int ld_src, int type, u16* __restrict__ dst, int ld_dst, int k_off, int kt, int ntile, char* smem, int tid) {
    float* lds = (float*)smem;
    const int k0 = kt * 64, n0 = ntile * 64;
    {
        const int r = tid >> 6, c = tid & 63;
        const int col = map_col(type, n0 + c);
#pragma unroll
        for (int i = 0; i < 16; ++i) {
            const int k = r + 4 * i;
            float v = 0.f;
            if (col >= 0) v = src[(size_t)(k0 + k) * ld_src + col];
            lds[k * 65 + c] = v;
        }
    }
    __syncthreads();
    {
        const int n = tid >> 2, kq = tid & 3;
        uint32_t w[8];
#pragma unroll
        for (int j = 0; j < 8; ++j) w[j] = pk2(lds[(kq * 16 + 2 * j) * 65 + n], lds[(kq * 16 + 2 * j + 1) * 65 + n]);
        u16* d = dst + (size_t)(n0 + n) * ld_dst + k_off + k0 + kq * 16;
        *(uint4*)d = uint4{w[0], w[1], w[2], w[3]};
        *(uint4*)(d + 8) = uint4{w[4], w[5], w[6], w[7]};
    }
    __syncthreads();
}

DEV void ph_prep(const Params& p, int l, char* smem, int bid, int G) {
    u16* W = WSP(u16, OFF_W);
    const int tid = VTID;
    constexpr int N_CONV = 6240, N_MODS = 288;
    for (int it = bid; it < N_CONV + N_MODS; it += G) {
        if (it < N_CONV) {
            int r = it;
            if (r < 2816) {
                const int which = r / 1408; r -= which * 1408;
                conv_tile(p.ffn_w_in + (size_t)(l * 2 + which) * 1024 * 5632, 5632, 1, W + (which ? WE_IN1 : WE_IN0), 1024, 0, r / 88, r % 88, smem, tid);
                continue;
            }
            r -= 2816;
            if (r < 1408) {
                const int which = r / 704; r -= which * 704;
                conv_tile(p.ffn_w_out + (size_t)(l * 2 + which) * 2816 * 1024, 1024, 0, W + (which ? WE_OUT1 : WE_OUT0), 2816, 0, r / 16, r % 16, smem, tid);
                continue;
            }
            r -= 1408;
            if (r < 1504) {
                conv_tile(p.mix_w_in + (size_t)l * 1024 * NIN, NIN, 2, W + WE_MIX, 1024, 0, r / 94, r % 94, smem, tid);
                continue;
            }
            r -= 1504;
            if (r < 64) { conv_tile(p.w_br_ml + (size_t)l * 256 * 1024, 1024, 0, W + WE_BR, 1024, 0, r / 16, r % 16, smem, tid); continue; }
            r -= 64;
            if (r < 96) { conv_tile(p.w_br_na + (size_t)l * 384 * 1024, 1024, 0, W + WE_BR, 1024, 256, r / 16, r % 16, smem, tid); continue; }
            r -= 96;
            if (r < 96) { conv_tile(p.w_br_gq + (size_t)l * 384 * 1024, 1024, 0, W + WE_BR, 1024, 640, r / 16, r % 16, smem, tid); continue; }
            r -= 96;
            conv_tile(p.w_out + (size_t)l * 1024 * 1024, 1024, 0, W + WE_O, 1024, 0, r / 16, r % 16, smem, tid);
        } else {
            const int cb = it - N_CONV;
            float* s = (float*)smem;
            float* red = s + 9 * 1024;
            for (int i = tid; i < 9 * 1024; i += 256) {
                const int b = i >> 10, k = i & 1023;
                const float v = b < 8 ? p.c[b * 1024 + k] : p.c_ctx[k];
                s[i] = v * sigmoidf_(v);
            }
            __syncthreads();
            const int kg = tid >> 5, c = tid & 31, col = cb * 32 + c;
            float a[9];
#pragma unroll
            for (int b = 0; b < 9; ++b) a[b] = 0.f;
            const float* wp = p.ada_w + (size_t)l * 1024 * 9216 + (size_t)(kg * 128) * 9216 + col;
#pragma unroll 16
            for (int k = 0; k < 128; ++k) {
                const float w = wp[(size_t)k * 9216];
#pragma unroll
                for (int b = 0; b < 9; ++b) a[b] += s[b * 1024 + kg * 128 + k] * w;
            }
#pragma unroll
            for (int b = 0; b < 9; ++b) red[(kg * 9 + b) * 32 + c] = a[b];
            __syncthreads();
            for (int i = tid; i < 288; i += 256) {
                const int b = i >> 5, cc = i & 31;
                float v = p.ada_b[l * 9216 + cb * 32 + cc];
#pragma unroll
                for (int g = 0; g < 8; ++g) v += red[(g * 9 + b) * 32 + cc];
                WSP(float, OFF_MODS)[b * 9216 + cb * 32 + cc] = v;
            }
            __syncthreads();
        }
    }
    if (l == 0) {
        const size_t gt = (size_t)bid * 256 + tid, gs = (size_t)G * 256;
        const float4* cs = (const float4*)p.ctx; float4* cd = WSP(float4, OFF_XC);
        for (size_t i = gt; i < (size_t)NCX * D / 4; i += gs) cd[i] = cs[i];
        float* rope = WSP(float, OFF_ROPE);
        for (size_t i = gt; i < (size_t)4096 * 32; i += gs) {
            const int t = (int)(i >> 5), f = (int)(i & 31);
            const float pos = (float)((f < 16) ? (t >> 6) : (t & 63));
            const float inv = powf(10000.f, -(float)(f & 15) / 16.f);
            float sn, cs_;
            sincosf(pos * inv, &sn, &cs_);
            rope[i * 2] = cs_;
            rope[i * 2 + 1] = sn;
        }
    }
}

DEV void ph_mod(const Params& p, int l, int sub, int nrows, int bid, int G) {
    const bool first = (l == 0 && sub == 0);
    const int lane = VTID & 63, gw = bid * 4 + (VTID >> 6), NW = G * 4;
    const float* nw = p.norm_w + (size_t)(l * 3 + sub) * 1024;
    const float* mods = WSP(float, OFF_MODS);
    u16* H = WSP(u16, OFF_H);
#pragma unroll 2
    for (int r = gw; r < nrows; r += NW) {
        const float* xr = r < NL ? (first ? p.x : p.out) + (size_t)r * D : (first ? p.ctx : WSP(float, OFF_XC)) + (size_t)(r - NL) * D;
        const int b9 = r < NL ? (r >> 12) : 8;
        const float* sh = mods + b9 * 9216 + (3 * sub) * 1024;
        const float* sc = sh + 1024;
        float4 v[4];
        float ss = 0.f;
        const bool fold = (r >= NL) && !first;
#pragma unroll
        for (int j = 0; j < 4; ++j) {
            v[j] = *(const float4*)(xr + lane * 4 + 256 * j);
            if (fold) {
#pragma unroll
                for (int ks = 0; ks < 4; ++ks) {
                    const float4 q4 = *(const float4*)(WSP(float, OFF_PART) + ((size_t)ks * NCX + (r - NL)) * D + lane * 4 + 256 * j);
                    v[j].x += q4.x; v[j].y += q4.y; v[j].z += q4.z; v[j].w += q4.w;
                }
                *(float4*)(WSP(float, OFF_XC) + (size_t)(r - NL) * D + lane * 4 + 256 * j) = v[j];
            }
            ss += v[j].x * v[j].x + v[j].y * v[j].y + v[j].z * v[j].z + v[j].w * v[j].w;
        }
        ss = wave_sum(ss);
        const float rstd = rsqrtf(ss * (1.f / 1024.f) + 1e-6f);
#pragma unroll
        for (int j = 0; j < 4; ++j) {
            const int k = lane * 4 + 256 * j;
            const float4 w = *(const float4*)(nw + k), s1 = *(const float4*)(sc + k), s0 = *(const float4*)(sh + k);
            const float y0 = v[j].x * rstd * w.x * (1.f + s1.x) + s0.x;
            const float y1 = v[j].y * rstd * w.y * (1.f + s1.y) + s0.y;
            const float y2 = v[j].z * rstd * w.z * (1.f + s1.z) + s0.z;
            const float y3 = v[j].w * rstd * w.w * (1.f + s1.w) + s0.w;
            *(uint2*)(H + (size_t)r * D + k) = uint2{pk2(y0, y1), pk2(y2, y3)};
        }
    }
}

DEV void ph_ffn_in(const Params& p, int which, int mt0, int mtiles, char* smem, int vid, int G) {
    const u16* H = WSP(u16, OFF_H);
    const u16* Wt = WSP(u16, OFF_W) + (which ? WE_IN1 : WE_IN0);
    u16* ACT = WSP(u16, OFF_P);
    const int lane = VTID & 63, wave = VTID >> 6, wm = wave >> 1, wn = wave & 1, fr = lane & 15, fq = lane >> 4;
    const int total = mtiles * 44;
    for (int t = vid; t < total; t += G) {
        int mt_, nt_;
        tile_decode(t, 44, mt_, nt_);
        mt_ += mt0;
        const int m0 = mt_ * 128, n0 = nt_ * 128;
        f32x4 acc[4][4];
        zero_acc<4>(acc);
        gemm_accum<4>(acc, H + (size_t)m0 * D, D, Wt + (size_t)n0 * D, D, D, smem, VTID);
#pragma unroll
        for (int mt = 0; mt < 4; ++mt)
#pragma unroll
            for (int pp = 0; pp < 2; ++pp)
#pragma unroll
                for (int r = 0; r < 4; ++r) {
                    const int row = m0 + wm * 64 + mt * 16 + fq * 4 + r;
                    const int hid = (n0 >> 1) + wn * 32 + pp * 16 + fr;
                    const float g = acc[mt][2 * pp][r], u = acc[mt][2 * pp + 1][r];
                    const float v = g * sigmoidf_(g) * u;
                    ACT[(size_t)row * DFF + hid] = (u16)(pk2(v, 0.f) & 0xffff);
                }
    }
}

DEV void ph_resid(const Params& p, const u16* A, int lda, const u16* Wt, int K, int modidx, float coef, int mt0, int mtiles, char* smem, int vid, int G) {
    const float* mods = WSP(float, OFF_MODS);
    const int lane = VTID & 63, wave = VTID >> 6, wm = wave >> 1, wn = wave & 1, fr = lane & 15, fq = lane >> 4;
    const int total = mtiles * 8 * 4;
    const int Kc = K >> 2;
    for (int t = vid; t < total; t += G) {
        int mt_, nt_;
        const int ksp = t & 3;
        tile_decode(t >> 2, 8, mt_, nt_);
        mt_ += mt0;
        const int m0 = mt_ * 128, n0 = nt_ * 128;
        f32x4 acc[4][4];
        zero_acc<4>(acc);
        gemm_accum<4>(acc, A + (size_t)m0 * lda + ksp * Kc, lda, Wt + (size_t)n0 * K + ksp * Kc, K, Kc, smem, VTID);
        const int b9 = m0 < NL ? (m0 >> 12) : 8;
        const float* gp = mods + b9 * 9216 + modidx * 1024;
#pragma unroll
        for (int nt = 0; nt < 4; ++nt) {
            const int col = n0 + wn * 64 + nt * 16 + fr;
            const float gv = gp[col] * coef;
#pragma unroll
            for (int mt = 0; mt < 4; ++mt)
#pragma unroll
                for (int r = 0; r < 4; ++r) {
                    const int row = m0 + wm * 64 + mt * 16 + fq * 4 + r;
                    WSP(float, OFF_PART)[((size_t)ksp * NCX + (row - NL)) * D + col] = gv * acc[mt][nt][r];
                }
        }
    }
}

DEV void ph_pgemm(const Params& p, int mt0, int mtiles, char* smem, int vid, int G) {
    const u16* H = WSP(u16, OFF_H);
    const u16* Wt = WSP(u16, OFF_W) + WE_MIX;
    u16* P = WSP(u16, OFF_P);
    u16* T = WSP(u16, OFF_T);
    float* Gt = WSP(float, OFF_G);
    const int lane = VTID & 63, wave = VTID >> 6, wm = wave >> 1, wn = wave & 1, fr = lane & 15, fq = lane >> 4;
    const int total = mtiles * 23;
    for (int t = vid; t < total; t += G) {
        int mt_, nt_;
        tile_decode(t, 23, mt_, nt_);
        mt_ += mt0;
        const int m0 = mt_ * 128, n0 = nt_ * 128;
        f32x4 acc[4][4];
        zero_acc<4>(acc);
        gemm_accum<4>(acc, H + (size_t)m0 * D, D, Wt + (size_t)n0 * D, D, D, smem, VTID);
        if (nt_ == 22) {
            if (wn == 0) {
#pragma unroll
                for (int mt = 0; mt < 4; ++mt)
#pragma unroll
                    for (int r = 0; r < 4; ++r) {
                        const int row = m0 + wm * 64 + mt * 16 + fq * 4 + r;
                        Gt[(size_t)row * 16 + fr] = acc[mt][0][r];
                    }
            }
            continue;
        }
        const bool rowmajor = nt_ < 16;
        const bool transp = (nt_ == 10) || (nt_ == 11) || (nt_ >= 16);
        if (rowmajor) {
#pragma unroll
            for (int mt = 0; mt < 4; ++mt)
#pragma unroll
                for (int nt = 0; nt < 4; ++nt)
#pragma unroll
                    for (int r = 0; r < 4; ++r) {
                        const int row = m0 + wm * 64 + mt * 16 + fq * 4 + r;
                        const int col = n0 + wn * 64 + nt * 16 + fr;
                        P[(size_t)row * PW + col] = (u16)(pk2(acc[mt][nt][r], 0.f) & 0xffff);
                    }
        }
        if (transp) {
            const int tcb = (nt_ >= 16) ? (n0 - 1792) : (n0 - 1280);
            int b, u0;
            if (m0 < NL) { b = m0 >> 12; u0 = m0 & 4095; } else { b = (m0 - NL) >> 8; u0 = SEQ + ((m0 - NL) & 255); }
#pragma unroll
            for (int mt = 0; mt < 4; ++mt)
#pragma unroll
                for (int nt = 0; nt < 4; ++nt) {
                    const int tc = tcb + wn * 64 + nt * 16 + fr;
                    const int u = u0 + wm * 64 + mt * 16 + fq * 4;
                    *(uint2*)(T + ((size_t)(b * TW + tc)) * UT + u) = uint2{pk2(acc[mt][nt][0], acc[mt][nt][1]), pk2(acc[mt][nt][2], acc[mt][nt][3])};
                }
        }
    }
}

DEV void ph_qknorm_gates(const Params& p, int l, int bid, int G) {
    const int lane = VTID & 63, gw = bid * 4 + (VTID >> 6), NW = G * 4;
    u16* P = WSP(u16, OFF_P);
    for (int it = gw; it < NSCAN * NCH; it += NW) {
        const int sc = it / NCH, c = it - sc * NCH, dir = sc & 1, h = (sc >> 1) & 3, b = sc >> 3;
        const float* Gt = WSP(float, OFF_G);
        float* BC = WSP(float, OFF_BC) + (size_t)sc * UT;
        float* IG = WSP(float, OFF_IG) + (size_t)sc * UT;
        float* WE = WSP(float, OFF_AE) + (size_t)sc * UT;
        const float bi = p.ml_gate_b[l * 16 + dir * 8 + h], bf = p.ml_gate_b[l * 16 + dir * 8 + 4 + h];
        const int cu = cu_of(c, dir);
        const int u = cu * 64 + (dir ? 63 - lane : lane);
        const int row = rowof(b, u);
        const float ig = Gt[(size_t)row * 16 + dir * 8 + h] + bi;
        const float fp = Gt[(size_t)row * 16 + dir * 8 + 4 + h] + bf;
        const float lf = fminf(fp, 0.f) - log1pf(expf(-fabsf(fp)));
        float bc = lf;
#pragma unroll
        for (int o = 1; o < 64; o <<= 1) { const float tv = __shfl_up(bc, o); if (lane >= o) bc += tv; }
        const float btot = __shfl(bc, 63);
        const float wend = btot - bc + ig;
        const float mx = wave_max(wend);
        WE[u] = wend;
        BC[u] = bc;
        IG[u] = ig;
        if (lane == 0) { WSP(float, OFF_MS)[sc * NCH + c] = btot; WSP(float, OFF_DEC)[sc * NCH + c] = mx; }
    }
    const float* rope = WSP(float, OFF_ROPE);
    const int hs = lane >> 4, e4 = (lane & 15) * 4;
    for (int r = NL + gw; r < MTOT; r += NW) {
        const bool latent = r < NL;
        const int tok = r & 4095;
#pragma unroll
        for (int g = 0; g < 5; ++g) {
            const int cbase = (g < 3 ? 256 + g * 256 : 1536 + (g - 3) * 256) + hs * 64 + e4;
            const int slot = g * 4 + hs;
            u16* pp = P + (size_t)r * PW + cbase;
            const uint2 raw = *(const uint2*)pp;
            float v0 = bflo(raw.x), v1 = bfhi(raw.x), v2 = bflo(raw.y), v3 = bfhi(raw.y);
            float ss = v0 * v0 + v1 * v1 + v2 * v2 + v3 * v3;
            ss += __shfl_xor(ss, 1); ss += __shfl_xor(ss, 2); ss += __shfl_xor(ss, 4); ss += __shfl_xor(ss, 8);
            const float* wv;
            float scl;
            bool do_rope;
            if (slot < 6) { wv = p.na_qk_w + (l * 2 + 0) * 64; scl = 0.125f; do_rope = false; }
            else if (slot < 12) { wv = p.gq_qk_w + (l * 2 + 0) * 64; scl = 0.125f; do_rope = latent; }
            else if (slot < 18) { wv = p.na_qk_w + (l * 2 + 1) * 64; scl = 1.f; do_rope = false; }
            else { wv = p.gq_qk_w + (l * 2 + 1) * 64; scl = 1.f; do_rope = latent; }
            const float rstd = rsqrtf(ss * (1.f / 64.f) + 1e-6f) * scl;
            const float4 w4 = *(const float4*)(wv + e4);
            v0 *= rstd * w4.x; v1 *= rstd * w4.y; v2 *= rstd * w4.z; v3 *= rstd * w4.w;
            const float o0 = __shfl_xor(v0, 8), o1 = __shfl_xor(v1, 8), o2 = __shfl_xor(v2, 8), o3 = __shfl_xor(v3, 8);
            if (do_rope) {
                const int fi = e4 & 31;
                const float4 cs01 = *(const float4*)(rope + ((size_t)tok * 32 + fi) * 2);
                const float4 cs23 = *(const float4*)(rope + ((size_t)tok * 32 + fi + 2) * 2);
                if (e4 < 32) {
                    v0 = v0 * cs01.x - o0 * cs01.y; v1 = v1 * cs01.z - o1 * cs01.w;
                    v2 = v2 * cs23.x - o2 * cs23.y; v3 = v3 * cs23.z - o3 * cs23.w;
                } else {
                    v0 = o0 * cs01.y + v0 * cs01.x; v1 = o1 * cs01.w + v1 * cs01.z;
                    v2 = o2 * cs23.y + v2 * cs23.x; v3 = o3 * cs23.w + v3 * cs23.z;
                }
            }
            *(uint2*)pp = uint2{pk2(v0, v1), pk2(v2, v3)};
        }
    }
}

template <int MT, bool NAMASK, int NWV>
DEV void flash_item(const Params& p, int b, int qrow0, int qcol, int kcol, int tcol, int ua, int n1, int ub, int ntiles,
                    int r_q, int rs, const float* __restrict__ rpb_h, char* smem, int ocol, float mfix = 0.f) {
    u16* P = WSP(u16, OFF_P);
    const u16* T = WSP(u16, OFF_T);
    const int tid = (NWV == 8) ? (int)(threadIdx.x + p.z) : VTID, lane = tid & 63, wave = tid >> 6, fr = lane & 15, fq = lane >> 4;
    constexpr int KVS = 64 * 144;
    char* Ks = smem;
    char* Vs = smem + 2 * KVS;
    float* rpb_s = (float*)(smem + 4 * KVS);
    __syncthreads();
    if (NAMASK) {
        for (int i = tid; i < 465; i += 256) rpb_s[i] = rpb_h[i] * 1.4426950408889634f;
    }
    Frag qf[MT][2];
#pragma unroll
    for (int mt = 0; mt < MT; ++mt)
#pragma unroll
        for (int ks = 0; ks < 2; ++ks)
            qf[mt][ks].q = *(const uint4*)(P + (size_t)(qrow0 + (wave * MT + mt) * 16 + fr) * PW + qcol + ks * 32 + fq * 8);
    const int lr = tid >> 3, lc8 = tid & 7;
    u32x4 rk0, rk1 = {0, 0, 0, 0}, rv0, rv1 = {0, 0, 0, 0};
#define FL_GLOAD(KT) do { const int kt_ = (KT); const int u0_ = kt_ < n1 ? ua + 64 * kt_ : ub + 64 * (kt_ - n1); const int row0_ = rowof(b, u0_); \
        rk0 = gld16(P + (size_t)(row0_ + lr) * PW + kcol + lc8 * 8); rv0 = gld16(T + ((size_t)(b * TW + tcol + lr)) * UT + u0_ + lc8 * 8); \
        if (NWV == 4) { rk1 = gld16(P + (size_t)(row0_ + lr + 32) * PW + kcol + lc8 * 8); rv1 = gld16(T + ((size_t)(b * TW + tcol + lr + 32)) * UT + u0_ + lc8 * 8); } } while (0)
#define FL_SSTORE(S) do { const int s_ = (S); \
        *(u32x4*)(Ks + s_ * KVS + lr * 144 + lc8 * 16) = rk0; *(u32x4*)(Vs + s_ * KVS + lr * 144 + lc8 * 16) = rv0; \
        if (NWV == 4) { *(u32x4*)(Ks + s_ * KVS + (lr + 32) * 144 + lc8 * 16) = rk1; *(u32x4*)(Vs + s_ * KVS + (lr + 32) * 144 + lc8 * 16) = rv1; } } while (0)
    FL_GLOAD(0);
    VM_WAIT0();
    FL_SSTORE(0);
    __syncthreads();
    f32x4 o[MT][4];
    float mrow[MT], lrow[MT];
#pragma unroll
    for (int mt = 0; mt < MT; ++mt) {
        mrow[mt] = -1e30f; lrow[mt] = 0.f;
#pragma unroll
        for (int dt = 0; dt < 4; ++dt) o[mt][dt] = f32x4{0.f, 0.f, 0.f, 0.f};
    }
    const float L2E = 1.4426950408889634f;
    for (int kt = 0; kt < ntiles; ++kt) {
        const int cur = kt & 1;
        const bool more = kt + 1 < ntiles;
        FL_GLOAD(more ? kt + 1 : kt);
        __builtin_amdgcn_sched_barrier(0);
        f32x4 s[MT][4];
#pragma unroll
        for (int mt = 0; mt < MT; ++mt)
#pragma unroll
            for (int nt = 0; nt < 4; ++nt) s[mt][nt] = f32x4{0.f, 0.f, 0.f, 0.f};
#pragma unroll
        for (int ks = 0; ks < 2; ++ks)
#pragma unroll
            for (int nt = 0; nt < 4; ++nt) {
                const bf16x8 kf = *(const bf16x8*)(Ks + cur * KVS + (nt * 16 + fr) * 144 + (ks * 32 + fq * 8) * 2);
#pragma unroll
                for (int mt = 0; mt < MT; ++mt) s[mt][nt] = mfma16(kf, qf[mt][ks].v, s[mt][nt]);
            }
        Frag pf[MT][2];
#pragma unroll
        for (int mt = 0; mt < MT; ++mt) {
            float rsum = 0.f;
            if (NAMASK && kt < 8) {
                const int qc = (wave * MT + mt) * 16 + fr;
                int cs = qc - 8; cs = cs < 0 ? 0 : (cs > 48 ? 48 : cs);
                const int brow = rs + kt - r_q + 7;
#pragma unroll
                for (int nt = 0; nt < 4; ++nt)
#pragma unroll
                    for (int r = 0; r < 4; ++r) {
                        const int kc = nt * 16 + fq * 4 + r;
                        const bool valid = (kc >= cs) && (kc < cs + 16);
                        const int bi = valid ? brow * 31 + (kc - qc + 15) : 0;
                        const float e = valid ? fexp2(fmaf(s[mt][nt][r], L2E, rpb_s[bi] - mfix)) : 0.f;
                        s[mt][nt][r] = e; rsum += e;
                    }
            } else {
#pragma unroll
                for (int nt = 0; nt < 4; ++nt)
#pragma unroll
                    for (int r = 0; r < 4; ++r) { const float e = fexp2(fmaf(s[mt][nt][r], L2E, -mfix)); s[mt][nt][r] = e; rsum += e; }
            }
            lrow[mt] += rsum;
#pragma unroll
            for (int ks = 0; ks < 2; ++ks) {
                pf[mt][ks].u[0] = pk2(s[mt][2 * ks][0], s[mt][2 * ks][1]);
                pf[mt][ks].u[1] = pk2(s[mt][2 * ks][2], s[mt][2 * ks][3]);
                pf[mt][ks].u[2] = pk2(s[mt][2 * ks + 1][0], s[mt][2 * ks + 1][1]);
                pf[mt][ks].u[3] = pk2(s[mt][2 * ks + 1][2], s[mt][2 * ks + 1][3]);
            }
        }
#pragma unroll
        for (int ks = 0; ks < 2; ++ks)
#pragma unroll
            for (int dt = 0; dt < 4; ++dt) {
                Frag vf;
                vf.d[0] = *(const uint2*)(Vs + cur * KVS + (dt * 16 + fr) * 144 + (ks * 32 + fq * 4) * 2);
                vf.d[1] = *(const uint2*)(Vs + cur * KVS + (dt * 16 + fr) * 144 + (ks * 32 + 16 + fq * 4) * 2);
#pragma unroll
                for (int mt = 0; mt < MT; ++mt) o[mt][dt] = mfma16(vf.v, pf[mt][ks].v, o[mt][dt]);
            }
        __builtin_amdgcn_sched_barrier(0);
        VM_WAIT0();
        FL_SSTORE(cur ^ 1);
        __syncthreads();
    }
#pragma unroll
    for (int mt = 0; mt < MT; ++mt) {
        const float inv = 1.f / xq_sum(lrow[mt]);
        u16* op = P + (size_t)(qrow0 + (wave * MT + mt) * 16 + fr) * PW + ocol;
#pragma unroll
        for (int dt = 0; dt < 4; ++dt)
            *(uint2*)(op + dt * 16 + fq * 4) = uint2{pk2(o[mt][dt][0] * inv, o[mt][dt][1] * inv), pk2(o[mt][dt][2] * inv, o[mt][dt][3] * inv)};
    }
}


DEV void m2_item(const Params& p, int sc, int c) {
    const u16* T = WSP(u16, OFF_T);
    const int lane = VTID & 63, wave = VTID >> 6, fr = lane & 15, fq = lane >> 4;
    const int dir = sc & 1, h = (sc >> 1) & 3, b = sc >> 3;
    const int u0 = cu_of(c, dir) * 64;
    const float* AE = WSP(float, OFF_AE) + (size_t)sc * UT + u0;
    float* S = WSP(float, OFF_S) + ((size_t)sc * NCH + c) * SCH;
    const float mnew = fmaxf(WSP(float, OFF_MS)[sc * NCH + c] + m_scan(p, sc, c), WSP(float, OFF_DEC)[sc * NCH + c]);
    f32x4 acc[4], accn[4];
#pragma unroll
    for (int nt = 0; nt < 4; ++nt) { acc[nt] = f32x4{0.f, 0.f, 0.f, 0.f}; accn[nt] = f32x4{0.f, 0.f, 0.f, 0.f}; }
    Frag ones;
    ones.u[0] = ones.u[1] = ones.u[2] = ones.u[3] = 0x3F803F80u;
#pragma unroll
    for (int ks = 0; ks < 2; ++ks) {
        Frag vf;
        vf.q = *(const uint4*)(T + ((size_t)(b * TW + TC_MLV + h * 64 + wave * 16 + fr)) * UT + u0 + ks * 32 + fq * 8);
        float4 a0 = *(const float4*)(AE + ks * 32 + fq * 8), a1 = *(const float4*)(AE + ks * 32 + fq * 8 + 4);
        a0.x = expf(a0.x - mnew); a0.y = expf(a0.y - mnew); a0.z = expf(a0.z - mnew); a0.w = expf(a0.w - mnew);
        a1.x = expf(a1.x - mnew); a1.y = expf(a1.y - mnew); a1.z = expf(a1.z - mnew); a1.w = expf(a1.w - mnew);
#pragma unroll
        for (int nt = 0; nt < 4; ++nt) {
            Frag kf, kb;
            kf.q = *(const uint4*)(T + ((size_t)(b * TW + TC_MLK + h * 64 + nt * 16 + fr)) * UT + u0 + ks * 32 + fq * 8);
            kb.u[0] = pk2(bflo(kf.u[0]) * a0.x * 0.125f, bfhi(kf.u[0]) * a0.y * 0.125f);
            kb.u[1] = pk2(bflo(kf.u[1]) * a0.z * 0.125f, bfhi(kf.u[1]) * a0.w * 0.125f);
            kb.u[2] = pk2(bflo(kf.u[2]) * a1.x * 0.125f, bfhi(kf.u[2]) * a1.y * 0.125f);
            kb.u[3] = pk2(bflo(kf.u[3]) * a1.z * 0.125f, bfhi(kf.u[3]) * a1.w * 0.125f);
            acc[nt] = mfma16(vf.v, kb.v, acc[nt]);
            if (wave == 0) accn[nt] = mfma16(ones.v, kb.v, accn[nt]);
        }
    }
#pragma unroll
    for (int nt = 0; nt < 4; ++nt) {
#pragma unroll
        for (int r = 0; r < 4; ++r) S[(wave * 16 + fq * 4 + r) * 64 + nt * 16 + fr] = acc[nt][r];
        if (wave == 0 && fq == 0) S[4096 + nt * 16 + fr] = accn[nt][0];
    }
}

DEV void ph_m3(const Params& p, int bid, int G) {
    const float* DEC = WSP(float, OFF_DEC);
    float* S = WSP(float, OFF_S);
    const int total = NSCAN * SCH;
    for (int i = bid * 256 + VTID; i < total; i += G * 256) {
        const int sc = i / SCH, e = i - sc * SCH;
        float* base = S + (size_t)sc * NCH * SCH + e;
        const float* mxp = DEC + sc * NCH;
        const float* btp = WSP(float, OFF_MS) + sc * NCH;
        float st = 0.f, m = 0.f;
#pragma unroll 17
        for (int c = 0; c < NCH; ++c) {
            const float tmp = base[(size_t)c * SCH];
            base[(size_t)c * SCH] = st;
            const float bm = btp[c] + m;
            const float mnew = fmaxf(bm, mxp[c]);
            st = expf(bm - mnew) * st + tmp;
            m = mnew;
        }
    }
}

DEV void m4_item(const Params& p, int l, int b, int h, int cu, int ocolbase) {
    u16* P = WSP(u16, OFF_P);
    const u16* T = WSP(u16, OFF_T);
    const int lane = VTID & 63, wave = VTID >> 6, fr = lane & 15, fq = lane >> 4;
    const int u0 = cu * 64;
    const int row0 = rowof(b, u0);
    const int j = wave * 16 + fr;
    Frag qf[2];
#pragma unroll
    for (int ks = 0; ks < 2; ++ks) qf[ks].q = *(const uint4*)(P + (size_t)(row0 + j) * PW + PC_MLQ + h * 64 + ks * 32 + fq * 8);
    f32x4 hsum[4];
#pragma unroll
    for (int dt = 0; dt < 4; ++dt) hsum[dt] = f32x4{0.f, 0.f, 0.f, 0.f};
#pragma unroll 1
    for (int dir = 0; dir < 2; ++dir) {
        const int sc = (b * 4 + h) * 2 + dir;
        int c;
        if (cu >= 64) c = dir ? 3 - (cu - 64) : (cu - 64); else c = 4 + (dir ? 63 - cu : cu);
        const float m0 = m_scan(p, sc, c);
        const float* BC = WSP(float, OFF_BC) + (size_t)sc * UT + u0;
        const float* IG = WSP(float, OFF_IG) + (size_t)sc * UT + u0;
        const float* S = WSP(float, OFF_S) + ((size_t)sc * NCH + c) * SCH;
        const float bj = BC[j];
        f32x4 s[4];
#pragma unroll
        for (int nt = 0; nt < 4; ++nt) s[nt] = f32x4{0.f, 0.f, 0.f, 0.f};
#pragma unroll
        for (int ks = 0; ks < 2; ++ks)
#pragma unroll
            for (int nt = 0; nt < 4; ++nt) {
                Frag kf;
                kf.q = *(const uint4*)(P + (size_t)(row0 + nt * 16 + fr) * PW + PC_MLK + h * 64 + ks * 32 + fq * 8);
                s[nt] = mfma16(kf.v, qf[ks].v, s[nt]);
            }
        float lw[4][4];
        float mx = -1e30f;
#pragma unroll
        for (int nt = 0; nt < 4; ++nt) {
            const float4 bs = *(const float4*)(BC + nt * 16 + fq * 4);
            const float4 is = *(const float4*)(IG + nt * 16 + fq * 4);
            const float bsv[4] = {bs.x, bs.y, bs.z, bs.w}, isv[4] = {is.x, is.y, is.z, is.w};
#pragma unroll
            for (int r = 0; r < 4; ++r) {
                const int sidx = nt * 16 + fq * 4 + r;
                const bool valid = dir ? (sidx >= j) : (sidx <= j);
                lw[nt][r] = valid ? (bj - bsv[r] + isv[r]) : -1e30f;
                mx = fmaxf(mx, lw[nt][r]);
            }
        }
        mx = xq_max(mx);
        const float minter = bj + m0;
        const float mj = fmaxf(minter, mx);
        const float g = fexp(minter - mj);
        float den = 0.f;
#pragma unroll
        for (int nt = 0; nt < 4; ++nt)
#pragma unroll
            for (int r = 0; r < 4; ++r) {
                const float w = fexp(lw[nt][r] - mj);
                const float qk = s[nt][r] * 0.125f * w;
                s[nt][r] = qk;
                den += qk;
            }
        den = xq_sum(den);
        Frag pf[2];
#pragma unroll
        for (int ks = 0; ks < 2; ++ks) {
            pf[ks].u[0] = pk2(s[2 * ks][0], s[2 * ks][1]);
            pf[ks].u[1] = pk2(s[2 * ks][2], s[2 * ks][3]);
            pf[ks].u[2] = pk2(s[2 * ks + 1][0], s[2 * ks + 1][1]);
            pf[ks].u[3] = pk2(s[2 * ks + 1][2], s[2 * ks + 1][3]);
        }
        f32x4 acc[4], accn = f32x4{0.f, 0.f, 0.f, 0.f};
#pragma unroll
        for (int dt = 0; dt < 4; ++dt) acc[dt] = f32x4{0.f, 0.f, 0.f, 0.f};
#pragma unroll
        for (int ks = 0; ks < 2; ++ks) {
            {
                const float4 n0 = *(const float4*)(S + 4096 + ks * 32 + fq * 8), n1 = *(const float4*)(S + 4096 + ks * 32 + fq * 8 + 4);
                Frag nf;
                nf.u[0] = pk2(n0.x, n0.y); nf.u[1] = pk2(n0.z, n0.w); nf.u[2] = pk2(n1.x, n1.y); nf.u[3] = pk2(n1.z, n1.w);
                accn = mfma16(nf.v, qf[ks].v, accn);
            }
#pragma unroll
            for (int dt = 0; dt < 4; ++dt) {
                const float* cp = S + (dt * 16 + fr) * 64 + ks * 32 + fq * 8;
                const float4 c0 = *(const float4*)cp, c1 = *(const float4*)(cp + 4);
                Frag cf;
                cf.u[0] = pk2(c0.x, c0.y); cf.u[1] = pk2(c0.z, c0.w); cf.u[2] = pk2(c1.x, c1.y); cf.u[3] = pk2(c1.z, c1.w);
                acc[dt] = mfma16(cf.v, qf[ks].v, acc[dt]);
            }
        }
#pragma unroll
        for (int dt = 0; dt < 4; ++dt) acc[dt] *= g;
        den += g * accn[0];
#pragma unroll
        for (int ks = 0; ks < 2; ++ks)
#pragma unroll
            for (int dt = 0; dt < 4; ++dt) {
                const u16* vp = T + ((size_t)(b * TW + TC_MLV + h * 64 + dt * 16 + fr)) * UT + u0 + ks * 32 + fq * 4;
                Frag vf;
                vf.d[0] = *(const uint2*)vp;
                vf.d[1] = *(const uint2*)(vp + 16);
                acc[dt] = mfma16(vf.v, pf[ks].v, acc[dt]);
            }
        const float dd = 1.f / fmaxf(fabsf(den), fexp(-mj));
#pragma unroll
        for (int dt = 0; dt < 4; ++dt) hsum[dt] += acc[dt] * dd;
    }
    float ss = 0.f;
#pragma unroll
    for (int dt = 0; dt < 4; ++dt)
#pragma unroll
        for (int r = 0; r < 4; ++r) ss += hsum[dt][r] * hsum[dt][r];
    ss = xq_sum(ss);
    const float rstd = rsqrtf(ss * (1.f / 64.f) + 1e-6f);
    const float* nw = p.ml_norm_w + l * 256 + h * 64;
    u16* orow = P + (size_t)(row0 + j) * PW;
#pragma unroll
    for (int dt = 0; dt < 4; ++dt) {
        const int v0 = dt * 16 + fq * 4;
        const float4 w4 = *(const float4*)(nw + v0);
        const uint2 og = *(const uint2*)(orow + PC_MLO + h * 64 + v0);
        const float y0 = hsum[dt][0] * rstd * w4.x * sigmoidf_(bflo(og.x));
        const float y1 = hsum[dt][1] * rstd * w4.y * sigmoidf_(bfhi(og.x));
        const float y2 = hsum[dt][2] * rstd * w4.z * sigmoidf_(bflo(og.y));
        const float y3 = hsum[dt][3] * rstd * w4.w * sigmoidf_(bfhi(og.y));
        *(uint2*)(orow + ocolbase + h * 64 + v0) = uint2{pk2(y0, y1), pk2(y2, y3)};
    }
}

DEV void ph_attn8(const Params& p, int l, char* smem0, int rbid, int RG) {
    const int n_gq = 768, n_c = (l == 0) ? 96 : 0;
    const int ln_ = (int)((threadIdx.x + p.z) & 63);
    const float bgq = 8.f * wave_max(fabsf(p.gq_qk_w[(l * 2 + 0) * 64 + ln_])) * wave_max(fabsf(p.gq_qk_w[(l * 2 + 1) * 64 + ln_])) * 1.4426950408889634f * 1.03f + 0.5f;
    const float bna = 8.f * wave_max(fabsf(p.na_qk_w[(l * 2 + 0) * 64 + ln_])) * wave_max(fabsf(p.na_qk_w[(l * 2 + 1) * 64 + ln_])) * 1.4426950408889634f * 1.03f + 0.5f;
    for (int it = rbid; it < n_gq + n_c; it += RG) {
        float mfix = bgq;
        int b, qrow0, qcol, kcol, tcol, ua, nt;
        if (it < n_gq) {
            const int qt = it & 15, hq = (it >> 4) % 6;
            b = it / 96; qrow0 = b * SEQ + qt * 256; qcol = PC_GQQ + hq * 64; kcol = PC_GQK + (hq / 3) * 64; tcol = TC_GQV + (hq / 3) * 64; ua = 0; nt = 68;
        } else {
            const int r = it - n_gq;
            const int kind = r / 48, rr = r % 48, hh = rr % 6;
            b = rr / 6; qrow0 = NL + b * CTXL; ua = SEQ; nt = 4;
            if (kind == 0) { qcol = PC_GQQ + hh * 64; kcol = PC_GQK + (hh / 3) * 64; tcol = TC_GQV + (hh / 3) * 64; }
            else { qcol = PC_NAQ + hh * 64; kcol = PC_NAK + hh * 64; tcol = TC_NAV + hh * 64; mfix = bna; }
        }
        flash_item<2, false, 8>(p, b, qrow0, qcol, kcol, tcol, ua, nt, 0, nt, 0, 0, nullptr, smem0, qcol, mfix);
    }
}
DEV void ph_attn(const Params& p, int l, char* smem, int bid, int G, int rep) {
    const int n_na = 3072, n_m2 = NSCAN * NCH;
    const int total = n_na + n_m2;
    const int ln_ = VTID & 63;
    float rmax = 0.f;
    for (int i = ln_; i < 6 * 465; i += 64) rmax = fmaxf(rmax, fabsf(p.na_rpb[(size_t)l * 6 * 465 + i]));
    const float mfix_na = (8.f * wave_max(fabsf(p.na_qk_w[(l * 2 + 0) * 64 + ln_])) * wave_max(fabsf(p.na_qk_w[(l * 2 + 1) * 64 + ln_])) * 1.03f + wave_max(rmax)) * 1.4426950408889634f + 0.5f;
    for (int it = bid; it < total; it += G) {
        int r = it;
        if (r < n_na) {
            const int gr = r & 63, hn = (r >> 6) % 6, b = r / 384;
            int rs = gr - 4; rs = rs < 0 ? 0 : (rs > 56 ? 56 : rs);
            flash_item<1, true, 4>(p, b, b * SEQ + gr * 64, PC_NAQ + hn * 64, PC_NAK + hn * 64, TC_NAV + hn * 64, rs * 64, 8, SEQ, 12, gr, rs,
                                p.na_rpb + (size_t)(l * 6 + hn) * 465, smem, PC_NAQ + hn * 64 + (rep ? 1792 : 0), mfix_na);
            continue;
        }
        r -= n_na;
        m2_item(p, r / NCH, r % NCH);
    }
}

DEV void ph_m4(const Params& p, int l, int bid, int G, int rep) {
    const int nch = (l == 0) ? NCH : 64;
    const int total = NB * 4 * nch;
    for (int it = bid; it < total; it += G) {
        const int cu = it % nch, h = (it / nch) & 3, b = it / (nch * 4);
        m4_item(p, l, b, h, cu, rep ? 2048 : PC_MLQ);
    }
}

DEV void ph_merge(const Params& p, int mt0, int mtiles, char* smem, int vid, int G) {
    const u16* H = WSP(u16, OFF_H);
    u16* P = WSP(u16, OFF_P);
    const u16* Wg = WSP(u16, OFF_W) + WE_MIX + (size_t)2944 * 1024;
    const u16* Wbr = WSP(u16, OFF_W) + WE_BR;
    const int lane = VTID & 63, wave = VTID >> 6, wm = wave >> 1, wn = wave & 1, fr = lane & 15, fq = lane >> 4;
    const int total = mtiles * 16;
    for (int t = vid; t < total; t += G) {
        int mt_, nt_;
        tile_decode(t, 16, mt_, nt_);
        mt_ += mt0;
        const int m0 = mt_ * 128, n0 = nt_ * 64;
        f32x4 y[4][2];
        zero_acc<2>(y);
#pragma unroll 1
        for (int br = 0; br < 3; ++br) {
            const int ko = br == 0 ? 0 : (br == 1 ? 256 : 640);
            const int kk = br == 0 ? 256 : 384;
            f32x4 g[4][2];
            zero_acc<2>(g);
            gemm_accum<2>(g, H + (size_t)m0 * D, D, Wg + (size_t)(br * 1024 + n0) * D, D, D, smem, VTID);
#pragma unroll
            for (int i = 0; i < 4; ++i)
#pragma unroll
                for (int jn = 0; jn < 2; ++jn)
#pragma unroll
                    for (int r = 0; r < 4; ++r) g[i][jn][r] = sigmoidf_(g[i][jn][r]);
            f32x4 a[4][2];
            zero_acc<2>(a);
            gemm_accum<2>(a, P + (size_t)m0 * PW + ko, PW, Wbr + (size_t)n0 * D + ko, D, kk, smem, VTID);
#pragma unroll
            for (int i = 0; i < 4; ++i)
#pragma unroll
                for (int jn = 0; jn < 2; ++jn) y[i][jn] += g[i][jn] * a[i][jn];
        }
#pragma unroll
        for (int mt = 0; mt < 4; ++mt)
#pragma unroll
            for (int nt = 0; nt < 2; ++nt)
#pragma unroll
                for (int r = 0; r < 4; ++r) {
                    const int row = m0 + wm * 64 + mt * 16 + fq * 4 + r;
                    const int col = n0 + wn * 32 + nt * 16 + fr;
                    P[(size_t)row * PW + PC_Y + col] = (u16)(pk2(y[mt][nt][r], 0.f) & 0xffff);
                }
    }
}


#ifdef DBG
constexpr size_t OFF_DBG = al256(WS_END);
__global__ void __launch_bounds__(64) dbg_mlstm(Params p, int l) {
    const int sc = blockIdx.x, dir = sc & 1, h = (sc >> 1) & 3, b = sc >> 3, lane = VTID;
    const u16* P = WSP(u16, OFF_P); const u16* T = WSP(u16, OFF_T); const float* Gt = WSP(float, OFF_G);
    float* HN = WSP(float, OFF_S) + (size_t)sc * UT * 64;
    const float bi = p.ml_gate_b[l * 16 + dir * 8 + h], bf = p.ml_gate_b[l * 16 + dir * 8 + 4 + h];
    float C[64], n[64];
    for (int k = 0; k < 64; ++k) { C[k] = 0.f; n[k] = 0.f; }
    float m = 0.f;
    for (int pos = 0; pos < UT; ++pos) {
        int u;
        if (pos < 256) u = SEQ + (dir ? 255 - pos : pos); else u = dir ? 4095 - (pos - 256) : (pos - 256);
        const int row = rowof(b, u);
        const float ig = Gt[(size_t)row * 16 + dir * 8 + h] + bi;
        const float fp = Gt[(size_t)row * 16 + dir * 8 + 4 + h] + bf;
        const float lf = fminf(fp, 0.f) - log1pf(expf(-fabsf(fp)));
        const float mn = fmaxf(lf + m, ig);
        const float fw = expf(lf + m - mn), iw = expf(ig - mn);
        m = mn;
        const float qv = __uint_as_float(((uint32_t)P[(size_t)row * PW + 2048 + h * 64 + lane]) << 16);
        const float kv = __uint_as_float(((uint32_t)P[(size_t)row * PW + PC_MLK + h * 64 + lane]) << 16) * 0.125f;
        const float vv = __uint_as_float(((uint32_t)T[((size_t)(b * TW + TC_MLV + h * 64 + lane)) * UT + u]) << 16);
        float num = 0.f, den = 0.f;
#pragma unroll
        for (int k = 0; k < 64; ++k) {
            const float kk = __shfl(kv, k), qq = __shfl(qv, k);
            C[k] = fw * C[k] + iw * kk * vv;
            n[k] = fw * n[k] + iw * kk;
            num += qq * C[k];
            den += qq * n[k];
        }
        HN[(size_t)u * 64 + lane] = num / fmaxf(fabsf(den), expf(-m));
    }
}
__global__ void dbg_cmp(Params p, int l) {
    const int gid = blockIdx.x * blockDim.x + VTID;
    const u16* P = WSP(u16, OFF_P); const u16* T = WSP(u16, OFF_T);
    unsigned* dw = (unsigned*)(p.ws + OFF_DBG);
    float* df = (float*)(p.ws + OFF_DBG);
    if (gid < NB * 4 * UT) {
        const int u = gid % UT, h = (gid / UT) & 3, b = gid / (UT * 4);
        const int row = rowof(b, u);
        const float* hf = WSP(float, OFF_S) + ((size_t)((b * 4 + h) * 2 + 0) * UT + u) * 64;
        const float* hb = WSP(float, OFF_S) + ((size_t)((b * 4 + h) * 2 + 1) * UT + u) * 64;
        float ss = 0.f;
        for (int v = 0; v < 64; ++v) { const float x = hf[v] + hb[v]; ss += x * x; }
        const float rstd = rsqrtf(ss / 64.f + 1e-6f);
        float md = 0.f;
        for (int v = 0; v < 64; ++v) {
            const float x = (hf[v] + hb[v]) * rstd * p.ml_norm_w[l * 256 + h * 64 + v];
            const float o = __uint_as_float(((uint32_t)P[(size_t)row * PW + PC_MLO + h * 64 + v]) << 16);
            const float y = x / (1.f + expf(-o));
            const float got = __uint_as_float(((uint32_t)P[(size_t)row * PW + PC_MLQ + h * 64 + v]) << 16);
            md += fabsf(y - got);
        }
        atomicAdd(df + (u < SEQ ? 0 : 1), md * (1.f / 64.f));
        return;
    }
    const int w = (gid - NB * 4 * UT) >> 6;
    const int lane = VTID & 63;
    int type, b, qrow, qc, kcol, tcol, ocol, hn = 0, gr = 0, gc = 0, nkeys;
    if (w < 6144) {
        type = 0; const int i = w & 127; hn = (w >> 7) % 6; b = w / 768;
        gr = i & 63; gc = (i < 64) ? gr : 63 - gr;
        qrow = b * SEQ + gr * 64 + gc; qc = 2048 + 256 + hn * 64; kcol = PC_NAK + hn * 64; tcol = TC_NAV + hn * 64; ocol = PC_NAQ + hn * 64; nkeys = 384;
    } else if (w < 6144 + 256) {
        type = 1; const int x = w - 6144; const int i = x & 15, hh = (x >> 4) & 1; b = x >> 5;
        qrow = b * SEQ + (i * 273) % 4096; qc = 2688 + hh * 64; kcol = PC_GQK + hh * 64; tcol = TC_GQV + hh * 64; ocol = PC_GQQ + hh * 3 * 64; nkeys = 4352;
    } else if (w < 6144 + 256 + 768) {
        type = 2; const int x = w - 6400; const int i = x & 15; hn = (x >> 4) % 6; b = x / 96;
        qrow = NL + b * CTXL + (i * 17) % 256; qc = 2048 + 256 + hn * 64; kcol = PC_NAK + hn * 64; tcol = TC_NAV + hn * 64; ocol = PC_NAQ + hn * 64; nkeys = 256;
    } else if (w < 6144 + 256 + 768 + 256) {
        type = 3; const int x = w - 7168; const int i = x & 15, hh = (x >> 4) & 1; b = x >> 5;
        qrow = NL + b * CTXL + (i * 17) % 256; qc = 2688 + hh * 64; kcol = PC_GQK + hh * 64; tcol = TC_GQV + hh * 64; ocol = PC_GQQ + hh * 3 * 64; nkeys = 256;
    } else return;
    const float q = __uint_as_float(((uint32_t)P[(size_t)qrow * PW + qc + lane]) << 16);
    float o = 0.f;
    int rs = gr - 4; rs = rs < 0 ? 0 : (rs > 56 ? 56 : rs);
    int cs = gc - 8; cs = cs < 0 ? 0 : (cs > 48 ? 48 : cs);
    float mx = -1e30f, lsum = 0.f;
    for (int kidx = 0; kidx < nkeys; ++kidx) {
        int u; float bias = 0.f;
        if (type == 0) {
            if (kidx < 128) {
                const int ri = kidx >> 4, ci = kidx & 15;
                u = (rs + ri) * 64 + cs + ci;
                bias = p.na_rpb[(size_t)(l * 6 + hn) * 465 + (rs + ri - gr + 7) * 31 + (cs + ci - gc + 15)];
            } else u = SEQ + (kidx - 128);
        } else if (type == 1) u = kidx;
        else u = SEQ + kidx;
        const int krow = rowof(b, u);
        float sdot = wave_sum(q * __uint_as_float(((uint32_t)P[(size_t)krow * PW + kcol + lane]) << 16));
        sdot += bias;
        const float mn = fmaxf(mx, sdot);
        const float al = expf(mx - mn), e = expf(sdot - mn);
        lsum = lsum * al + e; mx = mn;
        o = o * al + e * __uint_as_float(((uint32_t)T[((size_t)(b * TW + tcol + lane)) * UT + u]) << 16);
    }
    const float got = __uint_as_float(((uint32_t)P[(size_t)qrow * PW + ocol + lane]) << 16);
    float md = wave_max(fabsf(o / lsum - got));
    if (lane == 0) atomicMax(dw + 2 + type, __float_as_uint(md));
}
__global__ void dbg_copy(Params p) {
    u16* P = WSP(u16, OFF_P);
    for (size_t i = (size_t)blockIdx.x * 256 + VTID; i < (size_t)MTOT * 768; i += (size_t)gridDim.x * 256) {
        const size_t row = i / 768, c = i % 768;
        const size_t src = c < 640 ? c : (c < 704 ? PC_GQQ + (c - 640) : PC_GQQ + 192 + (c - 704));
        P[row * PW + 2048 + c] = P[row * PW + src];
    }
}
DEV int dbg_row(int sr) { return sr < 8 ? sr * 4096 + (sr * 577 + 13) % 4096 : NL + (sr - 8) * 256 + ((sr - 8) * 37 + 5) % 256; }
DEV float* dbg_xrow(const Params& p, int row) { return row < NL ? p.out + (size_t)row * D : WSP(float, OFF_XC) + (size_t)(row - NL) * D; }
DEV float dbg_mod(const Params& p, int l, int b9, int idx, int n) {
    float a = p.ada_b[l * 9216 + idx * 1024 + n];
    for (int k = 0; k < 1024; ++k) {
        const float c = b9 < 8 ? p.c[b9 * 1024 + k] : p.c_ctx[k];
        a += c / (1.f + expf(-c)) * p.ada_w[((size_t)l * 1024 + k) * 9216 + idx * 1024 + n];
    }
    return a;
}
DEV float blk_sum(float v, float* red) {
    v = wave_sum(v);
    __syncthreads();
    if ((VTID & 63) == 0) red[VTID >> 6] = v;
    __syncthreads();
    return red[0] + red[1] + red[2] + red[3];
}
DEV float blk_max(float v, float* red) {
    v = wave_max(v);
    __syncthreads();
    if ((VTID & 63) == 0) red[VTID >> 6] = v;
    __syncthreads();
    return fmaxf(fmaxf(red[0], red[1]), fmaxf(red[2], red[3]));
}
__global__ void dbg_save(Params p, int slot) {
    const int sr = blockIdx.x, row = dbg_row(sr);
    float* dst = (float*)(p.ws + OFF_DBG + 256) + ((size_t)slot * 16 + sr) * 1024;
    const float* src = dbg_xrow(p, row);
    for (int n = VTID; n < 1024; n += 256) dst[n] = src[n];
}
DEV float dbg_modulate(const Params& p, int l, int sub, int b9, const float* xs, float* hs, float* red) {
    float ss = 0.f;
    for (int n = VTID; n < 1024; n += 256) ss += xs[n] * xs[n];
    ss = blk_sum(ss, red);
    const float rstd = rsqrtf(ss / 1024.f + 1e-6f);
    float md = 0.f;
    for (int n = VTID; n < 1024; n += 256) {
        const float sh = dbg_mod(p, l, b9, 3 * sub, n), sc = dbg_mod(p, l, b9, 3 * sub + 1, n);
        md = fmaxf(md, fabsf(sh - WSP(float, OFF_MODS)[b9 * 9216 + (3 * sub) * 1024 + n]));
        md = fmaxf(md, fabsf(sc - WSP(float, OFF_MODS)[b9 * 9216 + (3 * sub + 1) * 1024 + n]));
        hs[n] = xs[n] * rstd * p.norm_w[(l * 3 + sub) * 1024 + n] * (1.f + sc) + sh;
    }
    __syncthreads();
    return md;
}
__global__ void __launch_bounds__(256) dbg_ffn(Params p, int l, int which, int slot, int bit) {
    __shared__ float xs[1024], hs[1024], gs[1024], as[2816], red[4];
    const int sr = blockIdx.x, row = dbg_row(sr), b9 = row < NL ? row >> 12 : 8, sub = which ? 2 : 0;
    const float* xin = (const float*)(p.ws + OFF_DBG + 256) + ((size_t)slot * 16 + sr) * 1024;
    for (int n = VTID; n < 1024; n += 256) xs[n] = xin[n];
    __syncthreads();
    float mdm = dbg_modulate(p, l, sub, b9, xs, hs, red);
    for (int n = VTID; n < 1024; n += 256) gs[n] = dbg_mod(p, l, b9, 3 * sub + 2, n);
    const float* win = p.ffn_w_in + (size_t)(l * 2 + which) * 1024 * 5632;
    const float* wout = p.ffn_w_out + (size_t)(l * 2 + which) * 2816 * 1024;
    for (int j = VTID; j < 2816; j += 256) {
        float g = 0.f, u = 0.f;
        for (int k = 0; k < 1024; ++k) { g += hs[k] * win[(size_t)k * 5632 + j]; u += hs[k] * win[(size_t)k * 5632 + 2816 + j]; }
        as[j] = g / (1.f + expf(-g)) * u;
    }
    __syncthreads();
    float md = 0.f;
    const float* xc = dbg_xrow(p, row);
    for (int n = VTID; n < 1024; n += 256) {
        float o = 0.f;
        for (int j = 0; j < 2816; ++j) o += as[j] * wout[(size_t)j * 1024 + n];
        md = fmaxf(md, fabsf(xs[n] + 0.5f * gs[n] * o - xc[n]));
    }
    md = blk_max(md, red);
    mdm = blk_max(mdm, red);
    unsigned* dw = (unsigned*)(p.ws + OFF_DBG);
    if (VTID == 0) { atomicMax(dw + bit, __float_as_uint(md)); atomicMax(dw + 15, __float_as_uint(mdm)); }
}
__global__ void __launch_bounds__(256) dbg_pchk(Params p, int l) {
    __shared__ float xs[1024], hs[1024], red[4];
    const int sr = blockIdx.x, row = dbg_row(sr), b9 = row < NL ? row >> 12 : 8;
    const float* xin = dbg_xrow(p, row);
    for (int n = VTID; n < 1024; n += 256) xs[n] = xin[n];
    __syncthreads();
    float mdm = dbg_modulate(p, l, 1, b9, xs, hs, red);
    const float* w = p.mix_w_in + (size_t)l * 1024 * NIN;
    const u16* P = WSP(u16, OFF_P); const u16* T = WSP(u16, OFF_T);
    int b, u;
    if (row < NL) { b = row >> 12; u = row & 4095; } else { b = (row - NL) >> 8; u = SEQ + ((row - NL) & 255); }
    float md = 0.f;
    for (int n = VTID; n < 2832; n += 256) {
        const int sc = map_col(2, n);
        float v = 0.f;
        for (int k = 0; k < 1024; ++k) v += hs[k] * w[(size_t)k * NIN + sc];
        if (n < 2048) md = fmaxf(md, fabsf(v - __uint_as_float(((uint32_t)P[(size_t)row * PW + n]) << 16)));
        if (n >= 1280 && n < 1536) md = fmaxf(md, fabsf(v - __uint_as_float(((uint32_t)T[((size_t)(b * TW + n - 1280)) * UT + u]) << 16)));
        if (n >= 2048 && n < 2816) md = fmaxf(md, fabsf(v - __uint_as_float(((uint32_t)T[((size_t)(b * TW + n - 1792)) * UT + u]) << 16)));
        if (n >= 2816) md = fmaxf(md, fabsf(v - WSP(float, OFF_G)[(size_t)row * 16 + n - 2816]));
    }
    md = blk_max(md, red);
    mdm = blk_max(mdm, red);
    unsigned* dw = (unsigned*)(p.ws + OFF_DBG);
    if (VTID == 0) { atomicMax(dw + 9, __float_as_uint(md)); atomicMax(dw + 15, __float_as_uint(mdm)); }
}
__global__ void __launch_bounds__(256) dbg_mix(Params p, int l, int slot) {
    __shared__ float xs[1024], hs[1024], os[1024], ys[1024], red[4];
    const int sr = blockIdx.x, row = dbg_row(sr), b9 = row < NL ? row >> 12 : 8;
    const float* xin = (const float*)(p.ws + OFF_DBG + 256) + ((size_t)slot * 16 + sr) * 1024;
    const u16* P = WSP(u16, OFF_P);
    for (int n = VTID; n < 1024; n += 256) { xs[n] = xin[n]; os[n] = __uint_as_float(((uint32_t)P[(size_t)row * PW + n]) << 16); }
    __syncthreads();
    float mdm = dbg_modulate(p, l, 1, b9, xs, hs, red);
    const float* w = p.mix_w_in + (size_t)l * 1024 * NIN;
    for (int n = VTID; n < 1024; n += 256) {
        float y = 0.f;
        for (int i = 0; i < 3; ++i) {
            float g = 0.f;
            for (int k = 0; k < 1024; ++k) g += hs[k] * w[(size_t)k * NIN + 2832 + i * 1024 + n];
            g = 1.f / (1.f + expf(-g));
            const float* wb = i == 0 ? p.w_br_ml + (size_t)l * 256 * 1024 : (i == 1 ? p.w_br_na + (size_t)l * 384 * 1024 : p.w_br_gq + (size_t)l * 384 * 1024);
            const int ko = i == 0 ? 0 : (i == 1 ? 256 : 640), kk = i == 0 ? 256 : 384;
            float a = 0.f;
            for (int k = 0; k < kk; ++k) a += os[ko + k] * wb[(size_t)k * 1024 + n];
            y += g * a;
        }
        ys[n] = y;
    }
    __syncthreads();
    float md = 0.f;
    const float* xc = dbg_xrow(p, row);
    for (int n = VTID; n < 1024; n += 256) {
        float o = 0.f;
        for (int k = 0; k < 1024; ++k) o += ys[k] * p.w_out[((size_t)l * 1024 + k) * 1024 + n];
        const float g5 = dbg_mod(p, l, b9, 5, n);
        md = fmaxf(md, fabsf(xs[n] + g5 * o - xc[n]));
    }
    md = blk_max(md, red);
    mdm = blk_max(mdm, red);
    unsigned* dw = (unsigned*)(p.ws + OFF_DBG);
    if (VTID == 0) { atomicMax(dw + 10, __float_as_uint(md)); atomicMax(dw + 15, __float_as_uint(mdm)); }
}
__global__ void dbg_fin(Params p) {
    const unsigned* dw = (const unsigned*)(p.ws + OFF_DBG);
    int mask = 0;
    if (__uint_as_float(dw[8]) > 0.02f) mask |= 1;
    if (__uint_as_float(dw[9]) > 0.03f) mask |= 2;
    if (__uint_as_float(dw[10]) > 0.02f) mask |= 4;
    if (__uint_as_float(dw[11]) > 0.02f) mask |= 8;
    if (__uint_as_float(dw[15]) > 1e-3f) mask |= 16;
    if (__uint_as_float(dw[4]) > 0.03f) mask |= 32;
    p.out[0] += 10.f * (float)mask;
    p.out[1] += 1000.f * __uint_as_float(dw[4]);
}
#endif


DEV void gemm8b_accum(f32x4 (&acc)[4][4], const u16* __restrict__ A, int lda, const u16* __restrict__ B, int ldb, int K, char* smem, int tid) {
    constexpr int STAGE = 49152;
    const int lane = tid & 63, wave = tid >> 6;
    const int wm = wave >> 1, wn = wave & 1, fr = lane & 15, fq = lane >> 4;
    const int lr = lane >> 3, pos = lane & 7;
    const int ce = pos ^ (lr >> 1), co = pos ^ (4 | (lr >> 1));
    const unsigned ra_ = (unsigned)((wave * 32 + lr) * lda) * 2u, rb_ = (unsigned)((wave * 16 + lr) * ldb) * 2u;
    const unsigned voa_e = ra_ + ce * 16, voa_o = ra_ + co * 16, vob_e = rb_ + ce * 16, vob_o = rb_ + co * 16;
    const int nk = K >> 6;
    const unsigned ldsb = (unsigned)(size_t)(__attribute__((address_space(3))) char*)smem;
    const unsigned ldsa_w = __builtin_amdgcn_readfirstlane(ldsb + wave * 4096);
    const unsigned ldsb_w = __builtin_amdgcn_readfirstlane(ldsb + 32768 + wave * 2048);
#define G8B_ISSUE(STG, K0) do { \
        _Pragma("unroll") for (int i = 0; i < 4; ++i) glds16(A + (size_t)(8 * i) * lda + (K0), (i & 1) ? voa_o : voa_e, ldsa_w + (STG) * STAGE + i * 1024); \
        _Pragma("unroll") for (int i = 0; i < 2; ++i) glds16(B + (size_t)(8 * i) * ldb + (K0), (i & 1) ? vob_o : vob_e, ldsb_w + (STG) * STAGE + i * 1024); \
    } while (0)
    G8B_ISSUE(0, 0);
    VM_WAIT0();
    __syncthreads();
    const int s3 = (fr >> 1) & 7;
    const int oa_base = (wm * 64 + fr) * 128 + ((fq ^ s3) * 16);
    const int ob_base = 32768 + (wn * 64 + fr) * 128 + ((fq ^ s3) * 16);
    for (int kt = 0; kt < nk; ++kt) {
        const int cur = kt & 1;
        const int k0 = (kt + 1 < nk ? kt + 1 : kt) * 64;
        G8B_ISSUE(cur ^ 1, k0);
        int o_a = cur * STAGE + oa_base, o_b = cur * STAGE + ob_base;
        asm volatile("" : "+v"(o_a), "+v"(o_b));
#pragma unroll
        for (int ks = 0; ks < 2; ++ks) {
            const char* sa_c = smem + (ks ? (o_a ^ 64) : o_a);
            const char* sb_c = smem + (ks ? (o_b ^ 64) : o_b);
            bf16x8 bfr[4], af[4];
#pragma unroll
            for (int nt = 0; nt < 4; ++nt) bfr[nt] = *(const bf16x8*)(sb_c + nt * 2048);
#pragma unroll
            for (int mt = 0; mt < 4; ++mt) af[mt] = *(const bf16x8*)(sa_c + mt * 2048);
#pragma unroll
            for (int mt = 0; mt < 4; ++mt)
#pragma unroll
                for (int nt = 0; nt < 4; ++nt) acc[mt][nt] = mfma16(af[mt], bfr[nt], acc[mt][nt]);
            __builtin_amdgcn_sched_group_barrier(0x100, 7, 0);
            __builtin_amdgcn_sched_group_barrier(0x008, 4, 0);
            __builtin_amdgcn_sched_group_barrier(0x100, 1, 0);
#pragma unroll
            for (int i = 0; i < 3; ++i) __builtin_amdgcn_sched_group_barrier(0x008, 4, 0);
        }
        VM_WAIT0();
        __syncthreads();
    }
#undef G8B_ISSUE
}

DEV void ph_merge8(const Params& p, char* smem, int rvid, int RG, int tid) {
    const u16* H = WSP(u16, OFF_H);
    u16* P = WSP(u16, OFF_P);
    const u16* Wg = WSP(u16, OFF_W) + WE_MIX + (size_t)2944 * 1024;
    const u16* Wbr = WSP(u16, OFF_W) + WE_BR;
    const int lane = tid & 63, wave = tid >> 6, wm = wave >> 1, wn = wave & 1, fr = lane & 15, fq = lane >> 4;
    const int total = 128 * 8;
    for (int t = rvid; t < total; t += RG) {
        const int gi = t >> 5, rem = t & 31;
        const int mt_ = gi * 4 + (rem & 3), nt_ = rem >> 2;
        const int m0 = mt_ * 256, n0 = nt_ * 128;
        f32x4 y[4][4];
        zero_acc<4>(y);
#pragma unroll 1
        for (int br = 0; br < 3; ++br) {
            const int ko = br == 0 ? 0 : (br == 1 ? 256 : 640);
            const int kk = br == 0 ? 256 : 384;
            uint32_t gpk[4][4][2];
            {
                f32x4 g[4][4];
                zero_acc<4>(g);
                gemm8b_accum(g, H + (size_t)m0 * D, D, Wg + (size_t)(br * 1024 + n0) * D, D, D, smem, tid);
#pragma unroll
                for (int i = 0; i < 4; ++i)
#pragma unroll
                    for (int jn = 0; jn < 4; ++jn) {
                        gpk[i][jn][0] = pk2(sigmoidf_(g[i][jn][0]), sigmoidf_(g[i][jn][1]));
                        gpk[i][jn][1] = pk2(sigmoidf_(g[i][jn][2]), sigmoidf_(g[i][jn][3]));
                    }
            }
            f32x4 a[4][4];
            zero_acc<4>(a);
            gemm8b_accum(a, P + (size_t)m0 * PW + ko, PW, Wbr + (size_t)n0 * D + ko, D, kk, smem, tid);
#pragma unroll
            for (int i = 0; i < 4; ++i)
#pragma unroll
                for (int jn = 0; jn < 4; ++jn) {
                    y[i][jn][0] += bflo(gpk[i][jn][0]) * a[i][jn][0];
                    y[i][jn][1] += bfhi(gpk[i][jn][0]) * a[i][jn][1];
                    y[i][jn][2] += bflo(gpk[i][jn][1]) * a[i][jn][2];
                    y[i][jn][3] += bfhi(gpk[i][jn][1]) * a[i][jn][3];
                }
        }
#pragma unroll
        for (int mt = 0; mt < 4; ++mt)
#pragma unroll
            for (int nt = 0; nt < 4; ++nt)
#pragma unroll
                for (int r = 0; r < 4; ++r) {
                    const int row = m0 + wm * 64 + mt * 16 + fq * 4 + r;
                    const int col = n0 + wn * 64 + nt * 16 + fr;
                    P[(size_t)row * PW + PC_Y + col] = (u16)(pk2(y[mt][nt][r], 0.f) & 0xffff);
                }
    }
}

constexpr int PH_PER_LAYER = 15;
constexpr int N_PHASES = 2 * PH_PER_LAYER;

#ifndef REPEAT_MASK
#define REPEAT_MASK 0
#endif
template <int Q>
DEV void run_phase_q(const Params& p, int l, char* smem) {
    const int half = (int)((threadIdx.x + p.z) >> 8);
    const int G = gridDim.x * 2, bid = blockIdx.x * 2 + half;
    const int vid = (gridDim.x % 8 == 0) ? (int)(blockIdx.x & 7) * (G >> 3) + (int)(blockIdx.x >> 3) * 2 + half : bid;
    smem += half * 73728;
    const bool last = (l == 1);
    const u16* W = WSP(u16, OFF_W);
    const int nrep = ((REPEAT_MASK >> Q) & 1) ? 2 : 1;
    char* smem0 = smem - half * 73728;
    const int rtid = (int)(threadIdx.x + p.z);
    const int RG = gridDim.x;
    const int rvid = (RG % 8 == 0) ? (int)(blockIdx.x & 7) * (RG >> 3) + (int)(blockIdx.x >> 3) : (int)blockIdx.x;
    for (int rep = 0; rep < nrep; ++rep) {
        const float cm = rep ? 0.f : 1.f;
        if (Q == 0) ph_prep(p, l, smem, bid, G);
        if (Q == 1) ph_mod(p, l, 0, MTOT, bid, G);
        Params p2 = p;
        if (Q == 2) { ph_ffn_in8(p, 0, 136, smem0, rvid, RG, rtid); }
        if (Q == 3) { ph_resid8(p, WSP(u16, OFF_P), DFF, W + WE_OUT0, DFF, 2, 0.5f * cm, smem0, rvid, RG, rtid, l == 0 ? p.x : p.out); int z2 = p.z; asm volatile("" : "+s"(z2) :: "memory"); p2.z = z2;
                      ph_resid(p2, WSP(u16, OFF_P), DFF, W + WE_OUT0, DFF, 2, 0.5f * cm, 256, 16, smem, vid, G); }
        if (Q == 4) ph_mod(p, l, 1, MTOT, bid, G);
        if (Q == 5) { ph_pgemm8(p, l, smem0, rvid, RG, rtid); int z2 = p.z; asm volatile("" : "+s"(z2) :: "memory"); p2.z = z2; ph_pgemm(p2, 256, 16, smem, vid, G); }
        if (Q == 6) ph_qknorm_gates(p, l, bid, G);
        if (Q == 7) { ph_attn8(p, l, smem0, rvid, RG); int z2 = p.z; asm volatile("" : "+s"(z2) :: "memory"); p2.z = z2; ph_attn(p2, l, smem, bid, G, rep); }
        if (Q == 8) ph_m3(p, bid, G);
        if (Q == 9) ph_m4(p, l, bid, G, rep);
        if (Q == 10) { ph_merge8(p, smem0, rvid, RG, rtid); int z2 = p.z; asm volatile("" : "+s"(z2) :: "memory"); p2.z = z2; if (!last) ph_merge(p2, 256, 16, smem, vid, G); }
        if (Q == 11) { ph_resid8(p, WSP(u16, OFF_P) + PC_Y, PW, W + WE_O, D, 5, 1.0f * cm, smem0, rvid, RG, rtid, p.out);
                       int z2 = p.z; asm volatile("" : "+s"(z2) :: "memory"); p2.z = z2;
                       if (!last) ph_resid(p2, WSP(u16, OFF_P) + PC_Y, PW, W + WE_O, D, 5, 1.0f * cm, 256, 16, smem, vid, G); }
        if (Q == 12) ph_mod(p, l, 2, last ? NL : MTOT, bid, G);
        if (Q == 13) { ph_ffn_in8(p, 1, last ? 128 : 136, smem0, rvid, RG, rtid); }
        if (Q == 14) { ph_resid8(p, WSP(u16, OFF_P), DFF, W + WE_OUT1, DFF, 8, 0.5f * cm, smem0, rvid, RG, rtid, p.out);
                       int z2 = p.z; asm volatile("" : "+s"(z2) :: "memory"); p2.z = z2;
                       if (!last) ph_resid(p2, WSP(u16, OFF_P), DFF, W + WE_OUT1, DFF, 8, 0.5f * cm, 256, 16, smem, vid, G); }
    }
}

DEV void run_phase(const Params& p, int ph, char* smem) {
    const int l = ph / PH_PER_LAYER, q = ph % PH_PER_LAYER;
    switch (q) {
        case 0: run_phase_q<0>(p, l, smem); break;
        case 1: run_phase_q<1>(p, l, smem); break;
        case 2: run_phase_q<2>(p, l, smem); break;
        case 3: run_phase_q<3>(p, l, smem); break;
        case 4: run_phase_q<4>(p, l, smem); break;
        case 5: run_phase_q<5>(p, l, smem); break;
        case 6: run_phase_q<6>(p, l, smem); break;
        case 7: run_phase_q<7>(p, l, smem); break;
        case 8: run_phase_q<8>(p, l, smem); break;
        case 9: run_phase_q<9>(p, l, smem); break;
        case 10: run_phase_q<10>(p, l, smem); break;
        case 11: run_phase_q<11>(p, l, smem); break;
        case 12: run_phase_q<12>(p, l, smem); break;
        case 13: run_phase_q<13>(p, l, smem); break;
        case 14: run_phase_q<14>(p, l, smem); break;
    }
}

template <int Q>
__global__ void __launch_bounds__(256, 2) phase_kernel(Params p, int l) {
    __shared__ __attribute__((aligned(16))) char smem[73728];
    run_phase_q<Q>(p, l, smem);
}

#if ONE_LAUNCH
#define XB_TMO      128
#define XB_XCNT(j)  (256  + 64 * (j))
#define XB_XSUB(j)  (1280 + 64 * (j))
#define XB_XGEN(j)  (2304 + 64 * (j))
#define XB_TOP      3328
#define XB_TOPGEN   3392
#define XB_SPIN_CAP (1u << 22)
DEV unsigned xb_ld(unsigned* q) { return __hip_atomic_load(q, __ATOMIC_RELAXED, __HIP_MEMORY_SCOPE_AGENT); }
DEV unsigned xb_add(unsigned* q, unsigned v) { return __hip_atomic_fetch_add(q, v, __ATOMIC_RELAXED, __HIP_MEMORY_SCOPE_AGENT); }
DEV unsigned xb_xcc_id() { return (unsigned)__builtin_amdgcn_s_getreg((3 << 11) | 20) & 0xFu; }
#define XB_SPIN(cond, bar) do { unsigned _sp = 0; while (cond) { __builtin_amdgcn_s_sleep(1); \
    if ((++_sp & 255u) == 0u) { if (xb_ld(&(bar)[XB_TMO])) break; if (_sp > XB_SPIN_CAP) { atomicAdd(&(bar)[XB_TMO], 1u); break; } } } } while (0)
DEV void xcd_census(unsigned* bar, unsigned x, unsigned& nloc, unsigned& nx) {
    const unsigned G = gridDim.x;
    unsigned sum, cnt, mine, sp = 0u;
    for (;;) {
        sum = 0u; cnt = 0u; mine = 0u;
#pragma unroll
        for (unsigned j = 0; j < 16; ++j) { const unsigned c = xb_ld(&bar[XB_XCNT(j)]); sum += c; cnt += (c > 0u) ? 1u : 0u; mine = (j == x) ? c : mine; }
        if (sum == G) break;
        __builtin_amdgcn_s_sleep(1);
        if ((++sp & 255u) == 0u) { if (xb_ld(&bar[XB_TMO])) break; if (sp > XB_SPIN_CAP) { atomicAdd(&bar[XB_TMO], 1u); break; } }
    }
    nloc = mine > 0u ? mine : 1u; nx = cnt > 0u ? cnt : 1u;
}
DEV void xcd_barrier(unsigned* bar, unsigned x, volatile unsigned* st, int tid) {
    asm volatile("s_waitcnt vmcnt(0)" ::: "memory");
    __syncthreads();
    if (tid == 0) {
        __builtin_amdgcn_s_waitcnt(0);
        unsigned nloc = st[0], nx = st[1];
        if (nloc == 0u) { xcd_census(bar, x, nloc, nx); st[0] = nloc; st[1] = nx; }
        const unsigned old = xb_add(&bar[XB_XSUB(x)], 1u);
        const unsigned gen = old / nloc;
        if (old + 1u == (gen + 1u) * nloc) {
            __builtin_amdgcn_fence(__ATOMIC_RELEASE, "agent");
            asm volatile("s_waitcnt vmcnt(0)" ::: "memory");
            const unsigned og = xb_add(&bar[XB_TOP], 1u);
            const unsigned tg = og / nx;
            if (og + 1u == (tg + 1u) * nx) xb_add(&bar[XB_TOPGEN], 1u);
            else XB_SPIN(xb_ld(&bar[XB_TOPGEN]) == tg, bar);
            __builtin_amdgcn_fence(__ATOMIC_ACQUIRE, "agent");
            xb_add(&bar[XB_XGEN(x)], 1u);
            asm volatile("s_waitcnt vmcnt(0)" ::: "memory");
        } else {
            XB_SPIN(xb_ld(&bar[XB_XGEN(x)]) == gen, bar);
            __builtin_amdgcn_fence(__ATOMIC_ACQUIRE, "agent");
            asm volatile("s_waitcnt vmcnt(0)" ::: "memory");
        }
    }
    __syncthreads();
}
__global__ void __launch_bounds__(512, 2) mega_kernel(Params p0, int ph_begin, int ph_end) {
    __shared__ __attribute__((aligned(16))) char smem[147456];
    __shared__ uint4 xb_words;
    unsigned* bar = (unsigned*)(p0.ws + OFF_BAR);
    const unsigned xcc = xb_xcc_id();
    if (threadIdx.x == 0) { xb_words = make_uint4(0u, 0u, 0u, 0u); (void)xb_add(&bar[XB_XCNT(xcc)], 1u); }
    __syncthreads();
    for (int ph = ph_begin; ph < ph_end; ++ph) {
        Params p = p0;
        int z = p0.z;
        asm volatile("" : "+s"(z));
        p.z = z;
        p.ws = p0.ws + z;
        p.out = p0.out + z;
        run_phase(p, ph, smem);
        if (ph + 1 < ph_end) {
            if (p0.z == 0x7fffffff) cg::this_grid().sync();
            xcd_barrier(bar, xcc, (volatile unsigned*)&xb_words, (int)threadIdx.x + z);
        }
    }
}
#endif

extern "C" void kernel_launch(void* const* d_in, const int* in_sizes, int n_in, void* d_out, int out_size, void* d_ws, size_t ws_size,
                              hipStream_t stream) {
    if (ws_size < WS_END) { fprintf(stderr, "workspace too small: %zu < %zu\n", ws_size, (size_t)WS_END); return; }
    Params p{};
    p.x = (const float*)d_in[0]; p.c = (const float*)d_in[1]; p.ctx = (const float*)d_in[2]; p.c_ctx = (const float*)d_in[3];
    p.ada_w = (const float*)d_in[4]; p.ada_b = (const float*)d_in[5]; p.norm_w = (const float*)d_in[6];
    p.ffn_w_in = (const float*)d_in[7]; p.ffn_w_out = (const float*)d_in[8]; p.mix_w_in = (const float*)d_in[9];
    p.ml_gate_b = (const float*)d_in[10]; p.ml_norm_w = (const float*)d_in[11]; p.na_qk_w = (const float*)d_in[12];
    p.na_rpb = (const float*)d_in[13]; p.gq_qk_w = (const float*)d_in[14]; p.w_br_ml = (const float*)d_in[15];
    p.w_br_na = (const float*)d_in[16]; p.w_br_gq = (const float*)d_in[17]; p.w_out = (const float*)d_in[18];
    p.out = (float*)d_out; p.ws = (char*)d_ws;
#ifdef NANFILL
    hipMemsetAsync(d_ws, 0xFF, WS_END, stream);
#endif
#if ONE_LAUNCH
    static int grid_blocks = 0;
    if (!grid_blocks) {
        int dev = 0, cus = 0, per_cu = 0;
        hipGetDevice(&dev);
        hipDeviceGetAttribute(&cus, hipDeviceAttributeMultiprocessorCount, dev);
        hipOccupancyMaxActiveBlocksPerMultiprocessor(&per_cu, mega_kernel, 512, 0);
        per_cu = 1;
        grid_blocks = cus * per_cu;
    }
    hipMemsetAsync((char*)d_ws + OFF_BAR, 0, 3456 * 4, stream);
    int pb = 0, pe = N_PHASES;
    void* args[] = {&p, &pb, &pe};
#ifdef SPLIT_TEST
    (void)args;
    for (int ph = 0; ph < N_PHASES; ++ph) mega_kernel<<<grid_blocks, 256, 0, stream>>>(p, ph, ph + 1);
#else
    hipError_t e = hipLaunchCooperativeKernel((void*)mega_kernel, dim3(grid_blocks), dim3(512), args, 0, stream);
    if (e != hipSuccess) fprintf(stderr, "cooperative launch failed: %s (grid %d)\n", hipGetErrorString(e), grid_blocks);
#endif
#else
    for (int l = 0; l < 2; ++l) {
#define LP(Q) phase_kernel<Q><<<512, 256, 0, stream>>>(p, l)
#ifdef DBG
        const bool dl = (l == DBG_LAYER);
        if (dl) hipMemsetAsync((char*)d_ws + OFF_DBG, 0, 256, stream);
        LP(0);
        if (dl) dbg_save<<<16, 256, 0, stream>>>(p, 0);
        LP(1); LP(2); LP(3);
        if (dl) dbg_ffn<<<16, 256, 0, stream>>>(p, l, 0, 0, 8);
        LP(4); LP(5);
        if (dl) dbg_pchk<<<16, 256, 0, stream>>>(p, l);
        LP(6);
        if (dl) dbg_copy<<<2048, 256, 0, stream>>>(p);
        LP(7); LP(8); LP(9);
        if (dl) {
            dbg_mlstm<<<64, 64, 0, stream>>>(p, l);
            dbg_cmp<<<(NB * 4 * UT + 7424 * 64 + 255) / 256, 256, 0, stream>>>(p, l);
            dbg_save<<<16, 256, 0, stream>>>(p, 1);
        }
        LP(10); LP(11);
        if (dl) { dbg_mix<<<16, 256, 0, stream>>>(p, l, 1); dbg_save<<<16, 256, 0, stream>>>(p, 2); }
        LP(12); LP(13); LP(14);
        if (dl) dbg_ffn<<<16, 256, 0, stream>>>(p, l, 1, 2, 11);
#else
        LP(0); LP(1); LP(2); LP(3); LP(4); LP(5); LP(6); LP(7); LP(8); LP(9); LP(10); LP(11); LP(12); LP(13); LP(14);
#endif
#undef LP
    }
#ifdef DBG
    dbg_fin<<<1, 1, 0, stream>>>(p);
#endif
#endif
}
```

```cpp
#include <hip/hip_runtime.h>
#include <hip/hip_cooperative_groups.h>
#include <stdint.h>
#include <cstdio>
namespace cg = cooperative_groups;

#ifndef ONE_LAUNCH
#define ONE_LAUNCH 1
#endif

#define VTID ((int)((threadIdx.x + p.z) & 255))
typedef unsigned short u16;
typedef __attribute__((ext_vector_type(8))) short bf16x8;
typedef __attribute__((ext_vector_type(4))) float f32x4;
#define DEV __device__ __forceinline__

constexpr int D = 1024, NB = 8, SEQ = 4096, CTXL = 256;
constexpr int NL = NB * SEQ, NCX = NB * CTXL, MTOT = NL + NCX;
constexpr int DFF = 2816, PW = 2816, UT = SEQ + CTXL, NCH = UT / 64;
constexpr int NIN = 5904;
constexpr int PC_MLQ = 0, PC_NAQ = 256, PC_GQQ = 640, PC_MLO = 1024, PC_MLK = 1280, PC_NAK = 1536, PC_GQK = 1920,
              PC_MLV = 2048, PC_NAV = 2304, PC_GQV = 2688, PC_Y = 1024;
constexpr int TC_MLK = 0, TC_MLV = 256, TC_NAV = 512, TC_GQV = 896, TW = 1024;
constexpr int DBG_MLO = PC_MLQ, DBG_NAO = PC_NAQ;
constexpr int SCH = 4160;
constexpr int NSCAN = 64;

constexpr size_t al256(size_t x) { return (x + 255) & ~(size_t)255; }
constexpr size_t OFF_MODS = 0;
constexpr size_t OFF_ROPE = al256(OFF_MODS + (size_t)9 * 9216 * 4);
constexpr size_t OFF_G    = al256(OFF_ROPE + (size_t)4096 * 64 * 4);
constexpr size_t OFF_BC   = al256(OFF_G + (size_t)MTOT * 16 * 4);
constexpr size_t OFF_IG   = al256(OFF_BC + (size_t)NSCAN * UT * 4);
constexpr size_t OFF_AE   = al256(OFF_IG + (size_t)NSCAN * UT * 4);
constexpr size_t OFF_MS   = al256(OFF_AE + (size_t)NSCAN * UT * 4);
constexpr size_t OFF_DEC  = al256(OFF_MS + (size_t)NSCAN * NCH * 4);
constexpr size_t OFF_XC   = al256(OFF_DEC + (size_t)NSCAN * NCH * 4);
constexpr size_t OFF_H    = al256(OFF_XC + (size_t)NCX * D * 4);
constexpr size_t OFF_P    = al256(OFF_H + (size_t)MTOT * D * 2);
constexpr size_t OFF_T    = al256(OFF_P + (size_t)MTOT * PW * 2);
constexpr size_t OFF_S    = al256(OFF_T + (size_t)NB * TW * UT * 2);
constexpr size_t OFF_W    = al256(OFF_S + (size_t)NSCAN * NCH * SCH * 4);
constexpr size_t WE_IN0 = 0, WE_IN1 = WE_IN0 + (size_t)5632 * 1024, WE_OUT0 = WE_IN1 + (size_t)5632 * 1024,
                 WE_OUT1 = WE_OUT0 + (size_t)1024 * 2816, WE_MIX = WE_OUT1 + (size_t)1024 * 2816,
                 WE_BR = WE_MIX + (size_t)6016 * 1024, WE_O = WE_BR + (size_t)1024 * 1024, WE_END = WE_O + (size_t)1024 * 1024;
constexpr size_t OFF_BAR = al256(OFF_W + WE_END * 2);
constexpr size_t OFF_PART = al256(OFF_BAR + 3456 * 4);
constexpr size_t WS_END = OFF_PART + (size_t)4 * NCX * D * 4;
static_assert(WS_END < (size_t)536000000, "workspace too large");

struct Params {
    const float *x, *c, *ctx, *c_ctx, *ada_w, *ada_b, *norm_w, *ffn_w_in, *ffn_w_out, *mix_w_in, *ml_gate_b, *ml_norm_w,
        *na_qk_w, *na_rpb, *gq_qk_w, *w_br_ml, *w_br_na, *w_br_gq, *w_out;
    float* out;
    char* ws;
    int z, pad;
};

DEV uint32_t pk2(float lo, float hi) { uint32_t r; asm("v_cvt_pk_bf16_f32 %0, %1, %2" : "=v"(r) : "v"(lo), "v"(hi)); return r; }
DEV float bflo(uint32_t w) { return __uint_as_float(w << 16); }
DEV float bfhi(uint32_t w) { return __uint_as_float(w & 0xffff0000u); }
DEV f32x4 mfma16(bf16x8 a, bf16x8 b, f32x4 c) { return __builtin_amdgcn_mfma_f32_16x16x32_bf16(a, b, c, 0, 0, 0); }
typedef unsigned u32x4 __attribute__((ext_vector_type(4)));
DEV u32x4 gld16(const void* q) { u32x4 r; asm volatile("global_load_dwordx4 %0, %1, off" : "=v"(r) : "v"(q) : "memory"); return r; }
DEV u32x4 gld16s(const void* sbase, unsigned voff) { u32x4 r; asm volatile("global_load_dwordx4 %0, %1, %2" : "=v"(r) : "v"(voff), "s"(sbase) : "memory"); return r; }
DEV void glds16(const void* sbase, unsigned voff, unsigned ldsaddr) {
    asm volatile("s_mov_b32 m0, %2\n\ts_nop 0\n\tglobal_load_lds_dwordx4 %0, %1" :: "v"(voff), "s"(sbase), "s"(ldsaddr) : "memory", "m0");
}
#define VM_WAIT0() asm volatile("s_waitcnt vmcnt(0)" ::: "memory")
union Frag { bf16x8 v; uint4 q; uint32_t u[4]; uint2 d[2]; };
DEV int cu_of(int c, int dir) { return c < 4 ? 64 + (dir ? 3 - c : c) : (dir ? 63 - (c - 4) : (c - 4)); }
DEV int rowof(int b, int u) { return u < SEQ ? b * SEQ + u : NL + b * CTXL + (u - SEQ); }
DEV float fexp2(float x) { return __builtin_amdgcn_exp2f(x); }
DEV float fexp(float x) { return __builtin_amdgcn_exp2f(x * 1.4426950408889634f); }
DEV float sigmoidf_(float x) { return 1.f / (1.f + fexp(-x)); }
DEV float xq_max(float v) {
    auto r = __builtin_amdgcn_permlane16_swap(__float_as_uint(v), __float_as_uint(v), false, false);
    const float m = fmaxf(__uint_as_float(r[0]), __uint_as_float(r[1]));
    auto q = __builtin_amdgcn_permlane32_swap(__float_as_uint(m), __float_as_uint(m), false, false);
    return fmaxf(__uint_as_float(q[0]), __uint_as_float(q[1]));
}
DEV float xq_sum(float v) {
    auto r = __builtin_amdgcn_permlane16_swap(__float_as_uint(v), __float_as_uint(v), false, false);
    const float m = __uint_as_float(r[0]) + __uint_as_float(r[1]);
    auto q = __builtin_amdgcn_permlane32_swap(__float_as_uint(m), __float_as_uint(m), false, false);
    return __uint_as_float(q[0]) + __uint_as_float(q[1]);
}
DEV float wave_sum(float v) {
#pragma unroll
    for (int o = 1; o < 64; o <<= 1) v += __shfl_xor(v, o);
    return v;
}
DEV float wave_max(float v) {
#pragma unroll
    for (int o = 1; o < 64; o <<= 1) v = fmaxf(v, __shfl_xor(v, o));
    return v;
}

#define WSP(T_, off) ((T_*)(p.ws + (off)))
DEV float m_scan(const Params& p, int sc, int c_end) {
    const float* BT = WSP(float, OFF_MS) + sc * NCH;
    const float* MX = WSP(float, OFF_DEC) + sc * NCH;
    const int lane = VTID & 63;
    const float bt0 = BT[lane], mx0 = MX[lane], bt1 = BT[64 + (lane & 3)], mx1 = MX[64 + (lane & 3)];
    float m = 0.f;
    for (int c = 0; c < c_end; ++c) {
        const float b = c < 64 ? __shfl(bt0, c) : __shfl(bt1, c - 64);
        const float x = c < 64 ? __shfl(mx0, c) : __shfl(mx1, c - 64);
        m = fmaxf(b + m, x);
    }
    return m;
}

template <int TN>
DEV void gemm_accum(f32x4 (&acc)[4][TN], const u16* __restrict__ A, int lda, const u16* __restrict__ B, int ldb, int K, char* smem, int tid) {
    constexpr int BROWS = TN * 32;
    constexpr int STAGE = (128 + BROWS) * 144;
    constexpr int NBCH = BROWS / 32;
    const int lane = tid & 63, wave = tid >> 6;
    const int wm = wave >> 1, wn = wave & 1, fr = lane & 15, fq = lane >> 4;
    const int lrow = tid >> 3, lc8 = tid & 7;
    const u16* ga = A + (size_t)lrow * lda + lc8 * 8;
    const u16* gb = B + (size_t)lrow * ldb + lc8 * 8;
    u32x4 ra[4], rb[NBCH];
    const int nk = K >> 6;
#pragma unroll
    for (int i = 0; i < 4; ++i) ra[i] = gld16(ga + (size_t)(32 * i) * lda);
#pragma unroll
    for (int i = 0; i < NBCH; ++i) rb[i] = gld16(gb + (size_t)(32 * i) * ldb);
    char* sw = smem + lrow * 144 + lc8 * 16;
    VM_WAIT0();
#pragma unroll
    for (int i = 0; i < 4; ++i) *(u32x4*)(sw + i * 32 * 144) = ra[i];
#pragma unroll
    for (int i = 0; i < NBCH; ++i) *(u32x4*)(sw + 128 * 144 + i * 32 * 144) = rb[i];
    __syncthreads();
    const char* sa_r = smem + (wm * 64 + fr) * 144 + fq * 16;
    const char* sb_r = smem + 128 * 144 + (wn * TN * 16 + fr) * 144 + fq * 16;
    for (int kt = 0; kt < nk; ++kt) {
        const int cur = kt & 1;
        const int k0 = (kt + 1 < nk ? kt + 1 : kt) * 64;
#pragma unroll
        for (int i = 0; i < 4; ++i) ra[i] = gld16(ga + (size_t)(32 * i) * lda + k0);
#pragma unroll
        for (int i = 0; i < NBCH; ++i) rb[i] = gld16(gb + (size_t)(32 * i) * ldb + k0);
        __builtin_amdgcn_sched_barrier(0);
#pragma unroll
        for (int ks = 0; ks < 2; ++ks) {
            bf16x8 af[4], bfr[TN];
#pragma unroll
            for (int mt = 0; mt < 4; ++mt) af[mt] = *(const bf16x8*)(sa_r + cur * STAGE + mt * 16 * 144 + ks * 64);
#pragma unroll
            for (int nt = 0; nt < TN; ++nt) bfr[nt] = *(const bf16x8*)(sb_r + cur * STAGE + nt * 16 * 144 + ks * 64);
#pragma unroll
            for (int mt = 0; mt < 4; ++mt)
#pragma unroll
                for (int nt = 0; nt < TN; ++nt) acc[mt][nt] = mfma16(af[mt], bfr[nt], acc[mt][nt]);
        }
        __builtin_amdgcn_sched_barrier(0);
        VM_WAIT0();
        {
            char* sw2 = sw + (cur ^ 1) * STAGE;
#pragma unroll
            for (int i = 0; i < 4; ++i) *(u32x4*)(sw2 + i * 32 * 144) = ra[i];
#pragma unroll
            for (int i = 0; i < NBCH; ++i) *(u32x4*)(sw2 + 128 * 144 + i * 32 * 144) = rb[i];
        }
        __syncthreads();
    }
}

template <int TN>
DEV void zero_acc(f32x4 (&acc)[4][TN]) {
#pragma unroll
    for (int i = 0; i < 4; ++i)
#pragma unroll
        for (int j = 0; j < TN; ++j) acc[i][j] = f32x4{0.f, 0.f, 0.f, 0.f};
}

DEV void tile_decode(int t, int ntn, int& mt, int& nt) {
    const int per = 8 * ntn;
    const int gi = t / per, rem = t - gi * per;
    nt = rem >> 3;
    mt = gi * 8 + (rem & 7);
}


template <bool SWAP = false>
DEV void gemm8_accum(f32x4 (&acc)[8][4], const u16* __restrict__ A, int lda, const u16* __restrict__ B, int ldb, int K, char* smem, int tid) {
    constexpr int STAGE = 65536;
    const int lane = tid & 63, wave = tid >> 6;
    const int wm = wave >> 2, wn = wave & 3, fr = lane & 15, fq = lane >> 4;
    const int lr = lane >> 3, pos = lane & 7;
    const int ce = pos ^ (lr >> 1), co = pos ^ (4 | (lr >> 1));
    const unsigned ra_ = (unsigned)((wave * 32 + lr) * lda) * 2u, rb_ = (unsigned)((wave * 32 + lr) * ldb) * 2u;
    const unsigned voa_e = ra_ + ce * 16, voa_o = ra_ + co * 16, vob_e = rb_ + ce * 16, vob_o = rb_ + co * 16;
    const int nk = K >> 6;
    const unsigned ldsw = __builtin_amdgcn_readfirstlane((unsigned)(size_t)(__attribute__((address_space(3))) char*)smem + wave * 4096);
#define G8_ISSUE(STG, K0) do { \
        _Pragma("unroll") for (int i = 0; i < 4; ++i) { \
            glds16(A + (size_t)(8 * i) * lda + (K0), (i & 1) ? voa_o : voa_e, ldsw + (STG) * STAGE + i * 1024); \
            glds16(B + (size_t)(8 * i) * ldb + (K0), (i & 1) ? vob_o : vob_e, ldsw + (STG) * STAGE + 32768 + i * 1024); \
        } } while (0)
    G8_ISSUE(0, 0);
    VM_WAIT0();
    __syncthreads();
    const int s3 = (fr >> 1) & 7;
    const int oa_base = (wm * 128 + fr) * 128 + ((fq ^ s3) * 16);
    const int ob_base = 32768 + (wn * 64 + fr) * 128 + ((fq ^ s3) * 16);
    for (int kt = 0; kt < nk; ++kt) {
        const int cur = kt & 1;
        const int k0 = (kt + 1 < nk ? kt + 1 : kt) * 64;
        G8_ISSUE(cur ^ 1, k0);
        int o_a = cur * STAGE + oa_base, o_b = cur * STAGE + ob_base;
        asm volatile("" : "+v"(o_a), "+v"(o_b));
#pragma unroll
        for (int ks = 0; ks < 2; ++ks) {
            const char* sa_c = smem + (ks ? (o_a ^ 64) : o_a);
            const char* sb_c = smem + (ks ? (o_b ^ 64) : o_b);
            bf16x8 bfr[4], af[8];
#pragma unroll
            for (int nt = 0; nt < 4; ++nt) bfr[nt] = *(const bf16x8*)(sb_c + nt * 2048);
#pragma unroll
            for (int mt = 0; mt < 8; ++mt) af[mt] = *(const bf16x8*)(sa_c + mt * 2048);
#pragma unroll
            for (int mt = 0; mt < 8; ++mt)
#pragma unroll
                for (int nt = 0; nt < 4; ++nt) acc[mt][nt] = SWAP ? mfma16(bfr[nt], af[mt], acc[mt][nt]) : mfma16(af[mt], bfr[nt], acc[mt][nt]);
            __builtin_amdgcn_sched_group_barrier(0x100, 7, 0);
#pragma unroll
            for (int i = 0; i < 5; ++i) { __builtin_amdgcn_sched_group_barrier(0x008, 4, 0); __builtin_amdgcn_sched_group_barrier(0x100, 1, 0); }
#pragma unroll
            for (int i = 0; i < 3; ++i) __builtin_amdgcn_sched_group_barrier(0x008, 4, 0);
        }
        VM_WAIT0();
        __syncthreads();
    }
#undef G8_ISSUE
}
DEV void zero_acc8(f32x4 (&acc)[8][4]) {
#pragma unroll
    for (int i = 0; i < 8; ++i)
#pragma unroll
        for (int j = 0; j < 4; ++j) acc[i][j] = f32x4{0.f, 0.f, 0.f, 0.f};
}
DEV void tile_decode8(int t, int ntn, int& mt, int& nt) {
    const int per = 4 * ntn;
    const int gi = t / per, rem = t - gi * per;
    nt = rem >> 2;
    mt = gi * 4 + (rem & 3);
}

DEV void ph_ffn_in8(const Params& p, int which, int mtiles8, char* smem, int rvid, int RG, int tid) {
    const u16* H = WSP(u16, OFF_H);
    const u16* Wt = WSP(u16, OFF_W) + (which ? WE_IN1 : WE_IN0);
    u16* ACT = WSP(u16, OFF_P);
    const int lane = tid & 63, wave = tid >> 6, wm = wave >> 2, wn = wave & 3, fr = lane & 15, fq = lane >> 4;
    const int total = mtiles8 * 22;
    for (int t = rvid; t < total; t += RG) {
        int mt_, nt_;
        tile_decode8(t, 22, mt_, nt_);
        const int m0 = mt_ * 256, n0 = nt_ * 256;
        f32x4 acc[8][4];
        zero_acc8(acc);
        gemm8_accum(acc, H + (size_t)m0 * D, D, Wt + (size_t)n0 * D, D, D, smem, tid);
#pragma unroll
        for (int mt = 0; mt < 8; ++mt)
#pragma unroll
            for (int pp = 0; pp < 2; ++pp)
#pragma unroll
                for (int r = 0; r < 4; ++r) {
                    const int row = m0 + wm * 128 + mt * 16 + fq * 4 + r;
                    const int hid = (n0 >> 1) + wn * 32 + pp * 16 + fr;
                    const float g = acc[mt][2 * pp][r], u = acc[mt][2 * pp + 1][r];
                    const float v = g * sigmoidf_(g) * u;
                    ACT[(size_t)row * DFF + hid] = (u16)(pk2(v, 0.f) & 0xffff);
                }
    }
}
DEV void ph_resid8(const Params& p, const u16* A, int lda, const u16* Wt, int K, int modidx, float coef, char* smem, int rvid, int RG, int tid, const float* xsrc) {
    const float* mods = WSP(float, OFF_MODS);
    const int lane = tid & 63, wave = tid >> 6, wm = wave >> 2, wn = wave & 3, fr = lane & 15, fq = lane >> 4;
    const int total = 128 * 4;
    for (int t = rvid; t < total; t += RG) {
        int mt_, nt_;
        tile_decode8(t, 4, mt_, nt_);
        const int m0 = mt_ * 256, n0 = nt_ * 256;
        f32x4 acc[8][4];
        zero_acc8(acc);
        gemm8_accum<true>(acc, A + (size_t)m0 * lda, lda, Wt + (size_t)n0 * K, K, K, smem, tid);
        const float* gp = mods + (m0 >> 12) * 9216 + modidx * 1024;
#pragma unroll
        for (int nt = 0; nt < 4; ++nt) {
            const int col = n0 + wn * 64 + nt * 16 + fq * 4;
            float4 g4 = *(const float4*)(gp + col);
            g4.x *= coef; g4.y *= coef; g4.z *= coef; g4.w *= coef;
#pragma unroll
            for (int mt = 0; mt < 8; ++mt) {
                const size_t off = (size_t)(m0 + wm * 128 + mt * 16 + fr) * D + col;
                float4 xv = *(const float4*)(xsrc + off);
                xv.x += g4.x * acc[mt][nt][0];
                xv.y += g4.y * acc[mt][nt][1];
                xv.z += g4.z * acc[mt][nt][2];
                xv.w += g4.w * acc[mt][nt][3];
                *(float4*)(p.out + off) = xv;
            }
        }
    }
}
DEV void ph_pgemm8(const Params& p, int lsel, char* smem, int rvid, int RG, int tid) {
    const u16* H = WSP(u16, OFF_H);
    const u16* Wt = WSP(u16, OFF_W) + WE_MIX;
    u16* P = WSP(u16, OFF_P);
    u16* T = WSP(u16, OFF_T);
    float* Gt = WSP(float, OFF_G);
    const int lane = tid & 63, wave = tid >> 6, wm = wave >> 2, wn = wave & 3, fr = lane & 15, fq = lane >> 4;
    const int total = 128 * 12;
    for (int t = rvid; t < total; t += RG) {
        int mt_, nt_;
        tile_decode8(t, 12, mt_, nt_);
        const int m0 = mt_ * 256, n0 = nt_ * 256;
        f32x4 acc[8][4];
        zero_acc8(acc);
        const int cb = n0 + wn * 64;
        const int j = cb >> 7;
        const bool swap_tile = (nt_ <= 4) || (nt_ == 6) || (nt_ == 7);
        if (swap_tile) {
            gemm8_accum<true>(acc, H + (size_t)m0 * D, D, Wt + (size_t)n0 * D, D, D, smem, tid);
            const bool normed = (cb >= 256 && cb < 1024) || (cb >= 1536);
            const bool isq = cb < 1024;
            const bool isgq = (cb >= 640 && cb < 1024) || (cb >= 1920);
            const float* wv = (isgq ? p.gq_qk_w : p.na_qk_w) + (lsel * 2 + (isq ? 0 : 1)) * 64;
            const float scl = isq ? 0.125f : 1.f;
            float4 w4[4];
#pragma unroll
            for (int nt = 0; nt < 4; ++nt) w4[nt] = normed ? *(const float4*)(wv + nt * 16 + fq * 4) : float4{1.f, 1.f, 1.f, 1.f};
            const float* rope = WSP(float, OFF_ROPE);
#pragma unroll
            for (int mt = 0; mt < 8; ++mt) {
                const int row = m0 + wm * 128 + mt * 16 + fr;
                if (normed) {
                    float ss = 0.f;
#pragma unroll
                    for (int nt = 0; nt < 4; ++nt)
#pragma unroll
                        for (int r = 0; r < 4; ++r) ss += acc[mt][nt][r] * acc[mt][nt][r];
                    ss = xq_sum(ss);
                    const float rstd = rsqrtf(ss * (1.f / 64.f) + 1e-6f) * scl;
#pragma unroll
                    for (int nt = 0; nt < 4; ++nt) {
                        acc[mt][nt][0] *= rstd * w4[nt].x; acc[mt][nt][1] *= rstd * w4[nt].y;
                        acc[mt][nt][2] *= rstd * w4[nt].z; acc[mt][nt][3] *= rstd * w4[nt].w;
                    }
                    if (isgq) {
                        const int tok = row & 4095;
#pragma unroll
                        for (int nt = 0; nt < 2; ++nt) {
                            const float* rp = rope + ((size_t)tok * 32 + nt * 16 + fq * 4) * 2;
                            const float4 cs01 = *(const float4*)rp, cs23 = *(const float4*)(rp + 4);
                            const float cv[4] = {cs01.x, cs01.z, cs23.x, cs23.z}, sv[4] = {cs01.y, cs01.w, cs23.y, cs23.w};
#pragma unroll
                            for (int r = 0; r < 4; ++r) {
                                const float x1 = acc[mt][nt][r], x2 = acc[mt][nt + 2][r];
                                acc[mt][nt][r] = x1 * cv[r] - x2 * sv[r];
                                acc[mt][nt + 2][r] = x1 * sv[r] + x2 * cv[r];
                            }
                        }
                    }
                }
#pragma unroll
                for (int nt = 0; nt < 4; ++nt)
                    *(uint2*)(P + (size_t)row * PW + cb + nt * 16 + fq * 4) = uint2{pk2(acc[mt][nt][0], acc[mt][nt][1]), pk2(acc[mt][nt][2], acc[mt][nt][3])};
            }
            continue;
        }
        gemm8_accum(acc, H + (size_t)m0 * D, D, Wt + (size_t)n0 * D, D, D, smem, tid);
        if (j >= 22) {
            if (cb == 2816) {
#pragma unroll
                for (int mt = 0; mt < 8; ++mt)
#pragma unroll
                    for (int r = 0; r < 4; ++r) {
                        const int row = m0 + wm * 128 + mt * 16 + fq * 4 + r;
                        Gt[(size_t)row * 16 + fr] = acc[mt][0][r];
                    }
            }
            continue;
        }
        const bool rowmajor = j < 16;
        const bool transp = (j == 10) || (j == 11) || (j >= 16);
        if (rowmajor) {
#pragma unroll
            for (int mt = 0; mt < 8; ++mt)
#pragma unroll
                for (int nt = 0; nt < 4; ++nt)
#pragma unroll
                    for (int r = 0; r < 4; ++r) {
                        const int row = m0 + wm * 128 + mt * 16 + fq * 4 + r;
                        P[(size_t)row * PW + cb + nt * 16 + fr] = (u16)(pk2(acc[mt][nt][r], 0.f) & 0xffff);
                    }
        }
        if (transp) {
            const int tcb = (j >= 16) ? (cb - 1792) : (cb - 1280);
            const int b = m0 >> 12, u0 = m0 & 4095;
#pragma unroll
            for (int mt = 0; mt < 8; ++mt)
#pragma unroll
                for (int nt = 0; nt < 4; ++nt) {
                    const int tc = tcb + nt * 16 + fr;
                    const int u = u0 + wm * 128 + mt * 16 + fq * 4;
                    *(uint2*)(T + ((size_t)(b * TW + tc)) * UT + u) = uint2{pk2(acc[mt][nt][0], acc[mt][nt][1]), pk2(acc[mt][nt][2], acc[mt][nt][3])};
                }
        }
    }
}

DEV int map_col(int type, int n) {
    if (type == 0) return n;
    if (type == 1) {
        const int jb = n >> 5, r = n & 31;
        return r < 16 ? jb * 16 + r : DFF + jb * 16 + (r - 16);
    }
    if (n < 256) return 1552 + n;
    if (n < 640) return 2064 + (n - 256);
    if (n < 1024) return 2448 + (n - 640);
    if (n < 1280) return 1808 + (n - 1024);
    if (n < 1536) return (n - 1280);
    if (n < 1920) return 528 + (n - 1536);
    if (n < 2048) return 1296 + (n - 1920);
    if (n < 2304) return 256 + (n - 2048);
    if (n < 2688) return 912 + (n - 2304);
    if (n < 2816) return 1424 + (n - 2688);
    if (n < 2832) return 512 + (n - 2816);
    if (n < 2944) return -1;
    return 2832 + (n - 2944);
}

DEV void conv_tile(const float* __restrict__ src, int ld_src, int type, u16* __restrict__ dst, int ld_dst, int k_off, int kt, int ntile, char* smem, int tid) {
    float* lds = (float*)smem;
    const int k0 = kt * 64, n0 = ntile * 64;
    {
        const int r = tid >> 6, c = tid & 63;
        const int col = map_col(type, n0 + c);
#pragma unroll
        for (int i = 0; i < 16; ++i) {
            const int k = r + 4 * i;
            float v = 0.f;
            if (col >= 0) v = src[(size_t)(k0 + k) * ld_src + col];
            lds[k * 65 + c] = v;
        }
    }
    __syncthreads();
    {
        const int n = tid >> 2, kq = tid & 3;
        uint32_t w[8];
#pragma unroll
        for (int j = 0; j < 8; ++j) w[j] = pk2(lds[(kq * 16 + 2 * j) * 65 + n], lds[(kq * 16 + 2 * j + 1) * 65 + n]);
        u16* d = dst + (size_t)(n0 + n) * ld_dst + k_off + k0 + kq * 16;
        *(uint4*)d = uint4{w[0], w[1], w[2], w[3]};
        *(uint4*)(d + 8) = uint4{w[4], w[5], w[6], w[7]};
    }
    __syncthreads();
}

DEV void ph_prep(const Params& p, int l, char* smem, int bid, int G) {
    u16* W = WSP(u16, OFF_W);
    const int tid = VTID;
    constexpr int N_CONV = 6240, N_MODS = 288;
    for (int it = bid; it < N_CONV + N_MODS; it += G) {
        if (it < N_CONV) {
            int r = it;
            if (r < 2816) {
                const int which = r / 1408; r -= which * 1408;
                conv_tile(p.ffn_w_in + (size_t)(l * 2 + which) * 1024 * 5632, 5632, 1, W + (which ? WE_IN1 : WE_IN0), 1024, 0, r / 88, r % 88, smem, tid);
                continue;
            }
            r -= 2816;
            if (r < 1408) {
                const int which = r / 704; r -= which * 704;
                conv_tile(p.ffn_w_out + (size_t)(l * 2 + which) * 2816 * 1024, 1024, 0, W + (which ? WE_OUT1 : WE_OUT0), 2816, 0, r / 16, r % 16, smem, tid);
                continue;
            }
            r -= 1408;
            if (r < 1504) {
                conv_tile(p.mix_w_in + (size_t)l * 1024 * NIN, NIN, 2, W + WE_MIX, 1024, 0, r / 94, r % 94, smem, tid);
                continue;
            }
            r -= 1504;
            if (r < 64) { conv_tile(p.w_br_ml + (size_t)l * 256 * 1024, 1024, 0, W + WE_BR, 1024, 0, r / 16, r % 16, smem, tid); continue; }
            r -= 64;
            if (r < 96) { conv_tile(p.w_br_na + (size_t)l * 384 * 1024, 1024, 0, W + WE_BR, 1024, 256, r / 16, r % 16, smem, tid); continue; }
            r -= 96;
            if (r < 96) { conv_tile(p.w_br_gq + (size_t)l * 384 * 1024, 1024, 0, W + WE_BR, 1024, 640, r / 16, r % 16, smem, tid); continue; }
            r -= 96;
            conv_tile(p.w_out + (size_t)l * 1024 * 1024, 1024, 0, W + WE_O, 1024, 0, r / 16, r % 16, smem, tid);
        } else {
            const int cb = it - N_CONV;
            float* s = (float*)smem;
            float* red = s + 9 * 1024;
            for (int i = tid; i < 9 * 1024; i += 256) {
                const int b = i >> 10, k = i & 1023;
                const float v = b < 8 ? p.c[b * 1024 + k] : p.c_ctx[k];
                s[i] = v * sigmoidf_(v);
            }
            __syncthreads();
            const int kg = tid >> 5, c = tid & 31, col = cb * 32 + c;
            float a[9];
#pragma unroll
            for (int b = 0; b < 9; ++b) a[b] = 0.f;
            const float* wp = p.ada_w + (size_t)l * 1024 * 9216 + (size_t)(kg * 128) * 9216 + col;
#pragma unroll 16
            for (int k = 0; k < 128; ++k) {
                const float w = wp[(size_t)k * 9216];
#pragma unroll
                for (int b = 0; b < 9; ++b) a[b] += s[b * 1024 + kg * 128 + k] * w;
            }
#pragma unroll
            for (int b = 0; b < 9; ++b) red[(kg * 9 + b) * 32 + c] = a[b];
            __syncthreads();
            for (int i = tid; i < 288; i += 256) {
                const int b = i >> 5, cc = i & 31;
                float v = p.ada_b[l * 9216 + cb * 32 + cc];
#pragma unroll
                for (int g = 0; g < 8; ++g) v += red[(g * 9 + b) * 32 + cc];
                WSP(float, OFF_MODS)[b * 9216 + cb * 32 + cc] = v;
            }
            __syncthreads();
        }
    }
    if (l == 0) {
        const size_t gt = (size_t)bid * 256 + tid, gs = (size_t)G * 256;
        const float4* cs = (const float4*)p.ctx; float4* cd = WSP(float4, OFF_XC);
        for (size_t i = gt; i < (size_t)NCX * D / 4; i += gs) cd[i] = cs[i];
        float* rope = WSP(float, OFF_ROPE);
        for (size_t i = gt; i < (size_t)4096 * 32; i += gs) {
            const int t = (int)(i >> 5), f = (int)(i & 31);
            const float pos = (float)((f < 16) ? (t >> 6) : (t & 63));
            const float inv = powf(10000.f, -(float)(f & 15) / 16.f);
            float sn, cs_;
            sincosf(pos * inv, &sn, &cs_);
            rope[i * 2] = cs_;
            rope[i * 2 + 1] = sn;
        }
    }
}

#define KIDX(j) (lane * 8 + ((j) & 1) * 4 + ((j) >> 1) * 512)
DEV void ph_mod(const Params& p, int l, int sub, int nrows, int bid, int G) {
    const bool first = (l == 0 && sub == 0);
    const int lane = VTID & 63, gw = bid * 4 + (VTID >> 6), NW = G * 4;
    const float* nw = p.norm_w + (size_t)(l * 3 + sub) * 1024;
    const float* mods = WSP(float, OFF_MODS);
    u16* H = WSP(u16, OFF_H);
#pragma unroll 2
    for (int r = gw; r < nrows; r += NW) {
        const float* xr = r < NL ? (first ? p.x : p.out) + (size_t)r * D : (first ? p.ctx : WSP(float, OFF_XC)) + (size_t)(r - NL) * D;
        const int b9 = r < NL ? (r >> 12) : 8;
        const float* sh = mods + b9 * 9216 + (3 * sub) * 1024;
        const float* sc = sh + 1024;
        float4 v[4];
        float ss = 0.f;
        const bool fold = (r >= NL) && !first;
#pragma unroll
        for (int j = 0; j < 4; ++j) {
            v[j] = *(const float4*)(xr + KIDX(j));
            if (fold) {
#pragma unroll
                for (int ks = 0; ks < 4; ++ks) {
                    const float4 q4 = *(const float4*)(WSP(float, OFF_PART) + ((size_t)ks * NCX + (r - NL)) * D + KIDX(j));
                    v[j].x += q4.x; v[j].y += q4.y; v[j].z += q4.z; v[j].w += q4.w;
                }
                *(float4*)(WSP(float, OFF_XC) + (size_t)(r - NL) * D + KIDX(j)) = v[j];
            }
            ss += v[j].x * v[j].x + v[j].y * v[j].y + v[j].z * v[j].z + v[j].w * v[j].w;
        }
        ss = wave_sum(ss);
        const float rstd = rsqrtf(ss * (1.f / 1024.f) + 1e-6f);
        uint2 hp[4];
#pragma unroll
        for (int j = 0; j < 4; ++j) {
            const int k = KIDX(j);
            const float4 w = *(const float4*)(nw + k), s1 = *(const float4*)(sc + k), s0 = *(const float4*)(sh + k);
            const float y0 = v[j].x * rstd * w.x * (1.f + s1.x) + s0.x;
            const float y1 = v[j].y * rstd * w.y * (1.f + s1.y) + s0.y;
            const float y2 = v[j].z * rstd * w.z * (1.f + s1.z) + s0.z;
            const float y3 = v[j].w * rstd * w.w * (1.f + s1.w) + s0.w;
            hp[j] = uint2{pk2(y0, y1), pk2(y2, y3)};
        }
        *(uint4*)(H + (size_t)r * D + KIDX(0)) = uint4{hp[0].x, hp[0].y, hp[1].x, hp[1].y};
        *(uint4*)(H + (size_t)r * D + KIDX(2)) = uint4{hp[2].x, hp[2].y, hp[3].x, hp[3].y};
    }
}

#undef KIDX
DEV void ph_ffn_in(const Params& p, int which, int mt0, int mtiles, char* smem, int vid, int G) {
    const u16* H = WSP(u16, OFF_H);
    const u16* Wt = WSP(u16, OFF_W) + (which ? WE_IN1 : WE_IN0);
    u16* ACT = WSP(u16, OFF_P);
    const int lane = VTID & 63, wave = VTID >> 6, wm = wave >> 1, wn = wave & 1, fr = lane & 15, fq = lane >> 4;
    const int total = mtiles * 44;
    for (int t = vid; t < total; t += G) {
        int mt_, nt_;
        tile_decode(t, 44, mt_, nt_);
        mt_ += mt0;
        const int m0 = mt_ * 128, n0 = nt_ * 128;
        f32x4 acc[4][4];
        zero_acc<4>(acc);
        gemm_accum<4>(acc, H + (size_t)m0 * D, D, Wt + (size_t)n0 * D, D, D, smem, VTID);
#pragma unroll
        for (int mt = 0; mt < 4; ++mt)
#pragma unroll
            for (int pp = 0; pp < 2; ++pp)
#pragma unroll
                for (int r = 0; r < 4; ++r) {
                    const int row = m0 + wm * 64 + mt * 16 + fq * 4 + r;
                    const int hid = (n0 >> 1) + wn * 32 + pp * 16 + fr;
                    const float g = acc[mt][2 * pp][r], u = acc[mt][2 * pp + 1][r];
                    const float v = g * sigmoidf_(g) * u;
                    ACT[(size_t)row * DFF + hid] = (u16)(pk2(v, 0.f) & 0xffff);
                }
    }
}

DEV void ph_resid(const Params& p, const u16* A, int lda, const u16* Wt, int K, int modidx, float coef, int mt0, int mtiles, char* smem, int vid, int G) {
    const float* mods = WSP(float, OFF_MODS);
    const int lane = VTID & 63, wave = VTID >> 6, wm = wave >> 1, wn = wave & 1, fr = lane & 15, fq = lane >> 4;
    const int total = mtiles * 8 * 4;
    const int Kc = K >> 2;
    for (int t = vid; t < total; t += G) {
        int mt_, nt_;
        const int ksp = t & 3;
        tile_decode(t >> 2, 8, mt_, nt_);
        mt_ += mt0;
        const int m0 = mt_ * 128, n0 = nt_ * 128;
        f32x4 acc[4][4];
        zero_acc<4>(acc);
        gemm_accum<4>(acc, A + (size_t)m0 * lda + ksp * Kc, lda, Wt + (size_t)n0 * K + ksp * Kc, K, Kc, smem, VTID);
        const int b9 = m0 < NL ? (m0 >> 12) : 8;
        const float* gp = mods + b9 * 9216 + modidx * 1024;
#pragma unroll
        for (int nt = 0; nt < 4; ++nt) {
            const int col = n0 + wn * 64 + nt * 16 + fr;
            const float gv = gp[col] * coef;
#pragma unroll
            for (int mt = 0; mt < 4; ++mt)
#pragma unroll
                for (int r = 0; r < 4; ++r) {
                    const int row = m0 + wm * 64 + mt * 16 + fq * 4 + r;
                    WSP(float, OFF_PART)[((size_t)ksp * NCX + (row - NL)) * D + col] = gv * acc[mt][nt][r];
                }
        }
    }
}

DEV void ph_pgemm(const Params& p, int mt0, int mtiles, char* smem, int vid, int G) {
    const u16* H = WSP(u16, OFF_H);
    const u16* Wt = WSP(u16, OFF_W) + WE_MIX;
    u16* P = WSP(u16, OFF_P);
    u16* T = WSP(u16, OFF_T);
    float* Gt = WSP(float, OFF_G);
    const int lane = VTID & 63, wave = VTID >> 6, wm = wave >> 1, wn = wave & 1, fr = lane & 15, fq = lane >> 4;
    const int total = mtiles * 23;
    for (int t = vid; t < total; t += G) {
        int mt_, nt_;
        tile_decode(t, 23, mt_, nt_);
        mt_ += mt0;
        const int m0 = mt_ * 128, n0 = nt_ * 128;
        f32x4 acc[4][4];
        zero_acc<4>(acc);
        gemm_accum<4>(acc, H + (size_t)m0 * D, D, Wt + (size_t)n0 * D, D, D, smem, VTID);
        if (nt_ == 22) {
            if (wn == 0) {
#pragma unroll
                for (int mt = 0; mt < 4; ++mt)
#pragma unroll
                    for (int r = 0; r < 4; ++r) {
                        const int row = m0 + wm * 64 + mt * 16 + fq * 4 + r;
                        Gt[(size_t)row * 16 + fr] = acc[mt][0][r];
                    }
            }
            continue;
        }
        const bool rowmajor = nt_ < 16;
        const bool transp = (nt_ == 10) || (nt_ == 11) || (nt_ >= 16);
        if (rowmajor) {
#pragma unroll
            for (int mt = 0; mt < 4; ++mt)
#pragma unroll
                for (int nt = 0; nt < 4; ++nt)
#pragma unroll
                    for (int r = 0; r < 4; ++r) {
                        const int row = m0 + wm * 64 + mt * 16 + fq * 4 + r;
                        const int col = n0 + wn * 64 + nt * 16 + fr;
                        P[(size_t)row * PW + col] = (u16)(pk2(acc[mt][nt][r], 0.f) & 0xffff);
                    }
        }
        if (transp) {
            const int tcb = (nt_ >= 16) ? (n0 - 1792) : (n0 - 1280);
            int b, u0;
            if (m0 < NL) { b = m0 >> 12; u0 = m0 & 4095; } else { b = (m0 - NL) >> 8; u0 = SEQ + ((m0 - NL) & 255); }
#pragma unroll
            for (int mt = 0; mt < 4; ++mt)
#pragma unroll
                for (int nt = 0; nt < 4; ++nt) {
                    const int tc = tcb + wn * 64 + nt * 16 + fr;
                    const int u = u0 + wm * 64 + mt * 16 + fq * 4;
                    *(uint2*)(T + ((size_t)(b * TW + tc)) * UT + u) = uint2{pk2(acc[mt][nt][0], acc[mt][nt][1]), pk2(acc[mt][nt][2], acc[mt][nt][3])};
                }
        }
    }
}

DEV void ph_qknorm_gates(const Params& p, int l, int bid, int G) {
    const int lane = VTID & 63, gw = bid * 4 + (VTID >> 6), NW = G * 4;
    u16* P = WSP(u16, OFF_P);
    for (int it = gw; it < NSCAN * NCH; it += NW) {
        const int sc = it / NCH, c = it - sc * NCH, dir = sc & 1, h = (sc >> 1) & 3, b = sc >> 3;
        const float* Gt = WSP(float, OFF_G);
        float* BC = WSP(float, OFF_BC) + (size_t)sc * UT;
        float* IG = WSP(float, OFF_IG) + (size_t)sc * UT;
        float* WE = WSP(float, OFF_AE) + (size_t)sc * UT;
        const float bi = p.ml_gate_b[l * 16 + dir * 8 + h], bf = p.ml_gate_b[l * 16 + dir * 8 + 4 + h];
        const int cu = cu_of(c, dir);
        const int u = cu * 64 + (dir ? 63 - lane : lane);
        const int row = rowof(b, u);
        const float ig = Gt[(size_t)row * 16 + dir * 8 + h] + bi;
        const float fp = Gt[(size_t)row * 16 + dir * 8 + 4 + h] + bf;
        const float lf = fminf(fp, 0.f) - log1pf(expf(-fabsf(fp)));
        float bc = lf;
#pragma unroll
        for (int o = 1; o < 64; o <<= 1) { const float tv = __shfl_up(bc, o); if (lane >= o) bc += tv; }
        const float btot = __shfl(bc, 63);
        const float wend = btot - bc + ig;
        const float mx = wave_max(wend);
        WE[u] = wend;
        BC[u] = bc;
        IG[u] = ig;
        if (lane == 0) { WSP(float, OFF_MS)[sc * NCH + c] = btot; WSP(float, OFF_DEC)[sc * NCH + c] = mx; }
    }
    const float* rope = WSP(float, OFF_ROPE);
    const int hs = lane >> 4, e4 = (lane & 15) * 4;
    for (int r = NL + gw; r < MTOT; r += NW) {
        const bool latent = r < NL;
        const int tok = r & 4095;
#pragma unroll
        for (int g = 0; g < 5; ++g) {
            const int cbase = (g < 3 ? 256 + g * 256 : 1536 + (g - 3) * 256) + hs * 64 + e4;
            const int slot = g * 4 + hs;
            u16* pp = P + (size_t)r * PW + cbase;
            const uint2 raw = *(const uint2*)pp;
            float v0 = bflo(raw.x), v1 = bfhi(raw.x), v2 = bflo(raw.y), v3 = bfhi(raw.y);
            float ss = v0 * v0 + v1 * v1 + v2 * v2 + v3 * v3;
            ss += __shfl_xor(ss, 1); ss += __shfl_xor(ss, 2); ss += __shfl_xor(ss, 4); ss += __shfl_xor(ss, 8);
            const float* wv;
            float scl;
            bool do_rope;
            if (slot < 6) { wv = p.na_qk_w + (l * 2 + 0) * 64; scl = 0.125f; do_rope = false; }
            else if (slot < 12) { wv = p.gq_qk_w + (l * 2 + 0) * 64; scl = 0.125f; do_rope = latent; }
            else if (slot < 18) { wv = p.na_qk_w + (l * 2 + 1) * 64; scl = 1.f; do_rope = false; }
            else { wv = p.gq_qk_w + (l * 2 + 1) * 64; scl = 1.f; do_rope = latent; }
            const float rstd = rsqrtf(ss * (1.f / 64.f) + 1e-6f) * scl;
            const float4 w4 = *(const float4*)(wv + e4);
            v0 *= rstd * w4.x; v1 *= rstd * w4.y; v2 *= rstd * w4.z; v3 *= rstd * w4.w;
            const float o0 = __shfl_xor(v0, 8), o1 = __shfl_xor(v1, 8), o2 = __shfl_xor(v2, 8), o3 = __shfl_xor(v3, 8);
            if (do_rope) {
                const int fi = e4 & 31;
                const float4 cs01 = *(const float4*)(rope + ((size_t)tok * 32 + fi) * 2);
                const float4 cs23 = *(const float4*)(rope + ((size_t)tok * 32 + fi + 2) * 2);
                if (e4 < 32) {
                    v0 = v0 * cs01.x - o0 * cs01.y; v1 = v1 * cs01.z - o1 * cs01.w;
                    v2 = v2 * cs23.x - o2 * cs23.y; v3 = v3 * cs23.z - o3 * cs23.w;
                } else {
                    v0 = o0 * cs01.y + v0 * cs01.x; v1 = o1 * cs01.w + v1 * cs01.z;
                    v2 = o2 * cs23.y + v2 * cs23.x; v3 = o3 * cs23.w + v3 * cs23.z;
                }
            }
            *(uint2*)pp = uint2{pk2(v0, v1), pk2(v2, v3)};
        }
    }
}

template <int MT, bool NAMASK, int NWV>
DEV void flash_item(const Params& p, int b, int qrow0, int qcol, int kcol, int tcol, int ua, int n1, int ub, int ntiles,
                    int r_q, int rs, const float* __restrict__ rpb_h, char* smem, int ocol, float mfix = 0.f) {
    u16* P = WSP(u16, OFF_P);
    const u16* T = WSP(u16, OFF_T);
    const int tid = (NWV == 8) ? (int)(threadIdx.x + p.z) : VTID, lane = tid & 63, wave = tid >> 6, fr = lane & 15, fq = lane >> 4;
    constexpr int KVS = 64 * 144;
    char* Ks = smem;
    char* Vs = smem + 2 * KVS;
    float* rpb_s = (float*)(smem + 4 * KVS);
    __syncthreads();
    if (NAMASK) {
        for (int i = tid; i < 465; i += 256) rpb_s[i] = rpb_h[i] * 1.4426950408889634f;
    }
    Frag qf[MT][2];
#pragma unroll
    for (int mt = 0; mt < MT; ++mt)
#pragma unroll
        for (int ks = 0; ks < 2; ++ks)
            qf[mt][ks].q = *(const uint4*)(P + (size_t)(qrow0 + (wave * MT + mt) * 16 + fr) * PW + qcol + ks * 32 + fq * 8);
    const int lr = tid >> 3, lc8 = tid & 7;
    u32x4 rk0, rk1 = {0, 0, 0, 0}, rv0, rv1 = {0, 0, 0, 0};
#define FL_GLOAD(KT) do { const int kt_ = (KT); const int u0_ = kt_ < n1 ? ua + 64 * kt_ : ub + 64 * (kt_ - n1); const int row0_ = rowof(b, u0_); \
        rk0 = gld16(P + (size_t)(row0_ + lr) * PW + kcol + lc8 * 8); rv0 = gld16(T + ((size_t)(b * TW + tcol + lr)) * UT + u0_ + lc8 * 8); \
        if (NWV == 4) { rk1 = gld16(P + (size_t)(row0_ + lr + 32) * PW + kcol + lc8 * 8); rv1 = gld16(T + ((size_t)(b * TW + tcol + lr + 32)) * UT + u0_ + lc8 * 8); } } while (0)
#define FL_SSTORE(S) do { const int s_ = (S); \
        *(u32x4*)(Ks + s_ * KVS + lr * 144 + lc8 * 16) = rk0; *(u32x4*)(Vs + s_ * KVS + lr * 144 + lc8 * 16) = rv0; \
        if (NWV == 4) { *(u32x4*)(Ks + s_ * KVS + (lr + 32) * 144 + lc8 * 16) = rk1; *(u32x4*)(Vs + s_ * KVS + (lr + 32) * 144 + lc8 * 16) = rv1; } } while (0)
    FL_GLOAD(0);
    VM_WAIT0();
    FL_SSTORE(0);
    __syncthreads();
    f32x4 o[MT][4];
    float mrow[MT], lrow[MT];
#pragma unroll
    for (int mt = 0; mt < MT; ++mt) {
        mrow[mt] = -1e30f; lrow[mt] = 0.f;
#pragma unroll
        for (int dt = 0; dt < 4; ++dt) o[mt][dt] = f32x4{0.f, 0.f, 0.f, 0.f};
    }
    const float L2E = 1.4426950408889634f;
    for (int kt = 0; kt < ntiles; ++kt) {
        const int cur = kt & 1;
        const bool more = kt + 1 < ntiles;
        FL_GLOAD(more ? kt + 1 : kt);
        __builtin_amdgcn_sched_barrier(0);
        f32x4 s[MT][4];
#pragma unroll
        for (int mt = 0; mt < MT; ++mt)
#pragma unroll
            for (int nt = 0; nt < 4; ++nt) s[mt][nt] = f32x4{0.f, 0.f, 0.f, 0.f};
#pragma unroll
        for (int ks = 0; ks < 2; ++ks)
#pragma unroll
            for (int nt = 0; nt < 4; ++nt) {
                const bf16x8 kf = *(const bf16x8*)(Ks + cur * KVS + (nt * 16 + fr) * 144 + (ks * 32 + fq * 8) * 2);
#pragma unroll
                for (int mt = 0; mt < MT; ++mt) s[mt][nt] = mfma16(kf, qf[mt][ks].v, s[mt][nt]);
            }
        Frag pf[MT][2];
#pragma unroll
        for (int mt = 0; mt < MT; ++mt) {
            float rsum = 0.f;
            if (NAMASK && kt < 8) {
                const int qc = (wave * MT + mt) * 16 + fr;
                int cs = qc - 8; cs = cs < 0 ? 0 : (cs > 48 ? 48 : cs);
                const int brow = rs + kt - r_q + 7;
#pragma unroll
                for (int nt = 0; nt < 4; ++nt)
#pragma unroll
                    for (int r = 0; r < 4; ++r) {
                        const int kc = nt * 16 + fq * 4 + r;
                        const bool valid = (kc >= cs) && (kc < cs + 16);
                        const int bi = valid ? brow * 31 + (kc - qc + 15) : 0;
                        const float e = valid ? fexp2(fmaf(s[mt][nt][r], L2E, rpb_s[bi] - mfix)) : 0.f;
                        s[mt][nt][r] = e; rsum += e;
                    }
            } else {
#pragma unroll
                for (int nt = 0; nt < 4; ++nt)
#pragma unroll
                    for (int r = 0; r < 4; ++r) { const float e = fexp2(fmaf(s[mt][nt][r], L2E, -mfix)); s[mt][nt][r] = e; rsum += e; }
            }
            lrow[mt] += rsum;
#pragma unroll
            for (int ks = 0; ks < 2; ++ks) {
                pf[mt][ks].u[0] = pk2(s[mt][2 * ks][0], s[mt][2 * ks][1]);
                pf[mt][ks].u[1] = pk2(s[mt][2 * ks][2], s[mt][2 * ks][3]);
                pf[mt][ks].u[2] = pk2(s[mt][2 * ks + 1][0], s[mt][2 * ks + 1][1]);
                pf[mt][ks].u[3] = pk2(s[mt][2 * ks + 1][2], s[mt][2 * ks + 1][3]);
            }
        }
#pragma unroll
        for (int ks = 0; ks < 2; ++ks)
#pragma unroll
            for (int dt = 0; dt < 4; ++dt) {
                Frag vf;
                vf.d[0] = *(const uint2*)(Vs + cur * KVS + (dt * 16 + fr) * 144 + (ks * 32 + fq * 4) * 2);
                vf.d[1] = *(const uint2*)(Vs + cur * KVS + (dt * 16 + fr) * 144 + (ks * 32 + 16 + fq * 4) * 2);
#pragma unroll
                for (int mt = 0; mt < MT; ++mt) o[mt][dt] = mfma16(vf.v, pf[mt][ks].v, o[mt][dt]);
            }
        __builtin_amdgcn_sched_barrier(0);
        VM_WAIT0();
        FL_SSTORE(cur ^ 1);
        __syncthreads();
    }
#pragma unroll
    for (int mt = 0; mt < MT; ++mt) {
        const float inv = 1.f / xq_sum(lrow[mt]);
        u16* op = P + (size_t)(qrow0 + (wave * MT + mt) * 16 + fr) * PW + ocol;
#pragma unroll
        for (int dt = 0; dt < 4; ++dt)
            *(uint2*)(op + dt * 16 + fq * 4) = uint2{pk2(o[mt][dt][0] * inv, o[mt][dt][1] * inv), pk2(o[mt][dt][2] * inv, o[mt][dt][3] * inv)};
    }
}


DEV void m2_item(const Params& p, int sc, int c) {
    const u16* T = WSP(u16, OFF_T);
    const int lane = VTID & 63, wave = VTID >> 6, fr = lane & 15, fq = lane >> 4;
    const int dir = sc & 1, h = (sc >> 1) & 3, b = sc >> 3;
    const int u0 = cu_of(c, dir) * 64;
    const float* AE = WSP(float, OFF_AE) + (size_t)sc * UT + u0;
    float* S = WSP(float, OFF_S) + ((size_t)sc * NCH + c) * SCH;
    const float mnew = fmaxf(WSP(float, OFF_MS)[sc * NCH + c] + m_scan(p, sc, c), WSP(float, OFF_DEC)[sc * NCH + c]);
    f32x4 acc[4], accn[4];
#pragma unroll
    for (int nt = 0; nt < 4; ++nt) { acc[nt] = f32x4{0.f, 0.f, 0.f, 0.f}; accn[nt] = f32x4{0.f, 0.f, 0.f, 0.f}; }
    Frag ones;
    ones.u[0] = ones.u[1] = ones.u[2] = ones.u[3] = 0x3F803F80u;
#pragma unroll
    for (int ks = 0; ks < 2; ++ks) {
        Frag vf;
        vf.q = *(const uint4*)(T + ((size_t)(b * TW + TC_MLV + h * 64 + wave * 16 + fr)) * UT + u0 + ks * 32 + fq * 8);
        float4 a0 = *(const float4*)(AE + ks * 32 + fq * 8), a1 = *(const float4*)(AE + ks * 32 + fq * 8 + 4);
        a0.x = expf(a0.x - mnew); a0.y = expf(a0.y - mnew); a0.z = expf(a0.z - mnew); a0.w = expf(a0.w - mnew);
        a1.x = expf(a1.x - mnew); a1.y = expf(a1.y - mnew); a1.z = expf(a1.z - mnew); a1.w = expf(a1.w - mnew);
#pragma unroll
        for (int nt = 0; nt < 4; ++nt) {
            Frag kf, kb;
            kf.q = *(const uint4*)(T + ((size_t)(b * TW + TC_MLK + h * 64 + nt * 16 + fr)) * UT + u0 + ks * 32 + fq * 8);
            kb.u[0] = pk2(bflo(kf.u[0]) * a0.x * 0.125f, bfhi(kf.u[0]) * a0.y * 0.125f);
            kb.u[1] = pk2(bflo(kf.u[1]) * a0.z * 0.125f, bfhi(kf.u[1]) * a0.w * 0.125f);
            kb.u[2] = pk2(bflo(kf.u[2]) * a1.x * 0.125f, bfhi(kf.u[2]) * a1.y * 0.125f);
            kb.u[3] = pk2(bflo(kf.u[3]) * a1.z * 0.125f, bfhi(kf.u[3]) * a1.w * 0.125f);
            acc[nt] = mfma16(vf.v, kb.v, acc[nt]);
            if (wave == 0) accn[nt] = mfma16(ones.v, kb.v, accn[nt]);
        }
    }
#pragma unroll
    for (int nt = 0; nt < 4; ++nt) {
#pragma unroll
        for (int r = 0; r < 4; ++r) S[(wave * 16 + fq * 4 + r) * 64 + nt * 16 + fr] = acc[nt][r];
        if (wave == 0 && fq == 0) S[4096 + nt * 16 + fr] = accn[nt][0];
    }
}

DEV void ph_m3(const Params& p, int bid, int G) {
    const float* DEC = WSP(float, OFF_DEC);
    float* S = WSP(float, OFF_S);
    const int total = NSCAN * SCH;
    for (int i = bid * 256 + VTID; i < total; i += G * 256) {
        const int sc = i / SCH, e = i - sc * SCH;
        float* base = S + (size_t)sc * NCH * SCH + e;
        const float* mxp = DEC + sc * NCH;
        const float* btp = WSP(float, OFF_MS) + sc * NCH;
        float st = 0.f, m = 0.f;
#pragma unroll 17
        for (int c = 0; c < NCH; ++c) {
            const float tmp = base[(size_t)c * SCH];
            base[(size_t)c * SCH] = st;
            const float bm = btp[c] + m;
            const float mnew = fmaxf(bm, mxp[c]);
            st = expf(bm - mnew) * st + tmp;
            m = mnew;
        }
    }
}

DEV void m4_item(const Params& p, int l, int b, int h, int cu, int ocolbase) {
    u16* P = WSP(u16, OFF_P);
    const u16* T = WSP(u16, OFF_T);
    const int lane = VTID & 63, wave = VTID >> 6, fr = lane & 15, fq = lane >> 4;
    const int u0 = cu * 64;
    const int row0 = rowof(b, u0);
    const int j = wave * 16 + fr;
    Frag qf[2];
#pragma unroll
    for (int ks = 0; ks < 2; ++ks) qf[ks].q = *(const uint4*)(P + (size_t)(row0 + j) * PW + PC_MLQ + h * 64 + ks * 32 + fq * 8);
    f32x4 hsum[4];
#pragma unroll
    for (int dt = 0; dt < 4; ++dt) hsum[dt] = f32x4{0.f, 0.f, 0.f, 0.f};
#pragma unroll 1
    for (int dir = 0; dir < 2; ++dir) {
        const int sc = (b * 4 + h) * 2 + dir;
        int c;
        if (cu >= 64) c = dir ? 3 - (cu - 64) : (cu - 64); else c = 4 + (dir ? 63 - cu : cu);
        const float m0 = m_scan(p, sc, c);
        const float* BC = WSP(float, OFF_BC) + (size_t)sc * UT + u0;
        const float* IG = WSP(float, OFF_IG) + (size_t)sc * UT + u0;
        const float* S = WSP(float, OFF_S) + ((size_t)sc * NCH + c) * SCH;
        const float bj = BC[j];
        f32x4 s[4];
#pragma unroll
        for (int nt = 0; nt < 4; ++nt) s[nt] = f32x4{0.f, 0.f, 0.f, 0.f};
#pragma unroll
        for (int ks = 0; ks < 2; ++ks)
#pragma unroll
            for (int nt = 0; nt < 4; ++nt) {
                Frag kf;
                kf.q = *(const uint4*)(P + (size_t)(row0 + nt * 16 + fr) * PW + PC_MLK + h * 64 + ks * 32 + fq * 8);
                s[nt] = mfma16(kf.v, qf[ks].v, s[nt]);
            }
        float lw[4][4];
        float mx = -1e30f;
#pragma unroll
        for (int nt = 0; nt < 4; ++nt) {
            const float4 bs = *(const float4*)(BC + nt * 16 + fq * 4);
            const float4 is = *(const float4*)(IG + nt * 16 + fq * 4);
            const float bsv[4] = {bs.x, bs.y, bs.z, bs.w}, isv[4] = {is.x, is.y, is.z, is.w};
#pragma unroll
            for (int r = 0; r < 4; ++r) {
                const int sidx = nt * 16 + fq * 4 + r;
                const bool valid = dir ? (sidx >= j) : (sidx <= j);
                lw[nt][r] = valid ? (bj - bsv[r] + isv[r]) : -1e30f;
                mx = fmaxf(mx, lw[nt][r]);
            }
        }
        mx = xq_max(mx);
        const float minter = bj + m0;
        const float mj = fmaxf(minter, mx);
        const float g = fexp(minter - mj);
        float den = 0.f;
#pragma unroll
        for (int nt = 0; nt < 4; ++nt)
#pragma unroll
            for (int r = 0; r < 4; ++r) {
                const float w = fexp(lw[nt][r] - mj);
                const float qk = s[nt][r] * 0.125f * w;
                s[nt][r] = qk;
                den += qk;
            }
        den = xq_sum(den);
        Frag pf[2];
#pragma unroll
        for (int ks = 0; ks < 2; ++ks) {
            pf[ks].u[0] = pk2(s[2 * ks][0], s[2 * ks][1]);
            pf[ks].u[1] = pk2(s[2 * ks][2], s[2 * ks][3]);
            pf[ks].u[2] = pk2(s[2 * ks + 1][0], s[2 * ks + 1][1]);
            pf[ks].u[3] = pk2(s[2 * ks + 1][2], s[2 * ks + 1][3]);
        }
        f32x4 acc[4], accn = f32x4{0.f, 0.f, 0.f, 0.f};
#pragma unroll
        for (int dt = 0; dt < 4; ++dt) acc[dt] = f32x4{0.f, 0.f, 0.f, 0.f};
#pragma unroll
        for (int ks = 0; ks < 2; ++ks) {
            {
                const float4 n0 = *(const float4*)(S + 4096 + ks * 32 + fq * 8), n1 = *(const float4*)(S + 4096 + ks * 32 + fq * 8 + 4);
                Frag nf;
                nf.u[0] = pk2(n0.x, n0.y); nf.u[1] = pk2(n0.z, n0.w); nf.u[2] = pk2(n1.x, n1.y); nf.u[3] = pk2(n1.z, n1.w);
                accn = mfma16(nf.v, qf[ks].v, accn);
            }
#pragma unroll
            for (int dt = 0; dt < 4; ++dt) {
                const float* cp = S + (dt * 16 + fr) * 64 + ks * 32 + fq * 8;
                const float4 c0 = *(const float4*)cp, c1 = *(const float4*)(cp + 4);
                Frag cf;
                cf.u[0] = pk2(c0.x, c0.y); cf.u[1] = pk2(c0.z, c0.w); cf.u[2] = pk2(c1.x, c1.y); cf.u[3] = pk2(c1.z, c1.w);
                acc[dt] = mfma16(cf.v, qf[ks].v, acc[dt]);
            }
        }
#pragma unroll
        for (int dt = 0; dt < 4; ++dt) acc[dt] *= g;
        den += g * accn[0];
#pragma unroll
        for (int ks = 0; ks < 2; ++ks)
#pragma unroll
            for (int dt = 0; dt < 4; ++dt) {
                const u16* vp = T + ((size_t)(b * TW + TC_MLV + h * 64 + dt * 16 + fr)) * UT + u0 + ks * 32 + fq * 4;
                Frag vf;
                vf.d[0] = *(const uint2*)vp;
                vf.d[1] = *(const uint2*)(vp + 16);
                acc[dt] = mfma16(vf.v, pf[ks].v, acc[dt]);
            }
        const float dd = 1.f / fmaxf(fabsf(den), fexp(-mj));
#pragma unroll
        for (int dt = 0; dt < 4; ++dt) hsum[dt] += acc[dt] * dd;
    }
    float ss = 0.f;
#pragma unroll
    for (int dt = 0; dt < 4; ++dt)
#pragma unroll
        for (int r = 0; r < 4; ++r) ss += hsum[dt][r] * hsum[dt][r];
    ss = xq_sum(ss);
    const float rstd = rsqrtf(ss * (1.f / 64.f) + 1e-6f);
    const float* nw = p.ml_norm_w + l * 256 + h * 64;
    u16* orow = P + (size_t)(row0 + j) * PW;
#pragma unroll
    for (int dt = 0; dt < 4; ++dt) {
        const int v0 = dt * 16 + fq * 4;
        const float4 w4 = *(const float4*)(nw + v0);
        const uint2 og = *(const uint2*)(orow + PC_MLO + h * 64 + v0);
        const float y0 = hsum[dt][0] * rstd * w4.x * sigmoidf_(bflo(og.x));
        const float y1 = hsum[dt][1] * rstd * w4.y * sigmoidf_(bfhi(og.x));
        const float y2 = hsum[dt][2] * rstd * w4.z * sigmoidf_(bflo(og.y));
        const float y3 = hsum[dt][3] * rstd * w4.w * sigmoidf_(bfhi(og.y));
        *(uint2*)(orow + ocolbase + h * 64 + v0) = uint2{pk2(y0, y1), pk2(y2, y3)};
    }
}

DEV void ph_attn8(const Params& p, int l, char* smem0, int rbid, int RG) {
    const int n_gq = 768, n_c = (l == 0) ? 96 : 0;
    const int ln_ = (int)((threadIdx.x + p.z) & 63);
    const float bgq = 8.f * wave_max(fabsf(p.gq_qk_w[(l * 2 + 0) * 64 + ln_])) * wave_max(fabsf(p.gq_qk_w[(l * 2 + 1) * 64 + ln_])) * 1.4426950408889634f * 1.03f + 0.5f;
    const float bna = 8.f * wave_max(fabsf(p.na_qk_w[(l * 2 + 0) * 64 + ln_])) * wave_max(fabsf(p.na_qk_w[(l * 2 + 1) * 64 + ln_])) * 1.4426950408889634f * 1.03f + 0.5f;
    for (int it = rbid; it < n_gq + n_c; it += RG) {
        float mfix = bgq;
        int b, qrow0, qcol, kcol, tcol, ua, nt;
        if (it < n_gq) {
            const int qt = it & 15, hq = (it >> 4) % 6;
            b = it / 96; qrow0 = b * SEQ + qt * 256; qcol = PC_GQQ + hq * 64; kcol = PC_GQK + (hq / 3) * 64; tcol = TC_GQV + (hq / 3) * 64; ua = 0; nt = 68;
        } else {
            const int r = it - n_gq;
            const int kind = r / 48, rr = r % 48, hh = rr % 6;
            b = rr / 6; qrow0 = NL + b * CTXL; ua = SEQ; nt = 4;
            if (kind == 0) { qcol = PC_GQQ + hh * 64; kcol = PC_GQK + (hh / 3) * 64; tcol = TC_GQV + (hh / 3) * 64; }
            else { qcol = PC_NAQ + hh * 64; kcol = PC_NAK + hh * 64; tcol = TC_NAV + hh * 64; mfix = bna; }
        }
        flash_item<2, false, 8>(p, b, qrow0, qcol, kcol, tcol, ua, nt, 0, nt, 0, 0, nullptr, smem0, qcol, mfix);
    }
}
DEV void ph_attn(const Params& p, int l, char* smem, int bid, int G, int rep) {
    const int n_na = 3072, n_m2 = NSCAN * NCH;
    const int total = n_na + n_m2;
    const int ln_ = VTID & 63;
    float rmax = 0.f;
    for (int i = ln_; i < 6 * 465; i += 64) rmax = fmaxf(rmax, fabsf(p.na_rpb[(size_t)l * 6 * 465 + i]));
    const float mfix_na = (8.f * wave_max(fabsf(p.na_qk_w[(l * 2 + 0) * 64 + ln_])) * wave_max(fabsf(p.na_qk_w[(l * 2 + 1) * 64 + ln_])) * 1.03f + wave_max(rmax)) * 1.4426950408889634f + 0.5f;
    for (int it = bid; it < total; it += G) {
        int r = it;
        if (r < n_na) {
            const int gr = r & 63, hn = (r >> 6) % 6, b = r / 384;
            int rs = gr - 4; rs = rs < 0 ? 0 : (rs > 56 ? 56 : rs);
            flash_item<1, true, 4>(p, b, b * SEQ + gr * 64, PC_NAQ + hn * 64, PC_NAK + hn * 64, TC_NAV + hn * 64, rs * 64, 8, SEQ, 12, gr, rs,
                                p.na_rpb + (size_t)(l * 6 + hn) * 465, smem, PC_NAQ + hn * 64 + (rep ? 1792 : 0), mfix_na);
            continue;
        }
        r -= n_na;
        m2_item(p, r / NCH, r % NCH);
    }
}

DEV void ph_m4(const Params& p, int l, int bid, int G, int rep) {
    const int nch = (l == 0) ? NCH : 64;
    const int total = NB * 4 * nch;
    for (int it = bid; it < total; it += G) {
        const int cu = it % nch, h = (it / nch) & 3, b = it / (nch * 4);
        m4_item(p, l, b, h, cu, rep ? 2048 : PC_MLQ);
    }
}

DEV void ph_merge(const Params& p, int mt0, int mtiles, char* smem, int vid, int G) {
    const u16* H = WSP(u16, OFF_H);
    u16* P = WSP(u16, OFF_P);
    const u16* Wg = WSP(u16, OFF_W) + WE_MIX + (size_t)2944 * 1024;
    const u16* Wbr = WSP(u16, OFF_W) + WE_BR;
    const int lane = VTID & 63, wave = VTID >> 6, wm = wave >> 1, wn = wave & 1, fr = lane & 15, fq = lane >> 4;
    const int total = mtiles * 16;
    for (int t = vid; t < total; t += G) {
        int mt_, nt_;
        tile_decode(t, 16, mt_, nt_);
        mt_ += mt0;
        const int m0 = mt_ * 128, n0 = nt_ * 64;
        f32x4 y[4][2];
        zero_acc<2>(y);
#pragma unroll 1
        for (int br = 0; br < 3; ++br) {
            const int ko = br == 0 ? 0 : (br == 1 ? 256 : 640);
            const int kk = br == 0 ? 256 : 384;
            f32x4 g[4][2];
            zero_acc<2>(g);
            gemm_accum<2>(g, H + (size_t)m0 * D, D, Wg + (size_t)(br * 1024 + n0) * D, D, D, smem, VTID);
#pragma unroll
            for (int i = 0; i < 4; ++i)
#pragma unroll
                for (int jn = 0; jn < 2; ++jn)
#pragma unroll
                    for (int r = 0; r < 4; ++r) g[i][jn][r] = sigmoidf_(g[i][jn][r]);
            f32x4 a[4][2];
            zero_acc<2>(a);
            gemm_accum<2>(a, P + (size_t)m0 * PW + ko, PW, Wbr + (size_t)n0 * D + ko, D, kk, smem, VTID);
#pragma unroll
            for (int i = 0; i < 4; ++i)
#pragma unroll
                for (int jn = 0; jn < 2; ++jn) y[i][jn] += g[i][jn] * a[i][jn];
        }
#pragma unroll
        for (int mt = 0; mt < 4; ++mt)
#pragma unroll
            for (int nt = 0; nt < 2; ++nt)
#pragma unroll
                for (int r = 0; r < 4; ++r) {
                    const int row = m0 + wm * 64 + mt * 16 + fq * 4 + r;
                    const int col = n0 + wn * 32 + nt * 16 + fr;
                    P[(size_t)row * PW + PC_Y + col] = (u16)(pk2(y[mt][nt][r], 0.f) & 0xffff);
                }
    }
}


#ifdef DBG
constexpr size_t OFF_DBG = al256(WS_END);
__global__ void __launch_bounds__(64) dbg_mlstm(Params p, int l) {
    const int sc = blockIdx.x, dir = sc & 1, h = (sc >> 1) & 3, b = sc >> 3, lane = VTID;
    const u16* P = WSP(u16, OFF_P); const u16* T = WSP(u16, OFF_T); const float* Gt = WSP(float, OFF_G);
    float* HN = WSP(float, OFF_S) + (size_t)sc * UT * 64;
    const float bi = p.ml_gate_b[l * 16 + dir * 8 + h], bf = p.ml_gate_b[l * 16 + dir * 8 + 4 + h];
    float C[64], n[64];
    for (int k = 0; k < 64; ++k) { C[k] = 0.f; n[k] = 0.f; }
    float m = 0.f;
    for (int pos = 0; pos < UT; ++pos) {
        int u;
        if (pos < 256) u = SEQ + (dir ? 255 - pos : pos); else u = dir ? 4095 - (pos - 256) : (pos - 256);
        const int row = rowof(b, u);
        const float ig = Gt[(size_t)row * 16 + dir * 8 + h] + bi;
        const float fp = Gt[(size_t)row * 16 + dir * 8 + 4 + h] + bf;
        const float lf = fminf(fp, 0.f) - log1pf(expf(-fabsf(fp)));
        const float mn = fmaxf(lf + m, ig);
        const float fw = expf(lf + m - mn), iw = expf(ig - mn);
        m = mn;
        const float qv = __uint_as_float(((uint32_t)P[(size_t)row * PW + 2048 + h * 64 + lane]) << 16);
        const float kv = __uint_as_float(((uint32_t)P[(size_t)row * PW + PC_MLK + h * 64 + lane]) << 16) * 0.125f;
        const float vv = __uint_as_float(((uint32_t)T[((size_t)(b * TW + TC_MLV + h * 64 + lane)) * UT + u]) << 16);
        float num = 0.f, den = 0.f;
#pragma unroll
        for (int k = 0; k < 64; ++k) {
            const float kk = __shfl(kv, k), qq = __shfl(qv, k);
            C[k] = fw * C[k] + iw * kk * vv;
            n[k] = fw * n[k] + iw * kk;
            num += qq * C[k];
            den += qq * n[k];
        }
        HN[(size_t)u * 64 + lane] = num / fmaxf(fabsf(den), expf(-m));
    }
}
__global__ void dbg_cmp(Params p, int l) {
    const int gid = blockIdx.x * blockDim.x + VTID;
    const u16* P = WSP(u16, OFF_P); const u16* T = WSP(u16, OFF_T);
    unsigned* dw = (unsigned*)(p.ws + OFF_DBG);
    float* df = (float*)(p.ws + OFF_DBG);
    if (gid < NB * 4 * UT) {
        const int u = gid % UT, h = (gid / UT) & 3, b = gid / (UT * 4);
        const int row = rowof(b, u);
        const float* hf = WSP(float, OFF_S) + ((size_t)((b * 4 + h) * 2 + 0) * UT + u) * 64;
        const float* hb = WSP(float, OFF_S) + ((size_t)((b * 4 + h) * 2 + 1) * UT + u) * 64;
        float ss = 0.f;
        for (int v = 0; v < 64; ++v) { const float x = hf[v] + hb[v]; ss += x * x; }
        const float rstd = rsqrtf(ss / 64.f + 1e-6f);
        float md = 0.f;
        for (int v = 0; v < 64; ++v) {
            const float x = (hf[v] + hb[v]) * rstd * p.ml_norm_w[l * 256 + h * 64 + v];
            const float o = __uint_as_float(((uint32_t)P[(size_t)row * PW + PC_MLO + h * 64 + v]) << 16);
            const float y = x / (1.f + expf(-o));
            const float got = __uint_as_float(((uint32_t)P[(size_t)row * PW + PC_MLQ + h * 64 + v]) << 16);
            md += fabsf(y - got);
        }
        atomicAdd(df + (u < SEQ ? 0 : 1), md * (1.f / 64.f));
        return;
    }
    const int w = (gid - NB * 4 * UT) >> 6;
    const int lane = VTID & 63;
    int type, b, qrow, qc, kcol, tcol, ocol, hn = 0, gr = 0, gc = 0, nkeys;
    if (w < 6144) {
        type = 0; const int i = w & 127; hn = (w >> 7) % 6; b = w / 768;
        gr = i & 63; gc = (i < 64) ? gr : 63 - gr;
        qrow = b * SEQ + gr * 64 + gc; qc = 2048 + 256 + hn * 64; kcol = PC_NAK + hn * 64; tcol = TC_NAV + hn * 64; ocol = PC_NAQ + hn * 64; nkeys = 384;
    } else if (w < 6144 + 256) {
        type = 1; const int x = w - 6144; const int i = x & 15, hh = (x >> 4) & 1; b = x >> 5;
        qrow = b * SEQ + (i * 273) % 4096; qc = 2688 + hh * 64; kcol = PC_GQK + hh * 64; tcol = TC_GQV + hh * 64; ocol = PC_GQQ + hh * 3 * 64; nkeys = 4352;
    } else if (w < 6144 + 256 + 768) {
        type = 2; const int x = w - 6400; const int i = x & 15; hn = (x >> 4) % 6; b = x / 96;
        qrow = NL + b * CTXL + (i * 17) % 256; qc = 2048 + 256 + hn * 64; kcol = PC_NAK + hn * 64; tcol = TC_NAV + hn * 64; ocol = PC_NAQ + hn * 64; nkeys = 256;
    } else if (w < 6144 + 256 + 768 + 256) {
        type = 3; const int x = w - 7168; const int i = x & 15, hh = (x >> 4) & 1; b = x >> 5;
        qrow = NL + b * CTXL + (i * 17) % 256; qc = 2688 + hh * 64; kcol = PC_GQK + hh * 64; tcol = TC_GQV + hh * 64; ocol = PC_GQQ + hh * 3 * 64; nkeys = 256;
    } else return;
    const float q = __uint_as_float(((uint32_t)P[(size_t)qrow * PW + qc + lane]) << 16);
    float o = 0.f;
    int rs = gr - 4; rs = rs < 0 ? 0 : (rs > 56 ? 56 : rs);
    int cs = gc - 8; cs = cs < 0 ? 0 : (cs > 48 ? 48 : cs);
    float mx = -1e30f, lsum = 0.f;
    for (int kidx = 0; kidx < nkeys; ++kidx) {
        int u; float bias = 0.f;
        if (type == 0) {
            if (kidx < 128) {
                const int ri = kidx >> 4, ci = kidx & 15;
                u = (rs + ri) * 64 + cs + ci;
                bias = p.na_rpb[(size_t)(l * 6 + hn) * 465 + (rs + ri - gr + 7) * 31 + (cs + ci - gc + 15)];
            } else u = SEQ + (kidx - 128);
        } else if (type == 1) u = kidx;
        else u = SEQ + kidx;
        const int krow = rowof(b, u);
        float sdot = wave_sum(q * __uint_as_float(((uint32_t)P[(size_t)krow * PW + kcol + lane]) << 16));
        sdot += bias;
        const float mn = fmaxf(mx, sdot);
        const float al = expf(mx - mn), e = expf(sdot - mn);
        lsum = lsum * al + e; mx = mn;
        o = o * al + e * __uint_as_float(((uint32_t)T[((size_t)(b * TW + tcol + lane)) * UT + u]) << 16);
    }
    const float got = __uint_as_float(((uint32_t)P[(size_t)qrow * PW + ocol + lane]) << 16);
    float md = wave_max(fabsf(o / lsum - got));
    if (lane == 0) atomicMax(dw + 2 + type, __float_as_uint(md));
}
__global__ void dbg_copy(Params p) {
    u16* P = WSP(u16, OFF_P);
    for (size_t i = (size_t)blockIdx.x * 256 + VTID; i < (size_t)MTOT * 768; i += (size_t)gridDim.x * 256) {
        const size_t row = i / 768, c = i % 768;
        const size_t src = c < 640 ? c : (c < 704 ? PC_GQQ + (c - 640) : PC_GQQ + 192 + (c - 704));
        P[row * PW + 2048 + c] = P[row * PW + src];
    }
}
DEV int dbg_row(int sr) { return sr < 8 ? sr * 4096 + (sr * 577 + 13) % 4096 : NL + (sr - 8) * 256 + ((sr - 8) * 37 + 5) % 256; }
DEV float* dbg_xrow(const Params& p, int row) { return row < NL ? p.out + (size_t)row * D : WSP(float, OFF_XC) + (size_t)(row - NL) * D; }
DEV float dbg_mod(const Params& p, int l, int b9, int idx, int n) {
    float a = p.ada_b[l * 9216 + idx * 1024 + n];
    for (int k = 0; k < 1024; ++k) {
        const float c = b9 < 8 ? p.c[b9 * 1024 + k] : p.c_ctx[k];
        a += c / (1.f + expf(-c)) * p.ada_w[((size_t)l * 1024 + k) * 9216 + idx * 1024 + n];
    }
    return a;
}
DEV float blk_sum(float v, float* red) {
    v = wave_sum(v);
    __syncthreads();
    if ((VTID & 63) == 0) red[VTID >> 6] = v;
    __syncthreads();
    return red[0] + red[1] + red[2] + red[3];
}
DEV float blk_max(float v, float* red) {
    v = wave_max(v);
    __syncthreads();
    if ((VTID & 63) == 0) red[VTID >> 6] = v;
    __syncthreads();
    return fmaxf(fmaxf(red[0], red[1]), fmaxf(red[2], red[3]));
}
__global__ void dbg_save(Params p, int slot) {
    const int sr = blockIdx.x, row = dbg_row(sr);
    float* dst = (float*)(p.ws + OFF_DBG + 256) + ((size_t)slot * 16 + sr) * 1024;
    const float* src = dbg_xrow(p, row);
    for (int n = VTID; n < 1024; n += 256) dst[n] = src[n];
}
DEV float dbg_modulate(const Params& p, int l, int sub, int b9, const float* xs, float* hs, float* red) {
    float ss = 0.f;
    for (int n = VTID; n < 1024; n += 256) ss += xs[n] * xs[n];
    ss = blk_sum(ss, red);
    const float rstd = rsqrtf(ss / 1024.f + 1e-6f);
    float md = 0.f;
    for (int n = VTID; n < 1024; n += 256) {
        const float sh = dbg_mod(p, l, b9, 3 * sub, n), sc = dbg_mod(p, l, b9, 3 * sub + 1, n);
        md = fmaxf(md, fabsf(sh - WSP(float, OFF_MODS)[b9 * 9216 + (3 * sub) * 1024 + n]));
        md = fmaxf(md, fabsf(sc - WSP(float, OFF_MODS)[b9 * 9216 + (3 * sub + 1) * 1024 + n]));
        hs[n] = xs[n] * rstd * p.norm_w[(l * 3 + sub) * 1024 + n] * (1.f + sc) + sh;
    }
    __syncthreads();
    return md;
}
__global__ void __launch_bounds__(256) dbg_ffn(Params p, int l, int which, int slot, int bit) {
    __shared__ float xs[1024], hs[1024], gs[1024], as[2816], red[4];
    const int sr = blockIdx.x, row = dbg_row(sr), b9 = row < NL ? row >> 12 : 8, sub = which ? 2 : 0;
    const float* xin = (const float*)(p.ws + OFF_DBG + 256) + ((size_t)slot * 16 + sr) * 1024;
    for (int n = VTID; n < 1024; n += 256) xs[n] = xin[n];
    __syncthreads();
    float mdm = dbg_modulate(p, l, sub, b9, xs, hs, red);
    for (int n = VTID; n < 1024; n += 256) gs[n] = dbg_mod(p, l, b9, 3 * sub + 2, n);
    const float* win = p.ffn_w_in + (size_t)(l * 2 + which) * 1024 * 5632;
    const float* wout = p.ffn_w_out + (size_t)(l * 2 + which) * 2816 * 1024;
    for (int j = VTID; j < 2816; j += 256) {
        float g = 0.f, u = 0.f;
        for (int k = 0; k < 1024; ++k) { g += hs[k] * win[(size_t)k * 5632 + j]; u += hs[k] * win[(size_t)k * 5632 + 2816 + j]; }
        as[j] = g / (1.f + expf(-g)) * u;
    }
    __syncthreads();
    float md = 0.f;
    const float* xc = dbg_xrow(p, row);
    for (int n = VTID; n < 1024; n += 256) {
        float o = 0.f;
        for (int j = 0; j < 2816; ++j) o += as[j] * wout[(size_t)j * 1024 + n];
        md = fmaxf(md, fabsf(xs[n] + 0.5f * gs[n] * o - xc[n]));
    }
    md = blk_max(md, red);
    mdm = blk_max(mdm, red);
    unsigned* dw = (unsigned*)(p.ws + OFF_DBG);
    if (VTID == 0) { atomicMax(dw + bit, __float_as_uint(md)); atomicMax(dw + 15, __float_as_uint(mdm)); }
}
__global__ void __launch_bounds__(256) dbg_pchk(Params p, int l) {
    __shared__ float xs[1024], hs[1024], red[4];
    const int sr = blockIdx.x, row = dbg_row(sr), b9 = row < NL ? row >> 12 : 8;
    const float* xin = dbg_xrow(p, row);
    for (int n = VTID; n < 1024; n += 256) xs[n] = xin[n];
    __syncthreads();
    float mdm = dbg_modulate(p, l, 1, b9, xs, hs, red);
    const float* w = p.mix_w_in + (size_t)l * 1024 * NIN;
    const u16* P = WSP(u16, OFF_P); const u16* T = WSP(u16, OFF_T);
    int b, u;
    if (row < NL) { b = row >> 12; u = row & 4095; } else { b = (row - NL) >> 8; u = SEQ + ((row - NL) & 255); }
    float md = 0.f;
    for (int n = VTID; n < 2832; n += 256) {
        const int sc = map_col(2, n);
        float v = 0.f;
        for (int k = 0; k < 1024; ++k) v += hs[k] * w[(size_t)k * NIN + sc];
        if (n < 2048) md = fmaxf(md, fabsf(v - __uint_as_float(((uint32_t)P[(size_t)row * PW + n]) << 16)));
        if (n >= 1280 && n < 1536) md = fmaxf(md, fabsf(v - __uint_as_float(((uint32_t)T[((size_t)(b * TW + n - 1280)) * UT + u]) << 16)));
        if (n >= 2048 && n < 2816) md = fmaxf(md, fabsf(v - __uint_as_float(((uint32_t)T[((size_t)(b * TW + n - 1792)) * UT + u]) << 16)));
        if (n >= 2816) md = fmaxf(md, fabsf(v - WSP(float, OFF_G)[(size_t)row * 16 + n - 2816]));
    }
    md = blk_max(md, red);
    mdm = blk_max(mdm, red);
    unsigned* dw = (unsigned*)(p.ws + OFF_DBG);
    if (VTID == 0) { atomicMax(dw + 9, __float_as_uint(md)); atomicMax(dw + 15, __float_as_uint(mdm)); }
}
__global__ void __launch_bounds__(256) dbg_mix(Params p, int l, int slot) {
    __shared__ float xs[1024], hs[1024], os[1024], ys[1024], red[4];
    const int sr = blockIdx.x, row = dbg_row(sr), b9 = row < NL ? row >> 12 : 8;
    const float* xin = (const float*)(p.ws + OFF_DBG + 256) + ((size_t)slot * 16 + sr) * 1024;
    const u16* P = WSP(u16, OFF_P);
    for (int n = VTID; n < 1024; n += 256) { xs[n] = xin[n]; os[n] = __uint_as_float(((uint32_t)P[(size_t)row * PW + n]) << 16); }
    __syncthreads();
    float mdm = dbg_modulate(p, l, 1, b9, xs, hs, red);
    const float* w = p.mix_w_in + (size_t)l * 1024 * NIN;
    for (int n = VTID; n < 1024; n += 256) {
        float y = 0.f;
        for (int i = 0; i < 3; ++i) {
            float g = 0.f;
            for (int k = 0; k < 1024; ++k) g += hs[k] * w[(size_t)k * NIN + 2832 + i * 1024 + n];
            g = 1.f / (1.f + expf(-g));
            const float* wb = i == 0 ? p.w_br_ml + (size_t)l * 256 * 1024 : (i == 1 ? p.w_br_na + (size_t)l * 384 * 1024 : p.w_br_gq + (size_t)l * 384 * 1024);
            const int ko = i == 0 ? 0 : (i == 1 ? 256 : 640), kk = i == 0 ? 256 : 384;
            float a = 0.f;
            for (int k = 0; k < kk; ++k) a += os[ko + k] * wb[(size_t)k * 1024 + n];
            y += g * a;
        }
        ys[n] = y;
    }
    __syncthreads();
    float md = 0.f;
    const float* xc = dbg_xrow(p, row);
    for (int n = VTID; n < 1024; n += 256) {
        float o = 0.f;
        for (int k = 0; k < 1024; ++k) o += ys[k] * p.w_out[((size_t)l * 1024 + k) * 1024 + n];
        const float g5 = dbg_mod(p, l, b9, 5, n);
        md = fmaxf(md, fabsf(xs[n] + g5 * o - xc[n]));
    }
    md = blk_max(md, red);
    mdm = blk_max(mdm, red);
    unsigned* dw = (unsigned*)(p.ws + OFF_DBG);
    if (VTID == 0) { atomicMax(dw + 10, __float_as_uint(md)); atomicMax(dw + 15, __float_as_uint(mdm)); }
}
__global__ void dbg_fin(Params p) {
    const unsigned* dw = (const unsigned*)(p.ws + OFF_DBG);
    int mask = 0;
    if (__uint_as_float(dw[8]) > 0.02f) mask |= 1;
    if (__uint_as_float(dw[9]) > 0.03f) mask |= 2;
    if (__uint_as_float(dw[10]) > 0.02f) mask |= 4;
    if (__uint_as_float(dw[11]) > 0.02f) mask |= 8;
    if (__uint_as_float(dw[15]) > 1e-3f) mask |= 16;
    if (__uint_as_float(dw[4]) > 0.03f) mask |= 32;
    p.out[0] += 10.f * (float)mask;
    p.out[1] += 1000.f * __uint_as_float(dw[4]);
}
#endif


DEV void gemm8b_accum(f32x4 (&acc)[4][4], const u16* __restrict__ A, int lda, const u16* __restrict__ B, int ldb, int K, char* smem, int tid) {
    constexpr int STAGE = 49152;
    const int lane = tid & 63, wave = tid >> 6;
    const int wm = wave >> 1, wn = wave & 1, fr = lane & 15, fq = lane >> 4;
    const int lr = lane >> 3, pos = lane & 7;
    const int ce = pos ^ (lr >> 1), co = pos ^ (4 | (lr >> 1));
    const unsigned ra_ = (unsigned)((wave * 32 + lr) * lda) * 2u, rb_ = (unsigned)((wave * 16 + lr) * ldb) * 2u;
    const unsigned voa_e = ra_ + ce * 16, voa_o = ra_ + co * 16, vob_e = rb_ + ce * 16, vob_o = rb_ + co * 16;
    const int nk = K >> 6;
    const unsigned ldsb = (unsigned)(size_t)(__attribute__((address_space(3))) char*)smem;
    const unsigned ldsa_w = __builtin_amdgcn_readfirstlane(ldsb + wave * 4096);
    const unsigned ldsb_w = __builtin_amdgcn_readfirstlane(ldsb + 32768 + wave * 2048);
#define G8B_ISSUE(STG, K0) do { \
        _Pragma("unroll") for (int i = 0; i < 4; ++i) glds16(A + (size_t)(8 * i) * lda + (K0), (i & 1) ? voa_o : voa_e, ldsa_w + (STG) * STAGE + i * 1024); \
        _Pragma("unroll") for (int i = 0; i < 2; ++i) glds16(B + (size_t)(8 * i) * ldb + (K0), (i & 1) ? vob_o : vob_e, ldsb_w + (STG) * STAGE + i * 1024); \
    } while (0)
    G8B_ISSUE(0, 0);
    VM_WAIT0();
    __syncthreads();
    const int s3 = (fr >> 1) & 7;
    const int oa_base = (wm * 64 + fr) * 128 + ((fq ^ s3) * 16);
    const int ob_base = 32768 + (wn * 64 + fr) * 128 + ((fq ^ s3) * 16);
    for (int kt = 0; kt < nk; ++kt) {
        const int cur = kt & 1;
        const int k0 = (kt + 1 < nk ? kt + 1 : kt) * 64;
        G8B_ISSUE(cur ^ 1, k0);
        int o_a = cur * STAGE + oa_base, o_b = cur * STAGE + ob_base;
        asm volatile("" : "+v"(o_a), "+v"(o_b));
#pragma unroll
        for (int ks = 0; ks < 2; ++ks) {
            const char* sa_c = smem + (ks ? (o_a ^ 64) : o_a);
            const char* sb_c = smem + (ks ? (o_b ^ 64) : o_b);
            bf16x8 bfr[4], af[4];
#pragma unroll
            for (int nt = 0; nt < 4; ++nt) bfr[nt] = *(const bf16x8*)(sb_c + nt * 2048);
#pragma unroll
            for (int mt = 0; mt < 4; ++mt) af[mt] = *(const bf16x8*)(sa_c + mt * 2048);
#pragma unroll
            for (int mt = 0; mt < 4; ++mt)
#pragma unroll
                for (int nt = 0; nt < 4; ++nt) acc[mt][nt] = mfma16(af[mt], bfr[nt], acc[mt][nt]);
            __builtin_amdgcn_sched_group_barrier(0x100, 7, 0);
            __builtin_amdgcn_sched_group_barrier(0x008, 4, 0);
            __builtin_amdgcn_sched_group_barrier(0x100, 1, 0);
#pragma unroll
            for (int i = 0; i < 3; ++i) __builtin_amdgcn_sched_group_barrier(0x008, 4, 0);
        }
        VM_WAIT0();
        __syncthreads();
    }
#undef G8B_ISSUE
}

DEV void ph_merge8(const Params& p, char* smem, int rvid, int RG, int tid) {
    const u16* H = WSP(u16, OFF_H);
    u16* P = WSP(u16, OFF_P);
    const u16* Wg = WSP(u16, OFF_W) + WE_MIX + (size_t)2944 * 1024;
    const u16* Wbr = WSP(u16, OFF_W) + WE_BR;
    const int lane = tid & 63, wave = tid >> 6, wm = wave >> 1, wn = wave & 1, fr = lane & 15, fq = lane >> 4;
    const int total = 128 * 8;
    for (int t = rvid; t < total; t += RG) {
        const int gi = t >> 5, rem = t & 31;
        const int mt_ = gi * 4 + (rem & 3), nt_ = rem >> 2;
        const int m0 = mt_ * 256, n0 = nt_ * 128;
        f32x4 y[4][4];
        zero_acc<4>(y);
#pragma unroll 1
        for (int br = 0; br < 3; ++br) {
            const int ko = br == 0 ? 0 : (br == 1 ? 256 : 640);
            const int kk = br == 0 ? 256 : 384;
            uint32_t gpk[4][4][2];
            {
                f32x4 g[4][4];
                zero_acc<4>(g);
                gemm8b_accum(g, H + (size_t)m0 * D, D, Wg + (size_t)(br * 1024 + n0) * D, D, D, smem, tid);
#pragma unroll
                for (int i = 0; i < 4; ++i)
#pragma unroll
                    for (int jn = 0; jn < 4; ++jn) {
                        gpk[i][jn][0] = pk2(sigmoidf_(g[i][jn][0]), sigmoidf_(g[i][jn][1]));
                        gpk[i][jn][1] = pk2(sigmoidf_(g[i][jn][2]), sigmoidf_(g[i][jn][3]));
                    }
            }
            f32x4 a[4][4];
            zero_acc<4>(a);
            gemm8b_accum(a, P + (size_t)m0 * PW + ko, PW, Wbr + (size_t)n0 * D + ko, D, kk, smem, tid);
#pragma unroll
            for (int i = 0; i < 4; ++i)
#pragma unroll
                for (int jn = 0; jn < 4; ++jn) {
                    y[i][jn][0] += bflo(gpk[i][jn][0]) * a[i][jn][0];
                    y[i][jn][1] += bfhi(gpk[i][jn][0]) * a[i][jn][1];
                    y[i][jn][2] += bflo(gpk[i][jn][1]) * a[i][jn][2];
                    y[i][jn][3] += bfhi(gpk[i][jn][1]) * a[i][jn][3];
                }
        }
#pragma unroll
        for (int mt = 0; mt < 4; ++mt)
#pragma unroll
            for (int nt = 0; nt < 4; ++nt)
#pragma unroll
                for (int r = 0; r < 4; ++r) {
                    const int row = m0 + wm * 64 + mt * 16 + fq * 4 + r;
                    const int col = n0 + wn * 64 + nt * 16 + fr;
                    P[(size_t)row * PW + PC_Y + col] = (u16)(pk2(y[mt][nt][r], 0.f) & 0xffff);
                }
    }
}

constexpr int PH_PER_LAYER = 15;
constexpr int N_PHASES = 2 * PH_PER_LAYER;

#ifndef REPEAT_MASK
#define REPEAT_MASK 0
#endif
template <int Q>
DEV void run_phase_q(const Params& p, int l, char* smem) {
    const int half = (int)((threadIdx.x + p.z) >> 8);
    const int G = gridDim.x * 2, bid = blockIdx.x * 2 + half;
    const int vid = (gridDim.x % 8 == 0) ? (int)(blockIdx.x & 7) * (G >> 3) + (int)(blockIdx.x >> 3) * 2 + half : bid;
    smem += half * 73728;
    const bool last = (l == 1);
    const u16* W = WSP(u16, OFF_W);
    const int nrep = ((REPEAT_MASK >> Q) & 1) ? 2 : 1;
    char* smem0 = smem - half * 73728;
    const int rtid = (int)(threadIdx.x + p.z);
    const int RG = gridDim.x;
    const int rvid = (RG % 8 == 0) ? (int)(blockIdx.x & 7) * (RG >> 3) + (int)(blockIdx.x >> 3) : (int)blockIdx.x;
    for (int rep = 0; rep < nrep; ++rep) {
        const float cm = rep ? 0.f : 1.f;
        if (Q == 0) ph_prep(p, l, smem, bid, G);
        if (Q == 1) ph_mod(p, l, 0, MTOT, bid, G);
        Params p2 = p;
        if (Q == 2) { ph_ffn_in8(p, 0, 136, smem0, rvid, RG, rtid); }
        if (Q == 3) { ph_resid8(p, WSP(u16, OFF_P), DFF, W + WE_OUT0, DFF, 2, 0.5f * cm, smem0, rvid, RG, rtid, l == 0 ? p.x : p.out); int z2 = p.z; asm volatile("" : "+s"(z2) :: "memory"); p2.z = z2;
                      ph_resid(p2, WSP(u16, OFF_P), DFF, W + WE_OUT0, DFF, 2, 0.5f * cm, 256, 16, smem, vid, G); }
        if (Q == 4) ph_mod(p, l, 1, MTOT, bid, G);
        if (Q == 5) { ph_pgemm8(p, l, smem0, rvid, RG, rtid); int z2 = p.z; asm volatile("" : "+s"(z2) :: "memory"); p2.z = z2; ph_pgemm(p2, 256, 16, smem, vid, G); }
        if (Q == 6) ph_qknorm_gates(p, l, bid, G);
        if (Q == 7) { ph_attn8(p, l, smem0, rvid, RG); int z2 = p.z; asm volatile("" : "+s"(z2) :: "memory"); p2.z = z2; ph_attn(p2, l, smem, bid, G, rep); }
        if (Q == 8) ph_m3(p, bid, G);
        if (Q == 9) ph_m4(p, l, bid, G, rep);
        if (Q == 10) { ph_merge8(p, smem0, rvid, RG, rtid); int z2 = p.z; asm volatile("" : "+s"(z2) :: "memory"); p2.z = z2; if (!last) ph_merge(p2, 256, 16, smem, vid, G); }
        if (Q == 11) { ph_resid8(p, WSP(u16, OFF_P) + PC_Y, PW, W + WE_O, D, 5, 1.0f * cm, smem0, rvid, RG, rtid, p.out);
                       int z2 = p.z; asm volatile("" : "+s"(z2) :: "memory"); p2.z = z2;
                       if (!last) ph_resid(p2, WSP(u16, OFF_P) + PC_Y, PW, W + WE_O, D, 5, 1.0f * cm, 256, 16, smem, vid, G); }
        if (Q == 12) ph_mod(p, l, 2, last ? NL : MTOT, bid, G);
        if (Q == 13) { ph_ffn_in8(p, 1, last ? 128 : 136, smem0, rvid, RG, rtid); }
        if (Q == 14) { ph_resid8(p, WSP(u16, OFF_P), DFF, W + WE_OUT1, DFF, 8, 0.5f * cm, smem0, rvid, RG, rtid, p.out);
                       int z2 = p.z; asm volatile("" : "+s"(z2) :: "memory"); p2.z = z2;
                       if (!last) ph_resid(p2, WSP(u16, OFF_P), DFF, W + WE_OUT1, DFF, 8, 0.5f * cm, 256, 16, smem, vid, G); }
    }
}

DEV void run_phase(const Params& p, int ph, char* smem) {
    const int l = ph / PH_PER_LAYER, q = ph % PH_PER_LAYER;
    switch (q) {
        case 0: run_phase_q<0>(p, l, smem); break;
        case 1: run_phase_q<1>(p, l, smem); break;
        case 2: run_phase_q<2>(p, l, smem); break;
        case 3: run_phase_q<3>(p, l, smem); break;
        case 4: run_phase_q<4>(p, l, smem); break;
        case 5: run_phase_q<5>(p, l, smem); break;
        case 6: run_phase_q<6>(p, l, smem); break;
        case 7: run_phase_q<7>(p, l, smem); break;
        case 8: run_phase_q<8>(p, l, smem); break;
        case 9: run_phase_q<9>(p, l, smem); break;
        case 10: run_phase_q<10>(p, l, smem); break;
        case 11: run_phase_q<11>(p, l, smem); break;
        case 12: run_phase_q<12>(p, l, smem); break;
        case 13: run_phase_q<13>(p, l, smem); break;
        case 14: run_phase_q<14>(p, l, smem); break;
    }
}

template <int Q>
__global__ void __launch_bounds__(256, 2) phase_kernel(Params p, int l) {
    __shared__ __attribute__((aligned(16))) char smem[73728];
    run_phase_q<Q>(p, l, smem);
}

#if ONE_LAUNCH
#define XB_TMO      128
#define XB_XCNT(j)  (256  + 64 * (j))
#define XB_XSUB(j)  (1280 + 64 * (j))
#define XB_XGEN(j)  (2304 + 64 * (j))
#define XB_TOP      3328
#define XB_TOPGEN   3392
#define XB_SPIN_CAP (1u << 22)
DEV unsigned xb_ld(unsigned* q) { return __hip_atomic_load(q, __ATOMIC_RELAXED, __HIP_MEMORY_SCOPE_AGENT); }
DEV unsigned xb_add(unsigned* q, unsigned v) { return __hip_atomic_fetch_add(q, v, __ATOMIC_RELAXED, __HIP_MEMORY_SCOPE_AGENT); }
DEV unsigned xb_xcc_id() { return (unsigned)__builtin_amdgcn_s_getreg((3 << 11) | 20) & 0xFu; }
#define XB_SPIN(cond, bar) do { unsigned _sp = 0; while (cond) { __builtin_amdgcn_s_sleep(1); \
    if ((++_sp & 255u) == 0u) { if (xb_ld(&(bar)[XB_TMO])) break; if (_sp > XB_SPIN_CAP) { atomicAdd(&(bar)[XB_TMO], 1u); break; } } } } while (0)
DEV void xcd_census(unsigned* bar, unsigned x, unsigned& nloc, unsigned& nx) {
    const unsigned G = gridDim.x;
    unsigned sum, cnt, mine, sp = 0u;
    for (;;) {
        sum = 0u; cnt = 0u; mine = 0u;
#pragma unroll
        for (unsigned j = 0; j < 16; ++j) { const unsigned c = xb_ld(&bar[XB_XCNT(j)]); sum += c; cnt += (c > 0u) ? 1u : 0u; mine = (j == x) ? c : mine; }
        if (sum == G) break;
        __builtin_amdgcn_s_sleep(1);
        if ((++sp & 255u) == 0u) { if (xb_ld(&bar[XB_TMO])) break; if (sp > XB_SPIN_CAP) { atomicAdd(&bar[XB_TMO], 1u); break; } }
    }
    nloc = mine > 0u ? mine : 1u; nx = cnt > 0u ? cnt : 1u;
}
DEV void xcd_barrier(unsigned* bar, unsigned x, volatile unsigned* st, int tid) {
    asm volatile("s_waitcnt vmcnt(0)" ::: "memory");
    __syncthreads();
    if (tid == 0) {
        __builtin_amdgcn_s_waitcnt(0);
        unsigned nloc = st[0], nx = st[1];
        if (nloc == 0u) { xcd_census(bar, x, nloc, nx); st[0] = nloc; st[1] = nx; }
        const unsigned old = xb_add(&bar[XB_XSUB(x)], 1u);
        const unsigned gen = old / nloc;
        if (old + 1u == (gen + 1u) * nloc) {
            __builtin_amdgcn_fence(__ATOMIC_RELEASE, "agent");
            asm volatile("s_waitcnt vmcnt(0)" ::: "memory");
            const unsigned og = xb_add(&bar[XB_TOP], 1u);
            const unsigned tg = og / nx;
            if (og + 1u == (tg + 1u) * nx) xb_add(&bar[XB_TOPGEN], 1u);
            else XB_SPIN(xb_ld(&bar[XB_TOPGEN]) == tg, bar);
            __builtin_amdgcn_fence(__ATOMIC_ACQUIRE, "agent");
            xb_add(&bar[XB_XGEN(x)], 1u);
            asm volatile("s_waitcnt vmcnt(0)" ::: "memory");
        } else {
            XB_SPIN(xb_ld(&bar[XB_XGEN(x)]) == gen, bar);
            __builtin_amdgcn_fence(__ATOMIC_ACQUIRE, "agent");
            asm volatile("s_waitcnt vmcnt(0)" ::: "memory");
        }
    }
    __syncthreads();
}
__global__ void __launch_bounds__(512, 2) mega_kernel(Params p0, int ph_begin, int ph_end) {
    __shared__ __attribute__((aligned(16))) char smem[147456];
    __shared__ uint4 xb_words;
    unsigned* bar = (unsigned*)(p0.ws + OFF_BAR);
    const unsigned xcc = xb_xcc_id();
    if (threadIdx.x == 0) { xb_words = make_uint4(0u, 0u, 0u, 0u); (void)xb_add(&bar[XB_XCNT(xcc)], 1u); }
    __syncthreads();
    for (int ph = ph_begin; ph < ph_end; ++ph) {
        Params p = p0;
        int z = p0.z;
        asm volatile("" : "+s"(z));
        p.z = z;
        p.ws = p0.ws + z;
        p.out = p0.out + z;
        run_phase(p, ph, smem);
        if (ph + 1 < ph_end) {
            if (p0.z == 0x7fffffff) cg::this_grid().sync();
            xcd_barrier(bar, xcc, (volatile unsigned*)&xb_words, (int)threadIdx.x + z);
        }
    }
}
#endif

extern "C" void kernel_launch(void* const* d_in, const int* in_sizes, int n_in, void* d_out, int out_size, void* d_ws, size_t ws_size,
                              hipStream_t stream) {
    if (ws_size < WS_END) { fprintf(stderr, "workspace too small: %zu < %zu\n", ws_size, (size_t)WS_END); return; }
    Params p{};
    p.x = (const float*)d_in[0]; p.c = (const float*)d_in[1]; p.ctx = (const float*)d_in[2]; p.c_ctx = (const float*)d_in[3];
    p.ada_w = (const float*)d_in[4]; p.ada_b = (const float*)d_in[5]; p.norm_w = (const float*)d_in[6];
    p.ffn_w_in = (const float*)d_in[7]; p.ffn_w_out = (const float*)d_in[8]; p.mix_w_in = (const float*)d_in[9];
    p.ml_gate_b = (const float*)d_in[10]; p.ml_norm_w = (const float*)d_in[11]; p.na_qk_w = (const float*)d_in[12];
    p.na_rpb = (const float*)d_in[13]; p.gq_qk_w = (const float*)d_in[14]; p.w_br_ml = (const float*)d_in[15];
    p.w_br_na = (const float*)d_in[16]; p.w_br_gq = (const float*)d_in[17]; p.w_out = (const float*)d_in[18];
    p.out = (float*)d_out; p.ws = (char*)d_ws;
#ifdef NANFILL
    hipMemsetAsync(d_ws, 0xFF, WS_END, stream);
#endif
#if ONE_LAUNCH
    static int grid_blocks = 0;
    if (!grid_blocks) {
        int dev = 0, cus = 0, per_cu = 0;
        hipGetDevice(&dev);
        hipDeviceGetAttribute(&cus, hipDeviceAttributeMultiprocessorCount, dev);
        hipOccupancyMaxActiveBlocksPerMultiprocessor(&per_cu, mega_kernel, 512, 0);
        per_cu = 1;
        grid_blocks = cus * per_cu;
    }
    hipMemsetAsync((char*)d_ws + OFF_BAR, 0, 3456 * 4, stream);
    int pb = 0, pe = N_PHASES;
    void* args[] = {&p, &pb, &pe};
#ifdef SPLIT_TEST
    (void)args;
    for (int ph = 0; ph < N_PHASES; ++ph) mega_kernel<<<grid_blocks, 256, 0, stream>>>(p, ph, ph + 1);
#else
    hipError_t e = hipLaunchCooperativeKernel((void*)mega_kernel, dim3(grid_blocks), dim3(512), args, 0, stream);
    if (e != hipSuccess) fprintf(stderr, "cooperative launch failed: %s (grid %d)\n", hipGetErrorString(e), grid_blocks);
#endif
#else
    for (int l = 0; l < 2; ++l) {
#define LP(Q) phase_kernel<Q><<<512, 256, 0, stream>>>(p, l)
#ifdef DBG
        const bool dl = (l == DBG_LAYER);
        if (dl) hipMemsetAsync((char*)d_ws + OFF_DBG, 0, 256, stream);
        LP(0);
        if (dl) dbg_save<<<16, 256, 0, stream>>>(p, 0);
        LP(1); LP(2); LP(3);
        if (dl) dbg_ffn<<<16, 256, 0, stream>>>(p, l, 0, 0, 8);
        LP(4); LP(5);
        if (dl) dbg_pchk<<<16, 256, 0, stream>>>(p, l);
        LP(6);
        if (dl) dbg_copy<<<2048, 256, 0, stream>>>(p);
        LP(7); LP(8); LP(9);
        if (dl) {
            dbg_mlstm<<<64, 64, 0, stream>>>(p, l);
            dbg_cmp<<<(NB * 4 * UT + 7424 * 64 + 255) / 256, 256, 0, stream>>>(p, l);
            dbg_save<<<16, 256, 0, stream>>>(p, 1);
        }
        LP(10); LP(11);
        if (dl) { dbg_mix<<<16, 256, 0, stream>>>(p, l, 1); dbg_save<<<16, 256, 0, stream>>>(p, 2); }
        LP(12); LP(13); LP(14);
        if (dl) dbg_ffn<<<16, 256, 0, stream>>>(p, l, 1, 2, 11);
#else
        LP(0); LP(1); LP(2); LP(3); LP(4); LP(5); LP(6); LP(7); LP(8); LP(9); LP(10); LP(11); LP(12); LP(13); LP(14);
#endif
#undef LP
    }
#ifdef DBG
    dbg_fin<<<1, 1, 0, stream>>>(p);
#endif
#endif
}
```

```cpp
#include <hip/hip_runtime.h>
#include <hip/hip_cooperative_groups.h>
#include <stdint.h>
#include <cstdio>
namespace cg = cooperative_groups;

#ifndef ONE_LAUNCH
#define ONE_LAUNCH 1
#endif

#define VTID ((int)((threadIdx.x + p.z) & 255))
typedef unsigned short u16;
typedef __attribute__((ext_vector_type(8))) short bf16x8;
typedef __attribute__((ext_vector_type(4))) float f32x4;
#define DEV __device__ __forceinline__

constexpr int D = 1024, NB = 8, SEQ = 4096, CTXL = 256;
constexpr int NL = NB * SEQ, NCX = NB * CTXL, MTOT = NL + NCX;
constexpr int DFF = 2816, PW = 2816, UT = SEQ + CTXL, NCH = UT / 64;
constexpr int NIN = 5904;
constexpr int PC_MLQ = 0, PC_NAQ = 256, PC_GQQ = 640, PC_MLO = 1024, PC_MLK = 1280, PC_NAK = 1536, PC_GQK = 1920,
              PC_MLV = 2048, PC_NAV = 2304, PC_GQV = 2688, PC_Y = 1024;
constexpr int TC_MLK = 0, TC_MLV = 256, TC_NAV = 512, TC_GQV = 896, TW = 1024;
constexpr int DBG_MLO = PC_MLQ, DBG_NAO = PC_NAQ;
constexpr int SCH = 4160;
constexpr int NSCAN = 64;

constexpr size_t al256(size_t x) { return (x + 255) & ~(size_t)255; }
constexpr size_t OFF_MODS = 0;
constexpr size_t OFF_ROPE = al256(OFF_MODS + (size_t)9 * 9216 * 4);
constexpr size_t OFF_G    = al256(OFF_ROPE + (size_t)4096 * 64 * 4);
constexpr size_t OFF_BC   = al256(OFF_G + (size_t)MTOT * 16 * 4);
constexpr size_t OFF_IG   = al256(OFF_BC + (size_t)NSCAN * UT * 4);
constexpr size_t OFF_AE   = al256(OFF_IG + (size_t)NSCAN * UT * 4);
constexpr size_t OFF_MS   = al256(OFF_AE + (size_t)NSCAN * UT * 4);
constexpr size_t OFF_DEC  = al256(OFF_MS + (size_t)NSCAN * NCH * 4);
constexpr size_t OFF_XC   = al256(OFF_DEC + (size_t)NSCAN * NCH * 4);
constexpr size_t OFF_H    = al256(OFF_XC + (size_t)NCX * D * 4);
constexpr size_t OFF_P    = al256(OFF_H + (size_t)MTOT * D * 2);
constexpr size_t OFF_T    = al256(OFF_P + (size_t)MTOT * PW * 2);
constexpr size_t OFF_S    = al256(OFF_T + (size_t)NB * TW * UT * 2);
constexpr size_t OFF_W    = al256(OFF_S + (size_t)NSCAN * NCH * SCH * 4);
constexpr size_t WE_IN0 = 0, WE_IN1 = WE_IN0 + (size_t)5632 * 1024, WE_OUT0 = WE_IN1 + (size_t)5632 * 1024,
                 WE_OUT1 = WE_OUT0 + (size_t)1024 * 2816, WE_MIX = WE_OUT1 + (size_t)1024 * 2816,
                 WE_BR = WE_MIX + (size_t)6016 * 1024, WE_O = WE_BR + (size_t)1024 * 1024, WE_END = WE_O + (size_t)1024 * 1024;
constexpr size_t OFF_BAR = al256(OFF_W + WE_END * 2);
constexpr size_t OFF_PART = al256(OFF_BAR + 3456 * 4);
constexpr size_t WS_END = OFF_PART + (size_t)4 * NCX * D * 4;
static_assert(WS_END < (size_t)536000000, "workspace too large");

struct Params {
    const float *x, *c, *ctx, *c_ctx, *ada_w, *ada_b, *norm_w, *ffn_w_in, *ffn_w_out, *mix_w_in, *ml_gate_b, *ml_norm_w,
        *na_qk_w, *na_rpb, *gq_qk_w, *w_br_ml, *w_br_na, *w_br_gq, *w_out;
    float* out;
    char* ws;
    int z, pad;
};

DEV uint32_t pk2(float lo, float hi) { uint32_t r; asm("v_cvt_pk_bf16_f32 %0, %1, %2" : "=v"(r) : "v"(lo), "v"(hi)); return r; }
DEV float bflo(uint32_t w) { return __uint_as_float(w << 16); }
DEV float bfhi(uint32_t w) { return __uint_as_float(w & 0xffff0000u); }
DEV f32x4 mfma16(bf16x8 a, bf16x8 b, f32x4 c) { return __builtin_amdgcn_mfma_f32_16x16x32_bf16(a, b, c, 0, 0, 0); }
typedef unsigned u32x4 __attribute__((ext_vector_type(4)));
DEV u32x4 gld16(const void* q) { u32x4 r; asm volatile("global_load_dwordx4 %0, %1, off" : "=v"(r) : "v"(q) : "memory"); return r; }
DEV u32x4 gld16s(const void* sbase, unsigned voff) { u32x4 r; asm volatile("global_load_dwordx4 %0, %1, %2" : "=v"(r) : "v"(voff), "s"(sbase) : "memory"); return r; }
DEV void glds16(const void* sbase, unsigned voff, unsigned ldsaddr) {
    asm volatile("s_mov_b32 m0, %2\n\ts_nop 0\n\tglobal_load_lds_dwordx4 %0, %1" :: "v"(voff), "s"(sbase), "s"(ldsaddr) : "memory", "m0");
}
#define VM_WAIT0() asm volatile("s_waitcnt vmcnt(0)" ::: "memory")
union Frag { bf16x8 v; uint4 q; uint32_t u[4]; uint2 d[2]; };
DEV int cu_of(int c, int dir) { return c < 4 ? 64 + (dir ? 3 - c : c) : (dir ? 63 - (c - 4) : (c - 4)); }
DEV int rowof(int b, int u) { return u < SEQ ? b * SEQ + u : NL + b * CTXL + (u - SEQ); }
DEV float fexp2(float x) { return __builtin_amdgcn_exp2f(x); }
DEV float fexp(float x) { return __builtin_amdgcn_exp2f(x * 1.4426950408889634f); }
DEV float sigmoidf_(float x) { return 1.f / (1.f + fexp(-x)); }
DEV float xq_max(float v) {
    auto r = __builtin_amdgcn_permlane16_swap(__float_as_uint(v), __float_as_uint(v), false, false);
    const float m = fmaxf(__uint_as_float(r[0]), __uint_as_float(r[1]));
    auto q = __builtin_amdgcn_permlane32_swap(__float_as_uint(m), __float_as_uint(m), false, false);
    return fmaxf(__uint_as_float(q[0]), __uint_as_float(q[1]));
}
DEV float xq_sum(float v) {
    auto r = __builtin_amdgcn_permlane16_swap(__float_as_uint(v), __float_as_uint(v), false, false);
    const float m = __uint_as_float(r[0]) + __uint_as_float(r[1]);
    auto q = __builtin_amdgcn_permlane32_swap(__float_as_uint(m), __float_as_uint(m), false, false);
    return __uint_as_float(q[0]) + __uint_as_float(q[1]);
}
DEV float wave_sum(float v) {
#pragma unroll
    for (int o = 1; o < 64; o <<= 1) v += __shfl_xor(v, o);
    return v;
}
DEV float wave_max(float v) {
#pragma unroll
    for (int o = 1; o < 64; o <<= 1) v = fmaxf(v, __shfl_xor(v, o));
    return v;
}

#define WSP(T_, off) ((T_*)(p.ws + (off)))
DEV float m_scan(const Params& p, int sc, int c_end) {
    const float* BT = WSP(float, OFF_MS) + sc * NCH;
    const float* MX = WSP(float, OFF_DEC) + sc * NCH;
    const int lane = VTID & 63;
    const float bt0 = BT[lane], mx0 = MX[lane], bt1 = BT[64 + (lane & 3)], mx1 = MX[64 + (lane & 3)];
    float m = 0.f;
    for (int c = 0; c < c_end; ++c) {
        const float b = c < 64 ? __shfl(bt0, c) : __shfl(bt1, c - 64);
        const float x = c < 64 ? __shfl(mx0, c) : __shfl(mx1, c - 64);
        m = fmaxf(b + m, x);
    }
    return m;
}

template <int TN>
DEV void gemm_accum(f32x4 (&acc)[4][TN], const u16* __restrict__ A, int lda, const u16* __restrict__ B, int ldb, int K, char* smem, int tid) {
    constexpr int BROWS = TN * 32;
    constexpr int STAGE = (128 + BROWS) * 144;
    constexpr int NBCH = BROWS / 32;
    const int lane = tid & 63, wave = tid >> 6;
    const int wm = wave >> 1, wn = wave & 1, fr = lane & 15, fq = lane >> 4;
    const int lrow = tid >> 3, lc8 = tid & 7;
    const u16* ga = A + (size_t)lrow * lda + lc8 * 8;
    const u16* gb = B + (size_t)lrow * ldb + lc8 * 8;
    u32x4 ra[4], rb[NBCH];
    const int nk = K >> 6;
#pragma unroll
    for (int i = 0; i < 4; ++i) ra[i] = gld16(ga + (size_t)(32 * i) * lda);
#pragma unroll
    for (int i = 0; i < NBCH; ++i) rb[i] = gld16(gb + (size_t)(32 * i) * ldb);
    char* sw = smem + lrow * 144 + lc8 * 16;
    VM_WAIT0();
#pragma unroll
    for (int i = 0; i < 4; ++i) *(u32x4*)(sw + i * 32 * 144) = ra[i];
#pragma unroll
    for (int i = 0; i < NBCH; ++i) *(u32x4*)(sw + 128 * 144 + i * 32 * 144) = rb[i];
    __syncthreads();
    const char* sa_r = smem + (wm * 64 + fr) * 144 + fq * 16;
    const char* sb_r = smem + 128 * 144 + (wn * TN * 16 + fr) * 144 + fq * 16;
    for (int kt = 0; kt < nk; ++kt) {
        const int cur = kt & 1;
        const int k0 = (kt + 1 < nk ? kt + 1 : kt) * 64;
#pragma unroll
        for (int i = 0; i < 4; ++i) ra[i] = gld16(ga + (size_t)(32 * i) * lda + k0);
#pragma unroll
        for (int i = 0; i < NBCH; ++i) rb[i] = gld16(gb + (size_t)(32 * i) * ldb + k0);
        __builtin_amdgcn_sched_barrier(0);
#pragma unroll
        for (int ks = 0; ks < 2; ++ks) {
            bf16x8 af[4], bfr[TN];
#pragma unroll
            for (int mt = 0; mt < 4; ++mt) af[mt] = *(const bf16x8*)(sa_r + cur * STAGE + mt * 16 * 144 + ks * 64);
#pragma unroll
            for (int nt = 0; nt < TN; ++nt) bfr[nt] = *(const bf16x8*)(sb_r + cur * STAGE + nt * 16 * 144 + ks * 64);
#pragma unroll
            for (int mt = 0; mt < 4; ++mt)
#pragma unroll
                for (int nt = 0; nt < TN; ++nt) acc[mt][nt] = mfma16(af[mt], bfr[nt], acc[mt][nt]);
        }
        __builtin_amdgcn_sched_barrier(0);
        VM_WAIT0();
        {
            char* sw2 = sw + (cur ^ 1) * STAGE;
#pragma unroll
            for (int i = 0; i < 4; ++i) *(u32x4*)(sw2 + i * 32 * 144) = ra[i];
#pragma unroll
            for (int i = 0; i < NBCH; ++i) *(u32x4*)(sw2 + 128 * 144 + i * 32 * 144) = rb[i];
        }
        __syncthreads();
    }
}

template <int TN>
DEV void zero_acc(f32x4 (&acc)[4][TN]) {
#pragma unroll
    for (int i = 0; i < 4; ++i)
#pragma unroll
        for (int j = 0; j < TN; ++j) acc[i][j] = f32x4{0.f, 0.f, 0.f, 0.f};
}

DEV void tile_decode(int t, int ntn, int& mt, int& nt) {
    const int per = 8 * ntn;
    const int gi = t / per, rem = t - gi * per;
    nt = rem >> 3;
    mt = gi * 8 + (rem & 7);
}


template <bool SWAP = false>
DEV void gemm8_accum(f32x4 (&acc)[8][4], const u16* __restrict__ A, int lda, const u16* __restrict__ B, int ldb, int K, char* smem, int tid) {
    constexpr int STAGE = 65536;
    const int lane = tid & 63, wave = tid >> 6;
    const int wm = wave >> 2, wn = wave & 3, fr = lane & 15, fq = lane >> 4;
    const int lr = lane >> 3, pos = lane & 7;
    const int ce = pos ^ (lr >> 1), co = pos ^ (4 | (lr >> 1));
    const unsigned ra_ = (unsigned)((wave * 32 + lr) * lda) * 2u, rb_ = (unsigned)((wave * 32 + lr) * ldb) * 2u;
    const unsigned voa_e = ra_ + ce * 16, voa_o = ra_ + co * 16, vob_e = rb_ + ce * 16, vob_o = rb_ + co * 16;
    const int nk = K >> 6;
    const unsigned ldsw = __builtin_amdgcn_readfirstlane((unsigned)(size_t)(__attribute__((address_space(3))) char*)smem + wave * 4096);
#define G8_ISSUE(STG, K0) do { \
        _Pragma("unroll") for (int i = 0; i < 4; ++i) { \
            glds16(A + (size_t)(8 * i) * lda + (K0), (i & 1) ? voa_o : voa_e, ldsw + (STG) * STAGE + i * 1024); \
            glds16(B + (size_t)(8 * i) * ldb + (K0), (i & 1) ? vob_o : vob_e, ldsw + (STG) * STAGE + 32768 + i * 1024); \
        } } while (0)
    G8_ISSUE(0, 0);
    VM_WAIT0();
    __syncthreads();
    const int s3 = (fr >> 1) & 7;
    const int oa_base = (wm * 128 + fr) * 128 + ((fq ^ s3) * 16);
    const int ob_base = 32768 + (wn * 64 + fr) * 128 + ((fq ^ s3) * 16);
    for (int kt = 0; kt < nk; ++kt) {
        const int cur = kt & 1;
        const int k0 = (kt + 1 < nk ? kt + 1 : kt) * 64;
        G8_ISSUE(cur ^ 1, k0);
        int o_a = cur * STAGE + oa_base, o_b = cur * STAGE + ob_base;
        asm volatile("" : "+v"(o_a), "+v"(o_b));
#pragma unroll
        for (int ks = 0; ks < 2; ++ks) {
            const char* sa_c = smem + (ks ? (o_a ^ 64) : o_a);
            const char* sb_c = smem + (ks ? (o_b ^ 64) : o_b);
            bf16x8 bfr[4], af[8];
#pragma unroll
            for (int nt = 0; nt < 4; ++nt) bfr[nt] = *(const bf16x8*)(sb_c + nt * 2048);
#pragma unroll
            for (int mt = 0; mt < 8; ++mt) af[mt] = *(const bf16x8*)(sa_c + mt * 2048);
#pragma unroll
            for (int mt = 0; mt < 8; ++mt)
#pragma unroll
                for (int nt = 0; nt < 4; ++nt) acc[mt][nt] = SWAP ? mfma16(bfr[nt], af[mt], acc[mt][nt]) : mfma16(af[mt], bfr[nt], acc[mt][nt]);
            __builtin_amdgcn_sched_group_barrier(0x100, 7, 0);
#pragma unroll
            for (int i = 0; i < 5; ++i) { __builtin_amdgcn_sched_group_barrier(0x008, 4, 0); __builtin_amdgcn_sched_group_barrier(0x100, 1, 0); }
#pragma unroll
            for (int i = 0; i < 3; ++i) __builtin_amdgcn_sched_group_barrier(0x008, 4, 0);
        }
        VM_WAIT0();
        __syncthreads();
    }
#undef G8_ISSUE
}
DEV void zero_acc8(f32x4 (&acc)[8][4]) {
#pragma unroll
    for (int i = 0; i < 8; ++i)
#pragma unroll
        for (int j = 0; j < 4; ++j) acc[i][j] = f32x4{0.f, 0.f, 0.f, 0.f};
}
DEV void tile_decode8(int t, int ntn, int& mt, int& nt) {
    const int per = 4 * ntn;
    const int gi = t / per, rem = t - gi * per;
    nt = rem >> 2;
    mt = gi * 4 + (rem & 3);
}

DEV void ph_ffn_in8(const Params& p, int which, int mtiles8, char* smem, int rvid, int RG, int tid) {
    const u16* H = WSP(u16, OFF_H);
    const u16* Wt = WSP(u16, OFF_W) + (which ? WE_IN1 : WE_IN0);
    u16* ACT = WSP(u16, OFF_P);
    const int lane = tid & 63, wave = tid >> 6, wm = wave >> 2, wn = wave & 3, fr = lane & 15, fq = lane >> 4;
    const int total = mtiles8 * 22;
    for (int t = rvid; t < total; t += RG) {
        int mt_, nt_;
        tile_decode8(t, 22, mt_, nt_);
        const int m0 = mt_ * 256, n0 = nt_ * 256;
        f32x4 acc[8][4];
        zero_acc8(acc);
        gemm8_accum(acc, H + (size_t)m0 * D, D, Wt + (size_t)n0 * D, D, D, smem, tid);
#pragma unroll
        for (int mt = 0; mt < 8; ++mt)
#pragma unroll
            for (int pp = 0; pp < 2; ++pp)
#pragma unroll
                for (int r = 0; r < 4; ++r) {
                    const int row = m0 + wm * 128 + mt * 16 + fq * 4 + r;
                    const int hid = (n0 >> 1) + wn * 32 + pp * 16 + fr;
                    const float g = acc[mt][2 * pp][r], u = acc[mt][2 * pp + 1][r];
                    const float v = g * sigmoidf_(g) * u;
                    ACT[(size_t)row * DFF + hid] = (u16)(pk2(v, 0.f) & 0xffff);
                }
    }
}
DEV void ph_resid8(const Params& p, const u16* A, int lda, const u16* Wt, int K, int modidx, float coef, char* smem, int rvid, int RG, int tid, const float* xsrc) {
    const float* mods = WSP(float, OFF_MODS);
    const int lane = tid & 63, wave = tid >> 6, wm = wave >> 2, wn = wave & 3, fr = lane & 15, fq = lane >> 4;
    const int total = 128 * 4;
    for (int t = rvid; t < total; t += RG) {
        int mt_, nt_;
        tile_decode8(t, 4, mt_, nt_);
        const int m0 = mt_ * 256, n0 = nt_ * 256;
        f32x4 acc[8][4];
        zero_acc8(acc);
        gemm8_accum<true>(acc, A + (size_t)m0 * lda, lda, Wt + (size_t)n0 * K, K, K, smem, tid);
        const float* gp = mods + (m0 >> 12) * 9216 + modidx * 1024;
#pragma unroll
        for (int nt = 0; nt < 4; ++nt) {
            const int col = n0 + wn * 64 + nt * 16 + fq * 4;
            float4 g4 = *(const float4*)(gp + col);
            g4.x *= coef; g4.y *= coef; g4.z *= coef; g4.w *= coef;
#pragma unroll
            for (int mt = 0; mt < 8; ++mt) {
                const size_t off = (size_t)(m0 + wm * 128 + mt * 16 + fr) * D + col;
                float4 xv = *(const float4*)(xsrc + off);
                xv.x += g4.x * acc[mt][nt][0];
                xv.y += g4.y * acc[mt][nt][1];
                xv.z += g4.z * acc[mt][nt][2];
                xv.w += g4.w * acc[mt][nt][3];
                *(float4*)(p.out + off) = xv;
            }
        }
    }
}
DEV void ph_pgemm8(const Params& p, int lsel, char* smem, int rvid, int RG, int tid) {
    const u16* H = WSP(u16, OFF_H);
    const u16* Wt = WSP(u16, OFF_W) + WE_MIX;
    u16* P = WSP(u16, OFF_P);
    u16* T = WSP(u16, OFF_T);
    float* Gt = WSP(float, OFF_G);
    const int lane = tid & 63, wave = tid >> 6, wm = wave >> 2, wn = wave & 3, fr = lane & 15, fq = lane >> 4;
    const int total = 128 * 12;
    for (int t = rvid; t < total; t += RG) {
        int mt_, nt_;
        tile_decode8(t, 12, mt_, nt_);
        const int m0 = mt_ * 256, n0 = nt_ * 256;
        f32x4 acc[8][4];
        zero_acc8(acc);
        const int cb = n0 + wn * 64;
        const int j = cb >> 7;
        const bool swap_tile = (nt_ <= 4) || (nt_ == 6) || (nt_ == 7);
        if (swap_tile) {
            gemm8_accum<true>(acc, H + (size_t)m0 * D, D, Wt + (size_t)n0 * D, D, D, smem, tid);
            const bool normed = (cb >= 256 && cb < 1024) || (cb >= 1536);
            const bool isq = cb < 1024;
            const bool isgq = (cb >= 640 && cb < 1024) || (cb >= 1920);
            const float* wv = (isgq ? p.gq_qk_w : p.na_qk_w) + (lsel * 2 + (isq ? 0 : 1)) * 64;
            const float scl = isq ? 0.125f : 1.f;
            float4 w4[4];
#pragma unroll
            for (int nt = 0; nt < 4; ++nt) w4[nt] = normed ? *(const float4*)(wv + nt * 16 + fq * 4) : float4{1.f, 1.f, 1.f, 1.f};
            const float* rope = WSP(float, OFF_ROPE);
#pragma unroll
            for (int mt = 0; mt < 8; ++mt) {
                const int row = m0 + wm * 128 + mt * 16 + fr;
                if (normed) {
                    float ss = 0.f;
#pragma unroll
                    for (int nt = 0; nt < 4; ++nt)
#pragma unroll
                        for (int r = 0; r < 4; ++r) ss += acc[mt][nt][r] * acc[mt][nt][r];
                    ss = xq_sum(ss);
                    const float rstd = rsqrtf(ss * (1.f / 64.f) + 1e-6f) * scl;
#pragma unroll
                    for (int nt = 0; nt < 4; ++nt) {
                        acc[mt][nt][0] *= rstd * w4[nt].x; acc[mt][nt][1] *= rstd * w4[nt].y;
                        acc[mt][nt][2] *= rstd * w4[nt].z; acc[mt][nt][3] *= rstd * w4[nt].w;
                    }
                    if (isgq) {
                        const int tok = row & 4095;
#pragma unroll
                        for (int nt = 0; nt < 2; ++nt) {
                            const float* rp = rope + ((size_t)tok * 32 + nt * 16 + fq * 4) * 2;
                            const float4 cs01 = *(const float4*)rp, cs23 = *(const float4*)(rp + 4);
                            const float cv[4] = {cs01.x, cs01.z, cs23.x, cs23.z}, sv[4] = {cs01.y, cs01.w, cs23.y, cs23.w};
#pragma unroll
                            for (int r = 0; r < 4; ++r) {
                                const float x1 = acc[mt][nt][r], x2 = acc[mt][nt + 2][r];
                                acc[mt][nt][r] = x1 * cv[r] - x2 * sv[r];
                                acc[mt][nt + 2][r] = x1 * sv[r] + x2 * cv[r];
                            }
                        }
                    }
                }
#pragma unroll
                for (int nt = 0; nt < 4; ++nt)
                    *(uint2*)(P + (size_t)row * PW + cb + nt * 16 + fq * 4) = uint2{pk2(acc[mt][nt][0], acc[mt][nt][1]), pk2(acc[mt][nt][2], acc[mt][nt][3])};
            }
            continue;
        }
        gemm8_accum(acc, H + (size_t)m0 * D, D, Wt + (size_t)n0 * D, D, D, smem, tid);
        if (j >= 22) {
            if (cb == 2816) {
#pragma unroll
                for (int mt = 0; mt < 8; ++mt)
#pragma unroll
                    for (int r = 0; r < 4; ++r) {
                        const int row = m0 + wm * 128 + mt * 16 + fq * 4 + r;
                        Gt[(size_t)row * 16 + fr] = acc[mt][0][r];
                    }
            }
            continue;
        }
        const bool rowmajor = j < 16;
        const bool transp = (j == 10) || (j == 11) || (j >= 16);
        if (rowmajor) {
#pragma unroll
            for (int mt = 0; mt < 8; ++mt)
#pragma unroll
                for (int nt = 0; nt < 4; ++nt)
#pragma unroll
                    for (int r = 0; r < 4; ++r) {
                        const int row = m0 + wm * 128 + mt * 16 + fq * 4 + r;
                        P[(size_t)row * PW + cb + nt * 16 + fr] = (u16)(pk2(acc[mt][nt][r], 0.f) & 0xffff);
                    }
        }
        if (transp) {
            const int tcb = (j >= 16) ? (cb - 1792) : (cb - 1280);
            const int b = m0 >> 12, u0 = m0 & 4095;
#pragma unroll
            for (int mt = 0; mt < 8; ++mt)
#pragma unroll
                for (int nt = 0; nt < 4; ++nt) {
                    const int tc = tcb + nt * 16 + fr;
                    const int u = u0 + wm * 128 + mt * 16 + fq * 4;
                    *(uint2*)(T + ((size_t)(b * TW + tc)) * UT + u) = uint2{pk2(acc[mt][nt][0], acc[mt][nt][1]), pk2(acc[mt][nt][2], acc[mt][nt][3])};
                }
        }
    }
}

DEV int map_col(int type, int n) {
    if (type == 0) return n;
    if (type == 1) {
        const int jb = n >> 5, r = n & 31;
        return r < 16 ? jb * 16 + r : DFF + jb * 16 + (r - 16);
    }
    if (n < 256) return 1552 + n;
    if (n < 640) return 2064 + (n - 256);
    if (n < 1024) return 2448 + (n - 640);
    if (n < 1280) return 1808 + (n - 1024);
    if (n < 1536) return (n - 1280);
    if (n < 1920) return 528 + (n - 1536);
    if (n < 2048) return 1296 + (n - 1920);
    if (n < 2304) return 256 + (n - 2048);
    if (n < 2688) return 912 + (n - 2304);
    if (n < 2816) return 1424 + (n - 2688);
    if (n < 2832) return 512 + (n - 2816);
    if (n < 2944) return -1;
    return 2832 + (n - 2944);
}

DEV void conv_tile(const float* __restrict__ src, int ld_src, int type, u16* __restrict__ dst, int ld_dst, int k_off, int kt, int ntile, char* smem, int tid) {
    float* lds = (float*)smem;
    const int k0 = kt * 64, n0 = ntile * 64;
    {
        const int r = tid >> 6, c = tid & 63;
        const int col = map_col(type, n0 + c);
#pragma unroll
        for (int i = 0; i < 16; ++i) {
            const int k = r + 4 * i;
            float v = 0.f;
            if (col >= 0) v = src[(size_t)(k0 + k) * ld_src + col];
            lds[k * 65 + c] = v;
        }
    }
    __syncthreads();
    {
        const int n = tid >> 2, kq = tid & 3;
        uint32_t w[8];
#pragma unroll
        for (int j = 0; j < 8; ++j) w[j] = pk2(lds[(kq * 16 + 2 * j) * 65 + n], lds[(kq * 16 + 2 * j + 1) * 65 + n]);
        u16* d = dst + (size_t)(n0 + n) * ld_dst + k_off + k0 + kq * 16;
        *(uint4*)d = uint4{w[0], w[1], w[2], w[3]};
        *(uint4*)(d + 8) = uint4{w[4], w[5], w[6], w[7]};
    }
    __syncthreads();
}

DEV void ph_prep(const Params& p, int l, char* smem, int bid, int G) {
    u16* W = WSP(u16, OFF_W);
    const int tid = VTID;
    constexpr int N_CONV = 6240, N_MODS = 288;
    for (int it = bid; it < N_CONV + N_MODS; it += G) {
        if (it < N_CONV) {
            int r = it;
            if (r < 2816) {
                const int which = r / 1408; r -= which * 1408;
                conv_tile(p.ffn_w_in + (size_t)(l * 2 + which) * 1024 * 5632, 5632, 1, W + (which ? WE_IN1 : WE_IN0), 1024, 0, r / 88, r % 88, smem, tid);
                continue;
            }
            r -= 2816;
            if (r < 1408) {
                const int which = r / 704; r -= which * 704;
                conv_tile(p.ffn_w_out + (size_t)(l * 2 + which) * 2816 * 1024, 1024, 0, W + (which ? WE_OUT1 : WE_OUT0), 2816, 0, r / 16, r % 16, smem, tid);
                continue;
            }
            r -= 1408;
            if (r < 1504) {
                conv_tile(p.mix_w_in + (size_t)l * 1024 * NIN, NIN, 2, W + WE_MIX, 1024, 0, r / 94, r % 94, smem, tid);
                continue;
            }
            r -= 1504;
            if (r < 64) { conv_tile(p.w_br_ml + (size_t)l * 256 * 1024, 1024, 0, W + WE_BR, 1024, 0, r / 16, r % 16, smem, tid); continue; }
            r -= 64;
            if (r < 96) { conv_tile(p.w_br_na + (size_t)l * 384 * 1024, 1024, 0, W + WE_BR, 1024, 256, r / 16, r % 16, smem, tid); continue; }
            r -= 96;
            if (r < 96) { conv_tile(p.w_br_gq + (size_t)l * 384 * 1024, 1024, 0, W + WE_BR, 1024, 640, r / 16, r % 16, smem, tid); continue; }
            r -= 96;
            conv_tile(p.w_out + (size_t)l * 1024 * 1024, 1024, 0, W + WE_O, 1024, 0, r / 16, r % 16, smem, tid);
        } else {
            const int cb = it - N_CONV;
            float* s = (float*)smem;
            float* red = s + 9 * 1024;
            for (int i = tid; i < 9 * 1024; i += 256) {
                const int b = i >> 10, k = i & 1023;
                const float v = b < 8 ? p.c[b * 1024 + k] : p.c_ctx[k];
                s[i] = v * sigmoidf_(v);
            }
            __syncthreads();
            const int kg = tid >> 5, c = tid & 31, col = cb * 32 + c;
            float a[9];
#pragma unroll
            for (int b = 0; b < 9; ++b) a[b] = 0.f;
            const float* wp = p.ada_w + (size_t)l * 1024 * 9216 + (size_t)(kg * 128) * 9216 + col;
#pragma unroll 16
            for (int k = 0; k < 128; ++k) {
                const float w = wp[(size_t)k * 9216];
#pragma unroll
                for (int b = 0; b < 9; ++b) a[b] += s[b * 1024 + kg * 128 + k] * w;
            }
#pragma unroll
            for (int b = 0; b < 9; ++b) red[(kg * 9 + b) * 32 + c] = a[b];
            __syncthreads();
            for (int i = tid; i < 288; i += 256) {
                const int b = i >> 5, cc = i & 31;
                float v = p.ada_b[l * 9216 + cb * 32 + cc];
#pragma unroll
                for (int g = 0; g < 8; ++g) v += red[(g * 9 + b) * 32 + cc];
                WSP(float, OFF_MODS)[b * 9216 + cb * 32 + cc] = v;
            }
            __syncthreads();
        }
    }
    if (l == 0) {
        const size_t gt = (size_t)bid * 256 + tid, gs = (size_t)G * 256;
        const float4* cs = (const float4*)p.ctx; float4* cd = WSP(float4, OFF_XC);
        for (size_t i = gt; i < (size_t)NCX * D / 4; i += gs) cd[i] = cs[i];
        float* rope = WSP(float, OFF_ROPE);
        for (size_t i = gt; i < (size_t)4096 * 32; i += gs) {
            const int t = (int)(i >> 5), f = (int)(i & 31);
            const float pos = (float)((f < 16) ? (t >> 6) : (t & 63));
            const float inv = powf(10000.f, -(float)(f & 15) / 16.f);
            float sn, cs_;
            sincosf(pos * inv, &sn, &cs_);
            rope[i * 2] = cs_;
            rope[i * 2 + 1] = sn;
        }
    }
}

#define KIDX(j) (lane * 8 + ((j) & 1) * 4 + ((j) >> 1) * 512)
DEV void ph_mod(const Params& p, int l, int sub, int nrows, int bid, int G) {
    const bool first = (l == 0 && sub == 0);
    const int lane = VTID & 63, gw = bid * 4 + (VTID >> 6), NW = G * 4;
    const float* nw = p.norm_w + (size_t)(l * 3 + sub) * 1024;
    const float* mods = WSP(float, OFF_MODS);
    u16* H = WSP(u16, OFF_H);
#pragma unroll 2
    for (int r = gw; r < nrows; r += NW) {
        const float* xr = r < NL ? (first ? p.x : p.out) + (size_t)r * D : (first ? p.ctx : WSP(float, OFF_XC)) + (size_t)(r - NL) * D;
        const int b9 = r < NL ? (r >> 12) : 8;
        const float* sh = mods + b9 * 9216 + (3 * sub) * 1024;
        const float* sc = sh + 1024;
        float4 v[4];
        float ss = 0.f;
        const bool fold = (r >= NL) && !first;
#pragma unroll
        for (int j = 0; j < 4; ++j) {
            v[j] = *(const float4*)(xr + KIDX(j));
            if (fold) {
#pragma unroll
                for (int ks = 0; ks < 4; ++ks) {
                    const float4 q4 = *(const float4*)(WSP(float, OFF_PART) + ((size_t)ks * NCX + (r - NL)) * D + KIDX(j));
                    v[j].x += q4.x; v[j].y += q4.y; v[j].z += q4.z; v[j].w += q4.w;
                }
                *(float4*)(WSP(float, OFF_XC) + (size_t)(r - NL) * D + KIDX(j)) = v[j];
            }
            ss += v[j].x * v[j].x + v[j].y * v[j].y + v[j].z * v[j].z + v[j].w * v[j].w;
        }
        ss = wave_sum(ss);
        const float rstd = rsqrtf(ss * (1.f / 1024.f) + 1e-6f);
        uint2 hp[4];
#pragma unroll
        for (int j = 0; j < 4; ++j) {
            const int k = KIDX(j);
            const float4 w = *(const float4*)(nw + k), s1 = *(const float4*)(sc + k), s0 = *(const float4*)(sh + k);
            const float y0 = v[j].x * rstd * w.x * (1.f + s1.x) + s0.x;
            const float y1 = v[j].y * rstd * w.y * (1.f + s1.y) + s0.y;
            const float y2 = v[j].z * rstd * w.z * (1.f + s1.z) + s0.z;
            const float y3 = v[j].w * rstd * w.w * (1.f + s1.w) + s0.w;
            hp[j] = uint2{pk2(y0, y1), pk2(y2, y3)};
        }
        *(uint4*)(H + (size_t)r * D + KIDX(0)) = uint4{hp[0].x, hp[0].y, hp[1].x, hp[1].y};
        *(uint4*)(H + (size_t)r * D + KIDX(2)) = uint4{hp[2].x, hp[2].y, hp[3].x, hp[3].y};
    }
}

#undef KIDX
DEV void ph_ffn_in(const Params& p, int which, int mt0, int mtiles, char* smem, int vid, int G) {
    const u16* H = WSP(u16, OFF_H);
    const u16* Wt = WSP(u16, OFF_W) + (which ? WE_IN1 : WE_IN0);
    u16* ACT = WSP(u16, OFF_P);
    const int lane = VTID & 63, wave = VTID >> 6, wm = wave >> 1, wn = wave & 1, fr = lane & 15, fq = lane >> 4;
    const int total = mtiles * 44;
    for (int t = vid; t < total; t += G) {
        int mt_, nt_;
        tile_decode(t, 44, mt_, nt_);
        mt_ += mt0;
        const int m0 = mt_ * 128, n0 = nt_ * 128;
        f32x4 acc[4][4];
        zero_acc<4>(acc);
        gemm_accum<4>(acc, H + (size_t)m0 * D, D, Wt + (size_t)n0 * D, D, D, smem, VTID);
#pragma unroll
        for (int mt = 0; mt < 4; ++mt)
#pragma unroll
            for (int pp = 0; pp < 2; ++pp)
#pragma unroll
                for (int r = 0; r < 4; ++r) {
                    const int row = m0 + wm * 64 + mt * 16 + fq * 4 + r;
                    const int hid = (n0 >> 1) + wn * 32 + pp * 16 + fr;
                    const float g = acc[mt][2 * pp][r], u = acc[mt][2 * pp + 1][r];
                    const float v = g * sigmoidf_(g) * u;
                    ACT[(size_t)row * DFF + hid] = (u16)(pk2(v, 0.f) & 0xffff);
                }
    }
}

DEV void ph_resid(const Params& p, const u16* A, int lda, const u16* Wt, int K, int modidx, float coef, int mt0, int mtiles, char* smem, int vid, int G) {
    const float* mods = WSP(float, OFF_MODS);
    const int lane = VTID & 63, wave = VTID >> 6, wm = wave >> 1, wn = wave & 1, fr = lane & 15, fq = lane >> 4;
    const int total = mtiles * 8 * 4;
    const int Kc = K >> 2;
    for (int t = vid; t < total; t += G) {
        int mt_, nt_;
        const int ksp = t & 3;
        tile_decode(t >> 2, 8, mt_, nt_);
        mt_ += mt0;
        const int m0 = mt_ * 128, n0 = nt_ * 128;
        f32x4 acc[4][4];
        zero_acc<4>(acc);
        gemm_accum<4>(acc, A + (size_t)m0 * lda + ksp * Kc, lda, Wt + (size_t)n0 * K + ksp * Kc, K, Kc, smem, VTID);
        const int b9 = m0 < NL ? (m0 >> 12) : 8;
        const float* gp = mods + b9 * 9216 + modidx * 1024;
#pragma unroll
        for (int nt = 0; nt < 4; ++nt) {
            const int col = n0 + wn * 64 + nt * 16 + fr;
            const float gv = gp[col] * coef;
#pragma unroll
            for (int mt = 0; mt < 4; ++mt)
#pragma unroll
                for (int r = 0; r < 4; ++r) {
                    const int row = m0 + wm * 64 + mt * 16 + fq * 4 + r;
                    WSP(float, OFF_PART)[((size_t)ksp * NCX + (row - NL)) * D + col] = gv * acc[mt][nt][r];
                }
        }
    }
}

DEV void ph_pgemm(const Params& p, int mt0, int mtiles, char* smem, int vid, int G) {
    const u16* H = WSP(u16, OFF_H);
    const u16* Wt = WSP(u16, OFF_W) + WE_MIX;
    u16* P = WSP(u16, OFF_P);
    u16* T = WSP(u16, OFF_T);
    float* Gt = WSP(float, OFF_G);
    const int lane = VTID & 63, wave = VTID >> 6, wm = wave >> 1, wn = wave & 1, fr = lane & 15, fq = lane >> 4;
    const int total = mtiles * 23;
    for (int t = vid; t < total; t += G) {
        int mt_, nt_;
        tile_decode(t, 23, mt_, nt_);
        mt_ += mt0;
        const int m0 = mt_ * 128, n0 = nt_ * 128;
        f32x4 acc[4][4];
        zero_acc<4>(acc);
        gemm_accum<4>(acc, H + (size_t)m0 * D, D, Wt + (size_t)n0 * D, D, D, smem, VTID);
        if (nt_ == 22) {
            if (wn == 0) {
#pragma unroll
                for (int mt = 0; mt < 4; ++mt)
#pragma unroll
                    for (int r = 0; r < 4; ++r) {
                        const int row = m0 + wm * 64 + mt * 16 + fq * 4 + r;
                        Gt[(size_t)row * 16 + fr] = acc[mt][0][r];
                    }
            }
            continue;
        }
        const bool rowmajor = nt_ < 16;
        const bool transp = (nt_ == 10) || (nt_ == 11) || (nt_ >= 16);
        if (rowmajor) {
#pragma unroll
            for (int mt = 0; mt < 4; ++mt)
#pragma unroll
                for (int nt = 0; nt < 4; ++nt)
#pragma unroll
                    for (int r = 0; r < 4; ++r) {
                        const int row = m0 + wm * 64 + mt * 16 + fq * 4 + r;
                        const int col = n0 + wn * 64 + nt * 16 + fr;
                        P[(size_t)row * PW + col] = (u16)(pk2(acc[mt][nt][r], 0.f) & 0xffff);
                    }
        }
        if (transp) {
            const int tcb = (nt_ >= 16) ? (n0 - 1792) : (n0 - 1280);
            int b, u0;
            if (m0 < NL) { b = m0 >> 12; u0 = m0 & 4095; } else { b = (m0 - NL) >> 8; u0 = SEQ + ((m0 - NL) & 255); }
#pragma unroll
            for (int mt = 0; mt < 4; ++mt)
#pragma unroll
                for (int nt = 0; nt < 4; ++nt) {
                    const int tc = tcb + wn * 64 + nt * 16 + fr;
                    const int u = u0 + wm * 64 + mt * 16 + fq * 4;
                    *(uint2*)(T + ((size_t)(b * TW + tc)) * UT + u) = uint2{pk2(acc[mt][nt][0], acc[mt][nt][1]), pk2(acc[mt][nt][2], acc[mt][nt][3])};
                }
        }
    }
}

DEV void ph_qknorm_gates(const Params& p, int l, int bid, int G) {
    const int lane = VTID & 63, gw = bid * 4 + (VTID >> 6), NW = G * 4;
    u16* P = WSP(u16, OFF_P);
    for (int it = gw; it < NSCAN * NCH; it += NW) {
        const int sc = it / NCH, c = it - sc * NCH, dir = sc & 1, h = (sc >> 1) & 3, b = sc >> 3;
        const float* Gt = WSP(float, OFF_G);
        float* BC = WSP(float, OFF_BC) + (size_t)sc * UT;
        float* IG = WSP(float, OFF_IG) + (size_t)sc * UT;
        float* WE = WSP(float, OFF_AE) + (size_t)sc * UT;
        const float bi = p.ml_gate_b[l * 16 + dir * 8 + h], bf = p.ml_gate_b[l * 16 + dir * 8 + 4 + h];
        const int cu = cu_of(c, dir);
        const int u = cu * 64 + (dir ? 63 - lane : lane);
        const int row = rowof(b, u);
        const float ig = Gt[(size_t)row * 16 + dir * 8 + h] + bi;
        const float fp = Gt[(size_t)row * 16 + dir * 8 + 4 + h] + bf;
        const float lf = fminf(fp, 0.f) - log1pf(expf(-fabsf(fp)));
        float bc = lf;
#pragma unroll
        for (int o = 1; o < 64; o <<= 1) { const float tv = __shfl_up(bc, o); if (lane >= o) bc += tv; }
        const float btot = __shfl(bc, 63);
        const float wend = btot - bc + ig;
        const float mx = wave_max(wend);
        WE[u] = wend;
        BC[u] = bc;
        IG[u] = ig;
        if (lane == 0) { WSP(float, OFF_MS)[sc * NCH + c] = btot; WSP(float, OFF_DEC)[sc * NCH + c] = mx; }
    }
    const float* rope = WSP(float, OFF_ROPE);
    const int hs = lane >> 4, e4 = (lane & 15) * 4;
    for (int r = NL + gw; r < MTOT; r += NW) {
        const bool latent = r < NL;
        const int tok = r & 4095;
#pragma unroll
        for (int g = 0; g < 5; ++g) {
            const int cbase = (g < 3 ? 256 + g * 256 : 1536 + (g - 3) * 256) + hs * 64 + e4;
            const int slot = g * 4 + hs;
            u16* pp = P + (size_t)r * PW + cbase;
            const uint2 raw = *(const uint2*)pp;
            float v0 = bflo(raw.x), v1 = bfhi(raw.x), v2 = bflo(raw.y), v3 = bfhi(raw.y);
            float ss = v0 * v0 + v1 * v1 + v2 * v2 + v3 * v3;
            ss += __shfl_xor(ss, 1); ss += __shfl_xor(ss, 2); ss += __shfl_xor(ss, 4); ss += __shfl_xor(ss, 8);
            const float* wv;
            float scl;
            bool do_rope;
            if (slot < 6) { wv = p.na_qk_w + (l * 2 + 0) * 64; scl = 0.125f; do_rope = false; }
            else if (slot < 12) { wv = p.gq_qk_w + (l * 2 + 0) * 64; scl = 0.125f; do_rope = latent; }
            else if (slot < 18) { wv = p.na_qk_w + (l * 2 + 1) * 64; scl = 1.f; do_rope = false; }
            else { wv = p.gq_qk_w + (l * 2 + 1) * 64; scl = 1.f; do_rope = latent; }
            const float rstd = rsqrtf(ss * (1.f / 64.f) + 1e-6f) * scl;
            const float4 w4 = *(const float4*)(wv + e4);
            v0 *= rstd * w4.x; v1 *= rstd * w4.y; v2 *= rstd * w4.z; v3 *= rstd * w4.w;
            const float o0 = __shfl_xor(v0, 8), o1 = __shfl_xor(v1, 8), o2 = __shfl_xor(v2, 8), o3 = __shfl_xor(v3, 8);
            if (do_rope) {
                const int fi = e4 & 31;
                const float4 cs01 = *(const float4*)(rope + ((size_t)tok * 32 + fi) * 2);
                const float4 cs23 = *(const float4*)(rope + ((size_t)tok * 32 + fi + 2) * 2);
                if (e4 < 32) {
                    v0 = v0 * cs01.x - o0 * cs01.y; v1 = v1 * cs01.z - o1 * cs01.w;
                    v2 = v2 * cs23.x - o2 * cs23.y; v3 = v3 * cs23.z - o3 * cs23.w;
                } else {
                    v0 = o0 * cs01.y + v0 * cs01.x; v1 = o1 * cs01.w + v1 * cs01.z;
                    v2 = o2 * cs23.y + v2 * cs23.x; v3 = o3 * cs23.w + v3 * cs23.z;
                }
            }
            *(uint2*)pp = uint2{pk2(v0, v1), pk2(v2, v3)};
        }
    }
}

template <int MT, bool NAMASK, int NWV>
DEV void flash_item(const Params& p, int b, int qrow0, int qcol, int kcol, int tcol, int ua, int n1, int ub, int ntiles,
                    int r_q, int rs, const float* __restrict__ rpb_h, char* smem, int ocol, float mfix = 0.f) {
    u16* P = WSP(u16, OFF_P);
    const u16* T = WSP(u16, OFF_T);
    const int tid = (NWV == 8) ? (int)(threadIdx.x + p.z) : VTID, lane = tid & 63, wave = tid >> 6, fr = lane & 15, fq = lane >> 4;
    constexpr int KVS = 64 * 144;
    char* Ks = smem;
    char* Vs = smem + 2 * KVS;
    float* rpb_s = (float*)(smem + 4 * KVS);
    __syncthreads();
    if (NAMASK) {
        for (int i = tid; i < 465; i += 256) rpb_s[i] = rpb_h[i] * 1.4426950408889634f;
    }
    Frag qf[MT][2];
#pragma unroll
    for (int mt = 0; mt < MT; ++mt)
#pragma unroll
        for (int ks = 0; ks < 2; ++ks)
            qf[mt][ks].q = *(const uint4*)(P + (size_t)(qrow0 + (wave * MT + mt) * 16 + fr) * PW + qcol + ks * 32 + fq * 8);
    const int lr = tid >> 3, lc8 = tid & 7;
    u32x4 rk0, rk1 = {0, 0, 0, 0}, rv0, rv1 = {0, 0, 0, 0};
#define FL_GLOAD(KT) do { const int kt_ = (KT); const int u0_ = kt_ < n1 ? ua + 64 * kt_ : ub + 64 * (kt_ - n1); const int row0_ = rowof(b, u0_); \
        rk0 = gld16(P + (size_t)(row0_ + lr) * PW + kcol + lc8 * 8); rv0 = gld16(T + ((size_t)(b * TW + tcol + lr)) * UT + u0_ + lc8 * 8); \
        if (NWV == 4) { rk1 = gld16(P + (size_t)(row0_ + lr + 32) * PW + kcol + lc8 * 8); rv1 = gld16(T + ((size_t)(b * TW + tcol + lr + 32)) * UT + u0_ + lc8 * 8); } } while (0)
#define FL_SSTORE(S) do { const int s_ = (S); \
        *(u32x4*)(Ks + s_ * KVS + lr * 144 + lc8 * 16) = rk0; *(u32x4*)(Vs + s_ * KVS + lr * 144 + lc8 * 16) = rv0; \
        if (NWV == 4) { *(u32x4*)(Ks + s_ * KVS + (lr + 32) * 144 + lc8 * 16) = rk1; *(u32x4*)(Vs + s_ * KVS + (lr + 32) * 144 + lc8 * 16) = rv1; } } while (0)
    FL_GLOAD(0);
    VM_WAIT0();
    FL_SSTORE(0);
    __syncthreads();
    f32x4 o[MT][4];
    float mrow[MT], lrow[MT];
#pragma unroll
    for (int mt = 0; mt < MT; ++mt) {
        mrow[mt] = -1e30f; lrow[mt] = 0.f;
#pragma unroll
        for (int dt = 0; dt < 4; ++dt) o[mt][dt] = f32x4{0.f, 0.f, 0.f, 0.f};
    }
    const float L2E = 1.4426950408889634f;
    for (int kt = 0; kt < ntiles; ++kt) {
        const int cur = kt & 1;
        const bool more = kt + 1 < ntiles;
        FL_GLOAD(more ? kt + 1 : kt);
        __builtin_amdgcn_sched_barrier(0);
        f32x4 s[MT][4];
#pragma unroll
        for (int mt = 0; mt < MT; ++mt)
#pragma unroll
            for (int nt = 0; nt < 4; ++nt) s[mt][nt] = f32x4{0.f, 0.f, 0.f, 0.f};
#pragma unroll
        for (int ks = 0; ks < 2; ++ks)
#pragma unroll
            for (int nt = 0; nt < 4; ++nt) {
                const bf16x8 kf = *(const bf16x8*)(Ks + cur * KVS + (nt * 16 + fr) * 144 + (ks * 32 + fq * 8) * 2);
#pragma unroll
                for (int mt = 0; mt < MT; ++mt) s[mt][nt] = mfma16(kf, qf[mt][ks].v, s[mt][nt]);
            }
        Frag pf[MT][2];
#pragma unroll
        for (int mt = 0; mt < MT; ++mt) {
            float rsum = 0.f;
            if (NAMASK && kt < 8) {
                const int qc = (wave * MT + mt) * 16 + fr;
                int cs = qc - 8; cs = cs < 0 ? 0 : (cs > 48 ? 48 : cs);
                const int brow = rs + kt - r_q + 7;
#pragma unroll
                for (int nt = 0; nt < 4; ++nt)
#pragma unroll
                    for (int r = 0; r < 4; ++r) {
                        const int kc = nt * 16 + fq * 4 + r;
                        const bool valid = (kc >= cs) && (kc < cs + 16);
                        const int bi = valid ? brow * 31 + (kc - qc + 15) : 0;
                        const float e = valid ? fexp2(fmaf(s[mt][nt][r], L2E, rpb_s[bi] - mfix)) : 0.f;
                        s[mt][nt][r] = e; rsum += e;
                    }
            } else {
#pragma unroll
                for (int nt = 0; nt < 4; ++nt)
#pragma unroll
                    for (int r = 0; r < 4; ++r) { const float e = fexp2(fmaf(s[mt][nt][r], L2E, -mfix)); s[mt][nt][r] = e; rsum += e; }
            }
            lrow[mt] += rsum;
#pragma unroll
            for (int ks = 0; ks < 2; ++ks) {
                pf[mt][ks].u[0] = pk2(s[mt][2 * ks][0], s[mt][2 * ks][1]);
                pf[mt][ks].u[1] = pk2(s[mt][2 * ks][2], s[mt][2 * ks][3]);
                pf[mt][ks].u[2] = pk2(s[mt][2 * ks + 1][0], s[mt][2 * ks + 1][1]);
                pf[mt][ks].u[3] = pk2(s[mt][2 * ks + 1][2], s[mt][2 * ks + 1][3]);
            }
        }
#pragma unroll
        for (int ks = 0; ks < 2; ++ks)
#pragma unroll
            for (int dt = 0; dt < 4; ++dt) {
                Frag vf;
                vf.d[0] = *(const uint2*)(Vs + cur * KVS + (dt * 16 + fr) * 144 + (ks * 32 + fq * 4) * 2);
                vf.d[1] = *(const uint2*)(Vs + cur * KVS + (dt * 16 + fr) * 144 + (ks * 32 + 16 + fq * 4) * 2);
#pragma unroll
                for (int mt = 0; mt < MT; ++mt) o[mt][dt] = mfma16(vf.v, pf[mt][ks].v, o[mt][dt]);
            }
        __builtin_amdgcn_sched_barrier(0);
        VM_WAIT0();
        FL_SSTORE(cur ^ 1);
        __syncthreads();
    }
#pragma unroll
    for (int mt = 0; mt < MT; ++mt) {
        const float inv = 1.f / xq_sum(lrow[mt]);
        u16* op = P + (size_t)(qrow0 + (wave * MT + mt) * 16 + fr) * PW + ocol;
#pragma unroll
        for (int dt = 0; dt < 4; ++dt)
            *(uint2*)(op + dt * 16 + fq * 4) = uint2{pk2(o[mt][dt][0] * inv, o[mt][dt][1] * inv), pk2(o[mt][dt][2] * inv, o[mt][dt][3] * inv)};
    }
}

template <int MT>
DEV void flash8_item(const Params& p, int b, int qrow0, int qcol, int kcol, int tcol, int ua, int ntiles, char* smem, float mfix) {
    u16* P = WSP(u16, OFF_P);
    const u16* T = WSP(u16, OFF_T);
    const int tid = (int)(threadIdx.x + p.z), lane = tid & 63, wave = tid >> 6, fr = lane & 15, fq = lane >> 4;
    constexpr int STG = 16384;
    __syncthreads();
    Frag qf[MT][2];
#pragma unroll
    for (int mt = 0; mt < MT; ++mt)
#pragma unroll
        for (int ks = 0; ks < 2; ++ks)
            qf[mt][ks].q = *(const uint4*)(P + (size_t)(qrow0 + (wave * MT + mt) * 16 + fr) * PW + qcol + ks * 32 + fq * 8);
    const int lr = lane >> 3, pos = lane & 7, rowl = wave * 8 + lr;
    const int cch = pos ^ ((rowl >> 1) & 7);
    const unsigned voK = (unsigned)(rowl * PW + cch * 8) * 2u, voV = (unsigned)(rowl * UT + cch * 8) * 2u;
    const unsigned ldsw = __builtin_amdgcn_readfirstlane((unsigned)(size_t)(__attribute__((address_space(3))) char*)smem + wave * 1024);
    const u16* Tb = T + (size_t)(b * TW + tcol) * UT;
#define F8_ISSUE(KT, STGI) do { const int u0_ = ua + 64 * (KT); const int row0_ = rowof(b, u0_); \
        glds16(P + (size_t)row0_ * PW + kcol, voK, ldsw + (STGI) * STG); glds16(Tb + u0_, voV, ldsw + (STGI) * STG + 8192); } while (0)
    F8_ISSUE(0, 0);
    F8_ISSUE(ntiles > 1 ? 1 : 0, 1);
    F8_ISSUE(ntiles > 2 ? 2 : ntiles - 1, 2);
    f32x4 o[MT][4];
    float lrow[MT];
#pragma unroll
    for (int mt = 0; mt < MT; ++mt) {
        lrow[mt] = 0.f;
#pragma unroll
        for (int dt = 0; dt < 4; ++dt) o[mt][dt] = f32x4{0.f, 0.f, 0.f, 0.f};
    }
    const int s3 = (fr >> 1) & 7;
    const int okb = fr * 128 + ((fq ^ s3) * 16);
    const int ovb = 8192 + fr * 128 + (((fq >> 1) ^ s3) * 16) + (fq & 1) * 8;
    const float L2E = 1.4426950408889634f;
    f32x4 sc_[MT][4];
    asm volatile("s_waitcnt vmcnt(4)" ::: "memory");
    __syncthreads();
#define F8_SCORES(DST, STGI) do { int ob_ = (STGI) * STG; asm volatile("" : "+v"(ob_)); const char* bs_ = smem + ob_; \
        _Pragma("unroll") for (int mt = 0; mt < MT; ++mt) _Pragma("unroll") for (int nt = 0; nt < 4; ++nt) DST[mt][nt] = f32x4{0.f, 0.f, 0.f, 0.f}; \
        _Pragma("unroll") for (int ks = 0; ks < 2; ++ks) _Pragma("unroll") for (int nt = 0; nt < 4; ++nt) { \
            const bf16x8 kf = *(const bf16x8*)(bs_ + (okb ^ (ks * 64)) + nt * 2048); \
            _Pragma("unroll") for (int mt = 0; mt < MT; ++mt) DST[mt][nt] = mfma16(kf, qf[mt][ks].v, DST[mt][nt]); } } while (0)
    F8_SCORES(sc_, 0);
    for (int kt = 0; kt < ntiles; ++kt) {
        const int stg = kt & 3;
        asm volatile("s_waitcnt vmcnt(2)" ::: "memory");
        __syncthreads();
        {
            const int kn = kt + 3 < ntiles ? kt + 3 : ntiles - 1;
            F8_ISSUE(kn, (kt + 3) & 3);
        }
        f32x4 sn_[MT][4];
        if (kt + 1 < ntiles) F8_SCORES(sn_, (kt + 1) & 3);
        int ob = stg * STG;
        asm volatile("" : "+v"(ob));
        const char* base = smem + ob;
        Frag pf[MT][2];
#pragma unroll
        for (int mt = 0; mt < MT; ++mt) {
            float rsum = 0.f;
#pragma unroll
            for (int nt = 0; nt < 4; ++nt)
#pragma unroll
                for (int r = 0; r < 4; ++r) { const float e = fexp2(fmaf(sc_[mt][nt][r], L2E, -mfix)); sc_[mt][nt][r] = e; rsum += e; }
            lrow[mt] += rsum;
#pragma unroll
            for (int ks = 0; ks < 2; ++ks) {
                pf[mt][ks].u[0] = pk2(sc_[mt][2 * ks][0], sc_[mt][2 * ks][1]);
                pf[mt][ks].u[1] = pk2(sc_[mt][2 * ks][2], sc_[mt][2 * ks][3]);
                pf[mt][ks].u[2] = pk2(sc_[mt][2 * ks + 1][0], sc_[mt][2 * ks + 1][1]);
                pf[mt][ks].u[3] = pk2(sc_[mt][2 * ks + 1][2], sc_[mt][2 * ks + 1][3]);
            }
        }
#pragma unroll
        for (int ks = 0; ks < 2; ++ks)
#pragma unroll
            for (int dt = 0; dt < 4; ++dt) {
                Frag vf;
                vf.d[0] = *(const uint2*)(base + (ovb ^ (ks * 64)) + dt * 2048);
                vf.d[1] = *(const uint2*)(base + ((ovb ^ (ks * 64)) ^ 32) + dt * 2048);
#pragma unroll
                for (int mt = 0; mt < MT; ++mt) o[mt][dt] = mfma16(vf.v, pf[mt][ks].v, o[mt][dt]);
            }
        if (kt + 1 < ntiles) {
#pragma unroll
            for (int mt = 0; mt < MT; ++mt)
#pragma unroll
                for (int nt = 0; nt < 4; ++nt) sc_[mt][nt] = sn_[mt][nt];
        }
    }
#undef F8_SCORES
    VM_WAIT0();
    __syncthreads();
#undef F8_ISSUE
#pragma unroll
    for (int mt = 0; mt < MT; ++mt) {
        const float inv = 1.f / xq_sum(lrow[mt]);
        u16* op = P + (size_t)(qrow0 + (wave * MT + mt) * 16 + fr) * PW + qcol;
#pragma unroll
        for (int dt = 0; dt < 4; ++dt)
            *(uint2*)(op + dt * 16 + fq * 4) = uint2{pk2(o[mt][dt][0] * inv, o[mt][dt][1] * inv), pk2(o[mt][dt][2] * inv, o[mt][dt][3] * inv)};
    }
}


DEV void m2_item(const Params& p, int sc, int c) {
    const u16* T = WSP(u16, OFF_T);
    const int lane = VTID & 63, wave = VTID >> 6, fr = lane & 15, fq = lane >> 4;
    const int dir = sc & 1, h = (sc >> 1) & 3, b = sc >> 3;
    const int u0 = cu_of(c, dir) * 64;
    const float* AE = WSP(float, OFF_AE) + (size_t)sc * UT + u0;
    float* S = WSP(float, OFF_S) + ((size_t)sc * NCH + c) * SCH;
    const float mnew = fmaxf(WSP(float, OFF_MS)[sc * NCH + c] + m_scan(p, sc, c), WSP(float, OFF_DEC)[sc * NCH + c]);
    f32x4 acc[4], accn[4];
#pragma unroll
    for (int nt = 0; nt < 4; ++nt) { acc[nt] = f32x4{0.f, 0.f, 0.f, 0.f}; accn[nt] = f32x4{0.f, 0.f, 0.f, 0.f}; }
    Frag ones;
    ones.u[0] = ones.u[1] = ones.u[2] = ones.u[3] = 0x3F803F80u;
#pragma unroll
    for (int ks = 0; ks < 2; ++ks) {
        Frag vf;
        vf.q = *(const uint4*)(T + ((size_t)(b * TW + TC_MLV + h * 64 + wave * 16 + fr)) * UT + u0 + ks * 32 + fq * 8);
        float4 a0 = *(const float4*)(AE + ks * 32 + fq * 8), a1 = *(const float4*)(AE + ks * 32 + fq * 8 + 4);
        a0.x = expf(a0.x - mnew); a0.y = expf(a0.y - mnew); a0.z = expf(a0.z - mnew); a0.w = expf(a0.w - mnew);
        a1.x = expf(a1.x - mnew); a1.y = expf(a1.y - mnew); a1.z = expf(a1.z - mnew); a1.w = expf(a1.w - mnew);
#pragma unroll
        for (int nt = 0; nt < 4; ++nt) {
            Frag kf, kb;
            kf.q = *(const uint4*)(T + ((size_t)(b * TW + TC_MLK + h * 64 + nt * 16 + fr)) * UT + u0 + ks * 32 + fq * 8);
            kb.u[0] = pk2(bflo(kf.u[0]) * a0.x * 0.125f, bfhi(kf.u[0]) * a0.y * 0.125f);
            kb.u[1] = pk2(bflo(kf.u[1]) * a0.z * 0.125f, bfhi(kf.u[1]) * a0.w * 0.125f);
            kb.u[2] = pk2(bflo(kf.u[2]) * a1.x * 0.125f, bfhi(kf.u[2]) * a1.y * 0.125f);
            kb.u[3] = pk2(bflo(kf.u[3]) * a1.z * 0.125f, bfhi(kf.u[3]) * a1.w * 0.125f);
            acc[nt] = mfma16(vf.v, kb.v, acc[nt]);
            if (wave == 0) accn[nt] = mfma16(ones.v, kb.v, accn[nt]);
        }
    }
#pragma unroll
    for (int nt = 0; nt < 4; ++nt) {
#pragma unroll
        for (int r = 0; r < 4; ++r) S[(wave * 16 + fq * 4 + r) * 64 + nt * 16 + fr] = acc[nt][r];
        if (wave == 0 && fq == 0) S[4096 + nt * 16 + fr] = accn[nt][0];
    }
}

DEV void ph_m3(const Params& p, int bid, int G) {
    const float* DEC = WSP(float, OFF_DEC);
    float* S = WSP(float, OFF_S);
    const int total = NSCAN * SCH;
    for (int i = bid * 256 + VTID; i < total; i += G * 256) {
        const int sc = i / SCH, e = i - sc * SCH;
        float* base = S + (size_t)sc * NCH * SCH + e;
        const float* mxp = DEC + sc * NCH;
        const float* btp = WSP(float, OFF_MS) + sc * NCH;
        float st = 0.f, m = 0.f;
#pragma unroll 17
        for (int c = 0; c < NCH; ++c) {
            const float tmp = base[(size_t)c * SCH];
            base[(size_t)c * SCH] = st;
            const float bm = btp[c] + m;
            const float mnew = fmaxf(bm, mxp[c]);
            st = expf(bm - mnew) * st + tmp;
            m = mnew;
        }
    }
}

DEV void m4_item(const Params& p, int l, int b, int h, int cu, int ocolbase) {
    u16* P = WSP(u16, OFF_P);
    const u16* T = WSP(u16, OFF_T);
    const int lane = VTID & 63, wave = VTID >> 6, fr = lane & 15, fq = lane >> 4;
    const int u0 = cu * 64;
    const int row0 = rowof(b, u0);
    const int j = wave * 16 + fr;
    Frag qf[2];
#pragma unroll
    for (int ks = 0; ks < 2; ++ks) qf[ks].q = *(const uint4*)(P + (size_t)(row0 + j) * PW + PC_MLQ + h * 64 + ks * 32 + fq * 8);
    f32x4 hsum[4];
#pragma unroll
    for (int dt = 0; dt < 4; ++dt) hsum[dt] = f32x4{0.f, 0.f, 0.f, 0.f};
#pragma unroll 1
    for (int dir = 0; dir < 2; ++dir) {
        const int sc = (b * 4 + h) * 2 + dir;
        int c;
        if (cu >= 64) c = dir ? 3 - (cu - 64) : (cu - 64); else c = 4 + (dir ? 63 - cu : cu);
        const float m0 = m_scan(p, sc, c);
        const float* BC = WSP(float, OFF_BC) + (size_t)sc * UT + u0;
        const float* IG = WSP(float, OFF_IG) + (size_t)sc * UT + u0;
        const float* S = WSP(float, OFF_S) + ((size_t)sc * NCH + c) * SCH;
        const float bj = BC[j];
        f32x4 s[4];
#pragma unroll
        for (int nt = 0; nt < 4; ++nt) s[nt] = f32x4{0.f, 0.f, 0.f, 0.f};
#pragma unroll
        for (int ks = 0; ks < 2; ++ks)
#pragma unroll
            for (int nt = 0; nt < 4; ++nt) {
                Frag kf;
                kf.q = *(const uint4*)(P + (size_t)(row0 + nt * 16 + fr) * PW + PC_MLK + h * 64 + ks * 32 + fq * 8);
                s[nt] = mfma16(kf.v, qf[ks].v, s[nt]);
            }
        float lw[4][4];
        float mx = -1e30f;
#pragma unroll
        for (int nt = 0; nt < 4; ++nt) {
            const float4 bs = *(const float4*)(BC + nt * 16 + fq * 4);
            const float4 is = *(const float4*)(IG + nt * 16 + fq * 4);
            const float bsv[4] = {bs.x, bs.y, bs.z, bs.w}, isv[4] = {is.x, is.y, is.z, is.w};
#pragma unroll
            for (int r = 0; r < 4; ++r) {
                const int sidx = nt * 16 + fq * 4 + r;
                const bool valid = dir ? (sidx >= j) : (sidx <= j);
                lw[nt][r] = valid ? (bj - bsv[r] + isv[r]) : -1e30f;
                mx = fmaxf(mx, lw[nt][r]);
            }
        }
        mx = xq_max(mx);
        const float minter = bj + m0;
        const float mj = fmaxf(minter, mx);
        const float g = fexp(minter - mj);
        float den = 0.f;
#pragma unroll
        for (int nt = 0; nt < 4; ++nt)
#pragma unroll
            for (int r = 0; r < 4; ++r) {
                const float w = fexp(lw[nt][r] - mj);
                const float qk = s[nt][r] * 0.125f * w;
                s[nt][r] = qk;
                den += qk;
            }
        den = xq_sum(den);
        Frag pf[2];
#pragma unroll
        for (int ks = 0; ks < 2; ++ks) {
            pf[ks].u[0] = pk2(s[2 * ks][0], s[2 * ks][1]);
            pf[ks].u[1] = pk2(s[2 * ks][2], s[2 * ks][3]);
            pf[ks].u[2] = pk2(s[2 * ks + 1][0], s[2 * ks + 1][1]);
            pf[ks].u[3] = pk2(s[2 * ks + 1][2], s[2 * ks + 1][3]);
        }
        f32x4 acc[4], accn = f32x4{0.f, 0.f, 0.f, 0.f};
#pragma unroll
        for (int dt = 0; dt < 4; ++dt) acc[dt] = f32x4{0.f, 0.f, 0.f, 0.f};
#pragma unroll
        for (int ks = 0; ks < 2; ++ks) {
            {
                const float4 n0 = *(const float4*)(S + 4096 + ks * 32 + fq * 8), n1 = *(const float4*)(S + 4096 + ks * 32 + fq * 8 + 4);
                Frag nf;
                nf.u[0] = pk2(n0.x, n0.y); nf.u[1] = pk2(n0.z, n0.w); nf.u[2] = pk2(n1.x, n1.y); nf.u[3] = pk2(n1.z, n1.w);
                accn = mfma16(nf.v, qf[ks].v, accn);
            }
#pragma unroll
            for (int dt = 0; dt < 4; ++dt) {
                const float* cp = S + (dt * 16 + fr) * 64 + ks * 32 + fq * 8;
                const float4 c0 = *(const float4*)cp, c1 = *(const float4*)(cp + 4);
                Frag cf;
                cf.u[0] = pk2(c0.x, c0.y); cf.u[1] = pk2(c0.z, c0.w); cf.u[2] = pk2(c1.x, c1.y); cf.u[3] = pk2(c1.z, c1.w);
                acc[dt] = mfma16(cf.v, qf[ks].v, acc[dt]);
            }
        }
#pragma unroll
        for (int dt = 0; dt < 4; ++dt) acc[dt] *= g;
        den += g * accn[0];
#pragma unroll
        for (int ks = 0; ks < 2; ++ks)
#pragma unroll
            for (int dt = 0; dt < 4; ++dt) {
                const u16* vp = T + ((size_t)(b * TW + TC_MLV + h * 64 + dt * 16 + fr)) * UT + u0 + ks * 32 + fq * 4;
                Frag vf;
                vf.d[0] = *(const uint2*)vp;
                vf.d[1] = *(const uint2*)(vp + 16);
                acc[dt] = mfma16(vf.v, pf[ks].v, acc[dt]);
            }
        const float dd = 1.f / fmaxf(fabsf(den), fexp(-mj));
#pragma unroll
        for (int dt = 0; dt < 4; ++dt) hsum[dt] += acc[dt] * dd;
    }
    float ss = 0.f;
#pragma unroll
    for (int dt = 0; dt < 4; ++dt)
#pragma unroll
        for (int r = 0; r < 4; ++r) ss += hsum[dt][r] * hsum[dt][r];
    ss = xq_sum(ss);
    const float rstd = rsqrtf(ss * (1.f / 64.f) + 1e-6f);
    const float* nw = p.ml_norm_w + l * 256 + h * 64;
    u16* orow = P + (size_t)(row0 + j) * PW;
#pragma unroll
    for (int dt = 0; dt < 4; ++dt) {
        const int v0 = dt * 16 + fq * 4;
        const float4 w4 = *(const float4*)(nw + v0);
        const uint2 og = *(const uint2*)(orow + PC_MLO + h * 64 + v0);
        const float y0 = hsum[dt][0] * rstd * w4.x * sigmoidf_(bflo(og.x));
        const float y1 = hsum[dt][1] * rstd * w4.y * sigmoidf_(bfhi(og.x));
        const float y2 = hsum[dt][2] * rstd * w4.z * sigmoidf_(bflo(og.y));
        const float y3 = hsum[dt][3] * rstd * w4.w * sigmoidf_(bfhi(og.y));
        *(uint2*)(orow + ocolbase + h * 64 + v0) = uint2{pk2(y0, y1), pk2(y2, y3)};
    }
}

DEV void ph_attn8(const Params& p, int l, char* smem0, int rbid, int RG) {
    const int n_gq = 768, n_c = (l == 0) ? 96 : 0;
    const int ln_ = (int)((threadIdx.x + p.z) & 63);
    const float bgq = 8.f * wave_max(fabsf(p.gq_qk_w[(l * 2 + 0) * 64 + ln_])) * wave_max(fabsf(p.gq_qk_w[(l * 2 + 1) * 64 + ln_])) * 1.4426950408889634f * 1.03f + 0.5f;
    const float bna = 8.f * wave_max(fabsf(p.na_qk_w[(l * 2 + 0) * 64 + ln_])) * wave_max(fabsf(p.na_qk_w[(l * 2 + 1) * 64 + ln_])) * 1.4426950408889634f * 1.03f + 0.5f;
    for (int it = rbid; it < n_gq + n_c; it += RG) {
        float mfix = bgq;
        int b, qrow0, qcol, kcol, tcol, ua, nt;
        if (it < n_gq) {
            const int qt = it & 15, hq = (it >> 4) % 6;
            b = it / 96; qrow0 = b * SEQ + qt * 256; qcol = PC_GQQ + hq * 64; kcol = PC_GQK + (hq / 3) * 64; tcol = TC_GQV + (hq / 3) * 64; ua = 0; nt = 68;
        } else {
            const int r = it - n_gq;
            const int kind = r / 48, rr = r % 48, hh = rr % 6;
            b = rr / 6; qrow0 = NL + b * CTXL; ua = SEQ; nt = 4;
            if (kind == 0) { qcol = PC_GQQ + hh * 64; kcol = PC_GQK + (hh / 3) * 64; tcol = TC_GQV + (hh / 3) * 64; }
            else { qcol = PC_NAQ + hh * 64; kcol = PC_NAK + hh * 64; tcol = TC_NAV + hh * 64; mfix = bna; }
        }
        flash8_item<2>(p, b, qrow0, qcol, kcol, tcol, ua, nt, smem0, mfix);
    }
}
DEV void ph_attn(const Params& p, int l, char* smem, int bid, int G, int rep) {
    const int n_na = 3072, n_m2 = NSCAN * NCH;
    const int total = n_na + n_m2;
    const int ln_ = VTID & 63;
    float rmax = 0.f;
    for (int i = ln_; i < 6 * 465; i += 64) rmax = fmaxf(rmax, fabsf(p.na_rpb[(size_t)l * 6 * 465 + i]));
    const float mfix_na = (8.f * wave_max(fabsf(p.na_qk_w[(l * 2 + 0) * 64 + ln_])) * wave_max(fabsf(p.na_qk_w[(l * 2 + 1) * 64 + ln_])) * 1.03f + wave_max(rmax)) * 1.4426950408889634f + 0.5f;
    for (int it = bid; it < total; it += G) {
        int r = it;
        if (r < n_na) {
            const int gr = r & 63, hn = (r >> 6) % 6, b = r / 384;
            int rs = gr - 4; rs = rs < 0 ? 0 : (rs > 56 ? 56 : rs);
            flash_item<1, true, 4>(p, b, b * SEQ + gr * 64, PC_NAQ + hn * 64, PC_NAK + hn * 64, TC_NAV + hn * 64, rs * 64, 8, SEQ, 12, gr, rs,
                                p.na_rpb + (size_t)(l * 6 + hn) * 465, smem, PC_NAQ + hn * 64 + (rep ? 1792 : 0), mfix_na);
            continue;
        }
        r -= n_na;
        m2_item(p, r / NCH, r % NCH);
    }
}

DEV void ph_m4(const Params& p, int l, int bid, int G, int rep) {
    const int nch = (l == 0) ? NCH : 64;
    const int total = NB * 4 * nch;
    for (int it = bid; it < total; it += G) {
        const int cu = it % nch, h = (it / nch) & 3, b = it / (nch * 4);
        m4_item(p, l, b, h, cu, rep ? 2048 : PC_MLQ);
    }
}

DEV void ph_merge(const Params& p, int mt0, int mtiles, char* smem, int vid, int G) {
    const u16* H = WSP(u16, OFF_H);
    u16* P = WSP(u16, OFF_P);
    const u16* Wg = WSP(u16, OFF_W) + WE_MIX + (size_t)2944 * 1024;
    const u16* Wbr = WSP(u16, OFF_W) + WE_BR;
    const int lane = VTID & 63, wave = VTID >> 6, wm = wave >> 1, wn = wave & 1, fr = lane & 15, fq = lane >> 4;
    const int total = mtiles * 16;
    for (int t = vid; t < total; t += G) {
        int mt_, nt_;
        tile_decode(t, 16, mt_, nt_);
        mt_ += mt0;
        const int m0 = mt_ * 128, n0 = nt_ * 64;
        f32x4 y[4][2];
        zero_acc<2>(y);
#pragma unroll 1
        for (int br = 0; br < 3; ++br) {
            const int ko = br == 0 ? 0 : (br == 1 ? 256 : 640);
            const int kk = br == 0 ? 256 : 384;
            f32x4 g[4][2];
            zero_acc<2>(g);
            gemm_accum<2>(g, H + (size_t)m0 * D, D, Wg + (size_t)(br * 1024 + n0) * D, D, D, smem, VTID);
#pragma unroll
            for (int i = 0; i < 4; ++i)
#pragma unroll
                for (int jn = 0; jn < 2; ++jn)
#pragma unroll
                    for (int r = 0; r < 4; ++r) g[i][jn][r] = sigmoidf_(g[i][jn][r]);
            f32x4 a[4][2];
            zero_acc<2>(a);
            gemm_accum<2>(a, P + (size_t)m0 * PW + ko, PW, Wbr + (size_t)n0 * D + ko, D, kk, smem, VTID);
#pragma unroll
            for (int i = 0; i < 4; ++i)
#pragma unroll
                for (int jn = 0; jn < 2; ++jn) y[i][jn] += g[i][jn] * a[i][jn];
        }
#pragma unroll
        for (int mt = 0; mt < 4; ++mt)
#pragma unroll
            for (int nt = 0; nt < 2; ++nt)
#pragma unroll
                for (int r = 0; r < 4; ++r) {
                    const int row = m0 + wm * 64 + mt * 16 + fq * 4 + r;
                    const int col = n0 + wn * 32 + nt * 16 + fr;
                    P[(size_t)row * PW + PC_Y + col] = (u16)(pk2(y[mt][nt][r], 0.f) & 0xffff);
                }
    }
}


#ifdef DBG
constexpr size_t OFF_DBG = al256(WS_END);
__global__ void __launch_bounds__(64) dbg_mlstm(Params p, int l) {
    const int sc = blockIdx.x, dir = sc & 1, h = (sc >> 1) & 3, b = sc >> 3, lane = VTID;
    const u16* P = WSP(u16, OFF_P); const u16* T = WSP(u16, OFF_T); const float* Gt = WSP(float, OFF_G);
    float* HN = WSP(float, OFF_S) + (size_t)sc * UT * 64;
    const float bi = p.ml_gate_b[l * 16 + dir * 8 + h], bf = p.ml_gate_b[l * 16 + dir * 8 + 4 + h];
    float C[64], n[64];
    for (int k = 0; k < 64; ++k) { C[k] = 0.f; n[k] = 0.f; }
    float m = 0.f;
    for (int pos = 0; pos < UT; ++pos) {
        int u;
        if (pos < 256) u = SEQ + (dir ? 255 - pos : pos); else u = dir ? 4095 - (pos - 256) : (pos - 256);
        const int row = rowof(b, u);
        const float ig = Gt[(size_t)row * 16 + dir * 8 + h] + bi;
        const float fp = Gt[(size_t)row * 16 + dir * 8 + 4 + h] + bf;
        const float lf = fminf(fp, 0.f) - log1pf(expf(-fabsf(fp)));
        const float mn = fmaxf(lf + m, ig);
        const float fw = expf(lf + m - mn), iw = expf(ig - mn);
        m = mn;
        const float qv = __uint_as_float(((uint32_t)P[(size_t)row * PW + 2048 + h * 64 + lane]) << 16);
        const float kv = __uint_as_float(((uint32_t)P[(size_t)row * PW + PC_MLK + h * 64 + lane]) << 16) * 0.125f;
        const float vv = __uint_as_float(((uint32_t)T[((size_t)(b * TW + TC_MLV + h * 64 + lane)) * UT + u]) << 16);
        float num = 0.f, den = 0.f;
#pragma unroll
        for (int k = 0; k < 64; ++k) {
            const float kk = __shfl(kv, k), qq = __shfl(qv, k);
            C[k] = fw * C[k] + iw * kk * vv;
            n[k] = fw * n[k] + iw * kk;
            num += qq * C[k];
            den += qq * n[k];
        }
        HN[(size_t)u * 64 + lane] = num / fmaxf(fabsf(den), expf(-m));
    }
}
__global__ void dbg_cmp(Params p, int l) {
    const int gid = blockIdx.x * blockDim.x + VTID;
    const u16* P = WSP(u16, OFF_P); const u16* T = WSP(u16, OFF_T);
    unsigned* dw = (unsigned*)(p.ws + OFF_DBG);
    float* df = (float*)(p.ws + OFF_DBG);
    if (gid < NB * 4 * UT) {
        const int u = gid % UT, h = (gid / UT) & 3, b = gid / (UT * 4);
        const int row = rowof(b, u);
        const float* hf = WSP(float, OFF_S) + ((size_t)((b * 4 + h) * 2 + 0) * UT + u) * 64;
        const float* hb = WSP(float, OFF_S) + ((size_t)((b * 4 + h) * 2 + 1) * UT + u) * 64;
        float ss = 0.f;
        for (int v = 0; v < 64; ++v) { const float x = hf[v] + hb[v]; ss += x * x; }
        const float rstd = rsqrtf(ss / 64.f + 1e-6f);
        float md = 0.f;
        for (int v = 0; v < 64; ++v) {
            const float x = (hf[v] + hb[v]) * rstd * p.ml_norm_w[l * 256 + h * 64 + v];
            const float o = __uint_as_float(((uint32_t)P[(size_t)row * PW + PC_MLO + h * 64 + v]) << 16);
            const float y = x / (1.f + expf(-o));
            const float got = __uint_as_float(((uint32_t)P[(size_t)row * PW + PC_MLQ + h * 64 + v]) << 16);
            md += fabsf(y - got);
        }
        atomicAdd(df + (u < SEQ ? 0 : 1), md * (1.f / 64.f));
        return;
    }
    const int w = (gid - NB * 4 * UT) >> 6;
    const int lane = VTID & 63;
    int type, b, qrow, qc, kcol, tcol, ocol, hn = 0, gr = 0, gc = 0, nkeys;
    if (w < 6144) {
        type = 0; const int i = w & 127; hn = (w >> 7) % 6; b = w / 768;
        gr = i & 63; gc = (i < 64) ? gr : 63 - gr;
        qrow = b * SEQ + gr * 64 + gc; qc = 2048 + 256 + hn * 64; kcol = PC_NAK + hn * 64; tcol = TC_NAV + hn * 64; ocol = PC_NAQ + hn * 64; nkeys = 384;
    } else if (w < 6144 + 256) {
        type = 1; const int x = w - 6144; const int i = x & 15, hh = (x >> 4) & 1; b = x >> 5;
        qrow = b * SEQ + (i * 273) % 4096; qc = 2688 + hh * 64; kcol = PC_GQK + hh * 64; tcol = TC_GQV + hh * 64; ocol = PC_GQQ + hh * 3 * 64; nkeys = 4352;
    } else if (w < 6144 + 256 + 768) {
        type = 2; const int x = w - 6400; const int i = x & 15; hn = (x >> 4) % 6; b = x / 96;
        qrow = NL + b * CTXL + (i * 17) % 256; qc = 2048 + 256 + hn * 64; kcol = PC_NAK + hn * 64; tcol = TC_NAV + hn * 64; ocol = PC_NAQ + hn * 64; nkeys = 256;
    } else if (w < 6144 + 256 + 768 + 256) {
        type = 3; const int x = w - 7168; const int i = x & 15, hh = (x >> 4) & 1; b = x >> 5;
        qrow = NL + b * CTXL + (i * 17) % 256; qc = 2688 + hh * 64; kcol = PC_GQK + hh * 64; tcol = TC_GQV + hh * 64; ocol = PC_GQQ + hh * 3 * 64; nkeys = 256;
    } else return;
    const float q = __uint_as_float(((uint32_t)P[(size_t)qrow * PW + qc + lane]) << 16);
    float o = 0.f;
    int rs = gr - 4; rs = rs < 0 ? 0 : (rs > 56 ? 56 : rs);
    int cs = gc - 8; cs = cs < 0 ? 0 : (cs > 48 ? 48 : cs);
    float mx = -1e30f, lsum = 0.f;
    for (int kidx = 0; kidx < nkeys; ++kidx) {
        int u; float bias = 0.f;
        if (type == 0) {
            if (kidx < 128) {
                const int ri = kidx >> 4, ci = kidx & 15;
                u = (rs + ri) * 64 + cs + ci;
                bias = p.na_rpb[(size_t)(l * 6 + hn) * 465 + (rs + ri - gr + 7) * 31 + (cs + ci - gc + 15)];
            } else u = SEQ + (kidx - 128);
        } else if (type == 1) u = kidx;
        else u = SEQ + kidx;
        const int krow = rowof(b, u);
        float sdot = wave_sum(q * __uint_as_float(((uint32_t)P[(size_t)krow * PW + kcol + lane]) << 16));
        sdot += bias;
        const float mn = fmaxf(mx, sdot);
        const float al = expf(mx - mn), e = expf(sdot - mn);
        lsum = lsum * al + e; mx = mn;
        o = o * al + e * __uint_as_float(((uint32_t)T[((size_t)(b * TW + tcol + lane)) * UT + u]) << 16);
    }
    const float got = __uint_as_float(((uint32_t)P[(size_t)qrow * PW + ocol + lane]) << 16);
    float md = wave_max(fabsf(o / lsum - got));
    if (lane == 0) atomicMax(dw + 2 + type, __float_as_uint(md));
}
__global__ void dbg_copy(Params p) {
    u16* P = WSP(u16, OFF_P);
    for (size_t i = (size_t)blockIdx.x * 256 + VTID; i < (size_t)MTOT * 768; i += (size_t)gridDim.x * 256) {
        const size_t row = i / 768, c = i % 768;
        const size_t src = c < 640 ? c : (c < 704 ? PC_GQQ + (c - 640) : PC_GQQ + 192 + (c - 704));
        P[row * PW + 2048 + c] = P[row * PW + src];
    }
}
DEV int dbg_row(int sr) { return sr < 8 ? sr * 4096 + (sr * 577 + 13) % 4096 : NL + (sr - 8) * 256 + ((sr - 8) * 37 + 5) % 256; }
DEV float* dbg_xrow(const Params& p, int row) { return row < NL ? p.out + (size_t)row * D : WSP(float, OFF_XC) + (size_t)(row - NL) * D; }
DEV float dbg_mod(const Params& p, int l, int b9, int idx, int n) {
    float a = p.ada_b[l * 9216 + idx * 1024 + n];
    for (int k = 0; k < 1024; ++k) {
        const float c = b9 < 8 ? p.c[b9 * 1024 + k] : p.c_ctx[k];
        a += c / (1.f + expf(-c)) * p.ada_w[((size_t)l * 1024 + k) * 9216 + idx * 1024 + n];
    }
    return a;
}
DEV float blk_sum(float v, float* red) {
    v = wave_sum(v);
    __syncthreads();
    if ((VTID & 63) == 0) red[VTID >> 6] = v;
    __syncthreads();
    return red[0] + red[1] + red[2] + red[3];
}
DEV float blk_max(float v, float* red) {
    v = wave_max(v);
    __syncthreads();
    if ((VTID & 63) == 0) red[VTID >> 6] = v;
    __syncthreads();
    return fmaxf(fmaxf(red[0], red[1]), fmaxf(red[2], red[3]));
}
__global__ void dbg_save(Params p, int slot) {
    const int sr = blockIdx.x, row = dbg_row(sr);
    float* dst = (float*)(p.ws + OFF_DBG + 256) + ((size_t)slot * 16 + sr) * 1024;
    const float* src = dbg_xrow(p, row);
    for (int n = VTID; n < 1024; n += 256) dst[n] = src[n];
}
DEV float dbg_modulate(const Params& p, int l, int sub, int b9, const float* xs, float* hs, float* red) {
    float ss = 0.f;
    for (int n = VTID; n < 1024; n += 256) ss += xs[n] * xs[n];
    ss = blk_sum(ss, red);
    const float rstd = rsqrtf(ss / 1024.f + 1e-6f);
    float md = 0.f;
    for (int n = VTID; n < 1024; n += 256) {
        const float sh = dbg_mod(p, l, b9, 3 * sub, n), sc = dbg_mod(p, l, b9, 3 * sub + 1, n);
        md = fmaxf(md, fabsf(sh - WSP(float, OFF_MODS)[b9 * 9216 + (3 * sub) * 1024 + n]));
        md = fmaxf(md, fabsf(sc - WSP(float, OFF_MODS)[b9 * 9216 + (3 * sub + 1) * 1024 + n]));
        hs[n] = xs[n] * rstd * p.norm_w[(l * 3 + sub) * 1024 + n] * (1.f + sc) + sh;
    }
    __syncthreads();
    return md;
}
__global__ void __launch_bounds__(256) dbg_ffn(Params p, int l, int which, int slot, int bit) {
    __shared__ float xs[1024], hs[1024], gs[1024], as[2816], red[4];
    const int sr = blockIdx.x, row = dbg_row(sr), b9 = row < NL ? row >> 12 : 8, sub = which ? 2 : 0;
    const float* xin = (const float*)(p.ws + OFF_DBG + 256) + ((size_t)slot * 16 + sr) * 1024;
    for (int n = VTID; n < 1024; n += 256) xs[n] = xin[n];
    __syncthreads();
    float mdm = dbg_modulate(p, l, sub, b9, xs, hs, red);
    for (int n = VTID; n < 1024; n += 256) gs[n] = dbg_mod(p, l, b9, 3 * sub + 2, n);
    const float* win = p.ffn_w_in + (size_t)(l * 2 + which) * 1024 * 5632;
    const float* wout = p.ffn_w_out + (size_t)(l * 2 + which) * 2816 * 1024;
    for (int j = VTID; j < 2816; j += 256) {
        float g = 0.f, u = 0.f;
        for (int k = 0; k < 1024; ++k) { g += hs[k] * win[(size_t)k * 5632 + j]; u += hs[k] * win[(size_t)k * 5632 + 2816 + j]; }
        as[j] = g / (1.f + expf(-g)) * u;
    }
    __syncthreads();
    float md = 0.f;
    const float* xc = dbg_xrow(p, row);
    for (int n = VTID; n < 1024; n += 256) {
        float o = 0.f;
        for (int j = 0; j < 2816; ++j) o += as[j] * wout[(size_t)j * 1024 + n];
        md = fmaxf(md, fabsf(xs[n] + 0.5f * gs[n] * o - xc[n]));
    }
    md = blk_max(md, red);
    mdm = blk_max(mdm, red);
    unsigned* dw = (unsigned*)(p.ws + OFF_DBG);
    if (VTID == 0) { atomicMax(dw + bit, __float_as_uint(md)); atomicMax(dw + 15, __float_as_uint(mdm)); }
}
__global__ void __launch_bounds__(256) dbg_pchk(Params p, int l) {
    __shared__ float xs[1024], hs[1024], red[4];
    const int sr = blockIdx.x, row = dbg_row(sr), b9 = row < NL ? row >> 12 : 8;
    const float* xin = dbg_xrow(p, row);
    for (int n = VTID; n < 1024; n += 256) xs[n] = xin[n];
    __syncthreads();
    float mdm = dbg_modulate(p, l, 1, b9, xs, hs, red);
    const float* w = p.mix_w_in + (size_t)l * 1024 * NIN;
    const u16* P = WSP(u16, OFF_P); const u16* T = WSP(u16, OFF_T);
    int b, u;
    if (row < NL) { b = row >> 12; u = row & 4095; } else { b = (row - NL) >> 8; u = SEQ + ((row - NL) & 255); }
    float md = 0.f;
    for (int n = VTID; n < 2832; n += 256) {
        const int sc = map_col(2, n);
        float v = 0.f;
        for (int k = 0; k < 1024; ++k) v += hs[k] * w[(size_t)k * NIN + sc];
        if (n < 2048) md = fmaxf(md, fabsf(v - __uint_as_float(((uint32_t)P[(size_t)row * PW + n]) << 16)));
        if (n >= 1280 && n < 1536) md = fmaxf(md, fabsf(v - __uint_as_float(((uint32_t)T[((size_t)(b * TW + n - 1280)) * UT + u]) << 16)));
        if (n >= 2048 && n < 2816) md = fmaxf(md, fabsf(v - __uint_as_float(((uint32_t)T[((size_t)(b * TW + n - 1792)) * UT + u]) << 16)));
        if (n >= 2816) md = fmaxf(md, fabsf(v - WSP(float, OFF_G)[(size_t)row * 16 + n - 2816]));
    }
    md = blk_max(md, red);
    mdm = blk_max(mdm, red);
    unsigned* dw = (unsigned*)(p.ws + OFF_DBG);
    if (VTID == 0) { atomicMax(dw + 9, __float_as_uint(md)); atomicMax(dw + 15, __float_as_uint(mdm)); }
}
__global__ void __launch_bounds__(256) dbg_mix(Params p, int l, int slot) {
    __shared__ float xs[1024], hs[1024], os[1024], ys[1024], red[4];
    const int sr = blockIdx.x, row = dbg_row(sr), b9 = row < NL ? row >> 12 : 8;
    const float* xin = (const float*)(p.ws + OFF_DBG + 256) + ((size_t)slot * 16 + sr) * 1024;
    const u16* P = WSP(u16, OFF_P);
    for (int n = VTID; n < 1024; n += 256) { xs[n] = xin[n]; os[n] = __uint_as_float(((uint32_t)P[(size_t)row * PW + n]) << 16); }
    __syncthreads();
    float mdm = dbg_modulate(p, l, 1, b9, xs, hs, red);
    const float* w = p.mix_w_in + (size_t)l * 1024 * NIN;
    for (int n = VTID; n < 1024; n += 256) {
        float y = 0.f;
        for (int i = 0; i < 3; ++i) {
            float g = 0.f;
            for (int k = 0; k < 1024; ++k) g += hs[k] * w[(size_t)k * NIN + 2832 + i * 1024 + n];
            g = 1.f / (1.f + expf(-g));
            const float* wb = i == 0 ? p.w_br_ml + (size_t)l * 256 * 1024 : (i == 1 ? p.w_br_na + (size_t)l * 384 * 1024 : p.w_br_gq + (size_t)l * 384 * 1024);
            const int ko = i == 0 ? 0 : (i == 1 ? 256 : 640), kk = i == 0 ? 256 : 384;
            float a = 0.f;
            for (int k = 0; k < kk; ++k) a += os[ko + k] * wb[(size_t)k * 1024 + n];
            y += g * a;
        }
        ys[n] = y;
    }
    __syncthreads();
    float md = 0.f;
    const float* xc = dbg_xrow(p, row);
    for (int n = VTID; n < 1024; n += 256) {
        float o = 0.f;
        for (int k = 0; k < 1024; ++k) o += ys[k] * p.w_out[((size_t)l * 1024 + k) * 1024 + n];
        const float g5 = dbg_mod(p, l, b9, 5, n);
        md = fmaxf(md, fabsf(xs[n] + g5 * o - xc[n]));
    }
    md = blk_max(md, red);
    mdm = blk_max(mdm, red);
    unsigned* dw = (unsigned*)(p.ws + OFF_DBG);
    if (VTID == 0) { atomicMax(dw + 10, __float_as_uint(md)); atomicMax(dw + 15, __float_as_uint(mdm)); }
}
__global__ void dbg_fin(Params p) {
    const unsigned* dw = (const unsigned*)(p.ws + OFF_DBG);
    int mask = 0;
    if (__uint_as_float(dw[8]) > 0.02f) mask |= 1;
    if (__uint_as_float(dw[9]) > 0.03f) mask |= 2;
    if (__uint_as_float(dw[10]) > 0.02f) mask |= 4;
    if (__uint_as_float(dw[11]) > 0.02f) mask |= 8;
    if (__uint_as_float(dw[15]) > 1e-3f) mask |= 16;
    if (__uint_as_float(dw[4]) > 0.03f) mask |= 32;
    p.out[0] += 10.f * (float)mask;
    p.out[1] += 1000.f * __uint_as_float(dw[4]);
}
#endif


DEV void gemm8b_accum(f32x4 (&acc)[4][4], const u16* __restrict__ A, int lda, const u16* __restrict__ B, int ldb, int K, char* smem, int tid) {
    constexpr int STAGE = 49152;
    const int lane = tid & 63, wave = tid >> 6;
    const int wm = wave >> 1, wn = wave & 1, fr = lane & 15, fq = lane >> 4;
    const int lr = lane >> 3, pos = lane & 7;
    const int ce = pos ^ (lr >> 1), co = pos ^ (4 | (lr >> 1));
    const unsigned ra_ = (unsigned)((wave * 32 + lr) * lda) * 2u, rb_ = (unsigned)((wave * 16 + lr) * ldb) * 2u;
    const unsigned voa_e = ra_ + ce * 16, voa_o = ra_ + co * 16, vob_e = rb_ + ce * 16, vob_o = rb_ + co * 16;
    const int nk = K >> 6;
    const unsigned ldsb = (unsigned)(size_t)(__attribute__((address_space(3))) char*)smem;
    const unsigned ldsa_w = __builtin_amdgcn_readfirstlane(ldsb + wave * 4096);
    const unsigned ldsb_w = __builtin_amdgcn_readfirstlane(ldsb + 32768 + wave * 2048);
#define G8B_ISSUE(STG, K0) do { \
        _Pragma("unroll") for (int i = 0; i < 4; ++i) glds16(A + (size_t)(8 * i) * lda + (K0), (i & 1) ? voa_o : voa_e, ldsa_w + (STG) * STAGE + i * 1024); \
        _Pragma("unroll") for (int i = 0; i < 2; ++i) glds16(B + (size_t)(8 * i) * ldb + (K0), (i & 1) ? vob_o : vob_e, ldsb_w + (STG) * STAGE + i * 1024); \
    } while (0)
    G8B_ISSUE(0, 0);
    VM_WAIT0();
    __syncthreads();
    const int s3 = (fr >> 1) & 7;
    const int oa_base = (wm * 64 + fr) * 128 + ((fq ^ s3) * 16);
    const int ob_base = 32768 + (wn * 64 + fr) * 128 + ((fq ^ s3) * 16);
    for (int kt = 0; kt < nk; ++kt) {
        const int cur = kt & 1;
        const int k0 = (kt + 1 < nk ? kt + 1 : kt) * 64;
        G8B_ISSUE(cur ^ 1, k0);
        int o_a = cur * STAGE + oa_base, o_b = cur * STAGE + ob_base;
        asm volatile("" : "+v"(o_a), "+v"(o_b));
#pragma unroll
        for (int ks = 0; ks < 2; ++ks) {
            const char* sa_c = smem + (ks ? (o_a ^ 64) : o_a);
            const char* sb_c = smem + (ks ? (o_b ^ 64) : o_b);
            bf16x8 bfr[4], af[4];
#pragma unroll
            for (int nt = 0; nt < 4; ++nt) bfr[nt] = *(const bf16x8*)(sb_c + nt * 2048);
#pragma unroll
            for (int mt = 0; mt < 4; ++mt) af[mt] = *(const bf16x8*)(sa_c + mt * 2048);
#pragma unroll
            for (int mt = 0; mt < 4; ++mt)
#pragma unroll
                for (int nt = 0; nt < 4; ++nt) acc[mt][nt] = mfma16(af[mt], bfr[nt], acc[mt][nt]);
            __builtin_amdgcn_sched_group_barrier(0x100, 7, 0);
            __builtin_amdgcn_sched_group_barrier(0x008, 4, 0);
            __builtin_amdgcn_sched_group_barrier(0x100, 1, 0);
#pragma unroll
            for (int i = 0; i < 3; ++i) __builtin_amdgcn_sched_group_barrier(0x008, 4, 0);
        }
        VM_WAIT0();
        __syncthreads();
    }
#undef G8B_ISSUE
}

DEV void ph_merge8(const Params& p, char* smem, int rvid, int RG, int tid) {
    const u16* H = WSP(u16, OFF_H);
    u16* P = WSP(u16, OFF_P);
    const u16* Wg = WSP(u16, OFF_W) + WE_MIX + (size_t)2944 * 1024;
    const u16* Wbr = WSP(u16, OFF_W) + WE_BR;
    const int lane = tid & 63, wave = tid >> 6, wm = wave >> 1, wn = wave & 1, fr = lane & 15, fq = lane >> 4;
    const int total = 128 * 8;
    for (int t = rvid; t < total; t += RG) {
        const int gi = t >> 5, rem = t & 31;
        const int mt_ = gi * 4 + (rem & 3), nt_ = rem >> 2;
        const int m0 = mt_ * 256, n0 = nt_ * 128;
        f32x4 y[4][4];
        zero_acc<4>(y);
#pragma unroll 1
        for (int br = 0; br < 3; ++br) {
            const int ko = br == 0 ? 0 : (br == 1 ? 256 : 640);
            const int kk = br == 0 ? 256 : 384;
            uint32_t gpk[4][4][2];
            {
                f32x4 g[4][4];
                zero_acc<4>(g);
                gemm8b_accum(g, H + (size_t)m0 * D, D, Wg + (size_t)(br * 1024 + n0) * D, D, D, smem, tid);
#pragma unroll
                for (int i = 0; i < 4; ++i)
#pragma unroll
                    for (int jn = 0; jn < 4; ++jn) {
                        gpk[i][jn][0] = pk2(sigmoidf_(g[i][jn][0]), sigmoidf_(g[i][jn][1]));
                        gpk[i][jn][1] = pk2(sigmoidf_(g[i][jn][2]), sigmoidf_(g[i][jn][3]));
                    }
            }
            f32x4 a[4][4];
            zero_acc<4>(a);
            gemm8b_accum(a, P + (size_t)m0 * PW + ko, PW, Wbr + (size_t)n0 * D + ko, D, kk, smem, tid);
#pragma unroll
            for (int i = 0; i < 4; ++i)
#pragma unroll
                for (int jn = 0; jn < 4; ++jn) {
                    y[i][jn][0] += bflo(gpk[i][jn][0]) * a[i][jn][0];
                    y[i][jn][1] += bfhi(gpk[i][jn][0]) * a[i][jn][1];
                    y[i][jn][2] += bflo(gpk[i][jn][1]) * a[i][jn][2];
                    y[i][jn][3] += bfhi(gpk[i][jn][1]) * a[i][jn][3];
                }
        }
#pragma unroll
        for (int mt = 0; mt < 4; ++mt)
#pragma unroll
            for (int nt = 0; nt < 4; ++nt)
#pragma unroll
                for (int r = 0; r < 4; ++r) {
                    const int row = m0 + wm * 64 + mt * 16 + fq * 4 + r;
                    const int col = n0 + wn * 64 + nt * 16 + fr;
                    P[(size_t)row * PW + PC_Y + col] = (u16)(pk2(y[mt][nt][r], 0.f) & 0xffff);
                }
    }
}

constexpr int PH_PER_LAYER = 15;
constexpr int N_PHASES = 2 * PH_PER_LAYER;

#ifndef REPEAT_MASK
#define REPEAT_MASK 0
#endif
template <int Q>
DEV void run_phase_q(const Params& p, int l, char* smem) {
    const int half = (int)((threadIdx.x + p.z) >> 8);
    const int G = gridDim.x * 2, bid = blockIdx.x * 2 + half;
    const int vid = (gridDim.x % 8 == 0) ? (int)(blockIdx.x & 7) * (G >> 3) + (int)(blockIdx.x >> 3) * 2 + half : bid;
    smem += half * 73728;
    const bool last = (l == 1);
    const u16* W = WSP(u16, OFF_W);
    const int nrep = ((REPEAT_MASK >> Q) & 1) ? 2 : 1;
    char* smem0 = smem - half * 73728;
    const int rtid = (int)(threadIdx.x + p.z);
    const int RG = gridDim.x;
    const int rvid = (RG % 8 == 0) ? (int)(blockIdx.x & 7) * (RG >> 3) + (int)(blockIdx.x >> 3) : (int)blockIdx.x;
    for (int rep = 0; rep < nrep; ++rep) {
        const float cm = rep ? 0.f : 1.f;
        if (Q == 0) ph_prep(p, l, smem, bid, G);
        if (Q == 1) ph_mod(p, l, 0, MTOT, bid, G);
        Params p2 = p;
        if (Q == 2) { ph_ffn_in8(p, 0, 136, smem0, rvid, RG, rtid); }
        if (Q == 3) { ph_resid8(p, WSP(u16, OFF_P), DFF, W + WE_OUT0, DFF, 2, 0.5f * cm, smem0, rvid, RG, rtid, l == 0 ? p.x : p.out); int z2 = p.z; asm volatile("" : "+s"(z2) :: "memory"); p2.z = z2;
                      ph_resid(p2, WSP(u16, OFF_P), DFF, W + WE_OUT0, DFF, 2, 0.5f * cm, 256, 16, smem, vid, G); }
        if (Q == 4) ph_mod(p, l, 1, MTOT, bid, G);
        if (Q == 5) { ph_pgemm8(p, l, smem0, rvid, RG, rtid); int z2 = p.z; asm volatile("" : "+s"(z2) :: "memory"); p2.z = z2; ph_pgemm(p2, 256, 16, smem, vid, G); }
        if (Q == 6) ph_qknorm_gates(p, l, bid, G);
        if (Q == 7) { ph_attn8(p, l, smem0, rvid, RG); int z2 = p.z; asm volatile("" : "+s"(z2) :: "memory"); p2.z = z2; ph_attn(p2, l, smem, bid, G, rep); }
        if (Q == 8) ph_m3(p, bid, G);
        if (Q == 9) ph_m4(p, l, bid, G, rep);
        if (Q == 10) { ph_merge8(p, smem0, rvid, RG, rtid); int z2 = p.z; asm volatile("" : "+s"(z2) :: "memory"); p2.z = z2; if (!last) ph_merge(p2, 256, 16, smem, vid, G); }
        if (Q == 11) { ph_resid8(p, WSP(u16, OFF_P) + PC_Y, PW, W + WE_O, D, 5, 1.0f * cm, smem0, rvid, RG, rtid, p.out);
                       int z2 = p.z; asm volatile("" : "+s"(z2) :: "memory"); p2.z = z2;
                       if (!last) ph_resid(p2, WSP(u16, OFF_P) + PC_Y, PW, W + WE_O, D, 5, 1.0f * cm, 256, 16, smem, vid, G); }
        if (Q == 12) ph_mod(p, l, 2, last ? NL : MTOT, bid, G);
        if (Q == 13) { ph_ffn_in8(p, 1, last ? 128 : 136, smem0, rvid, RG, rtid); }
        if (Q == 14) { ph_resid8(p, WSP(u16, OFF_P), DFF, W + WE_OUT1, DFF, 8, 0.5f * cm, smem0, rvid, RG, rtid, p.out);
                       int z2 = p.z; asm volatile("" : "+s"(z2) :: "memory"); p2.z = z2;
                       if (!last) ph_resid(p2, WSP(u16, OFF_P), DFF, W + WE_OUT1, DFF, 8, 0.5f * cm, 256, 16, smem, vid, G); }
    }
}

DEV void run_phase(const Params& p, int ph, char* smem) {
    const int l = ph / PH_PER_LAYER, q = ph % PH_PER_LAYER;
    switch (q) {
        case 0: run_phase_q<0>(p, l, smem); break;
        case 1: run_phase_q<1>(p, l, smem); break;
        case 2: run_phase_q<2>(p, l, smem); break;
        case 3: run_phase_q<3>(p, l, smem); break;
        case 4: run_phase_q<4>(p, l, smem); break;
        case 5: run_phase_q<5>(p, l, smem); break;
        case 6: run_phase_q<6>(p, l, smem); break;
        case 7: run_phase_q<7>(p, l, smem); break;
        case 8: run_phase_q<8>(p, l, smem); break;
        case 9: run_phase_q<9>(p, l, smem); break;
        case 10: run_phase_q<10>(p, l, smem); break;
        case 11: run_phase_q<11>(p, l, smem); break;
        case 12: run_phase_q<12>(p, l, smem); break;
        case 13: run_phase_q<13>(p, l, smem); break;
        case 14: run_phase_q<14>(p, l, smem); break;
    }
}

template <int Q>
__global__ void __launch_bounds__(256, 2) phase_kernel(Params p, int l) {
    __shared__ __attribute__((aligned(16))) char smem[73728];
    run_phase_q<Q>(p, l, smem);
}

#if ONE_LAUNCH
#define XB_TMO      128
#define XB_XCNT(j)  (256  + 64 * (j))
#define XB_XSUB(j)  (1280 + 64 * (j))
#define XB_XGEN(j)  (2304 + 64 * (j))
#define XB_TOP      3328
#define XB_TOPGEN   3392
#define XB_SPIN_CAP (1u << 22)
DEV unsigned xb_ld(unsigned* q) { return __hip_atomic_load(q, __ATOMIC_RELAXED, __HIP_MEMORY_SCOPE_AGENT); }
DEV unsigned xb_add(unsigned* q, unsigned v) { return __hip_atomic_fetch_add(q, v, __ATOMIC_RELAXED, __HIP_MEMORY_SCOPE_AGENT); }
DEV unsigned xb_xcc_id() { return (unsigned)__builtin_amdgcn_s_getreg((3 << 11) | 20) & 0xFu; }
#define XB_SPIN(cond, bar) do { unsigned _sp = 0; while (cond) { __builtin_amdgcn_s_sleep(1); \
    if ((++_sp & 255u) == 0u) { if (xb_ld(&(bar)[XB_TMO])) break; if (_sp > XB_SPIN_CAP) { atomicAdd(&(bar)[XB_TMO], 1u); break; } } } } while (0)
DEV void xcd_census(unsigned* bar, unsigned x, unsigned& nloc, unsigned& nx) {
    const unsigned G = gridDim.x;
    unsigned sum, cnt, mine, sp = 0u;
    for (;;) {
        sum = 0u; cnt = 0u; mine = 0u;
#pragma unroll
        for (unsigned j = 0; j < 16; ++j) { const unsigned c = xb_ld(&bar[XB_XCNT(j)]); sum += c; cnt += (c > 0u) ? 1u : 0u; mine = (j == x) ? c : mine; }
        if (sum == G) break;
        __builtin_amdgcn_s_sleep(1);
        if ((++sp & 255u) == 0u) { if (xb_ld(&bar[XB_TMO])) break; if (sp > XB_SPIN_CAP) { atomicAdd(&bar[XB_TMO], 1u); break; } }
    }
    nloc = mine > 0u ? mine : 1u; nx = cnt > 0u ? cnt : 1u;
}
DEV void xcd_barrier(unsigned* bar, unsigned x, volatile unsigned* st, int tid) {
    asm volatile("s_waitcnt vmcnt(0)" ::: "memory");
    __syncthreads();
    if (tid == 0) {
        __builtin_amdgcn_s_waitcnt(0);
        unsigned nloc = st[0], nx = st[1];
        if (nloc == 0u) { xcd_census(bar, x, nloc, nx); st[0] = nloc; st[1] = nx; }
        const unsigned old = xb_add(&bar[XB_XSUB(x)], 1u);
        const unsigned gen = old / nloc;
        if (old + 1u == (gen + 1u) * nloc) {
            __builtin_amdgcn_fence(__ATOMIC_RELEASE, "agent");
            asm volatile("s_waitcnt vmcnt(0)" ::: "memory");
            const unsigned og = xb_add(&bar[XB_TOP], 1u);
            const unsigned tg = og / nx;
            if (og + 1u == (tg + 1u) * nx) xb_add(&bar[XB_TOPGEN], 1u);
            else XB_SPIN(xb_ld(&bar[XB_TOPGEN]) == tg, bar);
            __builtin_amdgcn_fence(__ATOMIC_ACQUIRE, "agent");
            xb_add(&bar[XB_XGEN(x)], 1u);
            asm volatile("s_waitcnt vmcnt(0)" ::: "memory");
        } else {
            XB_SPIN(xb_ld(&bar[XB_XGEN(x)]) == gen, bar);
            __builtin_amdgcn_fence(__ATOMIC_ACQUIRE, "agent");
            asm volatile("s_waitcnt vmcnt(0)" ::: "memory");
        }
    }
    __syncthreads();
}
__global__ void __launch_bounds__(512, 2) mega_kernel(Params p0, int ph_begin, int ph_end) {
    __shared__ __attribute__((aligned(16))) char smem[147456];
    __shared__ uint4 xb_words;
    unsigned* bar = (unsigned*)(p0.ws + OFF_BAR);
    const unsigned xcc = xb_xcc_id();
    if (threadIdx.x == 0) { xb_words = make_uint4(0u, 0u, 0u, 0u); (void)xb_add(&bar[XB_XCNT(xcc)], 1u); }
    __syncthreads();
    for (int ph = ph_begin; ph < ph_end; ++ph) {
        Params p = p0;
        int z = p0.z;
        asm volatile("" : "+s"(z));
        p.z = z;
        p.ws = p0.ws + z;
        p.out = p0.out + z;
        run_phase(p, ph, smem);
        if (ph + 1 < ph_end) {
            if (p0.z == 0x7fffffff) cg::this_grid().sync();
            xcd_barrier(bar, xcc, (volatile unsigned*)&xb_words, (int)threadIdx.x + z);
        }
    }
}
#endif

extern "C" void kernel_launch(void* const* d_in, const int* in_sizes, int n_in, void* d_out, int out_size, void* d_ws, size_t ws_size,
                              hipStream_t stream) {
    if (ws_size < WS_END) { fprintf(stderr, "workspace too small: %zu < %zu\n", ws_size, (size_t)WS_END); return; }
    Params p{};
    p.x = (const float*)d_in[0]; p.c = (const float*)d_in[1]; p.ctx = (const float*)d_in[2]; p.c_ctx = (const float*)d_in[3];
    p.ada_w = (const float*)d_in[4]; p.ada_b = (const float*)d_in[5]; p.norm_w = (const float*)d_in[6];
    p.ffn_w_in = (const float*)d_in[7]; p.ffn_w_out = (const float*)d_in[8]; p.mix_w_in = (const float*)d_in[9];
    p.ml_gate_b = (const float*)d_in[10]; p.ml_norm_w = (const float*)d_in[11]; p.na_qk_w = (const float*)d_in[12];
    p.na_rpb = (const float*)d_in[13]; p.gq_qk_w = (const float*)d_in[14]; p.w_br_ml = (const float*)d_in[15];
    p.w_br_na = (const float*)d_in[16]; p.w_br_gq = (const float*)d_in[17]; p.w_out = (const float*)d_in[18];
    p.out = (float*)d_out; p.ws = (char*)d_ws;
#ifdef NANFILL
    hipMemsetAsync(d_ws, 0xFF, WS_END, stream);
#endif
#if ONE_LAUNCH
    static int grid_blocks = 0;
    if (!grid_blocks) {
        int dev = 0, cus = 0, per_cu = 0;
        hipGetDevice(&dev);
        hipDeviceGetAttribute(&cus, hipDeviceAttributeMultiprocessorCount, dev);
        hipOccupancyMaxActiveBlocksPerMultiprocessor(&per_cu, mega_kernel, 512, 0);
        per_cu = 1;
        grid_blocks = cus * per_cu;
    }
    hipMemsetAsync((char*)d_ws + OFF_BAR, 0, 3456 * 4, stream);
    int pb = 0, pe = N_PHASES;
    void* args[] = {&p, &pb, &pe};
#ifdef SPLIT_TEST
    (void)args;
    for (int ph = 0; ph < N_PHASES; ++ph) mega_kernel<<<grid_blocks, 256, 0, stream>>>(p, ph, ph + 1);
#else
    hipError_t e = hipLaunchCooperativeKernel((void*)mega_kernel, dim3(grid_blocks), dim3(512), args, 0, stream);
    if (e != hipSuccess) fprintf(stderr, "cooperative launch failed: %s (grid %d)\n", hipGetErrorString(e), grid_blocks);
#endif
#else
    for (int l = 0; l < 2; ++l) {
#define LP(Q) phase_kernel<Q><<<512, 256, 0, stream>>>(p, l)
#ifdef DBG
        const bool dl = (l == DBG_LAYER);
        if (dl) hipMemsetAsync((char*)d_ws + OFF_DBG, 0, 256, stream);
        LP(0);
        if (dl) dbg_save<<<16, 256, 0, stream>>>(p, 0);
        LP(1); LP(2); LP(3);
        if (dl) dbg_ffn<<<16, 256, 0, stream>>>(p, l, 0, 0, 8);
        LP(4); LP(5);
        if (dl) dbg_pchk<<<16, 256, 0, stream>>>(p, l);
        LP(6);
        if (dl) dbg_copy<<<2048, 256, 0, stream>>>(p);
        LP(7); LP(8); LP(9);
        if (dl) {
            dbg_mlstm<<<64, 64, 0, stream>>>(p, l);
            dbg_cmp<<<(NB * 4 * UT + 7424 * 64 + 255) / 256, 256, 0, stream>>>(p, l);
            dbg_save<<<16, 256, 0, stream>>>(p, 1);
        }
        LP(10); LP(11);
        if (dl) { dbg_mix<<<16, 256, 0, stream>>>(p, l, 1); dbg_save<<<16, 256, 0, stream>>>(p, 2); }
        LP(12); LP(13); LP(14);
        if (dl) dbg_ffn<<<16, 256, 0, stream>>>(p, l, 1, 2, 11);
#else
        LP(0); LP(1); LP(2); LP(3); LP(4); LP(5); LP(6); LP(7); LP(8); LP(9); LP(10); LP(11); LP(12); LP(13); LP(14);
#endif
#undef LP
    }
#ifdef DBG
    dbg_fin<<<1, 1, 0, stream>>>(p);
#endif
#endif
}
```

```cpp
#include <hip/hip_runtime.h>
#include <hip/hip_cooperative_groups.h>
#include <stdint.h>
#include <cstdio>
namespace cg = cooperative_groups;

#ifndef ONE_LAUNCH
#define ONE_LAUNCH 1
#endif

#define VTID ((int)((threadIdx.x + p.z) & 255))
typedef unsigned short u16;
typedef __attribute__((ext_vector_type(8))) short bf16x8;
typedef __attribute__((ext_vector_type(4))) float f32x4;
#define DEV __device__ __forceinline__

constexpr int D = 1024, NB = 8, SEQ = 4096, CTXL = 256;
constexpr int NL = NB * SEQ, NCX = NB * CTXL, MTOT = NL + NCX;
constexpr int DFF = 2816, PW = 2816, UT = SEQ + CTXL, NCH = UT / 64;
constexpr int NIN = 5904;
constexpr int PC_MLQ = 0, PC_NAQ = 256, PC_GQQ = 640, PC_MLO = 1024, PC_MLK = 1280, PC_NAK = 1536, PC_GQK = 1920,
              PC_MLV = 2048, PC_NAV = 2304, PC_GQV = 2688, PC_Y = 1024;
constexpr int TC_MLK = 0, TC_MLV = 256, TC_NAV = 512, TC_GQV = 896, TW = 1024;
constexpr int DBG_MLO = PC_MLQ, DBG_NAO = PC_NAQ;
constexpr int SCH = 4160;
constexpr int NSCAN = 64;

constexpr size_t al256(size_t x) { return (x + 255) & ~(size_t)255; }
constexpr size_t OFF_MODS = 0;
constexpr size_t OFF_ROPE = al256(OFF_MODS + (size_t)9 * 9216 * 4);
constexpr size_t OFF_G    = al256(OFF_ROPE + (size_t)4096 * 64 * 4);
constexpr size_t OFF_BC   = al256(OFF_G + (size_t)MTOT * 16 * 4);
constexpr size_t OFF_IG   = al256(OFF_BC + (size_t)NSCAN * UT * 4);
constexpr size_t OFF_AE   = al256(OFF_IG + (size_t)NSCAN * UT * 4);
constexpr size_t OFF_MS   = al256(OFF_AE + (size_t)NSCAN * UT * 4);
constexpr size_t OFF_DEC  = al256(OFF_MS + (size_t)NSCAN * NCH * 4);
constexpr size_t OFF_XC   = al256(OFF_DEC + (size_t)NSCAN * NCH * 4);
constexpr size_t OFF_H    = al256(OFF_XC + (size_t)NCX * D * 4);
constexpr size_t OFF_P    = al256(OFF_H + (size_t)MTOT * D * 2);
constexpr size_t OFF_T    = al256(OFF_P + (size_t)MTOT * PW * 2);
constexpr size_t OFF_S    = al256(OFF_T + (size_t)NB * TW * UT * 2);
constexpr size_t OFF_W    = al256(OFF_S + (size_t)NSCAN * NCH * SCH * 4);
constexpr size_t WE_IN0 = 0, WE_IN1 = WE_IN0 + (size_t)5632 * 1024, WE_OUT0 = WE_IN1 + (size_t)5632 * 1024,
                 WE_OUT1 = WE_OUT0 + (size_t)1024 * 2816, WE_MIX = WE_OUT1 + (size_t)1024 * 2816,
                 WE_BR = WE_MIX + (size_t)6016 * 1024, WE_O = WE_BR + (size_t)1024 * 1024, WE_END = WE_O + (size_t)1024 * 1024;
constexpr size_t OFF_BAR = al256(OFF_W + WE_END * 2);
constexpr size_t OFF_PART = al256(OFF_BAR + 3456 * 4);
constexpr size_t WS_END = OFF_PART + (size_t)4 * NCX * D * 4;
static_assert(WS_END < (size_t)536000000, "workspace too large");

struct Params {
    const float *x, *c, *ctx, *c_ctx, *ada_w, *ada_b, *norm_w, *ffn_w_in, *ffn_w_out, *mix_w_in, *ml_gate_b, *ml_norm_w,
        *na_qk_w, *na_rpb, *gq_qk_w, *w_br_ml, *w_br_na, *w_br_gq, *w_out;
    float* out;
    char* ws;
    int z, pad;
};

DEV uint32_t pk2(float lo, float hi) { uint32_t r; asm("v_cvt_pk_bf16_f32 %0, %1, %2" : "=v"(r) : "v"(lo), "v"(hi)); return r; }
DEV float bflo(uint32_t w) { return __uint_as_float(w << 16); }
DEV float bfhi(uint32_t w) { return __uint_as_float(w & 0xffff0000u); }
DEV f32x4 mfma16(bf16x8 a, bf16x8 b, f32x4 c) { return __builtin_amdgcn_mfma_f32_16x16x32_bf16(a, b, c, 0, 0, 0); }
typedef unsigned u32x4 __attribute__((ext_vector_type(4)));
DEV u32x4 gld16(const void* q) { u32x4 r; asm volatile("global_load_dwordx4 %0, %1, off" : "=v"(r) : "v"(q) : "memory"); return r; }
DEV u32x4 gld16s(const void* sbase, unsigned voff) { u32x4 r; asm volatile("global_load_dwordx4 %0, %1, %2" : "=v"(r) : "v"(voff), "s"(sbase) : "memory"); return r; }
DEV void glds16(const void* sbase, unsigned voff, unsigned ldsaddr) {
    asm volatile("s_mov_b32 m0, %2\n\ts_nop 0\n\tglobal_load_lds_dwordx4 %0, %1" :: "v"(voff), "s"(sbase), "s"(ldsaddr) : "memory", "m0");
}
#define VM_WAIT0() asm volatile("s_waitcnt vmcnt(0)" ::: "memory")
union Frag { bf16x8 v; uint4 q; uint32_t u[4]; uint2 d[2]; };
DEV int cu_of(int c, int dir) { return c < 4 ? 64 + (dir ? 3 - c : c) : (dir ? 63 - (c - 4) : (c - 4)); }
DEV int rowof(int b, int u) { return u < SEQ ? b * SEQ + u : NL + b * CTXL + (u - SEQ); }
DEV float fexp2(float x) { return __builtin_amdgcn_exp2f(x); }
DEV float fexp(float x) { return __builtin_amdgcn_exp2f(x * 1.4426950408889634f); }
DEV float sigmoidf_(float x) { return 1.f / (1.f + fexp(-x)); }
DEV float xq_max(float v) {
    auto r = __builtin_amdgcn_permlane16_swap(__float_as_uint(v), __float_as_uint(v), false, false);
    const float m = fmaxf(__uint_as_float(r[0]), __uint_as_float(r[1]));
    auto q = __builtin_amdgcn_permlane32_swap(__float_as_uint(m), __float_as_uint(m), false, false);
    return fmaxf(__uint_as_float(q[0]), __uint_as_float(q[1]));
}
DEV float xq_sum(float v) {
    auto r = __builtin_amdgcn_permlane16_swap(__float_as_uint(v), __float_as_uint(v), false, false);
    const float m = __uint_as_float(r[0]) + __uint_as_float(r[1]);
    auto q = __builtin_amdgcn_permlane32_swap(__float_as_uint(m), __float_as_uint(m), false, false);
    return __uint_as_float(q[0]) + __uint_as_float(q[1]);
}
DEV float wave_sum(float v) {
#pragma unroll
    for (int o = 1; o < 64; o <<= 1) v += __shfl_xor(v, o);
    return v;
}
DEV float wave_max(float v) {
#pragma unroll
    for (int o = 1; o < 64; o <<= 1) v = fmaxf(v, __shfl_xor(v, o));
    return v;
}

#define WSP(T_, off) ((T_*)(p.ws + (off)))
DEV float m_scan(const Params& p, int sc, int c_end) {
    const float* BT = WSP(float, OFF_MS) + sc * NCH;
    const float* MX = WSP(float, OFF_DEC) + sc * NCH;
    const int lane = VTID & 63;
    const float bt0 = BT[lane], mx0 = MX[lane], bt1 = BT[64 + (lane & 3)], mx1 = MX[64 + (lane & 3)];
    float m = 0.f;
    for (int c = 0; c < c_end; ++c) {
        const float b = c < 64 ? __shfl(bt0, c) : __shfl(bt1, c - 64);
        const float x = c < 64 ? __shfl(mx0, c) : __shfl(mx1, c - 64);
        m = fmaxf(b + m, x);
    }
    return m;
}

template <int TN>
DEV void gemm_accum(f32x4 (&acc)[4][TN], const u16* __restrict__ A, int lda, const u16* __restrict__ B, int ldb, int K, char* smem, int tid) {
    constexpr int BROWS = TN * 32;
    constexpr int STAGE = (128 + BROWS) * 144;
    constexpr int NBCH = BROWS / 32;
    const int lane = tid & 63, wave = tid >> 6;
    const int wm = wave >> 1, wn = wave & 1, fr = lane & 15, fq = lane >> 4;
    const int lrow = tid >> 3, lc8 = tid & 7;
    const u16* ga = A + (size_t)lrow * lda + lc8 * 8;
    const u16* gb = B + (size_t)lrow * ldb + lc8 * 8;
    u32x4 ra[4], rb[NBCH];
    const int nk = K >> 6;
#pragma unroll
    for (int i = 0; i < 4; ++i) ra[i] = gld16(ga + (size_t)(32 * i) * lda);
#pragma unroll
    for (int i = 0; i < NBCH; ++i) rb[i] = gld16(gb + (size_t)(32 * i) * ldb);
    char* sw = smem + lrow * 144 + lc8 * 16;
    VM_WAIT0();
#pragma unroll
    for (int i = 0; i < 4; ++i) *(u32x4*)(sw + i * 32 * 144) = ra[i];
#pragma unroll
    for (int i = 0; i < NBCH; ++i) *(u32x4*)(sw + 128 * 144 + i * 32 * 144) = rb[i];
    __syncthreads();
    const char* sa_r = smem + (wm * 64 + fr) * 144 + fq * 16;
    const char* sb_r = smem + 128 * 144 + (wn * TN * 16 + fr) * 144 + fq * 16;
    for (int kt = 0; kt < nk; ++kt) {
        const int cur = kt & 1;
        const int k0 = (kt + 1 < nk ? kt + 1 : kt) * 64;
#pragma unroll
        for (int i = 0; i < 4; ++i) ra[i] = gld16(ga + (size_t)(32 * i) * lda + k0);
#pragma unroll
        for (int i = 0; i < NBCH; ++i) rb[i] = gld16(gb + (size_t)(32 * i) * ldb + k0);
        __builtin_amdgcn_sched_barrier(0);
#pragma unroll
        for (int ks = 0; ks < 2; ++ks) {
            bf16x8 af[4], bfr[TN];
#pragma unroll
            for (int mt = 0; mt < 4; ++mt) af[mt] = *(const bf16x8*)(sa_r + cur * STAGE + mt * 16 * 144 + ks * 64);
#pragma unroll
            for (int nt = 0; nt < TN; ++nt) bfr[nt] = *(const bf16x8*)(sb_r + cur * STAGE + nt * 16 * 144 + ks * 64);
#pragma unroll
            for (int mt = 0; mt < 4; ++mt)
#pragma unroll
                for (int nt = 0; nt < TN; ++nt) acc[mt][nt] = mfma16(af[mt], bfr[nt], acc[mt][nt]);
        }
        __builtin_amdgcn_sched_barrier(0);
        VM_WAIT0();
        {
            char* sw2 = sw + (cur ^ 1) * STAGE;
#pragma unroll
            for (int i = 0; i < 4; ++i) *(u32x4*)(sw2 + i * 32 * 144) = ra[i];
#pragma unroll
            for (int i = 0; i < NBCH; ++i) *(u32x4*)(sw2 + 128 * 144 + i * 32 * 144) = rb[i];
        }
        __syncthreads();
    }
}

template <int TN>
DEV void zero_acc(f32x4 (&acc)[4][TN]) {
#pragma unroll
    for (int i = 0; i < 4; ++i)
#pragma unroll
        for (int j = 0; j < TN; ++j) acc[i][j] = f32x4{0.f, 0.f, 0.f, 0.f};
}

DEV void tile_decode(int t, int ntn, int& mt, int& nt) {
    const int per = 8 * ntn;
    const int gi = t / per, rem = t - gi * per;
    nt = rem >> 3;
    mt = gi * 8 + (rem & 7);
}


template <bool SWAP = false>
DEV void gemm8_accum(f32x4 (&acc)[8][4], const u16* __restrict__ A, int lda, const u16* __restrict__ B, int ldb, int K, char* smem, int tid) {
    constexpr int STAGE = 65536;
    const int lane = tid & 63, wave = tid >> 6;
    const int wm = wave >> 2, wn = wave & 3, fr = lane & 15, fq = lane >> 4;
    const int lr = lane >> 3, pos = lane & 7;
    const int ce = pos ^ (lr >> 1), co = pos ^ (4 | (lr >> 1));
    const unsigned ra_ = (unsigned)((wave * 32 + lr) * lda) * 2u, rb_ = (unsigned)((wave * 32 + lr) * ldb) * 2u;
    const unsigned voa_e = ra_ + ce * 16, voa_o = ra_ + co * 16, vob_e = rb_ + ce * 16, vob_o = rb_ + co * 16;
    const int nk = K >> 6;
    const unsigned ldsw = __builtin_amdgcn_readfirstlane((unsigned)(size_t)(__attribute__((address_space(3))) char*)smem + wave * 4096);
#define G8_ISSUE(STG, K0) do { \
        _Pragma("unroll") for (int i = 0; i < 4; ++i) { \
            glds16(A + (size_t)(8 * i) * lda + (K0), (i & 1) ? voa_o : voa_e, ldsw + (STG) * STAGE + i * 1024); \
            glds16(B + (size_t)(8 * i) * ldb + (K0), (i & 1) ? vob_o : vob_e, ldsw + (STG) * STAGE + 32768 + i * 1024); \
        } } while (0)
    G8_ISSUE(0, 0);
    VM_WAIT0();
    __syncthreads();
    const int s3 = (fr >> 1) & 7;
    const int oa_base = (wm * 128 + fr) * 128 + ((fq ^ s3) * 16);
    const int ob_base = 32768 + (wn * 64 + fr) * 128 + ((fq ^ s3) * 16);
    for (int kt = 0; kt < nk; ++kt) {
        const int cur = kt & 1;
        const int k0 = (kt + 1 < nk ? kt + 1 : kt) * 64;
        G8_ISSUE(cur ^ 1, k0);
        int o_a = cur * STAGE + oa_base, o_b = cur * STAGE + ob_base;
        asm volatile("" : "+v"(o_a), "+v"(o_b));
#pragma unroll
        for (int ks = 0; ks < 2; ++ks) {
            const char* sa_c = smem + (ks ? (o_a ^ 64) : o_a);
            const char* sb_c = smem + (ks ? (o_b ^ 64) : o_b);
            bf16x8 bfr[4], af[8];
#pragma unroll
            for (int nt = 0; nt < 4; ++nt) bfr[nt] = *(const bf16x8*)(sb_c + nt * 2048);
#pragma unroll
            for (int mt = 0; mt < 8; ++mt) af[mt] = *(const bf16x8*)(sa_c + mt * 2048);
#pragma unroll
            for (int mt = 0; mt < 8; ++mt)
#pragma unroll
                for (int nt = 0; nt < 4; ++nt) acc[mt][nt] = SWAP ? mfma16(bfr[nt], af[mt], acc[mt][nt]) : mfma16(af[mt], bfr[nt], acc[mt][nt]);
            __builtin_amdgcn_sched_group_barrier(0x100, 7, 0);
#pragma unroll
            for (int i = 0; i < 5; ++i) { __builtin_amdgcn_sched_group_barrier(0x008, 4, 0); __builtin_amdgcn_sched_group_barrier(0x100, 1, 0); }
#pragma unroll
            for (int i = 0; i < 3; ++i) __builtin_amdgcn_sched_group_barrier(0x008, 4, 0);
        }
        VM_WAIT0();
        __syncthreads();
    }
#undef G8_ISSUE
}
DEV void zero_acc8(f32x4 (&acc)[8][4]) {
#pragma unroll
    for (int i = 0; i < 8; ++i)
#pragma unroll
        for (int j = 0; j < 4; ++j) acc[i][j] = f32x4{0.f, 0.f, 0.f, 0.f};
}
DEV void tile_decode8(int t, int ntn, int& mt, int& nt) {
    const int per = 4 * ntn;
    const int gi = t / per, rem = t - gi * per;
    nt = rem >> 2;
    mt = gi * 4 + (rem & 3);
}

DEV void ph_ffn_in8(const Params& p, int which, int mtiles8, char* smem, int rvid, int RG, int tid) {
    const u16* H = WSP(u16, OFF_H);
    const u16* Wt = WSP(u16, OFF_W) + (which ? WE_IN1 : WE_IN0);
    u16* ACT = WSP(u16, OFF_P);
    const int lane = tid & 63, wave = tid >> 6, wm = wave >> 2, wn = wave & 3, fr = lane & 15, fq = lane >> 4;
    const int total = mtiles8 * 22;
    for (int t = rvid; t < total; t += RG) {
        int mt_, nt_;
        tile_decode8(t, 22, mt_, nt_);
        const int m0 = mt_ * 256, n0 = nt_ * 256;
        f32x4 acc[8][4];
        zero_acc8(acc);
        gemm8_accum(acc, H + (size_t)m0 * D, D, Wt + (size_t)n0 * D, D, D, smem, tid);
#pragma unroll
        for (int mt = 0; mt < 8; ++mt)
#pragma unroll
            for (int pp = 0; pp < 2; ++pp)
#pragma unroll
                for (int r = 0; r < 4; ++r) {
                    const int row = m0 + wm * 128 + mt * 16 + fq * 4 + r;
                    const int hid = (n0 >> 1) + wn * 32 + pp * 16 + fr;
                    const float g = acc[mt][2 * pp][r], u = acc[mt][2 * pp + 1][r];
                    const float v = g * sigmoidf_(g) * u;
                    ACT[(size_t)row * DFF + hid] = (u16)(pk2(v, 0.f) & 0xffff);
                }
    }
}
DEV void ph_resid8(const Params& p, const u16* A, int lda, const u16* Wt, int K, int modidx, float coef, char* smem, int rvid, int RG, int tid, const float* xsrc) {
    const float* mods = WSP(float, OFF_MODS);
    const int lane = tid & 63, wave = tid >> 6, wm = wave >> 2, wn = wave & 3, fr = lane & 15, fq = lane >> 4;
    const int total = 128 * 4;
    for (int t = rvid; t < total; t += RG) {
        int mt_, nt_;
        tile_decode8(t, 4, mt_, nt_);
        const int m0 = mt_ * 256, n0 = nt_ * 256;
        f32x4 acc[8][4];
        zero_acc8(acc);
        gemm8_accum<true>(acc, A + (size_t)m0 * lda, lda, Wt + (size_t)n0 * K, K, K, smem, tid);
        const float* gp = mods + (m0 >> 12) * 9216 + modidx * 1024;
#pragma unroll
        for (int nt = 0; nt < 4; ++nt) {
            const int col = n0 + wn * 64 + nt * 16 + fq * 4;
            float4 g4 = *(const float4*)(gp + col);
            g4.x *= coef; g4.y *= coef; g4.z *= coef; g4.w *= coef;
#pragma unroll
            for (int mt = 0; mt < 8; ++mt) {
                const size_t off = (size_t)(m0 + wm * 128 + mt * 16 + fr) * D + col;
                float4 xv = *(const float4*)(xsrc + off);
                xv.x += g4.x * acc[mt][nt][0];
                xv.y += g4.y * acc[mt][nt][1];
                xv.z += g4.z * acc[mt][nt][2];
                xv.w += g4.w * acc[mt][nt][3];
                *(float4*)(p.out + off) = xv;
            }
        }
    }
}
DEV void ph_pgemm8(const Params& p, int lsel, char* smem, int rvid, int RG, int tid) {
    const u16* H = WSP(u16, OFF_H);
    const u16* Wt = WSP(u16, OFF_W) + WE_MIX;
    u16* P = WSP(u16, OFF_P);
    u16* T = WSP(u16, OFF_T);
    float* Gt = WSP(float, OFF_G);
    const int lane = tid & 63, wave = tid >> 6, wm = wave >> 2, wn = wave & 3, fr = lane & 15, fq = lane >> 4;
    const int total = 128 * 12;
    for (int t = rvid; t < total; t += RG) {
        int mt_, nt_;
        tile_decode8(t, 12, mt_, nt_);
        const int m0 = mt_ * 256, n0 = nt_ * 256;
        f32x4 acc[8][4];
        zero_acc8(acc);
        const int cb = n0 + wn * 64;
        const int j = cb >> 7;
        const bool swap_tile = (nt_ <= 4) || (nt_ == 6) || (nt_ == 7);
        if (swap_tile) {
            gemm8_accum<true>(acc, H + (size_t)m0 * D, D, Wt + (size_t)n0 * D, D, D, smem, tid);
            const bool normed = (cb >= 256 && cb < 1024) || (cb >= 1536);
            const bool isq = cb < 1024;
            const bool isgq = (cb >= 640 && cb < 1024) || (cb >= 1920);
            const float* wv = (isgq ? p.gq_qk_w : p.na_qk_w) + (lsel * 2 + (isq ? 0 : 1)) * 64;
            const float scl = isq ? 0.125f : 1.f;
            float4 w4[4];
#pragma unroll
            for (int nt = 0; nt < 4; ++nt) w4[nt] = normed ? *(const float4*)(wv + nt * 16 + fq * 4) : float4{1.f, 1.f, 1.f, 1.f};
            const float* rope = WSP(float, OFF_ROPE);
#pragma unroll
            for (int mt = 0; mt < 8; ++mt) {
                const int row = m0 + wm * 128 + mt * 16 + fr;
                if (normed) {
                    float ss = 0.f;
#pragma unroll
                    for (int nt = 0; nt < 4; ++nt)
#pragma unroll
                        for (int r = 0; r < 4; ++r) ss += acc[mt][nt][r] * acc[mt][nt][r];
                    ss = xq_sum(ss);
                    const float rstd = rsqrtf(ss * (1.f / 64.f) + 1e-6f) * scl;
#pragma unroll
                    for (int nt = 0; nt < 4; ++nt) {
                        acc[mt][nt][0] *= rstd * w4[nt].x; acc[mt][nt][1] *= rstd * w4[nt].y;
                        acc[mt][nt][2] *= rstd * w4[nt].z; acc[mt][nt][3] *= rstd * w4[nt].w;
                    }
                    if (isgq) {
                        const int tok = row & 4095;
#pragma unroll
                        for (int nt = 0; nt < 2; ++nt) {
                            const float* rp = rope + ((size_t)tok * 32 + nt * 16 + fq * 4) * 2;
                            const float4 cs01 = *(const float4*)rp, cs23 = *(const float4*)(rp + 4);
                            const float cv[4] = {cs01.x, cs01.z, cs23.x, cs23.z}, sv[4] = {cs01.y, cs01.w, cs23.y, cs23.w};
#pragma unroll
                            for (int r = 0; r < 4; ++r) {
                                const float x1 = acc[mt][nt][r], x2 = acc[mt][nt + 2][r];
                                acc[mt][nt][r] = x1 * cv[r] - x2 * sv[r];
                                acc[mt][nt + 2][r] = x1 * sv[r] + x2 * cv[r];
                            }
                        }
                    }
                }
#pragma unroll
                for (int nt = 0; nt < 4; ++nt)
                    *(uint2*)(P + (size_t)row * PW + cb + nt * 16 + fq * 4) = uint2{pk2(acc[mt][nt][0], acc[mt][nt][1]), pk2(acc[mt][nt][2], acc[mt][nt][3])};
            }
            continue;
        }
        gemm8_accum(acc, H + (size_t)m0 * D, D, Wt + (size_t)n0 * D, D, D, smem, tid);
        if (j >= 22) {
            if (cb == 2816) {
#pragma unroll
                for (int mt = 0; mt < 8; ++mt)
#pragma unroll
                    for (int r = 0; r < 4; ++r) {
                        const int row = m0 + wm * 128 + mt * 16 + fq * 4 + r;
                        Gt[(size_t)row * 16 + fr] = acc[mt][0][r];
                    }
            }
            continue;
        }
        const bool rowmajor = j < 16;
        const bool transp = (j == 10) || (j == 11) || (j >= 16);
        if (rowmajor) {
#pragma unroll
            for (int mt = 0; mt < 8; ++mt)
#pragma unroll
                for (int nt = 0; nt < 4; ++nt)
#pragma unroll
                    for (int r = 0; r < 4; ++r) {
                        const int row = m0 + wm * 128 + mt * 16 + fq * 4 + r;
                        P[(size_t)row * PW + cb + nt * 16 + fr] = (u16)(pk2(acc[mt][nt][r], 0.f) & 0xffff);
                    }
        }
        if (transp) {
            const int tcb = (j >= 16) ? (cb - 1792) : (cb - 1280);
            const int b = m0 >> 12, u0 = m0 & 4095;
#pragma unroll
            for (int mt = 0; mt < 8; ++mt)
#pragma unroll
                for (int nt = 0; nt < 4; ++nt) {
                    const int tc = tcb + nt * 16 + fr;
                    const int u = u0 + wm * 128 + mt * 16 + fq * 4;
                    *(uint2*)(T + ((size_t)(b * TW + tc)) * UT + u) = uint2{pk2(acc[mt][nt][0], acc[mt][nt][1]), pk2(acc[mt][nt][2], acc[mt][nt][3])};
                }
        }
    }
}

DEV int map_col(int type, int n) {
    if (type == 0) return n;
    if (type == 1) {
        const int jb = n >> 5, r = n & 31;
        return r < 16 ? jb * 16 + r : DFF + jb * 16 + (r - 16);
    }
    if (n < 256) return 1552 + n;
    if (n < 640) return 2064 + (n - 256);
    if (n < 1024) return 2448 + (n - 640);
    if (n < 1280) return 1808 + (n - 1024);
    if (n < 1536) return (n - 1280);
    if (n < 1920) return 528 + (n - 1536);
    if (n < 2048) return 1296 + (n - 1920);
    if (n < 2304) return 256 + (n - 2048);
    if (n < 2688) return 912 + (n - 2304);
    if (n < 2816) return 1424 + (n - 2688);
    if (n < 2832) return 512 + (n - 2816);
    if (n < 2944) return -1;
    return 2832 + (n - 2944);
}

DEV void conv_tile(const float* __restrict__ src, int ld_src, int type, u16* __restrict__ dst, int ld_dst, int k_off, int kt, int ntile, char* smem, int tid) {
    float* lds = (float*)smem;
    const int k0 = kt * 64, n0 = ntile * 64;
    {
        const int r = tid >> 6, c = tid & 63;
        const int col = map_col(type, n0 + c);
#pragma unroll
        for (int i = 0; i < 16; ++i) {
            const int k = r + 4 * i;
            float v = 0.f;
            if (col >= 0) v = src[(size_t)(k0 + k) * ld_src + col];
            lds[k * 65 + c] = v;
        }
    }
    __syncthreads();
    {
        const int n = tid >> 2, kq = tid & 3;
        uint32_t w[8];
#pragma unroll
        for (int j = 0; j < 8; ++j) w[j] = pk2(lds[(kq * 16 + 2 * j) * 65 + n], lds[(kq * 16 + 2 * j + 1) * 65 + n]);
        u16* d = dst + (size_t)(n0 + n) * ld_dst + k_off + k0 + kq * 16;
        *(uint4*)d = uint4{w[0], w[1], w[2], w[3]};
        *(uint4*)(d + 8) = uint4{w[4], w[5], w[6], w[7]};
    }
    __syncthreads();
}

DEV void ph_prep(const Params& p, int l, char* smem, int bid, int G) {
    u16* W = WSP(u16, OFF_W);
    const int tid = VTID;
    constexpr int N_CONV = 6240, N_MODS = 288;
    for (int it = bid; it < N_CONV + N_MODS; it += G) {
        if (it < N_CONV) {
            int r = it;
            if (r < 2816) {
                const int which = r / 1408; r -= which * 1408;
                conv_tile(p.ffn_w_in + (size_t)(l * 2 + which) * 1024 * 5632, 5632, 1, W + (which ? WE_IN1 : WE_IN0), 1024, 0, r / 88, r % 88, smem, tid);
                continue;
            }
            r -= 2816;
            if (r < 1408) {
                const int which = r / 704; r -= which * 704;
                conv_tile(p.ffn_w_out + (size_t)(l * 2 + which) * 2816 * 1024, 1024, 0, W + (which ? WE_OUT1 : WE_OUT0), 2816, 0, r / 16, r % 16, smem, tid);
                continue;
            }
            r -= 1408;
            if (r < 1504) {
                conv_tile(p.mix_w_in + (size_t)l * 1024 * NIN, NIN, 2, W + WE_MIX, 1024, 0, r / 94, r % 94, smem, tid);
                continue;
            }
            r -= 1504;
            if (r < 64) { conv_tile(p.w_br_ml + (size_t)l * 256 * 1024, 1024, 0, W + WE_BR, 1024, 0, r / 16, r % 16, smem, tid); continue; }
            r -= 64;
            if (r < 96) { conv_tile(p.w_br_na + (size_t)l * 384 * 1024, 1024, 0, W + WE_BR, 1024, 256, r / 16, r % 16, smem, tid); continue; }
            r -= 96;
            if (r < 96) { conv_tile(p.w_br_gq + (size_t)l * 384 * 1024, 1024, 0, W + WE_BR, 1024, 640, r / 16, r % 16, smem, tid); continue; }
            r -= 96;
            conv_tile(p.w_out + (size_t)l * 1024 * 1024, 1024, 0, W + WE_O, 1024, 0, r / 16, r % 16, smem, tid);
        } else {
            const int cb = it - N_CONV;
            float* s = (float*)smem;
            float* red = s + 9 * 1024;
            for (int i = tid; i < 9 * 1024; i += 256) {
                const int b = i >> 10, k = i & 1023;
                const float v = b < 8 ? p.c[b * 1024 + k] : p.c_ctx[k];
                s[i] = v * sigmoidf_(v);
            }
            __syncthreads();
            const int kg = tid >> 5, c = tid & 31, col = cb * 32 + c;
            float a[9];
#pragma unroll
            for (int b = 0; b < 9; ++b) a[b] = 0.f;
            const float* wp = p.ada_w + (size_t)l * 1024 * 9216 + (size_t)(kg * 128) * 9216 + col;
#pragma unroll 16
            for (int k = 0; k < 128; ++k) {
                const float w = wp[(size_t)k * 9216];
#pragma unroll
                for (int b = 0; b < 9; ++b) a[b] += s[b * 1024 + kg * 128 + k] * w;
            }
#pragma unroll
            for (int b = 0; b < 9; ++b) red[(kg * 9 + b) * 32 + c] = a[b];
            __syncthreads();
            for (int i = tid; i < 288; i += 256) {
                const int b = i >> 5, cc = i & 31;
                float v = p.ada_b[l * 9216 + cb * 32 + cc];
#pragma unroll
                for (int g = 0; g < 8; ++g) v += red[(g * 9 + b) * 32 + cc];
                WSP(float, OFF_MODS)[b * 9216 + cb * 32 + cc] = v;
            }
            __syncthreads();
        }
    }
    if (l == 0) {
        const size_t gt = (size_t)bid * 256 + tid, gs = (size_t)G * 256;
        const float4* cs = (const float4*)p.ctx; float4* cd = WSP(float4, OFF_XC);
        for (size_t i = gt; i < (size_t)NCX * D / 4; i += gs) cd[i] = cs[i];
        float* rope = WSP(float, OFF_ROPE);
        for (size_t i = gt; i < (size_t)4096 * 32; i += gs) {
            const int t = (int)(i >> 5), f = (int)(i & 31);
            const float pos = (float)((f < 16) ? (t >> 6) : (t & 63));
            const float inv = powf(10000.f, -(float)(f & 15) / 16.f);
            float sn, cs_;
            sincosf(pos * inv, &sn, &cs_);
            rope[i * 2] = cs_;
            rope[i * 2 + 1] = sn;
        }
    }
}

#define KIDX(j) (lane * 8 + ((j) & 1) * 4 + ((j) >> 1) * 512)
DEV void ph_mod(const Params& p, int l, int sub, int nrows, int bid, int G) {
    const bool first = (l == 0 && sub == 0);
    const int lane = VTID & 63, gw = bid * 4 + (VTID >> 6), NW = G * 4;
    const float* nw = p.norm_w + (size_t)(l * 3 + sub) * 1024;
    const float* mods = WSP(float, OFF_MODS);
    u16* H = WSP(u16, OFF_H);
#pragma unroll 2
    for (int r = gw; r < nrows; r += NW) {
        const float* xr = r < NL ? (first ? p.x : p.out) + (size_t)r * D : (first ? p.ctx : WSP(float, OFF_XC)) + (size_t)(r - NL) * D;
        const int b9 = r < NL ? (r >> 12) : 8;
        const float* sh = mods + b9 * 9216 + (3 * sub) * 1024;
        const float* sc = sh + 1024;
        float4 v[4];
        float ss = 0.f;
        const bool fold = (r >= NL) && !first;
#pragma unroll
        for (int j = 0; j < 4; ++j) {
            v[j] = *(const float4*)(xr + KIDX(j));
            if (fold) {
#pragma unroll
                for (int ks = 0; ks < 4; ++ks) {
                    const float4 q4 = *(const float4*)(WSP(float, OFF_PART) + ((size_t)ks * NCX + (r - NL)) * D + KIDX(j));
                    v[j].x += q4.x; v[j].y += q4.y; v[j].z += q4.z; v[j].w += q4.w;
                }
                *(float4*)(WSP(float, OFF_XC) + (size_t)(r - NL) * D + KIDX(j)) = v[j];
            }
            ss += v[j].x * v[j].x + v[j].y * v[j].y + v[j].z * v[j].z + v[j].w * v[j].w;
        }
        ss = wave_sum(ss);
        const float rstd = rsqrtf(ss * (1.f / 1024.f) + 1e-6f);
        uint2 hp[4];
#pragma unroll
        for (int j = 0; j < 4; ++j) {
            const int k = KIDX(j);
            const float4 w = *(const float4*)(nw + k), s1 = *(const float4*)(sc + k), s0 = *(const float4*)(sh + k);
            const float y0 = v[j].x * rstd * w.x * (1.f + s1.x) + s0.x;
            const float y1 = v[j].y * rstd * w.y * (1.f + s1.y) + s0.y;
            const float y2 = v[j].z * rstd * w.z * (1.f + s1.z) + s0.z;
            const float y3 = v[j].w * rstd * w.w * (1.f + s1.w) + s0.w;
            hp[j] = uint2{pk2(y0, y1), pk2(y2, y3)};
        }
        *(uint4*)(H + (size_t)r * D + KIDX(0)) = uint4{hp[0].x, hp[0].y, hp[1].x, hp[1].y};
        *(uint4*)(H + (size_t)r * D + KIDX(2)) = uint4{hp[2].x, hp[2].y, hp[3].x, hp[3].y};
    }
}

#undef KIDX
DEV void ph_ffn_in(const Params& p, int which, int mt0, int mtiles, char* smem, int vid, int G) {
    const u16* H = WSP(u16, OFF_H);
    const u16* Wt = WSP(u16, OFF_W) + (which ? WE_IN1 : WE_IN0);
    u16* ACT = WSP(u16, OFF_P);
    const int lane = VTID & 63, wave = VTID >> 6, wm = wave >> 1, wn = wave & 1, fr = lane & 15, fq = lane >> 4;
    const int total = mtiles * 44;
    for (int t = vid; t < total; t += G) {
        int mt_, nt_;
        tile_decode(t, 44, mt_, nt_);
        mt_ += mt0;
        const int m0 = mt_ * 128, n0 = nt_ * 128;
        f32x4 acc[4][4];
        zero_acc<4>(acc);
        gemm_accum<4>(acc, H + (size_t)m0 * D, D, Wt + (size_t)n0 * D, D, D, smem, VTID);
#pragma unroll
        for (int mt = 0; mt < 4; ++mt)
#pragma unroll
            for (int pp = 0; pp < 2; ++pp)
#pragma unroll
                for (int r = 0; r < 4; ++r) {
                    const int row = m0 + wm * 64 + mt * 16 + fq * 4 + r;
                    const int hid = (n0 >> 1) + wn * 32 + pp * 16 + fr;
                    const float g = acc[mt][2 * pp][r], u = acc[mt][2 * pp + 1][r];
                    const float v = g * sigmoidf_(g) * u;
                    ACT[(size_t)row * DFF + hid] = (u16)(pk2(v, 0.f) & 0xffff);
                }
    }
}

DEV void ph_resid(const Params& p, const u16* A, int lda, const u16* Wt, int K, int modidx, float coef, int mt0, int mtiles, char* smem, int vid, int G) {
    const float* mods = WSP(float, OFF_MODS);
    const int lane = VTID & 63, wave = VTID >> 6, wm = wave >> 1, wn = wave & 1, fr = lane & 15, fq = lane >> 4;
    const int total = mtiles * 8 * 4;
    const int Kc = K >> 2;
    for (int t = vid; t < total; t += G) {
        int mt_, nt_;
        const int ksp = t & 3;
        tile_decode(t >> 2, 8, mt_, nt_);
        mt_ += mt0;
        const int m0 = mt_ * 128, n0 = nt_ * 128;
        f32x4 acc[4][4];
        zero_acc<4>(acc);
        gemm_accum<4>(acc, A + (size_t)m0 * lda + ksp * Kc, lda, Wt + (size_t)n0 * K + ksp * Kc, K, Kc, smem, VTID);
        const int b9 = m0 < NL ? (m0 >> 12) : 8;
        const float* gp = mods + b9 * 9216 + modidx * 1024;
#pragma unroll
        for (int nt = 0; nt < 4; ++nt) {
            const int col = n0 + wn * 64 + nt * 16 + fr;
            const float gv = gp[col] * coef;
#pragma unroll
            for (int mt = 0; mt < 4; ++mt)
#pragma unroll
                for (int r = 0; r < 4; ++r) {
                    const int row = m0 + wm * 64 + mt * 16 + fq * 4 + r;
                    WSP(float, OFF_PART)[((size_t)ksp * NCX + (row - NL)) * D + col] = gv * acc[mt][nt][r];
                }
        }
    }
}

DEV void ph_pgemm(const Params& p, int mt0, int mtiles, char* smem, int vid, int G) {
    const u16* H = WSP(u16, OFF_H);
    const u16* Wt = WSP(u16, OFF_W) + WE_MIX;
    u16* P = WSP(u16, OFF_P);
    u16* T = WSP(u16, OFF_T);
    float* Gt = WSP(float, OFF_G);
    const int lane = VTID & 63, wave = VTID >> 6, wm = wave >> 1, wn = wave & 1, fr = lane & 15, fq = lane >> 4;
    const int total = mtiles * 23;
    for (int t = vid; t < total; t += G) {
        int mt_, nt_;
        tile_decode(t, 23, mt_, nt_);
        mt_ += mt0;
        const int m0 = mt_ * 128, n0 = nt_ * 128;
        f32x4 acc[4][4];
        zero_acc<4>(acc);
        gemm_accum<4>(acc, H + (size_t)m0 * D, D, Wt + (size_t)n0 * D, D, D, smem, VTID);
        if (nt_ == 22) {
            if (wn == 0) {
#pragma unroll
                for (int mt = 0; mt < 4; ++mt)
#pragma unroll
                    for (int r = 0; r < 4; ++r) {
                        const int row = m0 + wm * 64 + mt * 16 + fq * 4 + r;
                        Gt[(size_t)row * 16 + fr] = acc[mt][0][r];
                    }
            }
            continue;
        }
        const bool rowmajor = nt_ < 16;
        const bool transp = (nt_ == 10) || (nt_ == 11) || (nt_ >= 16);
        if (rowmajor) {
#pragma unroll
            for (int mt = 0; mt < 4; ++mt)
#pragma unroll
                for (int nt = 0; nt < 4; ++nt)
#pragma unroll
                    for (int r = 0; r < 4; ++r) {
                        const int row = m0 + wm * 64 + mt * 16 + fq * 4 + r;
                        const int col = n0 + wn * 64 + nt * 16 + fr;
                        P[(size_t)row * PW + col] = (u16)(pk2(acc[mt][nt][r], 0.f) & 0xffff);
                    }
        }
        if (transp) {
            const int tcb = (nt_ >= 16) ? (n0 - 1792) : (n0 - 1280);
            int b, u0;
            if (m0 < NL) { b = m0 >> 12; u0 = m0 & 4095; } else { b = (m0 - NL) >> 8; u0 = SEQ + ((m0 - NL) & 255); }
#pragma unroll
            for (int mt = 0; mt < 4; ++mt)
#pragma unroll
                for (int nt = 0; nt < 4; ++nt) {
                    const int tc = tcb + wn * 64 + nt * 16 + fr;
                    const int u = u0 + wm * 64 + mt * 16 + fq * 4;
                    *(uint2*)(T + ((size_t)(b * TW + tc)) * UT + u) = uint2{pk2(acc[mt][nt][0], acc[mt][nt][1]), pk2(acc[mt][nt][2], acc[mt][nt][3])};
                }
        }
    }
}

DEV void ph_qknorm_gates(const Params& p, int l, int bid, int G) {
    const int lane = VTID & 63, gw = bid * 4 + (VTID >> 6), NW = G * 4;
    u16* P = WSP(u16, OFF_P);
    for (int it = gw; it < NSCAN * NCH; it += NW) {
        const int sc = it / NCH, c = it - sc * NCH, dir = sc & 1, h = (sc >> 1) & 3, b = sc >> 3;
        const float* Gt = WSP(float, OFF_G);
        float* BC = WSP(float, OFF_BC) + (size_t)sc * UT;
        float* IG = WSP(float, OFF_IG) + (size_t)sc * UT;
        float* WE = WSP(float, OFF_AE) + (size_t)sc * UT;
        const float bi = p.ml_gate_b[l * 16 + dir * 8 + h], bf = p.ml_gate_b[l * 16 + dir * 8 + 4 + h];
        const int cu = cu_of(c, dir);
        const int u = cu * 64 + (dir ? 63 - lane : lane);
        const int row = rowof(b, u);
        const float ig = Gt[(size_t)row * 16 + dir * 8 + h] + bi;
        const float fp = Gt[(size_t)row * 16 + dir * 8 + 4 + h] + bf;
        const float lf = fminf(fp, 0.f) - log1pf(expf(-fabsf(fp)));
        float bc = lf;
#pragma unroll
        for (int o = 1; o < 64; o <<= 1) { const float tv = __shfl_up(bc, o); if (lane >= o) bc += tv; }
        const float btot = __shfl(bc, 63);
        const float wend = btot - bc + ig;
        const float mx = wave_max(wend);
        WE[u] = wend;
        BC[u] = bc;
        IG[u] = ig;
        if (lane == 0) { WSP(float, OFF_MS)[sc * NCH + c] = btot; WSP(float, OFF_DEC)[sc * NCH + c] = mx; }
    }
    const float* rope = WSP(float, OFF_ROPE);
    const int hs = lane >> 4, e4 = (lane & 15) * 4;
    for (int r = NL + gw; r < MTOT; r += NW) {
        const bool latent = r < NL;
        const int tok = r & 4095;
#pragma unroll
        for (int g = 0; g < 5; ++g) {
            const int cbase = (g < 3 ? 256 + g * 256 : 1536 + (g - 3) * 256) + hs * 64 + e4;
            const int slot = g * 4 + hs;
            u16* pp = P + (size_t)r * PW + cbase;
            const uint2 raw = *(const uint2*)pp;
            float v0 = bflo(raw.x), v1 = bfhi(raw.x), v2 = bflo(raw.y), v3 = bfhi(raw.y);
            float ss = v0 * v0 + v1 * v1 + v2 * v2 + v3 * v3;
            ss += __shfl_xor(ss, 1); ss += __shfl_xor(ss, 2); ss += __shfl_xor(ss, 4); ss += __shfl_xor(ss, 8);
            const float* wv;
            float scl;
            bool do_rope;
            if (slot < 6) { wv = p.na_qk_w + (l * 2 + 0) * 64; scl = 0.125f; do_rope = false; }
            else if (slot < 12) { wv = p.gq_qk_w + (l * 2 + 0) * 64; scl = 0.125f; do_rope = latent; }
            else if (slot < 18) { wv = p.na_qk_w + (l * 2 + 1) * 64; scl = 1.f; do_rope = false; }
            else { wv = p.gq_qk_w + (l * 2 + 1) * 64; scl = 1.f; do_rope = latent; }
            const float rstd = rsqrtf(ss * (1.f / 64.f) + 1e-6f) * scl;
            const float4 w4 = *(const float4*)(wv + e4);
            v0 *= rstd * w4.x; v1 *= rstd * w4.y; v2 *= rstd * w4.z; v3 *= rstd * w4.w;
            const float o0 = __shfl_xor(v0, 8), o1 = __shfl_xor(v1, 8), o2 = __shfl_xor(v2, 8), o3 = __shfl_xor(v3, 8);
            if (do_rope) {
                const int fi = e4 & 31;
                const float4 cs01 = *(const float4*)(rope + ((size_t)tok * 32 + fi) * 2);
                const float4 cs23 = *(const float4*)(rope + ((size_t)tok * 32 + fi + 2) * 2);
                if (e4 < 32) {
                    v0 = v0 * cs01.x - o0 * cs01.y; v1 = v1 * cs01.z - o1 * cs01.w;
                    v2 = v2 * cs23.x - o2 * cs23.y; v3 = v3 * cs23.z - o3 * cs23.w;
                } else {
                    v0 = o0 * cs01.y + v0 * cs01.x; v1 = o1 * cs01.w + v1 * cs01.z;
                    v2 = o2 * cs23.y + v2 * cs23.x; v3 = o3 * cs23.w + v3 * cs23.z;
                }
            }
            *(uint2*)pp = uint2{pk2(v0, v1), pk2(v2, v3)};
        }
    }
}

template <int MT, bool NAMASK, int NWV>
DEV void flash_item(const Params& p, int b, int qrow0, int qcol, int kcol, int tcol, int ua, int n1, int ub, int ntiles,
                    int r_q, int rs, const float* __restrict__ rpb_h, char* smem, int ocol, float mfix = 0.f) {
    u16* P = WSP(u16, OFF_P);
    const u16* T = WSP(u16, OFF_T);
    const int tid = (NWV == 8) ? (int)(threadIdx.x + p.z) : VTID, lane = tid & 63, wave = tid >> 6, fr = lane & 15, fq = lane >> 4;
    constexpr int KVS = 64 * 144;
    char* Ks = smem;
    char* Vs = smem + 2 * KVS;
    float* rpb_s = (float*)(smem + 4 * KVS);
    __syncthreads();
    if (NAMASK) {
        for (int i = tid; i < 465; i += 256) rpb_s[i] = rpb_h[i] * 1.4426950408889634f;
    }
    Frag qf[MT][2];
#pragma unroll
    for (int mt = 0; mt < MT; ++mt)
#pragma unroll
        for (int ks = 0; ks < 2; ++ks)
            qf[mt][ks].q = *(const uint4*)(P + (size_t)(qrow0 + (wave * MT + mt) * 16 + fr) * PW + qcol + ks * 32 + fq * 8);
    const int lr = tid >> 3, lc8 = tid & 7;
    u32x4 rk0, rk1 = {0, 0, 0, 0}, rv0, rv1 = {0, 0, 0, 0};
#define FL_GLOAD(KT) do { const int kt_ = (KT); const int u0_ = kt_ < n1 ? ua + 64 * kt_ : ub + 64 * (kt_ - n1); const int row0_ = rowof(b, u0_); \
        rk0 = gld16(P + (size_t)(row0_ + lr) * PW + kcol + lc8 * 8); rv0 = gld16(T + ((size_t)(b * TW + tcol + lr)) * UT + u0_ + lc8 * 8); \
        if (NWV == 4) { rk1 = gld16(P + (size_t)(row0_ + lr + 32) * PW + kcol + lc8 * 8); rv1 = gld16(T + ((size_t)(b * TW + tcol + lr + 32)) * UT + u0_ + lc8 * 8); } } while (0)
#define FL_SSTORE(S) do { const int s_ = (S); \
        *(u32x4*)(Ks + s_ * KVS + lr * 144 + lc8 * 16) = rk0; *(u32x4*)(Vs + s_ * KVS + lr * 144 + lc8 * 16) = rv0; \
        if (NWV == 4) { *(u32x4*)(Ks + s_ * KVS + (lr + 32) * 144 + lc8 * 16) = rk1; *(u32x4*)(Vs + s_ * KVS + (lr + 32) * 144 + lc8 * 16) = rv1; } } while (0)
    FL_GLOAD(0);
    VM_WAIT0();
    FL_SSTORE(0);
    __syncthreads();
    f32x4 o[MT][4];
    float mrow[MT], lrow[MT];
#pragma unroll
    for (int mt = 0; mt < MT; ++mt) {
        mrow[mt] = -1e30f; lrow[mt] = 0.f;
#pragma unroll
        for (int dt = 0; dt < 4; ++dt) o[mt][dt] = f32x4{0.f, 0.f, 0.f, 0.f};
    }
    const float L2E = 1.4426950408889634f;
    for (int kt = 0; kt < ntiles; ++kt) {
        const int cur = kt & 1;
        const bool more = kt + 1 < ntiles;
        FL_GLOAD(more ? kt + 1 : kt);
        __builtin_amdgcn_sched_barrier(0);
        f32x4 s[MT][4];
#pragma unroll
        for (int mt = 0; mt < MT; ++mt)
#pragma unroll
            for (int nt = 0; nt < 4; ++nt) s[mt][nt] = f32x4{0.f, 0.f, 0.f, 0.f};
#pragma unroll
        for (int ks = 0; ks < 2; ++ks)
#pragma unroll
            for (int nt = 0; nt < 4; ++nt) {
                const bf16x8 kf = *(const bf16x8*)(Ks + cur * KVS + (nt * 16 + fr) * 144 + (ks * 32 + fq * 8) * 2);
#pragma unroll
                for (int mt = 0; mt < MT; ++mt) s[mt][nt] = mfma16(kf, qf[mt][ks].v, s[mt][nt]);
            }
        Frag pf[MT][2];
#pragma unroll
        for (int mt = 0; mt < MT; ++mt) {
            float rsum = 0.f;
            if (NAMASK && kt < 8) {
                const int qc = (wave * MT + mt) * 16 + fr;
                int cs = qc - 8; cs = cs < 0 ? 0 : (cs > 48 ? 48 : cs);
                const int brow = rs + kt - r_q + 7;
#pragma unroll
                for (int nt = 0; nt < 4; ++nt)
#pragma unroll
                    for (int r = 0; r < 4; ++r) {
                        const int kc = nt * 16 + fq * 4 + r;
                        const bool valid = (kc >= cs) && (kc < cs + 16);
                        const int bi = valid ? brow * 31 + (kc - qc + 15) : 0;
                        const float e = valid ? fexp2(fmaf(s[mt][nt][r], L2E, rpb_s[bi] - mfix)) : 0.f;
                        s[mt][nt][r] = e; rsum += e;
                    }
            } else {
#pragma unroll
                for (int nt = 0; nt < 4; ++nt)
#pragma unroll
                    for (int r = 0; r < 4; ++r) { const float e = fexp2(fmaf(s[mt][nt][r], L2E, -mfix)); s[mt][nt][r] = e; rsum += e; }
            }
            lrow[mt] += rsum;
#pragma unroll
            for (int ks = 0; ks < 2; ++ks) {
                pf[mt][ks].u[0] = pk2(s[mt][2 * ks][0], s[mt][2 * ks][1]);
                pf[mt][ks].u[1] = pk2(s[mt][2 * ks][2], s[mt][2 * ks][3]);
                pf[mt][ks].u[2] = pk2(s[mt][2 * ks + 1][0], s[mt][2 * ks + 1][1]);
                pf[mt][ks].u[3] = pk2(s[mt][2 * ks + 1][2], s[mt][2 * ks + 1][3]);
            }
        }
#pragma unroll
        for (int ks = 0; ks < 2; ++ks)
#pragma unroll
            for (int dt = 0; dt < 4; ++dt) {
                Frag vf;
                vf.d[0] = *(const uint2*)(Vs + cur * KVS + (dt * 16 + fr) * 144 + (ks * 32 + fq * 4) * 2);
                vf.d[1] = *(const uint2*)(Vs + cur * KVS + (dt * 16 + fr) * 144 + (ks * 32 + 16 + fq * 4) * 2);
#pragma unroll
                for (int mt = 0; mt < MT; ++mt) o[mt][dt] = mfma16(vf.v, pf[mt][ks].v, o[mt][dt]);
            }
        __builtin_amdgcn_sched_barrier(0);
        VM_WAIT0();
        FL_SSTORE(cur ^ 1);
        __syncthreads();
    }
#pragma unroll
    for (int mt = 0; mt < MT; ++mt) {
        const float inv = 1.f / xq_sum(lrow[mt]);
        u16* op = P + (size_t)(qrow0 + (wave * MT + mt) * 16 + fr) * PW + ocol;
#pragma unroll
        for (int dt = 0; dt < 4; ++dt)
            *(uint2*)(op + dt * 16 + fq * 4) = uint2{pk2(o[mt][dt][0] * inv, o[mt][dt][1] * inv), pk2(o[mt][dt][2] * inv, o[mt][dt][3] * inv)};
    }
}

template <int MT>
DEV void flash8_item(const Params& p, int b, int qrow0, int qcol, int kcol, int tcol, int ua, int ntiles, char* smem, float mfix) {
    u16* P = WSP(u16, OFF_P);
    const u16* T = WSP(u16, OFF_T);
    const int tid = (int)(threadIdx.x + p.z), lane = tid & 63, wave = tid >> 6, fr = lane & 15, fq = lane >> 4;
    constexpr int STG = 16384;
    __syncthreads();
    Frag qf[MT][2];
#pragma unroll
    for (int mt = 0; mt < MT; ++mt)
#pragma unroll
        for (int ks = 0; ks < 2; ++ks)
            qf[mt][ks].q = *(const uint4*)(P + (size_t)(qrow0 + (wave * MT + mt) * 16 + fr) * PW + qcol + ks * 32 + fq * 8);
    const int lr = lane >> 3, pos = lane & 7, rowl = wave * 8 + lr;
    const int cch = pos ^ ((rowl >> 1) & 7);
    const unsigned voK = (unsigned)(rowl * PW + cch * 8) * 2u, voV = (unsigned)(rowl * UT + cch * 8) * 2u;
    const unsigned ldsw = __builtin_amdgcn_readfirstlane((unsigned)(size_t)(__attribute__((address_space(3))) char*)smem + wave * 1024);
    const u16* Tb = T + (size_t)(b * TW + tcol) * UT;
#define F8_ISSUE(KT, STGI) do { const int u0_ = ua + 64 * (KT); const int row0_ = rowof(b, u0_); \
        glds16(P + (size_t)row0_ * PW + kcol, voK, ldsw + (STGI) * STG); glds16(Tb + u0_, voV, ldsw + (STGI) * STG + 8192); } while (0)
    F8_ISSUE(0, 0);
    F8_ISSUE(ntiles > 1 ? 1 : 0, 1);
    F8_ISSUE(ntiles > 2 ? 2 : ntiles - 1, 2);
    f32x4 o[MT][4];
    float lrow[MT];
#pragma unroll
    for (int mt = 0; mt < MT; ++mt) {
        lrow[mt] = 0.f;
#pragma unroll
        for (int dt = 0; dt < 4; ++dt) o[mt][dt] = f32x4{0.f, 0.f, 0.f, 0.f};
    }
    const int s3 = (fr >> 1) & 7;
    const int okb = fr * 128 + ((fq ^ s3) * 16);
    const int ovb = 8192 + fr * 128 + (((fq >> 1) ^ s3) * 16) + (fq & 1) * 8;
    const float L2E = 1.4426950408889634f;
    f32x4 sc_[MT][4];
    asm volatile("s_waitcnt vmcnt(4)" ::: "memory");
    __syncthreads();
#define F8_SCORES(DST, STGI) do { int ob_ = (STGI) * STG; asm volatile("" : "+v"(ob_)); const char* bs_ = smem + ob_; \
        _Pragma("unroll") for (int mt = 0; mt < MT; ++mt) _Pragma("unroll") for (int nt = 0; nt < 4; ++nt) DST[mt][nt] = f32x4{0.f, 0.f, 0.f, 0.f}; \
        _Pragma("unroll") for (int ks = 0; ks < 2; ++ks) _Pragma("unroll") for (int nt = 0; nt < 4; ++nt) { \
            const bf16x8 kf = *(const bf16x8*)(bs_ + (okb ^ (ks * 64)) + nt * 2048); \
            _Pragma("unroll") for (int mt = 0; mt < MT; ++mt) DST[mt][nt] = mfma16(kf, qf[mt][ks].v, DST[mt][nt]); } } while (0)
    F8_SCORES(sc_, 0);
    f32x4 sn_[MT][4];
    typedef float f32x2_ __attribute__((ext_vector_type(2)));
    const f32x2_ l2e2 = {L2E, L2E}, mf2 = {-mfix, -mfix};
#define F8_STEP(KT, CUR, NXT, HASNEXT) do { \
        const int kt_ = (KT); \
        asm volatile("s_waitcnt vmcnt(2)" ::: "memory"); \
        __syncthreads(); \
        { const int kn = kt_ + 3 < ntiles ? kt_ + 3 : ntiles - 1; F8_ISSUE(kn, (kt_ + 3) & 3); } \
        if (HASNEXT) F8_SCORES(NXT, (kt_ + 1) & 3); \
        int ob = (kt_ & 3) * STG; \
        asm volatile("" : "+v"(ob)); \
        const char* base = smem + ob; \
        Frag pf[MT][2]; \
        _Pragma("unroll") for (int mt = 0; mt < MT; ++mt) { \
            float rsum = 0.f; \
            _Pragma("unroll") for (int nt = 0; nt < 4; ++nt) { \
                f32x2_ a01 = {CUR[mt][nt][0], CUR[mt][nt][1]}, a23 = {CUR[mt][nt][2], CUR[mt][nt][3]}; \
                a01 = a01 * l2e2 + mf2; a23 = a23 * l2e2 + mf2; \
                const float e0 = fexp2(a01[0]), e1 = fexp2(a01[1]), e2 = fexp2(a23[0]), e3 = fexp2(a23[1]); \
                CUR[mt][nt][0] = e0; CUR[mt][nt][1] = e1; CUR[mt][nt][2] = e2; CUR[mt][nt][3] = e3; \
                rsum += (e0 + e1) + (e2 + e3); } \
            lrow[mt] += rsum; \
            _Pragma("unroll") for (int ks = 0; ks < 2; ++ks) { \
                pf[mt][ks].u[0] = pk2(CUR[mt][2 * ks][0], CUR[mt][2 * ks][1]); \
                pf[mt][ks].u[1] = pk2(CUR[mt][2 * ks][2], CUR[mt][2 * ks][3]); \
                pf[mt][ks].u[2] = pk2(CUR[mt][2 * ks + 1][0], CUR[mt][2 * ks + 1][1]); \
                pf[mt][ks].u[3] = pk2(CUR[mt][2 * ks + 1][2], CUR[mt][2 * ks + 1][3]); } } \
        _Pragma("unroll") for (int ks = 0; ks < 2; ++ks) _Pragma("unroll") for (int dt = 0; dt < 4; ++dt) { \
            Frag vf; \
            vf.d[0] = *(const uint2*)(base + (ovb ^ (ks * 64)) + dt * 2048); \
            vf.d[1] = *(const uint2*)(base + ((ovb ^ (ks * 64)) ^ 32) + dt * 2048); \
            _Pragma("unroll") for (int mt = 0; mt < MT; ++mt) o[mt][dt] = mfma16(vf.v, pf[mt][ks].v, o[mt][dt]); } \
    } while (0)
    for (int kt = 0; kt < ntiles; kt += 2) {
        F8_STEP(kt, sc_, sn_, true);
        F8_STEP(kt + 1, sn_, sc_, (kt + 2 < ntiles));
    }
#undef F8_STEP
#undef F8_SCORES
    VM_WAIT0();
    __syncthreads();
#undef F8_ISSUE
#pragma unroll
    for (int mt = 0; mt < MT; ++mt) {
        const float inv = 1.f / xq_sum(lrow[mt]);
        u16* op = P + (size_t)(qrow0 + (wave * MT + mt) * 16 + fr) * PW + qcol;
#pragma unroll
        for (int dt = 0; dt < 4; ++dt)
            *(uint2*)(op + dt * 16 + fq * 4) = uint2{pk2(o[mt][dt][0] * inv, o[mt][dt][1] * inv), pk2(o[mt][dt][2] * inv, o[mt][dt][3] * inv)};
    }
}


DEV void m2_item(const Params& p, int sc, int c) {
    const u16* T = WSP(u16, OFF_T);
    const int lane = VTID & 63, wave = VTID >> 6, fr = lane & 15, fq = lane >> 4;
    const int dir = sc & 1, h = (sc >> 1) & 3, b = sc >> 3;
    const int u0 = cu_of(c, dir) * 64;
    const float* AE = WSP(float, OFF_AE) + (size_t)sc * UT + u0;
    float* S = WSP(float, OFF_S) + ((size_t)sc * NCH + c) * SCH;
    const float mnew = fmaxf(WSP(float, OFF_MS)[sc * NCH + c] + m_scan(p, sc, c), WSP(float, OFF_DEC)[sc * NCH + c]);
    f32x4 acc[4], accn[4];
#pragma unroll
    for (int nt = 0; nt < 4; ++nt) { acc[nt] = f32x4{0.f, 0.f, 0.f, 0.f}; accn[nt] = f32x4{0.f, 0.f, 0.f, 0.f}; }
    Frag ones;
    ones.u[0] = ones.u[1] = ones.u[2] = ones.u[3] = 0x3F803F80u;
#pragma unroll
    for (int ks = 0; ks < 2; ++ks) {
        Frag vf;
        vf.q = *(const uint4*)(T + ((size_t)(b * TW + TC_MLV + h * 64 + wave * 16 + fr)) * UT + u0 + ks * 32 + fq * 8);
        float4 a0 = *(const float4*)(AE + ks * 32 + fq * 8), a1 = *(const float4*)(AE + ks * 32 + fq * 8 + 4);
        a0.x = expf(a0.x - mnew); a0.y = expf(a0.y - mnew); a0.z = expf(a0.z - mnew); a0.w = expf(a0.w - mnew);
        a1.x = expf(a1.x - mnew); a1.y = expf(a1.y - mnew); a1.z = expf(a1.z - mnew); a1.w = expf(a1.w - mnew);
#pragma unroll
        for (int nt = 0; nt < 4; ++nt) {
            Frag kf, kb;
            kf.q = *(const uint4*)(T + ((size_t)(b * TW + TC_MLK + h * 64 + nt * 16 + fr)) * UT + u0 + ks * 32 + fq * 8);
            kb.u[0] = pk2(bflo(kf.u[0]) * a0.x * 0.125f, bfhi(kf.u[0]) * a0.y * 0.125f);
            kb.u[1] = pk2(bflo(kf.u[1]) * a0.z * 0.125f, bfhi(kf.u[1]) * a0.w * 0.125f);
            kb.u[2] = pk2(bflo(kf.u[2]) * a1.x * 0.125f, bfhi(kf.u[2]) * a1.y * 0.125f);
            kb.u[3] = pk2(bflo(kf.u[3]) * a1.z * 0.125f, bfhi(kf.u[3]) * a1.w * 0.125f);
            acc[nt] = mfma16(vf.v, kb.v, acc[nt]);
            if (wave == 0) accn[nt] = mfma16(ones.v, kb.v, accn[nt]);
        }
    }
#pragma unroll
    for (int nt = 0; nt < 4; ++nt) {
#pragma unroll
        for (int r = 0; r < 4; ++r) S[(wave * 16 + fq * 4 + r) * 64 + nt * 16 + fr] = acc[nt][r];
        if (wave == 0 && fq == 0) S[4096 + nt * 16 + fr] = accn[nt][0];
    }
}

DEV void ph_m3(const Params& p, int bid, int G) {
    const float* DEC = WSP(float, OFF_DEC);
    float* S = WSP(float, OFF_S);
    const int total = NSCAN * SCH;
    for (int i = bid * 256 + VTID; i < total; i += G * 256) {
        const int sc = i / SCH, e = i - sc * SCH;
        float* base = S + (size_t)sc * NCH * SCH + e;
        const float* mxp = DEC + sc * NCH;
        const float* btp = WSP(float, OFF_MS) + sc * NCH;
        float st = 0.f, m = 0.f;
#pragma unroll 17
        for (int c = 0; c < NCH; ++c) {
            const float tmp = base[(size_t)c * SCH];
            base[(size_t)c * SCH] = st;
            const float bm = btp[c] + m;
            const float mnew = fmaxf(bm, mxp[c]);
            st = expf(bm - mnew) * st + tmp;
            m = mnew;
        }
    }
}

DEV void m4_item(const Params& p, int l, int b, int h, int cu, int ocolbase) {
    u16* P = WSP(u16, OFF_P);
    const u16* T = WSP(u16, OFF_T);
    const int lane = VTID & 63, wave = VTID >> 6, fr = lane & 15, fq = lane >> 4;
    const int u0 = cu * 64;
    const int row0 = rowof(b, u0);
    const int j = wave * 16 + fr;
    Frag qf[2];
#pragma unroll
    for (int ks = 0; ks < 2; ++ks) qf[ks].q = *(const uint4*)(P + (size_t)(row0 + j) * PW + PC_MLQ + h * 64 + ks * 32 + fq * 8);
    f32x4 hsum[4];
#pragma unroll
    for (int dt = 0; dt < 4; ++dt) hsum[dt] = f32x4{0.f, 0.f, 0.f, 0.f};
#pragma unroll 1
    for (int dir = 0; dir < 2; ++dir) {
        const int sc = (b * 4 + h) * 2 + dir;
        int c;
        if (cu >= 64) c = dir ? 3 - (cu - 64) : (cu - 64); else c = 4 + (dir ? 63 - cu : cu);
        const float m0 = m_scan(p, sc, c);
        const float* BC = WSP(float, OFF_BC) + (size_t)sc * UT + u0;
        const float* IG = WSP(float, OFF_IG) + (size_t)sc * UT + u0;
        const float* S = WSP(float, OFF_S) + ((size_t)sc * NCH + c) * SCH;
        const float bj = BC[j];
        f32x4 s[4];
#pragma unroll
        for (int nt = 0; nt < 4; ++nt) s[nt] = f32x4{0.f, 0.f, 0.f, 0.f};
#pragma unroll
        for (int ks = 0; ks < 2; ++ks)
#pragma unroll
            for (int nt = 0; nt < 4; ++nt) {
                Frag kf;
                kf.q = *(const uint4*)(P + (size_t)(row0 + nt * 16 + fr) * PW + PC_MLK + h * 64 + ks * 32 + fq * 8);
                s[nt] = mfma16(kf.v, qf[ks].v, s[nt]);
            }
        float lw[4][4];
        float mx = -1e30f;
#pragma unroll
        for (int nt = 0; nt < 4; ++nt) {
            const float4 bs = *(const float4*)(BC + nt * 16 + fq * 4);
            const float4 is = *(const float4*)(IG + nt * 16 + fq * 4);
            const float bsv[4] = {bs.x, bs.y, bs.z, bs.w}, isv[4] = {is.x, is.y, is.z, is.w};
#pragma unroll
            for (int r = 0; r < 4; ++r) {
                const int sidx = nt * 16 + fq * 4 + r;
                const bool valid = dir ? (sidx >= j) : (sidx <= j);
                lw[nt][r] = valid ? (bj - bsv[r] + isv[r]) : -1e30f;
                mx = fmaxf(mx, lw[nt][r]);
            }
        }
        mx = xq_max(mx);
        const float minter = bj + m0;
        const float mj = fmaxf(minter, mx);
        const float g = fexp(minter - mj);
        float den = 0.f;
#pragma unroll
        for (int nt = 0; nt < 4; ++nt)
#pragma unroll
            for (int r = 0; r < 4; ++r) {
                const float w = fexp(lw[nt][r] - mj);
                const float qk = s[nt][r] * 0.125f * w;
                s[nt][r] = qk;
                den += qk;
            }
        den = xq_sum(den);
        Frag pf[2];
#pragma unroll
        for (int ks = 0; ks < 2; ++ks) {
            pf[ks].u[0] = pk2(s[2 * ks][0], s[2 * ks][1]);
            pf[ks].u[1] = pk2(s[2 * ks][2], s[2 * ks][3]);
            pf[ks].u[2] = pk2(s[2 * ks + 1][0], s[2 * ks + 1][1]);
            pf[ks].u[3] = pk2(s[2 * ks + 1][2], s[2 * ks + 1][3]);
        }
        f32x4 acc[4], accn = f32x4{0.f, 0.f, 0.f, 0.f};
#pragma unroll
        for (int dt = 0; dt < 4; ++dt) acc[dt] = f32x4{0.f, 0.f, 0.f, 0.f};
#pragma unroll
        for (int ks = 0; ks < 2; ++ks) {
            {
                const float4 n0 = *(const float4*)(S + 4096 + ks * 32 + fq * 8), n1 = *(const float4*)(S + 4096 + ks * 32 + fq * 8 + 4);
                Frag nf;
                nf.u[0] = pk2(n0.x, n0.y); nf.u[1] = pk2(n0.z, n0.w); nf.u[2] = pk2(n1.x, n1.y); nf.u[3] = pk2(n1.z, n1.w);
                accn = mfma16(nf.v, qf[ks].v, accn);
            }
#pragma unroll
            for (int dt = 0; dt < 4; ++dt) {
                const float* cp = S + (dt * 16 + fr) * 64 + ks * 32 + fq * 8;
                const float4 c0 = *(const float4*)cp, c1 = *(const float4*)(cp + 4);
                Frag cf;
                cf.u[0] = pk2(c0.x, c0.y); cf.u[1] = pk2(c0.z, c0.w); cf.u[2] = pk2(c1.x, c1.y); cf.u[3] = pk2(c1.z, c1.w);
                acc[dt] = mfma16(cf.v, qf[ks].v, acc[dt]);
            }
        }
#pragma unroll
        for (int dt = 0; dt < 4; ++dt) acc[dt] *= g;
        den += g * accn[0];
#pragma unroll
        for (int ks = 0; ks < 2; ++ks)
#pragma unroll
            for (int dt = 0; dt < 4; ++dt) {
                const u16* vp = T + ((size_t)(b * TW + TC_MLV + h * 64 + dt * 16 + fr)) * UT + u0 + ks * 32 + fq * 4;
                Frag vf;
                vf.d[0] = *(const uint2*)vp;
                vf.d[1] = *(const uint2*)(vp + 16);
                acc[dt] = mfma16(vf.v, pf[ks].v, acc[dt]);
            }
        const float dd = 1.f / fmaxf(fabsf(den), fexp(-mj));
#pragma unroll
        for (int dt = 0; dt < 4; ++dt) hsum[dt] += acc[dt] * dd;
    }
    float ss = 0.f;
#pragma unroll
    for (int dt = 0; dt < 4; ++dt)
#pragma unroll
        for (int r = 0; r < 4; ++r) ss += hsum[dt][r] * hsum[dt][r];
    ss = xq_sum(ss);
    const float rstd = rsqrtf(ss * (1.f / 64.f) + 1e-6f);
    const float* nw = p.ml_norm_w + l * 256 + h * 64;
    u16* orow = P + (size_t)(row0 + j) * PW;
#pragma unroll
    for (int dt = 0; dt < 4; ++dt) {
        const int v0 = dt * 16 + fq * 4;
        const float4 w4 = *(const float4*)(nw + v0);
        const uint2 og = *(const uint2*)(orow + PC_MLO + h * 64 + v0);
        const float y0 = hsum[dt][0] * rstd * w4.x * sigmoidf_(bflo(og.x));
        const float y1 = hsum[dt][1] * rstd * w4.y * sigmoidf_(bfhi(og.x));
        const float y2 = hsum[dt][2] * rstd * w4.z * sigmoidf_(bflo(og.y));
        const float y3 = hsum[dt][3] * rstd * w4.w * sigmoidf_(bfhi(og.y));
        *(uint2*)(orow + ocolbase + h * 64 + v0) = uint2{pk2(y0, y1), pk2(y2, y3)};
    }
}

DEV void ph_attn8(const Params& p, int l, char* smem0, int rbid, int RG) {
    const int n_gq = 768, n_c = (l == 0) ? 96 : 0;
    const int ln_ = (int)((threadIdx.x + p.z) & 63);
    const float bgq = 8.f * wave_max(fabsf(p.gq_qk_w[(l * 2 + 0) * 64 + ln_])) * wave_max(fabsf(p.gq_qk_w[(l * 2 + 1) * 64 + ln_])) * 1.4426950408889634f * 1.03f + 0.5f;
    const float bna = 8.f * wave_max(fabsf(p.na_qk_w[(l * 2 + 0) * 64 + ln_])) * wave_max(fabsf(p.na_qk_w[(l * 2 + 1) * 64 + ln_])) * 1.4426950408889634f * 1.03f + 0.5f;
    for (int it = rbid; it < n_gq + n_c; it += RG) {
        float mfix = bgq;
        int b, qrow0, qcol, kcol, tcol, ua, nt;
        if (it < n_gq) {
            const int qt = it & 15, hq = (it >> 4) % 6;
            b = it / 96; qrow0 = b * SEQ + qt * 256; qcol = PC_GQQ + hq * 64; kcol = PC_GQK + (hq / 3) * 64; tcol = TC_GQV + (hq / 3) * 64; ua = 0; nt = 68;
        } else {
            const int r = it - n_gq;
            const int kind = r / 48, rr = r % 48, hh = rr % 6;
            b = rr / 6; qrow0 = NL + b * CTXL; ua = SEQ; nt = 4;
            if (kind == 0) { qcol = PC_GQQ + hh * 64; kcol = PC_GQK + (hh / 3) * 64; tcol = TC_GQV + (hh / 3) * 64; }
            else { qcol = PC_NAQ + hh * 64; kcol = PC_NAK + hh * 64; tcol = TC_NAV + hh * 64; mfix = bna; }
        }
        flash8_item<2>(p, b, qrow0, qcol, kcol, tcol, ua, nt, smem0, mfix);
    }
}
DEV void ph_attn(const Params& p, int l, char* smem, int bid, int G, int rep) {
    const int n_na = 3072, n_m2 = NSCAN * NCH;
    const int total = n_na + n_m2;
    const int ln_ = VTID & 63;
    float rmax = 0.f;
    for (int i = ln_; i < 6 * 465; i += 64) rmax = fmaxf(rmax, fabsf(p.na_rpb[(size_t)l * 6 * 465 + i]));
    const float mfix_na = (8.f * wave_max(fabsf(p.na_qk_w[(l * 2 + 0) * 64 + ln_])) * wave_max(fabsf(p.na_qk_w[(l * 2 + 1) * 64 + ln_])) * 1.03f + wave_max(rmax)) * 1.4426950408889634f + 0.5f;
    for (int it = bid; it < total; it += G) {
        int r = it;
        if (r < n_na) {
            const int gr = r & 63, hn = (r >> 6) % 6, b = r / 384;
            int rs = gr - 4; rs = rs < 0 ? 0 : (rs > 56 ? 56 : rs);
            flash_item<1, true, 4>(p, b, b * SEQ + gr * 64, PC_NAQ + hn * 64, PC_NAK + hn * 64, TC_NAV + hn * 64, rs * 64, 8, SEQ, 12, gr, rs,
                                p.na_rpb + (size_t)(l * 6 + hn) * 465, smem, PC_NAQ + hn * 64 + (rep ? 1792 : 0), mfix_na);
            continue;
        }
        r -= n_na;
        m2_item(p, r / NCH, r % NCH);
    }
}

DEV void ph_m4(const Params& p, int l, int bid, int G, int rep) {
    const int nch = (l == 0) ? NCH : 64;
    const int total = NB * 4 * nch;
    for (int it = bid; it < total; it += G) {
        const int cu = it % nch, h = (it / nch) & 3, b = it / (nch * 4);
        m4_item(p, l, b, h, cu, rep ? 2048 : PC_MLQ);
    }
}

DEV void ph_merge(const Params& p, int mt0, int mtiles, char* smem, int vid, int G) {
    const u16* H = WSP(u16, OFF_H);
    u16* P = WSP(u16, OFF_P);
    const u16* Wg = WSP(u16, OFF_W) + WE_MIX + (size_t)2944 * 1024;
    const u16* Wbr = WSP(u16, OFF_W) + WE_BR;
    const int lane = VTID & 63, wave = VTID >> 6, wm = wave >> 1, wn = wave & 1, fr = lane & 15, fq = lane >> 4;
    const int total = mtiles * 16;
    for (int t = vid; t < total; t += G) {
        int mt_, nt_;
        tile_decode(t, 16, mt_, nt_);
        mt_ += mt0;
        const int m0 = mt_ * 128, n0 = nt_ * 64;
        f32x4 y[4][2];
        zero_acc<2>(y);
#pragma unroll 1
        for (int br = 0; br < 3; ++br) {
            const int ko = br == 0 ? 0 : (br == 1 ? 256 : 640);
            const int kk = br == 0 ? 256 : 384;
            f32x4 g[4][2];
            zero_acc<2>(g);
            gemm_accum<2>(g, H + (size_t)m0 * D, D, Wg + (size_t)(br * 1024 + n0) * D, D, D, smem, VTID);
#pragma unroll
            for (int i = 0; i < 4; ++i)
#pragma unroll
                for (int jn = 0; jn < 2; ++jn)
#pragma unroll
                    for (int r = 0; r < 4; ++r) g[i][jn][r] = sigmoidf_(g[i][jn][r]);
            f32x4 a[4][2];
            zero_acc<2>(a);
            gemm_accum<2>(a, P + (size_t)m0 * PW + ko, PW, Wbr + (size_t)n0 * D + ko, D, kk, smem, VTID);
#pragma unroll
            for (int i = 0; i < 4; ++i)
#pragma unroll
                for (int jn = 0; jn < 2; ++jn) y[i][jn] += g[i][jn] * a[i][jn];
        }
#pragma unroll
        for (int mt = 0; mt < 4; ++mt)
#pragma unroll
            for (int nt = 0; nt < 2; ++nt)
#pragma unroll
                for (int r = 0; r < 4; ++r) {
                    const int row = m0 + wm * 64 + mt * 16 + fq * 4 + r;
                    const int col = n0 + wn * 32 + nt * 16 + fr;
                    P[(size_t)row * PW + PC_Y + col] = (u16)(pk2(y[mt][nt][r], 0.f) & 0xffff);
                }
    }
}


#ifdef DBG
constexpr size_t OFF_DBG = al256(WS_END);
__global__ void __launch_bounds__(64) dbg_mlstm(Params p, int l) {
    const int sc = blockIdx.x, dir = sc & 1, h = (sc >> 1) & 3, b = sc >> 3, lane = VTID;
    const u16* P = WSP(u16, OFF_P); const u16* T = WSP(u16, OFF_T); const float* Gt = WSP(float, OFF_G);
    float* HN = WSP(float, OFF_S) + (size_t)sc * UT * 64;
    const float bi = p.ml_gate_b[l * 16 + dir * 8 + h], bf = p.ml_gate_b[l * 16 + dir * 8 + 4 + h];
    float C[64], n[64];
    for (int k = 0; k < 64; ++k) { C[k] = 0.f; n[k] = 0.f; }
    float m = 0.f;
    for (int pos = 0; pos < UT; ++pos) {
        int u;
        if (pos < 256) u = SEQ + (dir ? 255 - pos : pos); else u = dir ? 4095 - (pos - 256) : (pos - 256);
        const int row = rowof(b, u);
        const float ig = Gt[(size_t)row * 16 + dir * 8 + h] + bi;
        const float fp = Gt[(size_t)row * 16 + dir * 8 + 4 + h] + bf;
        const float lf = fminf(fp, 0.f) - log1pf(expf(-fabsf(fp)));
        const float mn = fmaxf(lf + m, ig);
        const float fw = expf(lf + m - mn), iw = expf(ig - mn);
        m = mn;
        const float qv = __uint_as_float(((uint32_t)P[(size_t)row * PW + 2048 + h * 64 + lane]) << 16);
        const float kv = __uint_as_float(((uint32_t)P[(size_t)row * PW + PC_MLK + h * 64 + lane]) << 16) * 0.125f;
        const float vv = __uint_as_float(((uint32_t)T[((size_t)(b * TW + TC_MLV + h * 64 + lane)) * UT + u]) << 16);
        float num = 0.f, den = 0.f;
#pragma unroll
        for (int k = 0; k < 64; ++k) {
            const float kk = __shfl(kv, k), qq = __shfl(qv, k);
            C[k] = fw * C[k] + iw * kk * vv;
            n[k] = fw * n[k] + iw * kk;
            num += qq * C[k];
            den += qq * n[k];
        }
        HN[(size_t)u * 64 + lane] = num / fmaxf(fabsf(den), expf(-m));
    }
}
__global__ void dbg_cmp(Params p, int l) {
    const int gid = blockIdx.x * blockDim.x + VTID;
    const u16* P = WSP(u16, OFF_P); const u16* T = WSP(u16, OFF_T);
    unsigned* dw = (unsigned*)(p.ws + OFF_DBG);
    float* df = (float*)(p.ws + OFF_DBG);
    if (gid < NB * 4 * UT) {
        const int u = gid % UT, h = (gid / UT) & 3, b = gid / (UT * 4);
        const int row = rowof(b, u);
        const float* hf = WSP(float, OFF_S) + ((size_t)((b * 4 + h) * 2 + 0) * UT + u) * 64;
        const float* hb = WSP(float, OFF_S) + ((size_t)((b * 4 + h) * 2 + 1) * UT + u) * 64;
        float ss = 0.f;
        for (int v = 0; v < 64; ++v) { const float x = hf[v] + hb[v]; ss += x * x; }
        const float rstd = rsqrtf(ss / 64.f + 1e-6f);
        float md = 0.f;
        for (int v = 0; v < 64; ++v) {
            const float x = (hf[v] + hb[v]) * rstd * p.ml_norm_w[l * 256 + h * 64 + v];
            const float o = __uint_as_float(((uint32_t)P[(size_t)row * PW + PC_MLO + h * 64 + v]) << 16);
            const float y = x / (1.f + expf(-o));
            const float got = __uint_as_float(((uint32_t)P[(size_t)row * PW + PC_MLQ + h * 64 + v]) << 16);
            md += fabsf(y - got);
        }
        atomicAdd(df + (u < SEQ ? 0 : 1), md * (1.f / 64.f));
        return;
    }
    const int w = (gid - NB * 4 * UT) >> 6;
    const int lane = VTID & 63;
    int type, b, qrow, qc, kcol, tcol, ocol, hn = 0, gr = 0, gc = 0, nkeys;
    if (w < 6144) {
        type = 0; const int i = w & 127; hn = (w >> 7) % 6; b = w / 768;
        gr = i & 63; gc = (i < 64) ? gr : 63 - gr;
        qrow = b * SEQ + gr * 64 + gc; qc = 2048 + 256 + hn * 64; kcol = PC_NAK + hn * 64; tcol = TC_NAV + hn * 64; ocol = PC_NAQ + hn * 64; nkeys = 384;
    } else if (w < 6144 + 256) {
        type = 1; const int x = w - 6144; const int i = x & 15, hh = (x >> 4) & 1; b = x >> 5;
        qrow = b * SEQ + (i * 273) % 4096; qc = 2688 + hh * 64; kcol = PC_GQK + hh * 64; tcol = TC_GQV + hh * 64; ocol = PC_GQQ + hh * 3 * 64; nkeys = 4352;
    } else if (w < 6144 + 256 + 768) {
        type = 2; const int x = w - 6400; const int i = x & 15; hn = (x >> 4) % 6; b = x / 96;
        qrow = NL + b * CTXL + (i * 17) % 256; qc = 2048 + 256 + hn * 64; kcol = PC_NAK + hn * 64; tcol = TC_NAV + hn * 64; ocol = PC_NAQ + hn * 64; nkeys = 256;
    } else if (w < 6144 + 256 + 768 + 256) {
        type = 3; const int x = w - 7168; const int i = x & 15, hh = (x >> 4) & 1; b = x >> 5;
        qrow = NL + b * CTXL + (i * 17) % 256; qc = 2688 + hh * 64; kcol = PC_GQK + hh * 64; tcol = TC_GQV + hh * 64; ocol = PC_GQQ + hh * 3 * 64; nkeys = 256;
    } else return;
    const float q = __uint_as_float(((uint32_t)P[(size_t)qrow * PW + qc + lane]) << 16);
    float o = 0.f;
    int rs = gr - 4; rs = rs < 0 ? 0 : (rs > 56 ? 56 : rs);
    int cs = gc - 8; cs = cs < 0 ? 0 : (cs > 48 ? 48 : cs);
    float mx = -1e30f, lsum = 0.f;
    for (int kidx = 0; kidx < nkeys; ++kidx) {
        int u; float bias = 0.f;
        if (type == 0) {
            if (kidx < 128) {
                const int ri = kidx >> 4, ci = kidx & 15;
                u = (rs + ri) * 64 + cs + ci;
                bias = p.na_rpb[(size_t)(l * 6 + hn) * 465 + (rs + ri - gr + 7) * 31 + (cs + ci - gc + 15)];
            } else u = SEQ + (kidx - 128);
        } else if (type == 1) u = kidx;
        else u = SEQ + kidx;
        const int krow = rowof(b, u);
        float sdot = wave_sum(q * __uint_as_float(((uint32_t)P[(size_t)krow * PW + kcol + lane]) << 16));
        sdot += bias;
        const float mn = fmaxf(mx, sdot);
        const float al = expf(mx - mn), e = expf(sdot - mn);
        lsum = lsum * al + e; mx = mn;
        o = o * al + e * __uint_as_float(((uint32_t)T[((size_t)(b * TW + tcol + lane)) * UT + u]) << 16);
    }
    const float got = __uint_as_float(((uint32_t)P[(size_t)qrow * PW + ocol + lane]) << 16);
    float md = wave_max(fabsf(o / lsum - got));
    if (lane == 0) atomicMax(dw + 2 + type, __float_as_uint(md));
}
__global__ void dbg_copy(Params p) {
    u16* P = WSP(u16, OFF_P);
    for (size_t i = (size_t)blockIdx.x * 256 + VTID; i < (size_t)MTOT * 768; i += (size_t)gridDim.x * 256) {
        const size_t row = i / 768, c = i % 768;
        const size_t src = c < 640 ? c : (c < 704 ? PC_GQQ + (c - 640) : PC_GQQ + 192 + (c - 704));
        P[row * PW + 2048 + c] = P[row * PW + src];
    }
}
DEV int dbg_row(int sr) { return sr < 8 ? sr * 4096 + (sr * 577 + 13) % 4096 : NL + (sr - 8) * 256 + ((sr - 8) * 37 + 5) % 256; }
DEV float* dbg_xrow(const Params& p, int row) { return row < NL ? p.out + (size_t)row * D : WSP(float, OFF_XC) + (size_t)(row - NL) * D; }
DEV float dbg_mod(const Params& p, int l, int b9, int idx, int n) {
    float a = p.ada_b[l * 9216 + idx * 1024 + n];
    for (int k = 0; k < 1024; ++k) {
        const float c = b9 < 8 ? p.c[b9 * 1024 + k] : p.c_ctx[k];
        a += c / (1.f + expf(-c)) * p.ada_w[((size_t)l * 1024 + k) * 9216 + idx * 1024 + n];
    }
    return a;
}
DEV float blk_sum(float v, float* red) {
    v = wave_sum(v);
    __syncthreads();
    if ((VTID & 63) == 0) red[VTID >> 6] = v;
    __syncthreads();
    return red[0] + red[1] + red[2] + red[3];
}
DEV float blk_max(float v, float* red) {
    v = wave_max(v);
    __syncthreads();
    if ((VTID & 63) == 0) red[VTID >> 6] = v;
    __syncthreads();
    return fmaxf(fmaxf(red[0], red[1]), fmaxf(red[2], red[3]));
}
__global__ void dbg_save(Params p, int slot) {
    const int sr = blockIdx.x, row = dbg_row(sr);
    float* dst = (float*)(p.ws + OFF_DBG + 256) + ((size_t)slot * 16 + sr) * 1024;
    const float* src = dbg_xrow(p, row);
    for (int n = VTID; n < 1024; n += 256) dst[n] = src[n];
}
DEV float dbg_modulate(const Params& p, int l, int sub, int b9, const float* xs, float* hs, float* red) {
    float ss = 0.f;
    for (int n = VTID; n < 1024; n += 256) ss += xs[n] * xs[n];
    ss = blk_sum(ss, red);
    const float rstd = rsqrtf(ss / 1024.f + 1e-6f);
    float md = 0.f;
    for (int n = VTID; n < 1024; n += 256) {
        const float sh = dbg_mod(p, l, b9, 3 * sub, n), sc = dbg_mod(p, l, b9, 3 * sub + 1, n);
        md = fmaxf(md, fabsf(sh - WSP(float, OFF_MODS)[b9 * 9216 + (3 * sub) * 1024 + n]));
        md = fmaxf(md, fabsf(sc - WSP(float, OFF_MODS)[b9 * 9216 + (3 * sub + 1) * 1024 + n]));
        hs[n] = xs[n] * rstd * p.norm_w[(l * 3 + sub) * 1024 + n] * (1.f + sc) + sh;
    }
    __syncthreads();
    return md;
}
__global__ void __launch_bounds__(256) dbg_ffn(Params p, int l, int which, int slot, int bit) {
    __shared__ float xs[1024], hs[1024], gs[1024], as[2816], red[4];
    const int sr = blockIdx.x, row = dbg_row(sr), b9 = row < NL ? row >> 12 : 8, sub = which ? 2 : 0;
    const float* xin = (const float*)(p.ws + OFF_DBG + 256) + ((size_t)slot * 16 + sr) * 1024;
    for (int n = VTID; n < 1024; n += 256) xs[n] = xin[n];
    __syncthreads();
    float mdm = dbg_modulate(p, l, sub, b9, xs, hs, red);
    for (int n = VTID; n < 1024; n += 256) gs[n] = dbg_mod(p, l, b9, 3 * sub + 2, n);
    const float* win = p.ffn_w_in + (size_t)(l * 2 + which) * 1024 * 5632;
    const float* wout = p.ffn_w_out + (size_t)(l * 2 + which) * 2816 * 1024;
    for (int j = VTID; j < 2816; j += 256) {
        float g = 0.f, u = 0.f;
        for (int k = 0; k < 1024; ++k) { g += hs[k] * win[(size_t)k * 5632 + j]; u += hs[k] * win[(size_t)k * 5632 + 2816 + j]; }
        as[j] = g / (1.f + expf(-g)) * u;
    }
    __syncthreads();
    float md = 0.f;
    const float* xc = dbg_xrow(p, row);
    for (int n = VTID; n < 1024; n += 256) {
        float o = 0.f;
        for (int j = 0; j < 2816; ++j) o += as[j] * wout[(size_t)j * 1024 + n];
        md = fmaxf(md, fabsf(xs[n] + 0.5f * gs[n] * o - xc[n]));
    }
    md = blk_max(md, red);
    mdm = blk_max(mdm, red);
    unsigned* dw = (unsigned*)(p.ws + OFF_DBG);
    if (VTID == 0) { atomicMax(dw + bit, __float_as_uint(md)); atomicMax(dw + 15, __float_as_uint(mdm)); }
}
__global__ void __launch_bounds__(256) dbg_pchk(Params p, int l) {
    __shared__ float xs[1024], hs[1024], red[4];
    const int sr = blockIdx.x, row = dbg_row(sr), b9 = row < NL ? row >> 12 : 8;
    const float* xin = dbg_xrow(p, row);
    for (int n = VTID; n < 1024; n += 256) xs[n] = xin[n];
    __syncthreads();
    float mdm = dbg_modulate(p, l, 1, b9, xs, hs, red);
    const float* w = p.mix_w_in + (size_t)l * 1024 * NIN;
    const u16* P = WSP(u16, OFF_P); const u16* T = WSP(u16, OFF_T);
    int b, u;
    if (row < NL) { b = row >> 12; u = row & 4095; } else { b = (row - NL) >> 8; u = SEQ + ((row - NL) & 255); }
    float md = 0.f;
    for (int n = VTID; n < 2832; n += 256) {
        const int sc = map_col(2, n);
        float v = 0.f;
        for (int k = 0; k < 1024; ++k) v += hs[k] * w[(size_t)k * NIN + sc];
        if (n < 2048) md = fmaxf(md, fabsf(v - __uint_as_float(((uint32_t)P[(size_t)row * PW + n]) << 16)));
        if (n >= 1280 && n < 1536) md = fmaxf(md, fabsf(v - __uint_as_float(((uint32_t)T[((size_t)(b * TW + n - 1280)) * UT + u]) << 16)));
        if (n >= 2048 && n < 2816) md = fmaxf(md, fabsf(v - __uint_as_float(((uint32_t)T[((size_t)(b * TW + n - 1792)) * UT + u]) << 16)));
        if (n >= 2816) md = fmaxf(md, fabsf(v - WSP(float, OFF_G)[(size_t)row * 16 + n - 2816]));
    }
    md = blk_max(md, red);
    mdm = blk_max(mdm, red);
    unsigned* dw = (unsigned*)(p.ws + OFF_DBG);
    if (VTID == 0) { atomicMax(dw + 9, __float_as_uint(md)); atomicMax(dw + 15, __float_as_uint(mdm)); }
}
__global__ void __launch_bounds__(256) dbg_mix(Params p, int l, int slot) {
    __shared__ float xs[1024], hs[1024], os[1024], ys[1024], red[4];
    const int sr = blockIdx.x, row = dbg_row(sr), b9 = row < NL ? row >> 12 : 8;
    const float* xin = (const float*)(p.ws + OFF_DBG + 256) + ((size_t)slot * 16 + sr) * 1024;
    const u16* P = WSP(u16, OFF_P);
    for (int n = VTID; n < 1024; n += 256) { xs[n] = xin[n]; os[n] = __uint_as_float(((uint32_t)P[(size_t)row * PW + n]) << 16); }
    __syncthreads();
    float mdm = dbg_modulate(p, l, 1, b9, xs, hs, red);
    const float* w = p.mix_w_in + (size_t)l * 1024 * NIN;
    for (int n = VTID; n < 1024; n += 256) {
        float y = 0.f;
        for (int i = 0; i < 3; ++i) {
            float g = 0.f;
            for (int k = 0; k < 1024; ++k) g += hs[k] * w[(size_t)k * NIN + 2832 + i * 1024 + n];
            g = 1.f / (1.f + expf(-g));
            const float* wb = i == 0 ? p.w_br_ml + (size_t)l * 256 * 1024 : (i == 1 ? p.w_br_na + (size_t)l * 384 * 1024 : p.w_br_gq + (size_t)l * 384 * 1024);
            const int ko = i == 0 ? 0 : (i == 1 ? 256 : 640), kk = i == 0 ? 256 : 384;
            float a = 0.f;
            for (int k = 0; k < kk; ++k) a += os[ko + k] * wb[(size_t)k * 1024 + n];
            y += g * a;
        }
        ys[n] = y;
    }
    __syncthreads();
    float md = 0.f;
    const float* xc = dbg_xrow(p, row);
    for (int n = VTID; n < 1024; n += 256) {
        float o = 0.f;
        for (int k = 0; k < 1024; ++k) o += ys[k] * p.w_out[((size_t)l * 1024 + k) * 1024 + n];
        const float g5 = dbg_mod(p, l, b9, 5, n);
        md = fmaxf(md, fabsf(xs[n] + g5 * o - xc[n]));
    }
    md = blk_max(md, red);
    mdm = blk_max(mdm, red);
    unsigned* dw = (unsigned*)(p.ws + OFF_DBG);
    if (VTID == 0) { atomicMax(dw + 10, __float_as_uint(md)); atomicMax(dw + 15, __float_as_uint(mdm)); }
}
__global__ void dbg_fin(Params p) {
    const unsigned* dw = (const unsigned*)(p.ws + OFF_DBG);
    int mask = 0;
    if (__uint_as_float(dw[8]) > 0.02f) mask |= 1;
    if (__uint_as_float(dw[9]) > 0.03f) mask |= 2;
    if (__uint_as_float(dw[10]) > 0.02f) mask |= 4;
    if (__uint_as_float(dw[11]) > 0.02f) mask |= 8;
    if (__uint_as_float(dw[15]) > 1e-3f) mask |= 16;
    if (__uint_as_float(dw[4]) > 0.03f) mask |= 32;
    p.out[0] += 10.f * (float)mask;
    p.out[1] += 1000.f * __uint_as_float(dw[4]);
}
#endif


DEV void gemm8b_accum(f32x4 (&acc)[4][4], const u16* __restrict__ A, int lda, const u16* __restrict__ B, int ldb, int K, char* smem, int tid) {
    constexpr int STAGE = 49152;
    const int lane = tid & 63, wave = tid >> 6;
    const int wm = wave >> 1, wn = wave & 1, fr = lane & 15, fq = lane >> 4;
    const int lr = lane >> 3, pos = lane & 7;
    const int ce = pos ^ (lr >> 1), co = pos ^ (4 | (lr >> 1));
    const unsigned ra_ = (unsigned)((wave * 32 + lr) * lda) * 2u, rb_ = (unsigned)((wave * 16 + lr) * ldb) * 2u;
    const unsigned voa_e = ra_ + ce * 16, voa_o = ra_ + co * 16, vob_e = rb_ + ce * 16, vob_o = rb_ + co * 16;
    const int nk = K >> 6;
    const unsigned ldsb = (unsigned)(size_t)(__attribute__((address_space(3))) char*)smem;
    const unsigned ldsa_w = __builtin_amdgcn_readfirstlane(ldsb + wave * 4096);
    const unsigned ldsb_w = __builtin_amdgcn_readfirstlane(ldsb + 32768 + wave * 2048);
#define G8B_ISSUE(STG, K0) do { \
        _Pragma("unroll") for (int i = 0; i < 4; ++i) glds16(A + (size_t)(8 * i) * lda + (K0), (i & 1) ? voa_o : voa_e, ldsa_w + (STG) * STAGE + i * 1024); \
        _Pragma("unroll") for (int i = 0; i < 2; ++i) glds16(B + (size_t)(8 * i) * ldb + (K0), (i & 1) ? vob_o : vob_e, ldsb_w + (STG) * STAGE + i * 1024); \
    } while (0)
    G8B_ISSUE(0, 0);
    VM_WAIT0();
    __syncthreads();
    const int s3 = (fr >> 1) & 7;
    const int oa_base = (wm * 64 + fr) * 128 + ((fq ^ s3) * 16);
    const int ob_base = 32768 + (wn * 64 + fr) * 128 + ((fq ^ s3) * 16);
    for (int kt = 0; kt < nk; ++kt) {
        const int cur = kt & 1;
        const int k0 = (kt + 1 < nk ? kt + 1 : kt) * 64;
        G8B_ISSUE(cur ^ 1, k0);
        int o_a = cur * STAGE + oa_base, o_b = cur * STAGE + ob_base;
        asm volatile("" : "+v"(o_a), "+v"(o_b));
#pragma unroll
        for (int ks = 0; ks < 2; ++ks) {
            const char* sa_c = smem + (ks ? (o_a ^ 64) : o_a);
            const char* sb_c = smem + (ks ? (o_b ^ 64) : o_b);
            bf16x8 bfr[4], af[4];
#pragma unroll
            for (int nt = 0; nt < 4; ++nt) bfr[nt] = *(const bf16x8*)(sb_c + nt * 2048);
#pragma unroll
            for (int mt = 0; mt < 4; ++mt) af[mt] = *(const bf16x8*)(sa_c + mt * 2048);
#pragma unroll
            for (int mt = 0; mt < 4; ++mt)
#pragma unroll
                for (int nt = 0; nt < 4; ++nt) acc[mt][nt] = mfma16(af[mt], bfr[nt], acc[mt][nt]);
            __builtin_amdgcn_sched_group_barrier(0x100, 7, 0);
            __builtin_amdgcn_sched_group_barrier(0x008, 4, 0);
            __builtin_amdgcn_sched_group_barrier(0x100, 1, 0);
#pragma unroll
            for (int i = 0; i < 3; ++i) __builtin_amdgcn_sched_group_barrier(0x008, 4, 0);
        }
        VM_WAIT0();
        __syncthreads();
    }
#undef G8B_ISSUE
}

DEV void ph_merge8(const Params& p, char* smem, int rvid, int RG, int tid) {
    const u16* H = WSP(u16, OFF_H);
    u16* P = WSP(u16, OFF_P);
    const u16* Wg = WSP(u16, OFF_W) + WE_MIX + (size_t)2944 * 1024;
    const u16* Wbr = WSP(u16, OFF_W) + WE_BR;
    const int lane = tid & 63, wave = tid >> 6, wm = wave >> 1, wn = wave & 1, fr = lane & 15, fq = lane >> 4;
    const int total = 128 * 8;
    for (int t = rvid; t < total; t += RG) {
        const int gi = t >> 5, rem = t & 31;
        const int mt_ = gi * 4 + (rem & 3), nt_ = rem >> 2;
        const int m0 = mt_ * 256, n0 = nt_ * 128;
        f32x4 y[4][4];
        zero_acc<4>(y);
#pragma unroll 1
        for (int br = 0; br < 3; ++br) {
            const int ko = br == 0 ? 0 : (br == 1 ? 256 : 640);
            const int kk = br == 0 ? 256 : 384;
            uint32_t gpk[4][4][2];
            {
                f32x4 g[4][4];
                zero_acc<4>(g);
                gemm8b_accum(g, H + (size_t)m0 * D, D, Wg + (size_t)(br * 1024 + n0) * D, D, D, smem, tid);
#pragma unroll
                for (int i = 0; i < 4; ++i)
#pragma unroll
                    for (int jn = 0; jn < 4; ++jn) {
                        gpk[i][jn][0] = pk2(sigmoidf_(g[i][jn][0]), sigmoidf_(g[i][jn][1]));
                        gpk[i][jn][1] = pk2(sigmoidf_(g[i][jn][2]), sigmoidf_(g[i][jn][3]));
                    }
            }
            f32x4 a[4][4];
            zero_acc<4>(a);
            gemm8b_accum(a, P + (size_t)m0 * PW + ko, PW, Wbr + (size_t)n0 * D + ko, D, kk, smem, tid);
#pragma unroll
            for (int i = 0; i < 4; ++i)
#pragma unroll
                for (int jn = 0; jn < 4; ++jn) {
                    y[i][jn][0] += bflo(gpk[i][jn][0]) * a[i][jn][0];
                    y[i][jn][1] += bfhi(gpk[i][jn][0]) * a[i][jn][1];
                    y[i][jn][2] += bflo(gpk[i][jn][1]) * a[i][jn][2];
                    y[i][jn][3] += bfhi(gpk[i][jn][1]) * a[i][jn][3];
                }
        }
#pragma unroll
        for (int mt = 0; mt < 4; ++mt)
#pragma unroll
            for (int nt = 0; nt < 4; ++nt)
#pragma unroll
                for (int r = 0; r < 4; ++r) {
                    const int row = m0 + wm * 64 + mt * 16 + fq * 4 + r;
                    const int col = n0 + wn * 64 + nt * 16 + fr;
                    P[(size_t)row * PW + PC_Y + col] = (u16)(pk2(y[mt][nt][r], 0.f) & 0xffff);
                }
    }
}

constexpr int PH_PER_LAYER = 15;
constexpr int N_PHASES = 2 * PH_PER_LAYER;

#ifndef REPEAT_MASK
#define REPEAT_MASK 0
#endif
template <int Q>
DEV void run_phase_q(const Params& p, int l, char* smem) {
    const int half = (int)((threadIdx.x + p.z) >> 8);
    const int G = gridDim.x * 2, bid = blockIdx.x * 2 + half;
    const int vid = (gridDim.x % 8 == 0) ? (int)(blockIdx.x & 7) * (G >> 3) + (int)(blockIdx.x >> 3) * 2 + half : bid;
    smem += half * 73728;
    const bool last = (l == 1);
    const u16* W = WSP(u16, OFF_W);
    const int nrep = ((REPEAT_MASK >> Q) & 1) ? 2 : 1;
    char* smem0 = smem - half * 73728;
    const int rtid = (int)(threadIdx.x + p.z);
    const int RG = gridDim.x;
    const int rvid = (RG % 8 == 0) ? (int)(blockIdx.x & 7) * (RG >> 3) + (int)(blockIdx.x >> 3) : (int)blockIdx.x;
    for (int rep = 0; rep < nrep; ++rep) {
        const float cm = rep ? 0.f : 1.f;
        if (Q == 0) ph_prep(p, l, smem, bid, G);
        if (Q == 1) ph_mod(p, l, 0, MTOT, bid, G);
        Params p2 = p;
        if (Q == 2) { ph_ffn_in8(p, 0, 136, smem0, rvid, RG, rtid); }
        if (Q == 3) { ph_resid8(p, WSP(u16, OFF_P), DFF, W + WE_OUT0, DFF, 2, 0.5f * cm, smem0, rvid, RG, rtid, l == 0 ? p.x : p.out); int z2 = p.z; asm volatile("" : "+s"(z2) :: "memory"); p2.z = z2;
                      ph_resid(p2, WSP(u16, OFF_P), DFF, W + WE_OUT0, DFF, 2, 0.5f * cm, 256, 16, smem, vid, G); }
        if (Q == 4) ph_mod(p, l, 1, MTOT, bid, G);
        if (Q == 5) { ph_pgemm8(p, l, smem0, rvid, RG, rtid); int z2 = p.z; asm volatile("" : "+s"(z2) :: "memory"); p2.z = z2; ph_pgemm(p2, 256, 16, smem, vid, G); }
        if (Q == 6) ph_qknorm_gates(p, l, bid, G);
        if (Q == 7) { ph_attn8(p, l, smem0, rvid, RG); int z2 = p.z; asm volatile("" : "+s"(z2) :: "memory"); p2.z = z2; ph_attn(p2, l, smem, bid, G, rep); }
        if (Q == 8) ph_m3(p, bid, G);
        if (Q == 9) ph_m4(p, l, bid, G, rep);
        if (Q == 10) { ph_merge8(p, smem0, rvid, RG, rtid); int z2 = p.z; asm volatile("" : "+s"(z2) :: "memory"); p2.z = z2; if (!last) ph_merge(p2, 256, 16, smem, vid, G); }
        if (Q == 11) { ph_resid8(p, WSP(u16, OFF_P) + PC_Y, PW, W + WE_O, D, 5, 1.0f * cm, smem0, rvid, RG, rtid, p.out);
                       int z2 = p.z; asm volatile("" : "+s"(z2) :: "memory"); p2.z = z2;
                       if (!last) ph_resid(p2, WSP(u16, OFF_P) + PC_Y, PW, W + WE_O, D, 5, 1.0f * cm, 256, 16, smem, vid, G); }
        if (Q == 12) ph_mod(p, l, 2, last ? NL : MTOT, bid, G);
        if (Q == 13) { ph_ffn_in8(p, 1, last ? 128 : 136, smem0, rvid, RG, rtid); }
        if (Q == 14) { ph_resid8(p, WSP(u16, OFF_P), DFF, W + WE_OUT1, DFF, 8, 0.5f * cm, smem0, rvid, RG, rtid, p.out);
                       int z2 = p.z; asm volatile("" : "+s"(z2) :: "memory"); p2.z = z2;
                       if (!last) ph_resid(p2, WSP(u16, OFF_P), DFF, W + WE_OUT1, DFF, 8, 0.5f * cm, 256, 16, smem, vid, G); }
    }
}

DEV void run_phase(const Params& p, int ph, char* smem) {
    const int l = ph / PH_PER_LAYER, q = ph % PH_PER_LAYER;
    switch (q) {
        case 0: run_phase_q<0>(p, l, smem); break;
        case 1: run_phase_q<1>(p, l, smem); break;
        case 2: run_phase_q<2>(p, l, smem); break;
        case 3: run_phase_q<3>(p, l, smem); break;
        case 4: run_phase_q<4>(p, l, smem); break;
        case 5: run_phase_q<5>(p, l, smem); break;
        case 6: run_phase_q<6>(p, l, smem); break;
        case 7: run_phase_q<7>(p, l, smem); break;
        case 8: run_phase_q<8>(p, l, smem); break;
        case 9: run_phase_q<9>(p, l, smem); break;
        case 10: run_phase_q<10>(p, l, smem); break;
        case 11: run_phase_q<11>(p, l, smem); break;
        case 12: run_phase_q<12>(p, l, smem); break;
        case 13: run_phase_q<13>(p, l, smem); break;
        case 14: run_phase_q<14>(p, l, smem); break;
    }
}

template <int Q>
__global__ void __launch_bounds__(256, 2) phase_kernel(Params p, int l) {
    __shared__ __attribute__((aligned(16))) char smem[73728];
    run_phase_q<Q>(p, l, smem);
}

#if ONE_LAUNCH
#define XB_TMO      128
#define XB_XCNT(j)  (256  + 64 * (j))
#define XB_XSUB(j)  (1280 + 64 * (j))
#define XB_XGEN(j)  (2304 + 64 * (j))
#define XB_TOP      3328
#define XB_TOPGEN   3392
#define XB_SPIN_CAP (1u << 22)
DEV unsigned xb_ld(unsigned* q) { return __hip_atomic_load(q, __ATOMIC_RELAXED, __HIP_MEMORY_SCOPE_AGENT); }
DEV unsigned xb_add(unsigned* q, unsigned v) { return __hip_atomic_fetch_add(q, v, __ATOMIC_RELAXED, __HIP_MEMORY_SCOPE_AGENT); }
DEV unsigned xb_xcc_id() { return (unsigned)__builtin_amdgcn_s_getreg((3 << 11) | 20) & 0xFu; }
#define XB_SPIN(cond, bar) do { unsigned _sp = 0; while (cond) { __builtin_amdgcn_s_sleep(1); \
    if ((++_sp & 255u) == 0u) { if (xb_ld(&(bar)[XB_TMO])) break; if (_sp > XB_SPIN_CAP) { atomicAdd(&(bar)[XB_TMO], 1u); break; } } } } while (0)
DEV void xcd_census(unsigned* bar, unsigned x, unsigned& nloc, unsigned& nx) {
    const unsigned G = gridDim.x;
    unsigned sum, cnt, mine, sp = 0u;
    for (;;) {
        sum = 0u; cnt = 0u; mine = 0u;
#pragma unroll
        for (unsigned j = 0; j < 16; ++j) { const unsigned c = xb_ld(&bar[XB_XCNT(j)]); sum += c; cnt += (c > 0u) ? 1u : 0u; mine = (j == x) ? c : mine; }
        if (sum == G) break;
        __builtin_amdgcn_s_sleep(1);
        if ((++sp & 255u) == 0u) { if (xb_ld(&bar[XB_TMO])) break; if (sp > XB_SPIN_CAP) { atomicAdd(&bar[XB_TMO], 1u); break; } }
    }
    nloc = mine > 0u ? mine : 1u; nx = cnt > 0u ? cnt : 1u;
}
DEV void xcd_barrier(unsigned* bar, unsigned x, volatile unsigned* st, int tid) {
    asm volatile("s_waitcnt vmcnt(0)" ::: "memory");
    __syncthreads();
    if (tid == 0) {
        __builtin_amdgcn_s_waitcnt(0);
        unsigned nloc = st[0], nx = st[1];
        if (nloc == 0u) { xcd_census(bar, x, nloc, nx); st[0] = nloc; st[1] = nx; }
        const unsigned old = xb_add(&bar[XB_XSUB(x)], 1u);
        const unsigned gen = old / nloc;
        if (old + 1u == (gen + 1u) * nloc) {
            __builtin_amdgcn_fence(__ATOMIC_RELEASE, "agent");
            asm volatile("s_waitcnt vmcnt(0)" ::: "memory");
            const unsigned og = xb_add(&bar[XB_TOP], 1u);
            const unsigned tg = og / nx;
            if (og + 1u == (tg + 1u) * nx) xb_add(&bar[XB_TOPGEN], 1u);
            else XB_SPIN(xb_ld(&bar[XB_TOPGEN]) == tg, bar);
            __builtin_amdgcn_fence(__ATOMIC_ACQUIRE, "agent");
            xb_add(&bar[XB_XGEN(x)], 1u);
            asm volatile("s_waitcnt vmcnt(0)" ::: "memory");
        } else {
            XB_SPIN(xb_ld(&bar[XB_XGEN(x)]) == gen, bar);
            __builtin_amdgcn_fence(__ATOMIC_ACQUIRE, "agent");
            asm volatile("s_waitcnt vmcnt(0)" ::: "memory");
        }
    }
    __syncthreads();
}
__global__ void __launch_bounds__(512, 2) mega_kernel(Params p0, int ph_begin, int ph_end) {
    __shared__ __attribute__((aligned(16))) char smem[147456];
    __shared__ uint4 xb_words;
    unsigned* bar = (unsigned*)(p0.ws + OFF_BAR);
    const unsigned xcc = xb_xcc_id();
    if (threadIdx.x == 0) { xb_words = make_uint4(0u, 0u, 0u, 0u); (void)xb_add(&bar[XB_XCNT(xcc)], 1u); }
    __syncthreads();
    for (int ph = ph_begin; ph < ph_end; ++ph) {
        Params p = p0;
        int z = p0.z;
        asm volatile("" : "+s"(z));
        p.z = z;
        p.ws = p0.ws + z;
        p.out = p0.out + z;
        run_phase(p, ph, smem);
        if (ph + 1 < ph_end) {
            if (p0.z == 0x7fffffff) cg::this_grid().sync();
            xcd_barrier(bar, xcc, (volatile unsigned*)&xb_words, (int)threadIdx.x + z);
        }
    }
}
#endif

extern "C" void kernel_launch(void* const* d_in, const int* in_sizes, int n_in, void* d_out, int out_size, void* d_ws, size_t ws_size,
                              hipStream_t stream) {
    if (ws_size < WS_END) { fprintf(stderr, "workspace too small: %zu < %zu\n", ws_size, (size_t)WS_END); return; }
    Params p{};
    p.x = (const float*)d_in[0]; p.c = (const float*)d_in[1]; p.ctx = (const float*)d_in[2]; p.c_ctx = (const float*)d_in[3];
    p.ada_w = (const float*)d_in[4]; p.ada_b = (const float*)d_in[5]; p.norm_w = (const float*)d_in[6];
    p.ffn_w_in = (const float*)d_in[7]; p.ffn_w_out = (const float*)d_in[8]; p.mix_w_in = (const float*)d_in[9];
    p.ml_gate_b = (const float*)d_in[10]; p.ml_norm_w = (const float*)d_in[11]; p.na_qk_w = (const float*)d_in[12];
    p.na_rpb = (const float*)d_in[13]; p.gq_qk_w = (const float*)d_in[14]; p.w_br_ml = (const float*)d_in[15];
    p.w_br_na = (const float*)d_in[16]; p.w_br_gq = (const float*)d_in[17]; p.w_out = (const float*)d_in[18];
    p.out = (float*)d_out; p.ws = (char*)d_ws;
#ifdef NANFILL
    hipMemsetAsync(d_ws, 0xFF, WS_END, stream);
#endif
#if ONE_LAUNCH
    static int grid_blocks = 0;
    if (!grid_blocks) {
        int dev = 0, cus = 0, per_cu = 0;
        hipGetDevice(&dev);
        hipDeviceGetAttribute(&cus, hipDeviceAttributeMultiprocessorCount, dev);
        hipOccupancyMaxActiveBlocksPerMultiprocessor(&per_cu, mega_kernel, 512, 0);
        per_cu = 1;
        grid_blocks = cus * per_cu;
    }
    hipMemsetAsync((char*)d_ws + OFF_BAR, 0, 3456 * 4, stream);
    int pb = 0, pe = N_PHASES;
    void* args[] = {&p, &pb, &pe};
#ifdef SPLIT_TEST
    (void)args;
    for (int ph = 0; ph < N_PHASES; ++ph) mega_kernel<<<grid_blocks, 256, 0, stream>>>(p, ph, ph + 1);
#else
    hipError_t e = hipLaunchCooperativeKernel((void*)mega_kernel, dim3(grid_blocks), dim3(512), args, 0, stream);
    if (e != hipSuccess) fprintf(stderr, "cooperative launch failed: %s (grid %d)\n", hipGetErrorString(e), grid_blocks);
#endif
#else
    for (int l = 0; l < 2; ++l) {
#define LP(Q) phase_kernel<Q><<<512, 256, 0, stream>>>(p, l)
#ifdef DBG
        const bool dl = (l == DBG_LAYER);
        if (dl) hipMemsetAsync((char*)d_ws + OFF_DBG, 0, 256, stream);
        LP(0);
        if (dl) dbg_save<<<16, 256, 0, stream>>>(p, 0);
        LP(1); LP(2); LP(3);
        if (dl) dbg_ffn<<<16, 256, 0, stream>>>(p, l, 0, 0, 8);
        LP(4); LP(5);
        if (dl) dbg_pchk<<<16, 256, 0, stream>>>(p, l);
        LP(6);
        if (dl) dbg_copy<<<2048, 256, 0, stream>>>(p);
        LP(7); LP(8); LP(9);
        if (dl) {
            dbg_mlstm<<<64, 64, 0, stream>>>(p, l);
            dbg_cmp<<<(NB * 4 * UT + 7424 * 64 + 255) / 256, 256, 0, stream>>>(p, l);
            dbg_save<<<16, 256, 0, stream>>>(p, 1);
        }
        LP(10); LP(11);
        if (dl) { dbg_mix<<<16, 256, 0, stream>>>(p, l, 1); dbg_save<<<16, 256, 0, stream>>>(p, 2); }
        LP(12); LP(13); LP(14);
        if (dl) dbg_ffn<<<16, 256, 0, stream>>>(p, l, 1, 2, 11);
#else
        LP(0); LP(1); LP(2); LP(3); LP(4); LP(5); LP(6); LP(7); LP(8); LP(9); LP(10); LP(11); LP(12); LP(13); LP(14);
#endif
#undef LP
    }
#ifdef DBG
    dbg_fin<<<1, 1, 0, stream>>>(p);
#endif
#endif
}
```
